# Optimizing an MI355X kernel written in HIP

```python
import math
import jax, jax.numpy as jnp
from jax import lax
import numpy as np

D_MODEL = 1024
BATCH = 4
SEQ = 8192
DEPTH = 1

CHUNK = 64
Q_BLOCK = 128
EPS = 1e-6
ROPE_THETA = 10000.0

DA_HEADS = 4
DA_HEAD_DIM = 64
DA_V_DIM = 2 * DA_HEAD_DIM
DA_QK_WIDTH = DA_HEADS * 2 * DA_HEAD_DIM
DA_WIDTH = DA_HEADS * DA_V_DIM

HG_HEADS = 4
HG_KEY_DIM = 128
HG_V_DIM = 128
HG_WIDTH = HG_HEADS * HG_KEY_DIM

N_BRANCHES = 2
IN_SPLITS = [DA_QK_WIDTH, DA_QK_WIDTH, DA_WIDTH,
             HG_WIDTH, HG_WIDTH, HG_HEADS * HG_V_DIM, HG_HEADS * HG_V_DIM,
             D_MODEL, D_MODEL]
IN_COLS = sum(IN_SPLITS)

N_EXPERTS = 32
TOP_K = 4
D_EXPERT = D_MODEL
SWIGLU_LIMIT = 7.0
SWIGLU_ALPHA = 1.702
MOE_BLOCK = 256

kernel_name = "hybrid_diffattn_hgrn2_moe_block"


def rms_norm(x, w):
    xf = x.astype(jnp.float32)
    y = xf * lax.rsqrt(jnp.mean(xf * xf, axis=-1, keepdims=True) + EPS)
    return (y * w.astype(jnp.float32)).astype(x.dtype)


def rope_tables(seq, dtype):
    pos = jnp.arange(seq, dtype=jnp.float32)
    inv = ROPE_THETA ** (-jnp.arange(0, DA_HEAD_DIM, 2, dtype=jnp.float32) / DA_HEAD_DIM)
    ang = pos[:, None] * inv[None, :]
    cos = jnp.cos(ang)[:, None, None, :].astype(dtype)
    sin = jnp.sin(ang)[:, None, None, :].astype(dtype)
    return cos, sin


def apply_rope(x, cos, sin):
    x1, x2 = jnp.split(x, 2, axis=-1)
    return jnp.concatenate([x1 * cos - x2 * sin, x2 * cos + x1 * sin], axis=-1)


def diff_attention(q, k, v, lam, lambda_init, subln_w, cos, sin):
    B, S = q.shape[0], q.shape[1]
    q = apply_rope(q, cos, sin).transpose(0, 2, 3, 1, 4)
    k = apply_rope(k, cos, sin).transpose(0, 2, 3, 1, 4)
    v = v.transpose(0, 2, 1, 3)
    nb = S // Q_BLOCK
    q_blocks = q.reshape(B, DA_HEADS, 2, nb, Q_BLOCK, DA_HEAD_DIM).transpose(3, 0, 1, 2, 4, 5)
    key_chunk = jnp.arange(S) // CHUNK
    scale = DA_HEAD_DIM ** -0.5
    neg = jnp.finfo(jnp.float32).min

    def one_block(args):
        qb, bi = args
        s = jnp.einsum('bhmqd,bhmkd->bhmqk', qb, k).astype(jnp.float32) * scale
        q_chunk = (bi * Q_BLOCK + jnp.arange(Q_BLOCK)) // CHUNK
        mask = key_chunk[None, :] <= q_chunk[:, None]
        p = jax.nn.softmax(jnp.where(mask, s, neg), axis=-1)
        a = p[:, :, 0] - lam * p[:, :, 1]
        return jnp.einsum('bhqk,bhkv->bhqv', a.astype(v.dtype), v)

    o = lax.map(one_block, (q_blocks, jnp.arange(nb)))
    o = o.transpose(1, 0, 3, 2, 4).reshape(B, S, DA_HEADS, DA_V_DIM)
    o = rms_norm(o, subln_w) * (1.0 - lambda_init)
    return o.reshape(B, S, DA_WIDTH)


def hgrn2(q_raw, f_raw, i_in, g_raw, lb, norm_w):
    B, S = q_raw.shape[0], q_raw.shape[1]
    n = S // CHUNK
    lb = lb.reshape(HG_HEADS, HG_KEY_DIM)
    q = jax.nn.silu(q_raw.astype(jnp.float32))
    f = lb + (1.0 - lb) * jax.nn.sigmoid(f_raw.astype(jnp.float32))
    k = 1.0 - f
    logf = jnp.log(f)
    v = i_in.astype(jnp.float32)

    def to_chunks(t):
        return t.reshape(B, n, CHUNK, HG_HEADS, t.shape[-1]).transpose(0, 3, 1, 2, 4)

    q, k, v, logf = to_chunks(q), to_chunks(k), to_chunks(v), to_chunks(logf)
    G = jnp.cumsum(logf, axis=3)
    G_last = G[:, :, :, -1:, :]
    q_t = q * jnp.exp(G)
    k_t = k * jnp.exp(-G)
    k_dec = k * jnp.exp(G_last - G)
    causal = jnp.tril(jnp.ones((CHUNK, CHUNK), dtype=bool))
    A = jnp.where(causal, jnp.einsum('bhncd,bhnsd->bhncs', q_t, k_t), 0.0)
    o_intra = jnp.einsum('bhncs,bhnsv->bhncv', A, v)
    dS = jnp.einsum('bhncd,bhncv->bhndv', k_dec, v)
    decay = jnp.exp(G_last[:, :, :, 0, :])

    def step(state, inp):
        dec, ds = inp
        return dec[..., None] * state + ds, state

    init = jnp.zeros((B, HG_HEADS, HG_KEY_DIM, HG_V_DIM), jnp.float32)
    _, S_prev = lax.scan(step, init, (decay.transpose(2, 0, 1, 3), dS.transpose(2, 0, 1, 3, 4)))
    o_inter = jnp.einsum('bhncd,nbhdv->bhncv', q_t, S_prev)
    o = (o_intra + o_inter).transpose(0, 2, 3, 1, 4).reshape(B, S, HG_HEADS, HG_V_DIM)
    o = rms_norm(o, norm_w) * jax.nn.silu(g_raw.astype(jnp.float32))
    return o.reshape(B, S, HG_HEADS * HG_V_DIM).astype(q_raw.dtype)


def hybrid_mixer(h, w_in, lam, lambda_init, da_subln, lb, hg_norm,
                 w_branch_a, w_branch_b, w_out, cos, sin):
    B, S, _ = h.shape
    proj = h @ w_in
    da_q, da_k, da_v, hg_q, hg_f, hg_i, hg_g, gate_a, gate_b = jnp.split(
        proj, np.cumsum(IN_SPLITS)[:-1].tolist(), axis=-1)
    ya = diff_attention(da_q.reshape(B, S, DA_HEADS, 2, DA_HEAD_DIM),
                        da_k.reshape(B, S, DA_HEADS, 2, DA_HEAD_DIM),
                        da_v.reshape(B, S, DA_HEADS, DA_V_DIM),
                        lam, lambda_init, da_subln, cos, sin)
    hs = lambda t: t.reshape(B, S, HG_HEADS, -1)
    yb = hgrn2(hs(hg_q), hs(hg_f), hs(hg_i), hs(hg_g), lb, hg_norm)
    merged = jax.nn.sigmoid(gate_a) * (ya @ w_branch_a) + jax.nn.sigmoid(gate_b) * (yb @ w_branch_b)
    return merged @ w_out


def moe(h, router_w, router_b, w_gate_up, b_gate_up, w_down, b_down):
    B, S, D = h.shape
    T = B * S
    xf = h.reshape(T, D)
    logits = (xf @ router_w + router_b).astype(jnp.float32)
    top_v, top_i = lax.top_k(logits, TOP_K)
    gates = jax.nn.softmax(top_v, axis=-1)
    n_assign = T * TOP_K
    flat_e = top_i.reshape(-1)
    flat_tok = jnp.arange(n_assign) // TOP_K
    flat_w = gates.reshape(-1)
    order = jnp.argsort(flat_e)
    sorted_e = flat_e[order]
    counts = jnp.zeros((N_EXPERTS,), jnp.int32).at[flat_e].add(1)
    starts = jnp.cumsum(counts) - counts
    padded = ((counts + MOE_BLOCK - 1) // MOE_BLOCK) * MOE_BLOCK
    pad_ends = jnp.cumsum(padded)
    pad_starts = pad_ends - padded
    dest = pad_starts[sorted_e] + (jnp.arange(n_assign) - starts[sorted_e])
    P = ((n_assign + MOE_BLOCK - 1) // MOE_BLOCK) * MOE_BLOCK + N_EXPERTS * MOE_BLOCK
    row_tok = jnp.zeros((P,), jnp.int32).at[dest].set(flat_tok[order])
    row_w = jnp.zeros((P,), jnp.float32).at[dest].set(flat_w[order])
    n_blocks = P // MOE_BLOCK
    block_e = jnp.clip(jnp.searchsorted(pad_ends, jnp.arange(n_blocks) * MOE_BLOCK, side='right'),
                       0, N_EXPERTS - 1)

    def expert_block(args):
        toks, e = args
        xb = xf[toks]
        gu = xb @ w_gate_up[e] + b_gate_up[e]
        g, u = jnp.split(gu, 2, axis=-1)
        g = jnp.minimum(g, SWIGLU_LIMIT)
        u = jnp.clip(u, -SWIGLU_LIMIT, SWIGLU_LIMIT)
        glu = g * jax.nn.sigmoid(g * SWIGLU_ALPHA)
        return ((u + 1.0) * glu) @ w_down[e] + b_down[e]

    Y = lax.map(expert_block, (row_tok.reshape(n_blocks, MOE_BLOCK), block_e)).reshape(P, D)
    out = jnp.zeros((T, D), Y.dtype).at[row_tok].add(Y * row_w[:, None].astype(Y.dtype))
    return out.reshape(B, S, D)


def setup_inputs(seed: int = 0) -> dict:
    key = jax.random.key(seed)
    ks = jax.random.split(key, 32)
    nrm = lambda k, shape, s: jax.random.normal(k, shape, jnp.float32) * s
    gain = lambda k, shape: 1.0 + 0.05 * jax.random.normal(k, shape, jnp.float32)
    L, D, E = DEPTH, D_MODEL, N_EXPERTS
    return {
        "x": nrm(ks[0], (BATCH, SEQ, D), 1.0),
        "c": nrm(ks[1], (BATCH, D), 1.0),
        "w_mod": nrm(ks[2], (L, D, 6 * D), 0.5 * D ** -0.5),
        "b_mod": nrm(ks[3], (L, 6 * D), 0.02),
        "norm_pre_mix": gain(ks[4], (L, D)),
        "norm_post_mix": gain(ks[5], (L, D)),
        "w_in": nrm(ks[6], (L, D, IN_COLS), D ** -0.5),
        "da_lambda_q1": nrm(ks[7], (L, DA_HEAD_DIM), 0.1),
        "da_lambda_k1": nrm(ks[8], (L, DA_HEAD_DIM), 0.1),
        "da_lambda_q2": nrm(ks[9], (L, DA_HEAD_DIM), 0.1),
        "da_lambda_k2": nrm(ks[10], (L, DA_HEAD_DIM), 0.1),
        "da_subln": gain(ks[11], (L, DA_V_DIM)),
        "hg_lb_logits": nrm(ks[12], (L + 1, HG_WIDTH), 0.1),
        "hg_norm": gain(ks[13], (L, HG_V_DIM)),
        "w_branch_a": nrm(ks[14], (L, DA_WIDTH, D), DA_WIDTH ** -0.5),
        "w_branch_b": nrm(ks[15], (L, HG_HEADS * HG_V_DIM, D), (HG_HEADS * HG_V_DIM) ** -0.5),
        "w_out": nrm(ks[16], (L, D, D), D ** -0.5),
        "norm_pre_ffn": gain(ks[17], (L, D)),
        "norm_post_ffn": gain(ks[18], (L, D)),
        "router_w": nrm(ks[19], (L, D, E), D ** -0.5),
        "router_b": nrm(ks[20], (L, E), 0.01),
        "w_gate_up": nrm(ks[21], (L, E, D, 2 * D_EXPERT), D ** -0.5),
        "b_gate_up": nrm(ks[22], (L, E, 2 * D_EXPERT), 0.02),
        "w_down": nrm(ks[23], (L, E, D_EXPERT, D), D_EXPERT ** -0.5),
        "b_down": nrm(ks[24], (L, E, D), 0.02),
    }


def reference(x, c, w_mod, b_mod, norm_pre_mix, norm_post_mix, w_in,
              da_lambda_q1, da_lambda_k1, da_lambda_q2, da_lambda_k2, da_subln,
              hg_lb_logits, hg_norm, w_branch_a, w_branch_b, w_out,
              norm_pre_ffn, norm_post_ffn, router_w, router_b,
              w_gate_up, b_gate_up, w_down, b_down):
    S = x.shape[1]
    cos, sin = rope_tables(S, x.dtype)
    lb_all = jnp.cumsum(jax.nn.softmax(hg_lb_logits.astype(jnp.float32), axis=0), axis=0)
    c_act = jax.nn.silu(c)
    for l in range(DEPTH):
        mod = (c_act @ w_mod[l] + b_mod[l])[:, None, :]
        sh1, sc1, g1, sh2, sc2, g2 = jnp.split(mod, 6, axis=-1)
        lambda_init = 0.8 - 0.6 * math.exp(-0.3 * l)
        lam = (jnp.exp(jnp.sum(da_lambda_q1[l] * da_lambda_k1[l]).astype(jnp.float32))
               - jnp.exp(jnp.sum(da_lambda_q2[l] * da_lambda_k2[l]).astype(jnp.float32))
               + lambda_init)
        h = rms_norm(x, norm_pre_mix[l]) * (1.0 + sc1) + sh1
        y = hybrid_mixer(h, w_in[l], lam, lambda_init, da_subln[l], lb_all[l], hg_norm[l],
                         w_branch_a[l], w_branch_b[l], w_out[l], cos, sin)
        x = x + g1 * rms_norm(y, norm_post_mix[l])
        h = rms_norm(x, norm_pre_ffn[l]) * (1.0 + sc2) + sh2
        y = moe(h, router_w[l], router_b[l], w_gate_up[l], b_gate_up[l], w_down[l], b_down[l])
        x = x + g2 * rms_norm(y, norm_post_ffn[l])
    return x
```

```cpp
#include <hip/hip_runtime.h>
#include <hip/hip_bf16.h>
#include <stdint.h>
#include <cstdio>

typedef unsigned short bf16_t;
__device__ __forceinline__ float bf2f(bf16_t v) { return __uint_as_float(((unsigned)v) << 16); }
__device__ __forceinline__ bf16_t f2bf(float f) { unsigned u = __float_as_uint(f); return (bf16_t)((u + 0x7fffu + ((u >> 16) & 1u)) >> 16); }

constexpr int NB_ = 4, SEQ = 8192, T = NB_ * SEQ, D = 1024, NC = 5632, NE = 32;
constexpr size_t MiB = 1u << 20;
constexpr size_t WS_CTL = 0;
constexpr size_t WS_SMALL = 1 * MiB;
constexpr size_t WS_ROPEC = 2 * MiB, WS_ROPES = 3 * MiB;
constexpr size_t WS_TOPI = 4 * MiB, WS_TOPW = 4 * MiB + 512 * 1024;
constexpr size_t WS_LIST = 6 * MiB;
constexpr size_t WS_WIN = 16 * MiB, WS_WA = 28 * MiB, WS_WB = 29 * MiB, WS_WO = 30 * MiB, WS_WGU = 32 * MiB, WS_WD = 160 * MiB;
constexpr size_t WS_H = 224 * MiB;
constexpr size_t WS_PROJ = 288 * MiB;
constexpr size_t WS_YA = 640 * MiB, WS_YB = 672 * MiB;
constexpr size_t WS_DS = 704 * MiB, WS_DEC = 768 * MiB;
constexpr size_t WS_MERGED = 772 * MiB;
constexpr size_t WS_Y = 836 * MiB;
constexpr size_t WS_ACT = 288 * MiB;
constexpr size_t WS_YM = 560 * MiB;
constexpr size_t WS_END = 964 * MiB;
constexpr int CW_CNT = 1024;

namespace nv {

__device__ __forceinline__ float wave_sum(float v) {
#pragma unroll
    for (int o = 1; o < 64; o <<= 1) v += __shfl_xor(v, o);
    return v;
}
__device__ __forceinline__ float sigm(float x) { return 1.f / (1.f + expf(-x)); }

__global__ void __launch_bounds__(256) k_mod(const float* c, const float* w_mod, const float* b_mod, float* mod) {
    const int j = blockIdx.x * 256 + threadIdx.x, b = blockIdx.y;
    float acc = 0.f;
    for (int k = 0; k < 1024; ++k) { const float cv = c[b * 1024 + k]; acc += (cv * sigm(cv)) * w_mod[(size_t)k * 6144 + j]; }
    mod[b * 6144 + j] = acc + b_mod[j];
}
__global__ void __launch_bounds__(256) k_small(const float* q1, const float* k1, const float* q2, const float* k2, const float* lbl,
                                               float* scal, float* ropec, float* ropes) {
    const int gid = blockIdx.x * 256 + threadIdx.x;
    if (gid == 0) { float s1 = 0.f, s2 = 0.f; for (int i = 0; i < 64; ++i) { s1 += q1[i] * k1[i]; s2 += q2[i] * k2[i]; } scal[0] = expf(s1) - expf(s2) + 0.2f; }
    if (gid < 512) { const float a = lbl[gid], b = lbl[512 + gid]; scal[64 + gid] = 1.f / (1.f + expf(b - a)); }
    if (gid < 8192 * 32) { const int s = gid >> 5, i = gid & 31; const float inv = powf(10000.f, -(float)(2 * i) / 64.f); const float ang = (float)s * inv; ropec[gid] = cosf(ang); ropes[gid] = sinf(ang); }
}
__global__ void __launch_bounds__(256) k_rowmod(const float* x, const float* w, const float* mod, bf16_t* out, int shoff, int scoff) {
    const int row = blockIdx.x * 4 + (threadIdx.x >> 6), lane = threadIdx.x & 63, b = row >> 13;
    const float* xr = x + (size_t)row * 1024; float v[16]; float ss = 0.f;
#pragma unroll
    for (int j = 0; j < 16; ++j) { v[j] = xr[lane + 64 * j]; ss += v[j] * v[j]; }
    ss = wave_sum(ss); const float rstd = rsqrtf(ss * (1.f / 1024.f) + 1e-6f);
#pragma unroll
    for (int j = 0; j < 16; ++j) { const int col = lane + 64 * j; const float h = v[j] * rstd * w[col] * (1.f + mod[b * 6144 + scoff + col]) + mod[b * 6144 + shoff + col]; out[(size_t)row * 1024 + col] = f2bf(h); }
}

struct NG {
    const bf16_t* A;
    const int* rowidx;
    const int* cnt;
    const int* rowbase;
    const float* B; size_t strideB;
    int lda, idxstride, idxshift, M  , ldb, K, b1off, pad;
};
template <class Epi, int NB>
__global__ void __launch_bounds__(256) k_gemm(NG p, Epi epi) {
    __shared__ float As[16][68];
    __shared__ float Bs[NB][16][64];
    const int z = blockIdx.z, Mz = p.cnt ? p.cnt[z] : p.M, m0 = blockIdx.y * 64, n0 = blockIdx.x * 64;
    if (m0 >= Mz) return;
    const int tid = threadIdx.x, tx = tid & 15, ty = tid >> 4;
    const float* B = p.B + (size_t)z * p.strideB;
    const int base = p.rowbase ? p.rowbase[z] : 0;
    const int lr = tid >> 2, lk = (tid & 3) * 4;
    int lrow = m0 + lr; if (lrow >= Mz) lrow = Mz - 1;
    const size_t arow = p.rowidx ? (size_t)(p.rowidx[(size_t)z * p.idxstride + lrow] >> p.idxshift) : (size_t)(base + lrow);
    const bf16_t* ap = p.A + arow * p.lda + lk;
    const int bk = tid >> 4, bc = (tid & 15) * 4;
    float acc[NB][4][4];
#pragma unroll
    for (int q = 0; q < NB; ++q)
#pragma unroll
        for (int i = 0; i < 4; ++i)
#pragma unroll
            for (int j = 0; j < 4; ++j) acc[q][i][j] = 0.f;
    for (int k0 = 0; k0 < p.K; k0 += 16) {
        const uint2 av = *(const uint2*)(ap + k0);
        As[lk + 0][lr] = __uint_as_float(av.x << 16); As[lk + 1][lr] = __uint_as_float(av.x & 0xffff0000u);
        As[lk + 2][lr] = __uint_as_float(av.y << 16); As[lk + 3][lr] = __uint_as_float(av.y & 0xffff0000u);
#pragma unroll
        for (int q = 0; q < NB; ++q) { const float4 bv = *(const float4*)(B + (size_t)(k0 + bk) * p.ldb + n0 + bc + q * p.b1off); *(float4*)&Bs[q][bk][bc] = bv; }
        __syncthreads();
#pragma unroll
        for (int k = 0; k < 16; ++k) {
            float a[4]; const float4 a4 = *(const float4*)&As[k][ty * 4]; a[0] = a4.x; a[1] = a4.y; a[2] = a4.z; a[3] = a4.w;
#pragma unroll
            for (int q = 0; q < NB; ++q) { const float4 b4 = *(const float4*)&Bs[q][k][tx * 4]; const float b[4] = {b4.x, b4.y, b4.z, b4.w};
#pragma unroll
                for (int i = 0; i < 4; ++i)
#pragma unroll
                    for (int j = 0; j < 4; ++j) acc[q][i][j] += a[i] * b[j]; }
        }
        __syncthreads();
    }
#pragma unroll
    for (int i = 0; i < 4; ++i) { const int lrw = m0 + ty * 4 + i; if (lrw < Mz) {
#pragma unroll
        for (int j = 0; j < 4; ++j) epi(z, lrw, base + lrw, n0 + tx * 4 + j, acc[0][i][j], NB == 2 ? acc[NB - 1][i][j] : 0.f); } }
}
struct EpiStoreBf16 { bf16_t* C; long long ldc; __device__ void operator()(int, int, int r, int c, float v, float) const { C[(size_t)r * ldc + c] = f2bf(v); } };
struct EpiStoreF32 { float* C; long long ldc; __device__ void operator()(int, int, int r, int c, float v, float) const { C[(size_t)r * ldc + c] = v; } };
struct EpiBranchA { float* tmp; const bf16_t* proj; __device__ void operator()(int, int, int r, int c, float v, float) const { tmp[(size_t)r * 1024 + c] = sigm(bf2f(proj[(size_t)r * 5632 + 3584 + c])) * v; } };
struct EpiBranchB { const float* tmp; const bf16_t* proj; bf16_t* merged; __device__ void operator()(int, int, int r, int c, float v, float) const {
    merged[(size_t)r * 1024 + c] = f2bf(tmp[(size_t)r * 1024 + c] + sigm(bf2f(proj[(size_t)r * 5632 + 4608 + c])) * v); } };
struct EpiGateUp { const float* bgu; bf16_t* act; __device__ void operator()(int e, int, int r, int c, float v0, float v1) const {
    float g = v0 + bgu[e * 2048 + c], u = v1 + bgu[e * 2048 + 1024 + c]; g = fminf(g, 7.f); u = fminf(fmaxf(u, -7.f), 7.f);
    const float glu = g * sigm(1.702f * g); act[(size_t)r * 1024 + c] = f2bf((u + 1.f) * glu); } };
struct EpiDown { const float* bd; const int* list; bf16_t* ym; __device__ void operator()(int e, int lr, int, int c, float v, float) const {
    const int a = list[(size_t)e * 32768 + lr]; ym[(size_t)a * 1024 + c] = f2bf(v + bd[e * 1024 + c]); } };

constexpr int AT_LD = 129;
constexpr int AT_LDS = (3 * 64 * AT_LD + 64 * 65) * 4;
__device__ __forceinline__ void at_load_rope(float* dst, const bf16_t* proj, int tok0, int colbase, const float* ropec, const float* ropes, int s0, int tid) {
    for (int i = 0; i < 16; ++i) { const int idx = tid + 256 * i, row = idx >> 6, rem = idx & 63, m = rem >> 5, d = rem & 31;
        const bf16_t* pr = proj + (size_t)(tok0 + row) * 5632 + colbase + m * 64;
        const float x1 = bf2f(pr[d]), x2 = bf2f(pr[32 + d]), c = ropec[(s0 + row) * 32 + d], s = ropes[(s0 + row) * 32 + d];
        dst[row * AT_LD + m * 64 + d] = x1 * c - x2 * s; dst[row * AT_LD + m * 64 + 32 + d] = x2 * c + x1 * s; }
}
__global__ void __launch_bounds__(256) k_attn(const bf16_t* proj, const float* ropec, const float* ropes, const float* scal, const float* subln, bf16_t* ya) {
    extern __shared__ float sm[];
    float* Qs = sm; float* Ks = Qs + 64 * AT_LD; float* Vs = Ks + 64 * AT_LD; float* As = Vs + 64 * AT_LD;
    const int qc = blockIdx.x, h = blockIdx.y, b = blockIdx.z, tid = threadIdx.x, r = tid >> 2, qd = tid & 3;
    const int tokq = b * 8192 + qc * 64; const float lam = scal[0];
    at_load_rope(Qs, proj, tokq, h * 128, ropec, ropes, qc * 64, tid);
    float m0 = -1e30f, l0 = 0.f, m1 = -1e30f, l1 = 0.f;
    for (int kc = 0; kc <= qc; ++kc) {
        __syncthreads();
        at_load_rope(Ks, proj, b * 8192 + kc * 64, 512 + h * 128, ropec, ropes, kc * 64, tid);
        __syncthreads();
        for (int i = 0; i < 16; ++i) { const int j = 4 * i + qd; float s0 = 0.f, s1 = 0.f;
            for (int d = 0; d < 64; ++d) { s0 += Qs[r * AT_LD + d] * Ks[j * AT_LD + d]; s1 += Qs[r * AT_LD + 64 + d] * Ks[j * AT_LD + 64 + d]; }
            s0 *= 0.125f; s1 *= 0.125f;
            float mn = fmaxf(m0, s0); l0 = l0 * expf(m0 - mn) + expf(s0 - mn); m0 = mn;
            mn = fmaxf(m1, s1); l1 = l1 * expf(m1 - mn) + expf(s1 - mn); m1 = mn; }
    }
#pragma unroll
    for (int o = 1; o < 4; o <<= 1) {
        float mo = __shfl_xor(m0, o), lo = __shfl_xor(l0, o); float mn = fmaxf(m0, mo); l0 = l0 * expf(m0 - mn) + lo * expf(mo - mn); m0 = mn;
        mo = __shfl_xor(m1, o); lo = __shfl_xor(l1, o); mn = fmaxf(m1, mo); l1 = l1 * expf(m1 - mn) + lo * expf(mo - mn); m1 = mn; }
    const float il0 = 1.f / l0, il1 = lam / l1;
    float o[32];
#pragma unroll
    for (int i = 0; i < 32; ++i) o[i] = 0.f;
    for (int kc = 0; kc <= qc; ++kc) {
        __syncthreads();
        at_load_rope(Ks, proj, b * 8192 + kc * 64, 512 + h * 128, ropec, ropes, kc * 64, tid);
        for (int i = 0; i < 32; ++i) { const int idx = tid + 256 * i, row = idx >> 7, col = idx & 127; Vs[row * AT_LD + col] = bf2f(proj[(size_t)(b * 8192 + kc * 64 + row) * 5632 + 1024 + h * 128 + col]); }
        __syncthreads();
        for (int i = 0; i < 16; ++i) { const int j = 4 * i + qd; float s0 = 0.f, s1 = 0.f;
            for (int d = 0; d < 64; ++d) { s0 += Qs[r * AT_LD + d] * Ks[j * AT_LD + d]; s1 += Qs[r * AT_LD + 64 + d] * Ks[j * AT_LD + 64 + d]; }
            s0 *= 0.125f; s1 *= 0.125f;
            As[r * 65 + j] = expf(s0 - m0) * il0 - expf(s1 - m1) * il1; }
        __syncthreads();
        for (int j = 0; j < 64; ++j) { const float av = As[r * 65 + j];
#pragma unroll
            for (int dv = 0; dv < 32; ++dv) o[dv] += av * Vs[j * AT_LD + 32 * qd + dv]; }
    }
    float ss = 0.f;
#pragma unroll
    for (int i = 0; i < 32; ++i) ss += o[i] * o[i];
    ss += __shfl_xor(ss, 1); ss += __shfl_xor(ss, 2);
    const float rstd = rsqrtf(ss * (1.f / 128.f) + 1e-6f);
#pragma unroll
    for (int i = 0; i < 32; ++i) { const int dv = 32 * qd + i; ya[(size_t)(tokq + r) * 512 + h * 128 + dv] = f2bf(o[i] * rstd * subln[dv] * 0.8f); }
}

__global__ void __launch_bounds__(256) k_hgA(const bf16_t* proj, const float* scal, bf16_t* ds, float* dec) {
    extern __shared__ float sm[];
    float* G = sm; float* V = sm + 64 * 128;
    const int n = blockIdx.x, h = blockIdx.y, b = blockIdx.z, tid = threadIdx.x, tok0 = b * 8192 + n * 64, bh = b * 4 + h;
    for (int i = 0; i < 32; ++i) { const int idx = tid + 256 * i, c = idx >> 7, d = idx & 127; const bf16_t* pr = proj + (size_t)(tok0 + c) * 5632 + h * 128 + d;
        const float lb = scal[64 + h * 128 + d]; const float f = lb + (1.f - lb) * sigm(bf2f(pr[2048])); G[c * 128 + d] = f; V[c * 128 + d] = bf2f(pr[2560]); }
    __syncthreads();
    float kk[64]; float glast = 0.f; const int d = tid & 127, vb = (tid >> 7) * 64;
    {
        float g = 0.f;
#pragma unroll
        for (int c = 0; c < 64; ++c) { const float f = G[c * 128 + d]; g += logf(f); kk[c] = g; }
        glast = g;
#pragma unroll
        for (int c = 0; c < 64; ++c) { const float f = G[c * 128 + d]; kk[c] = (1.f - f) * expf(glast - kk[c]); }
    }
    if (tid < 128) dec[(size_t)(bh * 128 + n) * 128 + d] = expf(glast);
    for (int v0 = 0; v0 < 64; v0 += 16) {
        float acc[16];
#pragma unroll
        for (int i = 0; i < 16; ++i) acc[i] = 0.f;
#pragma unroll
        for (int c = 0; c < 64; ++c) {
#pragma unroll
            for (int i = 0; i < 16; ++i) acc[i] += kk[c] * V[c * 128 + vb + v0 + i]; }
#pragma unroll
        for (int i = 0; i < 16; ++i) ds[((size_t)(bh * 128 + n) * 128 + d) * 128 + vb + v0 + i] = f2bf(acc[i]);
    }
}
__global__ void __launch_bounds__(256) k_scan(bf16_t* ds, const float* dec) {
    const int gid = blockIdx.x * 256 + threadIdx.x; const int bh = gid >> 14, d = (gid >> 7) & 127, v = gid & 127;
    float st = 0.f;
    for (int n = 0; n < 128; ++n) { const size_t o = ((size_t)(bh * 128 + n) * 128 + d) * 128 + v; const float x = bf2f(ds[o]); ds[o] = f2bf(st); st = dec[(size_t)(bh * 128 + n) * 128 + d] * st + x; }
}
constexpr int HC_LDS = (2 * 64 * 129 + 64 * 128 + 64 * 65) * 4;
__global__ void __launch_bounds__(256) k_hgC(const bf16_t* proj, const float* scal, const bf16_t* sp, const float* hgnorm, bf16_t* yb) {
    extern __shared__ float sm[];
    float* QT = sm; float* KT = QT + 64 * 129; float* V = KT + 64 * 129; float* As = V + 64 * 128;
    const int n = blockIdx.x, h = blockIdx.y, b = blockIdx.z, tid = threadIdx.x, tok0 = b * 8192 + n * 64, bh = b * 4 + h;
    for (int i = 0; i < 32; ++i) { const int idx = tid + 256 * i, c = idx >> 7, d = idx & 127; const bf16_t* pr = proj + (size_t)(tok0 + c) * 5632 + h * 128 + d;
        const float lb = scal[64 + h * 128 + d]; const float f = lb + (1.f - lb) * sigm(bf2f(pr[2048])); const float q = bf2f(pr[1536]);
        QT[c * 129 + d] = q * sigm(q); KT[c * 129 + d] = f; V[c * 128 + d] = bf2f(pr[2560]); }
    __syncthreads();
    if (tid < 128) { float g = 0.f; for (int c = 0; c < 64; ++c) { const float f = KT[c * 129 + tid]; g += logf(f); QT[c * 129 + tid] *= expf(g); KT[c * 129 + tid] = (1.f - f) * expf(-g); } }
    __syncthreads();
    const int c = tid >> 2, q4 = tid & 3;
    for (int i = 0; i < 16; ++i) { const int s = 4 * i + q4; float a = 0.f;
        if (s <= c) { for (int d = 0; d < 128; ++d) a += QT[c * 129 + d] * KT[s * 129 + d]; }
        As[c * 65 + s] = a; }
    __syncthreads();
    float o[32];
#pragma unroll
    for (int i = 0; i < 32; ++i) o[i] = 0.f;
    for (int s = 0; s < 64; ++s) { const float a = As[c * 65 + s];
#pragma unroll
        for (int i = 0; i < 32; ++i) o[i] += a * V[s * 128 + 32 * q4 + i]; }
    const bf16_t* spb = sp + (size_t)(bh * 128 + n) * 128 * 128;
    for (int d = 0; d < 128; ++d) { const float qv = QT[c * 129 + d];
#pragma unroll
        for (int i = 0; i < 32; ++i) o[i] += qv * bf2f(spb[d * 128 + 32 * q4 + i]); }
    float ss = 0.f;
#pragma unroll
    for (int i = 0; i < 32; ++i) ss += o[i] * o[i];
    ss += __shfl_xor(ss, 1); ss += __shfl_xor(ss, 2);
    const float rstd = rsqrtf(ss * (1.f / 128.f) + 1e-6f);
#pragma unroll
    for (int i = 0; i < 32; ++i) { const int v = 32 * q4 + i; const float g = bf2f(proj[(size_t)(tok0 + c) * 5632 + 3072 + h * 128 + v]);
        yb[(size_t)(tok0 + c) * 512 + h * 128 + v] = f2bf(o[i] * rstd * hgnorm[v] * (g * sigm(g))); }
}
__global__ void __launch_bounds__(256) k_x1(const float* x, const float* y, const float* w, const float* mod, long long goff, float* x1) {
    const int row = blockIdx.x * 4 + (threadIdx.x >> 6), lane = threadIdx.x & 63, b = row >> 13;
    const float* yr = y + (size_t)row * 1024; float v[16]; float ss = 0.f;
#pragma unroll
    for (int j = 0; j < 16; ++j) { v[j] = yr[lane + 64 * j]; ss += v[j] * v[j]; }
    ss = wave_sum(ss); const float rstd = rsqrtf(ss * (1.f / 1024.f) + 1e-6f);
#pragma unroll
    for (int j = 0; j < 16; ++j) { const int col = lane + 64 * j; x1[(size_t)row * 1024 + col] = x[(size_t)row * 1024 + col] + mod[b * 6144 + goff + col] * v[j] * rstd * w[col]; }
}
__global__ void __launch_bounds__(256) k_route(const float* x1, const float* w, const float* mod, const float* rw, const float* rb, int* topi, float* topw) {
    const int row = blockIdx.x * 4 + (threadIdx.x >> 6), lane = threadIdx.x & 63, b = row >> 13;
    const float* xr = x1 + (size_t)row * 1024; float v[16]; float ss = 0.f;
#pragma unroll
    for (int j = 0; j < 16; ++j) { v[j] = xr[lane + 64 * j]; ss += v[j] * v[j]; }
    ss = wave_sum(ss); const float rstd = rsqrtf(ss * (1.f / 1024.f) + 1e-6f);
    float lg[32];
#pragma unroll
    for (int e = 0; e < 32; ++e) lg[e] = 0.f;
#pragma unroll
    for (int j = 0; j < 16; ++j) { const int col = lane + 64 * j; const float h = v[j] * rstd * w[col] * (1.f + mod[b * 6144 + 4096 + col]) + mod[b * 6144 + 3072 + col];
#pragma unroll
        for (int e = 0; e < 32; ++e) lg[e] += h * rw[col * 32 + e]; }
#pragma unroll
    for (int e = 0; e < 32; ++e) lg[e] = wave_sum(lg[e]) + rb[e];
    int bi[4]; float bv[4];
#pragma unroll
    for (int k = 0; k < 4; ++k) { float best = -3.0e38f; int be = 0;
#pragma unroll
        for (int e = 0; e < 32; ++e) { bool taken = false;
#pragma unroll
            for (int q = 0; q < 4; ++q) if (q < k && bi[q] == e) taken = true;
            if (!taken && lg[e] > best) { best = lg[e]; be = e; } }
        bi[k] = be; bv[k] = best; }
    const float e1 = expf(bv[1] - bv[0]), e2 = expf(bv[2] - bv[0]), e3 = expf(bv[3] - bv[0]); const float inv = 1.f / (1.f + e1 + e2 + e3);
    if (lane == 0) { topi[row * 4 + 0] = bi[0]; topi[row * 4 + 1] = bi[1]; topi[row * 4 + 2] = bi[2]; topi[row * 4 + 3] = bi[3];
        topw[row * 4 + 0] = inv; topw[row * 4 + 1] = e1 * inv; topw[row * 4 + 2] = e2 * inv; topw[row * 4 + 3] = e3 * inv; }
}
__global__ void __launch_bounds__(256) k_lists(const int* topi, int* cnt, int* list) {
    const int a = blockIdx.x * 256 + threadIdx.x; const int e = topi[a]; const int pos = atomicAdd(&cnt[e], 1); list[(size_t)e * 32768 + pos] = a;
}
__global__ void k_pads(const int* cnt, int* pads) { if (threadIdx.x == 0) { int s = 0; for (int e = 0; e < 32; ++e) { pads[e] = s; s += ((cnt[e] + 255) / 256) * 256; } } }
__global__ void __launch_bounds__(256) k_final(float* out, const bf16_t* ym, const float* topw, const float* w, const float* mod) {
    const int row = blockIdx.x * 4 + (threadIdx.x >> 6), lane = threadIdx.x & 63, b = row >> 13;
    float v[16]; float ss = 0.f; const float w0 = topw[row * 4], w1 = topw[row * 4 + 1], w2 = topw[row * 4 + 2], w3 = topw[row * 4 + 3];
    const bf16_t* y0 = ym + (size_t)row * 4096;
#pragma unroll
    for (int j = 0; j < 16; ++j) { const int col = lane + 64 * j; v[j] = w0 * bf2f(y0[col]) + w1 * bf2f(y0[1024 + col]) + w2 * bf2f(y0[2048 + col]) + w3 * bf2f(y0[3072 + col]); ss += v[j] * v[j]; }
    ss = wave_sum(ss); const float rstd = rsqrtf(ss * (1.f / 1024.f) + 1e-6f);
#pragma unroll
    for (int j = 0; j < 16; ++j) { const int col = lane + 64 * j; out[(size_t)row * 1024 + col] += mod[b * 6144 + 5120 + col] * v[j] * rstd * w[col]; }
}
}

extern "C" void kernel_launch(void* const* d_in, const int* in_sizes, int n_in, void* d_out, int out_size, void* d_ws, size_t ws_size, hipStream_t stream) {
    if (n_in != 25 || out_size != T * D || ws_size < WS_END) { fprintf(stderr, "kernel_launch: unexpected shapes / workspace (%d inputs, out %d, ws %zu)\n", n_in, out_size, ws_size); return; }
    const float* x = (const float*)d_in[0]; const float* c = (const float*)d_in[1]; const float* w_mod = (const float*)d_in[2]; const float* b_mod = (const float*)d_in[3];
    const float* norm_pre_mix = (const float*)d_in[4]; const float* norm_post_mix = (const float*)d_in[5]; const float* w_in = (const float*)d_in[6];
    const float* lq1 = (const float*)d_in[7]; const float* lk1 = (const float*)d_in[8]; const float* lq2 = (const float*)d_in[9]; const float* lk2 = (const float*)d_in[10];
    const float* subln = (const float*)d_in[11]; const float* lbl = (const float*)d_in[12]; const float* hgnorm = (const float*)d_in[13];
    const float* wa = (const float*)d_in[14]; const float* wb = (const float*)d_in[15]; const float* wo = (const float*)d_in[16];
    const float* norm_pre_ffn = (const float*)d_in[17]; const float* norm_post_ffn = (const float*)d_in[18]; const float* rw = (const float*)d_in[19]; const float* rb = (const float*)d_in[20];
    const float* wgu = (const float*)d_in[21]; const float* bgu = (const float*)d_in[22]; const float* wd = (const float*)d_in[23]; const float* bd = (const float*)d_in[24];
    unsigned char* ws = (unsigned char*)d_ws; float* out = (float*)d_out;
    float* MOD = (float*)(ws + WS_SMALL); float* SCAL = (float*)(ws + WS_SMALL + 128 * 1024); int* PADS = (int*)(ws + WS_SMALL + 192 * 1024);
    float* ROPEC = (float*)(ws + WS_ROPEC); float* ROPES = (float*)(ws + WS_ROPES);
    int* TOPI = (int*)(ws + WS_TOPI); float* TOPW = (float*)(ws + WS_TOPW); int* LIST = (int*)(ws + WS_LIST); int* CNT = (int*)(ws + WS_CTL) + CW_CNT;
    bf16_t* H = (bf16_t*)(ws + WS_H); bf16_t* PROJ = (bf16_t*)(ws + WS_PROJ); bf16_t* YA = (bf16_t*)(ws + WS_YA); bf16_t* YB = (bf16_t*)(ws + WS_YB);
    bf16_t* DS = (bf16_t*)(ws + WS_DS); float* DEC = (float*)(ws + WS_DEC); bf16_t* MERGED = (bf16_t*)(ws + WS_MERGED); float* Y = (float*)(ws + WS_Y);
    bf16_t* ACT = (bf16_t*)(ws + WS_ACT); bf16_t* YM = (bf16_t*)(ws + WS_YM);

    static bool attr_done = false;
    if (!attr_done) {
        (void)hipFuncSetAttribute((const void*)nv::k_attn, hipFuncAttributeMaxDynamicSharedMemorySize, nv::AT_LDS);
        (void)hipFuncSetAttribute((const void*)nv::k_hgA, hipFuncAttributeMaxDynamicSharedMemorySize, 65536);
        (void)hipFuncSetAttribute((const void*)nv::k_hgC, hipFuncAttributeMaxDynamicSharedMemorySize, nv::HC_LDS);
        attr_done = true;
    }
    (void)hipMemsetAsync(ws + WS_CTL, 0, 1 * MiB, stream);
    nv::k_mod<<<dim3(24, 4), 256, 0, stream>>>(c, w_mod, b_mod, MOD);
    nv::k_small<<<1024, 256, 0, stream>>>(lq1, lk1, lq2, lk2, lbl, SCAL, ROPEC, ROPES);
    nv::k_rowmod<<<T / 4, 256, 0, stream>>>(x, norm_pre_mix, MOD, H, 0, 1024);
    { nv::NG p{}; p.A = H; p.lda = 1024; p.M = T; p.B = w_in; p.ldb = NC; p.K = 1024;
      nv::k_gemm<nv::EpiStoreBf16, 1><<<dim3(NC / 64, T / 64, 1), 256, 0, stream>>>(p, nv::EpiStoreBf16{PROJ, (long long)NC}); }
    nv::k_attn<<<dim3(128, 4, 4), 256, nv::AT_LDS, stream>>>(PROJ, ROPEC, ROPES, SCAL, subln, YA);
    nv::k_hgA<<<dim3(128, 4, 4), 256, 65536, stream>>>(PROJ, SCAL, DS, DEC);
    nv::k_scan<<<1024, 256, 0, stream>>>(DS, DEC);
    nv::k_hgC<<<dim3(128, 4, 4), 256, nv::HC_LDS, stream>>>(PROJ, SCAL, DS, hgnorm, YB);
    { nv::NG p{}; p.A = YA; p.lda = 512; p.M = T; p.B = wa; p.ldb = 1024; p.K = 512;
      nv::k_gemm<nv::EpiBranchA, 1><<<dim3(16, T / 64, 1), 256, 0, stream>>>(p, nv::EpiBranchA{out, PROJ}); }
    { nv::NG p{}; p.A = YB; p.lda = 512; p.M = T; p.B = wb; p.ldb = 1024; p.K = 512;
      nv::k_gemm<nv::EpiBranchB, 1><<<dim3(16, T / 64, 1), 256, 0, stream>>>(p, nv::EpiBranchB{out, PROJ, MERGED}); }
    { nv::NG p{}; p.A = MERGED; p.lda = 1024; p.M = T; p.B = wo; p.ldb = 1024; p.K = 1024;
      nv::k_gemm<nv::EpiStoreF32, 1><<<dim3(16, T / 64, 1), 256, 0, stream>>>(p, nv::EpiStoreF32{Y, 1024LL}); }
    nv::k_x1<<<T / 4, 256, 0, stream>>>(x, Y, norm_post_mix, MOD, 2048LL, out);
    nv::k_rowmod<<<T / 4, 256, 0, stream>>>(out, norm_pre_ffn, MOD, H, 3072, 4096);
    nv::k_route<<<T / 4, 256, 0, stream>>>(out, norm_pre_ffn, MOD, rw, rb, TOPI, TOPW);
    nv::k_lists<<<T * 4 / 256, 256, 0, stream>>>(TOPI, CNT, LIST);
    nv::k_pads<<<1, 64, 0, stream>>>(CNT, PADS);
    { nv::NG p{}; p.A = H; p.lda = 1024; p.rowidx = LIST; p.idxstride = 32768; p.idxshift = 2; p.cnt = CNT; p.rowbase = PADS; p.B = wgu; p.strideB = (size_t)1024 * 2048; p.ldb = 2048; p.K = 1024; p.b1off = 1024;
      nv::k_gemm<nv::EpiGateUp, 2><<<dim3(16, T / 64, 32), 256, 0, stream>>>(p, nv::EpiGateUp{bgu, ACT}); }
    { nv::NG p{}; p.A = ACT; p.lda = 1024; p.cnt = CNT; p.rowbase = PADS; p.B = wd; p.strideB = (size_t)1024 * 1024; p.ldb = 1024; p.K = 1024;
      nv::k_gemm<nv::EpiDown, 1><<<dim3(16, T / 64, 32), 256, 0, stream>>>(p, nv::EpiDown{bd, LIST, YM}); }
    nv::k_final<<<T / 4, 256, 0, stream>>>(out, YM, TOPW, norm_post_ffn, MOD);
}
```

```cpp
#include <hip/hip_runtime.h>
#include <hip/hip_bf16.h>
#include <stdint.h>
#include <cstdio>

typedef unsigned short bf16_t;
__device__ __forceinline__ float bf2f(bf16_t v) { return __uint_as_float(((unsigned)v) << 16); }
__device__ __forceinline__ bf16_t f2bf(float f) { unsigned u = __float_as_uint(f); return (bf16_t)((u + 0x7fffu + ((u >> 16) & 1u)) >> 16); }

constexpr int NB_ = 4, SEQ = 8192, T = NB_ * SEQ, D = 1024, NC = 5632, NE = 32;
constexpr size_t MiB = 1u << 20;
constexpr size_t WS_CTL = 0;
constexpr size_t WS_SMALL = 1 * MiB;
constexpr size_t WS_ROPEC = 2 * MiB, WS_ROPES = 3 * MiB;
constexpr size_t WS_TOPI = 4 * MiB, WS_TOPW = 4 * MiB + 512 * 1024;
constexpr size_t WS_LIST = 6 * MiB;
constexpr size_t WS_WIN = 16 * MiB, WS_WA = 28 * MiB, WS_WB = 29 * MiB, WS_WO = 30 * MiB, WS_WGU = 32 * MiB, WS_WD = 160 * MiB;
constexpr size_t WS_H = 224 * MiB;
constexpr size_t WS_PROJ = 288 * MiB;
constexpr size_t WS_YA = 640 * MiB, WS_YB = 672 * MiB;
constexpr size_t WS_DS = 704 * MiB, WS_DEC = 768 * MiB;
constexpr size_t WS_MERGED = 772 * MiB;
constexpr size_t WS_Y = 836 * MiB;
constexpr size_t WS_ACT = 288 * MiB;
constexpr size_t WS_YM = 560 * MiB;
constexpr size_t WS_END = 964 * MiB;
constexpr int CW_CNT = 1024;
constexpr int CW_BAR = 4096;

namespace nv {

__device__ __forceinline__ float wave_sum(float v) {
#pragma unroll
    for (int o = 1; o < 64; o <<= 1) v += __shfl_xor(v, o);
    return v;
}
__device__ __forceinline__ float sigm(float x) { return 1.f / (1.f + expf(-x)); }

__global__ void __launch_bounds__(256) k_mod(const float* c, const float* w_mod, const float* b_mod, float* mod) {
    const int j = blockIdx.x * 256 + threadIdx.x, b = blockIdx.y;
    float acc = 0.f;
    for (int k = 0; k < 1024; ++k) { const float cv = c[b * 1024 + k]; acc += (cv * sigm(cv)) * w_mod[(size_t)k * 6144 + j]; }
    mod[b * 6144 + j] = acc + b_mod[j];
}
__global__ void __launch_bounds__(256) k_small(const float* q1, const float* k1, const float* q2, const float* k2, const float* lbl,
                                               float* scal, float* ropec, float* ropes) {
    const int gid = blockIdx.x * 256 + threadIdx.x;
    if (gid == 0) { float s1 = 0.f, s2 = 0.f; for (int i = 0; i < 64; ++i) { s1 += q1[i] * k1[i]; s2 += q2[i] * k2[i]; } scal[0] = expf(s1) - expf(s2) + 0.2f; }
    if (gid < 512) { const float a = lbl[gid], b = lbl[512 + gid]; scal[64 + gid] = 1.f / (1.f + expf(b - a)); }
    if (gid < 8192 * 32) { const int s = gid >> 5, i = gid & 31; const float inv = powf(10000.f, -(float)(2 * i) / 64.f); const float ang = (float)s * inv; ropec[gid] = cosf(ang); ropes[gid] = sinf(ang); }
}
__global__ void __launch_bounds__(256) k_rowmod(const float* x, const float* w, const float* mod, bf16_t* out, int shoff, int scoff) {
    const int row = blockIdx.x * 4 + (threadIdx.x >> 6), lane = threadIdx.x & 63, b = row >> 13;
    const float* xr = x + (size_t)row * 1024; float v[16]; float ss = 0.f;
#pragma unroll
    for (int j = 0; j < 16; ++j) { v[j] = xr[lane + 64 * j]; ss += v[j] * v[j]; }
    ss = wave_sum(ss); const float rstd = rsqrtf(ss * (1.f / 1024.f) + 1e-6f);
#pragma unroll
    for (int j = 0; j < 16; ++j) { const int col = lane + 64 * j; const float h = v[j] * rstd * w[col] * (1.f + mod[b * 6144 + scoff + col]) + mod[b * 6144 + shoff + col]; out[(size_t)row * 1024 + col] = f2bf(h); }
}

struct NG {
    const bf16_t* A;
    const int* rowidx;
    const int* cnt;
    const int* rowbase;
    const float* B; size_t strideB;
    int lda, idxstride, idxshift, M  , ldb, K, b1off, pad;
};
template <class Epi, int NB>
__global__ void __launch_bounds__(256) k_gemm(NG p, Epi epi) {
    __shared__ float As[16][68];
    __shared__ float Bs[NB][16][64];
    const int z = blockIdx.z, Mz = p.cnt ? p.cnt[z] : p.M, m0 = blockIdx.y * 64, n0 = blockIdx.x * 64;
    if (m0 >= Mz) return;
    const int tid = threadIdx.x, tx = tid & 15, ty = tid >> 4;
    const float* B = p.B + (size_t)z * p.strideB;
    const int base = p.rowbase ? p.rowbase[z] : 0;
    const int lr = tid >> 2, lk = (tid & 3) * 4;
    int lrow = m0 + lr; if (lrow >= Mz) lrow = Mz - 1;
    const size_t arow = p.rowidx ? (size_t)(p.rowidx[(size_t)z * p.idxstride + lrow] >> p.idxshift) : (size_t)(base + lrow);
    const bf16_t* ap = p.A + arow * p.lda + lk;
    const int bk = tid >> 4, bc = (tid & 15) * 4;
    float acc[NB][4][4];
#pragma unroll
    for (int q = 0; q < NB; ++q)
#pragma unroll
        for (int i = 0; i < 4; ++i)
#pragma unroll
            for (int j = 0; j < 4; ++j) acc[q][i][j] = 0.f;
    for (int k0 = 0; k0 < p.K; k0 += 16) {
        const uint2 av = *(const uint2*)(ap + k0);
        As[lk + 0][lr] = __uint_as_float(av.x << 16); As[lk + 1][lr] = __uint_as_float(av.x & 0xffff0000u);
        As[lk + 2][lr] = __uint_as_float(av.y << 16); As[lk + 3][lr] = __uint_as_float(av.y & 0xffff0000u);
#pragma unroll
        for (int q = 0; q < NB; ++q) { const float4 bv = *(const float4*)(B + (size_t)(k0 + bk) * p.ldb + n0 + bc + q * p.b1off); *(float4*)&Bs[q][bk][bc] = bv; }
        __syncthreads();
#pragma unroll
        for (int k = 0; k < 16; ++k) {
            float a[4]; const float4 a4 = *(const float4*)&As[k][ty * 4]; a[0] = a4.x; a[1] = a4.y; a[2] = a4.z; a[3] = a4.w;
#pragma unroll
            for (int q = 0; q < NB; ++q) { const float4 b4 = *(const float4*)&Bs[q][k][tx * 4]; const float b[4] = {b4.x, b4.y, b4.z, b4.w};
#pragma unroll
                for (int i = 0; i < 4; ++i)
#pragma unroll
                    for (int j = 0; j < 4; ++j) acc[q][i][j] += a[i] * b[j]; }
        }
        __syncthreads();
    }
#pragma unroll
    for (int i = 0; i < 4; ++i) { const int lrw = m0 + ty * 4 + i; if (lrw < Mz) {
#pragma unroll
        for (int j = 0; j < 4; ++j) epi(z, lrw, base + lrw, n0 + tx * 4 + j, acc[0][i][j], NB == 2 ? acc[NB - 1][i][j] : 0.f); } }
}
struct EpiStoreBf16 { bf16_t* C; long long ldc; __device__ void operator()(int, int, int r, int c, float v, float) const { C[(size_t)r * ldc + c] = f2bf(v); } };
struct EpiStoreF32 { float* C; long long ldc; __device__ void operator()(int, int, int r, int c, float v, float) const { C[(size_t)r * ldc + c] = v; } };
struct EpiBranchA { float* tmp; const bf16_t* proj; __device__ void operator()(int, int, int r, int c, float v, float) const { tmp[(size_t)r * 1024 + c] = sigm(bf2f(proj[(size_t)r * 5632 + 3584 + c])) * v; } };
struct EpiBranchB { const float* tmp; const bf16_t* proj; bf16_t* merged; __device__ void operator()(int, int, int r, int c, float v, float) const {
    merged[(size_t)r * 1024 + c] = f2bf(tmp[(size_t)r * 1024 + c] + sigm(bf2f(proj[(size_t)r * 5632 + 4608 + c])) * v); } };
struct EpiGateUp { const float* bgu; bf16_t* act; __device__ void operator()(int e, int, int r, int c, float v0, float v1) const {
    float g = v0 + bgu[e * 2048 + c], u = v1 + bgu[e * 2048 + 1024 + c]; g = fminf(g, 7.f); u = fminf(fmaxf(u, -7.f), 7.f);
    const float glu = g * sigm(1.702f * g); act[(size_t)r * 1024 + c] = f2bf((u + 1.f) * glu); } };
struct EpiDown { const float* bd; const int* list; bf16_t* ym; __device__ void operator()(int e, int lr, int, int c, float v, float) const {
    const int a = list[(size_t)e * 32768 + lr]; ym[(size_t)a * 1024 + c] = f2bf(v + bd[e * 1024 + c]); } };

constexpr int AT_LD = 129;
constexpr int AT_LDS = (3 * 64 * AT_LD + 64 * 65) * 4;
__device__ __forceinline__ void at_load_rope(float* dst, const bf16_t* proj, int tok0, int colbase, const float* ropec, const float* ropes, int s0, int tid) {
    for (int i = 0; i < 16; ++i) { const int idx = tid + 256 * i, row = idx >> 6, rem = idx & 63, m = rem >> 5, d = rem & 31;
        const bf16_t* pr = proj + (size_t)(tok0 + row) * 5632 + colbase + m * 64;
        const float x1 = bf2f(pr[d]), x2 = bf2f(pr[32 + d]), c = ropec[(s0 + row) * 32 + d], s = ropes[(s0 + row) * 32 + d];
        dst[row * AT_LD + m * 64 + d] = x1 * c - x2 * s; dst[row * AT_LD + m * 64 + 32 + d] = x2 * c + x1 * s; }
}
__global__ void __launch_bounds__(256) k_attn(const bf16_t* proj, const float* ropec, const float* ropes, const float* scal, const float* subln, bf16_t* ya) {
    extern __shared__ float sm[];
    float* Qs = sm; float* Ks = Qs + 64 * AT_LD; float* Vs = Ks + 64 * AT_LD; float* As = Vs + 64 * AT_LD;
    const int qc = blockIdx.x, h = blockIdx.y, b = blockIdx.z, tid = threadIdx.x, r = tid >> 2, qd = tid & 3;
    const int tokq = b * 8192 + qc * 64; const float lam = scal[0];
    at_load_rope(Qs, proj, tokq, h * 128, ropec, ropes, qc * 64, tid);
    float m0 = -1e30f, l0 = 0.f, m1 = -1e30f, l1 = 0.f;
    for (int kc = 0; kc <= qc; ++kc) {
        __syncthreads();
        at_load_rope(Ks, proj, b * 8192 + kc * 64, 512 + h * 128, ropec, ropes, kc * 64, tid);
        __syncthreads();
        for (int i = 0; i < 16; ++i) { const int j = 4 * i + qd; float s0 = 0.f, s1 = 0.f;
            for (int d = 0; d < 64; ++d) { s0 += Qs[r * AT_LD + d] * Ks[j * AT_LD + d]; s1 += Qs[r * AT_LD + 64 + d] * Ks[j * AT_LD + 64 + d]; }
            s0 *= 0.125f; s1 *= 0.125f;
            float mn = fmaxf(m0, s0); l0 = l0 * expf(m0 - mn) + expf(s0 - mn); m0 = mn;
            mn = fmaxf(m1, s1); l1 = l1 * expf(m1 - mn) + expf(s1 - mn); m1 = mn; }
    }
#pragma unroll
    for (int o = 1; o < 4; o <<= 1) {
        float mo = __shfl_xor(m0, o), lo = __shfl_xor(l0, o); float mn = fmaxf(m0, mo); l0 = l0 * expf(m0 - mn) + lo * expf(mo - mn); m0 = mn;
        mo = __shfl_xor(m1, o); lo = __shfl_xor(l1, o); mn = fmaxf(m1, mo); l1 = l1 * expf(m1 - mn) + lo * expf(mo - mn); m1 = mn; }
    const float il0 = 1.f / l0, il1 = lam / l1;
    float o[32];
#pragma unroll
    for (int i = 0; i < 32; ++i) o[i] = 0.f;
    for (int kc = 0; kc <= qc; ++kc) {
        __syncthreads();
        at_load_rope(Ks, proj, b * 8192 + kc * 64, 512 + h * 128, ropec, ropes, kc * 64, tid);
        for (int i = 0; i < 32; ++i) { const int idx = tid + 256 * i, row = idx >> 7, col = idx & 127; Vs[row * AT_LD + col] = bf2f(proj[(size_t)(b * 8192 + kc * 64 + row) * 5632 + 1024 + h * 128 + col]); }
        __syncthreads();
        for (int i = 0; i < 16; ++i) { const int j = 4 * i + qd; float s0 = 0.f, s1 = 0.f;
            for (int d = 0; d < 64; ++d) { s0 += Qs[r * AT_LD + d] * Ks[j * AT_LD + d]; s1 += Qs[r * AT_LD + 64 + d] * Ks[j * AT_LD + 64 + d]; }
            s0 *= 0.125f; s1 *= 0.125f;
            As[r * 65 + j] = expf(s0 - m0) * il0 - expf(s1 - m1) * il1; }
        __syncthreads();
        for (int j = 0; j < 64; ++j) { const float av = As[r * 65 + j];
#pragma unroll
            for (int dv = 0; dv < 32; ++dv) o[dv] += av * Vs[j * AT_LD + 32 * qd + dv]; }
    }
    float ss = 0.f;
#pragma unroll
    for (int i = 0; i < 32; ++i) ss += o[i] * o[i];
    ss += __shfl_xor(ss, 1); ss += __shfl_xor(ss, 2);
    const float rstd = rsqrtf(ss * (1.f / 128.f) + 1e-6f);
#pragma unroll
    for (int i = 0; i < 32; ++i) { const int dv = 32 * qd + i; ya[(size_t)(tokq + r) * 512 + h * 128 + dv] = f2bf(o[i] * rstd * subln[dv] * 0.8f); }
}

__global__ void __launch_bounds__(256) k_hgA(const bf16_t* proj, const float* scal, bf16_t* ds, float* dec) {
    extern __shared__ float sm[];
    float* G = sm; float* V = sm + 64 * 128;
    const int n = blockIdx.x, h = blockIdx.y, b = blockIdx.z, tid = threadIdx.x, tok0 = b * 8192 + n * 64, bh = b * 4 + h;
    for (int i = 0; i < 32; ++i) { const int idx = tid + 256 * i, c = idx >> 7, d = idx & 127; const bf16_t* pr = proj + (size_t)(tok0 + c) * 5632 + h * 128 + d;
        const float lb = scal[64 + h * 128 + d]; const float f = lb + (1.f - lb) * sigm(bf2f(pr[2048])); G[c * 128 + d] = f; V[c * 128 + d] = bf2f(pr[2560]); }
    __syncthreads();
    float kk[64]; float glast = 0.f; const int d = tid & 127, vb = (tid >> 7) * 64;
    {
        float g = 0.f;
#pragma unroll
        for (int c = 0; c < 64; ++c) { const float f = G[c * 128 + d]; g += logf(f); kk[c] = g; }
        glast = g;
#pragma unroll
        for (int c = 0; c < 64; ++c) { const float f = G[c * 128 + d]; kk[c] = (1.f - f) * expf(glast - kk[c]); }
    }
    if (tid < 128) dec[(size_t)(bh * 128 + n) * 128 + d] = expf(glast);
    for (int v0 = 0; v0 < 64; v0 += 16) {
        float acc[16];
#pragma unroll
        for (int i = 0; i < 16; ++i) acc[i] = 0.f;
#pragma unroll
        for (int c = 0; c < 64; ++c) {
#pragma unroll
            for (int i = 0; i < 16; ++i) acc[i] += kk[c] * V[c * 128 + vb + v0 + i]; }
#pragma unroll
        for (int i = 0; i < 16; ++i) ds[((size_t)(bh * 128 + n) * 128 + d) * 128 + vb + v0 + i] = f2bf(acc[i]);
    }
}
__global__ void __launch_bounds__(256) k_scan(bf16_t* ds, const float* dec) {
    const int gid = blockIdx.x * 256 + threadIdx.x; const int bh = gid >> 14, d = (gid >> 7) & 127, v = gid & 127;
    float st = 0.f;
    for (int n = 0; n < 128; ++n) { const size_t o = ((size_t)(bh * 128 + n) * 128 + d) * 128 + v; const float x = bf2f(ds[o]); ds[o] = f2bf(st); st = dec[(size_t)(bh * 128 + n) * 128 + d] * st + x; }
}
constexpr int HC_LDS = (2 * 64 * 129 + 64 * 128 + 64 * 65) * 4;
__global__ void __launch_bounds__(256) k_hgC(const bf16_t* proj, const float* scal, const bf16_t* sp, const float* hgnorm, bf16_t* yb) {
    extern __shared__ float sm[];
    float* QT = sm; float* KT = QT + 64 * 129; float* V = KT + 64 * 129; float* As = V + 64 * 128;
    const int n = blockIdx.x, h = blockIdx.y, b = blockIdx.z, tid = threadIdx.x, tok0 = b * 8192 + n * 64, bh = b * 4 + h;
    for (int i = 0; i < 32; ++i) { const int idx = tid + 256 * i, c = idx >> 7, d = idx & 127; const bf16_t* pr = proj + (size_t)(tok0 + c) * 5632 + h * 128 + d;
        const float lb = scal[64 + h * 128 + d]; const float f = lb + (1.f - lb) * sigm(bf2f(pr[2048])); const float q = bf2f(pr[1536]);
        QT[c * 129 + d] = q * sigm(q); KT[c * 129 + d] = f; V[c * 128 + d] = bf2f(pr[2560]); }
    __syncthreads();
    if (tid < 128) { float g = 0.f; for (int c = 0; c < 64; ++c) { const float f = KT[c * 129 + tid]; g += logf(f); QT[c * 129 + tid] *= expf(g); KT[c * 129 + tid] = (1.f - f) * expf(-g); } }
    __syncthreads();
    const int c = tid >> 2, q4 = tid & 3;
    for (int i = 0; i < 16; ++i) { const int s = 4 * i + q4; float a = 0.f;
        if (s <= c) { for (int d = 0; d < 128; ++d) a += QT[c * 129 + d] * KT[s * 129 + d]; }
        As[c * 65 + s] = a; }
    __syncthreads();
    float o[32];
#pragma unroll
    for (int i = 0; i < 32; ++i) o[i] = 0.f;
    for (int s = 0; s < 64; ++s) { const float a = As[c * 65 + s];
#pragma unroll
        for (int i = 0; i < 32; ++i) o[i] += a * V[s * 128 + 32 * q4 + i]; }
    const bf16_t* spb = sp + (size_t)(bh * 128 + n) * 128 * 128;
    for (int d = 0; d < 128; ++d) { const float qv = QT[c * 129 + d];
#pragma unroll
        for (int i = 0; i < 32; ++i) o[i] += qv * bf2f(spb[d * 128 + 32 * q4 + i]); }
    float ss = 0.f;
#pragma unroll
    for (int i = 0; i < 32; ++i) ss += o[i] * o[i];
    ss += __shfl_xor(ss, 1); ss += __shfl_xor(ss, 2);
    const float rstd = rsqrtf(ss * (1.f / 128.f) + 1e-6f);
#pragma unroll
    for (int i = 0; i < 32; ++i) { const int v = 32 * q4 + i; const float g = bf2f(proj[(size_t)(tok0 + c) * 5632 + 3072 + h * 128 + v]);
        yb[(size_t)(tok0 + c) * 512 + h * 128 + v] = f2bf(o[i] * rstd * hgnorm[v] * (g * sigm(g))); }
}
__global__ void __launch_bounds__(256) k_x1(const float* x, const float* y, const float* w, const float* mod, long long goff, float* x1) {
    const int row = blockIdx.x * 4 + (threadIdx.x >> 6), lane = threadIdx.x & 63, b = row >> 13;
    const float* yr = y + (size_t)row * 1024; float v[16]; float ss = 0.f;
#pragma unroll
    for (int j = 0; j < 16; ++j) { v[j] = yr[lane + 64 * j]; ss += v[j] * v[j]; }
    ss = wave_sum(ss); const float rstd = rsqrtf(ss * (1.f / 1024.f) + 1e-6f);
#pragma unroll
    for (int j = 0; j < 16; ++j) { const int col = lane + 64 * j; x1[(size_t)row * 1024 + col] = x[(size_t)row * 1024 + col] + mod[b * 6144 + goff + col] * v[j] * rstd * w[col]; }
}
__global__ void __launch_bounds__(256) k_route(const float* x1, const float* w, const float* mod, const float* rw, const float* rb, int* topi, float* topw) {
    const int row = blockIdx.x * 4 + (threadIdx.x >> 6), lane = threadIdx.x & 63, b = row >> 13;
    const float* xr = x1 + (size_t)row * 1024; float v[16]; float ss = 0.f;
#pragma unroll
    for (int j = 0; j < 16; ++j) { v[j] = xr[lane + 64 * j]; ss += v[j] * v[j]; }
    ss = wave_sum(ss); const float rstd = rsqrtf(ss * (1.f / 1024.f) + 1e-6f);
    float lg[32];
#pragma unroll
    for (int e = 0; e < 32; ++e) lg[e] = 0.f;
#pragma unroll
    for (int j = 0; j < 16; ++j) { const int col = lane + 64 * j; const float h = v[j] * rstd * w[col] * (1.f + mod[b * 6144 + 4096 + col]) + mod[b * 6144 + 3072 + col];
#pragma unroll
        for (int e = 0; e < 32; ++e) lg[e] += h * rw[col * 32 + e]; }
#pragma unroll
    for (int e = 0; e < 32; ++e) lg[e] = wave_sum(lg[e]) + rb[e];
    int bi[4]; float bv[4];
#pragma unroll
    for (int k = 0; k < 4; ++k) { float best = -3.0e38f; int be = 0;
#pragma unroll
        for (int e = 0; e < 32; ++e) { bool taken = false;
#pragma unroll
            for (int q = 0; q < 4; ++q) if (q < k && bi[q] == e) taken = true;
            if (!taken && lg[e] > best) { best = lg[e]; be = e; } }
        bi[k] = be; bv[k] = best; }
    const float e1 = expf(bv[1] - bv[0]), e2 = expf(bv[2] - bv[0]), e3 = expf(bv[3] - bv[0]); const float inv = 1.f / (1.f + e1 + e2 + e3);
    if (lane == 0) { topi[row * 4 + 0] = bi[0]; topi[row * 4 + 1] = bi[1]; topi[row * 4 + 2] = bi[2]; topi[row * 4 + 3] = bi[3];
        topw[row * 4 + 0] = inv; topw[row * 4 + 1] = e1 * inv; topw[row * 4 + 2] = e2 * inv; topw[row * 4 + 3] = e3 * inv; }
}
__global__ void __launch_bounds__(256) k_lists(const int* topi, int* cnt, int* list) {
    const int a = blockIdx.x * 256 + threadIdx.x; const int e = topi[a]; const int pos = atomicAdd(&cnt[e], 1); list[(size_t)e * 32768 + pos] = a;
}
__global__ void k_pads(const int* cnt, int* pads) { if (threadIdx.x == 0) { int s = 0; for (int e = 0; e < 32; ++e) { pads[e] = s; s += ((cnt[e] + 255) / 256) * 256; } } }
__global__ void __launch_bounds__(256) k_final(float* out, const bf16_t* ym, const float* topw, const float* w, const float* mod) {
    const int row = blockIdx.x * 4 + (threadIdx.x >> 6), lane = threadIdx.x & 63, b = row >> 13;
    float v[16]; float ss = 0.f; const float w0 = topw[row * 4], w1 = topw[row * 4 + 1], w2 = topw[row * 4 + 2], w3 = topw[row * 4 + 3];
    const bf16_t* y0 = ym + (size_t)row * 4096;
#pragma unroll
    for (int j = 0; j < 16; ++j) { const int col = lane + 64 * j; v[j] = w0 * bf2f(y0[col]) + w1 * bf2f(y0[1024 + col]) + w2 * bf2f(y0[2048 + col]) + w3 * bf2f(y0[3072 + col]); ss += v[j] * v[j]; }
    ss = wave_sum(ss); const float rstd = rsqrtf(ss * (1.f / 1024.f) + 1e-6f);
#pragma unroll
    for (int j = 0; j < 16; ++j) { const int col = lane + 64 * j; out[(size_t)row * 1024 + col] += mod[b * 6144 + 5120 + col] * v[j] * rstd * w[col]; }
}
}
#define GAS __attribute__((address_space(1)))
#define LAS __attribute__((address_space(3)))
typedef GAS unsigned gu32;
#define RLX_AGENT __ATOMIC_RELAXED, __HIP_MEMORY_SCOPE_AGENT
#define XB_TMO      128
#define XB_XCNT(j)  (256  + 64 * (j))
#define XB_XSUB(j)  (1280 + 64 * (j))
#define XB_XGEN(j)  (2304 + 64 * (j))
#define XB_TOP      3328
#define XB_TOPGEN   3392
#define XCD_BAR_WORDS 3456
#define XB_SPIN_CAP (1u << 22)

__device__ __forceinline__ unsigned xb_ld(unsigned* p)              { return __hip_atomic_load(p, __ATOMIC_RELAXED, __HIP_MEMORY_SCOPE_AGENT); }
__device__ __forceinline__ unsigned xb_add(unsigned* p, unsigned v) { return __hip_atomic_fetch_add(p, v, __ATOMIC_RELAXED, __HIP_MEMORY_SCOPE_AGENT); }
__device__ __forceinline__ unsigned xb_xcc_id() { return (unsigned)__builtin_amdgcn_s_getreg((3 << 11) | 20) & 0xFu; }
#define XB_SPIN(cond, bar) do { unsigned _sp = 0; while (cond) { __builtin_amdgcn_s_sleep(1); \
    if ((++_sp & 255u) == 0u) { if (xb_ld(&(bar)[XB_TMO])) break; if (_sp > XB_SPIN_CAP) { atomicAdd(&(bar)[XB_TMO], 1u); break; } } } } while (0)

struct XcdBarrier {
    unsigned* bar; unsigned x;
    volatile LAS unsigned* st;
};
__device__ __forceinline__ XcdBarrier xcd_barrier_post(unsigned* bar, volatile LAS unsigned* st) {
    XcdBarrier b; b.bar = bar; b.x = xb_xcc_id(); b.st = st;
    if (threadIdx.x == 0) (void)xb_add(&bar[XB_XCNT(b.x)], 1u);
    return b;
}
__device__ __forceinline__ void xcd_barrier_complete(unsigned* bar, unsigned x, unsigned& nloc, unsigned& nx) {
    const unsigned G = gridDim.x * gridDim.y * gridDim.z;
    unsigned sum, cnt, mine, sp = 0u;
    for (;;) {
        sum = 0u; cnt = 0u; mine = 0u;
#pragma unroll
        for (unsigned j = 0; j < 16; ++j) { const unsigned c = xb_ld(&bar[XB_XCNT(j)]); sum += c; cnt += (c > 0u) ? 1u : 0u; mine = (j == x) ? c : mine; }
        if (sum == G) break;
        __builtin_amdgcn_s_sleep(1);
        if ((++sp & 255u) == 0u) { if (xb_ld(&bar[XB_TMO])) break; if (sp > XB_SPIN_CAP) { atomicAdd(&bar[XB_TMO], 1u); break; } }
    }
    nloc = mine > 0u ? mine : 1u; nx = cnt > 0u ? cnt : 1u;
}
__device__ __forceinline__ void xcd_barrier(const XcdBarrier& b) {
    asm volatile("s_waitcnt vmcnt(0)" ::: "memory");
    __syncthreads();
    if (threadIdx.x == 0) {
        unsigned* bar = b.bar;
        __builtin_amdgcn_s_waitcnt(0);
        unsigned nloc = b.st[0], nx = b.st[1];
        if (nloc == 0u) { xcd_barrier_complete(bar, b.x, nloc, nx); b.st[0] = nloc; b.st[1] = nx; }
        const unsigned old = xb_add(&bar[XB_XSUB(b.x)], 1u);
        const unsigned gen = old / nloc;
        if (old + 1u == (gen + 1u) * nloc) {
            __builtin_amdgcn_fence(__ATOMIC_RELEASE, "agent");
            asm volatile("s_waitcnt vmcnt(0)" ::: "memory");
            const unsigned og = xb_add(&bar[XB_TOP], 1u);
            const unsigned tg = og / nx;
            if (og + 1u == (tg + 1u) * nx) xb_add(&bar[XB_TOPGEN], 1u);
            else XB_SPIN(xb_ld(&bar[XB_TOPGEN]) == tg, bar);
            __builtin_amdgcn_fence(__ATOMIC_ACQUIRE, "agent");
            xb_add(&bar[XB_XGEN(b.x)], 1u);
            asm volatile("s_waitcnt vmcnt(0)" ::: "memory");
        } else {
            XB_SPIN(xb_ld(&bar[XB_XGEN(b.x)]) == gen, bar);
            __builtin_amdgcn_fence(__ATOMIC_ACQUIRE, "agent");
            asm volatile("s_waitcnt vmcnt(0)" ::: "memory");
        }
    }
    __syncthreads();
}
namespace pg8 {
#define PG8_LAS __attribute__((address_space(3)))
typedef short bf16x8 __attribute__((ext_vector_type(8)));
typedef float f32x4 __attribute__((ext_vector_type(4)));
typedef float f32x2 __attribute__((ext_vector_type(2)));
typedef unsigned u32x4 __attribute__((ext_vector_type(4)));
typedef unsigned u32x2 __attribute__((ext_vector_type(2)));
constexpr int BM = 256, BK = 64, HALF = 128, HTB = HALF * BK * 2  , STAGE_BYTES = 8 * HTB, NXCD = 8, WGM = 8;

__host__ __device__ __forceinline__ int lds_byte(int r, int c) { const int st = (r >> 4) * 2 + (c >> 5), rr = r & 15, cc = c & 31, ob = rr * 64 + cc * 2; return st * 1024 + (ob ^ (((ob >> 9) & 1) << 5)); }
__host__ __device__ __forceinline__ void stage_rc(int b, int& R, int& C) { const int st = b / 1024, sb = b % 1024, swz = sb ^ (((sb >> 9) & 1) << 5); R = (st >> 1) * 16 + swz / 64; C = (st & 1) * 32 + (swz % 64) / 2; }
__host__ __device__ __forceinline__ int perm32(int rho) { const int n = rho >> 4, i = rho & 15; return 8 * (i >> 2) + 4 * n + (i & 3); }

struct Unit { int pm, pn, z, arow, brow; };
struct Gemm { const bf16_t* A; const bf16_t* Bt; int K; };

struct DenseOrder {
    int nM, nN, nwg, G, c;
    __device__ void init(int M, int N, int G_, int c_) { nM = M / BM; nN = N / BM; nwg = nM * nN; G = G_; c = c_; }
    __device__ bool next(int i, Unit& u) const {
        const long L = (long)i * G + c; if (L >= nwg) return false;
        int wgid = (int)L; { const int q = nwg / NXCD, r = nwg % NXCD, xcd = wgid % NXCD, off = wgid / NXCD; wgid = (xcd < r ? xcd * (q + 1) : r * (q + 1) + (xcd - r) * q) + off; }
        const int nig = WGM * nN, gid = wgid / nig, fm = gid * WGM, gsz = (nM - fm) < WGM ? (nM - fm) : WGM;
        u.pm = fm + ((wgid % nig) % gsz); u.pn = (wgid % nig) / gsz; u.z = 0; u.arow = u.pm * BM; u.brow = u.pn * BM; return true;
    }
    __device__ __forceinline__ unsigned row_off(const Unit&, int) const { return 0u; }
};

__device__ __forceinline__ unsigned cvt_pk_bf16(float lo, float hi) { unsigned r; asm volatile("v_cvt_pk_bf16_f32 %0, %1, %2" : "=v"(r) : "v"(lo), "v"(hi)); return r; }


template <class Epi, class Sched, bool GATHER>
__device__ __forceinline__ void gemm_phase(PG8_LAS unsigned char* lds, const Gemm g, const Sched& S, const Epi& E) {
    int tid_ = threadIdx.x; asm volatile("" : "+v"(tid_));
    const int tid = tid_, wid = __builtin_amdgcn_readfirstlane(tid >> 6), lane = tid & 63, wr = wid >> 2, wc = wid & 3, fr = lane & 15, fq = lane >> 4;
    const int K = g.K, nt = K / BK;
    unsigned voffA[2], voffB[2]; int RA[2];
#pragma unroll
    for (int i = 0; i < 2; ++i) { int R, C; stage_rc(tid * 16 + i * 8192, R, C); const int Rb = Epi::PERM ? ((R & ~31) + perm32(R & 31)) : R;
        RA[i] = R; voffA[i] = GATHER ? (unsigned)(C * 2) : (unsigned)(R * K + C) * 2u; voffB[i] = (unsigned)(Rb * K + C) * 2u; }
    const size_t kstep = (size_t)(BK * 2);
    const size_t hstep = (size_t)HALF * K * 2;
    const unsigned ldsw = (unsigned)wid * 1024u;
    const int aoff = lds_byte(wr * 64 + fr, fq * 8), boff = lds_byte(wc * 32 + fr, fq * 8);
    unsigned gAc[2][2], gAn[2][2];
#define PG8_SA(b, h) (((b) * 2 + (h)) * HTB)
#define PG8_SB(b, h) ((4 + (b) * 2 + (h)) * HTB)
#define PG8_STAGE(bufoff, gbase, voff) do { _Pragma("unroll") for (int _i = 0; _i < 2; ++_i) \
        __builtin_amdgcn_global_load_lds((const unsigned*)((const char*)(gbase) + (voff)[_i]), (PG8_LAS unsigned*)(lds + (bufoff) + ldsw + _i * 8192), 16, 0, 0); } while (0)
#define PG8_STAGEA(bufoff, gbase, h, nx) do { if constexpr (GATHER) { _Pragma("unroll") for (int _i = 0; _i < 2; ++_i) { const unsigned _v = ((nx) ? gAn[h][_i] : gAc[h][_i]) + voffA[_i]; \
        __builtin_amdgcn_global_load_lds((const unsigned*)((const char*)(gbase) + _v), (PG8_LAS unsigned*)(lds + (bufoff) + ldsw + _i * 8192), 16, 0, 0); } } \
        else { PG8_STAGE(bufoff, (const char*)(gbase) + (h) * hstep, voffA); } } while (0)
#define PG8_LDA(dst, b, h) do { _Pragma("unroll") for (int m = 0; m < 4; ++m) _Pragma("unroll") for (int k = 0; k < 2; ++k) dst[m][k] = *(const PG8_LAS bf16x8*)(lds + PG8_SA(b, h) + aoff + m * 2048 + k * 1024); } while (0)
#define PG8_LDB(dst, b, h) do { _Pragma("unroll") for (int n = 0; n < 2; ++n) _Pragma("unroll") for (int k = 0; k < 2; ++k) dst[n][k] = *(const PG8_LAS bf16x8*)(lds + PG8_SB(b, h) + boff + n * 2048 + k * 1024); } while (0)
#define PG8_MMA(ai, bj, At, Bt) do { __builtin_amdgcn_s_setprio(1); _Pragma("unroll") for (int m = 0; m < 4; ++m) _Pragma("unroll") for (int n = 0; n < 2; ++n) _Pragma("unroll") for (int k = 0; k < 2; ++k) \
        acc[ai][bj][m][n] = __builtin_amdgcn_mfma_f32_16x16x32_bf16(Bt[n][k], At[m][k], acc[ai][bj][m][n], 0, 0, 0); __builtin_amdgcn_s_setprio(0); } while (0)
#define PG8_WAIT_V(n) asm volatile("s_waitcnt vmcnt(" #n ")" ::: "memory")
#define PG8_WAIT_L(n) asm volatile("s_waitcnt lgkmcnt(" #n ")" ::: "memory")
#define PG8_BAR __builtin_amdgcn_s_barrier()
#define PG8_SCHED __builtin_amdgcn_sched_barrier(0)
    Unit cur, nxt; int ui = 0;
    if (!S.next(0, cur)) return;
    f32x4 acc[2][2][4][2];
#pragma unroll
    for (int a = 0; a < 2; ++a)
#pragma unroll
        for (int b = 0; b < 2; ++b)
#pragma unroll
            for (int m = 0; m < 4; ++m)
#pragma unroll
                for (int n = 0; n < 2; ++n) acc[a][b][m][n] = (f32x4){0.f, 0.f, 0.f, 0.f};
    bf16x8 At[4][2], B0[2][2], B1[2][2];
    const char* cA = GATHER ? (const char*)g.A : (const char*)g.A + (size_t)cur.arow * K * 2; const char* cB = (const char*)g.Bt + (size_t)cur.brow * K * 2;
    if constexpr (GATHER) {
#pragma unroll
        for (int h = 0; h < 2; ++h)
#pragma unroll
            for (int i = 0; i < 2; ++i) { gAc[h][i] = S.row_off(cur, h * HALF + RA[i]); gAn[h][i] = gAc[h][i]; }
    }
    PG8_STAGE(PG8_SB(0, 0), cB, voffB); PG8_STAGE(PG8_SB(0, 1), cB + hstep, voffB); PG8_STAGEA(PG8_SA(0, 0), cA, 0, false); PG8_STAGEA(PG8_SA(0, 1), cA, 1, false);
    if (wr == 1) PG8_BAR;
    PG8_WAIT_V(2); PG8_BAR;
    PG8_STAGE(PG8_SB(1, 0), cB + kstep, voffB); PG8_STAGEA(PG8_SA(1, 0), cA + kstep, 0, false); PG8_STAGE(PG8_SB(1, 1), cB + hstep + kstep, voffB);
    PG8_WAIT_V(6); PG8_BAR;
    for (;;) {
        const bool has_next = S.next(ui + 1, nxt);
        const char* nA = has_next ? (GATHER ? (const char*)g.A : (const char*)g.A + (size_t)nxt.arow * K * 2) : cA; const char* nB = has_next ? (const char*)g.Bt + (size_t)nxt.brow * K * 2 : cB;
        if constexpr (GATHER) { if (has_next) {
#pragma unroll
            for (int h = 0; h < 2; ++h)
#pragma unroll
                for (int i = 0; i < 2; ++i) gAn[h][i] = S.row_off(nxt, h * HALF + RA[i]); } }
        for (int t = 0; t < nt; t += 2) {
            const bool last = (t == nt - 2);
            const char* a1 = cA + (size_t)(t + 1) * kstep;
            const char* a2 = last ? nA : cA + (size_t)(t + 2) * kstep; const char* b2 = last ? nB : cB + (size_t)(t + 2) * kstep;
            const char* a3 = a2 + kstep; const char* b3 = b2 + kstep;
            PG8_LDB(B0, 0, 0); PG8_LDB(B1, 0, 1); PG8_SCHED; PG8_LDA(At, 0, 0); PG8_STAGEA(PG8_SA(1, 1), a1, 1, false);
            PG8_WAIT_V(8); PG8_WAIT_L(0); PG8_BAR; PG8_MMA(0, 0, At, B0); PG8_MMA(0, 1, At, B1); PG8_BAR; PG8_SCHED;
            PG8_LDA(At, 0, 1); PG8_STAGE(PG8_SB(0, 0), b2, voffB); PG8_STAGE(PG8_SB(0, 1), b2 + hstep, voffB); PG8_STAGEA(PG8_SA(0, 0), a2, 0, last);
            PG8_WAIT_V(8); PG8_WAIT_L(0); PG8_BAR; PG8_MMA(1, 0, At, B0); PG8_MMA(1, 1, At, B1); PG8_BAR; PG8_SCHED;
            PG8_LDB(B0, 1, 0); PG8_LDB(B1, 1, 1); PG8_SCHED; PG8_LDA(At, 1, 0); PG8_STAGEA(PG8_SA(0, 1), a2, 1, last);
            PG8_WAIT_V(8); PG8_WAIT_L(0); PG8_BAR; PG8_MMA(0, 0, At, B0); PG8_MMA(0, 1, At, B1); PG8_BAR; PG8_SCHED;
            PG8_LDA(At, 1, 1); PG8_STAGE(PG8_SB(1, 0), b3, voffB); PG8_STAGE(PG8_SB(1, 1), b3 + hstep, voffB); PG8_STAGEA(PG8_SA(1, 0), a3, 0, last);
            PG8_WAIT_V(8); PG8_WAIT_L(0); PG8_BAR; PG8_MMA(1, 0, At, B0); PG8_MMA(1, 1, At, B1); PG8_BAR; PG8_SCHED;
        }
        if (wr == 0) PG8_BAR;
        E(acc, cur, wr, wc, fr, fq);
        if (!has_next) break;
#pragma unroll
        for (int a = 0; a < 2; ++a)
#pragma unroll
            for (int b = 0; b < 2; ++b)
#pragma unroll
                for (int m = 0; m < 4; ++m)
#pragma unroll
                    for (int n = 0; n < 2; ++n) acc[a][b][m][n] = (f32x4){0.f, 0.f, 0.f, 0.f};
        cur = nxt; cA = nA; cB = nB; ++ui;
        if constexpr (GATHER) {
#pragma unroll
            for (int h = 0; h < 2; ++h)
#pragma unroll
                for (int i = 0; i < 2; ++i) gAc[h][i] = gAn[h][i];
        }
        if (wr == 1) PG8_BAR;
    }
    PG8_WAIT_V(0);
    PG8_BAR;
#undef PG8_SA
#undef PG8_SB
#undef PG8_STAGE
#undef PG8_STAGEA
#undef PG8_LDA
#undef PG8_LDB
#undef PG8_MMA
#undef PG8_WAIT_V
#undef PG8_WAIT_L
#undef PG8_BAR
#undef PG8_SCHED
}
}
namespace mk {
using pg8::f32x4; using pg8::u32x4; using pg8::u32x2; using pg8::Unit;
constexpr int NWAVES = 8, NTHR = 512;
constexpr int RING_BYTES = 131072, LDSCTL_OFF = RING_BYTES, LDS_BYTES = 147456;
constexpr int LW_BAR = 0, LW_TPRE = 16  , LW_CNT = 64  , LW_MISC = 128;
enum Phase { PH_PRO = 0, PH_H1, PH_G1, PH_ROPE_HGA, PH_ATT_SCAN, PH_HGC, PH_G2A, PH_G2B, PH_G3, PH_TOK, PH_G4, PH_G5, PH_FIN, PH_N };

struct Args {
    const float* in[25]; float* out; unsigned char* ws; int ph_lo, ph_hi, li, pad;
};

__device__ __forceinline__ float wave_sum(float v) {
#pragma unroll
    for (int o = 1; o < 64; o <<= 1) v += __shfl_xor(v, o);
    return v;
}
__device__ __forceinline__ float sigm(float x) { return 1.f / (1.f + __expf(-x)); }
__device__ __forceinline__ unsigned pk2(float lo, float hi) { return (unsigned)f2bf(lo) | ((unsigned)f2bf(hi) << 16); }

struct EpiBf16 {
    static constexpr bool PERM = true;
    bf16_t* O; int ldc;
    __device__ __forceinline__ void operator()(const f32x4 (&acc)[2][2][4][2], const Unit& u, int wr, int wc, int fr, int fq) const {
        const int row0 = u.pm * 256 + wr * 64 + fr, col0 = u.pn * 256 + wc * 32 + 8 * fq;
#pragma unroll
        for (int ai = 0; ai < 2; ++ai)
#pragma unroll
            for (int m = 0; m < 4; ++m) { bf16_t* rowp = O + (size_t)(row0 + ai * 128 + m * 16) * ldc + col0;
#pragma unroll
                for (int bj = 0; bj < 2; ++bj) { const f32x4 v0 = acc[ai][bj][m][0], v1 = acc[ai][bj][m][1]; u32x4 w; w.x = pk2(v0[0], v0[1]); w.y = pk2(v0[2], v0[3]); w.z = pk2(v1[0], v1[1]); w.w = pk2(v1[2], v1[3]);
                    *(u32x4*)(rowp + bj * 128) = w; } }
    }
};
struct EpiF32 {
    static constexpr bool PERM = false;
    float* O; int ldc;
    __device__ __forceinline__ void operator()(const f32x4 (&acc)[2][2][4][2], const Unit& u, int wr, int wc, int fr, int fq) const {
        const int row0 = u.pm * 256 + wr * 64 + fr, col0 = u.pn * 256 + wc * 32 + 4 * fq;
#pragma unroll
        for (int ai = 0; ai < 2; ++ai)
#pragma unroll
            for (int m = 0; m < 4; ++m) { float* rowp = O + (size_t)(row0 + ai * 128 + m * 16) * ldc + col0;
#pragma unroll
                for (int bj = 0; bj < 2; ++bj)
#pragma unroll
                    for (int n = 0; n < 2; ++n) *(f32x4*)(rowp + bj * 128 + n * 16) = acc[ai][bj][m][n]; }
    }
};
template <bool SECOND> struct EpiBranch {
    static constexpr bool PERM = false;
    float* tmp; const bf16_t* proj; bf16_t* merged;
    __device__ __forceinline__ void operator()(const f32x4 (&acc)[2][2][4][2], const Unit& u, int wr, int wc, int fr, int fq) const {
        const int row0 = u.pm * 256 + wr * 64 + fr, col0 = u.pn * 256 + wc * 32 + 4 * fq;
#pragma unroll
        for (int ai = 0; ai < 2; ++ai)
#pragma unroll
            for (int m = 0; m < 4; ++m) { const size_t row = (size_t)(row0 + ai * 128 + m * 16);
#pragma unroll
                for (int bj = 0; bj < 2; ++bj)
#pragma unroll
                    for (int n = 0; n < 2; ++n) { const int col = col0 + bj * 128 + n * 16; const f32x4 a = acc[ai][bj][m][n];
                        const u32x2 gw = *(const u32x2*)(proj + row * 5632 + (SECOND ? 4608 : 3584) + col);
                        f32x4 gt; gt[0] = sigm(__uint_as_float(gw.x << 16)); gt[1] = sigm(__uint_as_float(gw.x & 0xffff0000u)); gt[2] = sigm(__uint_as_float(gw.y << 16)); gt[3] = sigm(__uint_as_float(gw.y & 0xffff0000u));
                        if (!SECOND) { *(f32x4*)(tmp + row * 1024 + col) = gt * a; }
                        else { const f32x4 t = *(const f32x4*)(tmp + row * 1024 + col); const f32x4 r = t + gt * a; u32x2 w; w.x = pk2(r[0], r[1]); w.y = pk2(r[2], r[3]); *(u32x2*)(merged + row * 1024 + col) = w; } } }
    }
};
struct EpiGateUp {
    static constexpr bool PERM = true;
    const float* bgu; bf16_t* act;
    __device__ __forceinline__ void operator()(const f32x4 (&acc)[2][2][4][2], const Unit& u, int wr, int wc, int fr, int fq) const {
        const int e = u.z, colA = u.pn * 128 + wc * 32 + 8 * fq;
        f32x4 bg[2], bu[2];
#pragma unroll
        for (int n = 0; n < 2; ++n) { bg[n] = *(const f32x4*)(bgu + e * 2048 + colA + 4 * n); bu[n] = *(const f32x4*)(bgu + e * 2048 + 1024 + colA + 4 * n); }
#pragma unroll
        for (int ai = 0; ai < 2; ++ai)
#pragma unroll
            for (int m = 0; m < 4; ++m) { const size_t slot = (size_t)(u.arow + ai * 128 + wr * 64 + m * 16 + fr); unsigned w[4];
#pragma unroll
                for (int n = 0; n < 2; ++n) { float r[4];
#pragma unroll
                    for (int j = 0; j < 4; ++j) { float g = acc[ai][0][m][n][j] + bg[n][j], uu = acc[ai][1][m][n][j] + bu[n][j]; g = fminf(g, 7.f); uu = fminf(fmaxf(uu, -7.f), 7.f); r[j] = (uu + 1.f) * g * sigm(1.702f * g); }
                    w[2 * n] = pk2(r[0], r[1]); w[2 * n + 1] = pk2(r[2], r[3]); }
                *(u32x4*)(act + slot * 1024 + colA) = (u32x4){w[0], w[1], w[2], w[3]}; }
    }
};
struct EpiDown {
    static constexpr bool PERM = true;
    const float* bd; const int* list; bf16_t* ym; const LAS int* cnt;
    __device__ __forceinline__ void operator()(const f32x4 (&acc)[2][2][4][2], const Unit& u, int wr, int wc, int fr, int fq) const {
        const int e = u.z, nvalid = cnt[e] - u.pm * 256, col0 = u.pn * 256 + wc * 32 + 8 * fq;
        f32x4 bv[2][2];
#pragma unroll
        for (int bj = 0; bj < 2; ++bj)
#pragma unroll
            for (int n = 0; n < 2; ++n) bv[bj][n] = *(const f32x4*)(bd + e * 1024 + col0 + bj * 128 + 4 * n);
#pragma unroll
        for (int ai = 0; ai < 2; ++ai)
#pragma unroll
            for (int m = 0; m < 4; ++m) { const int r = ai * 128 + wr * 64 + m * 16 + fr;
                if (r < nvalid) { const int a = list[(size_t)e * 32768 + u.pm * 256 + r]; bf16_t* rowp = ym + (size_t)a * 1024 + col0;
#pragma unroll
                    for (int bj = 0; bj < 2; ++bj) { const f32x4 v0 = acc[ai][bj][m][0] + bv[bj][0], v1 = acc[ai][bj][m][1] + bv[bj][1]; u32x4 w; w.x = pk2(v0[0], v0[1]); w.y = pk2(v0[2], v0[3]); w.z = pk2(v1[0], v1[1]); w.w = pk2(v1[2], v1[3]);
                        *(u32x4*)(rowp + bj * 128) = w; } } }
    }
};
struct MoeOrder {
    const LAS int* tpre; const LAS int* cnt; const int* list; int nN, G, c, rowpitch  , brows  ;
    __device__ bool next(int i, Unit& u) const {
        const int nwg = tpre[32] * nN; const long L = (long)i * G + c; if (L >= nwg) return false;
        int wgid = (int)L; { const int q = nwg / 8, r = nwg % 8, xcd = wgid % 8, off = wgid / 8; wgid = (xcd < r ? xcd * (q + 1) : r * (q + 1) + (xcd - r) * q) + off; }
        int e = 0;
#pragma unroll 1
        for (int s = 16; s > 0; s >>= 1) { if (tpre[e + s] * nN <= wgid) e += s; }
        const int w = wgid - tpre[e] * nN, nM = tpre[e + 1] - tpre[e];
        const int nig = 8 * nN, gid = w / nig, fm = gid * 8, gsz = (nM - fm) < 8 ? (nM - fm) : 8;
        u.pm = fm + ((w % nig) % gsz); u.pn = (w % nig) / gsz; u.z = e; u.arow = (tpre[e] + u.pm) * 256; u.brow = e * brows + u.pn * 256; return true;
    }
    __device__ __forceinline__ unsigned row_off(const Unit& u, int r) const {
        const int lr = u.pm * 256 + r; const int a = list[(size_t)u.z * 32768 + (lr < cnt[u.z] ? lr : 0)]; return (unsigned)(a >> 2) * (unsigned)rowpitch;
    }
};

__device__ __forceinline__ void transpose_item(const float* W, int K, int N, bf16_t* WT, int k0, int n0, int dst_row0, LAS float* scr, int lane) {
#pragma unroll 8
    for (int i = 0; i < 32; ++i) { const int kk = 2 * i + (lane >> 5); scr[kk * 33 + (lane & 31)] = W[(size_t)(k0 + kk) * N + n0 + (lane & 31)]; }
    asm volatile("s_waitcnt lgkmcnt(0)" ::: "memory");
    const int c = lane & 7;
#pragma unroll
    for (int j = 0; j < 4; ++j) { const int n = (lane >> 3) + 8 * j; const LAS float* s = scr + (8 * c) * 33 + n;
        u32x4 o; o.x = pk2(s[0 * 33], s[1 * 33]); o.y = pk2(s[2 * 33], s[3 * 33]); o.z = pk2(s[4 * 33], s[5 * 33]); o.w = pk2(s[6 * 33], s[7 * 33]);
        *(u32x4*)(WT + (size_t)(dst_row0 + n) * K + k0 + 8 * c) = o; }
    asm volatile("s_waitcnt lgkmcnt(0)" ::: "memory");
}
template <bool GU>
__device__ __forceinline__ void transpose_matrix(const float* W, int K, int N, bf16_t* WT, LAS float* scr, int lane, int gw, int NGW, int& itbase) {
    const int nblk = N / 32, nitems = (K / 64) * nblk;
    int first = (gw - itbase) % NGW; if (first < 0) first += NGW;
    for (int it = first; it < nitems; it += NGW) { const int kb = it / nblk, nb = it % nblk, n0 = nb * 32;
        int dst = n0; if (GU) { const int nn = n0 & 1023; dst = (nn >> 7) * 256 + (n0 >> 10) * 128 + (nn & 127); }
        transpose_item(W, K, N, WT, kb * 64, n0, dst, scr, lane); }
    itbase += nitems;
}


#define MOD ((float*)(ws + WS_SMALL))
#define SCAL ((float*)(ws + WS_SMALL + 128 * 1024))
#define ROPEC ((float*)(ws + WS_ROPEC))
#define ROPES ((float*)(ws + WS_ROPES))
#define TOPI ((int*)(ws + WS_TOPI))
#define TOPW ((float*)(ws + WS_TOPW))
#define LIST ((int*)(ws + WS_LIST))
#define CNT ((int*)(ws + WS_CTL) + CW_CNT)
#define H ((bf16_t*)(ws + WS_H))
#define PROJ ((bf16_t*)(ws + WS_PROJ))
#define YA ((bf16_t*)(ws + WS_YA))
#define YB ((bf16_t*)(ws + WS_YB))
#define DS ((bf16_t*)(ws + WS_DS))
#define DEC ((float*)(ws + WS_DEC))
#define MERGED ((bf16_t*)(ws + WS_MERGED))
#define Y ((float*)(ws + WS_Y))
#define ACT ((bf16_t*)(ws + WS_ACT))
#define YM ((bf16_t*)(ws + WS_YM))
#define WT_IN ((bf16_t*)(ws + WS_WIN))
#define WT_A ((bf16_t*)(ws + WS_WA))
#define WT_B ((bf16_t*)(ws + WS_WB))
#define WT_O ((bf16_t*)(ws + WS_WO))
#define WT_GU ((bf16_t*)(ws + WS_WGU))
#define WT_D ((bf16_t*)(ws + WS_WD))
#define PHASE_BEGIN unsigned char* ws = args.ws; asm volatile("" : "+s"(ws)); int tid = threadIdx.x; asm volatile("" : "+v"(tid)); const int lane = tid & 63; (void)lane; const float* x = args.in[0]; float* out = args.out; (void)x; (void)out;
__global__ void __launch_bounds__(NTHR, 2) mega(Args args) {
    extern __shared__ __attribute__((aligned(16))) unsigned char lds_[];
    LAS unsigned char* lds = (LAS unsigned char*)lds_;
    volatile LAS unsigned* LW = (volatile LAS unsigned*)(lds + LDSCTL_OFF);
    const int tid = threadIdx.x, lane = tid & 63, wave = __builtin_amdgcn_readfirstlane(tid >> 6);
    const int G = gridDim.x; const int bx = blockIdx.x; const int vcu = (G % 8 == 0) ? (bx % 8) * (G / 8) + bx / 8 : bx;
    const int gw = vcu * NWAVES + wave, NGW = G * NWAVES;
    unsigned* CTL = (unsigned*)(args.ws + WS_CTL);
    for (int u = tid; u < (LDS_BYTES - LDSCTL_OFF) / 4; u += NTHR) ((LAS unsigned*)(lds + LDSCTL_OFF))[u] = 0u;
    __syncthreads();
    const int lo = args.ph_lo, hi = args.ph_hi;
    XcdBarrier bar; bar.bar = CTL + CW_BAR + args.li * 4096; bar.x = 0; bar.st = nullptr;
    if (hi - lo > 1) bar = xcd_barrier_post(CTL + CW_BAR + args.li * 4096, LW + LW_BAR);
#ifndef PHMASK
#define PHMASK 0xffff
#endif
#define IN(k) ((((PHMASK) >> (k)) & 1) && lo <= (k) && (k) < hi)
#define SEAM(k) do { if (IN(k) && IN((k) + 1)) xcd_barrier(bar); } while (0)

    if (IN(PH_PRO)) {
        PHASE_BEGIN
        const float* c = args.in[1]; const float* w_mod = args.in[2]; const float* b_mod = args.in[3];
        LAS float* cact = (LAS float*)lds; LAS float* red = cact + 4096;
        for (int i = tid; i < 4096; i += NTHR) { const float cv = c[i]; cact[i] = cv / (1.f + expf(-cv)); }
        __syncthreads();
        for (int it = vcu; it < 384; it += G) { const int b = it / 96, j0 = (it % 96) * 64, kq = tid >> 6, col = tid & 63; float acc = 0.f;
            for (int k = kq * 128; k < kq * 128 + 128; ++k) acc += cact[b * 1024 + k] * w_mod[(size_t)k * 6144 + j0 + col];
            red[kq * 64 + col] = acc; __syncthreads();
            if (tid < 64) { float s = 0.f;
#pragma unroll
                for (int q = 0; q < 8; ++q) s += red[q * 64 + tid];
                MOD[b * 6144 + j0 + tid] = s + b_mod[j0 + tid]; }
            __syncthreads(); }
        const int gt = vcu * NTHR + tid, NGT = G * NTHR;
        if (gt == 0) { const float* q1 = args.in[7]; const float* k1 = args.in[8]; const float* q2 = args.in[9]; const float* k2 = args.in[10]; float s1 = 0.f, s2 = 0.f;
            for (int i = 0; i < 64; ++i) { s1 += q1[i] * k1[i]; s2 += q2[i] * k2[i]; } SCAL[0] = expf(s1) - expf(s2) + 0.2f; }
        if (gt < 512) { const float* lbl = args.in[12]; SCAL[64 + gt] = 1.f / (1.f + expf(lbl[512 + gt] - lbl[gt])); }
        for (int i = gt; i < 8192 * 32; i += NGT) { const int s = i >> 5, j = i & 31; const float inv = powf(10000.f, -(float)(2 * j) / 64.f); const float ang = (float)s * inv; ROPEC[i] = cosf(ang); ROPES[i] = sinf(ang); }
        LAS float* scr = (LAS float*)(lds + wave * 16384); int itbase = 0;
        transpose_matrix<false>(args.in[6], 1024, 5632, WT_IN, scr, lane, gw, NGW, itbase);
        transpose_matrix<false>(args.in[14], 512, 1024, WT_A, scr, lane, gw, NGW, itbase);
        transpose_matrix<false>(args.in[15], 512, 1024, WT_B, scr, lane, gw, NGW, itbase);
        transpose_matrix<false>(args.in[16], 1024, 1024, WT_O, scr, lane, gw, NGW, itbase);
        for (int e = 0; e < 32; ++e) transpose_matrix<true>(args.in[21] + (size_t)e * 1024 * 2048, 1024, 2048, WT_GU + (size_t)e * 2048 * 1024, scr, lane, gw, NGW, itbase);
        for (int e = 0; e < 32; ++e) transpose_matrix<false>(args.in[23] + (size_t)e * 1024 * 1024, 1024, 1024, WT_D + (size_t)e * 1024 * 1024, scr, lane, gw, NGW, itbase);
    }
    SEAM(PH_PRO);
    if (IN(PH_H1)) {
        PHASE_BEGIN
        const float* w = args.in[4];
        for (int row = gw; row < T; row += NGW) { const int b = row >> 13; const f32x4* xr = (const f32x4*)(x + (size_t)row * 1024) + lane; f32x4 v[4]; float ss = 0.f;
#pragma unroll
            for (int j = 0; j < 4; ++j) { v[j] = xr[64 * j]; ss += (v[j][0] * v[j][0] + v[j][1] * v[j][1]) + (v[j][2] * v[j][2] + v[j][3] * v[j][3]); }
            const float rstd = rsqrtf(wave_sum(ss) * (1.f / 1024.f) + 1e-6f);
#pragma unroll
            for (int j = 0; j < 4; ++j) { const int col = 4 * lane + 256 * j; const f32x4 wv = *(const f32x4*)(w + col), sc = *(const f32x4*)(MOD + b * 6144 + 1024 + col), sh = *(const f32x4*)(MOD + b * 6144 + col);
                const f32x4 h = v[j] * rstd * wv * (sc + 1.f) + sh; u32x2 o; o.x = pk2(h[0], h[1]); o.y = pk2(h[2], h[3]); *(u32x2*)(H + (size_t)row * 1024 + col) = o; } }
    }
    SEAM(PH_H1);
    if (IN(PH_G1)) {
        PHASE_BEGIN
        pg8::Gemm g{H, WT_IN, 1024}; pg8::DenseOrder S; S.init(T, NC, G, bx);
        EpiBf16 E{PROJ, NC};
        pg8::gemm_phase<EpiBf16, pg8::DenseOrder, false>(lds, g, S, E);
    }
    SEAM(PH_G1);
    if (IN(PH_ROPE_HGA)) {
        PHASE_BEGIN
        LAS float* Gs = (LAS float*)lds; LAS float* Vs = Gs + 64 * 128;
        for (int it = vcu; it < 2048; it += G) { const int n = it & 127, bh = it >> 7, h = bh & 3, b = bh >> 2, tok0 = b * 8192 + n * 64;
            __syncthreads();
            for (int i = 0; i < 16; ++i) { const int idx = tid + 512 * i, cc = idx >> 7, d = idx & 127; const bf16_t* pr = PROJ + (size_t)(tok0 + cc) * 5632 + h * 128 + d;
                const float lb = SCAL[64 + h * 128 + d]; const float f = lb + (1.f - lb) * sigm(bf2f(pr[2048])); Gs[cc * 128 + d] = f; Vs[cc * 128 + d] = bf2f(pr[2560]); }
            __syncthreads();
            const int d = tid & 127, vb = (tid >> 7) * 32;
            if (tid < 128) { float gl = 0.f;
                for (int cc = 0; cc < 64; ++cc) gl += __logf(Gs[cc * 128 + d]);
                float g = 0.f;
                for (int cc = 0; cc < 64; ++cc) { const float f = Gs[cc * 128 + d]; g += __logf(f); Gs[cc * 128 + d] = (1.f - f) * __expf(gl - g); }
                DEC[(size_t)(bh * 128 + n) * 128 + d] = __expf(gl); }
            __syncthreads();
            for (int v0 = 0; v0 < 32; v0 += 16) { float acc[16];
#pragma unroll
                for (int i = 0; i < 16; ++i) acc[i] = 0.f;
                for (int cc = 0; cc < 64; ++cc) { const float kd = Gs[cc * 128 + d];
#pragma unroll
                    for (int i = 0; i < 16; ++i) acc[i] += kd * Vs[cc * 128 + vb + v0 + i]; }
                unsigned w[8];
#pragma unroll
                for (int i = 0; i < 8; ++i) w[i] = pk2(acc[2 * i], acc[2 * i + 1]);
                u32x4* dst = (u32x4*)(DS + ((size_t)(bh * 128 + n) * 128 + d) * 128 + vb + v0); dst[0] = (u32x4){w[0], w[1], w[2], w[3]}; dst[1] = (u32x4){w[4], w[5], w[6], w[7]}; }
        }
        __syncthreads();
    }
    SEAM(PH_ROPE_HGA);
    if (IN(PH_ATT_SCAN)) {
        PHASE_BEGIN
        for (int gid = vcu * NTHR + tid; gid < 16 * 128 * 128; gid += G * NTHR) { const int bh = gid >> 14, d = (gid >> 7) & 127, v = gid & 127; float st = 0.f;
            for (int n = 0; n < 128; ++n) { const size_t o = ((size_t)(bh * 128 + n) * 128 + d) * 128 + v; const float xv = bf2f(DS[o]); DS[o] = f2bf(st); st = DEC[(size_t)(bh * 128 + n) * 128 + d] * st + xv; } }
        constexpr int LD = 129; LAS float* Qs = (LAS float*)lds; LAS float* Ks = Qs + 64 * LD; LAS float* Vs = Ks + 64 * LD; LAS float* As = Vs + 64 * LD;
        const float lam = SCAL[0]; const float* subln = args.in[11];
        for (int it = vcu; it < 2048; it += G) { const int qc = 127 - (it >> 4), bh = it & 15, h = bh & 3, b = bh >> 2, r = tid >> 3, qd = tid & 7, tokq = b * 8192 + qc * 64;
            __syncthreads();
            for (int i = 0; i < 8; ++i) { const int idx = tid + 512 * i, row = idx >> 6, rem = idx & 63, m = rem >> 5, d = rem & 31; const bf16_t* pr = PROJ + (size_t)(tokq + row) * 5632 + h * 128 + m * 64;
                const float x1 = bf2f(pr[d]), x2 = bf2f(pr[32 + d]), cs = ROPEC[(qc * 64 + row) * 32 + d], sn = ROPES[(qc * 64 + row) * 32 + d];
                Qs[row * LD + m * 64 + d] = x1 * cs - x2 * sn; Qs[row * LD + m * 64 + 32 + d] = x2 * cs + x1 * sn; }
            float m0 = -1e30f, l0 = 0.f, m1 = -1e30f, l1 = 0.f;
            for (int pass = 0; pass < 2; ++pass) {
                float il0 = 0.f, il1 = 0.f; float o[16];
#pragma unroll
                for (int i = 0; i < 16; ++i) o[i] = 0.f;
                if (pass == 1) {
#pragma unroll
                    for (int of = 1; of < 8; of <<= 1) { float mo = __shfl_xor(m0, of), lo2 = __shfl_xor(l0, of); float mn = fmaxf(m0, mo); l0 = l0 * __expf(m0 - mn) + lo2 * __expf(mo - mn); m0 = mn;
                        mo = __shfl_xor(m1, of); lo2 = __shfl_xor(l1, of); mn = fmaxf(m1, mo); l1 = l1 * __expf(m1 - mn) + lo2 * __expf(mo - mn); m1 = mn; }
                    il0 = 1.f / l0; il1 = lam / l1; }
                for (int kc = 0; kc <= qc; ++kc) {
                    __syncthreads();
                    for (int i = 0; i < 8; ++i) { const int idx = tid + 512 * i, row = idx >> 6, rem = idx & 63, m = rem >> 5, d = rem & 31; const bf16_t* pr = PROJ + (size_t)(b * 8192 + kc * 64 + row) * 5632 + 512 + h * 128 + m * 64;
                        const float x1 = bf2f(pr[d]), x2 = bf2f(pr[32 + d]), cs = ROPEC[(kc * 64 + row) * 32 + d], sn = ROPES[(kc * 64 + row) * 32 + d];
                        Ks[row * LD + m * 64 + d] = x1 * cs - x2 * sn; Ks[row * LD + m * 64 + 32 + d] = x2 * cs + x1 * sn; }
                    if (pass == 1) for (int i = 0; i < 16; ++i) { const int idx = tid + 512 * i, row = idx >> 7, col = idx & 127; Vs[row * LD + col] = bf2f(PROJ[(size_t)(b * 8192 + kc * 64 + row) * 5632 + 1024 + h * 128 + col]); }
                    __syncthreads();
                    for (int i = 0; i < 8; ++i) { const int j = 8 * i + qd; float s0 = 0.f, s1 = 0.f;
                        for (int d = 0; d < 64; ++d) { s0 += Qs[r * LD + d] * Ks[j * LD + d]; s1 += Qs[r * LD + 64 + d] * Ks[j * LD + 64 + d]; }
                        s0 *= 0.125f; s1 *= 0.125f;
                        if (pass == 0) { float mn = fmaxf(m0, s0); l0 = l0 * __expf(m0 - mn) + __expf(s0 - mn); m0 = mn; mn = fmaxf(m1, s1); l1 = l1 * __expf(m1 - mn) + __expf(s1 - mn); m1 = mn; }
                        else As[r * 65 + j] = __expf(s0 - m0) * il0 - __expf(s1 - m1) * il1; }
                    if (pass == 1) { __syncthreads();
                        for (int j = 0; j < 64; ++j) { const float av = As[r * 65 + j];
#pragma unroll
                            for (int dv = 0; dv < 16; ++dv) o[dv] += av * Vs[j * LD + 16 * qd + dv]; } }
                }
                if (pass == 1) { float ss = 0.f;
#pragma unroll
                    for (int i = 0; i < 16; ++i) ss += o[i] * o[i];
                    ss += __shfl_xor(ss, 1); ss += __shfl_xor(ss, 2); ss += __shfl_xor(ss, 4);
                    const float rstd = rsqrtf(ss * (1.f / 128.f) + 1e-6f);
#pragma unroll
                    for (int i = 0; i < 16; ++i) { const int dv = 16 * qd + i; YA[(size_t)(tokq + r) * 512 + h * 128 + dv] = f2bf(o[i] * rstd * subln[dv] * 0.8f); } }
            }
        }
        __syncthreads();
    }
    SEAM(PH_ATT_SCAN);
    if (IN(PH_HGC)) {
        PHASE_BEGIN
        LAS float* QT = (LAS float*)lds; LAS float* KT = QT + 64 * 129; LAS float* V = KT + 64 * 129; LAS float* As = V + 64 * 128; const float* hgnorm = args.in[13];
        for (int it = vcu; it < 2048; it += G) { const int n = it & 127, bh = it >> 7, h = bh & 3, b = bh >> 2, tok0 = b * 8192 + n * 64;
            __syncthreads();
            for (int i = 0; i < 16; ++i) { const int idx = tid + 512 * i, cc = idx >> 7, d = idx & 127; const bf16_t* pr = PROJ + (size_t)(tok0 + cc) * 5632 + h * 128 + d;
                const float lb = SCAL[64 + h * 128 + d]; const float f = lb + (1.f - lb) * sigm(bf2f(pr[2048])); const float q = bf2f(pr[1536]);
                QT[cc * 129 + d] = q * sigm(q); KT[cc * 129 + d] = f; V[cc * 128 + d] = bf2f(pr[2560]); }
            __syncthreads();
            if (tid < 128) { float g = 0.f; for (int cc = 0; cc < 64; ++cc) { const float f = KT[cc * 129 + tid]; g += __logf(f); QT[cc * 129 + tid] *= __expf(g); KT[cc * 129 + tid] = (1.f - f) * __expf(-g); } }
            __syncthreads();
            const int cc = tid >> 3, q8 = tid & 7;
            for (int i = 0; i < 8; ++i) { const int s = 8 * i + q8; float a = 0.f;
                if (s <= cc) { for (int d = 0; d < 128; ++d) a += QT[cc * 129 + d] * KT[s * 129 + d]; }
                As[cc * 65 + s] = a; }
            __syncthreads();
            float o[16];
#pragma unroll
            for (int i = 0; i < 16; ++i) o[i] = 0.f;
            for (int s = 0; s < 64; ++s) { const float a = As[cc * 65 + s];
#pragma unroll
                for (int i = 0; i < 16; ++i) o[i] += a * V[s * 128 + 16 * q8 + i]; }
            const bf16_t* spb = DS + (size_t)(bh * 128 + n) * 128 * 128;
            for (int d = 0; d < 128; ++d) { const float qv = QT[cc * 129 + d]; const u32x4 s0 = *(const u32x4*)(spb + d * 128 + 16 * q8), s1 = *(const u32x4*)(spb + d * 128 + 16 * q8 + 8);
                const unsigned sw[8] = {s0.x, s0.y, s0.z, s0.w, s1.x, s1.y, s1.z, s1.w};
#pragma unroll
                for (int i = 0; i < 8; ++i) { o[2 * i] += qv * __uint_as_float(sw[i] << 16); o[2 * i + 1] += qv * __uint_as_float(sw[i] & 0xffff0000u); } }
            float ss = 0.f;
#pragma unroll
            for (int i = 0; i < 16; ++i) ss += o[i] * o[i];
            ss += __shfl_xor(ss, 1); ss += __shfl_xor(ss, 2); ss += __shfl_xor(ss, 4);
            const float rstd = rsqrtf(ss * (1.f / 128.f) + 1e-6f);
#pragma unroll
            for (int i = 0; i < 16; ++i) { const int v = 16 * q8 + i; const float gg = bf2f(PROJ[(size_t)(tok0 + cc) * 5632 + 3072 + h * 128 + v]);
                YB[(size_t)(tok0 + cc) * 512 + h * 128 + v] = f2bf(o[i] * rstd * hgnorm[v] * (gg * sigm(gg))); }
        }
        __syncthreads();
    }
    SEAM(PH_HGC);
    if (IN(PH_G2A)) {
        PHASE_BEGIN
        pg8::Gemm g{YA, WT_A, 512}; pg8::DenseOrder S; S.init(T, 1024, G, bx);
        EpiBranch<false> E{out, PROJ, MERGED};
        pg8::gemm_phase<EpiBranch<false>, pg8::DenseOrder, false>(lds, g, S, E);
    }
    if (IN(PH_G2B)) {
        PHASE_BEGIN
        asm volatile("s_waitcnt vmcnt(0)" ::: "memory"); __syncthreads();
        pg8::Gemm g{YB, WT_B, 512}; pg8::DenseOrder S; S.init(T, 1024, G, bx);
        EpiBranch<true> E{out, PROJ, MERGED};
        pg8::gemm_phase<EpiBranch<true>, pg8::DenseOrder, false>(lds, g, S, E);
    }
    SEAM(PH_G2B);
    if (IN(PH_G3)) {
        PHASE_BEGIN
        pg8::Gemm g{MERGED, WT_O, 1024}; pg8::DenseOrder S; S.init(T, 1024, G, bx);
        EpiF32 E{Y, 1024};
        pg8::gemm_phase<EpiF32, pg8::DenseOrder, false>(lds, g, S, E);
    }
    SEAM(PH_G3);
    if (IN(PH_TOK)) {
        PHASE_BEGIN
        const float* wpm = args.in[5]; const float* wpf = args.in[17]; const float* rw = args.in[19]; const float* rb = args.in[20];
        LAS int* lcnt = (LAS int*)lds; LAS int* lbase = lcnt + 32; LAS int* asg = lcnt + 64;
        for (int chunk = vcu; chunk < T / 128; chunk += G) {
            __syncthreads();
            if (tid < 32) lcnt[tid] = 0;
            __syncthreads();
            for (int i = 0; i < 16; ++i) { const int rloc = wave * 16 + i, row = chunk * 128 + rloc, b = row >> 13;
                const f32x4* yr = (const f32x4*)(Y + (size_t)row * 1024) + lane; const f32x4* xr = (const f32x4*)(x + (size_t)row * 1024) + lane; f32x4 v[4]; float ss = 0.f;
#pragma unroll
                for (int j = 0; j < 4; ++j) { v[j] = yr[64 * j]; ss += (v[j][0] * v[j][0] + v[j][1] * v[j][1]) + (v[j][2] * v[j][2] + v[j][3] * v[j][3]); }
                float rstd = rsqrtf(wave_sum(ss) * (1.f / 1024.f) + 1e-6f); ss = 0.f;
#pragma unroll
                for (int j = 0; j < 4; ++j) { const int col = 4 * lane + 256 * j; const f32x4 g1 = *(const f32x4*)(MOD + b * 6144 + 2048 + col), wv = *(const f32x4*)(wpm + col);
                    v[j] = xr[64 * j] + g1 * v[j] * rstd * wv; *(f32x4*)(out + (size_t)row * 1024 + col) = v[j]; ss += (v[j][0] * v[j][0] + v[j][1] * v[j][1]) + (v[j][2] * v[j][2] + v[j][3] * v[j][3]); }
                rstd = rsqrtf(wave_sum(ss) * (1.f / 1024.f) + 1e-6f);
                float lg[32];
#pragma unroll
                for (int e = 0; e < 32; ++e) lg[e] = 0.f;
#pragma unroll
                for (int j = 0; j < 4; ++j) { const int col = 4 * lane + 256 * j; const f32x4 wv = *(const f32x4*)(wpf + col), sc = *(const f32x4*)(MOD + b * 6144 + 4096 + col), sh = *(const f32x4*)(MOD + b * 6144 + 3072 + col);
                    const f32x4 h = v[j] * rstd * wv * (sc + 1.f) + sh; u32x2 o; o.x = pk2(h[0], h[1]); o.y = pk2(h[2], h[3]); *(u32x2*)(H + (size_t)row * 1024 + col) = o;
#pragma unroll
                    for (int q = 0; q < 4; ++q) { const f32x4* rwp = (const f32x4*)(rw + (size_t)(col + q) * 32);
#pragma unroll
                        for (int e4 = 0; e4 < 8; ++e4) { const f32x4 r4 = rwp[e4]; lg[4 * e4] += h[q] * r4[0]; lg[4 * e4 + 1] += h[q] * r4[1]; lg[4 * e4 + 2] += h[q] * r4[2]; lg[4 * e4 + 3] += h[q] * r4[3]; } } }
#pragma unroll
                for (int e = 0; e < 32; ++e) lg[e] = wave_sum(lg[e]) + rb[e];
                int bi[4]; float bv[4];
#pragma unroll
                for (int k = 0; k < 4; ++k) { float best = -3.0e38f; int be = 0;
#pragma unroll
                    for (int e = 0; e < 32; ++e) { bool taken = false;
#pragma unroll
                        for (int q = 0; q < 4; ++q) if (q < k && bi[q] == e) taken = true;
                        if (!taken && lg[e] > best) { best = lg[e]; be = e; } }
                    bi[k] = be; bv[k] = best; }
                const float e1 = expf(bv[1] - bv[0]), e2 = expf(bv[2] - bv[0]), e3 = expf(bv[3] - bv[0]); const float inv = 1.f / (1.f + e1 + e2 + e3);
                if (lane == 0) { *(f32x4*)(TOPW + row * 4) = (f32x4){inv, e1 * inv, e2 * inv, e3 * inv};
                    TOPI[row * 4 + 0] = bi[0]; TOPI[row * 4 + 1] = bi[1]; TOPI[row * 4 + 2] = bi[2]; TOPI[row * 4 + 3] = bi[3];
#pragma unroll
                    for (int k = 0; k < 4; ++k) { const int pos = __hip_atomic_fetch_add(lcnt + bi[k], 1, __ATOMIC_RELAXED, __HIP_MEMORY_SCOPE_WORKGROUP); asg[rloc * 4 + k] = (bi[k] << 16) | pos; } }
            }
            __syncthreads();
            if (tid < 32) lbase[tid] = atomicAdd(&CNT[tid], lcnt[tid]);
            __syncthreads();
            { const int v = asg[tid], e = v >> 16, pos = v & 0xffff; LIST[(size_t)e * 32768 + lbase[e] + pos] = chunk * 512 + tid; }
        }
        __syncthreads();
    }
    SEAM(PH_TOK);
    if (IN(PH_G4) || IN(PH_G5)) {
        PHASE_BEGIN
        if (tid < 32) ((LAS int*)LW)[LW_CNT + tid] = __hip_atomic_load(&CNT[tid], __ATOMIC_RELAXED, __HIP_MEMORY_SCOPE_AGENT);
        __syncthreads();
        if (tid == 0) { int s = 0; for (int e = 0; e < 32; ++e) { ((LAS int*)LW)[LW_TPRE + e] = s; s += (((LAS int*)LW)[LW_CNT + e] + 255) >> 8; } ((LAS int*)LW)[LW_TPRE + 32] = s; }
        __syncthreads();
    }
    if (IN(PH_G4)) {
        PHASE_BEGIN
        pg8::Gemm g{H, WT_GU, 1024}; MoeOrder S{(const LAS int*)LW + LW_TPRE, (const LAS int*)LW + LW_CNT, LIST, 8, G, bx, 2048, 2048};
        EpiGateUp E{args.in[22], ACT};
        pg8::gemm_phase<EpiGateUp, MoeOrder, true>(lds, g, S, E);
    }
    SEAM(PH_G4);
    if (IN(PH_G5)) {
        PHASE_BEGIN
        pg8::Gemm g{ACT, WT_D, 1024}; MoeOrder S{(const LAS int*)LW + LW_TPRE, (const LAS int*)LW + LW_CNT, LIST, 4, G, bx, 2048, 1024};
        EpiDown E{args.in[24], LIST, YM, (const LAS int*)LW + LW_CNT};
        pg8::gemm_phase<EpiDown, MoeOrder, false>(lds, g, S, E);
    }
    SEAM(PH_G5);
    if (IN(PH_FIN)) {
        PHASE_BEGIN
        const float* w = args.in[18];
        for (int row = gw; row < T; row += NGW) { const int b = row >> 13; const f32x4 tw = *(const f32x4*)(TOPW + row * 4); const bf16_t* y0 = YM + (size_t)row * 4096; f32x4 v[4]; float ss = 0.f;
#pragma unroll
            for (int j = 0; j < 4; ++j) { const int col = 4 * lane + 256 * j; f32x4 a = (f32x4){0.f, 0.f, 0.f, 0.f};
#pragma unroll
                for (int k = 0; k < 4; ++k) { const u32x2 yw = *(const u32x2*)(y0 + k * 1024 + col);
                    a[0] += tw[k] * __uint_as_float(yw.x << 16); a[1] += tw[k] * __uint_as_float(yw.x & 0xffff0000u); a[2] += tw[k] * __uint_as_float(yw.y << 16); a[3] += tw[k] * __uint_as_float(yw.y & 0xffff0000u); }
                v[j] = a; ss += (a[0] * a[0] + a[1] * a[1]) + (a[2] * a[2] + a[3] * a[3]); }
            const float rstd = rsqrtf(wave_sum(ss) * (1.f / 1024.f) + 1e-6f);
#pragma unroll
            for (int j = 0; j < 4; ++j) { const int col = 4 * lane + 256 * j; const f32x4 g2 = *(const f32x4*)(MOD + b * 6144 + 5120 + col), wv = *(const f32x4*)(w + col);
                f32x4* op = (f32x4*)(out + (size_t)row * 1024 + col); *op = *op + g2 * v[j] * rstd * wv; } }
    }
#undef IN
#undef SEAM
}
}
#undef MOD
#undef SCAL
#undef ROPEC
#undef ROPES
#undef TOPI
#undef TOPW
#undef LIST
#undef CNT
#undef H
#undef PROJ
#undef YA
#undef YB
#undef DS
#undef DEC
#undef MERGED
#undef Y
#undef ACT
#undef YM
#undef WT_IN
#undef WT_A
#undef WT_B
#undef WT_O
#undef WT_GU
#undef WT_D
#undef PHASE_BEGIN

#ifndef FASTMASK
#define FASTMASK 0x1fff
#endif

extern "C" void kernel_launch(void* const* d_in, const int* in_sizes, int n_in, void* d_out, int out_size, void* d_ws, size_t ws_size, hipStream_t stream) {
    if (n_in != 25 || out_size != T * D || ws_size < WS_END) { fprintf(stderr, "kernel_launch: unexpected shapes / workspace (%d inputs, out %d, ws %zu)\n", n_in, out_size, ws_size); return; }
    const float* x = (const float*)d_in[0]; const float* c = (const float*)d_in[1]; const float* w_mod = (const float*)d_in[2]; const float* b_mod = (const float*)d_in[3];
    const float* norm_pre_mix = (const float*)d_in[4]; const float* norm_post_mix = (const float*)d_in[5]; const float* w_in = (const float*)d_in[6];
    const float* lq1 = (const float*)d_in[7]; const float* lk1 = (const float*)d_in[8]; const float* lq2 = (const float*)d_in[9]; const float* lk2 = (const float*)d_in[10];
    const float* subln = (const float*)d_in[11]; const float* lbl = (const float*)d_in[12]; const float* hgnorm = (const float*)d_in[13];
    const float* wa = (const float*)d_in[14]; const float* wb = (const float*)d_in[15]; const float* wo = (const float*)d_in[16];
    const float* norm_pre_ffn = (const float*)d_in[17]; const float* norm_post_ffn = (const float*)d_in[18]; const float* rw = (const float*)d_in[19]; const float* rb = (const float*)d_in[20];
    const float* wgu = (const float*)d_in[21]; const float* bgu = (const float*)d_in[22]; const float* wd = (const float*)d_in[23]; const float* bd = (const float*)d_in[24];
    unsigned char* ws = (unsigned char*)d_ws; float* out = (float*)d_out;
    float* MOD = (float*)(ws + WS_SMALL); float* SCAL = (float*)(ws + WS_SMALL + 128 * 1024); int* PADS = (int*)(ws + WS_SMALL + 192 * 1024);
    float* ROPEC = (float*)(ws + WS_ROPEC); float* ROPES = (float*)(ws + WS_ROPES);
    int* TOPI = (int*)(ws + WS_TOPI); float* TOPW = (float*)(ws + WS_TOPW); int* LIST = (int*)(ws + WS_LIST); int* CNT = (int*)(ws + WS_CTL) + CW_CNT;
    bf16_t* H = (bf16_t*)(ws + WS_H); bf16_t* PROJ = (bf16_t*)(ws + WS_PROJ); bf16_t* YA = (bf16_t*)(ws + WS_YA); bf16_t* YB = (bf16_t*)(ws + WS_YB);
    bf16_t* DS = (bf16_t*)(ws + WS_DS); float* DEC = (float*)(ws + WS_DEC); bf16_t* MERGED = (bf16_t*)(ws + WS_MERGED); float* Y = (float*)(ws + WS_Y);
    bf16_t* ACT = (bf16_t*)(ws + WS_ACT); bf16_t* YM = (bf16_t*)(ws + WS_YM);

    static int grid = 0;
    if (grid == 0) {
        (void)hipFuncSetAttribute((const void*)nv::k_attn, hipFuncAttributeMaxDynamicSharedMemorySize, nv::AT_LDS);
        (void)hipFuncSetAttribute((const void*)nv::k_hgA, hipFuncAttributeMaxDynamicSharedMemorySize, 65536);
        (void)hipFuncSetAttribute((const void*)nv::k_hgC, hipFuncAttributeMaxDynamicSharedMemorySize, nv::HC_LDS);
        (void)hipFuncSetAttribute((const void*)mk::mega, hipFuncAttributeMaxDynamicSharedMemorySize, mk::LDS_BYTES);
        int dev = 0, cus = 0; (void)hipGetDevice(&dev); (void)hipDeviceGetAttribute(&cus, hipDeviceAttributeMultiprocessorCount, dev);
        (void)hipGetLastError();
        grid = cus > 0 ? cus : 256;
    }
    (void)hipMemsetAsync(ws + WS_CTL, 0, 1 * MiB, stream);
    mk::Args a{}; for (int i = 0; i < 25; ++i) a.in[i] = (const float*)d_in[i]; a.out = out; a.ws = ws;
    const unsigned fast = FASTMASK; int li = 0;
    for (int p = 0; p < mk::PH_N;) {
        if (fast & (1u << p)) { int q = p; while (q < mk::PH_N && (fast & (1u << q))) ++q;
            a.ph_lo = p; a.ph_hi = q; a.li = li++; a.pad = 0;
            hipLaunchKernelGGL(mk::mega, dim3(grid), dim3(mk::NTHR), mk::LDS_BYTES, stream, a);
            p = q; continue; }
        switch (p) {
        case mk::PH_PRO:
            nv::k_mod<<<dim3(24, 4), 256, 0, stream>>>(c, w_mod, b_mod, MOD);
            nv::k_small<<<1024, 256, 0, stream>>>(lq1, lk1, lq2, lk2, lbl, SCAL, ROPEC, ROPES); break;
        case mk::PH_H1: nv::k_rowmod<<<T / 4, 256, 0, stream>>>(x, norm_pre_mix, MOD, H, 0, 1024); break;
        case mk::PH_G1: { nv::NG p_{}; p_.A = H; p_.lda = 1024; p_.M = T; p_.B = w_in; p_.ldb = NC; p_.K = 1024;
            nv::k_gemm<nv::EpiStoreBf16, 1><<<dim3(NC / 64, T / 64, 1), 256, 0, stream>>>(p_, nv::EpiStoreBf16{PROJ, (long long)NC}); } break;
        case mk::PH_ROPE_HGA: nv::k_hgA<<<dim3(128, 4, 4), 256, 65536, stream>>>(PROJ, SCAL, DS, DEC); break;
        case mk::PH_ATT_SCAN:
            nv::k_attn<<<dim3(128, 4, 4), 256, nv::AT_LDS, stream>>>(PROJ, ROPEC, ROPES, SCAL, subln, YA);
            nv::k_scan<<<1024, 256, 0, stream>>>(DS, DEC); break;
        case mk::PH_HGC: nv::k_hgC<<<dim3(128, 4, 4), 256, nv::HC_LDS, stream>>>(PROJ, SCAL, DS, hgnorm, YB); break;
        case mk::PH_G2A: { nv::NG p_{}; p_.A = YA; p_.lda = 512; p_.M = T; p_.B = wa; p_.ldb = 1024; p_.K = 512;
            nv::k_gemm<nv::EpiBranchA, 1><<<dim3(16, T / 64, 1), 256, 0, stream>>>(p_, nv::EpiBranchA{out, PROJ}); } break;
        case mk::PH_G2B: { nv::NG p_{}; p_.A = YB; p_.lda = 512; p_.M = T; p_.B = wb; p_.ldb = 1024; p_.K = 512;
            nv::k_gemm<nv::EpiBranchB, 1><<<dim3(16, T / 64, 1), 256, 0, stream>>>(p_, nv::EpiBranchB{out, PROJ, MERGED}); } break;
        case mk::PH_G3: { nv::NG p_{}; p_.A = MERGED; p_.lda = 1024; p_.M = T; p_.B = wo; p_.ldb = 1024; p_.K = 1024;
            nv::k_gemm<nv::EpiStoreF32, 1><<<dim3(16, T / 64, 1), 256, 0, stream>>>(p_, nv::EpiStoreF32{Y, 1024LL}); } break;
        case mk::PH_TOK:
            nv::k_x1<<<T / 4, 256, 0, stream>>>(x, Y, norm_post_mix, MOD, 2048LL, out);
            nv::k_rowmod<<<T / 4, 256, 0, stream>>>(out, norm_pre_ffn, MOD, H, 3072, 4096);
            nv::k_route<<<T / 4, 256, 0, stream>>>(out, norm_pre_ffn, MOD, rw, rb, TOPI, TOPW);
            nv::k_lists<<<T * 4 / 256, 256, 0, stream>>>(TOPI, CNT, LIST);
            nv::k_pads<<<1, 64, 0, stream>>>(CNT, PADS); break;
        case mk::PH_G4: { nv::NG p_{}; p_.A = H; p_.lda = 1024; p_.rowidx = LIST; p_.idxstride = 32768; p_.idxshift = 2; p_.cnt = CNT; p_.rowbase = PADS; p_.B = wgu; p_.strideB = (size_t)1024 * 2048; p_.ldb = 2048; p_.K = 1024; p_.b1off = 1024;
            nv::k_gemm<nv::EpiGateUp, 2><<<dim3(16, T / 64, 32), 256, 0, stream>>>(p_, nv::EpiGateUp{bgu, ACT}); } break;
        case mk::PH_G5: { nv::NG p_{}; p_.A = ACT; p_.lda = 1024; p_.cnt = CNT; p_.rowbase = PADS; p_.B = wd; p_.strideB = (size_t)1024 * 1024; p_.ldb = 1024; p_.K = 1024;
            nv::k_gemm<nv::EpiDown, 1><<<dim3(16, T / 64, 32), 256, 0, stream>>>(p_, nv::EpiDown{bd, LIST, YM}); } break;
        case mk::PH_FIN: nv::k_final<<<T / 4, 256, 0, stream>>>(out, YM, TOPW, norm_post_ffn, MOD); break;
        }
        ++p;
    }
}
```

```cpp
#include <hip/hip_runtime.h>
#include <hip/hip_bf16.h>
#include <stdint.h>
#include <cstdio>

typedef unsigned short bf16_t;
__device__ __forceinline__ float bf2f(bf16_t v) { return __uint_as_float(((unsigned)v) << 16); }
__device__ __forceinline__ bf16_t f2bf(float f) { unsigned u = __float_as_uint(f); return (bf16_t)((u + 0x7fffu + ((u >> 16) & 1u)) >> 16); }

constexpr int NB_ = 4, SEQ = 8192, T = NB_ * SEQ, D = 1024, NC = 5632, NE = 32;
constexpr size_t MiB = 1u << 20;
constexpr size_t WS_CTL = 0;
constexpr size_t WS_SMALL = 1 * MiB;
constexpr size_t WS_ROPEC = 2 * MiB, WS_ROPES = 3 * MiB;
constexpr size_t WS_TOPI = 4 * MiB, WS_TOPW = 4 * MiB + 512 * 1024;
constexpr size_t WS_LIST = 6 * MiB;
constexpr size_t WS_WIN = 16 * MiB, WS_WA = 28 * MiB, WS_WB = 29 * MiB, WS_WO = 30 * MiB, WS_WGU = 32 * MiB, WS_WD = 160 * MiB;
constexpr size_t WS_H = 224 * MiB;
constexpr size_t WS_PROJ = 288 * MiB;
constexpr size_t WS_YA = 640 * MiB, WS_YB = 672 * MiB;
constexpr size_t WS_DS = 704 * MiB, WS_DEC = 768 * MiB;
constexpr size_t WS_MERGED = 772 * MiB;
constexpr size_t WS_Y = 836 * MiB;
constexpr size_t WS_ACT = 288 * MiB;
constexpr size_t WS_YM = 560 * MiB;
constexpr size_t WS_END = 964 * MiB;
constexpr int CW_CNT = 1024;
constexpr int CW_BAR = 4096;

namespace nv {

__device__ __forceinline__ float wave_sum(float v) {
#pragma unroll
    for (int o = 1; o < 64; o <<= 1) v += __shfl_xor(v, o);
    return v;
}
__device__ __forceinline__ float sigm(float x) { return 1.f / (1.f + expf(-x)); }

__global__ void __launch_bounds__(256) k_mod(const float* c, const float* w_mod, const float* b_mod, float* mod) {
    const int j = blockIdx.x * 256 + threadIdx.x, b = blockIdx.y;
    float acc = 0.f;
    for (int k = 0; k < 1024; ++k) { const float cv = c[b * 1024 + k]; acc += (cv * sigm(cv)) * w_mod[(size_t)k * 6144 + j]; }
    mod[b * 6144 + j] = acc + b_mod[j];
}
__global__ void __launch_bounds__(256) k_small(const float* q1, const float* k1, const float* q2, const float* k2, const float* lbl,
                                               float* scal, float* ropec, float* ropes) {
    const int gid = blockIdx.x * 256 + threadIdx.x;
    if (gid == 0) { float s1 = 0.f, s2 = 0.f; for (int i = 0; i < 64; ++i) { s1 += q1[i] * k1[i]; s2 += q2[i] * k2[i]; } scal[0] = expf(s1) - expf(s2) + 0.2f; }
    if (gid < 512) { const float a = lbl[gid], b = lbl[512 + gid]; scal[64 + gid] = 1.f / (1.f + expf(b - a)); }
    if (gid < 8192 * 32) { const int s = gid >> 5, i = gid & 31; const float inv = powf(10000.f, -(float)(2 * i) / 64.f); const float ang = (float)s * inv; ropec[gid] = cosf(ang); ropes[gid] = sinf(ang); }
}
__global__ void __launch_bounds__(256) k_rowmod(const float* x, const float* w, const float* mod, bf16_t* out, int shoff, int scoff) {
    const int row = blockIdx.x * 4 + (threadIdx.x >> 6), lane = threadIdx.x & 63, b = row >> 13;
    const float* xr = x + (size_t)row * 1024; float v[16]; float ss = 0.f;
#pragma unroll
    for (int j = 0; j < 16; ++j) { v[j] = xr[lane + 64 * j]; ss += v[j] * v[j]; }
    ss = wave_sum(ss); const float rstd = rsqrtf(ss * (1.f / 1024.f) + 1e-6f);
#pragma unroll
    for (int j = 0; j < 16; ++j) { const int col = lane + 64 * j; const float h = v[j] * rstd * w[col] * (1.f + mod[b * 6144 + scoff + col]) + mod[b * 6144 + shoff + col]; out[(size_t)row * 1024 + col] = f2bf(h); }
}

struct NG {
    const bf16_t* A;
    const int* rowidx;
    const int* cnt;
    const int* rowbase;
    const float* B; size_t strideB;
    int lda, idxstride, idxshift, M  , ldb, K, b1off, pad;
};
template <class Epi, int NB>
__global__ void __launch_bounds__(256) k_gemm(NG p, Epi epi) {
    __shared__ float As[16][68];
    __shared__ float Bs[NB][16][64];
    const int z = blockIdx.z, Mz = p.cnt ? p.cnt[z] : p.M, m0 = blockIdx.y * 64, n0 = blockIdx.x * 64;
    if (m0 >= Mz) return;
    const int tid = threadIdx.x, tx = tid & 15, ty = tid >> 4;
    const float* B = p.B + (size_t)z * p.strideB;
    const int base = p.rowbase ? p.rowbase[z] : 0;
    const int lr = tid >> 2, lk = (tid & 3) * 4;
    int lrow = m0 + lr; if (lrow >= Mz) lrow = Mz - 1;
    const size_t arow = p.rowidx ? (size_t)(p.rowidx[(size_t)z * p.idxstride + lrow] >> p.idxshift) : (size_t)(base + lrow);
    const bf16_t* ap = p.A + arow * p.lda + lk;
    const int bk = tid >> 4, bc = (tid & 15) * 4;
    float acc[NB][4][4];
#pragma unroll
    for (int q = 0; q < NB; ++q)
#pragma unroll
        for (int i = 0; i < 4; ++i)
#pragma unroll
            for (int j = 0; j < 4; ++j) acc[q][i][j] = 0.f;
    for (int k0 = 0; k0 < p.K; k0 += 16) {
        const uint2 av = *(const uint2*)(ap + k0);
        As[lk + 0][lr] = __uint_as_float(av.x << 16); As[lk + 1][lr] = __uint_as_float(av.x & 0xffff0000u);
        As[lk + 2][lr] = __uint_as_float(av.y << 16); As[lk + 3][lr] = __uint_as_float(av.y & 0xffff0000u);
#pragma unroll
        for (int q = 0; q < NB; ++q) { const float4 bv = *(const float4*)(B + (size_t)(k0 + bk) * p.ldb + n0 + bc + q * p.b1off); *(float4*)&Bs[q][bk][bc] = bv; }
        __syncthreads();
#pragma unroll
        for (int k = 0; k < 16; ++k) {
            float a[4]; const float4 a4 = *(const float4*)&As[k][ty * 4]; a[0] = a4.x; a[1] = a4.y; a[2] = a4.z; a[3] = a4.w;
#pragma unroll
            for (int q = 0; q < NB; ++q) { const float4 b4 = *(const float4*)&Bs[q][k][tx * 4]; const float b[4] = {b4.x, b4.y, b4.z, b4.w};
#pragma unroll
                for (int i = 0; i < 4; ++i)
#pragma unroll
                    for (int j = 0; j < 4; ++j) acc[q][i][j] += a[i] * b[j]; }
        }
        __syncthreads();
    }
#pragma unroll
    for (int i = 0; i < 4; ++i) { const int lrw = m0 + ty * 4 + i; if (lrw < Mz) {
#pragma unroll
        for (int j = 0; j < 4; ++j) epi(z, lrw, base + lrw, n0 + tx * 4 + j, acc[0][i][j], NB == 2 ? acc[NB - 1][i][j] : 0.f); } }
}
struct EpiStoreBf16 { bf16_t* C; long long ldc; __device__ void operator()(int, int, int r, int c, float v, float) const { C[(size_t)r * ldc + c] = f2bf(v); } };
struct EpiStoreF32 { float* C; long long ldc; __device__ void operator()(int, int, int r, int c, float v, float) const { C[(size_t)r * ldc + c] = v; } };
struct EpiBranchA { float* tmp; const bf16_t* proj; __device__ void operator()(int, int, int r, int c, float v, float) const { tmp[(size_t)r * 1024 + c] = sigm(bf2f(proj[(size_t)r * 5632 + 3584 + c])) * v; } };
struct EpiBranchB { const float* tmp; const bf16_t* proj; bf16_t* merged; __device__ void operator()(int, int, int r, int c, float v, float) const {
    merged[(size_t)r * 1024 + c] = f2bf(tmp[(size_t)r * 1024 + c] + sigm(bf2f(proj[(size_t)r * 5632 + 4608 + c])) * v); } };
struct EpiGateUp { const float* bgu; bf16_t* act; __device__ void operator()(int e, int, int r, int c, float v0, float v1) const {
    float g = v0 + bgu[e * 2048 + c], u = v1 + bgu[e * 2048 + 1024 + c]; g = fminf(g, 7.f); u = fminf(fmaxf(u, -7.f), 7.f);
    const float glu = g * sigm(1.702f * g); act[(size_t)r * 1024 + c] = f2bf((u + 1.f) * glu); } };
struct EpiDown { const float* bd; const int* list; bf16_t* ym; __device__ void operator()(int e, int lr, int, int c, float v, float) const {
    const int a = list[(size_t)e * 32768 + lr]; ym[(size_t)a * 1024 + c] = f2bf(v + bd[e * 1024 + c]); } };

constexpr int AT_LD = 129;
constexpr int AT_LDS = (3 * 64 * AT_LD + 64 * 65) * 4;
__device__ __forceinline__ void at_load_rope(float* dst, const bf16_t* proj, int tok0, int colbase, const float* ropec, const float* ropes, int s0, int tid) {
    for (int i = 0; i < 16; ++i) { const int idx = tid + 256 * i, row = idx >> 6, rem = idx & 63, m = rem >> 5, d = rem & 31;
        const bf16_t* pr = proj + (size_t)(tok0 + row) * 5632 + colbase + m * 64;
        const float x1 = bf2f(pr[d]), x2 = bf2f(pr[32 + d]), c = ropec[(s0 + row) * 32 + d], s = ropes[(s0 + row) * 32 + d];
        dst[row * AT_LD + m * 64 + d] = x1 * c - x2 * s; dst[row * AT_LD + m * 64 + 32 + d] = x2 * c + x1 * s; }
}
__global__ void __launch_bounds__(256) k_attn(const bf16_t* proj, const float* ropec, const float* ropes, const float* scal, const float* subln, bf16_t* ya) {
    extern __shared__ float sm[];
    float* Qs = sm; float* Ks = Qs + 64 * AT_LD; float* Vs = Ks + 64 * AT_LD; float* As = Vs + 64 * AT_LD;
    const int qc = blockIdx.x, h = blockIdx.y, b = blockIdx.z, tid = threadIdx.x, r = tid >> 2, qd = tid & 3;
    const int tokq = b * 8192 + qc * 64; const float lam = scal[0];
    at_load_rope(Qs, proj, tokq, h * 128, ropec, ropes, qc * 64, tid);
    float m0 = -1e30f, l0 = 0.f, m1 = -1e30f, l1 = 0.f;
    for (int kc = 0; kc <= qc; ++kc) {
        __syncthreads();
        at_load_rope(Ks, proj, b * 8192 + kc * 64, 512 + h * 128, ropec, ropes, kc * 64, tid);
        __syncthreads();
        for (int i = 0; i < 16; ++i) { const int j = 4 * i + qd; float s0 = 0.f, s1 = 0.f;
            for (int d = 0; d < 64; ++d) { s0 += Qs[r * AT_LD + d] * Ks[j * AT_LD + d]; s1 += Qs[r * AT_LD + 64 + d] * Ks[j * AT_LD + 64 + d]; }
            s0 *= 0.125f; s1 *= 0.125f;
            float mn = fmaxf(m0, s0); l0 = l0 * expf(m0 - mn) + expf(s0 - mn); m0 = mn;
            mn = fmaxf(m1, s1); l1 = l1 * expf(m1 - mn) + expf(s1 - mn); m1 = mn; }
    }
#pragma unroll
    for (int o = 1; o < 4; o <<= 1) {
        float mo = __shfl_xor(m0, o), lo = __shfl_xor(l0, o); float mn = fmaxf(m0, mo); l0 = l0 * expf(m0 - mn) + lo * expf(mo - mn); m0 = mn;
        mo = __shfl_xor(m1, o); lo = __shfl_xor(l1, o); mn = fmaxf(m1, mo); l1 = l1 * expf(m1 - mn) + lo * expf(mo - mn); m1 = mn; }
    const float il0 = 1.f / l0, il1 = lam / l1;
    float o[32];
#pragma unroll
    for (int i = 0; i < 32; ++i) o[i] = 0.f;
    for (int kc = 0; kc <= qc; ++kc) {
        __syncthreads();
        at_load_rope(Ks, proj, b * 8192 + kc * 64, 512 + h * 128, ropec, ropes, kc * 64, tid);
        for (int i = 0; i < 32; ++i) { const int idx = tid + 256 * i, row = idx >> 7, col = idx & 127; Vs[row * AT_LD + col] = bf2f(proj[(size_t)(b * 8192 + kc * 64 + row) * 5632 + 1024 + h * 128 + col]); }
        __syncthreads();
        for (int i = 0; i < 16; ++i) { const int j = 4 * i + qd; float s0 = 0.f, s1 = 0.f;
            for (int d = 0; d < 64; ++d) { s0 += Qs[r * AT_LD + d] * Ks[j * AT_LD + d]; s1 += Qs[r * AT_LD + 64 + d] * Ks[j * AT_LD + 64 + d]; }
            s0 *= 0.125f; s1 *= 0.125f;
            As[r * 65 + j] = expf(s0 - m0) * il0 - expf(s1 - m1) * il1; }
        __syncthreads();
        for (int j = 0; j < 64; ++j) { const float av = As[r * 65 + j];
#pragma unroll
            for (int dv = 0; dv < 32; ++dv) o[dv] += av * Vs[j * AT_LD + 32 * qd + dv]; }
    }
    float ss = 0.f;
#pragma unroll
    for (int i = 0; i < 32; ++i) ss += o[i] * o[i];
    ss += __shfl_xor(ss, 1); ss += __shfl_xor(ss, 2);
    const float rstd = rsqrtf(ss * (1.f / 128.f) + 1e-6f);
#pragma unroll
    for (int i = 0; i < 32; ++i) { const int dv = 32 * qd + i; ya[(size_t)(tokq + r) * 512 + h * 128 + dv] = f2bf(o[i] * rstd * subln[dv] * 0.8f); }
}

__global__ void __launch_bounds__(256) k_hgA(const bf16_t* proj, const float* scal, bf16_t* ds, float* dec) {
    extern __shared__ float sm[];
    float* G = sm; float* V = sm + 64 * 128;
    const int n = blockIdx.x, h = blockIdx.y, b = blockIdx.z, tid = threadIdx.x, tok0 = b * 8192 + n * 64, bh = b * 4 + h;
    for (int i = 0; i < 32; ++i) { const int idx = tid + 256 * i, c = idx >> 7, d = idx & 127; const bf16_t* pr = proj + (size_t)(tok0 + c) * 5632 + h * 128 + d;
        const float lb = scal[64 + h * 128 + d]; const float f = lb + (1.f - lb) * sigm(bf2f(pr[2048])); G[c * 128 + d] = f; V[c * 128 + d] = bf2f(pr[2560]); }
    __syncthreads();
    float kk[64]; float glast = 0.f; const int d = tid & 127, vb = (tid >> 7) * 64;
    {
        float g = 0.f;
#pragma unroll
        for (int c = 0; c < 64; ++c) { const float f = G[c * 128 + d]; g += logf(f); kk[c] = g; }
        glast = g;
#pragma unroll
        for (int c = 0; c < 64; ++c) { const float f = G[c * 128 + d]; kk[c] = (1.f - f) * expf(glast - kk[c]); }
    }
    if (tid < 128) dec[(size_t)(bh * 128 + n) * 128 + d] = expf(glast);
    for (int v0 = 0; v0 < 64; v0 += 16) {
        float acc[16];
#pragma unroll
        for (int i = 0; i < 16; ++i) acc[i] = 0.f;
#pragma unroll
        for (int c = 0; c < 64; ++c) {
#pragma unroll
            for (int i = 0; i < 16; ++i) acc[i] += kk[c] * V[c * 128 + vb + v0 + i]; }
#pragma unroll
        for (int i = 0; i < 16; ++i) ds[((size_t)(bh * 128 + n) * 128 + d) * 128 + vb + v0 + i] = f2bf(acc[i]);
    }
}
__global__ void __launch_bounds__(256) k_scan(bf16_t* ds, const float* dec) {
    const int gid = blockIdx.x * 256 + threadIdx.x; const int bh = gid >> 14, d = (gid >> 7) & 127, v = gid & 127;
    float st = 0.f;
    for (int n = 0; n < 128; ++n) { const size_t o = ((size_t)(bh * 128 + n) * 128 + d) * 128 + v; const float x = bf2f(ds[o]); ds[o] = f2bf(st); st = dec[(size_t)(bh * 128 + n) * 128 + d] * st + x; }
}
constexpr int HC_LDS = (2 * 64 * 129 + 64 * 128 + 64 * 65) * 4;
__global__ void __launch_bounds__(256) k_hgC(const bf16_t* proj, const float* scal, const bf16_t* sp, const float* hgnorm, bf16_t* yb) {
    extern __shared__ float sm[];
    float* QT = sm; float* KT = QT + 64 * 129; float* V = KT + 64 * 129; float* As = V + 64 * 128;
    const int n = blockIdx.x, h = blockIdx.y, b = blockIdx.z, tid = threadIdx.x, tok0 = b * 8192 + n * 64, bh = b * 4 + h;
    for (int i = 0; i < 32; ++i) { const int idx = tid + 256 * i, c = idx >> 7, d = idx & 127; const bf16_t* pr = proj + (size_t)(tok0 + c) * 5632 + h * 128 + d;
        const float lb = scal[64 + h * 128 + d]; const float f = lb + (1.f - lb) * sigm(bf2f(pr[2048])); const float q = bf2f(pr[1536]);
        QT[c * 129 + d] = q * sigm(q); KT[c * 129 + d] = f; V[c * 128 + d] = bf2f(pr[2560]); }
    __syncthreads();
    if (tid < 128) { float g = 0.f; for (int c = 0; c < 64; ++c) { const float f = KT[c * 129 + tid]; g += logf(f); QT[c * 129 + tid] *= expf(g); KT[c * 129 + tid] = (1.f - f) * expf(-g); } }
    __syncthreads();
    const int c = tid >> 2, q4 = tid & 3;
    for (int i = 0; i < 16; ++i) { const int s = 4 * i + q4; float a = 0.f;
        if (s <= c) { for (int d = 0; d < 128; ++d) a += QT[c * 129 + d] * KT[s * 129 + d]; }
        As[c * 65 + s] = a; }
    __syncthreads();
    float o[32];
#pragma unroll
    for (int i = 0; i < 32; ++i) o[i] = 0.f;
    for (int s = 0; s < 64; ++s) { const float a = As[c * 65 + s];
#pragma unroll
        for (int i = 0; i < 32; ++i) o[i] += a * V[s * 128 + 32 * q4 + i]; }
    const bf16_t* spb = sp + (size_t)(bh * 128 + n) * 128 * 128;
    for (int d = 0; d < 128; ++d) { const float qv = QT[c * 129 + d];
#pragma unroll
        for (int i = 0; i < 32; ++i) o[i] += qv * bf2f(spb[d * 128 + 32 * q4 + i]); }
    float ss = 0.f;
#pragma unroll
    for (int i = 0; i < 32; ++i) ss += o[i] * o[i];
    ss += __shfl_xor(ss, 1); ss += __shfl_xor(ss, 2);
    const float rstd = rsqrtf(ss * (1.f / 128.f) + 1e-6f);
#pragma unroll
    for (int i = 0; i < 32; ++i) { const int v = 32 * q4 + i; const float g = bf2f(proj[(size_t)(tok0 + c) * 5632 + 3072 + h * 128 + v]);
        yb[(size_t)(tok0 + c) * 512 + h * 128 + v] = f2bf(o[i] * rstd * hgnorm[v] * (g * sigm(g))); }
}
__global__ void __launch_bounds__(256) k_x1(const float* x, const float* y, const float* w, const float* mod, long long goff, float* x1) {
    const int row = blockIdx.x * 4 + (threadIdx.x >> 6), lane = threadIdx.x & 63, b = row >> 13;
    const float* yr = y + (size_t)row * 1024; float v[16]; float ss = 0.f;
#pragma unroll
    for (int j = 0; j < 16; ++j) { v[j] = yr[lane + 64 * j]; ss += v[j] * v[j]; }
    ss = wave_sum(ss); const float rstd = rsqrtf(ss * (1.f / 1024.f) + 1e-6f);
#pragma unroll
    for (int j = 0; j < 16; ++j) { const int col = lane + 64 * j; x1[(size_t)row * 1024 + col] = x[(size_t)row * 1024 + col] + mod[b * 6144 + goff + col] * v[j] * rstd * w[col]; }
}
__global__ void __launch_bounds__(256) k_route(const float* x1, const float* w, const float* mod, const float* rw, const float* rb, int* topi, float* topw) {
    const int row = blockIdx.x * 4 + (threadIdx.x >> 6), lane = threadIdx.x & 63, b = row >> 13;
    const float* xr = x1 + (size_t)row * 1024; float v[16]; float ss = 0.f;
#pragma unroll
    for (int j = 0; j < 16; ++j) { v[j] = xr[lane + 64 * j]; ss += v[j] * v[j]; }
    ss = wave_sum(ss); const float rstd = rsqrtf(ss * (1.f / 1024.f) + 1e-6f);
    float lg[32];
#pragma unroll
    for (int e = 0; e < 32; ++e) lg[e] = 0.f;
#pragma unroll
    for (int j = 0; j < 16; ++j) { const int col = lane + 64 * j; const float h = v[j] * rstd * w[col] * (1.f + mod[b * 6144 + 4096 + col]) + mod[b * 6144 + 3072 + col];
#pragma unroll
        for (int e = 0; e < 32; ++e) lg[e] += h * rw[col * 32 + e]; }
#pragma unroll
    for (int e = 0; e < 32; ++e) lg[e] = wave_sum(lg[e]) + rb[e];
    int bi[4]; float bv[4];
#pragma unroll
    for (int k = 0; k < 4; ++k) { float best = -3.0e38f; int be = 0;
#pragma unroll
        for (int e = 0; e < 32; ++e) { bool taken = false;
#pragma unroll
            for (int q = 0; q < 4; ++q) if (q < k && bi[q] == e) taken = true;
            if (!taken && lg[e] > best) { best = lg[e]; be = e; } }
        bi[k] = be; bv[k] = best; }
    const float e1 = expf(bv[1] - bv[0]), e2 = expf(bv[2] - bv[0]), e3 = expf(bv[3] - bv[0]); const float inv = 1.f / (1.f + e1 + e2 + e3);
    if (lane == 0) { topi[row * 4 + 0] = bi[0]; topi[row * 4 + 1] = bi[1]; topi[row * 4 + 2] = bi[2]; topi[row * 4 + 3] = bi[3];
        topw[row * 4 + 0] = inv; topw[row * 4 + 1] = e1 * inv; topw[row * 4 + 2] = e2 * inv; topw[row * 4 + 3] = e3 * inv; }
}
__global__ void __launch_bounds__(256) k_lists(const int* topi, int* cnt, int* list) {
    const int a = blockIdx.x * 256 + threadIdx.x; const int e = topi[a]; const int pos = atomicAdd(&cnt[e], 1); list[(size_t)e * 32768 + pos] = a;
}
__global__ void k_pads(const int* cnt, int* pads) { if (threadIdx.x == 0) { int s = 0; for (int e = 0; e < 32; ++e) { pads[e] = s; s += ((cnt[e] + 255) / 256) * 256; } } }
__global__ void __launch_bounds__(256) k_final(float* out, const bf16_t* ym, const float* topw, const float* w, const float* mod) {
    const int row = blockIdx.x * 4 + (threadIdx.x >> 6), lane = threadIdx.x & 63, b = row >> 13;
    float v[16]; float ss = 0.f; const float w0 = topw[row * 4], w1 = topw[row * 4 + 1], w2 = topw[row * 4 + 2], w3 = topw[row * 4 + 3];
    const bf16_t* y0 = ym + (size_t)row * 4096;
#pragma unroll
    for (int j = 0; j < 16; ++j) { const int col = lane + 64 * j; v[j] = w0 * bf2f(y0[col]) + w1 * bf2f(y0[1024 + col]) + w2 * bf2f(y0[2048 + col]) + w3 * bf2f(y0[3072 + col]); ss += v[j] * v[j]; }
    ss = wave_sum(ss); const float rstd = rsqrtf(ss * (1.f / 1024.f) + 1e-6f);
#pragma unroll
    for (int j = 0; j < 16; ++j) { const int col = lane + 64 * j; out[(size_t)row * 1024 + col] += mod[b * 6144 + 5120 + col] * v[j] * rstd * w[col]; }
}
}
#define GAS __attribute__((address_space(1)))
#define LAS __attribute__((address_space(3)))
typedef GAS unsigned gu32;
#define RLX_AGENT __ATOMIC_RELAXED, __HIP_MEMORY_SCOPE_AGENT
#define XB_TMO      128
#define XB_XCNT(j)  (256  + 64 * (j))
#define XB_XSUB(j)  (1280 + 64 * (j))
#define XB_XGEN(j)  (2304 + 64 * (j))
#define XB_TOP      3328
#define XB_TOPGEN   3392
#define XCD_BAR_WORDS 3456
#define XB_SPIN_CAP (1u << 22)

__device__ __forceinline__ unsigned xb_ld(unsigned* p)              { return __hip_atomic_load(p, __ATOMIC_RELAXED, __HIP_MEMORY_SCOPE_AGENT); }
__device__ __forceinline__ unsigned xb_add(unsigned* p, unsigned v) { return __hip_atomic_fetch_add(p, v, __ATOMIC_RELAXED, __HIP_MEMORY_SCOPE_AGENT); }
__device__ __forceinline__ unsigned xb_xcc_id() { return (unsigned)__builtin_amdgcn_s_getreg((3 << 11) | 20) & 0xFu; }
#define XB_SPIN(cond, bar) do { unsigned _sp = 0; while (cond) { __builtin_amdgcn_s_sleep(1); \
    if ((++_sp & 255u) == 0u) { if (xb_ld(&(bar)[XB_TMO])) break; if (_sp > XB_SPIN_CAP) { atomicAdd(&(bar)[XB_TMO], 1u); break; } } } } while (0)

struct XcdBarrier {
    unsigned* bar; unsigned x;
    volatile LAS unsigned* st;
};
__device__ __forceinline__ XcdBarrier xcd_barrier_post(unsigned* bar, volatile LAS unsigned* st) {
    XcdBarrier b; b.bar = bar; b.x = xb_xcc_id(); b.st = st;
    if (threadIdx.x == 0) (void)xb_add(&bar[XB_XCNT(b.x)], 1u);
    return b;
}
__device__ __forceinline__ void xcd_barrier_complete(unsigned* bar, unsigned x, unsigned& nloc, unsigned& nx) {
    const unsigned G = gridDim.x * gridDim.y * gridDim.z;
    unsigned sum, cnt, mine, sp = 0u;
    for (;;) {
        sum = 0u; cnt = 0u; mine = 0u;
#pragma unroll
        for (unsigned j = 0; j < 16; ++j) { const unsigned c = xb_ld(&bar[XB_XCNT(j)]); sum += c; cnt += (c > 0u) ? 1u : 0u; mine = (j == x) ? c : mine; }
        if (sum == G) break;
        __builtin_amdgcn_s_sleep(1);
        if ((++sp & 255u) == 0u) { if (xb_ld(&bar[XB_TMO])) break; if (sp > XB_SPIN_CAP) { atomicAdd(&bar[XB_TMO], 1u); break; } }
    }
    nloc = mine > 0u ? mine : 1u; nx = cnt > 0u ? cnt : 1u;
}
__device__ __forceinline__ void xcd_barrier(const XcdBarrier& b) {
    asm volatile("s_waitcnt vmcnt(0)" ::: "memory");
    __syncthreads();
    if (threadIdx.x == 0) {
        unsigned* bar = b.bar;
        __builtin_amdgcn_s_waitcnt(0);
        unsigned nloc = b.st[0], nx = b.st[1];
        if (nloc == 0u) { xcd_barrier_complete(bar, b.x, nloc, nx); b.st[0] = nloc; b.st[1] = nx; }
        const unsigned old = xb_add(&bar[XB_XSUB(b.x)], 1u);
        const unsigned gen = old / nloc;
        if (old + 1u == (gen + 1u) * nloc) {
            __builtin_amdgcn_fence(__ATOMIC_RELEASE, "agent");
            asm volatile("s_waitcnt vmcnt(0)" ::: "memory");
            const unsigned og = xb_add(&bar[XB_TOP], 1u);
            const unsigned tg = og / nx;
            if (og + 1u == (tg + 1u) * nx) xb_add(&bar[XB_TOPGEN], 1u);
            else XB_SPIN(xb_ld(&bar[XB_TOPGEN]) == tg, bar);
            __builtin_amdgcn_fence(__ATOMIC_ACQUIRE, "agent");
            xb_add(&bar[XB_XGEN(b.x)], 1u);
            asm volatile("s_waitcnt vmcnt(0)" ::: "memory");
        } else {
            XB_SPIN(xb_ld(&bar[XB_XGEN(b.x)]) == gen, bar);
            __builtin_amdgcn_fence(__ATOMIC_ACQUIRE, "agent");
            asm volatile("s_waitcnt vmcnt(0)" ::: "memory");
        }
    }
    __syncthreads();
}
namespace pg8 {
#define PG8_LAS __attribute__((address_space(3)))
typedef short bf16x8 __attribute__((ext_vector_type(8)));
typedef float f32x4 __attribute__((ext_vector_type(4)));
typedef float f32x2 __attribute__((ext_vector_type(2)));
typedef unsigned u32x4 __attribute__((ext_vector_type(4)));
typedef unsigned u32x2 __attribute__((ext_vector_type(2)));
constexpr int BM = 256, BK = 64, HALF = 128, HTB = HALF * BK * 2  , STAGE_BYTES = 8 * HTB, NXCD = 8, WGM = 8;

__host__ __device__ __forceinline__ int lds_byte(int r, int c) { const int st = (r >> 4) * 2 + (c >> 5), rr = r & 15, cc = c & 31, ob = rr * 64 + cc * 2; return st * 1024 + (ob ^ (((ob >> 9) & 1) << 5)); }
__host__ __device__ __forceinline__ void stage_rc(int b, int& R, int& C) { const int st = b / 1024, sb = b % 1024, swz = sb ^ (((sb >> 9) & 1) << 5); R = (st >> 1) * 16 + swz / 64; C = (st & 1) * 32 + (swz % 64) / 2; }
__host__ __device__ __forceinline__ int perm32(int rho) { const int n = rho >> 4, i = rho & 15; return 8 * (i >> 2) + 4 * n + (i & 3); }

struct Unit { int pm, pn, z, arow, brow; };
struct Gemm { const bf16_t* A; const bf16_t* Bt; int K; };

struct DenseOrder {
    int nM, nN, nwg, G, c;
    __device__ void init(int M, int N, int G_, int c_) { nM = M / BM; nN = N / BM; nwg = nM * nN; G = G_; c = c_; }
    __device__ bool next(int i, Unit& u) const {
        const long L = (long)i * G + c; if (L >= nwg) return false;
        int wgid = (int)L; { const int q = nwg / NXCD, r = nwg % NXCD, xcd = wgid % NXCD, off = wgid / NXCD; wgid = (xcd < r ? xcd * (q + 1) : r * (q + 1) + (xcd - r) * q) + off; }
        const int nig = WGM * nN, gid = wgid / nig, fm = gid * WGM, gsz = (nM - fm) < WGM ? (nM - fm) : WGM;
        u.pm = fm + ((wgid % nig) % gsz); u.pn = (wgid % nig) / gsz; u.z = 0; u.arow = u.pm * BM; u.brow = u.pn * BM; return true;
    }
    __device__ __forceinline__ unsigned row_off(const Unit&, int) const { return 0u; }
};

__device__ __forceinline__ unsigned cvt_pk_bf16(float lo, float hi) { unsigned r; asm volatile("v_cvt_pk_bf16_f32 %0, %1, %2" : "=v"(r) : "v"(lo), "v"(hi)); return r; }


template <class Epi, class Sched, bool GATHER>
__device__ __forceinline__ void gemm_phase(PG8_LAS unsigned char* lds, const Gemm g, const Sched& S, const Epi& E) {
    int tid_ = threadIdx.x; asm volatile("" : "+v"(tid_));
    const int tid = tid_, wid = __builtin_amdgcn_readfirstlane(tid >> 6), lane = tid & 63, wr = wid >> 2, wc = wid & 3, fr = lane & 15, fq = lane >> 4;
    const int K = g.K, nt = K / BK;
    unsigned voffA[2], voffB[2]; int RA[2];
#pragma unroll
    for (int i = 0; i < 2; ++i) { int R, C; stage_rc(tid * 16 + i * 8192, R, C); const int Rb = Epi::PERM ? ((R & ~31) + perm32(R & 31)) : R;
        RA[i] = R; voffA[i] = GATHER ? (unsigned)(C * 2) : (unsigned)(R * K + C) * 2u; voffB[i] = (unsigned)(Rb * K + C) * 2u; }
    const size_t kstep = (size_t)(BK * 2);
    const size_t hstep = (size_t)HALF * K * 2;
    const unsigned ldsw = (unsigned)wid * 1024u;
    const int aoff = lds_byte(wr * 64 + fr, fq * 8), boff = lds_byte(wc * 32 + fr, fq * 8);
    unsigned gAc[2][2], gAn[2][2];
#define PG8_SA(b, h) (((b) * 2 + (h)) * HTB)
#define PG8_SB(b, h) ((4 + (b) * 2 + (h)) * HTB)
#define PG8_STAGE(bufoff, gbase, voff) do { _Pragma("unroll") for (int _i = 0; _i < 2; ++_i) \
        __builtin_amdgcn_global_load_lds((const unsigned*)((const char*)(gbase) + (voff)[_i]), (PG8_LAS unsigned*)(lds + (bufoff) + ldsw + _i * 8192), 16, 0, 0); } while (0)
#define PG8_STAGEA(bufoff, gbase, h, nx) do { if constexpr (GATHER) { _Pragma("unroll") for (int _i = 0; _i < 2; ++_i) { const unsigned _v = ((nx) ? gAn[h][_i] : gAc[h][_i]) + voffA[_i]; \
        __builtin_amdgcn_global_load_lds((const unsigned*)((const char*)(gbase) + _v), (PG8_LAS unsigned*)(lds + (bufoff) + ldsw + _i * 8192), 16, 0, 0); } } \
        else { PG8_STAGE(bufoff, (const char*)(gbase) + (h) * hstep, voffA); } } while (0)
#define PG8_LDA(dst, b, h) do { _Pragma("unroll") for (int m = 0; m < 4; ++m) _Pragma("unroll") for (int k = 0; k < 2; ++k) dst[m][k] = *(const PG8_LAS bf16x8*)(lds + PG8_SA(b, h) + aoff + m * 2048 + k * 1024); } while (0)
#define PG8_LDB(dst, b, h) do { _Pragma("unroll") for (int n = 0; n < 2; ++n) _Pragma("unroll") for (int k = 0; k < 2; ++k) dst[n][k] = *(const PG8_LAS bf16x8*)(lds + PG8_SB(b, h) + boff + n * 2048 + k * 1024); } while (0)
#define PG8_MMA(ai, bj, At, Bt) do { __builtin_amdgcn_s_setprio(1); _Pragma("unroll") for (int m = 0; m < 4; ++m) _Pragma("unroll") for (int n = 0; n < 2; ++n) _Pragma("unroll") for (int k = 0; k < 2; ++k) \
        acc[ai][bj][m][n] = __builtin_amdgcn_mfma_f32_16x16x32_bf16(Bt[n][k], At[m][k], acc[ai][bj][m][n], 0, 0, 0); __builtin_amdgcn_s_setprio(0); } while (0)
#define PG8_WAIT_V(n) asm volatile("s_waitcnt vmcnt(" #n ")" ::: "memory")
#define PG8_WAIT_L(n) asm volatile("s_waitcnt lgkmcnt(" #n ")" ::: "memory")
#define PG8_BAR __builtin_amdgcn_s_barrier()
#define PG8_SCHED __builtin_amdgcn_sched_barrier(0)
    Unit cur, nxt; int ui = 0;
    if (!S.next(0, cur)) return;
    f32x4 acc[2][2][4][2];
#pragma unroll
    for (int a = 0; a < 2; ++a)
#pragma unroll
        for (int b = 0; b < 2; ++b)
#pragma unroll
            for (int m = 0; m < 4; ++m)
#pragma unroll
                for (int n = 0; n < 2; ++n) acc[a][b][m][n] = (f32x4){0.f, 0.f, 0.f, 0.f};
    bf16x8 At[4][2], B0[2][2], B1[2][2];
    const char* cA = GATHER ? (const char*)g.A : (const char*)g.A + (size_t)cur.arow * K * 2; const char* cB = (const char*)g.Bt + (size_t)cur.brow * K * 2;
    if constexpr (GATHER) {
#pragma unroll
        for (int h = 0; h < 2; ++h)
#pragma unroll
            for (int i = 0; i < 2; ++i) { gAc[h][i] = S.row_off(cur, h * HALF + RA[i]); gAn[h][i] = gAc[h][i]; }
    }
    PG8_STAGE(PG8_SB(0, 0), cB, voffB); PG8_STAGE(PG8_SB(0, 1), cB + hstep, voffB); PG8_STAGEA(PG8_SA(0, 0), cA, 0, false); PG8_STAGEA(PG8_SA(0, 1), cA, 1, false);
    if (wr == 1) PG8_BAR;
    PG8_WAIT_V(2); PG8_BAR;
    PG8_STAGE(PG8_SB(1, 0), cB + kstep, voffB); PG8_STAGEA(PG8_SA(1, 0), cA + kstep, 0, false); PG8_STAGE(PG8_SB(1, 1), cB + hstep + kstep, voffB);
    PG8_WAIT_V(6); PG8_BAR;
    for (;;) {
        const bool has_next = S.next(ui + 1, nxt);
        const char* nA = has_next ? (GATHER ? (const char*)g.A : (const char*)g.A + (size_t)nxt.arow * K * 2) : cA; const char* nB = has_next ? (const char*)g.Bt + (size_t)nxt.brow * K * 2 : cB;
        if constexpr (GATHER) { if (has_next) {
#pragma unroll
            for (int h = 0; h < 2; ++h)
#pragma unroll
                for (int i = 0; i < 2; ++i) gAn[h][i] = S.row_off(nxt, h * HALF + RA[i]); } }
        for (int t = 0; t < nt; t += 2) {
            const bool last = (t == nt - 2);
            const char* a1 = cA + (size_t)(t + 1) * kstep;
            const char* a2 = last ? nA : cA + (size_t)(t + 2) * kstep; const char* b2 = last ? nB : cB + (size_t)(t + 2) * kstep;
            const char* a3 = a2 + kstep; const char* b3 = b2 + kstep;
            PG8_LDB(B0, 0, 0); PG8_LDB(B1, 0, 1); PG8_SCHED; PG8_LDA(At, 0, 0); PG8_STAGEA(PG8_SA(1, 1), a1, 1, false);
            PG8_WAIT_V(8); PG8_WAIT_L(0); PG8_BAR; PG8_MMA(0, 0, At, B0); PG8_MMA(0, 1, At, B1); PG8_BAR; PG8_SCHED;
            PG8_LDA(At, 0, 1); PG8_STAGE(PG8_SB(0, 0), b2, voffB); PG8_STAGE(PG8_SB(0, 1), b2 + hstep, voffB); PG8_STAGEA(PG8_SA(0, 0), a2, 0, last);
            PG8_WAIT_V(8); PG8_WAIT_L(0); PG8_BAR; PG8_MMA(1, 0, At, B0); PG8_MMA(1, 1, At, B1); PG8_BAR; PG8_SCHED;
            PG8_LDB(B0, 1, 0); PG8_LDB(B1, 1, 1); PG8_SCHED; PG8_LDA(At, 1, 0); PG8_STAGEA(PG8_SA(0, 1), a2, 1, last);
            PG8_WAIT_V(8); PG8_WAIT_L(0); PG8_BAR; PG8_MMA(0, 0, At, B0); PG8_MMA(0, 1, At, B1); PG8_BAR; PG8_SCHED;
            PG8_LDA(At, 1, 1); PG8_STAGE(PG8_SB(1, 0), b3, voffB); PG8_STAGE(PG8_SB(1, 1), b3 + hstep, voffB); PG8_STAGEA(PG8_SA(1, 0), a3, 0, last);
            PG8_WAIT_V(8); PG8_WAIT_L(0); PG8_BAR; PG8_MMA(1, 0, At, B0); PG8_MMA(1, 1, At, B1); PG8_BAR; PG8_SCHED;
        }
        if (wr == 0) PG8_BAR;
        E(acc, cur, wr, wc, fr, fq);
        if (!has_next) break;
#pragma unroll
        for (int a = 0; a < 2; ++a)
#pragma unroll
            for (int b = 0; b < 2; ++b)
#pragma unroll
                for (int m = 0; m < 4; ++m)
#pragma unroll
                    for (int n = 0; n < 2; ++n) acc[a][b][m][n] = (f32x4){0.f, 0.f, 0.f, 0.f};
        cur = nxt; cA = nA; cB = nB; ++ui;
        if constexpr (GATHER) {
#pragma unroll
            for (int h = 0; h < 2; ++h)
#pragma unroll
                for (int i = 0; i < 2; ++i) gAc[h][i] = gAn[h][i];
        }
        if (wr == 1) PG8_BAR;
    }
    PG8_WAIT_V(0);
    PG8_BAR;
#undef PG8_SA
#undef PG8_SB
#undef PG8_STAGE
#undef PG8_STAGEA
#undef PG8_LDA
#undef PG8_LDB
#undef PG8_MMA
#undef PG8_WAIT_V
#undef PG8_WAIT_L
#undef PG8_BAR
#undef PG8_SCHED
}
}
namespace at {
typedef short bf16x8 __attribute__((ext_vector_type(8)));
typedef short s16x4 __attribute__((ext_vector_type(4)));
typedef float f32x16 __attribute__((ext_vector_type(16)));
typedef unsigned u32x4 __attribute__((ext_vector_type(4)));
typedef __attribute__((address_space(3))) const char* lds_cptr;
typedef short v4i16_t __attribute__((ext_vector_type(4)));
constexpr int SLOT = 32768, L_WSF = 3 * SLOT;
constexpr float C2 = 0.125f * 1.4426950408889634f;
__device__ __forceinline__ int crow(int r, int hi) { return (r & 3) + 8 * (r >> 2) + 4 * hi; }
__device__ __forceinline__ void glds16(const void* gsrc, unsigned lds_dst) { unsigned keep;
    asm volatile("s_mov_b32 %0, m0\n\ts_mov_b32 m0, %2\n\ts_nop 0\n\tglobal_load_lds_dwordx4 %1, off\n\ts_mov_b32 m0, %0" : "=&s"(keep) : "v"(gsrc), "s"(lds_dst) : "memory"); }
typedef float f32x2_t __attribute__((ext_vector_type(2))); typedef __bf16 bf16x2_t __attribute__((ext_vector_type(2)));
__device__ __forceinline__ unsigned cvtpk(float lo, float hi) { f32x2_t v = {lo, hi}; bf16x2_t b = __builtin_convertvector(v, bf16x2_t); return __builtin_bit_cast(unsigned, b); }
__device__ __forceinline__ s16x4 vtr(lds_cptr p) { return __builtin_bit_cast(s16x4, __builtin_amdgcn_ds_read_tr16_b64_v4i16((__attribute__((address_space(3))) v4i16_t*)p)); }
#define AT_WAIT_BAR(N) asm volatile("s_waitcnt vmcnt(" #N ") lgkmcnt(0)\n\ts_barrier" ::: "memory")

__device__ __forceinline__ void attn_unit(__attribute__((address_space(3))) unsigned char* lds, const bf16_t* QKR, const bf16_t* PROJ, bf16_t* YA, const float* subln, float lam,
                                          int b, int h, int blk, int tid) {
    typedef __attribute__((address_space(3))) float lds_f;
    const int lane = tid & 63, r32 = lane & 31, hi = lane >> 5; const int w = __builtin_amdgcn_readfirstlane(tid >> 6), m = w & 1, rg = w >> 1;
    const int NT = 2 * blk + 2, my_nt = (rg < 2) ? NT - 1 : NT;
    const size_t tokb = (size_t)b * 8192;
    const unsigned lds0 = (unsigned)(size_t)lds;
    const bf16_t* ksrc0 = QKR + (tokb + lane) * 1024 + 512 + h * 128 + (2 * w) * 8;
    const bf16_t* vsrc0 = PROJ + (tokb + ((2 * w) & 3) * 16 + (lane >> 2)) * 5632 + 1024 + h * 128 + (w >> 1) * 32 + (lane & 3) * 8;
#define AT_DMA(t, slotoff) do { const bf16_t* ks_ = ksrc0 + (size_t)(t) * 64 * 1024; const bf16_t* vs_ = vsrc0 + (size_t)(t) * 64 * 5632; \
        const unsigned kd_ = (unsigned)__builtin_amdgcn_readfirstlane(lds0 + (unsigned)(slotoff) + (unsigned)w * 2048u); \
        glds16(ks_, kd_); glds16(ks_ + 8, kd_ + 1024u); glds16(vs_, kd_ + 16384u); glds16(vs_ + 16 * 5632, kd_ + 16384u + 1024u); } while (0)
    AT_DMA(0, 0); AT_DMA(1, SLOT);
    bf16x8 qr[4];
    { const bf16_t* qp = QKR + (tokb + blk * 128 + rg * 32 + r32) * 1024 + h * 128 + m * 64 + hi * 8;
#pragma unroll
      for (int d0 = 0; d0 < 4; ++d0) qr[d0] = *(const bf16x8*)(qp + d0 * 16); }
    f32x16 o[4];
#pragma unroll
    for (int i = 0; i < 4; ++i) o[i] = f32x16{};
    float m_run = -1e30f, lsum = 0.f;
    lds_f* wsf = (lds_f*)(lds + L_WSF) + w * 32;
    int slot = 0, slot2 = 2 * SLOT;
    for (int t = 0; t < NT; ++t) {
        if (t + 1 < NT) { AT_WAIT_BAR(4); } else { AT_WAIT_BAR(0); }
        if (t + 2 < NT) AT_DMA(t + 2, slot2);
        if (t < my_nt) {
            const lds_cptr kp = (lds_cptr)(lds + slot) + (m * 8 + hi) * 1024 + r32 * 16;
            f32x16 p0 = f32x16{}, p1 = f32x16{};
#pragma unroll
            for (int d0 = 0; d0 < 4; ++d0) { const bf16x8 k0 = *(const __attribute__((address_space(3))) bf16x8*)(kp + d0 * 2048), k1 = *(const __attribute__((address_space(3))) bf16x8*)(kp + d0 * 2048 + 512);
                p0 = __builtin_amdgcn_mfma_f32_32x32x16_bf16(k0, qr[d0], p0, 0, 0, 0); p1 = __builtin_amdgcn_mfma_f32_32x32x16_bf16(k1, qr[d0], p1, 0, 0, 0); }
            float rm = fmaxf(p0[0], p1[0]);
#pragma unroll
            for (int r = 1; r < 16; ++r) rm = fmaxf(rm, fmaxf(p0[r], p1[r]));
            { auto rr = __builtin_amdgcn_permlane32_swap(__float_as_uint(rm), __float_as_uint(rm), false, false); rm = fmaxf(__uint_as_float(rr[0]), __uint_as_float(rr[1])); }
            if (__any(rm > m_run + 8.f)) {
                const float mn = fmaxf(m_run, rm); const float f = __builtin_amdgcn_exp2f(m_run - mn); lsum *= f; m_run = mn;
                if (hi == 0) wsf[r32] = f;
                asm volatile("s_waitcnt lgkmcnt(0)" ::: "memory");
#pragma unroll
                for (int r = 0; r < 16; ++r) { const float fr_ = wsf[crow(r, hi)];
#pragma unroll
                    for (int d = 0; d < 4; ++d) o[d][r] *= fr_; }
                asm volatile("s_waitcnt lgkmcnt(0)" ::: "memory");
            }
            float sacc = 0.f;
#pragma unroll
            for (int r = 0; r < 16; ++r) { p0[r] = __builtin_amdgcn_exp2f(p0[r] - m_run); p1[r] = __builtin_amdgcn_exp2f(p1[r] - m_run); sacc += p0[r] + p1[r]; }
            lsum += sacc;
            bf16x8 pa[4];
            pa[0] = __builtin_bit_cast(bf16x8, (u32x4){cvtpk(p0[0], p0[1]), cvtpk(p0[2], p0[3]), cvtpk(p0[4], p0[5]), cvtpk(p0[6], p0[7])});
            pa[1] = __builtin_bit_cast(bf16x8, (u32x4){cvtpk(p0[8], p0[9]), cvtpk(p0[10], p0[11]), cvtpk(p0[12], p0[13]), cvtpk(p0[14], p0[15])});
            pa[2] = __builtin_bit_cast(bf16x8, (u32x4){cvtpk(p1[0], p1[1]), cvtpk(p1[2], p1[3]), cvtpk(p1[4], p1[5]), cvtpk(p1[6], p1[7])});
            pa[3] = __builtin_bit_cast(bf16x8, (u32x4){cvtpk(p1[8], p1[9]), cvtpk(p1[10], p1[11]), cvtpk(p1[12], p1[13]), cvtpk(p1[14], p1[15])});
            const lds_cptr vp = (lds_cptr)(lds + slot + 16384) + ((lane >> 4) & 1) * 32 + (lane & 3) * 8 + (4 * hi + ((lane & 15) >> 2)) * 64;
#pragma unroll
            for (int d = 0; d < 4; ++d) {
#pragma unroll
                for (int ks = 0; ks < 4; ++ks) { const s16x4 lo_ = vtr(vp + d * 4096 + ks * 1024), hi_ = vtr(vp + d * 4096 + ks * 1024 + 512);
                    const bf16x8 vf = (bf16x8){lo_[0], lo_[1], lo_[2], lo_[3], hi_[0], hi_[1], hi_[2], hi_[3]};
                    o[d] = __builtin_amdgcn_mfma_f32_32x32x16_bf16(pa[ks], vf, o[d], 0, 0, 0); } }
        }
        slot = (slot == 2 * SLOT) ? 0 : slot + SLOT; slot2 = (slot2 == 2 * SLOT) ? 0 : slot2 + SLOT;
    }
    { auto rr = __builtin_amdgcn_permlane32_swap(__float_as_uint(lsum), __float_as_uint(lsum), false, false); lsum = __uint_as_float(rr[0]) + __uint_as_float(rr[1]); }
    if (hi == 0) wsf[r32] = (m == 0 ? 1.f : -lam) / lsum;
    asm volatile("s_waitcnt lgkmcnt(0)" ::: "memory");
#pragma unroll
    for (int r = 0; r < 16; ++r) { const float fr_ = wsf[crow(r, hi)];
#pragma unroll
        for (int d = 0; d < 4; ++d) o[d][r] *= fr_; }
    AT_WAIT_BAR(0);
    lds_f* X = (lds_f*)lds + rg * 4096;
    if (m == 1) {
#pragma unroll
        for (int d = 0; d < 4; ++d)
#pragma unroll
            for (int r = 0; r < 16; ++r) X[(d * 16 + r) * 64 + lane] = o[d][r];
    }
    AT_WAIT_BAR(0);
    if (m == 0) {
        float ssq[16];
#pragma unroll
        for (int r = 0; r < 16; ++r) { float s = 0.f;
#pragma unroll
            for (int d = 0; d < 4; ++d) { o[d][r] += X[(d * 16 + r) * 64 + lane]; s += o[d][r] * o[d][r]; }
            ssq[r] = s; }
#pragma unroll
        for (int r = 0; r < 16; ++r) { float s = ssq[r];
#pragma unroll
            for (int of = 1; of < 32; of <<= 1) s += __shfl_xor(s, of);
            ssq[r] = rsqrtf(s * (1.f / 128.f) + 1e-6f) * 0.8f; }
        float sw[4];
#pragma unroll
        for (int d = 0; d < 4; ++d) sw[d] = subln[d * 32 + r32];
        bf16_t* yp = YA + (tokb + blk * 128 + rg * 32) * 512 + h * 128 + r32;
#pragma unroll
        for (int r = 0; r < 16; ++r)
#pragma unroll
            for (int d = 0; d < 4; ++d) yp[(size_t)crow(r, hi) * 512 + d * 32] = f2bf(o[d][r] * ssq[r] * sw[d]);
    }
    AT_WAIT_BAR(0);
#undef AT_DMA
}
}
namespace mk {
using pg8::f32x4; using pg8::u32x4; using pg8::u32x2; using pg8::Unit;
constexpr int NWAVES = 8, NTHR = 512;
constexpr int RING_BYTES = 131072, LDSCTL_OFF = RING_BYTES, LDS_BYTES = 147456;
constexpr int LW_BAR = 0, LW_TPRE = 16  , LW_CNT = 64  , LW_MISC = 128;
enum Phase { PH_PRO = 0, PH_H1, PH_G1, PH_ROPE_HGA, PH_ATT_SCAN, PH_HGC, PH_G2A, PH_G2B, PH_G3, PH_TOK, PH_G4, PH_G5, PH_FIN, PH_N };

struct Args {
    const float* in[25]; float* out; unsigned char* ws; int ph_lo, ph_hi, li, pad;
};

__device__ __forceinline__ float wave_sum(float v) {
#pragma unroll
    for (int o = 1; o < 64; o <<= 1) v += __shfl_xor(v, o);
    return v;
}
__device__ __forceinline__ float sigm(float x) { return 1.f / (1.f + __expf(-x)); }
__device__ __forceinline__ unsigned pk2(float lo, float hi) { return (unsigned)f2bf(lo) | ((unsigned)f2bf(hi) << 16); }

struct EpiBf16 {
    static constexpr bool PERM = true;
    bf16_t* O; int ldc;
    __device__ __forceinline__ void operator()(const f32x4 (&acc)[2][2][4][2], const Unit& u, int wr, int wc, int fr, int fq) const {
        const int row0 = u.pm * 256 + wr * 64 + fr, col0 = u.pn * 256 + wc * 32 + 8 * fq;
#pragma unroll
        for (int ai = 0; ai < 2; ++ai)
#pragma unroll
            for (int m = 0; m < 4; ++m) { bf16_t* rowp = O + (size_t)(row0 + ai * 128 + m * 16) * ldc + col0;
#pragma unroll
                for (int bj = 0; bj < 2; ++bj) { const f32x4 v0 = acc[ai][bj][m][0], v1 = acc[ai][bj][m][1]; u32x4 w; w.x = pk2(v0[0], v0[1]); w.y = pk2(v0[2], v0[3]); w.z = pk2(v1[0], v1[1]); w.w = pk2(v1[2], v1[3]);
                    *(u32x4*)(rowp + bj * 128) = w; } }
    }
};
struct EpiF32 {
    static constexpr bool PERM = false;
    float* O; int ldc;
    __device__ __forceinline__ void operator()(const f32x4 (&acc)[2][2][4][2], const Unit& u, int wr, int wc, int fr, int fq) const {
        const int row0 = u.pm * 256 + wr * 64 + fr, col0 = u.pn * 256 + wc * 32 + 4 * fq;
#pragma unroll
        for (int ai = 0; ai < 2; ++ai)
#pragma unroll
            for (int m = 0; m < 4; ++m) { float* rowp = O + (size_t)(row0 + ai * 128 + m * 16) * ldc + col0;
#pragma unroll
                for (int bj = 0; bj < 2; ++bj)
#pragma unroll
                    for (int n = 0; n < 2; ++n) *(f32x4*)(rowp + bj * 128 + n * 16) = acc[ai][bj][m][n]; }
    }
};
template <bool SECOND> struct EpiBranch {
    static constexpr bool PERM = false;
    float* tmp; const bf16_t* proj; bf16_t* merged;
    __device__ __forceinline__ void operator()(const f32x4 (&acc)[2][2][4][2], const Unit& u, int wr, int wc, int fr, int fq) const {
        const int row0 = u.pm * 256 + wr * 64 + fr, col0 = u.pn * 256 + wc * 32 + 4 * fq;
#pragma unroll
        for (int ai = 0; ai < 2; ++ai)
#pragma unroll
            for (int m = 0; m < 4; ++m) { const size_t row = (size_t)(row0 + ai * 128 + m * 16);
#pragma unroll
                for (int bj = 0; bj < 2; ++bj)
#pragma unroll
                    for (int n = 0; n < 2; ++n) { const int col = col0 + bj * 128 + n * 16; const f32x4 a = acc[ai][bj][m][n];
                        const u32x2 gw = *(const u32x2*)(proj + row * 5632 + (SECOND ? 4608 : 3584) + col);
                        f32x4 gt; gt[0] = sigm(__uint_as_float(gw.x << 16)); gt[1] = sigm(__uint_as_float(gw.x & 0xffff0000u)); gt[2] = sigm(__uint_as_float(gw.y << 16)); gt[3] = sigm(__uint_as_float(gw.y & 0xffff0000u));
                        if (!SECOND) { *(f32x4*)(tmp + row * 1024 + col) = gt * a; }
                        else { const f32x4 t = *(const f32x4*)(tmp + row * 1024 + col); const f32x4 r = t + gt * a; u32x2 w; w.x = pk2(r[0], r[1]); w.y = pk2(r[2], r[3]); *(u32x2*)(merged + row * 1024 + col) = w; } } }
    }
};
struct EpiGateUp {
    static constexpr bool PERM = true;
    const float* bgu; bf16_t* act;
    __device__ __forceinline__ void operator()(const f32x4 (&acc)[2][2][4][2], const Unit& u, int wr, int wc, int fr, int fq) const {
        const int e = u.z, colA = u.pn * 128 + wc * 32 + 8 * fq;
        f32x4 bg[2], bu[2];
#pragma unroll
        for (int n = 0; n < 2; ++n) { bg[n] = *(const f32x4*)(bgu + e * 2048 + colA + 4 * n); bu[n] = *(const f32x4*)(bgu + e * 2048 + 1024 + colA + 4 * n); }
#pragma unroll
        for (int ai = 0; ai < 2; ++ai)
#pragma unroll
            for (int m = 0; m < 4; ++m) { const size_t slot = (size_t)(u.arow + ai * 128 + wr * 64 + m * 16 + fr); unsigned w[4];
#pragma unroll
                for (int n = 0; n < 2; ++n) { float r[4];
#pragma unroll
                    for (int j = 0; j < 4; ++j) { float g = acc[ai][0][m][n][j] + bg[n][j], uu = acc[ai][1][m][n][j] + bu[n][j]; g = fminf(g, 7.f); uu = fminf(fmaxf(uu, -7.f), 7.f); r[j] = (uu + 1.f) * g * sigm(1.702f * g); }
                    w[2 * n] = pk2(r[0], r[1]); w[2 * n + 1] = pk2(r[2], r[3]); }
                *(u32x4*)(act + slot * 1024 + colA) = (u32x4){w[0], w[1], w[2], w[3]}; }
    }
};
struct EpiDown {
    static constexpr bool PERM = true;
    const float* bd; const int* list; bf16_t* ym; const LAS int* cnt;
    __device__ __forceinline__ void operator()(const f32x4 (&acc)[2][2][4][2], const Unit& u, int wr, int wc, int fr, int fq) const {
        const int e = u.z, nvalid = cnt[e] - u.pm * 256, col0 = u.pn * 256 + wc * 32 + 8 * fq;
        f32x4 bv[2][2];
#pragma unroll
        for (int bj = 0; bj < 2; ++bj)
#pragma unroll
            for (int n = 0; n < 2; ++n) bv[bj][n] = *(const f32x4*)(bd + e * 1024 + col0 + bj * 128 + 4 * n);
#pragma unroll
        for (int ai = 0; ai < 2; ++ai)
#pragma unroll
            for (int m = 0; m < 4; ++m) { const int r = ai * 128 + wr * 64 + m * 16 + fr;
                if (r < nvalid) { const int a = list[(size_t)e * 32768 + u.pm * 256 + r]; bf16_t* rowp = ym + (size_t)a * 1024 + col0;
#pragma unroll
                    for (int bj = 0; bj < 2; ++bj) { const f32x4 v0 = acc[ai][bj][m][0] + bv[bj][0], v1 = acc[ai][bj][m][1] + bv[bj][1]; u32x4 w; w.x = pk2(v0[0], v0[1]); w.y = pk2(v0[2], v0[3]); w.z = pk2(v1[0], v1[1]); w.w = pk2(v1[2], v1[3]);
                        *(u32x4*)(rowp + bj * 128) = w; } } }
    }
};
struct MoeOrder {
    const LAS int* tpre; const LAS int* cnt; const int* list; int nN, G, c, rowpitch  , brows  ;
    __device__ bool next(int i, Unit& u) const {
        const int nwg = tpre[32] * nN; const long L = (long)i * G + c; if (L >= nwg) return false;
        int wgid = (int)L; { const int q = nwg / 8, r = nwg % 8, xcd = wgid % 8, off = wgid / 8; wgid = (xcd < r ? xcd * (q + 1) : r * (q + 1) + (xcd - r) * q) + off; }
        int e = 0;
#pragma unroll 1
        for (int s = 16; s > 0; s >>= 1) { if (tpre[e + s] * nN <= wgid) e += s; }
        const int w = wgid - tpre[e] * nN, nM = tpre[e + 1] - tpre[e];
        const int nig = 8 * nN, gid = w / nig, fm = gid * 8, gsz = (nM - fm) < 8 ? (nM - fm) : 8;
        u.pm = fm + ((w % nig) % gsz); u.pn = (w % nig) / gsz; u.z = e; u.arow = (tpre[e] + u.pm) * 256; u.brow = e * brows + u.pn * 256; return true;
    }
    __device__ __forceinline__ unsigned row_off(const Unit& u, int r) const {
        const int lr = u.pm * 256 + r; const int a = list[(size_t)u.z * 32768 + (lr < cnt[u.z] ? lr : 0)]; return (unsigned)(a >> 2) * (unsigned)rowpitch;
    }
};

__device__ __forceinline__ void transpose_item(const float* W, int K, int N, bf16_t* WT, int k0, int n0, int dst_row0, LAS float* scr, int lane) {
#pragma unroll 8
    for (int i = 0; i < 32; ++i) { const int kk = 2 * i + (lane >> 5); scr[kk * 33 + (lane & 31)] = W[(size_t)(k0 + kk) * N + n0 + (lane & 31)]; }
    asm volatile("s_waitcnt lgkmcnt(0)" ::: "memory");
    const int c = lane & 7;
#pragma unroll
    for (int j = 0; j < 4; ++j) { const int n = (lane >> 3) + 8 * j; const LAS float* s = scr + (8 * c) * 33 + n;
        u32x4 o; o.x = pk2(s[0 * 33], s[1 * 33]); o.y = pk2(s[2 * 33], s[3 * 33]); o.z = pk2(s[4 * 33], s[5 * 33]); o.w = pk2(s[6 * 33], s[7 * 33]);
        *(u32x4*)(WT + (size_t)(dst_row0 + n) * K + k0 + 8 * c) = o; }
    asm volatile("s_waitcnt lgkmcnt(0)" ::: "memory");
}
template <bool GU>
__device__ __forceinline__ void transpose_matrix(const float* W, int K, int N, bf16_t* WT, LAS float* scr, int lane, int gw, int NGW, int& itbase) {
    const int nblk = N / 32, nitems = (K / 64) * nblk;
    int first = (gw - itbase) % NGW; if (first < 0) first += NGW;
    for (int it = first; it < nitems; it += NGW) { const int kb = it / nblk, nb = it % nblk, n0 = nb * 32;
        int dst = n0; if (GU) { const int nn = n0 & 1023; dst = (nn >> 7) * 256 + (n0 >> 10) * 128 + (nn & 127); }
        transpose_item(W, K, N, WT, kb * 64, n0, dst, scr, lane); }
    itbase += nitems;
}


#define MOD ((float*)(ws + WS_SMALL))
#define SCAL ((float*)(ws + WS_SMALL + 128 * 1024))
#define ROPEC ((float*)(ws + WS_ROPEC))
#define ROPES ((float*)(ws + WS_ROPES))
#define TOPI ((int*)(ws + WS_TOPI))
#define TOPW ((float*)(ws + WS_TOPW))
#define LIST ((int*)(ws + WS_LIST))
#define CNT ((int*)(ws + WS_CTL) + CW_CNT)
#define H ((bf16_t*)(ws + WS_H))
#define QKR ((bf16_t*)(ws + WS_H))
#define PROJ ((bf16_t*)(ws + WS_PROJ))
#define YA ((bf16_t*)(ws + WS_YA))
#define YB ((bf16_t*)(ws + WS_YB))
#define DS ((bf16_t*)(ws + WS_DS))
#define DEC ((float*)(ws + WS_DEC))
#define MERGED ((bf16_t*)(ws + WS_MERGED))
#define Y ((float*)(ws + WS_Y))
#define ACT ((bf16_t*)(ws + WS_ACT))
#define YM ((bf16_t*)(ws + WS_YM))
#define WT_IN ((bf16_t*)(ws + WS_WIN))
#define WT_A ((bf16_t*)(ws + WS_WA))
#define WT_B ((bf16_t*)(ws + WS_WB))
#define WT_O ((bf16_t*)(ws + WS_WO))
#define WT_GU ((bf16_t*)(ws + WS_WGU))
#define WT_D ((bf16_t*)(ws + WS_WD))
#define PHASE_BEGIN unsigned char* ws = args.ws; asm volatile("" : "+s"(ws)); int tid = threadIdx.x; asm volatile("" : "+v"(tid)); const int lane = tid & 63; (void)lane; const float* x = args.in[0]; float* out = args.out; (void)x; (void)out;
__global__ void __launch_bounds__(NTHR, 2) mega(Args args) {
    extern __shared__ __attribute__((aligned(16))) unsigned char lds_[];
    LAS unsigned char* lds = (LAS unsigned char*)lds_;
    volatile LAS unsigned* LW = (volatile LAS unsigned*)(lds + LDSCTL_OFF);
    const int tid = threadIdx.x, lane = tid & 63, wave = __builtin_amdgcn_readfirstlane(tid >> 6);
    const int G = gridDim.x; const int bx = blockIdx.x; const int vcu = (G % 8 == 0) ? (bx % 8) * (G / 8) + bx / 8 : bx;
    const int gw = vcu * NWAVES + wave, NGW = G * NWAVES;
    unsigned* CTL = (unsigned*)(args.ws + WS_CTL);
    for (int u = tid; u < (LDS_BYTES - LDSCTL_OFF) / 4; u += NTHR) ((LAS unsigned*)(lds + LDSCTL_OFF))[u] = 0u;
    __syncthreads();
    const int lo = args.ph_lo, hi = args.ph_hi;
    XcdBarrier bar; bar.bar = CTL + CW_BAR + args.li * 4096; bar.x = 0; bar.st = nullptr;
    if (hi - lo > 1) bar = xcd_barrier_post(CTL + CW_BAR + args.li * 4096, LW + LW_BAR);
#ifndef PHMASK
#define PHMASK 0xffff
#endif
#define IN(k) ((((PHMASK) >> (k)) & 1) && lo <= (k) && (k) < hi)
#define SEAM(k) do { if (IN(k) && IN((k) + 1)) xcd_barrier(bar); } while (0)

    if (IN(PH_PRO)) {
        PHASE_BEGIN
        const float* c = args.in[1]; const float* w_mod = args.in[2]; const float* b_mod = args.in[3];
        LAS float* cact = (LAS float*)lds; LAS float* red = cact + 4096;
        for (int i = tid; i < 4096; i += NTHR) { const float cv = c[i]; cact[i] = cv / (1.f + expf(-cv)); }
        __syncthreads();
        for (int it = vcu; it < 384; it += G) { const int b = it / 96, j0 = (it % 96) * 64, kq = tid >> 6, col = tid & 63; float acc = 0.f;
            for (int k = kq * 128; k < kq * 128 + 128; ++k) acc += cact[b * 1024 + k] * w_mod[(size_t)k * 6144 + j0 + col];
            red[kq * 64 + col] = acc; __syncthreads();
            if (tid < 64) { float s = 0.f;
#pragma unroll
                for (int q = 0; q < 8; ++q) s += red[q * 64 + tid];
                MOD[b * 6144 + j0 + tid] = s + b_mod[j0 + tid]; }
            __syncthreads(); }
        const int gt = vcu * NTHR + tid, NGT = G * NTHR;
        if (gt == 0) { const float* q1 = args.in[7]; const float* k1 = args.in[8]; const float* q2 = args.in[9]; const float* k2 = args.in[10]; float s1 = 0.f, s2 = 0.f;
            for (int i = 0; i < 64; ++i) { s1 += q1[i] * k1[i]; s2 += q2[i] * k2[i]; } SCAL[0] = expf(s1) - expf(s2) + 0.2f; }
        if (gt < 512) { const float* lbl = args.in[12]; SCAL[64 + gt] = 1.f / (1.f + expf(lbl[512 + gt] - lbl[gt])); }
        for (int i = gt; i < 8192 * 32; i += NGT) { const int s = i >> 5, j = i & 31; const float inv = powf(10000.f, -(float)(2 * j) / 64.f); const float ang = (float)s * inv; ROPEC[i] = cosf(ang); ROPES[i] = sinf(ang); }
        LAS float* scr = (LAS float*)(lds + wave * 16384); int itbase = 0;
        transpose_matrix<false>(args.in[6], 1024, 5632, WT_IN, scr, lane, gw, NGW, itbase);
        transpose_matrix<false>(args.in[14], 512, 1024, WT_A, scr, lane, gw, NGW, itbase);
        transpose_matrix<false>(args.in[15], 512, 1024, WT_B, scr, lane, gw, NGW, itbase);
        transpose_matrix<false>(args.in[16], 1024, 1024, WT_O, scr, lane, gw, NGW, itbase);
        for (int e = 0; e < 32; ++e) transpose_matrix<true>(args.in[21] + (size_t)e * 1024 * 2048, 1024, 2048, WT_GU + (size_t)e * 2048 * 1024, scr, lane, gw, NGW, itbase);
        for (int e = 0; e < 32; ++e) transpose_matrix<false>(args.in[23] + (size_t)e * 1024 * 1024, 1024, 1024, WT_D + (size_t)e * 1024 * 1024, scr, lane, gw, NGW, itbase);
    }
    SEAM(PH_PRO);
    if (IN(PH_H1)) {
        PHASE_BEGIN
        const float* w = args.in[4];
        for (int row = gw; row < T; row += NGW) { const int b = row >> 13; const f32x4* xr = (const f32x4*)(x + (size_t)row * 1024) + lane; f32x4 v[4]; float ss = 0.f;
#pragma unroll
            for (int j = 0; j < 4; ++j) { v[j] = xr[64 * j]; ss += (v[j][0] * v[j][0] + v[j][1] * v[j][1]) + (v[j][2] * v[j][2] + v[j][3] * v[j][3]); }
            const float rstd = rsqrtf(wave_sum(ss) * (1.f / 1024.f) + 1e-6f);
#pragma unroll
            for (int j = 0; j < 4; ++j) { const int col = 4 * lane + 256 * j; const f32x4 wv = *(const f32x4*)(w + col), sc = *(const f32x4*)(MOD + b * 6144 + 1024 + col), sh = *(const f32x4*)(MOD + b * 6144 + col);
                const f32x4 h = v[j] * rstd * wv * (sc + 1.f) + sh; u32x2 o; o.x = pk2(h[0], h[1]); o.y = pk2(h[2], h[3]); *(u32x2*)(H + (size_t)row * 1024 + col) = o; } }
    }
    SEAM(PH_H1);
    if (IN(PH_G1)) {
        PHASE_BEGIN
        pg8::Gemm g{H, WT_IN, 1024}; pg8::DenseOrder S; S.init(T, NC, G, bx);
        EpiBf16 E{PROJ, NC};
        pg8::gemm_phase<EpiBf16, pg8::DenseOrder, false>(lds, g, S, E);
    }
    SEAM(PH_G1);
    if (IN(PH_ROPE_HGA)) {
        PHASE_BEGIN
        for (int row = gw; row < T; row += NGW) { const int s = row & 8191;
#pragma unroll
            for (int j = 0; j < 2; ++j) { const int gq = lane + 64 * j, mb = gq >> 3, d4 = (gq & 7) * 4; const bf16_t* src = PROJ + (size_t)row * 5632 + mb * 64 + d4;
                const u32x2 a = *(const u32x2*)src, bq = *(const u32x2*)(src + 32); const f32x4 cs = *(const f32x4*)(ROPEC + s * 32 + d4), sn = *(const f32x4*)(ROPES + s * 32 + d4);
                const f32x4 x1 = (f32x4){__uint_as_float(a.x << 16), __uint_as_float(a.x & 0xffff0000u), __uint_as_float(a.y << 16), __uint_as_float(a.y & 0xffff0000u)};
                const f32x4 x2 = (f32x4){__uint_as_float(bq.x << 16), __uint_as_float(bq.x & 0xffff0000u), __uint_as_float(bq.y << 16), __uint_as_float(bq.y & 0xffff0000u)};
                const float sc = (mb < 8) ? at::C2 : 1.f; const f32x4 o1 = (x1 * cs - x2 * sn) * sc, o2 = (x2 * cs + x1 * sn) * sc;
                bf16_t* dst = QKR + (size_t)row * 1024 + mb * 64 + d4; u32x2 w1, w2; w1.x = pk2(o1[0], o1[1]); w1.y = pk2(o1[2], o1[3]); w2.x = pk2(o2[0], o2[1]); w2.y = pk2(o2[2], o2[3]);
                *(u32x2*)dst = w1; *(u32x2*)(dst + 32) = w2; } }
        LAS float* Gs = (LAS float*)lds; LAS float* Vs = Gs + 64 * 128;
        for (int it = vcu; it < 2048; it += G) { const int n = it & 127, bh = it >> 7, h = bh & 3, b = bh >> 2, tok0 = b * 8192 + n * 64;
            __syncthreads();
            for (int i = 0; i < 16; ++i) { const int idx = tid + 512 * i, cc = idx >> 7, d = idx & 127; const bf16_t* pr = PROJ + (size_t)(tok0 + cc) * 5632 + h * 128 + d;
                const float lb = SCAL[64 + h * 128 + d]; const float f = lb + (1.f - lb) * sigm(bf2f(pr[2048])); Gs[cc * 128 + d] = f; Vs[cc * 128 + d] = bf2f(pr[2560]); }
            __syncthreads();
            const int d = tid & 127, vb = (tid >> 7) * 32;
            if (tid < 128) { float gl = 0.f;
                for (int cc = 0; cc < 64; ++cc) gl += __logf(Gs[cc * 128 + d]);
                float g = 0.f;
                for (int cc = 0; cc < 64; ++cc) { const float f = Gs[cc * 128 + d]; g += __logf(f); Gs[cc * 128 + d] = (1.f - f) * __expf(gl - g); }
                DEC[(size_t)(bh * 128 + n) * 128 + d] = __expf(gl); }
            __syncthreads();
            for (int v0 = 0; v0 < 32; v0 += 16) { float acc[16];
#pragma unroll
                for (int i = 0; i < 16; ++i) acc[i] = 0.f;
                for (int cc = 0; cc < 64; ++cc) { const float kd = Gs[cc * 128 + d];
#pragma unroll
                    for (int i = 0; i < 16; ++i) acc[i] += kd * Vs[cc * 128 + vb + v0 + i]; }
                unsigned w[8];
#pragma unroll
                for (int i = 0; i < 8; ++i) w[i] = pk2(acc[2 * i], acc[2 * i + 1]);
                u32x4* dst = (u32x4*)(DS + ((size_t)(bh * 128 + n) * 128 + d) * 128 + vb + v0); dst[0] = (u32x4){w[0], w[1], w[2], w[3]}; dst[1] = (u32x4){w[4], w[5], w[6], w[7]}; }
        }
        __syncthreads();
    }
    SEAM(PH_ROPE_HGA);
    if (IN(PH_ATT_SCAN)) {
        PHASE_BEGIN
        for (int gid = vcu * NTHR + tid; gid < 16 * 128 * 128; gid += G * NTHR) { const int bh = gid >> 14, d = (gid >> 7) & 127, v = gid & 127; float st = 0.f;
            for (int n = 0; n < 128; ++n) { const size_t o = ((size_t)(bh * 128 + n) * 128 + d) * 128 + v; const float xv = bf2f(DS[o]); DS[o] = f2bf(st); st = DEC[(size_t)(bh * 128 + n) * 128 + d] * st + xv; } }
        { const float lam = SCAL[0]; const float* subln = args.in[11];
          for (int it = vcu; it < 1024; it += G) { int bh, blk;
              if (G == 256) { const int i = it >> 8, v = it & 255, s = v & 15; bh = v >> 4; blk = (i == 0) ? 63 - s : (i == 1) ? 32 + s : (i == 2) ? 31 - s : s; }
              else { blk = 63 - (it >> 4); bh = it & 15; }
              at::attn_unit(lds, QKR, PROJ, YA, subln, lam, bh >> 2, bh & 3, blk, tid); } }
    }
    SEAM(PH_ATT_SCAN);
    if (IN(PH_HGC)) {
        PHASE_BEGIN
        LAS float* QT = (LAS float*)lds; LAS float* KT = QT + 64 * 129; LAS float* V = KT + 64 * 129; LAS float* As = V + 64 * 128; const float* hgnorm = args.in[13];
        for (int it = vcu; it < 2048; it += G) { const int n = it & 127, bh = it >> 7, h = bh & 3, b = bh >> 2, tok0 = b * 8192 + n * 64;
            __syncthreads();
            for (int i = 0; i < 16; ++i) { const int idx = tid + 512 * i, cc = idx >> 7, d = idx & 127; const bf16_t* pr = PROJ + (size_t)(tok0 + cc) * 5632 + h * 128 + d;
                const float lb = SCAL[64 + h * 128 + d]; const float f = lb + (1.f - lb) * sigm(bf2f(pr[2048])); const float q = bf2f(pr[1536]);
                QT[cc * 129 + d] = q * sigm(q); KT[cc * 129 + d] = f; V[cc * 128 + d] = bf2f(pr[2560]); }
            __syncthreads();
            if (tid < 128) { float g = 0.f; for (int cc = 0; cc < 64; ++cc) { const float f = KT[cc * 129 + tid]; g += __logf(f); QT[cc * 129 + tid] *= __expf(g); KT[cc * 129 + tid] = (1.f - f) * __expf(-g); } }
            __syncthreads();
            const int cc = tid >> 3, q8 = tid & 7;
            for (int i = 0; i < 8; ++i) { const int s = 8 * i + q8; float a = 0.f;
                if (s <= cc) { for (int d = 0; d < 128; ++d) a += QT[cc * 129 + d] * KT[s * 129 + d]; }
                As[cc * 65 + s] = a; }
            __syncthreads();
            float o[16];
#pragma unroll
            for (int i = 0; i < 16; ++i) o[i] = 0.f;
            for (int s = 0; s < 64; ++s) { const float a = As[cc * 65 + s];
#pragma unroll
                for (int i = 0; i < 16; ++i) o[i] += a * V[s * 128 + 16 * q8 + i]; }
            const bf16_t* spb = DS + (size_t)(bh * 128 + n) * 128 * 128;
            for (int d = 0; d < 128; ++d) { const float qv = QT[cc * 129 + d]; const u32x4 s0 = *(const u32x4*)(spb + d * 128 + 16 * q8), s1 = *(const u32x4*)(spb + d * 128 + 16 * q8 + 8);
                const unsigned sw[8] = {s0.x, s0.y, s0.z, s0.w, s1.x, s1.y, s1.z, s1.w};
#pragma unroll
                for (int i = 0; i < 8; ++i) { o[2 * i] += qv * __uint_as_float(sw[i] << 16); o[2 * i + 1] += qv * __uint_as_float(sw[i] & 0xffff0000u); } }
            float ss = 0.f;
#pragma unroll
            for (int i = 0; i < 16; ++i) ss += o[i] * o[i];
            ss += __shfl_xor(ss, 1); ss += __shfl_xor(ss, 2); ss += __shfl_xor(ss, 4);
            const float rstd = rsqrtf(ss * (1.f / 128.f) + 1e-6f);
#pragma unroll
            for (int i = 0; i < 16; ++i) { const int v = 16 * q8 + i; const float gg = bf2f(PROJ[(size_t)(tok0 + cc) * 5632 + 3072 + h * 128 + v]);
                YB[(size_t)(tok0 + cc) * 512 + h * 128 + v] = f2bf(o[i] * rstd * hgnorm[v] * (gg * sigm(gg))); }
        }
        __syncthreads();
    }
    SEAM(PH_HGC);
    if (IN(PH_G2A)) {
        PHASE_BEGIN
        pg8::Gemm g{YA, WT_A, 512}; pg8::DenseOrder S; S.init(T, 1024, G, bx);
        EpiBranch<false> E{out, PROJ, MERGED};
        pg8::gemm_phase<EpiBranch<false>, pg8::DenseOrder, false>(lds, g, S, E);
    }
    if (IN(PH_G2B)) {
        PHASE_BEGIN
        asm volatile("s_waitcnt vmcnt(0)" ::: "memory"); __syncthreads();
        pg8::Gemm g{YB, WT_B, 512}; pg8::DenseOrder S; S.init(T, 1024, G, bx);
        EpiBranch<true> E{out, PROJ, MERGED};
        pg8::gemm_phase<EpiBranch<true>, pg8::DenseOrder, false>(lds, g, S, E);
    }
    SEAM(PH_G2B);
    if (IN(PH_G3)) {
        PHASE_BEGIN
        pg8::Gemm g{MERGED, WT_O, 1024}; pg8::DenseOrder S; S.init(T, 1024, G, bx);
        EpiF32 E{Y, 1024};
        pg8::gemm_phase<EpiF32, pg8::DenseOrder, false>(lds, g, S, E);
    }
    SEAM(PH_G3);
    if (IN(PH_TOK)) {
        PHASE_BEGIN
        const float* wpm = args.in[5]; const float* wpf = args.in[17]; const float* rw = args.in[19]; const float* rb = args.in[20];
        LAS int* lcnt = (LAS int*)lds; LAS int* lbase = lcnt + 32; LAS int* asg = lcnt + 64;
        for (int chunk = vcu; chunk < T / 128; chunk += G) {
            __syncthreads();
            if (tid < 32) lcnt[tid] = 0;
            __syncthreads();
            for (int i = 0; i < 16; ++i) { const int rloc = wave * 16 + i, row = chunk * 128 + rloc, b = row >> 13;
                const f32x4* yr = (const f32x4*)(Y + (size_t)row * 1024) + lane; const f32x4* xr = (const f32x4*)(x + (size_t)row * 1024) + lane; f32x4 v[4]; float ss = 0.f;
#pragma unroll
                for (int j = 0; j < 4; ++j) { v[j] = yr[64 * j]; ss += (v[j][0] * v[j][0] + v[j][1] * v[j][1]) + (v[j][2] * v[j][2] + v[j][3] * v[j][3]); }
                float rstd = rsqrtf(wave_sum(ss) * (1.f / 1024.f) + 1e-6f); ss = 0.f;
#pragma unroll
                for (int j = 0; j < 4; ++j) { const int col = 4 * lane + 256 * j; const f32x4 g1 = *(const f32x4*)(MOD + b * 6144 + 2048 + col), wv = *(const f32x4*)(wpm + col);
                    v[j] = xr[64 * j] + g1 * v[j] * rstd * wv; *(f32x4*)(out + (size_t)row * 1024 + col) = v[j]; ss += (v[j][0] * v[j][0] + v[j][1] * v[j][1]) + (v[j][2] * v[j][2] + v[j][3] * v[j][3]); }
                rstd = rsqrtf(wave_sum(ss) * (1.f / 1024.f) + 1e-6f);
                float lg[32];
#pragma unroll
                for (int e = 0; e < 32; ++e) lg[e] = 0.f;
#pragma unroll
                for (int j = 0; j < 4; ++j) { const int col = 4 * lane + 256 * j; const f32x4 wv = *(const f32x4*)(wpf + col), sc = *(const f32x4*)(MOD + b * 6144 + 4096 + col), sh = *(const f32x4*)(MOD + b * 6144 + 3072 + col);
                    const f32x4 h = v[j] * rstd * wv * (sc + 1.f) + sh; u32x2 o; o.x = pk2(h[0], h[1]); o.y = pk2(h[2], h[3]); *(u32x2*)(H + (size_t)row * 1024 + col) = o;
#pragma unroll
                    for (int q = 0; q < 4; ++q) { const f32x4* rwp = (const f32x4*)(rw + (size_t)(col + q) * 32);
#pragma unroll
                        for (int e4 = 0; e4 < 8; ++e4) { const f32x4 r4 = rwp[e4]; lg[4 * e4] += h[q] * r4[0]; lg[4 * e4 + 1] += h[q] * r4[1]; lg[4 * e4 + 2] += h[q] * r4[2]; lg[4 * e4 + 3] += h[q] * r4[3]; } } }
#pragma unroll
                for (int e = 0; e < 32; ++e) lg[e] = wave_sum(lg[e]) + rb[e];
                int bi[4]; float bv[4];
#pragma unroll
                for (int k = 0; k < 4; ++k) { float best = -3.0e38f; int be = 0;
#pragma unroll
                    for (int e = 0; e < 32; ++e) { bool taken = false;
#pragma unroll
                        for (int q = 0; q < 4; ++q) if (q < k && bi[q] == e) taken = true;
                        if (!taken && lg[e] > best) { best = lg[e]; be = e; } }
                    bi[k] = be; bv[k] = best; }
                const float e1 = expf(bv[1] - bv[0]), e2 = expf(bv[2] - bv[0]), e3 = expf(bv[3] - bv[0]); const float inv = 1.f / (1.f + e1 + e2 + e3);
                if (lane == 0) { *(f32x4*)(TOPW + row * 4) = (f32x4){inv, e1 * inv, e2 * inv, e3 * inv};
                    TOPI[row * 4 + 0] = bi[0]; TOPI[row * 4 + 1] = bi[1]; TOPI[row * 4 + 2] = bi[2]; TOPI[row * 4 + 3] = bi[3];
#pragma unroll
                    for (int k = 0; k < 4; ++k) { const int pos = __hip_atomic_fetch_add(lcnt + bi[k], 1, __ATOMIC_RELAXED, __HIP_MEMORY_SCOPE_WORKGROUP); asg[rloc * 4 + k] = (bi[k] << 16) | pos; } }
            }
            __syncthreads();
            if (tid < 32) lbase[tid] = atomicAdd(&CNT[tid], lcnt[tid]);
            __syncthreads();
            { const int v = asg[tid], e = v >> 16, pos = v & 0xffff; LIST[(size_t)e * 32768 + lbase[e] + pos] = chunk * 512 + tid; }
        }
        __syncthreads();
    }
    SEAM(PH_TOK);
    if (IN(PH_G4) || IN(PH_G5)) {
        PHASE_BEGIN
        if (tid < 32) ((LAS int*)LW)[LW_CNT + tid] = __hip_atomic_load(&CNT[tid], __ATOMIC_RELAXED, __HIP_MEMORY_SCOPE_AGENT);
        __syncthreads();
        if (tid == 0) { int s = 0; for (int e = 0; e < 32; ++e) { ((LAS int*)LW)[LW_TPRE + e] = s; s += (((LAS int*)LW)[LW_CNT + e] + 255) >> 8; } ((LAS int*)LW)[LW_TPRE + 32] = s; }
        __syncthreads();
    }
    if (IN(PH_G4)) {
        PHASE_BEGIN
        pg8::Gemm g{H, WT_GU, 1024}; MoeOrder S{(const LAS int*)LW + LW_TPRE, (const LAS int*)LW + LW_CNT, LIST, 8, G, bx, 2048, 2048};
        EpiGateUp E{args.in[22], ACT};
        pg8::gemm_phase<EpiGateUp, MoeOrder, true>(lds, g, S, E);
    }
    SEAM(PH_G4);
    if (IN(PH_G5)) {
        PHASE_BEGIN
        pg8::Gemm g{ACT, WT_D, 1024}; MoeOrder S{(const LAS int*)LW + LW_TPRE, (const LAS int*)LW + LW_CNT, LIST, 4, G, bx, 2048, 1024};
        EpiDown E{args.in[24], LIST, YM, (const LAS int*)LW + LW_CNT};
        pg8::gemm_phase<EpiDown, MoeOrder, false>(lds, g, S, E);
    }
    SEAM(PH_G5);
    if (IN(PH_FIN)) {
        PHASE_BEGIN
        const float* w = args.in[18];
        for (int row = gw; row < T; row += NGW) { const int b = row >> 13; const f32x4 tw = *(const f32x4*)(TOPW + row * 4); const bf16_t* y0 = YM + (size_t)row * 4096; f32x4 v[4]; float ss = 0.f;
#pragma unroll
            for (int j = 0; j < 4; ++j) { const int col = 4 * lane + 256 * j; f32x4 a = (f32x4){0.f, 0.f, 0.f, 0.f};
#pragma unroll
                for (int k = 0; k < 4; ++k) { const u32x2 yw = *(const u32x2*)(y0 + k * 1024 + col);
                    a[0] += tw[k] * __uint_as_float(yw.x << 16); a[1] += tw[k] * __uint_as_float(yw.x & 0xffff0000u); a[2] += tw[k] * __uint_as_float(yw.y << 16); a[3] += tw[k] * __uint_as_float(yw.y & 0xffff0000u); }
                v[j] = a; ss += (a[0] * a[0] + a[1] * a[1]) + (a[2] * a[2] + a[3] * a[3]); }
            const float rstd = rsqrtf(wave_sum(ss) * (1.f / 1024.f) + 1e-6f);
#pragma unroll
            for (int j = 0; j < 4; ++j) { const int col = 4 * lane + 256 * j; const f32x4 g2 = *(const f32x4*)(MOD + b * 6144 + 5120 + col), wv = *(const f32x4*)(w + col);
                f32x4* op = (f32x4*)(out + (size_t)row * 1024 + col); *op = *op + g2 * v[j] * rstd * wv; } }
    }
#undef IN
#undef SEAM
}
}
#undef MOD
#undef SCAL
#undef ROPEC
#undef ROPES
#undef TOPI
#undef TOPW
#undef LIST
#undef CNT
#undef H
#undef QKR
#undef PROJ
#undef YA
#undef YB
#undef DS
#undef DEC
#undef MERGED
#undef Y
#undef ACT
#undef YM
#undef WT_IN
#undef WT_A
#undef WT_B
#undef WT_O
#undef WT_GU
#undef WT_D
#undef PHASE_BEGIN

#ifndef FASTMASK
#define FASTMASK 0x1fff
#endif

extern "C" void kernel_launch(void* const* d_in, const int* in_sizes, int n_in, void* d_out, int out_size, void* d_ws, size_t ws_size, hipStream_t stream) {
    if (n_in != 25 || out_size != T * D || ws_size < WS_END) { fprintf(stderr, "kernel_launch: unexpected shapes / workspace (%d inputs, out %d, ws %zu)\n", n_in, out_size, ws_size); return; }
    const float* x = (const float*)d_in[0]; const float* c = (const float*)d_in[1]; const float* w_mod = (const float*)d_in[2]; const float* b_mod = (const float*)d_in[3];
    const float* norm_pre_mix = (const float*)d_in[4]; const float* norm_post_mix = (const float*)d_in[5]; const float* w_in = (const float*)d_in[6];
    const float* lq1 = (const float*)d_in[7]; const float* lk1 = (const float*)d_in[8]; const float* lq2 = (const float*)d_in[9]; const float* lk2 = (const float*)d_in[10];
    const float* subln = (const float*)d_in[11]; const float* lbl = (const float*)d_in[12]; const float* hgnorm = (const float*)d_in[13];
    const float* wa = (const float*)d_in[14]; const float* wb = (const float*)d_in[15]; const float* wo = (const float*)d_in[16];
    const float* norm_pre_ffn = (const float*)d_in[17]; const float* norm_post_ffn = (const float*)d_in[18]; const float* rw = (const float*)d_in[19]; const float* rb = (const float*)d_in[20];
    const float* wgu = (const float*)d_in[21]; const float* bgu = (const float*)d_in[22]; const float* wd = (const float*)d_in[23]; const float* bd = (const float*)d_in[24];
    unsigned char* ws = (unsigned char*)d_ws; float* out = (float*)d_out;
    float* MOD = (float*)(ws + WS_SMALL); float* SCAL = (float*)(ws + WS_SMALL + 128 * 1024); int* PADS = (int*)(ws + WS_SMALL + 192 * 1024);
    float* ROPEC = (float*)(ws + WS_ROPEC); float* ROPES = (float*)(ws + WS_ROPES);
    int* TOPI = (int*)(ws + WS_TOPI); float* TOPW = (float*)(ws + WS_TOPW); int* LIST = (int*)(ws + WS_LIST); int* CNT = (int*)(ws + WS_CTL) + CW_CNT;
    bf16_t* H = (bf16_t*)(ws + WS_H); bf16_t* PROJ = (bf16_t*)(ws + WS_PROJ); bf16_t* YA = (bf16_t*)(ws + WS_YA); bf16_t* YB = (bf16_t*)(ws + WS_YB);
    bf16_t* DS = (bf16_t*)(ws + WS_DS); float* DEC = (float*)(ws + WS_DEC); bf16_t* MERGED = (bf16_t*)(ws + WS_MERGED); float* Y = (float*)(ws + WS_Y);
    bf16_t* ACT = (bf16_t*)(ws + WS_ACT); bf16_t* YM = (bf16_t*)(ws + WS_YM);

    static int grid = 0;
    if (grid == 0) {
        (void)hipFuncSetAttribute((const void*)nv::k_attn, hipFuncAttributeMaxDynamicSharedMemorySize, nv::AT_LDS);
        (void)hipFuncSetAttribute((const void*)nv::k_hgA, hipFuncAttributeMaxDynamicSharedMemorySize, 65536);
        (void)hipFuncSetAttribute((const void*)nv::k_hgC, hipFuncAttributeMaxDynamicSharedMemorySize, nv::HC_LDS);
        (void)hipFuncSetAttribute((const void*)mk::mega, hipFuncAttributeMaxDynamicSharedMemorySize, mk::LDS_BYTES);
        int dev = 0, cus = 0; (void)hipGetDevice(&dev); (void)hipDeviceGetAttribute(&cus, hipDeviceAttributeMultiprocessorCount, dev);
        (void)hipGetLastError();
        grid = cus > 0 ? cus : 256;
    }
    (void)hipMemsetAsync(ws + WS_CTL, 0, 1 * MiB, stream);
    mk::Args a{}; for (int i = 0; i < 25; ++i) a.in[i] = (const float*)d_in[i]; a.out = out; a.ws = ws;
    const unsigned fast = FASTMASK; int li = 0;
    for (int p = 0; p < mk::PH_N;) {
        if (fast & (1u << p)) { int q = p; while (q < mk::PH_N && (fast & (1u << q))) ++q;
            a.ph_lo = p; a.ph_hi = q; a.li = li++; a.pad = 0;
            hipLaunchKernelGGL(mk::mega, dim3(grid), dim3(mk::NTHR), mk::LDS_BYTES, stream, a);
            p = q; continue; }
        switch (p) {
        case mk::PH_PRO:
            nv::k_mod<<<dim3(24, 4), 256, 0, stream>>>(c, w_mod, b_mod, MOD);
            nv::k_small<<<1024, 256, 0, stream>>>(lq1, lk1, lq2, lk2, lbl, SCAL, ROPEC, ROPES); break;
        case mk::PH_H1: nv::k_rowmod<<<T / 4, 256, 0, stream>>>(x, norm_pre_mix, MOD, H, 0, 1024); break;
        case mk::PH_G1: { nv::NG p_{}; p_.A = H; p_.lda = 1024; p_.M = T; p_.B = w_in; p_.ldb = NC; p_.K = 1024;
            nv::k_gemm<nv::EpiStoreBf16, 1><<<dim3(NC / 64, T / 64, 1), 256, 0, stream>>>(p_, nv::EpiStoreBf16{PROJ, (long long)NC}); } break;
        case mk::PH_ROPE_HGA: nv::k_hgA<<<dim3(128, 4, 4), 256, 65536, stream>>>(PROJ, SCAL, DS, DEC); break;
        case mk::PH_ATT_SCAN:
            nv::k_attn<<<dim3(128, 4, 4), 256, nv::AT_LDS, stream>>>(PROJ, ROPEC, ROPES, SCAL, subln, YA);
            nv::k_scan<<<1024, 256, 0, stream>>>(DS, DEC); break;
        case mk::PH_HGC: nv::k_hgC<<<dim3(128, 4, 4), 256, nv::HC_LDS, stream>>>(PROJ, SCAL, DS, hgnorm, YB); break;
        case mk::PH_G2A: { nv::NG p_{}; p_.A = YA; p_.lda = 512; p_.M = T; p_.B = wa; p_.ldb = 1024; p_.K = 512;
            nv::k_gemm<nv::EpiBranchA, 1><<<dim3(16, T / 64, 1), 256, 0, stream>>>(p_, nv::EpiBranchA{out, PROJ}); } break;
        case mk::PH_G2B: { nv::NG p_{}; p_.A = YB; p_.lda = 512; p_.M = T; p_.B = wb; p_.ldb = 1024; p_.K = 512;
            nv::k_gemm<nv::EpiBranchB, 1><<<dim3(16, T / 64, 1), 256, 0, stream>>>(p_, nv::EpiBranchB{out, PROJ, MERGED}); } break;
        case mk::PH_G3: { nv::NG p_{}; p_.A = MERGED; p_.lda = 1024; p_.M = T; p_.B = wo; p_.ldb = 1024; p_.K = 1024;
            nv::k_gemm<nv::EpiStoreF32, 1><<<dim3(16, T / 64, 1), 256, 0, stream>>>(p_, nv::EpiStoreF32{Y, 1024LL}); } break;
        case mk::PH_TOK:
            nv::k_x1<<<T / 4, 256, 0, stream>>>(x, Y, norm_post_mix, MOD, 2048LL, out);
            nv::k_rowmod<<<T / 4, 256, 0, stream>>>(out, norm_pre_ffn, MOD, H, 3072, 4096);
            nv::k_route<<<T / 4, 256, 0, stream>>>(out, norm_pre_ffn, MOD, rw, rb, TOPI, TOPW);
            nv::k_lists<<<T * 4 / 256, 256, 0, stream>>>(TOPI, CNT, LIST);
            nv::k_pads<<<1, 64, 0, stream>>>(CNT, PADS); break;
        case mk::PH_G4: { nv::NG p_{}; p_.A = H; p_.lda = 1024; p_.rowidx = LIST; p_.idxstride = 32768; p_.idxshift = 2; p_.cnt = CNT; p_.rowbase = PADS; p_.B = wgu; p_.strideB = (size_t)1024 * 2048; p_.ldb = 2048; p_.K = 1024; p_.b1off = 1024;
            nv::k_gemm<nv::EpiGateUp, 2><<<dim3(16, T / 64, 32), 256, 0, stream>>>(p_, nv::EpiGateUp{bgu, ACT}); } break;
        case mk::PH_G5: { nv::NG p_{}; p_.A = ACT; p_.lda = 1024; p_.cnt = CNT; p_.rowbase = PADS; p_.B = wd; p_.strideB = (size_t)1024 * 1024; p_.ldb = 1024; p_.K = 1024;
            nv::k_gemm<nv::EpiDown, 1><<<dim3(16, T / 64, 32), 256, 0, stream>>>(p_, nv::EpiDown{bd, LIST, YM}); } break;
        case mk::PH_FIN: nv::k_final<<<T / 4, 256, 0, stream>>>(out, YM, TOPW, norm_post_ffn, MOD); break;
        }
        ++p;
    }
}
```

```cpp
#include <hip/hip_runtime.h>
#include <hip/hip_bf16.h>
#include <stdint.h>
#include <cstdio>

typedef unsigned short bf16_t;
__device__ __forceinline__ float bf2f(bf16_t v) { return __uint_as_float(((unsigned)v) << 16); }
__device__ __forceinline__ bf16_t f2bf(float f) { unsigned u = __float_as_uint(f); return (bf16_t)((u + 0x7fffu + ((u >> 16) & 1u)) >> 16); }

constexpr int NB_ = 4, SEQ = 8192, T = NB_ * SEQ, D = 1024, NC = 5632, NE = 32;
constexpr size_t MiB = 1u << 20;
constexpr size_t WS_CTL = 0;
constexpr size_t WS_SMALL = 1 * MiB;
constexpr size_t WS_ROPEC = 2 * MiB, WS_ROPES = 3 * MiB;
constexpr size_t WS_TOPI = 4 * MiB, WS_TOPW = 4 * MiB + 512 * 1024;
constexpr size_t WS_LIST = 6 * MiB;
constexpr size_t WS_WIN = 16 * MiB, WS_WA = 28 * MiB, WS_WB = 29 * MiB, WS_WO = 30 * MiB, WS_WGU = 32 * MiB, WS_WD = 160 * MiB;
constexpr size_t WS_H = 224 * MiB;
constexpr size_t WS_PROJ = 288 * MiB;
constexpr size_t WS_YA = 640 * MiB, WS_YB = 672 * MiB;
constexpr size_t WS_DS = 704 * MiB, WS_DEC = 768 * MiB;
constexpr size_t WS_MERGED = 772 * MiB;
constexpr size_t WS_Y = 836 * MiB;
constexpr size_t WS_ACT = 288 * MiB;
constexpr size_t WS_YM = 560 * MiB;
constexpr size_t WS_END = 964 * MiB;
constexpr int CW_CNT = 1024;
constexpr int CW_BAR = 4096;

namespace nv {

__device__ __forceinline__ float wave_sum(float v) {
#pragma unroll
    for (int o = 1; o < 64; o <<= 1) v += __shfl_xor(v, o);
    return v;
}
__device__ __forceinline__ float sigm(float x) { return 1.f / (1.f + expf(-x)); }

__global__ void __launch_bounds__(256) k_mod(const float* c, const float* w_mod, const float* b_mod, float* mod) {
    const int j = blockIdx.x * 256 + threadIdx.x, b = blockIdx.y;
    float acc = 0.f;
    for (int k = 0; k < 1024; ++k) { const float cv = c[b * 1024 + k]; acc += (cv * sigm(cv)) * w_mod[(size_t)k * 6144 + j]; }
    mod[b * 6144 + j] = acc + b_mod[j];
}
__global__ void __launch_bounds__(256) k_small(const float* q1, const float* k1, const float* q2, const float* k2, const float* lbl,
                                               float* scal, float* ropec, float* ropes) {
    const int gid = blockIdx.x * 256 + threadIdx.x;
    if (gid == 0) { float s1 = 0.f, s2 = 0.f; for (int i = 0; i < 64; ++i) { s1 += q1[i] * k1[i]; s2 += q2[i] * k2[i]; } scal[0] = expf(s1) - expf(s2) + 0.2f; }
    if (gid < 512) { const float a = lbl[gid], b = lbl[512 + gid]; scal[64 + gid] = 1.f / (1.f + expf(b - a)); }
    if (gid < 8192 * 32) { const int s = gid >> 5, i = gid & 31; const float inv = powf(10000.f, -(float)(2 * i) / 64.f); const float ang = (float)s * inv; ropec[gid] = cosf(ang); ropes[gid] = sinf(ang); }
}
__global__ void __launch_bounds__(256) k_rowmod(const float* x, const float* w, const float* mod, bf16_t* out, int shoff, int scoff) {
    const int row = blockIdx.x * 4 + (threadIdx.x >> 6), lane = threadIdx.x & 63, b = row >> 13;
    const float* xr = x + (size_t)row * 1024; float v[16]; float ss = 0.f;
#pragma unroll
    for (int j = 0; j < 16; ++j) { v[j] = xr[lane + 64 * j]; ss += v[j] * v[j]; }
    ss = wave_sum(ss); const float rstd = rsqrtf(ss * (1.f / 1024.f) + 1e-6f);
#pragma unroll
    for (int j = 0; j < 16; ++j) { const int col = lane + 64 * j; const float h = v[j] * rstd * w[col] * (1.f + mod[b * 6144 + scoff + col]) + mod[b * 6144 + shoff + col]; out[(size_t)row * 1024 + col] = f2bf(h); }
}

struct NG {
    const bf16_t* A;
    const int* rowidx;
    const int* cnt;
    const int* rowbase;
    const float* B; size_t strideB;
    int lda, idxstride, idxshift, M  , ldb, K, b1off, pad;
};
template <class Epi, int NB>
__global__ void __launch_bounds__(256) k_gemm(NG p, Epi epi) {
    __shared__ float As[16][68];
    __shared__ float Bs[NB][16][64];
    const int z = blockIdx.z, Mz = p.cnt ? p.cnt[z] : p.M, m0 = blockIdx.y * 64, n0 = blockIdx.x * 64;
    if (m0 >= Mz) return;
    const int tid = threadIdx.x, tx = tid & 15, ty = tid >> 4;
    const float* B = p.B + (size_t)z * p.strideB;
    const int base = p.rowbase ? p.rowbase[z] : 0;
    const int lr = tid >> 2, lk = (tid & 3) * 4;
    int lrow = m0 + lr; if (lrow >= Mz) lrow = Mz - 1;
    const size_t arow = p.rowidx ? (size_t)(p.rowidx[(size_t)z * p.idxstride + lrow] >> p.idxshift) : (size_t)(base + lrow);
    const bf16_t* ap = p.A + arow * p.lda + lk;
    const int bk = tid >> 4, bc = (tid & 15) * 4;
    float acc[NB][4][4];
#pragma unroll
    for (int q = 0; q < NB; ++q)
#pragma unroll
        for (int i = 0; i < 4; ++i)
#pragma unroll
            for (int j = 0; j < 4; ++j) acc[q][i][j] = 0.f;
    for (int k0 = 0; k0 < p.K; k0 += 16) {
        const uint2 av = *(const uint2*)(ap + k0);
        As[lk + 0][lr] = __uint_as_float(av.x << 16); As[lk + 1][lr] = __uint_as_float(av.x & 0xffff0000u);
        As[lk + 2][lr] = __uint_as_float(av.y << 16); As[lk + 3][lr] = __uint_as_float(av.y & 0xffff0000u);
#pragma unroll
        for (int q = 0; q < NB; ++q) { const float4 bv = *(const float4*)(B + (size_t)(k0 + bk) * p.ldb + n0 + bc + q * p.b1off); *(float4*)&Bs[q][bk][bc] = bv; }
        __syncthreads();
#pragma unroll
        for (int k = 0; k < 16; ++k) {
            float a[4]; const float4 a4 = *(const float4*)&As[k][ty * 4]; a[0] = a4.x; a[1] = a4.y; a[2] = a4.z; a[3] = a4.w;
#pragma unroll
            for (int q = 0; q < NB; ++q) { const float4 b4 = *(const float4*)&Bs[q][k][tx * 4]; const float b[4] = {b4.x, b4.y, b4.z, b4.w};
#pragma unroll
                for (int i = 0; i < 4; ++i)
#pragma unroll
                    for (int j = 0; j < 4; ++j) acc[q][i][j] += a[i] * b[j]; }
        }
        __syncthreads();
    }
#pragma unroll
    for (int i = 0; i < 4; ++i) { const int lrw = m0 + ty * 4 + i; if (lrw < Mz) {
#pragma unroll
        for (int j = 0; j < 4; ++j) epi(z, lrw, base + lrw, n0 + tx * 4 + j, acc[0][i][j], NB == 2 ? acc[NB - 1][i][j] : 0.f); } }
}
struct EpiStoreBf16 { bf16_t* C; long long ldc; __device__ void operator()(int, int, int r, int c, float v, float) const { C[(size_t)r * ldc + c] = f2bf(v); } };
struct EpiStoreF32 { float* C; long long ldc; __device__ void operator()(int, int, int r, int c, float v, float) const { C[(size_t)r * ldc + c] = v; } };
struct EpiBranchA { float* tmp; const bf16_t* proj; __device__ void operator()(int, int, int r, int c, float v, float) const { tmp[(size_t)r * 1024 + c] = sigm(bf2f(proj[(size_t)r * 5632 + 3584 + c])) * v; } };
struct EpiBranchB { const float* tmp; const bf16_t* proj; bf16_t* merged; __device__ void operator()(int, int, int r, int c, float v, float) const {
    merged[(size_t)r * 1024 + c] = f2bf(tmp[(size_t)r * 1024 + c] + sigm(bf2f(proj[(size_t)r * 5632 + 4608 + c])) * v); } };
struct EpiGateUp { const float* bgu; bf16_t* act; __device__ void operator()(int e, int, int r, int c, float v0, float v1) const {
    float g = v0 + bgu[e * 2048 + c], u = v1 + bgu[e * 2048 + 1024 + c]; g = fminf(g, 7.f); u = fminf(fmaxf(u, -7.f), 7.f);
    const float glu = g * sigm(1.702f * g); act[(size_t)r * 1024 + c] = f2bf((u + 1.f) * glu); } };
struct EpiDown { const float* bd; const int* list; bf16_t* ym; __device__ void operator()(int e, int lr, int, int c, float v, float) const {
    const int a = list[(size_t)e * 32768 + lr]; ym[(size_t)a * 1024 + c] = f2bf(v + bd[e * 1024 + c]); } };

constexpr int AT_LD = 129;
constexpr int AT_LDS = (3 * 64 * AT_LD + 64 * 65) * 4;
__device__ __forceinline__ void at_load_rope(float* dst, const bf16_t* proj, int tok0, int colbase, const float* ropec, const float* ropes, int s0, int tid) {
    for (int i = 0; i < 16; ++i) { const int idx = tid + 256 * i, row = idx >> 6, rem = idx & 63, m = rem >> 5, d = rem & 31;
        const bf16_t* pr = proj + (size_t)(tok0 + row) * 5632 + colbase + m * 64;
        const float x1 = bf2f(pr[d]), x2 = bf2f(pr[32 + d]), c = ropec[(s0 + row) * 32 + d], s = ropes[(s0 + row) * 32 + d];
        dst[row * AT_LD + m * 64 + d] = x1 * c - x2 * s; dst[row * AT_LD + m * 64 + 32 + d] = x2 * c + x1 * s; }
}
__global__ void __launch_bounds__(256) k_attn(const bf16_t* proj, const float* ropec, const float* ropes, const float* scal, const float* subln, bf16_t* ya) {
    extern __shared__ float sm[];
    float* Qs = sm; float* Ks = Qs + 64 * AT_LD; float* Vs = Ks + 64 * AT_LD; float* As = Vs + 64 * AT_LD;
    const int qc = blockIdx.x, h = blockIdx.y, b = blockIdx.z, tid = threadIdx.x, r = tid >> 2, qd = tid & 3;
    const int tokq = b * 8192 + qc * 64; const float lam = scal[0];
    at_load_rope(Qs, proj, tokq, h * 128, ropec, ropes, qc * 64, tid);
    float m0 = -1e30f, l0 = 0.f, m1 = -1e30f, l1 = 0.f;
    for (int kc = 0; kc <= qc; ++kc) {
        __syncthreads();
        at_load_rope(Ks, proj, b * 8192 + kc * 64, 512 + h * 128, ropec, ropes, kc * 64, tid);
        __syncthreads();
        for (int i = 0; i < 16; ++i) { const int j = 4 * i + qd; float s0 = 0.f, s1 = 0.f;
            for (int d = 0; d < 64; ++d) { s0 += Qs[r * AT_LD + d] * Ks[j * AT_LD + d]; s1 += Qs[r * AT_LD + 64 + d] * Ks[j * AT_LD + 64 + d]; }
            s0 *= 0.125f; s1 *= 0.125f;
            float mn = fmaxf(m0, s0); l0 = l0 * expf(m0 - mn) + expf(s0 - mn); m0 = mn;
            mn = fmaxf(m1, s1); l1 = l1 * expf(m1 - mn) + expf(s1 - mn); m1 = mn; }
    }
#pragma unroll
    for (int o = 1; o < 4; o <<= 1) {
        float mo = __shfl_xor(m0, o), lo = __shfl_xor(l0, o); float mn = fmaxf(m0, mo); l0 = l0 * expf(m0 - mn) + lo * expf(mo - mn); m0 = mn;
        mo = __shfl_xor(m1, o); lo = __shfl_xor(l1, o); mn = fmaxf(m1, mo); l1 = l1 * expf(m1 - mn) + lo * expf(mo - mn); m1 = mn; }
    const float il0 = 1.f / l0, il1 = lam / l1;
    float o[32];
#pragma unroll
    for (int i = 0; i < 32; ++i) o[i] = 0.f;
    for (int kc = 0; kc <= qc; ++kc) {
        __syncthreads();
        at_load_rope(Ks, proj, b * 8192 + kc * 64, 512 + h * 128, ropec, ropes, kc * 64, tid);
        for (int i = 0; i < 32; ++i) { const int idx = tid + 256 * i, row = idx >> 7, col = idx & 127; Vs[row * AT_LD + col] = bf2f(proj[(size_t)(b * 8192 + kc * 64 + row) * 5632 + 1024 + h * 128 + col]); }
        __syncthreads();
        for (int i = 0; i < 16; ++i) { const int j = 4 * i + qd; float s0 = 0.f, s1 = 0.f;
            for (int d = 0; d < 64; ++d) { s0 += Qs[r * AT_LD + d] * Ks[j * AT_LD + d]; s1 += Qs[r * AT_LD + 64 + d] * Ks[j * AT_LD + 64 + d]; }
            s0 *= 0.125f; s1 *= 0.125f;
            As[r * 65 + j] = expf(s0 - m0) * il0 - expf(s1 - m1) * il1; }
        __syncthreads();
        for (int j = 0; j < 64; ++j) { const float av = As[r * 65 + j];
#pragma unroll
            for (int dv = 0; dv < 32; ++dv) o[dv] += av * Vs[j * AT_LD + 32 * qd + dv]; }
    }
    float ss = 0.f;
#pragma unroll
    for (int i = 0; i < 32; ++i) ss += o[i] * o[i];
    ss += __shfl_xor(ss, 1); ss += __shfl_xor(ss, 2);
    const float rstd = rsqrtf(ss * (1.f / 128.f) + 1e-6f);
#pragma unroll
    for (int i = 0; i < 32; ++i) { const int dv = 32 * qd + i; ya[(size_t)(tokq + r) * 512 + h * 128 + dv] = f2bf(o[i] * rstd * subln[dv] * 0.8f); }
}

__global__ void __launch_bounds__(256) k_hgA(const bf16_t* proj, const float* scal, bf16_t* ds, float* dec) {
    extern __shared__ float sm[];
    float* G = sm; float* V = sm + 64 * 128;
    const int n = blockIdx.x, h = blockIdx.y, b = blockIdx.z, tid = threadIdx.x, tok0 = b * 8192 + n * 64, bh = b * 4 + h;
    for (int i = 0; i < 32; ++i) { const int idx = tid + 256 * i, c = idx >> 7, d = idx & 127; const bf16_t* pr = proj + (size_t)(tok0 + c) * 5632 + h * 128 + d;
        const float lb = scal[64 + h * 128 + d]; const float f = lb + (1.f - lb) * sigm(bf2f(pr[2048])); G[c * 128 + d] = f; V[c * 128 + d] = bf2f(pr[2560]); }
    __syncthreads();
    float kk[64]; float glast = 0.f; const int d = tid & 127, vb = (tid >> 7) * 64;
    {
        float g = 0.f;
#pragma unroll
        for (int c = 0; c < 64; ++c) { const float f = G[c * 128 + d]; g += logf(f); kk[c] = g; }
        glast = g;
#pragma unroll
        for (int c = 0; c < 64; ++c) { const float f = G[c * 128 + d]; kk[c] = (1.f - f) * expf(glast - kk[c]); }
    }
    if (tid < 128) dec[(size_t)(bh * 128 + n) * 128 + d] = expf(glast);
    for (int v0 = 0; v0 < 64; v0 += 16) {
        float acc[16];
#pragma unroll
        for (int i = 0; i < 16; ++i) acc[i] = 0.f;
#pragma unroll
        for (int c = 0; c < 64; ++c) {
#pragma unroll
            for (int i = 0; i < 16; ++i) acc[i] += kk[c] * V[c * 128 + vb + v0 + i]; }
#pragma unroll
        for (int i = 0; i < 16; ++i) ds[((size_t)(bh * 128 + n) * 128 + d) * 128 + vb + v0 + i] = f2bf(acc[i]);
    }
}
__global__ void __launch_bounds__(256) k_scan(const bf16_t* ds, const float* dec, bf16_t* sp) {
    const int gid = blockIdx.x * 256 + threadIdx.x; const int bh = gid >> 14, d = (gid >> 7) & 127, v = gid & 127;
    float st = 0.f;
    for (int n = 0; n < 128; ++n) { const size_t o = ((size_t)(bh * 128 + n) * 128 + d) * 128 + v; const float x = bf2f(ds[o]); sp[o] = f2bf(st); st = dec[(size_t)(bh * 128 + n) * 128 + d] * st + x; }
}
constexpr int HC_LDS = (2 * 64 * 129 + 64 * 128 + 64 * 65) * 4;
__global__ void __launch_bounds__(256) k_hgC(const bf16_t* proj, const float* scal, const bf16_t* sp, const float* hgnorm, bf16_t* yb) {
    extern __shared__ float sm[];
    float* QT = sm; float* KT = QT + 64 * 129; float* V = KT + 64 * 129; float* As = V + 64 * 128;
    const int n = blockIdx.x, h = blockIdx.y, b = blockIdx.z, tid = threadIdx.x, tok0 = b * 8192 + n * 64, bh = b * 4 + h;
    for (int i = 0; i < 32; ++i) { const int idx = tid + 256 * i, c = idx >> 7, d = idx & 127; const bf16_t* pr = proj + (size_t)(tok0 + c) * 5632 + h * 128 + d;
        const float lb = scal[64 + h * 128 + d]; const float f = lb + (1.f - lb) * sigm(bf2f(pr[2048])); const float q = bf2f(pr[1536]);
        QT[c * 129 + d] = q * sigm(q); KT[c * 129 + d] = f; V[c * 128 + d] = bf2f(pr[2560]); }
    __syncthreads();
    if (tid < 128) { float g = 0.f; for (int c = 0; c < 64; ++c) { const float f = KT[c * 129 + tid]; g += logf(f); QT[c * 129 + tid] *= expf(g); KT[c * 129 + tid] = (1.f - f) * expf(-g); } }
    __syncthreads();
    const int c = tid >> 2, q4 = tid & 3;
    for (int i = 0; i < 16; ++i) { const int s = 4 * i + q4; float a = 0.f;
        if (s <= c) { for (int d = 0; d < 128; ++d) a += QT[c * 129 + d] * KT[s * 129 + d]; }
        As[c * 65 + s] = a; }
    __syncthreads();
    float o[32];
#pragma unroll
    for (int i = 0; i < 32; ++i) o[i] = 0.f;
    for (int s = 0; s < 64; ++s) { const float a = As[c * 65 + s];
#pragma unroll
        for (int i = 0; i < 32; ++i) o[i] += a * V[s * 128 + 32 * q4 + i]; }
    const bf16_t* spb = sp + (size_t)(bh * 128 + n) * 128 * 128;
    for (int d = 0; d < 128; ++d) { const float qv = QT[c * 129 + d];
#pragma unroll
        for (int i = 0; i < 32; ++i) o[i] += qv * bf2f(spb[d * 128 + 32 * q4 + i]); }
    float ss = 0.f;
#pragma unroll
    for (int i = 0; i < 32; ++i) ss += o[i] * o[i];
    ss += __shfl_xor(ss, 1); ss += __shfl_xor(ss, 2);
    const float rstd = rsqrtf(ss * (1.f / 128.f) + 1e-6f);
#pragma unroll
    for (int i = 0; i < 32; ++i) { const int v = 32 * q4 + i; const float g = bf2f(proj[(size_t)(tok0 + c) * 5632 + 3072 + h * 128 + v]);
        yb[(size_t)(tok0 + c) * 512 + h * 128 + v] = f2bf(o[i] * rstd * hgnorm[v] * (g * sigm(g))); }
}
__global__ void __launch_bounds__(256) k_x1(const float* x, const float* y, const float* w, const float* mod, long long goff, float* x1) {
    const int row = blockIdx.x * 4 + (threadIdx.x >> 6), lane = threadIdx.x & 63, b = row >> 13;
    const float* yr = y + (size_t)row * 1024; float v[16]; float ss = 0.f;
#pragma unroll
    for (int j = 0; j < 16; ++j) { v[j] = yr[lane + 64 * j]; ss += v[j] * v[j]; }
    ss = wave_sum(ss); const float rstd = rsqrtf(ss * (1.f / 1024.f) + 1e-6f);
#pragma unroll
    for (int j = 0; j < 16; ++j) { const int col = lane + 64 * j; x1[(size_t)row * 1024 + col] = x[(size_t)row * 1024 + col] + mod[b * 6144 + goff + col] * v[j] * rstd * w[col]; }
}
__global__ void __launch_bounds__(256) k_route(const float* x1, const float* w, const float* mod, const float* rw, const float* rb, int* topi, float* topw) {
    const int row = blockIdx.x * 4 + (threadIdx.x >> 6), lane = threadIdx.x & 63, b = row >> 13;
    const float* xr = x1 + (size_t)row * 1024; float v[16]; float ss = 0.f;
#pragma unroll
    for (int j = 0; j < 16; ++j) { v[j] = xr[lane + 64 * j]; ss += v[j] * v[j]; }
    ss = wave_sum(ss); const float rstd = rsqrtf(ss * (1.f / 1024.f) + 1e-6f);
    float lg[32];
#pragma unroll
    for (int e = 0; e < 32; ++e) lg[e] = 0.f;
#pragma unroll
    for (int j = 0; j < 16; ++j) { const int col = lane + 64 * j; const float h = v[j] * rstd * w[col] * (1.f + mod[b * 6144 + 4096 + col]) + mod[b * 6144 + 3072 + col];
#pragma unroll
        for (int e = 0; e < 32; ++e) lg[e] += h * rw[col * 32 + e]; }
#pragma unroll
    for (int e = 0; e < 32; ++e) lg[e] = wave_sum(lg[e]) + rb[e];
    int bi[4]; float bv[4];
#pragma unroll
    for (int k = 0; k < 4; ++k) { float best = -3.0e38f; int be = 0;
#pragma unroll
        for (int e = 0; e < 32; ++e) { bool taken = false;
#pragma unroll
            for (int q = 0; q < 4; ++q) if (q < k && bi[q] == e) taken = true;
            if (!taken && lg[e] > best) { best = lg[e]; be = e; } }
        bi[k] = be; bv[k] = best; }
    const float e1 = expf(bv[1] - bv[0]), e2 = expf(bv[2] - bv[0]), e3 = expf(bv[3] - bv[0]); const float inv = 1.f / (1.f + e1 + e2 + e3);
    if (lane == 0) { topi[row * 4 + 0] = bi[0]; topi[row * 4 + 1] = bi[1]; topi[row * 4 + 2] = bi[2]; topi[row * 4 + 3] = bi[3];
        topw[row * 4 + 0] = inv; topw[row * 4 + 1] = e1 * inv; topw[row * 4 + 2] = e2 * inv; topw[row * 4 + 3] = e3 * inv; }
}
__global__ void __launch_bounds__(256) k_lists(const int* topi, int* cnt, int* list) {
    const int a = blockIdx.x * 256 + threadIdx.x; const int e = topi[a]; const int pos = atomicAdd(&cnt[e], 1); list[(size_t)e * 32768 + pos] = a;
}
__global__ void k_pads(const int* cnt, int* pads) { if (threadIdx.x == 0) { int s = 0; for (int e = 0; e < 32; ++e) { pads[e] = s; s += ((cnt[e] + 255) / 256) * 256; } } }
__global__ void __launch_bounds__(256) k_final(float* out, const bf16_t* ym, const float* topw, const float* w, const float* mod) {
    const int row = blockIdx.x * 4 + (threadIdx.x >> 6), lane = threadIdx.x & 63, b = row >> 13;
    float v[16]; float ss = 0.f; const float w0 = topw[row * 4], w1 = topw[row * 4 + 1], w2 = topw[row * 4 + 2], w3 = topw[row * 4 + 3];
    const bf16_t* y0 = ym + (size_t)row * 4096;
#pragma unroll
    for (int j = 0; j < 16; ++j) { const int col = lane + 64 * j; v[j] = w0 * bf2f(y0[col]) + w1 * bf2f(y0[1024 + col]) + w2 * bf2f(y0[2048 + col]) + w3 * bf2f(y0[3072 + col]); ss += v[j] * v[j]; }
    ss = wave_sum(ss); const float rstd = rsqrtf(ss * (1.f / 1024.f) + 1e-6f);
#pragma unroll
    for (int j = 0; j < 16; ++j) { const int col = lane + 64 * j; out[(size_t)row * 1024 + col] += mod[b * 6144 + 5120 + col] * v[j] * rstd * w[col]; }
}
}
#define GAS __attribute__((address_space(1)))
#define LAS __attribute__((address_space(3)))
typedef GAS unsigned gu32;
#define RLX_AGENT __ATOMIC_RELAXED, __HIP_MEMORY_SCOPE_AGENT
#define XB_TMO      128
#define XB_XCNT(j)  (256  + 64 * (j))
#define XB_XSUB(j)  (1280 + 64 * (j))
#define XB_XGEN(j)  (2304 + 64 * (j))
#define XB_TOP      3328
#define XB_TOPGEN   3392
#define XCD_BAR_WORDS 3456
#define XB_SPIN_CAP (1u << 22)

__device__ __forceinline__ unsigned xb_ld(unsigned* p)              { return __hip_atomic_load(p, __ATOMIC_RELAXED, __HIP_MEMORY_SCOPE_AGENT); }
__device__ __forceinline__ unsigned xb_add(unsigned* p, unsigned v) { return __hip_atomic_fetch_add(p, v, __ATOMIC_RELAXED, __HIP_MEMORY_SCOPE_AGENT); }
__device__ __forceinline__ unsigned xb_xcc_id() { return (unsigned)__builtin_amdgcn_s_getreg((3 << 11) | 20) & 0xFu; }
#define XB_SPIN(cond, bar) do { unsigned _sp = 0; while (cond) { __builtin_amdgcn_s_sleep(1); \
    if ((++_sp & 255u) == 0u) { if (xb_ld(&(bar)[XB_TMO])) break; if (_sp > XB_SPIN_CAP) { atomicAdd(&(bar)[XB_TMO], 1u); break; } } } } while (0)

struct XcdBarrier {
    unsigned* bar; unsigned x;
    volatile LAS unsigned* st;
};
__device__ __forceinline__ XcdBarrier xcd_barrier_post(unsigned* bar, volatile LAS unsigned* st) {
    XcdBarrier b; b.bar = bar; b.x = xb_xcc_id(); b.st = st;
    if (threadIdx.x == 0) (void)xb_add(&bar[XB_XCNT(b.x)], 1u);
    return b;
}
__device__ __forceinline__ void xcd_barrier_complete(unsigned* bar, unsigned x, unsigned& nloc, unsigned& nx) {
    const unsigned G = gridDim.x * gridDim.y * gridDim.z;
    unsigned sum, cnt, mine, sp = 0u;
    for (;;) {
        sum = 0u; cnt = 0u; mine = 0u;
#pragma unroll
        for (unsigned j = 0; j < 16; ++j) { const unsigned c = xb_ld(&bar[XB_XCNT(j)]); sum += c; cnt += (c > 0u) ? 1u : 0u; mine = (j == x) ? c : mine; }
        if (sum == G) break;
        __builtin_amdgcn_s_sleep(1);
        if ((++sp & 255u) == 0u) { if (xb_ld(&bar[XB_TMO])) break; if (sp > XB_SPIN_CAP) { atomicAdd(&bar[XB_TMO], 1u); break; } }
    }
    nloc = mine > 0u ? mine : 1u; nx = cnt > 0u ? cnt : 1u;
}
__device__ __forceinline__ void xcd_barrier(const XcdBarrier& b) {
    asm volatile("s_waitcnt vmcnt(0)" ::: "memory");
    __syncthreads();
    if (threadIdx.x == 0) {
        unsigned* bar = b.bar;
        __builtin_amdgcn_s_waitcnt(0);
        unsigned nloc = b.st[0], nx = b.st[1];
        if (nloc == 0u) { xcd_barrier_complete(bar, b.x, nloc, nx); b.st[0] = nloc; b.st[1] = nx; }
        const unsigned old = xb_add(&bar[XB_XSUB(b.x)], 1u);
        const unsigned gen = old / nloc;
        if (old + 1u == (gen + 1u) * nloc) {
            __builtin_amdgcn_fence(__ATOMIC_RELEASE, "agent");
            asm volatile("s_waitcnt vmcnt(0)" ::: "memory");
            const unsigned og = xb_add(&bar[XB_TOP], 1u);
            const unsigned tg = og / nx;
            if (og + 1u == (tg + 1u) * nx) xb_add(&bar[XB_TOPGEN], 1u);
            else XB_SPIN(xb_ld(&bar[XB_TOPGEN]) == tg, bar);
            __builtin_amdgcn_fence(__ATOMIC_ACQUIRE, "agent");
            xb_add(&bar[XB_XGEN(b.x)], 1u);
            asm volatile("s_waitcnt vmcnt(0)" ::: "memory");
        } else {
            XB_SPIN(xb_ld(&bar[XB_XGEN(b.x)]) == gen, bar);
            __builtin_amdgcn_fence(__ATOMIC_ACQUIRE, "agent");
            asm volatile("s_waitcnt vmcnt(0)" ::: "memory");
        }
    }
    __syncthreads();
}
namespace pg8 {
#define PG8_LAS __attribute__((address_space(3)))
typedef short bf16x8 __attribute__((ext_vector_type(8)));
typedef float f32x4 __attribute__((ext_vector_type(4)));
typedef float f32x2 __attribute__((ext_vector_type(2)));
typedef unsigned u32x4 __attribute__((ext_vector_type(4)));
typedef unsigned u32x2 __attribute__((ext_vector_type(2)));
constexpr int BM = 256, BK = 64, HALF = 128, HTB = HALF * BK * 2  , STAGE_BYTES = 8 * HTB, NXCD = 8, WGM = 8;

__host__ __device__ __forceinline__ int lds_byte(int r, int c) { const int st = (r >> 4) * 2 + (c >> 5), rr = r & 15, cc = c & 31, ob = rr * 64 + cc * 2; return st * 1024 + (ob ^ (((ob >> 9) & 1) << 5)); }
__host__ __device__ __forceinline__ void stage_rc(int b, int& R, int& C) { const int st = b / 1024, sb = b % 1024, swz = sb ^ (((sb >> 9) & 1) << 5); R = (st >> 1) * 16 + swz / 64; C = (st & 1) * 32 + (swz % 64) / 2; }
__host__ __device__ __forceinline__ int perm32(int rho) { const int n = rho >> 4, i = rho & 15; return 8 * (i >> 2) + 4 * n + (i & 3); }

struct Unit { int pm, pn, z, arow, brow; };
struct Gemm { const bf16_t* A; const bf16_t* Bt; int K; };

struct DenseOrder {
    int nM, nN, nwg, G, c;
    __device__ void init(int M, int N, int G_, int c_) { nM = M / BM; nN = N / BM; nwg = nM * nN; G = G_; c = c_; }
    __device__ bool next(int i, Unit& u) const {
        const long L = (long)i * G + c; if (L >= nwg) return false;
        int wgid = (int)L; { const int q = nwg / NXCD, r = nwg % NXCD, xcd = wgid % NXCD, off = wgid / NXCD; wgid = (xcd < r ? xcd * (q + 1) : r * (q + 1) + (xcd - r) * q) + off; }
        const int nig = WGM * nN, gid = wgid / nig, fm = gid * WGM, gsz = (nM - fm) < WGM ? (nM - fm) : WGM;
        u.pm = fm + ((wgid % nig) % gsz); u.pn = (wgid % nig) / gsz; u.z = 0; u.arow = u.pm * BM; u.brow = u.pn * BM; return true;
    }
    __device__ __forceinline__ unsigned row_off(const Unit&, int) const { return 0u; }
};

__device__ __forceinline__ unsigned cvt_pk_bf16(float lo, float hi) { unsigned r; asm volatile("v_cvt_pk_bf16_f32 %0, %1, %2" : "=v"(r) : "v"(lo), "v"(hi)); return r; }


template <class Epi, class Sched, bool GATHER>
__device__ __forceinline__ void gemm_phase(PG8_LAS unsigned char* lds, const Gemm g, const Sched& S, const Epi& E) {
    int tid_ = threadIdx.x; asm volatile("" : "+v"(tid_));
    const int tid = tid_, wid = __builtin_amdgcn_readfirstlane(tid >> 6), lane = tid & 63, wr = wid >> 2, wc = wid & 3, fr = lane & 15, fq = lane >> 4;
    const int K = g.K, nt = K / BK;
    unsigned voffA[2], voffB[2]; int RA[2];
#pragma unroll
    for (int i = 0; i < 2; ++i) { int R, C; stage_rc(tid * 16 + i * 8192, R, C); const int Rb = Epi::PERM ? ((R & ~31) + perm32(R & 31)) : R;
        RA[i] = R; voffA[i] = GATHER ? (unsigned)(C * 2) : (unsigned)(R * K + C) * 2u; voffB[i] = (unsigned)(Rb * K + C) * 2u; }
    const size_t kstep = (size_t)(BK * 2);
    const size_t hstep = (size_t)HALF * K * 2;
    const unsigned ldsw = (unsigned)wid * 1024u;
    const int aoff = lds_byte(wr * 64 + fr, fq * 8), boff = lds_byte(wc * 32 + fr, fq * 8);
    unsigned gAc[2][2], gAn[2][2];
#define PG8_SA(b, h) (((b) * 2 + (h)) * HTB)
#define PG8_SB(b, h) ((4 + (b) * 2 + (h)) * HTB)
#define PG8_STAGE(bufoff, gbase, voff) do { _Pragma("unroll") for (int _i = 0; _i < 2; ++_i) \
        __builtin_amdgcn_global_load_lds((const unsigned*)((const char*)(gbase) + (voff)[_i]), (PG8_LAS unsigned*)(lds + (bufoff) + ldsw + _i * 8192), 16, 0, 0); } while (0)
#define PG8_STAGEA(bufoff, gbase, h, nx) do { if constexpr (GATHER) { _Pragma("unroll") for (int _i = 0; _i < 2; ++_i) { const unsigned _v = ((nx) ? gAn[h][_i] : gAc[h][_i]) + voffA[_i]; \
        __builtin_amdgcn_global_load_lds((const unsigned*)((const char*)(gbase) + _v), (PG8_LAS unsigned*)(lds + (bufoff) + ldsw + _i * 8192), 16, 0, 0); } } \
        else { PG8_STAGE(bufoff, (const char*)(gbase) + (h) * hstep, voffA); } } while (0)
#define PG8_LDA(dst, b, h) do { _Pragma("unroll") for (int m = 0; m < 4; ++m) _Pragma("unroll") for (int k = 0; k < 2; ++k) dst[m][k] = *(const PG8_LAS bf16x8*)(lds + PG8_SA(b, h) + aoff + m * 2048 + k * 1024); } while (0)
#define PG8_LDB(dst, b, h) do { _Pragma("unroll") for (int n = 0; n < 2; ++n) _Pragma("unroll") for (int k = 0; k < 2; ++k) dst[n][k] = *(const PG8_LAS bf16x8*)(lds + PG8_SB(b, h) + boff + n * 2048 + k * 1024); } while (0)
#define PG8_MMA(ai, bj, At, Bt) do { __builtin_amdgcn_s_setprio(1); _Pragma("unroll") for (int m = 0; m < 4; ++m) _Pragma("unroll") for (int n = 0; n < 2; ++n) _Pragma("unroll") for (int k = 0; k < 2; ++k) \
        acc[ai][bj][m][n] = __builtin_amdgcn_mfma_f32_16x16x32_bf16(Bt[n][k], At[m][k], acc[ai][bj][m][n], 0, 0, 0); __builtin_amdgcn_s_setprio(0); } while (0)
#define PG8_WAIT_V(n) asm volatile("s_waitcnt vmcnt(" #n ")" ::: "memory")
#define PG8_WAIT_L(n) asm volatile("s_waitcnt lgkmcnt(" #n ")" ::: "memory")
#define PG8_BAR __builtin_amdgcn_s_barrier()
#define PG8_SCHED __builtin_amdgcn_sched_barrier(0)
    Unit cur, nxt; int ui = 0;
    if (!S.next(0, cur)) return;
    f32x4 acc[2][2][4][2];
#pragma unroll
    for (int a = 0; a < 2; ++a)
#pragma unroll
        for (int b = 0; b < 2; ++b)
#pragma unroll
            for (int m = 0; m < 4; ++m)
#pragma unroll
                for (int n = 0; n < 2; ++n) acc[a][b][m][n] = (f32x4){0.f, 0.f, 0.f, 0.f};
    bf16x8 At[4][2], B0[2][2], B1[2][2];
    const char* cA = GATHER ? (const char*)g.A : (const char*)g.A + (size_t)cur.arow * K * 2; const char* cB = (const char*)g.Bt + (size_t)cur.brow * K * 2;
    if constexpr (GATHER) {
#pragma unroll
        for (int h = 0; h < 2; ++h)
#pragma unroll
            for (int i = 0; i < 2; ++i) { gAc[h][i] = S.row_off(cur, h * HALF + RA[i]); gAn[h][i] = gAc[h][i]; }
    }
    PG8_STAGE(PG8_SB(0, 0), cB, voffB); PG8_STAGE(PG8_SB(0, 1), cB + hstep, voffB); PG8_STAGEA(PG8_SA(0, 0), cA, 0, false); PG8_STAGEA(PG8_SA(0, 1), cA, 1, false);
    if (wr == 1) PG8_BAR;
    PG8_WAIT_V(2); PG8_BAR;
    PG8_STAGE(PG8_SB(1, 0), cB + kstep, voffB); PG8_STAGEA(PG8_SA(1, 0), cA + kstep, 0, false); PG8_STAGE(PG8_SB(1, 1), cB + hstep + kstep, voffB);
    PG8_WAIT_V(6); PG8_BAR;
    for (;;) {
        const bool has_next = S.next(ui + 1, nxt);
        const char* nA = has_next ? (GATHER ? (const char*)g.A : (const char*)g.A + (size_t)nxt.arow * K * 2) : cA; const char* nB = has_next ? (const char*)g.Bt + (size_t)nxt.brow * K * 2 : cB;
        if constexpr (GATHER) { if (has_next) {
#pragma unroll
            for (int h = 0; h < 2; ++h)
#pragma unroll
                for (int i = 0; i < 2; ++i) gAn[h][i] = S.row_off(nxt, h * HALF + RA[i]); } }
        for (int t = 0; t < nt; t += 2) {
            const bool last = (t == nt - 2);
            const char* a1 = cA + (size_t)(t + 1) * kstep;
            const char* a2 = last ? nA : cA + (size_t)(t + 2) * kstep; const char* b2 = last ? nB : cB + (size_t)(t + 2) * kstep;
            const char* a3 = a2 + kstep; const char* b3 = b2 + kstep;
            PG8_LDB(B0, 0, 0); PG8_LDB(B1, 0, 1); PG8_SCHED; PG8_LDA(At, 0, 0); PG8_STAGEA(PG8_SA(1, 1), a1, 1, false);
            PG8_WAIT_V(8); PG8_WAIT_L(0); PG8_BAR; PG8_MMA(0, 0, At, B0); PG8_MMA(0, 1, At, B1); PG8_BAR; PG8_SCHED;
            PG8_LDA(At, 0, 1); PG8_STAGE(PG8_SB(0, 0), b2, voffB); PG8_STAGE(PG8_SB(0, 1), b2 + hstep, voffB); PG8_STAGEA(PG8_SA(0, 0), a2, 0, last);
            PG8_WAIT_V(8); PG8_WAIT_L(0); PG8_BAR; PG8_MMA(1, 0, At, B0); PG8_MMA(1, 1, At, B1); PG8_BAR; PG8_SCHED;
            PG8_LDB(B0, 1, 0); PG8_LDB(B1, 1, 1); PG8_SCHED; PG8_LDA(At, 1, 0); PG8_STAGEA(PG8_SA(0, 1), a2, 1, last);
            PG8_WAIT_V(8); PG8_WAIT_L(0); PG8_BAR; PG8_MMA(0, 0, At, B0); PG8_MMA(0, 1, At, B1); PG8_BAR; PG8_SCHED;
            PG8_LDA(At, 1, 1); PG8_STAGE(PG8_SB(1, 0), b3, voffB); PG8_STAGE(PG8_SB(1, 1), b3 + hstep, voffB); PG8_STAGEA(PG8_SA(1, 0), a3, 0, last);
            PG8_WAIT_V(8); PG8_WAIT_L(0); PG8_BAR; PG8_MMA(1, 0, At, B0); PG8_MMA(1, 1, At, B1); PG8_BAR; PG8_SCHED;
        }
        if (wr == 0) PG8_BAR;
        E(acc, cur, wr, wc, fr, fq);
        if (!has_next) break;
#pragma unroll
        for (int a = 0; a < 2; ++a)
#pragma unroll
            for (int b = 0; b < 2; ++b)
#pragma unroll
                for (int m = 0; m < 4; ++m)
#pragma unroll
                    for (int n = 0; n < 2; ++n) acc[a][b][m][n] = (f32x4){0.f, 0.f, 0.f, 0.f};
        cur = nxt; cA = nA; cB = nB; ++ui;
        if constexpr (GATHER) {
#pragma unroll
            for (int h = 0; h < 2; ++h)
#pragma unroll
                for (int i = 0; i < 2; ++i) gAc[h][i] = gAn[h][i];
        }
        if (wr == 1) PG8_BAR;
    }
    PG8_WAIT_V(0);
    PG8_BAR;
#undef PG8_SA
#undef PG8_SB
#undef PG8_STAGE
#undef PG8_STAGEA
#undef PG8_LDA
#undef PG8_LDB
#undef PG8_MMA
#undef PG8_WAIT_V
#undef PG8_WAIT_L
#undef PG8_BAR
#undef PG8_SCHED
}
}
namespace at {
typedef short bf16x8 __attribute__((ext_vector_type(8)));
typedef short s16x4 __attribute__((ext_vector_type(4)));
typedef float f32x16 __attribute__((ext_vector_type(16)));
typedef unsigned u32x4 __attribute__((ext_vector_type(4)));
typedef __attribute__((address_space(3))) const char* lds_cptr;
typedef short v4i16_t __attribute__((ext_vector_type(4)));
constexpr int SLOT = 32768, L_WSF = 3 * SLOT;
constexpr float C2 = 0.125f * 1.4426950408889634f;
__device__ __forceinline__ int crow(int r, int hi) { return (r & 3) + 8 * (r >> 2) + 4 * hi; }
__device__ __forceinline__ void glds16(const void* gsrc, unsigned lds_dst) { unsigned keep;
    asm volatile("s_mov_b32 %0, m0\n\ts_mov_b32 m0, %2\n\ts_nop 0\n\tglobal_load_lds_dwordx4 %1, off\n\ts_mov_b32 m0, %0" : "=&s"(keep) : "v"(gsrc), "s"(lds_dst) : "memory"); }
typedef float f32x2_t __attribute__((ext_vector_type(2))); typedef __bf16 bf16x2_t __attribute__((ext_vector_type(2)));
__device__ __forceinline__ unsigned cvtpk(float lo, float hi) { f32x2_t v = {lo, hi}; bf16x2_t b = __builtin_convertvector(v, bf16x2_t); return __builtin_bit_cast(unsigned, b); }
__device__ __forceinline__ s16x4 vtr(lds_cptr p) { return __builtin_bit_cast(s16x4, __builtin_amdgcn_ds_read_tr16_b64_v4i16((__attribute__((address_space(3))) v4i16_t*)p)); }
#define AT_WAIT_BAR(N) asm volatile("s_waitcnt vmcnt(" #N ") lgkmcnt(0)\n\ts_barrier" ::: "memory")

__device__ __forceinline__ void attn_unit(__attribute__((address_space(3))) unsigned char* lds, const bf16_t* QKR, const bf16_t* PROJ, bf16_t* YA, const float* subln, float lam,
                                          int b, int h, int blk, int tid) {
    typedef __attribute__((address_space(3))) float lds_f;
    const int lane = tid & 63, r32 = lane & 31, hi = lane >> 5; const int w = __builtin_amdgcn_readfirstlane(tid >> 6), m = w & 1, rg = w >> 1;
    const int NT = 2 * blk + 2, my_nt = (rg < 2) ? NT - 1 : NT;
    const size_t tokb = (size_t)b * 8192;
    const unsigned lds0 = (unsigned)(size_t)lds;
    const bf16_t* ksrc0 = QKR + (tokb + lane) * 1024 + 512 + h * 128 + (2 * w) * 8;
    const bf16_t* vsrc0 = PROJ + (tokb + ((2 * w) & 3) * 16 + (lane >> 2)) * 5632 + 1024 + h * 128 + (w >> 1) * 32 + (lane & 3) * 8;
#define AT_DMA(t, slotoff) do { const bf16_t* ks_ = ksrc0 + (size_t)(t) * 64 * 1024; const bf16_t* vs_ = vsrc0 + (size_t)(t) * 64 * 5632; \
        const unsigned kd_ = (unsigned)__builtin_amdgcn_readfirstlane(lds0 + (unsigned)(slotoff) + (unsigned)w * 2048u); \
        glds16(ks_, kd_); glds16(ks_ + 8, kd_ + 1024u); glds16(vs_, kd_ + 16384u); glds16(vs_ + 16 * 5632, kd_ + 16384u + 1024u); } while (0)
    AT_DMA(0, 0); AT_DMA(1, SLOT);
    bf16x8 qr[4];
    { const bf16_t* qp = QKR + (tokb + blk * 128 + rg * 32 + r32) * 1024 + h * 128 + m * 64 + hi * 8;
#pragma unroll
      for (int d0 = 0; d0 < 4; ++d0) qr[d0] = *(const bf16x8*)(qp + d0 * 16); }
    f32x16 o[4];
#pragma unroll
    for (int i = 0; i < 4; ++i) o[i] = f32x16{};
    float m_run = -1e30f, lsum = 0.f;
    lds_f* wsf = (lds_f*)(lds + L_WSF) + w * 32;
    int slot = 0, slot2 = 2 * SLOT;
    for (int t = 0; t < NT; ++t) {
        if (t + 1 < NT) { AT_WAIT_BAR(4); } else { AT_WAIT_BAR(0); }
        if (t + 2 < NT) AT_DMA(t + 2, slot2);
        if (t < my_nt) {
            const lds_cptr kp = (lds_cptr)(lds + slot) + (m * 8 + hi) * 1024 + r32 * 16;
            f32x16 p0 = f32x16{}, p1 = f32x16{};
#pragma unroll
            for (int d0 = 0; d0 < 4; ++d0) { const bf16x8 k0 = *(const __attribute__((address_space(3))) bf16x8*)(kp + d0 * 2048), k1 = *(const __attribute__((address_space(3))) bf16x8*)(kp + d0 * 2048 + 512);
                p0 = __builtin_amdgcn_mfma_f32_32x32x16_bf16(k0, qr[d0], p0, 0, 0, 0); p1 = __builtin_amdgcn_mfma_f32_32x32x16_bf16(k1, qr[d0], p1, 0, 0, 0); }
            float rm = fmaxf(p0[0], p1[0]);
#pragma unroll
            for (int r = 1; r < 16; ++r) rm = fmaxf(rm, fmaxf(p0[r], p1[r]));
            { auto rr = __builtin_amdgcn_permlane32_swap(__float_as_uint(rm), __float_as_uint(rm), false, false); rm = fmaxf(__uint_as_float(rr[0]), __uint_as_float(rr[1])); }
            if (__any(rm > m_run + 8.f)) {
                const float mn = fmaxf(m_run, rm); const float f = __builtin_amdgcn_exp2f(m_run - mn); lsum *= f; m_run = mn;
                if (hi == 0) wsf[r32] = f;
                asm volatile("s_waitcnt lgkmcnt(0)" ::: "memory");
#pragma unroll
                for (int r = 0; r < 16; ++r) { const float fr_ = wsf[crow(r, hi)];
#pragma unroll
                    for (int d = 0; d < 4; ++d) o[d][r] *= fr_; }
                asm volatile("s_waitcnt lgkmcnt(0)" ::: "memory");
            }
            float sacc = 0.f;
#pragma unroll
            for (int r = 0; r < 16; ++r) { p0[r] = __builtin_amdgcn_exp2f(p0[r] - m_run); p1[r] = __builtin_amdgcn_exp2f(p1[r] - m_run); sacc += p0[r] + p1[r]; }
            lsum += sacc;
            bf16x8 pa[4];
            pa[0] = __builtin_bit_cast(bf16x8, (u32x4){cvtpk(p0[0], p0[1]), cvtpk(p0[2], p0[3]), cvtpk(p0[4], p0[5]), cvtpk(p0[6], p0[7])});
            pa[1] = __builtin_bit_cast(bf16x8, (u32x4){cvtpk(p0[8], p0[9]), cvtpk(p0[10], p0[11]), cvtpk(p0[12], p0[13]), cvtpk(p0[14], p0[15])});
            pa[2] = __builtin_bit_cast(bf16x8, (u32x4){cvtpk(p1[0], p1[1]), cvtpk(p1[2], p1[3]), cvtpk(p1[4], p1[5]), cvtpk(p1[6], p1[7])});
            pa[3] = __builtin_bit_cast(bf16x8, (u32x4){cvtpk(p1[8], p1[9]), cvtpk(p1[10], p1[11]), cvtpk(p1[12], p1[13]), cvtpk(p1[14], p1[15])});
            const lds_cptr vp = (lds_cptr)(lds + slot + 16384) + ((lane >> 4) & 1) * 32 + (lane & 3) * 8 + (4 * hi + ((lane & 15) >> 2)) * 64;
#pragma unroll
            for (int d = 0; d < 4; ++d) {
#pragma unroll
                for (int ks = 0; ks < 4; ++ks) { const s16x4 lo_ = vtr(vp + d * 4096 + ks * 1024), hi_ = vtr(vp + d * 4096 + ks * 1024 + 512);
                    const bf16x8 vf = (bf16x8){lo_[0], lo_[1], lo_[2], lo_[3], hi_[0], hi_[1], hi_[2], hi_[3]};
                    o[d] = __builtin_amdgcn_mfma_f32_32x32x16_bf16(pa[ks], vf, o[d], 0, 0, 0); } }
        }
        slot = (slot == 2 * SLOT) ? 0 : slot + SLOT; slot2 = (slot2 == 2 * SLOT) ? 0 : slot2 + SLOT;
    }
    { auto rr = __builtin_amdgcn_permlane32_swap(__float_as_uint(lsum), __float_as_uint(lsum), false, false); lsum = __uint_as_float(rr[0]) + __uint_as_float(rr[1]); }
    if (hi == 0) wsf[r32] = (m == 0 ? 1.f : -lam) / lsum;
    asm volatile("s_waitcnt lgkmcnt(0)" ::: "memory");
#pragma unroll
    for (int r = 0; r < 16; ++r) { const float fr_ = wsf[crow(r, hi)];
#pragma unroll
        for (int d = 0; d < 4; ++d) o[d][r] *= fr_; }
    AT_WAIT_BAR(0);
    lds_f* X = (lds_f*)lds + rg * 4096;
    if (m == 1) {
#pragma unroll
        for (int d = 0; d < 4; ++d)
#pragma unroll
            for (int r = 0; r < 16; ++r) X[(d * 16 + r) * 64 + lane] = o[d][r];
    }
    AT_WAIT_BAR(0);
    if (m == 0) {
        float ssq[16];
#pragma unroll
        for (int r = 0; r < 16; ++r) { float s = 0.f;
#pragma unroll
            for (int d = 0; d < 4; ++d) { o[d][r] += X[(d * 16 + r) * 64 + lane]; s += o[d][r] * o[d][r]; }
            ssq[r] = s; }
#pragma unroll
        for (int r = 0; r < 16; ++r) { float s = ssq[r];
#pragma unroll
            for (int of = 1; of < 32; of <<= 1) s += __shfl_xor(s, of);
            ssq[r] = rsqrtf(s * (1.f / 128.f) + 1e-6f) * 0.8f; }
        float sw[4];
#pragma unroll
        for (int d = 0; d < 4; ++d) sw[d] = subln[d * 32 + r32];
        bf16_t* yp = YA + (tokb + blk * 128 + rg * 32) * 512 + h * 128 + r32;
#pragma unroll
        for (int r = 0; r < 16; ++r)
#pragma unroll
            for (int d = 0; d < 4; ++d) yp[(size_t)crow(r, hi) * 512 + d * 32] = f2bf(o[d][r] * ssq[r] * sw[d]);
    }
    AT_WAIT_BAR(0);
#undef AT_DMA
}
}
namespace hg {
using at::bf16x8; using at::s16x4; using at::f32x16; using at::u32x4; using at::lds_cptr; using at::crow; using at::vtr; using at::cvtpk;
typedef __attribute__((address_space(3))) unsigned char lds_u8;
typedef __attribute__((address_space(3))) float lds_f;
typedef __attribute__((address_space(3))) bf16_t lds_h;
__device__ __forceinline__ float sigm(float x) { return 1.f / (1.f + __expf(-x)); }
__device__ __forceinline__ bf16x8 mkfrag(s16x4 a, s16x4 b) { return (bf16x8){a[0], a[1], a[2], a[3], b[0], b[1], b[2], b[3]}; }
template <int ROWS>
__device__ __forceinline__ void copy_img(lds_u8* lds, int off, const bf16_t* g, size_t gp, int tid) {
#pragma unroll
    for (int i = 0; i < ROWS * 16 / 512; ++i) { const int p = tid + 512 * i, r = p >> 4, q = p & 15;
        const u32x4 v = *(const u32x4*)(g + (size_t)r * gp + q * 8);
        *(__attribute__((address_space(3))) u32x4*)(lds + off + (q >> 2) * (ROWS * 64) + r * 64 + (q & 3) * 16) = v; }
}
__device__ __forceinline__ void copy_raw(lds_u8* lds, int off, const bf16_t* g, size_t gp, int tid) {
#pragma unroll
    for (int i = 0; i < 2; ++i) { const int p = tid + 512 * i, r = p >> 4, q = p & 15;
        const u32x4 v = *(const u32x4*)(g + (size_t)r * gp + q * 8);
        *(__attribute__((address_space(3))) u32x4*)(lds + off + r * 256 + q * 16) = v; }
}
__device__ __forceinline__ void gates(lds_u8* lds, int psum_off, int rawf_off, float lb, int tid, float (&f)[16], float (&G)[16], float& glast) {
    const int d = tid & 127, part = tid >> 7; lds_f* psum = (lds_f*)(lds + psum_off); const lds_h* rf = (const lds_h*)(lds + rawf_off) + part * 16 * 128 + d;
    float g = 0.f;
#pragma unroll
    for (int i = 0; i < 16; ++i) { const float raw = bf2f(rf[i * 128]); f[i] = lb + (1.f - lb) * sigm(raw); g += __logf(f[i]); G[i] = g; }
    psum[part * 128 + d] = g;
    __syncthreads();
    const float p0 = psum[d], p1 = psum[128 + d], p2 = psum[256 + d], p3 = psum[384 + d];
    const float offs = (part > 0 ? p0 : 0.f) + (part > 1 ? p1 : 0.f) + (part > 2 ? p2 : 0.f);
    glast = (p0 + p1) + (p2 + p3);
#pragma unroll
    for (int i = 0; i < 16; ++i) G[i] += offs;
}
constexpr int A_KD = 0, A_V = 16384, A_PS = 32768, A_RAWF = 36864, A_OUT = 53248;
__device__ __forceinline__ void hgA_unit(lds_u8* lds, const bf16_t* PROJ, const float* SCAL, bf16_t* DS, float* DEC, int bh, int n, int tid) {
    const int h = bh & 3, b = bh >> 2, lane = tid & 63, r32 = lane & 31, hi = lane >> 5, w = __builtin_amdgcn_readfirstlane(tid >> 6), d = tid & 127, part = tid >> 7;
    const size_t tok0 = (size_t)b * 8192 + n * 64;
    __syncthreads();
    copy_img<64>(lds, A_V, PROJ + tok0 * 5632 + 2560 + h * 128, 5632, tid);
    copy_raw(lds, A_RAWF, PROJ + tok0 * 5632 + 2048 + h * 128, 5632, tid);
    __syncthreads();
    float f[16], G[16], glast;
    gates(lds, A_PS, A_RAWF, SCAL[64 + h * 128 + d], tid, f, G, glast);
    lds_h* kd = (lds_h*)(lds + A_KD) + (d >> 5) * 2048 + (d & 31);
#pragma unroll
    for (int i = 0; i < 16; ++i) kd[(part * 16 + i) * 32] = f2bf((1.f - f[i]) * __expf(glast - G[i]));
    if (part == 0) DEC[(size_t)(bh * 128 + n) * 128 + d] = __expf(glast);
    __syncthreads();
    const int dt = w >> 1, vh = w & 1;
    const int lof = ((lane >> 4) & 1) * 32 + (lane & 3) * 8 + (8 * hi + ((lane & 15) >> 2)) * 64;
    const lds_cptr ap = (lds_cptr)(lds + A_KD) + dt * 4096 + lof;
    f32x16 acc[2] = {f32x16{}, f32x16{}};
#pragma unroll
    for (int ks = 0; ks < 4; ++ks) { const bf16x8 af = mkfrag(vtr(ap + ks * 1024), vtr(ap + ks * 1024 + 256));
#pragma unroll
        for (int t = 0; t < 2; ++t) { const lds_cptr bp = (lds_cptr)(lds + A_V) + (2 * vh + t) * 4096 + lof;
            const bf16x8 bfr = mkfrag(vtr(bp + ks * 1024), vtr(bp + ks * 1024 + 256));
            acc[t] = __builtin_amdgcn_mfma_f32_32x32x16_bf16(af, bfr, acc[t], 0, 0, 0); } }
    lds_h* ot = (lds_h*)(lds + A_OUT) + (dt * 32) * 128 + vh * 64 + r32;
#pragma unroll
    for (int t = 0; t < 2; ++t)
#pragma unroll
        for (int r = 0; r < 16; ++r) ot[crow(r, hi) * 128 + t * 32] = f2bf(acc[t][r]);
    __syncthreads();
    bf16_t* dst = DS + (size_t)(bh * 128 + n) * 16384;
#pragma unroll
    for (int i = 0; i < 4; ++i) { const int p = tid + 512 * i; *(u32x4*)(dst + p * 8) = *(const __attribute__((address_space(3))) u32x4*)(lds + A_OUT + p * 16); }
}
constexpr int C_QT = 0, C_KT = 16384, C_V = 32768, C_SP = 49152, C_PS = 81920, C_RAWF = 86016, C_RAWQ = 102400, C_OT = 86016;
__device__ __forceinline__ void hgC_unit(lds_u8* lds, const bf16_t* PROJ, const float* SCAL, const bf16_t* SP, const float* hgnorm, bf16_t* YB, int bh, int n, int tid) {
    const int h = bh & 3, b = bh >> 2, lane = tid & 63, r32 = lane & 31, hi = lane >> 5, w = __builtin_amdgcn_readfirstlane(tid >> 6), d = tid & 127, part = tid >> 7;
    const size_t tok0 = (size_t)b * 8192 + n * 64;
    __syncthreads();
    copy_img<64>(lds, C_V, PROJ + tok0 * 5632 + 2560 + h * 128, 5632, tid);
    copy_img<128>(lds, C_SP, SP + (size_t)(bh * 128 + n) * 16384, 128, tid);
    copy_raw(lds, C_RAWF, PROJ + tok0 * 5632 + 2048 + h * 128, 5632, tid);
    copy_raw(lds, C_RAWQ, PROJ + tok0 * 5632 + 1536 + h * 128, 5632, tid);
    __syncthreads();
    { float f[16], G[16], glast;
      gates(lds, C_PS, C_RAWF, SCAL[64 + h * 128 + d], tid, f, G, glast);
      const lds_h* rq = (const lds_h*)(lds + C_RAWQ) + part * 16 * 128 + d;
      lds_h* qt = (lds_h*)(lds + C_QT) + (d >> 3) * 512 + (d & 7) + part * 16 * 8; lds_h* kt = (lds_h*)(lds + C_KT) + (d >> 3) * 512 + (d & 7) + part * 16 * 8;
#pragma unroll
      for (int i = 0; i < 16; ++i) { const float q = bf2f(rq[i * 128]); const float eg = __expf(G[i]);
          qt[i * 8] = f2bf(q * sigm(q) * eg); kt[i * 8] = f2bf((1.f - f[i]) / eg); } }
    __syncthreads();
    const int ct = w & 1, vb = w >> 1;
    bf16x8 qf[8];
    { const lds_cptr qp = (lds_cptr)(lds + C_QT) + hi * 1024 + (32 * ct + r32) * 16;
#pragma unroll
      for (int ks = 0; ks < 8; ++ks) qf[ks] = *(const __attribute__((address_space(3))) bf16x8*)(qp + ks * 2048); }
    f32x16 o = f32x16{};
#pragma unroll
    for (int sh = 0; sh < 2; ++sh) { if (sh <= ct) {
        const lds_cptr kp = (lds_cptr)(lds + C_KT) + hi * 1024 + (32 * sh + r32) * 16;
        f32x16 p = f32x16{};
#pragma unroll
        for (int ks = 0; ks < 8; ++ks) { const bf16x8 kf = *(const __attribute__((address_space(3))) bf16x8*)(kp + ks * 2048); p = __builtin_amdgcn_mfma_f32_32x32x16_bf16(kf, qf[ks], p, 0, 0, 0); }
        const int cc = 32 * ct + r32;
#pragma unroll
        for (int r = 0; r < 16; ++r) { const int s = 32 * sh + crow(r, hi); if (s > cc) p[r] = 0.f; }
        const bf16x8 pa0 = __builtin_bit_cast(bf16x8, (u32x4){cvtpk(p[0], p[1]), cvtpk(p[2], p[3]), cvtpk(p[4], p[5]), cvtpk(p[6], p[7])});
        const bf16x8 pa1 = __builtin_bit_cast(bf16x8, (u32x4){cvtpk(p[8], p[9]), cvtpk(p[10], p[11]), cvtpk(p[12], p[13]), cvtpk(p[14], p[15])});
        const lds_cptr vp = (lds_cptr)(lds + C_V) + vb * 4096 + ((lane >> 4) & 1) * 32 + (lane & 3) * 8 + (4 * hi + ((lane & 15) >> 2)) * 64 + sh * 2048;
        o = __builtin_amdgcn_mfma_f32_32x32x16_bf16(pa0, mkfrag(vtr(vp), vtr(vp + 512)), o, 0, 0, 0);
        o = __builtin_amdgcn_mfma_f32_32x32x16_bf16(pa1, mkfrag(vtr(vp + 1024), vtr(vp + 1024 + 512)), o, 0, 0, 0); } }
    { const lds_cptr sp = (lds_cptr)(lds + C_SP) + vb * 8192 + ((lane >> 4) & 1) * 32 + (lane & 3) * 8 + (8 * hi + ((lane & 15) >> 2)) * 64;
#pragma unroll
      for (int ks = 0; ks < 8; ++ks) o = __builtin_amdgcn_mfma_f32_32x32x16_bf16(qf[ks], mkfrag(vtr(sp + ks * 1024), vtr(sp + ks * 1024 + 256)), o, 0, 0, 0); }
    { lds_f* ot = (lds_f*)(lds + C_OT) + (32 * ct) * 128 + 32 * vb + r32;
#pragma unroll
      for (int r = 0; r < 16; ++r) ot[crow(r, hi) * 128] = o[r]; }
    __syncthreads();
    { const int c = tid >> 3, sg = tid & 7; const __attribute__((address_space(3))) at::u32x4* orow = (const __attribute__((address_space(3))) at::u32x4*)(lds + C_OT + c * 512 + sg * 64);
      float ov[16]; float ss = 0.f;
#pragma unroll
      for (int q = 0; q < 4; ++q) { const at::u32x4 t4 = orow[q]; ov[4 * q] = __uint_as_float(t4.x); ov[4 * q + 1] = __uint_as_float(t4.y); ov[4 * q + 2] = __uint_as_float(t4.z); ov[4 * q + 3] = __uint_as_float(t4.w); }
#pragma unroll
      for (int q = 0; q < 16; ++q) ss += ov[q] * ov[q];
      ss += __shfl_xor(ss, 1); ss += __shfl_xor(ss, 2); ss += __shfl_xor(ss, 4);
      const float rstd = rsqrtf(ss * (1.f / 128.f) + 1e-6f);
      const bf16_t* gp = PROJ + (tok0 + c) * 5632 + 3072 + h * 128 + sg * 16; const u32x4 g0 = *(const u32x4*)gp, g1 = *(const u32x4*)(gp + 8);
      const unsigned gw[8] = {g0.x, g0.y, g0.z, g0.w, g1.x, g1.y, g1.z, g1.w}; unsigned ow[8];
#pragma unroll
      for (int q = 0; q < 8; ++q) { const float ga = __uint_as_float(gw[q] << 16), gb = __uint_as_float(gw[q] & 0xffff0000u);
          const float ra = ov[2 * q] * rstd * hgnorm[sg * 16 + 2 * q] * (ga * sigm(ga)), rb = ov[2 * q + 1] * rstd * hgnorm[sg * 16 + 2 * q + 1] * (gb * sigm(gb));
          ow[q] = cvtpk(ra, rb); }
      bf16_t* dst = YB + (tok0 + c) * 512 + h * 128 + sg * 16; *(u32x4*)dst = (u32x4){ow[0], ow[1], ow[2], ow[3]}; *(u32x4*)(dst + 8) = (u32x4){ow[4], ow[5], ow[6], ow[7]}; }
}
}
namespace mk {
using pg8::f32x4; using pg8::u32x4; using pg8::u32x2; using pg8::Unit;
constexpr int NWAVES = 8, NTHR = 512;
constexpr int RING_BYTES = 131072, LDSCTL_OFF = RING_BYTES, LDS_BYTES = 147456;
constexpr int LW_BAR = 0, LW_TPRE = 16  , LW_CNT = 64  , LW_MISC = 128;
enum Phase { PH_PRO = 0, PH_H1, PH_G1, PH_ROPE_HGA, PH_ATT_SCAN, PH_HGC, PH_G2A, PH_G2B, PH_G3, PH_TOK, PH_G4, PH_G5, PH_FIN, PH_N };

struct Args {
    const float* in[25]; float* out; unsigned char* ws; int ph_lo, ph_hi, li, pad;
};

__device__ __forceinline__ float wave_sum(float v) {
#pragma unroll
    for (int o = 1; o < 64; o <<= 1) v += __shfl_xor(v, o);
    return v;
}
__device__ __forceinline__ float sigm(float x) { return 1.f / (1.f + __expf(-x)); }
__device__ __forceinline__ unsigned pk2(float lo, float hi) { return (unsigned)f2bf(lo) | ((unsigned)f2bf(hi) << 16); }

struct EpiBf16 {
    static constexpr bool PERM = true;
    bf16_t* O; int ldc;
    __device__ __forceinline__ void operator()(const f32x4 (&acc)[2][2][4][2], const Unit& u, int wr, int wc, int fr, int fq) const {
        const int row0 = u.pm * 256 + wr * 64 + fr, col0 = u.pn * 256 + wc * 32 + 8 * fq;
#pragma unroll
        for (int ai = 0; ai < 2; ++ai)
#pragma unroll
            for (int m = 0; m < 4; ++m) { bf16_t* rowp = O + (size_t)(row0 + ai * 128 + m * 16) * ldc + col0;
#pragma unroll
                for (int bj = 0; bj < 2; ++bj) { const f32x4 v0 = acc[ai][bj][m][0], v1 = acc[ai][bj][m][1]; u32x4 w; w.x = pk2(v0[0], v0[1]); w.y = pk2(v0[2], v0[3]); w.z = pk2(v1[0], v1[1]); w.w = pk2(v1[2], v1[3]);
                    *(u32x4*)(rowp + bj * 128) = w; } }
    }
};
struct EpiF32 {
    static constexpr bool PERM = false;
    float* O; int ldc;
    __device__ __forceinline__ void operator()(const f32x4 (&acc)[2][2][4][2], const Unit& u, int wr, int wc, int fr, int fq) const {
        const int row0 = u.pm * 256 + wr * 64 + fr, col0 = u.pn * 256 + wc * 32 + 4 * fq;
#pragma unroll
        for (int ai = 0; ai < 2; ++ai)
#pragma unroll
            for (int m = 0; m < 4; ++m) { float* rowp = O + (size_t)(row0 + ai * 128 + m * 16) * ldc + col0;
#pragma unroll
                for (int bj = 0; bj < 2; ++bj)
#pragma unroll
                    for (int n = 0; n < 2; ++n) *(f32x4*)(rowp + bj * 128 + n * 16) = acc[ai][bj][m][n]; }
    }
};
template <bool SECOND> struct EpiBranch {
    static constexpr bool PERM = false;
    float* tmp; const bf16_t* proj; bf16_t* merged;
    __device__ __forceinline__ void operator()(const f32x4 (&acc)[2][2][4][2], const Unit& u, int wr, int wc, int fr, int fq) const {
        const int row0 = u.pm * 256 + wr * 64 + fr, col0 = u.pn * 256 + wc * 32 + 4 * fq;
#pragma unroll
        for (int ai = 0; ai < 2; ++ai)
#pragma unroll
            for (int m = 0; m < 4; ++m) { const size_t row = (size_t)(row0 + ai * 128 + m * 16);
#pragma unroll
                for (int bj = 0; bj < 2; ++bj)
#pragma unroll
                    for (int n = 0; n < 2; ++n) { const int col = col0 + bj * 128 + n * 16; const f32x4 a = acc[ai][bj][m][n];
                        const u32x2 gw = *(const u32x2*)(proj + row * 5632 + (SECOND ? 4608 : 3584) + col);
                        f32x4 gt; gt[0] = sigm(__uint_as_float(gw.x << 16)); gt[1] = sigm(__uint_as_float(gw.x & 0xffff0000u)); gt[2] = sigm(__uint_as_float(gw.y << 16)); gt[3] = sigm(__uint_as_float(gw.y & 0xffff0000u));
                        if (!SECOND) { *(f32x4*)(tmp + row * 1024 + col) = gt * a; }
                        else { const f32x4 t = *(const f32x4*)(tmp + row * 1024 + col); const f32x4 r = t + gt * a; u32x2 w; w.x = pk2(r[0], r[1]); w.y = pk2(r[2], r[3]); *(u32x2*)(merged + row * 1024 + col) = w; } } }
    }
};
struct EpiGateUp {
    static constexpr bool PERM = true;
    const float* bgu; bf16_t* act;
    __device__ __forceinline__ void operator()(const f32x4 (&acc)[2][2][4][2], const Unit& u, int wr, int wc, int fr, int fq) const {
        const int e = u.z, colA = u.pn * 128 + wc * 32 + 8 * fq;
        f32x4 bg[2], bu[2];
#pragma unroll
        for (int n = 0; n < 2; ++n) { bg[n] = *(const f32x4*)(bgu + e * 2048 + colA + 4 * n); bu[n] = *(const f32x4*)(bgu + e * 2048 + 1024 + colA + 4 * n); }
#pragma unroll
        for (int ai = 0; ai < 2; ++ai)
#pragma unroll
            for (int m = 0; m < 4; ++m) { const size_t slot = (size_t)(u.arow + ai * 128 + wr * 64 + m * 16 + fr); unsigned w[4];
#pragma unroll
                for (int n = 0; n < 2; ++n) { float r[4];
#pragma unroll
                    for (int j = 0; j < 4; ++j) { float g = acc[ai][0][m][n][j] + bg[n][j], uu = acc[ai][1][m][n][j] + bu[n][j]; g = fminf(g, 7.f); uu = fminf(fmaxf(uu, -7.f), 7.f); r[j] = (uu + 1.f) * g * sigm(1.702f * g); }
                    w[2 * n] = pk2(r[0], r[1]); w[2 * n + 1] = pk2(r[2], r[3]); }
                *(u32x4*)(act + slot * 1024 + colA) = (u32x4){w[0], w[1], w[2], w[3]}; }
    }
};
struct EpiDown {
    static constexpr bool PERM = true;
    const float* bd; const int* list; bf16_t* ym; const LAS int* cnt;
    __device__ __forceinline__ void operator()(const f32x4 (&acc)[2][2][4][2], const Unit& u, int wr, int wc, int fr, int fq) const {
        const int e = u.z, nvalid = cnt[e] - u.pm * 256, col0 = u.pn * 256 + wc * 32 + 8 * fq;
        f32x4 bv[2][2];
#pragma unroll
        for (int bj = 0; bj < 2; ++bj)
#pragma unroll
            for (int n = 0; n < 2; ++n) bv[bj][n] = *(const f32x4*)(bd + e * 1024 + col0 + bj * 128 + 4 * n);
#pragma unroll
        for (int ai = 0; ai < 2; ++ai)
#pragma unroll
            for (int m = 0; m < 4; ++m) { const int r = ai * 128 + wr * 64 + m * 16 + fr;
                if (r < nvalid) { const int a = list[(size_t)e * 32768 + u.pm * 256 + r]; bf16_t* rowp = ym + (size_t)a * 1024 + col0;
#pragma unroll
                    for (int bj = 0; bj < 2; ++bj) { const f32x4 v0 = acc[ai][bj][m][0] + bv[bj][0], v1 = acc[ai][bj][m][1] + bv[bj][1]; u32x4 w; w.x = pk2(v0[0], v0[1]); w.y = pk2(v0[2], v0[3]); w.z = pk2(v1[0], v1[1]); w.w = pk2(v1[2], v1[3]);
                        *(u32x4*)(rowp + bj * 128) = w; } } }
    }
};
struct MoeOrder {
    const LAS int* tpre; const LAS int* cnt; const int* list; int nN, G, c, rowpitch  , brows  ;
    __device__ bool next(int i, Unit& u) const {
        const int nwg = tpre[32] * nN; const long L = (long)i * G + c; if (L >= nwg) return false;
        int wgid = (int)L; { const int q = nwg / 8, r = nwg % 8, xcd = wgid % 8, off = wgid / 8; wgid = (xcd < r ? xcd * (q + 1) : r * (q + 1) + (xcd - r) * q) + off; }
        int e = 0;
#pragma unroll 1
        for (int s = 16; s > 0; s >>= 1) { if (tpre[e + s] * nN <= wgid) e += s; }
        const int w = wgid - tpre[e] * nN, nM = tpre[e + 1] - tpre[e];
        const int nig = 8 * nN, gid = w / nig, fm = gid * 8, gsz = (nM - fm) < 8 ? (nM - fm) : 8;
        u.pm = fm + ((w % nig) % gsz); u.pn = (w % nig) / gsz; u.z = e; u.arow = (tpre[e] + u.pm) * 256; u.brow = e * brows + u.pn * 256; return true;
    }
    __device__ __forceinline__ unsigned row_off(const Unit& u, int r) const {
        const int lr = u.pm * 256 + r; const int a = list[(size_t)u.z * 32768 + (lr < cnt[u.z] ? lr : 0)]; return (unsigned)(a >> 2) * (unsigned)rowpitch;
    }
};

__device__ __forceinline__ void transpose_item(const float* W, int K, int N, bf16_t* WT, int k0, int n0, int dst_row0, LAS float* scr, int lane) {
#pragma unroll 8
    for (int i = 0; i < 32; ++i) { const int kk = 2 * i + (lane >> 5); scr[kk * 33 + (lane & 31)] = W[(size_t)(k0 + kk) * N + n0 + (lane & 31)]; }
    asm volatile("s_waitcnt lgkmcnt(0)" ::: "memory");
    const int c = lane & 7;
#pragma unroll
    for (int j = 0; j < 4; ++j) { const int n = (lane >> 3) + 8 * j; const LAS float* s = scr + (8 * c) * 33 + n;
        u32x4 o; o.x = pk2(s[0 * 33], s[1 * 33]); o.y = pk2(s[2 * 33], s[3 * 33]); o.z = pk2(s[4 * 33], s[5 * 33]); o.w = pk2(s[6 * 33], s[7 * 33]);
        *(u32x4*)(WT + (size_t)(dst_row0 + n) * K + k0 + 8 * c) = o; }
    asm volatile("s_waitcnt lgkmcnt(0)" ::: "memory");
}
template <bool GU>
__device__ __forceinline__ void transpose_matrix(const float* W, int K, int N, bf16_t* WT, LAS float* scr, int lane, int gw, int NGW, int& itbase) {
    const int nblk = N / 32, nitems = (K / 64) * nblk;
    int first = (gw - itbase) % NGW; if (first < 0) first += NGW;
    for (int it = first; it < nitems; it += NGW) { const int kb = it / nblk, nb = it % nblk, n0 = nb * 32;
        int dst = n0; if (GU) { const int nn = n0 & 1023; dst = (nn >> 7) * 256 + (n0 >> 10) * 128 + (nn & 127); }
        transpose_item(W, K, N, WT, kb * 64, n0, dst, scr, lane); }
    itbase += nitems;
}


#define MOD ((float*)(ws + WS_SMALL))
#define SCAL ((float*)(ws + WS_SMALL + 128 * 1024))
#define ROPEC ((float*)(ws + WS_ROPEC))
#define ROPES ((float*)(ws + WS_ROPES))
#define TOPI ((int*)(ws + WS_TOPI))
#define TOPW ((float*)(ws + WS_TOPW))
#define LIST ((int*)(ws + WS_LIST))
#define CNT ((int*)(ws + WS_CTL) + CW_CNT)
#define H ((bf16_t*)(ws + WS_H))
#define QKR ((bf16_t*)(ws + WS_H))
#define PROJ ((bf16_t*)(ws + WS_PROJ))
#define YA ((bf16_t*)(ws + WS_YA))
#define YB ((bf16_t*)(ws + WS_YB))
#define DS ((bf16_t*)(ws + WS_DS))
#define DEC ((float*)(ws + WS_DEC))
#define MERGED ((bf16_t*)(ws + WS_MERGED))
#define SP ((bf16_t*)(ws + WS_MERGED))
#define Y ((float*)(ws + WS_Y))
#define ACT ((bf16_t*)(ws + WS_ACT))
#define YM ((bf16_t*)(ws + WS_YM))
#define WT_IN ((bf16_t*)(ws + WS_WIN))
#define WT_A ((bf16_t*)(ws + WS_WA))
#define WT_B ((bf16_t*)(ws + WS_WB))
#define WT_O ((bf16_t*)(ws + WS_WO))
#define WT_GU ((bf16_t*)(ws + WS_WGU))
#define WT_D ((bf16_t*)(ws + WS_WD))
#define PHASE_BEGIN unsigned char* ws = args.ws; asm volatile("" : "+s"(ws)); int tid = threadIdx.x; asm volatile("" : "+v"(tid)); const int lane = tid & 63; (void)lane; const float* x = args.in[0]; float* out = args.out; (void)x; (void)out;
__global__ void __launch_bounds__(NTHR, 2) mega(Args args) {
    extern __shared__ __attribute__((aligned(16))) unsigned char lds_[];
    LAS unsigned char* lds = (LAS unsigned char*)lds_;
    volatile LAS unsigned* LW = (volatile LAS unsigned*)(lds + LDSCTL_OFF);
    const int tid = threadIdx.x, lane = tid & 63, wave = __builtin_amdgcn_readfirstlane(tid >> 6);
    const int G = gridDim.x; const int bx = blockIdx.x; const int vcu = (G % 8 == 0) ? (bx % 8) * (G / 8) + bx / 8 : bx;
    const int gw = vcu * NWAVES + wave, NGW = G * NWAVES;
    unsigned* CTL = (unsigned*)(args.ws + WS_CTL);
    for (int u = tid; u < (LDS_BYTES - LDSCTL_OFF) / 4; u += NTHR) ((LAS unsigned*)(lds + LDSCTL_OFF))[u] = 0u;
    __syncthreads();
    const int lo = args.ph_lo, hi = args.ph_hi;
    XcdBarrier bar; bar.bar = CTL + CW_BAR + args.li * 4096; bar.x = 0; bar.st = nullptr;
    if (hi - lo > 1) bar = xcd_barrier_post(CTL + CW_BAR + args.li * 4096, LW + LW_BAR);
#ifndef PHMASK
#define PHMASK 0xffff
#endif
#define IN(k) ((((PHMASK) >> (k)) & 1) && lo <= (k) && (k) < hi)
#define SEAM(k) do { if (IN(k) && IN((k) + 1)) xcd_barrier(bar); } while (0)

    if (IN(PH_PRO)) {
        PHASE_BEGIN
        const float* c = args.in[1]; const float* w_mod = args.in[2]; const float* b_mod = args.in[3];
        LAS float* cact = (LAS float*)lds; LAS float* red = cact + 4096;
        for (int i = tid; i < 4096; i += NTHR) { const float cv = c[i]; cact[i] = cv / (1.f + expf(-cv)); }
        __syncthreads();
        for (int it = vcu; it < 384; it += G) { const int b = it / 96, j0 = (it % 96) * 64, kq = tid >> 6, col = tid & 63; float acc = 0.f;
            for (int k = kq * 128; k < kq * 128 + 128; ++k) acc += cact[b * 1024 + k] * w_mod[(size_t)k * 6144 + j0 + col];
            red[kq * 64 + col] = acc; __syncthreads();
            if (tid < 64) { float s = 0.f;
#pragma unroll
                for (int q = 0; q < 8; ++q) s += red[q * 64 + tid];
                MOD[b * 6144 + j0 + tid] = s + b_mod[j0 + tid]; }
            __syncthreads(); }
        const int gt = vcu * NTHR + tid, NGT = G * NTHR;
        if (gt == 0) { const float* q1 = args.in[7]; const float* k1 = args.in[8]; const float* q2 = args.in[9]; const float* k2 = args.in[10]; float s1 = 0.f, s2 = 0.f;
            for (int i = 0; i < 64; ++i) { s1 += q1[i] * k1[i]; s2 += q2[i] * k2[i]; } SCAL[0] = expf(s1) - expf(s2) + 0.2f; }
        if (gt < 512) { const float* lbl = args.in[12]; SCAL[64 + gt] = 1.f / (1.f + expf(lbl[512 + gt] - lbl[gt])); }
        for (int i = gt; i < 8192 * 32; i += NGT) { const int s = i >> 5, j = i & 31; const float inv = powf(10000.f, -(float)(2 * j) / 64.f); const float ang = (float)s * inv; ROPEC[i] = cosf(ang); ROPES[i] = sinf(ang); }
        LAS float* scr = (LAS float*)(lds + wave * 16384); int itbase = 0;
        transpose_matrix<false>(args.in[6], 1024, 5632, WT_IN, scr, lane, gw, NGW, itbase);
        transpose_matrix<false>(args.in[14], 512, 1024, WT_A, scr, lane, gw, NGW, itbase);
        transpose_matrix<false>(args.in[15], 512, 1024, WT_B, scr, lane, gw, NGW, itbase);
        transpose_matrix<false>(args.in[16], 1024, 1024, WT_O, scr, lane, gw, NGW, itbase);
        for (int e = 0; e < 32; ++e) transpose_matrix<true>(args.in[21] + (size_t)e * 1024 * 2048, 1024, 2048, WT_GU + (size_t)e * 2048 * 1024, scr, lane, gw, NGW, itbase);
        for (int e = 0; e < 32; ++e) transpose_matrix<false>(args.in[23] + (size_t)e * 1024 * 1024, 1024, 1024, WT_D + (size_t)e * 1024 * 1024, scr, lane, gw, NGW, itbase);
    }
    SEAM(PH_PRO);
    if (IN(PH_H1)) {
        PHASE_BEGIN
        const float* w = args.in[4];
        for (int row = gw; row < T; row += NGW) { const int b = row >> 13; const f32x4* xr = (const f32x4*)(x + (size_t)row * 1024) + lane; f32x4 v[4]; float ss = 0.f;
#pragma unroll
            for (int j = 0; j < 4; ++j) { v[j] = xr[64 * j]; ss += (v[j][0] * v[j][0] + v[j][1] * v[j][1]) + (v[j][2] * v[j][2] + v[j][3] * v[j][3]); }
            const float rstd = rsqrtf(wave_sum(ss) * (1.f / 1024.f) + 1e-6f);
#pragma unroll
            for (int j = 0; j < 4; ++j) { const int col = 4 * lane + 256 * j; const f32x4 wv = *(const f32x4*)(w + col), sc = *(const f32x4*)(MOD + b * 6144 + 1024 + col), sh = *(const f32x4*)(MOD + b * 6144 + col);
                const f32x4 h = v[j] * rstd * wv * (sc + 1.f) + sh; u32x2 o; o.x = pk2(h[0], h[1]); o.y = pk2(h[2], h[3]); *(u32x2*)(H + (size_t)row * 1024 + col) = o; } }
    }
    SEAM(PH_H1);
    if (IN(PH_G1)) {
        PHASE_BEGIN
        pg8::Gemm g{H, WT_IN, 1024}; pg8::DenseOrder S; S.init(T, NC, G, bx);
        EpiBf16 E{PROJ, NC};
        pg8::gemm_phase<EpiBf16, pg8::DenseOrder, false>(lds, g, S, E);
    }
    SEAM(PH_G1);
    if (IN(PH_ROPE_HGA)) {
        PHASE_BEGIN
        for (int row = gw; row < T; row += NGW) { const int s = row & 8191;
#pragma unroll
            for (int j = 0; j < 2; ++j) { const int gq = lane + 64 * j, mb = gq >> 3, d4 = (gq & 7) * 4; const bf16_t* src = PROJ + (size_t)row * 5632 + mb * 64 + d4;
                const u32x2 a = *(const u32x2*)src, bq = *(const u32x2*)(src + 32); const f32x4 cs = *(const f32x4*)(ROPEC + s * 32 + d4), sn = *(const f32x4*)(ROPES + s * 32 + d4);
                const f32x4 x1 = (f32x4){__uint_as_float(a.x << 16), __uint_as_float(a.x & 0xffff0000u), __uint_as_float(a.y << 16), __uint_as_float(a.y & 0xffff0000u)};
                const f32x4 x2 = (f32x4){__uint_as_float(bq.x << 16), __uint_as_float(bq.x & 0xffff0000u), __uint_as_float(bq.y << 16), __uint_as_float(bq.y & 0xffff0000u)};
                const float sc = (mb < 8) ? at::C2 : 1.f; const f32x4 o1 = (x1 * cs - x2 * sn) * sc, o2 = (x2 * cs + x1 * sn) * sc;
                bf16_t* dst = QKR + (size_t)row * 1024 + mb * 64 + d4; u32x2 w1, w2; w1.x = pk2(o1[0], o1[1]); w1.y = pk2(o1[2], o1[3]); w2.x = pk2(o2[0], o2[1]); w2.y = pk2(o2[2], o2[3]);
                *(u32x2*)dst = w1; *(u32x2*)(dst + 32) = w2; } }
        for (int it = vcu; it < 2048; it += G) hg::hgA_unit(lds, PROJ, SCAL, DS, DEC, it >> 7, it & 127, tid);
        __syncthreads();
    }
    SEAM(PH_ROPE_HGA);
    if (IN(PH_ATT_SCAN)) {
        PHASE_BEGIN
        for (int gid = vcu * NTHR + tid; gid < 16 * 128 * 128; gid += G * NTHR) { const int bh = gid >> 14, d = (gid >> 7) & 127, v = gid & 127; float st = 0.f;
            const bf16_t* __restrict__ src = DS + ((size_t)(bh * 128) * 128 + d) * 128 + v; bf16_t* __restrict__ dst = SP + ((size_t)(bh * 128) * 128 + d) * 128 + v; const float* __restrict__ dc = DEC + (size_t)(bh * 128) * 128 + d;
            for (int n0 = 0; n0 < 128; n0 += 8) { float xv[8], dv[8];
#pragma unroll
                for (int i = 0; i < 8; ++i) { xv[i] = bf2f(src[(size_t)(n0 + i) * 16384]); dv[i] = dc[(n0 + i) * 128]; }
#pragma unroll
                for (int i = 0; i < 8; ++i) { dst[(size_t)(n0 + i) * 16384] = f2bf(st); st = dv[i] * st + xv[i]; } } }
        { const float lam = SCAL[0]; const float* subln = args.in[11];
          for (int it = vcu; it < 1024; it += G) { int bh, blk;
              if (G == 256) { const int i = it >> 8, v = it & 255, s = v & 15; bh = v >> 4; blk = (i == 0) ? 63 - s : (i == 1) ? 32 + s : (i == 2) ? 31 - s : s; }
              else { blk = 63 - (it >> 4); bh = it & 15; }
              at::attn_unit(lds, QKR, PROJ, YA, subln, lam, bh >> 2, bh & 3, blk, tid); } }
    }
    SEAM(PH_ATT_SCAN);
    if (IN(PH_HGC)) {
        PHASE_BEGIN
        const float* hgnorm = args.in[13];
        for (int it = vcu; it < 2048; it += G) hg::hgC_unit(lds, PROJ, SCAL, SP, hgnorm, YB, it >> 7, it & 127, tid);
        __syncthreads();
    }
    SEAM(PH_HGC);
    if (IN(PH_G2A)) {
        PHASE_BEGIN
        pg8::Gemm g{YA, WT_A, 512}; pg8::DenseOrder S; S.init(T, 1024, G, bx);
        EpiBranch<false> E{out, PROJ, MERGED};
        pg8::gemm_phase<EpiBranch<false>, pg8::DenseOrder, false>(lds, g, S, E);
    }
    if (IN(PH_G2B)) {
        PHASE_BEGIN
        asm volatile("s_waitcnt vmcnt(0)" ::: "memory"); __syncthreads();
        pg8::Gemm g{YB, WT_B, 512}; pg8::DenseOrder S; S.init(T, 1024, G, bx);
        EpiBranch<true> E{out, PROJ, MERGED};
        pg8::gemm_phase<EpiBranch<true>, pg8::DenseOrder, false>(lds, g, S, E);
    }
    SEAM(PH_G2B);
    if (IN(PH_G3)) {
        PHASE_BEGIN
        pg8::Gemm g{MERGED, WT_O, 1024}; pg8::DenseOrder S; S.init(T, 1024, G, bx);
        EpiF32 E{Y, 1024};
        pg8::gemm_phase<EpiF32, pg8::DenseOrder, false>(lds, g, S, E);
    }
    SEAM(PH_G3);
    if (IN(PH_TOK)) {
        PHASE_BEGIN
        const float* wpm = args.in[5]; const float* wpf = args.in[17]; const float* rw = args.in[19]; const float* rb = args.in[20];
        LAS int* lcnt = (LAS int*)lds; LAS int* lbase = lcnt + 32; LAS int* asg = lcnt + 64;
        for (int chunk = vcu; chunk < T / 128; chunk += G) {
            __syncthreads();
            if (tid < 32) lcnt[tid] = 0;
            __syncthreads();
            for (int i = 0; i < 16; ++i) { const int rloc = wave * 16 + i, row = chunk * 128 + rloc, b = row >> 13;
                const f32x4* yr = (const f32x4*)(Y + (size_t)row * 1024) + lane; const f32x4* xr = (const f32x4*)(x + (size_t)row * 1024) + lane; f32x4 v[4]; float ss = 0.f;
#pragma unroll
                for (int j = 0; j < 4; ++j) { v[j] = yr[64 * j]; ss += (v[j][0] * v[j][0] + v[j][1] * v[j][1]) + (v[j][2] * v[j][2] + v[j][3] * v[j][3]); }
                float rstd = rsqrtf(wave_sum(ss) * (1.f / 1024.f) + 1e-6f); ss = 0.f;
#pragma unroll
                for (int j = 0; j < 4; ++j) { const int col = 4 * lane + 256 * j; const f32x4 g1 = *(const f32x4*)(MOD + b * 6144 + 2048 + col), wv = *(const f32x4*)(wpm + col);
                    v[j] = xr[64 * j] + g1 * v[j] * rstd * wv; *(f32x4*)(out + (size_t)row * 1024 + col) = v[j]; ss += (v[j][0] * v[j][0] + v[j][1] * v[j][1]) + (v[j][2] * v[j][2] + v[j][3] * v[j][3]); }
                rstd = rsqrtf(wave_sum(ss) * (1.f / 1024.f) + 1e-6f);
                float lg[32];
#pragma unroll
                for (int e = 0; e < 32; ++e) lg[e] = 0.f;
#pragma unroll
                for (int j = 0; j < 4; ++j) { const int col = 4 * lane + 256 * j; const f32x4 wv = *(const f32x4*)(wpf + col), sc = *(const f32x4*)(MOD + b * 6144 + 4096 + col), sh = *(const f32x4*)(MOD + b * 6144 + 3072 + col);
                    const f32x4 h = v[j] * rstd * wv * (sc + 1.f) + sh; u32x2 o; o.x = pk2(h[0], h[1]); o.y = pk2(h[2], h[3]); *(u32x2*)(H + (size_t)row * 1024 + col) = o;
#pragma unroll
                    for (int q = 0; q < 4; ++q) { const f32x4* rwp = (const f32x4*)(rw + (size_t)(col + q) * 32);
#pragma unroll
                        for (int e4 = 0; e4 < 8; ++e4) { const f32x4 r4 = rwp[e4]; lg[4 * e4] += h[q] * r4[0]; lg[4 * e4 + 1] += h[q] * r4[1]; lg[4 * e4 + 2] += h[q] * r4[2]; lg[4 * e4 + 3] += h[q] * r4[3]; } } }
#pragma unroll
                for (int e = 0; e < 32; ++e) lg[e] = wave_sum(lg[e]) + rb[e];
                int bi[4]; float bv[4];
#pragma unroll
                for (int k = 0; k < 4; ++k) { float best = -3.0e38f; int be = 0;
#pragma unroll
                    for (int e = 0; e < 32; ++e) { bool taken = false;
#pragma unroll
                        for (int q = 0; q < 4; ++q) if (q < k && bi[q] == e) taken = true;
                        if (!taken && lg[e] > best) { best = lg[e]; be = e; } }
                    bi[k] = be; bv[k] = best; }
                const float e1 = expf(bv[1] - bv[0]), e2 = expf(bv[2] - bv[0]), e3 = expf(bv[3] - bv[0]); const float inv = 1.f / (1.f + e1 + e2 + e3);
                if (lane == 0) { *(f32x4*)(TOPW + row * 4) = (f32x4){inv, e1 * inv, e2 * inv, e3 * inv};
                    TOPI[row * 4 + 0] = bi[0]; TOPI[row * 4 + 1] = bi[1]; TOPI[row * 4 + 2] = bi[2]; TOPI[row * 4 + 3] = bi[3];
#pragma unroll
                    for (int k = 0; k < 4; ++k) { const int pos = __hip_atomic_fetch_add(lcnt + bi[k], 1, __ATOMIC_RELAXED, __HIP_MEMORY_SCOPE_WORKGROUP); asg[rloc * 4 + k] = (bi[k] << 16) | pos; } }
            }
            __syncthreads();
            if (tid < 32) lbase[tid] = atomicAdd(&CNT[tid], lcnt[tid]);
            __syncthreads();
            { const int v = asg[tid], e = v >> 16, pos = v & 0xffff; LIST[(size_t)e * 32768 + lbase[e] + pos] = chunk * 512 + tid; }
        }
        __syncthreads();
    }
    SEAM(PH_TOK);
    if (IN(PH_G4) || IN(PH_G5)) {
        PHASE_BEGIN
        if (tid < 32) ((LAS int*)LW)[LW_CNT + tid] = __hip_atomic_load(&CNT[tid], __ATOMIC_RELAXED, __HIP_MEMORY_SCOPE_AGENT);
        __syncthreads();
        if (tid == 0) { int s = 0; for (int e = 0; e < 32; ++e) { ((LAS int*)LW)[LW_TPRE + e] = s; s += (((LAS int*)LW)[LW_CNT + e] + 255) >> 8; } ((LAS int*)LW)[LW_TPRE + 32] = s; }
        __syncthreads();
    }
    if (IN(PH_G4)) {
        PHASE_BEGIN
        pg8::Gemm g{H, WT_GU, 1024}; MoeOrder S{(const LAS int*)LW + LW_TPRE, (const LAS int*)LW + LW_CNT, LIST, 8, G, bx, 2048, 2048};
        EpiGateUp E{args.in[22], ACT};
        pg8::gemm_phase<EpiGateUp, MoeOrder, true>(lds, g, S, E);
    }
    SEAM(PH_G4);
    if (IN(PH_G5)) {
        PHASE_BEGIN
        pg8::Gemm g{ACT, WT_D, 1024}; MoeOrder S{(const LAS int*)LW + LW_TPRE, (const LAS int*)LW + LW_CNT, LIST, 4, G, bx, 2048, 1024};
        EpiDown E{args.in[24], LIST, YM, (const LAS int*)LW + LW_CNT};
        pg8::gemm_phase<EpiDown, MoeOrder, false>(lds, g, S, E);
    }
    SEAM(PH_G5);
    if (IN(PH_FIN)) {
        PHASE_BEGIN
        const float* w = args.in[18];
        for (int row = gw; row < T; row += NGW) { const int b = row >> 13; const f32x4 tw = *(const f32x4*)(TOPW + row * 4); const bf16_t* y0 = YM + (size_t)row * 4096; f32x4 v[4]; float ss = 0.f;
#pragma unroll
            for (int j = 0; j < 4; ++j) { const int col = 4 * lane + 256 * j; f32x4 a = (f32x4){0.f, 0.f, 0.f, 0.f};
#pragma unroll
                for (int k = 0; k < 4; ++k) { const u32x2 yw = *(const u32x2*)(y0 + k * 1024 + col);
                    a[0] += tw[k] * __uint_as_float(yw.x << 16); a[1] += tw[k] * __uint_as_float(yw.x & 0xffff0000u); a[2] += tw[k] * __uint_as_float(yw.y << 16); a[3] += tw[k] * __uint_as_float(yw.y & 0xffff0000u); }
                v[j] = a; ss += (a[0] * a[0] + a[1] * a[1]) + (a[2] * a[2] + a[3] * a[3]); }
            const float rstd = rsqrtf(wave_sum(ss) * (1.f / 1024.f) + 1e-6f);
#pragma unroll
            for (int j = 0; j < 4; ++j) { const int col = 4 * lane + 256 * j; const f32x4 g2 = *(const f32x4*)(MOD + b * 6144 + 5120 + col), wv = *(const f32x4*)(w + col);
                f32x4* op = (f32x4*)(out + (size_t)row * 1024 + col); *op = *op + g2 * v[j] * rstd * wv; } }
    }
#undef IN
#undef SEAM
}
}
#undef MOD
#undef SCAL
#undef ROPEC
#undef ROPES
#undef TOPI
#undef TOPW
#undef LIST
#undef CNT
#undef H
#undef QKR
#undef PROJ
#undef YA
#undef YB
#undef DS
#undef DEC
#undef MERGED
#undef SP
#undef Y
#undef ACT
#undef YM
#undef WT_IN
#undef WT_A
#undef WT_B
#undef WT_O
#undef WT_GU
#undef WT_D
#undef PHASE_BEGIN

#ifndef FASTMASK
#define FASTMASK 0x1fff
#endif

extern "C" void kernel_launch(void* const* d_in, const int* in_sizes, int n_in, void* d_out, int out_size, void* d_ws, size_t ws_size, hipStream_t stream) {
    if (n_in != 25 || out_size != T * D || ws_size < WS_END) { fprintf(stderr, "kernel_launch: unexpected shapes / workspace (%d inputs, out %d, ws %zu)\n", n_in, out_size, ws_size); return; }
    const float* x = (const float*)d_in[0]; const float* c = (const float*)d_in[1]; const float* w_mod = (const float*)d_in[2]; const float* b_mod = (const float*)d_in[3];
    const float* norm_pre_mix = (const float*)d_in[4]; const float* norm_post_mix = (const float*)d_in[5]; const float* w_in = (const float*)d_in[6];
    const float* lq1 = (const float*)d_in[7]; const float* lk1 = (const float*)d_in[8]; const float* lq2 = (const float*)d_in[9]; const float* lk2 = (const float*)d_in[10];
    const float* subln = (const float*)d_in[11]; const float* lbl = (const float*)d_in[12]; const float* hgnorm = (const float*)d_in[13];
    const float* wa = (const float*)d_in[14]; const float* wb = (const float*)d_in[15]; const float* wo = (const float*)d_in[16];
    const float* norm_pre_ffn = (const float*)d_in[17]; const float* norm_post_ffn = (const float*)d_in[18]; const float* rw = (const float*)d_in[19]; const float* rb = (const float*)d_in[20];
    const float* wgu = (const float*)d_in[21]; const float* bgu = (const float*)d_in[22]; const float* wd = (const float*)d_in[23]; const float* bd = (const float*)d_in[24];
    unsigned char* ws = (unsigned char*)d_ws; float* out = (float*)d_out;
    float* MOD = (float*)(ws + WS_SMALL); float* SCAL = (float*)(ws + WS_SMALL + 128 * 1024); int* PADS = (int*)(ws + WS_SMALL + 192 * 1024);
    float* ROPEC = (float*)(ws + WS_ROPEC); float* ROPES = (float*)(ws + WS_ROPES);
    int* TOPI = (int*)(ws + WS_TOPI); float* TOPW = (float*)(ws + WS_TOPW); int* LIST = (int*)(ws + WS_LIST); int* CNT = (int*)(ws + WS_CTL) + CW_CNT;
    bf16_t* H = (bf16_t*)(ws + WS_H); bf16_t* PROJ = (bf16_t*)(ws + WS_PROJ); bf16_t* YA = (bf16_t*)(ws + WS_YA); bf16_t* YB = (bf16_t*)(ws + WS_YB);
    bf16_t* DS = (bf16_t*)(ws + WS_DS); float* DEC = (float*)(ws + WS_DEC); bf16_t* MERGED = (bf16_t*)(ws + WS_MERGED); float* Y = (float*)(ws + WS_Y);
    bf16_t* SP = (bf16_t*)(ws + WS_MERGED);
    bf16_t* ACT = (bf16_t*)(ws + WS_ACT); bf16_t* YM = (bf16_t*)(ws + WS_YM);

    static int grid = 0;
    if (grid == 0) {
        (void)hipFuncSetAttribute((const void*)nv::k_attn, hipFuncAttributeMaxDynamicSharedMemorySize, nv::AT_LDS);
        (void)hipFuncSetAttribute((const void*)nv::k_hgA, hipFuncAttributeMaxDynamicSharedMemorySize, 65536);
        (void)hipFuncSetAttribute((const void*)nv::k_hgC, hipFuncAttributeMaxDynamicSharedMemorySize, nv::HC_LDS);
        (void)hipFuncSetAttribute((const void*)mk::mega, hipFuncAttributeMaxDynamicSharedMemorySize, mk::LDS_BYTES);
        int dev = 0, cus = 0; (void)hipGetDevice(&dev); (void)hipDeviceGetAttribute(&cus, hipDeviceAttributeMultiprocessorCount, dev);
        (void)hipGetLastError();
        grid = cus > 0 ? cus : 256;
    }
    (void)hipMemsetAsync(ws + WS_CTL, 0, 1 * MiB, stream);
    mk::Args a{}; for (int i = 0; i < 25; ++i) a.in[i] = (const float*)d_in[i]; a.out = out; a.ws = ws;
    const unsigned fast = FASTMASK; int li = 0;
    for (int p = 0; p < mk::PH_N;) {
        if (fast & (1u << p)) { int q = p; while (q < mk::PH_N && (fast & (1u << q))) ++q;
            a.ph_lo = p; a.ph_hi = q; a.li = li++; a.pad = 0;
            hipLaunchKernelGGL(mk::mega, dim3(grid), dim3(mk::NTHR), mk::LDS_BYTES, stream, a);
            p = q; continue; }
        switch (p) {
        case mk::PH_PRO:
            nv::k_mod<<<dim3(24, 4), 256, 0, stream>>>(c, w_mod, b_mod, MOD);
            nv::k_small<<<1024, 256, 0, stream>>>(lq1, lk1, lq2, lk2, lbl, SCAL, ROPEC, ROPES); break;
        case mk::PH_H1: nv::k_rowmod<<<T / 4, 256, 0, stream>>>(x, norm_pre_mix, MOD, H, 0, 1024); break;
        case mk::PH_G1: { nv::NG p_{}; p_.A = H; p_.lda = 1024; p_.M = T; p_.B = w_in; p_.ldb = NC; p_.K = 1024;
            nv::k_gemm<nv::EpiStoreBf16, 1><<<dim3(NC / 64, T / 64, 1), 256, 0, stream>>>(p_, nv::EpiStoreBf16{PROJ, (long long)NC}); } break;
        case mk::PH_ROPE_HGA: nv::k_hgA<<<dim3(128, 4, 4), 256, 65536, stream>>>(PROJ, SCAL, DS, DEC); break;
        case mk::PH_ATT_SCAN:
            nv::k_attn<<<dim3(128, 4, 4), 256, nv::AT_LDS, stream>>>(PROJ, ROPEC, ROPES, SCAL, subln, YA);
            nv::k_scan<<<1024, 256, 0, stream>>>(DS, DEC, SP); break;
        case mk::PH_HGC: nv::k_hgC<<<dim3(128, 4, 4), 256, nv::HC_LDS, stream>>>(PROJ, SCAL, SP, hgnorm, YB); break;
        case mk::PH_G2A: { nv::NG p_{}; p_.A = YA; p_.lda = 512; p_.M = T; p_.B = wa; p_.ldb = 1024; p_.K = 512;
            nv::k_gemm<nv::EpiBranchA, 1><<<dim3(16, T / 64, 1), 256, 0, stream>>>(p_, nv::EpiBranchA{out, PROJ}); } break;
        case mk::PH_G2B: { nv::NG p_{}; p_.A = YB; p_.lda = 512; p_.M = T; p_.B = wb; p_.ldb = 1024; p_.K = 512;
            nv::k_gemm<nv::EpiBranchB, 1><<<dim3(16, T / 64, 1), 256, 0, stream>>>(p_, nv::EpiBranchB{out, PROJ, MERGED}); } break;
        case mk::PH_G3: { nv::NG p_{}; p_.A = MERGED; p_.lda = 1024; p_.M = T; p_.B = wo; p_.ldb = 1024; p_.K = 1024;
            nv::k_gemm<nv::EpiStoreF32, 1><<<dim3(16, T / 64, 1), 256, 0, stream>>>(p_, nv::EpiStoreF32{Y, 1024LL}); } break;
        case mk::PH_TOK:
            nv::k_x1<<<T / 4, 256, 0, stream>>>(x, Y, norm_post_mix, MOD, 2048LL, out);
            nv::k_rowmod<<<T / 4, 256, 0, stream>>>(out, norm_pre_ffn, MOD, H, 3072, 4096);
            nv::k_route<<<T / 4, 256, 0, stream>>>(out, norm_pre_ffn, MOD, rw, rb, TOPI, TOPW);
            nv::k_lists<<<T * 4 / 256, 256, 0, stream>>>(TOPI, CNT, LIST);
            nv::k_pads<<<1, 64, 0, stream>>>(CNT, PADS); break;
        case mk::PH_G4: { nv::NG p_{}; p_.A = H; p_.lda = 1024; p_.rowidx = LIST; p_.idxstride = 32768; p_.idxshift = 2; p_.cnt = CNT; p_.rowbase = PADS; p_.B = wgu; p_.strideB = (size_t)1024 * 2048; p_.ldb = 2048; p_.K = 1024; p_.b1off = 1024;
            nv::k_gemm<nv::EpiGateUp, 2><<<dim3(16, T / 64, 32), 256, 0, stream>>>(p_, nv::EpiGateUp{bgu, ACT}); } break;
        case mk::PH_G5: { nv::NG p_{}; p_.A = ACT; p_.lda = 1024; p_.cnt = CNT; p_.rowbase = PADS; p_.B = wd; p_.strideB = (size_t)1024 * 1024; p_.ldb = 1024; p_.K = 1024;
            nv::k_gemm<nv::EpiDown, 1><<<dim3(16, T / 64, 32), 256, 0, stream>>>(p_, nv::EpiDown{bd, LIST, YM}); } break;
        case mk::PH_FIN: nv::k_final<<<T / 4, 256, 0, stream>>>(out, YM, TOPW, norm_post_ffn, MOD); break;
        }
        ++p;
    }
}
```

```cpp
#include <hip/hip_runtime.h>
#include <hip/hip_bf16.h>
#include <stdint.h>
#include <cstdio>

typedef unsigned short bf16_t;
__device__ __forceinline__ float bf2f(bf16_t v) { return __uint_as_float(((unsigned)v) << 16); }
__device__ __forceinline__ bf16_t f2bf(float f) { unsigned u = __float_as_uint(f); return (bf16_t)((u + 0x7fffu + ((u >> 16) & 1u)) >> 16); }

constexpr int NB_ = 4, SEQ = 8192, T = NB_ * SEQ, D = 1024, NC = 5632, NE = 32;
constexpr size_t MiB = 1u << 20;
constexpr size_t WS_CTL = 0;
constexpr size_t WS_SMALL = 1 * MiB;
constexpr size_t WS_ROPEC = 2 * MiB, WS_ROPES = 3 * MiB;
constexpr size_t WS_TOPI = 4 * MiB, WS_TOPW = 4 * MiB + 512 * 1024;
constexpr size_t WS_RWT = 5 * MiB;
constexpr size_t WS_LIST = 6 * MiB;
constexpr size_t WS_WIN = 16 * MiB, WS_WA = 28 * MiB, WS_WB = 29 * MiB, WS_WO = 30 * MiB, WS_WGU = 32 * MiB, WS_WD = 160 * MiB;
constexpr size_t WS_H = 224 * MiB;
constexpr size_t WS_PROJ = 288 * MiB;
constexpr size_t WS_YA = 640 * MiB, WS_YB = 672 * MiB;
constexpr size_t WS_DS = 704 * MiB, WS_DEC = 768 * MiB;
constexpr size_t WS_MERGED = 772 * MiB;
constexpr size_t WS_Y = 836 * MiB;
constexpr size_t WS_ACT = 288 * MiB;
constexpr size_t WS_YM = 560 * MiB;
constexpr size_t WS_END = 964 * MiB;
constexpr int CW_CNT = 1024;
constexpr int CW_BAR = 4096;

namespace nv {

__device__ __forceinline__ float wave_sum(float v) {
#pragma unroll
    for (int o = 1; o < 64; o <<= 1) v += __shfl_xor(v, o);
    return v;
}
__device__ __forceinline__ float sigm(float x) { return 1.f / (1.f + expf(-x)); }

__global__ void __launch_bounds__(256) k_mod(const float* c, const float* w_mod, const float* b_mod, float* mod) {
    const int j = blockIdx.x * 256 + threadIdx.x, b = blockIdx.y;
    float acc = 0.f;
    for (int k = 0; k < 1024; ++k) { const float cv = c[b * 1024 + k]; acc += (cv * sigm(cv)) * w_mod[(size_t)k * 6144 + j]; }
    mod[b * 6144 + j] = acc + b_mod[j];
}
__global__ void __launch_bounds__(256) k_small(const float* q1, const float* k1, const float* q2, const float* k2, const float* lbl,
                                               float* scal, float* ropec, float* ropes) {
    const int gid = blockIdx.x * 256 + threadIdx.x;
    if (gid == 0) { float s1 = 0.f, s2 = 0.f; for (int i = 0; i < 64; ++i) { s1 += q1[i] * k1[i]; s2 += q2[i] * k2[i]; } scal[0] = expf(s1) - expf(s2) + 0.2f; }
    if (gid < 512) { const float a = lbl[gid], b = lbl[512 + gid]; scal[64 + gid] = 1.f / (1.f + expf(b - a)); }
    if (gid < 8192 * 32) { const int s = gid >> 5, i = gid & 31; const float inv = powf(10000.f, -(float)(2 * i) / 64.f); const float ang = (float)s * inv; ropec[gid] = cosf(ang); ropes[gid] = sinf(ang); }
}
__global__ void __launch_bounds__(256) k_rowmod(const float* x, const float* w, const float* mod, bf16_t* out, int shoff, int scoff) {
    const int row = blockIdx.x * 4 + (threadIdx.x >> 6), lane = threadIdx.x & 63, b = row >> 13;
    const float* xr = x + (size_t)row * 1024; float v[16]; float ss = 0.f;
#pragma unroll
    for (int j = 0; j < 16; ++j) { v[j] = xr[lane + 64 * j]; ss += v[j] * v[j]; }
    ss = wave_sum(ss); const float rstd = rsqrtf(ss * (1.f / 1024.f) + 1e-6f);
#pragma unroll
    for (int j = 0; j < 16; ++j) { const int col = lane + 64 * j; const float h = v[j] * rstd * w[col] * (1.f + mod[b * 6144 + scoff + col]) + mod[b * 6144 + shoff + col]; out[(size_t)row * 1024 + col] = f2bf(h); }
}

struct NG {
    const bf16_t* A;
    const int* rowidx;
    const int* cnt;
    const int* rowbase;
    const float* B; size_t strideB;
    int lda, idxstride, idxshift, M  , ldb, K, b1off, pad;
};
template <class Epi, int NB>
__global__ void __launch_bounds__(256) k_gemm(NG p, Epi epi) {
    __shared__ float As[16][68];
    __shared__ float Bs[NB][16][64];
    const int z = blockIdx.z, Mz = p.cnt ? p.cnt[z] : p.M, m0 = blockIdx.y * 64, n0 = blockIdx.x * 64;
    if (m0 >= Mz) return;
    const int tid = threadIdx.x, tx = tid & 15, ty = tid >> 4;
    const float* B = p.B + (size_t)z * p.strideB;
    const int base = p.rowbase ? p.rowbase[z] : 0;
    const int lr = tid >> 2, lk = (tid & 3) * 4;
    int lrow = m0 + lr; if (lrow >= Mz) lrow = Mz - 1;
    const size_t arow = p.rowidx ? (size_t)(p.rowidx[(size_t)z * p.idxstride + lrow] >> p.idxshift) : (size_t)(base + lrow);
    const bf16_t* ap = p.A + arow * p.lda + lk;
    const int bk = tid >> 4, bc = (tid & 15) * 4;
    float acc[NB][4][4];
#pragma unroll
    for (int q = 0; q < NB; ++q)
#pragma unroll
        for (int i = 0; i < 4; ++i)
#pragma unroll
            for (int j = 0; j < 4; ++j) acc[q][i][j] = 0.f;
    for (int k0 = 0; k0 < p.K; k0 += 16) {
        const uint2 av = *(const uint2*)(ap + k0);
        As[lk + 0][lr] = __uint_as_float(av.x << 16); As[lk + 1][lr] = __uint_as_float(av.x & 0xffff0000u);
        As[lk + 2][lr] = __uint_as_float(av.y << 16); As[lk + 3][lr] = __uint_as_float(av.y & 0xffff0000u);
#pragma unroll
        for (int q = 0; q < NB; ++q) { const float4 bv = *(const float4*)(B + (size_t)(k0 + bk) * p.ldb + n0 + bc + q * p.b1off); *(float4*)&Bs[q][bk][bc] = bv; }
        __syncthreads();
#pragma unroll
        for (int k = 0; k < 16; ++k) {
            float a[4]; const float4 a4 = *(const float4*)&As[k][ty * 4]; a[0] = a4.x; a[1] = a4.y; a[2] = a4.z; a[3] = a4.w;
#pragma unroll
            for (int q = 0; q < NB; ++q) { const float4 b4 = *(const float4*)&Bs[q][k][tx * 4]; const float b[4] = {b4.x, b4.y, b4.z, b4.w};
#pragma unroll
                for (int i = 0; i < 4; ++i)
#pragma unroll
                    for (int j = 0; j < 4; ++j) acc[q][i][j] += a[i] * b[j]; }
        }
        __syncthreads();
    }
#pragma unroll
    for (int i = 0; i < 4; ++i) { const int lrw = m0 + ty * 4 + i; if (lrw < Mz) {
#pragma unroll
        for (int j = 0; j < 4; ++j) epi(z, lrw, base + lrw, n0 + tx * 4 + j, acc[0][i][j], NB == 2 ? acc[NB - 1][i][j] : 0.f); } }
}
struct EpiStoreBf16 { bf16_t* C; long long ldc; __device__ void operator()(int, int, int r, int c, float v, float) const { C[(size_t)r * ldc + c] = f2bf(v); } };
struct EpiStoreF32 { float* C; long long ldc; __device__ void operator()(int, int, int r, int c, float v, float) const { C[(size_t)r * ldc + c] = v; } };
struct EpiBranchA { float* tmp; const bf16_t* proj; __device__ void operator()(int, int, int r, int c, float v, float) const { tmp[(size_t)r * 1024 + c] = sigm(bf2f(proj[(size_t)r * 5632 + 3584 + c])) * v; } };
struct EpiBranchB { const float* tmp; const bf16_t* proj; bf16_t* merged; __device__ void operator()(int, int, int r, int c, float v, float) const {
    merged[(size_t)r * 1024 + c] = f2bf(tmp[(size_t)r * 1024 + c] + sigm(bf2f(proj[(size_t)r * 5632 + 4608 + c])) * v); } };
struct EpiGateUp { const float* bgu; bf16_t* act; __device__ void operator()(int e, int, int r, int c, float v0, float v1) const {
    float g = v0 + bgu[e * 2048 + c], u = v1 + bgu[e * 2048 + 1024 + c]; g = fminf(g, 7.f); u = fminf(fmaxf(u, -7.f), 7.f);
    const float glu = g * sigm(1.702f * g); act[(size_t)r * 1024 + c] = f2bf((u + 1.f) * glu); } };
struct EpiDown { const float* bd; const int* list; bf16_t* ym; __device__ void operator()(int e, int lr, int, int c, float v, float) const {
    const int a = list[(size_t)e * 32768 + lr]; ym[(size_t)a * 1024 + c] = f2bf(v + bd[e * 1024 + c]); } };

constexpr int AT_LD = 129;
constexpr int AT_LDS = (3 * 64 * AT_LD + 64 * 65) * 4;
__device__ __forceinline__ void at_load_rope(float* dst, const bf16_t* proj, int tok0, int colbase, const float* ropec, const float* ropes, int s0, int tid) {
    for (int i = 0; i < 16; ++i) { const int idx = tid + 256 * i, row = idx >> 6, rem = idx & 63, m = rem >> 5, d = rem & 31;
        const bf16_t* pr = proj + (size_t)(tok0 + row) * 5632 + colbase + m * 64;
        const float x1 = bf2f(pr[d]), x2 = bf2f(pr[32 + d]), c = ropec[(s0 + row) * 32 + d], s = ropes[(s0 + row) * 32 + d];
        dst[row * AT_LD + m * 64 + d] = x1 * c - x2 * s; dst[row * AT_LD + m * 64 + 32 + d] = x2 * c + x1 * s; }
}
__global__ void __launch_bounds__(256) k_attn(const bf16_t* proj, const float* ropec, const float* ropes, const float* scal, const float* subln, bf16_t* ya) {
    extern __shared__ float sm[];
    float* Qs = sm; float* Ks = Qs + 64 * AT_LD; float* Vs = Ks + 64 * AT_LD; float* As = Vs + 64 * AT_LD;
    const int qc = blockIdx.x, h = blockIdx.y, b = blockIdx.z, tid = threadIdx.x, r = tid >> 2, qd = tid & 3;
    const int tokq = b * 8192 + qc * 64; const float lam = scal[0];
    at_load_rope(Qs, proj, tokq, h * 128, ropec, ropes, qc * 64, tid);
    float m0 = -1e30f, l0 = 0.f, m1 = -1e30f, l1 = 0.f;
    for (int kc = 0; kc <= qc; ++kc) {
        __syncthreads();
        at_load_rope(Ks, proj, b * 8192 + kc * 64, 512 + h * 128, ropec, ropes, kc * 64, tid);
        __syncthreads();
        for (int i = 0; i < 16; ++i) { const int j = 4 * i + qd; float s0 = 0.f, s1 = 0.f;
            for (int d = 0; d < 64; ++d) { s0 += Qs[r * AT_LD + d] * Ks[j * AT_LD + d]; s1 += Qs[r * AT_LD + 64 + d] * Ks[j * AT_LD + 64 + d]; }
            s0 *= 0.125f; s1 *= 0.125f;
            float mn = fmaxf(m0, s0); l0 = l0 * expf(m0 - mn) + expf(s0 - mn); m0 = mn;
            mn = fmaxf(m1, s1); l1 = l1 * expf(m1 - mn) + expf(s1 - mn); m1 = mn; }
    }
#pragma unroll
    for (int o = 1; o < 4; o <<= 1) {
        float mo = __shfl_xor(m0, o), lo = __shfl_xor(l0, o); float mn = fmaxf(m0, mo); l0 = l0 * expf(m0 - mn) + lo * expf(mo - mn); m0 = mn;
        mo = __shfl_xor(m1, o); lo = __shfl_xor(l1, o); mn = fmaxf(m1, mo); l1 = l1 * expf(m1 - mn) + lo * expf(mo - mn); m1 = mn; }
    const float il0 = 1.f / l0, il1 = lam / l1;
    float o[32];
#pragma unroll
    for (int i = 0; i < 32; ++i) o[i] = 0.f;
    for (int kc = 0; kc <= qc; ++kc) {
        __syncthreads();
        at_load_rope(Ks, proj, b * 8192 + kc * 64, 512 + h * 128, ropec, ropes, kc * 64, tid);
        for (int i = 0; i < 32; ++i) { const int idx = tid + 256 * i, row = idx >> 7, col = idx & 127; Vs[row * AT_LD + col] = bf2f(proj[(size_t)(b * 8192 + kc * 64 + row) * 5632 + 1024 + h * 128 + col]); }
        __syncthreads();
        for (int i = 0; i < 16; ++i) { const int j = 4 * i + qd; float s0 = 0.f, s1 = 0.f;
            for (int d = 0; d < 64; ++d) { s0 += Qs[r * AT_LD + d] * Ks[j * AT_LD + d]; s1 += Qs[r * AT_LD + 64 + d] * Ks[j * AT_LD + 64 + d]; }
            s0 *= 0.125f; s1 *= 0.125f;
            As[r * 65 + j] = expf(s0 - m0) * il0 - expf(s1 - m1) * il1; }
        __syncthreads();
        for (int j = 0; j < 64; ++j) { const float av = As[r * 65 + j];
#pragma unroll
            for (int dv = 0; dv < 32; ++dv) o[dv] += av * Vs[j * AT_LD + 32 * qd + dv]; }
    }
    float ss = 0.f;
#pragma unroll
    for (int i = 0; i < 32; ++i) ss += o[i] * o[i];
    ss += __shfl_xor(ss, 1); ss += __shfl_xor(ss, 2);
    const float rstd = rsqrtf(ss * (1.f / 128.f) + 1e-6f);
#pragma unroll
    for (int i = 0; i < 32; ++i) { const int dv = 32 * qd + i; ya[(size_t)(tokq + r) * 512 + h * 128 + dv] = f2bf(o[i] * rstd * subln[dv] * 0.8f); }
}

__global__ void __launch_bounds__(256) k_hgA(const bf16_t* proj, const float* scal, bf16_t* ds, float* dec) {
    extern __shared__ float sm[];
    float* G = sm; float* V = sm + 64 * 128;
    const int n = blockIdx.x, h = blockIdx.y, b = blockIdx.z, tid = threadIdx.x, tok0 = b * 8192 + n * 64, bh = b * 4 + h;
    for (int i = 0; i < 32; ++i) { const int idx = tid + 256 * i, c = idx >> 7, d = idx & 127; const bf16_t* pr = proj + (size_t)(tok0 + c) * 5632 + h * 128 + d;
        const float lb = scal[64 + h * 128 + d]; const float f = lb + (1.f - lb) * sigm(bf2f(pr[2048])); G[c * 128 + d] = f; V[c * 128 + d] = bf2f(pr[2560]); }
    __syncthreads();
    float kk[64]; float glast = 0.f; const int d = tid & 127, vb = (tid >> 7) * 64;
    {
        float g = 0.f;
#pragma unroll
        for (int c = 0; c < 64; ++c) { const float f = G[c * 128 + d]; g += logf(f); kk[c] = g; }
        glast = g;
#pragma unroll
        for (int c = 0; c < 64; ++c) { const float f = G[c * 128 + d]; kk[c] = (1.f - f) * expf(glast - kk[c]); }
    }
    if (tid < 128) dec[(size_t)(bh * 128 + n) * 128 + d] = expf(glast);
    for (int v0 = 0; v0 < 64; v0 += 16) {
        float acc[16];
#pragma unroll
        for (int i = 0; i < 16; ++i) acc[i] = 0.f;
#pragma unroll
        for (int c = 0; c < 64; ++c) {
#pragma unroll
            for (int i = 0; i < 16; ++i) acc[i] += kk[c] * V[c * 128 + vb + v0 + i]; }
#pragma unroll
        for (int i = 0; i < 16; ++i) ds[((size_t)(bh * 128 + n) * 128 + d) * 128 + vb + v0 + i] = f2bf(acc[i]);
    }
}
__global__ void __launch_bounds__(256) k_scan(const bf16_t* ds, const float* dec, bf16_t* sp) {
    const int gid = blockIdx.x * 256 + threadIdx.x; const int bh = gid >> 14, d = (gid >> 7) & 127, v = gid & 127;
    float st = 0.f;
    for (int n = 0; n < 128; ++n) { const size_t o = ((size_t)(bh * 128 + n) * 128 + d) * 128 + v; const float x = bf2f(ds[o]); sp[o] = f2bf(st); st = dec[(size_t)(bh * 128 + n) * 128 + d] * st + x; }
}
constexpr int HC_LDS = (2 * 64 * 129 + 64 * 128 + 64 * 65) * 4;
__global__ void __launch_bounds__(256) k_hgC(const bf16_t* proj, const float* scal, const bf16_t* sp, const float* hgnorm, bf16_t* yb) {
    extern __shared__ float sm[];
    float* QT = sm; float* KT = QT + 64 * 129; float* V = KT + 64 * 129; float* As = V + 64 * 128;
    const int n = blockIdx.x, h = blockIdx.y, b = blockIdx.z, tid = threadIdx.x, tok0 = b * 8192 + n * 64, bh = b * 4 + h;
    for (int i = 0; i < 32; ++i) { const int idx = tid + 256 * i, c = idx >> 7, d = idx & 127; const bf16_t* pr = proj + (size_t)(tok0 + c) * 5632 + h * 128 + d;
        const float lb = scal[64 + h * 128 + d]; const float f = lb + (1.f - lb) * sigm(bf2f(pr[2048])); const float q = bf2f(pr[1536]);
        QT[c * 129 + d] = q * sigm(q); KT[c * 129 + d] = f; V[c * 128 + d] = bf2f(pr[2560]); }
    __syncthreads();
    if (tid < 128) { float g = 0.f; for (int c = 0; c < 64; ++c) { const float f = KT[c * 129 + tid]; g += logf(f); QT[c * 129 + tid] *= expf(g); KT[c * 129 + tid] = (1.f - f) * expf(-g); } }
    __syncthreads();
    const int c = tid >> 2, q4 = tid & 3;
    for (int i = 0; i < 16; ++i) { const int s = 4 * i + q4; float a = 0.f;
        if (s <= c) { for (int d = 0; d < 128; ++d) a += QT[c * 129 + d] * KT[s * 129 + d]; }
        As[c * 65 + s] = a; }
    __syncthreads();
    float o[32];
#pragma unroll
    for (int i = 0; i < 32; ++i) o[i] = 0.f;
    for (int s = 0; s < 64; ++s) { const float a = As[c * 65 + s];
#pragma unroll
        for (int i = 0; i < 32; ++i) o[i] += a * V[s * 128 + 32 * q4 + i]; }
    const bf16_t* spb = sp + (size_t)(bh * 128 + n) * 128 * 128;
    for (int d = 0; d < 128; ++d) { const float qv = QT[c * 129 + d];
#pragma unroll
        for (int i = 0; i < 32; ++i) o[i] += qv * bf2f(spb[d * 128 + 32 * q4 + i]); }
    float ss = 0.f;
#pragma unroll
    for (int i = 0; i < 32; ++i) ss += o[i] * o[i];
    ss += __shfl_xor(ss, 1); ss += __shfl_xor(ss, 2);
    const float rstd = rsqrtf(ss * (1.f / 128.f) + 1e-6f);
#pragma unroll
    for (int i = 0; i < 32; ++i) { const int v = 32 * q4 + i; const float g = bf2f(proj[(size_t)(tok0 + c) * 5632 + 3072 + h * 128 + v]);
        yb[(size_t)(tok0 + c) * 512 + h * 128 + v] = f2bf(o[i] * rstd * hgnorm[v] * (g * sigm(g))); }
}
__global__ void __launch_bounds__(256) k_x1(const float* x, const float* y, const float* w, const float* mod, long long goff, float* x1) {
    const int row = blockIdx.x * 4 + (threadIdx.x >> 6), lane = threadIdx.x & 63, b = row >> 13;
    const float* yr = y + (size_t)row * 1024; float v[16]; float ss = 0.f;
#pragma unroll
    for (int j = 0; j < 16; ++j) { v[j] = yr[lane + 64 * j]; ss += v[j] * v[j]; }
    ss = wave_sum(ss); const float rstd = rsqrtf(ss * (1.f / 1024.f) + 1e-6f);
#pragma unroll
    for (int j = 0; j < 16; ++j) { const int col = lane + 64 * j; x1[(size_t)row * 1024 + col] = x[(size_t)row * 1024 + col] + mod[b * 6144 + goff + col] * v[j] * rstd * w[col]; }
}
__global__ void __launch_bounds__(256) k_route(const float* x1, const float* w, const float* mod, const float* rw, const float* rb, int* topi, float* topw) {
    const int row = blockIdx.x * 4 + (threadIdx.x >> 6), lane = threadIdx.x & 63, b = row >> 13;
    const float* xr = x1 + (size_t)row * 1024; float v[16]; float ss = 0.f;
#pragma unroll
    for (int j = 0; j < 16; ++j) { v[j] = xr[lane + 64 * j]; ss += v[j] * v[j]; }
    ss = wave_sum(ss); const float rstd = rsqrtf(ss * (1.f / 1024.f) + 1e-6f);
    float lg[32];
#pragma unroll
    for (int e = 0; e < 32; ++e) lg[e] = 0.f;
#pragma unroll
    for (int j = 0; j < 16; ++j) { const int col = lane + 64 * j; const float h = v[j] * rstd * w[col] * (1.f + mod[b * 6144 + 4096 + col]) + mod[b * 6144 + 3072 + col];
#pragma unroll
        for (int e = 0; e < 32; ++e) lg[e] += h * rw[col * 32 + e]; }
#pragma unroll
    for (int e = 0; e < 32; ++e) lg[e] = wave_sum(lg[e]) + rb[e];
    int bi[4]; float bv[4];
#pragma unroll
    for (int k = 0; k < 4; ++k) { float best = -3.0e38f; int be = 0;
#pragma unroll
        for (int e = 0; e < 32; ++e) { bool taken = false;
#pragma unroll
            for (int q = 0; q < 4; ++q) if (q < k && bi[q] == e) taken = true;
            if (!taken && lg[e] > best) { best = lg[e]; be = e; } }
        bi[k] = be; bv[k] = best; }
    const float e1 = expf(bv[1] - bv[0]), e2 = expf(bv[2] - bv[0]), e3 = expf(bv[3] - bv[0]); const float inv = 1.f / (1.f + e1 + e2 + e3);
    if (lane == 0) { topi[row * 4 + 0] = bi[0]; topi[row * 4 + 1] = bi[1]; topi[row * 4 + 2] = bi[2]; topi[row * 4 + 3] = bi[3];
        topw[row * 4 + 0] = inv; topw[row * 4 + 1] = e1 * inv; topw[row * 4 + 2] = e2 * inv; topw[row * 4 + 3] = e3 * inv; }
}
__global__ void __launch_bounds__(256) k_lists(const int* topi, int* cnt, int* list) {
    const int a = blockIdx.x * 256 + threadIdx.x; const int e = topi[a]; const int pos = atomicAdd(&cnt[e], 1); list[(size_t)e * 32768 + pos] = a;
}
__global__ void k_pads(const int* cnt, int* pads) { if (threadIdx.x == 0) { int s = 0; for (int e = 0; e < 32; ++e) { pads[e] = s; s += ((cnt[e] + 255) / 256) * 256; } } }
__global__ void __launch_bounds__(256) k_final(float* out, const bf16_t* ym, const float* topw, const float* w, const float* mod) {
    const int row = blockIdx.x * 4 + (threadIdx.x >> 6), lane = threadIdx.x & 63, b = row >> 13;
    float v[16]; float ss = 0.f; const float w0 = topw[row * 4], w1 = topw[row * 4 + 1], w2 = topw[row * 4 + 2], w3 = topw[row * 4 + 3];
    const bf16_t* y0 = ym + (size_t)row * 4096;
#pragma unroll
    for (int j = 0; j < 16; ++j) { const int col = lane + 64 * j; v[j] = w0 * bf2f(y0[col]) + w1 * bf2f(y0[1024 + col]) + w2 * bf2f(y0[2048 + col]) + w3 * bf2f(y0[3072 + col]); ss += v[j] * v[j]; }
    ss = wave_sum(ss); const float rstd = rsqrtf(ss * (1.f / 1024.f) + 1e-6f);
#pragma unroll
    for (int j = 0; j < 16; ++j) { const int col = lane + 64 * j; out[(size_t)row * 1024 + col] += mod[b * 6144 + 5120 + col] * v[j] * rstd * w[col]; }
}
}
#define GAS __attribute__((address_space(1)))
#define LAS __attribute__((address_space(3)))
typedef GAS unsigned gu32;
#define RLX_AGENT __ATOMIC_RELAXED, __HIP_MEMORY_SCOPE_AGENT
#define XB_TMO      128
#define XB_XCNT(j)  (256  + 64 * (j))
#define XB_XSUB(j)  (1280 + 64 * (j))
#define XB_XGEN(j)  (2304 + 64 * (j))
#define XB_TOP      3328
#define XB_TOPGEN   3392
#define XCD_BAR_WORDS 3456
#define XB_SPIN_CAP (1u << 22)

__device__ __forceinline__ unsigned xb_ld(unsigned* p)              { return __hip_atomic_load(p, __ATOMIC_RELAXED, __HIP_MEMORY_SCOPE_AGENT); }
__device__ __forceinline__ unsigned xb_add(unsigned* p, unsigned v) { return __hip_atomic_fetch_add(p, v, __ATOMIC_RELAXED, __HIP_MEMORY_SCOPE_AGENT); }
__device__ __forceinline__ unsigned xb_xcc_id() { return (unsigned)__builtin_amdgcn_s_getreg((3 << 11) | 20) & 0xFu; }
#define XB_SPIN(cond, bar) do { unsigned _sp = 0; while (cond) { __builtin_amdgcn_s_sleep(1); \
    if ((++_sp & 255u) == 0u) { if (xb_ld(&(bar)[XB_TMO])) break; if (_sp > XB_SPIN_CAP) { atomicAdd(&(bar)[XB_TMO], 1u); break; } } } } while (0)

struct XcdBarrier {
    unsigned* bar; unsigned x;
    volatile LAS unsigned* st;
};
__device__ __forceinline__ XcdBarrier xcd_barrier_post(unsigned* bar, volatile LAS unsigned* st) {
    XcdBarrier b; b.bar = bar; b.x = xb_xcc_id(); b.st = st;
    if (threadIdx.x == 0) (void)xb_add(&bar[XB_XCNT(b.x)], 1u);
    return b;
}
__device__ __forceinline__ void xcd_barrier_complete(unsigned* bar, unsigned x, unsigned& nloc, unsigned& nx) {
    const unsigned G = gridDim.x * gridDim.y * gridDim.z;
    unsigned sum, cnt, mine, sp = 0u;
    for (;;) {
        sum = 0u; cnt = 0u; mine = 0u;
#pragma unroll
        for (unsigned j = 0; j < 16; ++j) { const unsigned c = xb_ld(&bar[XB_XCNT(j)]); sum += c; cnt += (c > 0u) ? 1u : 0u; mine = (j == x) ? c : mine; }
        if (sum == G) break;
        __builtin_amdgcn_s_sleep(1);
        if ((++sp & 255u) == 0u) { if (xb_ld(&bar[XB_TMO])) break; if (sp > XB_SPIN_CAP) { atomicAdd(&bar[XB_TMO], 1u); break; } }
    }
    nloc = mine > 0u ? mine : 1u; nx = cnt > 0u ? cnt : 1u;
}
__device__ __forceinline__ void xcd_barrier(const XcdBarrier& b) {
    asm volatile("s_waitcnt vmcnt(0)" ::: "memory");
    __syncthreads();
    if (threadIdx.x == 0) {
        unsigned* bar = b.bar;
        __builtin_amdgcn_s_waitcnt(0);
        unsigned nloc = b.st[0], nx = b.st[1];
        if (nloc == 0u) { xcd_barrier_complete(bar, b.x, nloc, nx); b.st[0] = nloc; b.st[1] = nx; }
        const unsigned old = xb_add(&bar[XB_XSUB(b.x)], 1u);
        const unsigned gen = old / nloc;
        if (old + 1u == (gen + 1u) * nloc) {
            __builtin_amdgcn_fence(__ATOMIC_RELEASE, "agent");
            asm volatile("s_waitcnt vmcnt(0)" ::: "memory");
            const unsigned og = xb_add(&bar[XB_TOP], 1u);
            const unsigned tg = og / nx;
            if (og + 1u == (tg + 1u) * nx) xb_add(&bar[XB_TOPGEN], 1u);
            else XB_SPIN(xb_ld(&bar[XB_TOPGEN]) == tg, bar);
            __builtin_amdgcn_fence(__ATOMIC_ACQUIRE, "agent");
            xb_add(&bar[XB_XGEN(b.x)], 1u);
            asm volatile("s_waitcnt vmcnt(0)" ::: "memory");
        } else {
            XB_SPIN(xb_ld(&bar[XB_XGEN(b.x)]) == gen, bar);
            __builtin_amdgcn_fence(__ATOMIC_ACQUIRE, "agent");
            asm volatile("s_waitcnt vmcnt(0)" ::: "memory");
        }
    }
    __syncthreads();
}
namespace pg8 {
#define PG8_LAS __attribute__((address_space(3)))
typedef short bf16x8 __attribute__((ext_vector_type(8)));
typedef float f32x4 __attribute__((ext_vector_type(4)));
typedef float f32x2 __attribute__((ext_vector_type(2)));
typedef unsigned u32x4 __attribute__((ext_vector_type(4)));
typedef unsigned u32x2 __attribute__((ext_vector_type(2)));
constexpr int BM = 256, BK = 64, HALF = 128, HTB = HALF * BK * 2  , STAGE_BYTES = 8 * HTB, NXCD = 8, WGM = 8;

__host__ __device__ __forceinline__ int lds_byte(int r, int c) { const int st = (r >> 4) * 2 + (c >> 5), rr = r & 15, cc = c & 31, ob = rr * 64 + cc * 2; return st * 1024 + (ob ^ (((ob >> 9) & 1) << 5)); }
__host__ __device__ __forceinline__ void stage_rc(int b, int& R, int& C) { const int st = b / 1024, sb = b % 1024, swz = sb ^ (((sb >> 9) & 1) << 5); R = (st >> 1) * 16 + swz / 64; C = (st & 1) * 32 + (swz % 64) / 2; }
__host__ __device__ __forceinline__ int perm32(int rho) { const int n = rho >> 4, i = rho & 15; return 8 * (i >> 2) + 4 * n + (i & 3); }

struct Unit { int pm, pn, z, arow, brow; };
struct Gemm { const bf16_t* A; const bf16_t* Bt; int K; };

struct DenseOrder {
    int nM, nN, nwg, G, c;
    __device__ void init(int M, int N, int G_, int c_) { nM = M / BM; nN = N / BM; nwg = nM * nN; G = G_; c = c_; }
    __device__ bool next(int i, Unit& u) const {
        const long L = (long)i * G + c; if (L >= nwg) return false;
        int wgid = (int)L; { const int q = nwg / NXCD, r = nwg % NXCD, xcd = wgid % NXCD, off = wgid / NXCD; wgid = (xcd < r ? xcd * (q + 1) : r * (q + 1) + (xcd - r) * q) + off; }
        const int nig = WGM * nN, gid = wgid / nig, fm = gid * WGM, gsz = (nM - fm) < WGM ? (nM - fm) : WGM;
        u.pm = fm + ((wgid % nig) % gsz); u.pn = (wgid % nig) / gsz; u.z = 0; u.arow = u.pm * BM; u.brow = u.pn * BM; return true;
    }
    __device__ __forceinline__ unsigned row_off(const Unit&, int) const { return 0u; }
};

__device__ __forceinline__ unsigned cvt_pk_bf16(float lo, float hi) { unsigned r; asm volatile("v_cvt_pk_bf16_f32 %0, %1, %2" : "=v"(r) : "v"(lo), "v"(hi)); return r; }


template <class Epi, class Sched, bool GATHER>
__device__ __forceinline__ void gemm_phase(PG8_LAS unsigned char* lds, const Gemm g, const Sched& S, const Epi& E) {
    int tid_ = threadIdx.x; asm volatile("" : "+v"(tid_));
    const int tid = tid_, wid = __builtin_amdgcn_readfirstlane(tid >> 6), lane = tid & 63, wr = wid >> 2, wc = wid & 3, fr = lane & 15, fq = lane >> 4;
    const int K = g.K, nt = K / BK;
    unsigned voffA[2], voffB[2]; int RA[2];
#pragma unroll
    for (int i = 0; i < 2; ++i) { int R, C; stage_rc(tid * 16 + i * 8192, R, C); const int Rb = Epi::PERM ? ((R & ~31) + perm32(R & 31)) : R;
        RA[i] = R; voffA[i] = GATHER ? (unsigned)(C * 2) : (unsigned)(R * K + C) * 2u; voffB[i] = (unsigned)(Rb * K + C) * 2u; }
    const size_t kstep = (size_t)(BK * 2);
    const size_t hstep = (size_t)HALF * K * 2;
    const unsigned ldsw = (unsigned)wid * 1024u;
    const int aoff = lds_byte(wr * 64 + fr, fq * 8), boff = lds_byte(wc * 32 + fr, fq * 8);
    unsigned gAc[2][2], gAn[2][2];
#define PG8_SA(b, h) (((b) * 2 + (h)) * HTB)
#define PG8_SB(b, h) ((4 + (b) * 2 + (h)) * HTB)
#define PG8_STAGE(bufoff, gbase, voff) do { _Pragma("unroll") for (int _i = 0; _i < 2; ++_i) \
        __builtin_amdgcn_global_load_lds((const unsigned*)((const char*)(gbase) + (voff)[_i]), (PG8_LAS unsigned*)(lds + (bufoff) + ldsw + _i * 8192), 16, 0, 0); } while (0)
#define PG8_STAGEA(bufoff, gbase, h, nx) do { if constexpr (GATHER) { _Pragma("unroll") for (int _i = 0; _i < 2; ++_i) { const unsigned _v = ((nx) ? gAn[h][_i] : gAc[h][_i]) + voffA[_i]; \
        __builtin_amdgcn_global_load_lds((const unsigned*)((const char*)(gbase) + _v), (PG8_LAS unsigned*)(lds + (bufoff) + ldsw + _i * 8192), 16, 0, 0); } } \
        else { PG8_STAGE(bufoff, (const char*)(gbase) + (h) * hstep, voffA); } } while (0)
#define PG8_LDA(dst, b, h) do { _Pragma("unroll") for (int m = 0; m < 4; ++m) _Pragma("unroll") for (int k = 0; k < 2; ++k) dst[m][k] = *(const PG8_LAS bf16x8*)(lds + PG8_SA(b, h) + aoff + m * 2048 + k * 1024); } while (0)
#define PG8_LDB(dst, b, h) do { _Pragma("unroll") for (int n = 0; n < 2; ++n) _Pragma("unroll") for (int k = 0; k < 2; ++k) dst[n][k] = *(const PG8_LAS bf16x8*)(lds + PG8_SB(b, h) + boff + n * 2048 + k * 1024); } while (0)
#define PG8_MMA(ai, bj, At, Bt) do { __builtin_amdgcn_s_setprio(1); _Pragma("unroll") for (int m = 0; m < 4; ++m) _Pragma("unroll") for (int n = 0; n < 2; ++n) _Pragma("unroll") for (int k = 0; k < 2; ++k) \
        acc[ai][bj][m][n] = __builtin_amdgcn_mfma_f32_16x16x32_bf16(Bt[n][k], At[m][k], acc[ai][bj][m][n], 0, 0, 0); __builtin_amdgcn_s_setprio(0); } while (0)
#define PG8_WAIT_V(n) asm volatile("s_waitcnt vmcnt(" #n ")" ::: "memory")
#define PG8_WAIT_L(n) asm volatile("s_waitcnt lgkmcnt(" #n ")" ::: "memory")
#define PG8_BAR __builtin_amdgcn_s_barrier()
#define PG8_SCHED __builtin_amdgcn_sched_barrier(0)
    Unit cur, nxt; int ui = 0;
    if (!S.next(0, cur)) return;
    f32x4 acc[2][2][4][2];
#pragma unroll
    for (int a = 0; a < 2; ++a)
#pragma unroll
        for (int b = 0; b < 2; ++b)
#pragma unroll
            for (int m = 0; m < 4; ++m)
#pragma unroll
                for (int n = 0; n < 2; ++n) acc[a][b][m][n] = (f32x4){0.f, 0.f, 0.f, 0.f};
    bf16x8 At[4][2], B0[2][2], B1[2][2];
    const char* cA = GATHER ? (const char*)g.A : (const char*)g.A + (size_t)cur.arow * K * 2; const char* cB = (const char*)g.Bt + (size_t)cur.brow * K * 2;
    if constexpr (GATHER) {
#pragma unroll
        for (int h = 0; h < 2; ++h)
#pragma unroll
            for (int i = 0; i < 2; ++i) { gAc[h][i] = S.row_off(cur, h * HALF + RA[i]); gAn[h][i] = gAc[h][i]; }
    }
    PG8_STAGE(PG8_SB(0, 0), cB, voffB); PG8_STAGE(PG8_SB(0, 1), cB + hstep, voffB); PG8_STAGEA(PG8_SA(0, 0), cA, 0, false); PG8_STAGEA(PG8_SA(0, 1), cA, 1, false);
    if (wr == 1) PG8_BAR;
    PG8_WAIT_V(2); PG8_BAR;
    PG8_STAGE(PG8_SB(1, 0), cB + kstep, voffB); PG8_STAGEA(PG8_SA(1, 0), cA + kstep, 0, false); PG8_STAGE(PG8_SB(1, 1), cB + hstep + kstep, voffB);
    PG8_WAIT_V(6); PG8_BAR;
    for (;;) {
        const bool has_next = S.next(ui + 1, nxt);
        const char* nA = has_next ? (GATHER ? (const char*)g.A : (const char*)g.A + (size_t)nxt.arow * K * 2) : cA; const char* nB = has_next ? (const char*)g.Bt + (size_t)nxt.brow * K * 2 : cB;
        if constexpr (GATHER) { if (has_next) {
#pragma unroll
            for (int h = 0; h < 2; ++h)
#pragma unroll
                for (int i = 0; i < 2; ++i) gAn[h][i] = S.row_off(nxt, h * HALF + RA[i]); } }
        for (int t = 0; t < nt; t += 2) {
            const bool last = (t == nt - 2);
            const char* a1 = cA + (size_t)(t + 1) * kstep;
            const char* a2 = last ? nA : cA + (size_t)(t + 2) * kstep; const char* b2 = last ? nB : cB + (size_t)(t + 2) * kstep;
            const char* a3 = a2 + kstep; const char* b3 = b2 + kstep;
            PG8_LDB(B0, 0, 0); PG8_LDB(B1, 0, 1); PG8_SCHED; PG8_LDA(At, 0, 0); PG8_STAGEA(PG8_SA(1, 1), a1, 1, false);
            PG8_WAIT_V(8); PG8_WAIT_L(0); PG8_BAR; PG8_MMA(0, 0, At, B0); PG8_MMA(0, 1, At, B1); PG8_BAR; PG8_SCHED;
            PG8_LDA(At, 0, 1); PG8_STAGE(PG8_SB(0, 0), b2, voffB); PG8_STAGE(PG8_SB(0, 1), b2 + hstep, voffB); PG8_STAGEA(PG8_SA(0, 0), a2, 0, last);
            PG8_WAIT_V(8); PG8_WAIT_L(0); PG8_BAR; PG8_MMA(1, 0, At, B0); PG8_MMA(1, 1, At, B1); PG8_BAR; PG8_SCHED;
            PG8_LDB(B0, 1, 0); PG8_LDB(B1, 1, 1); PG8_SCHED; PG8_LDA(At, 1, 0); PG8_STAGEA(PG8_SA(0, 1), a2, 1, last);
            PG8_WAIT_V(8); PG8_WAIT_L(0); PG8_BAR; PG8_MMA(0, 0, At, B0); PG8_MMA(0, 1, At, B1); PG8_BAR; PG8_SCHED;
            PG8_LDA(At, 1, 1); PG8_STAGE(PG8_SB(1, 0), b3, voffB); PG8_STAGE(PG8_SB(1, 1), b3 + hstep, voffB); PG8_STAGEA(PG8_SA(1, 0), a3, 0, last);
            PG8_WAIT_V(8); PG8_WAIT_L(0); PG8_BAR; PG8_MMA(1, 0, At, B0); PG8_MMA(1, 1, At, B1); PG8_BAR; PG8_SCHED;
        }
        if (wr == 0) PG8_BAR;
        E(acc, cur, wr, wc, fr, fq);
        if (!has_next) break;
#pragma unroll
        for (int a = 0; a < 2; ++a)
#pragma unroll
            for (int b = 0; b < 2; ++b)
#pragma unroll
                for (int m = 0; m < 4; ++m)
#pragma unroll
                    for (int n = 0; n < 2; ++n) acc[a][b][m][n] = (f32x4){0.f, 0.f, 0.f, 0.f};
        cur = nxt; cA = nA; cB = nB; ++ui;
        if constexpr (GATHER) {
#pragma unroll
            for (int h = 0; h < 2; ++h)
#pragma unroll
                for (int i = 0; i < 2; ++i) gAc[h][i] = gAn[h][i];
        }
        if (wr == 1) PG8_BAR;
    }
    PG8_WAIT_V(0);
    PG8_BAR;
#undef PG8_SA
#undef PG8_SB
#undef PG8_STAGE
#undef PG8_STAGEA
#undef PG8_LDA
#undef PG8_LDB
#undef PG8_MMA
#undef PG8_WAIT_V
#undef PG8_WAIT_L
#undef PG8_BAR
#undef PG8_SCHED
}
}
namespace at {
typedef short bf16x8 __attribute__((ext_vector_type(8)));
typedef short s16x4 __attribute__((ext_vector_type(4)));
typedef float f32x16 __attribute__((ext_vector_type(16)));
typedef unsigned u32x4 __attribute__((ext_vector_type(4)));
typedef __attribute__((address_space(3))) const char* lds_cptr;
typedef short v4i16_t __attribute__((ext_vector_type(4)));
constexpr int SLOT = 32768, L_WSF = 3 * SLOT;
constexpr float C2 = 0.125f * 1.4426950408889634f;
__device__ __forceinline__ int crow(int r, int hi) { return (r & 3) + 8 * (r >> 2) + 4 * hi; }
__device__ __forceinline__ void glds16(const void* gsrc, unsigned lds_dst) { unsigned keep;
    asm volatile("s_mov_b32 %0, m0\n\ts_mov_b32 m0, %2\n\ts_nop 0\n\tglobal_load_lds_dwordx4 %1, off\n\ts_mov_b32 m0, %0" : "=&s"(keep) : "v"(gsrc), "s"(lds_dst) : "memory"); }
typedef float f32x2_t __attribute__((ext_vector_type(2))); typedef __bf16 bf16x2_t __attribute__((ext_vector_type(2)));
__device__ __forceinline__ unsigned cvtpk(float lo, float hi) { f32x2_t v = {lo, hi}; bf16x2_t b = __builtin_convertvector(v, bf16x2_t); return __builtin_bit_cast(unsigned, b); }
__device__ __forceinline__ s16x4 vtr(lds_cptr p) { return __builtin_bit_cast(s16x4, __builtin_amdgcn_ds_read_tr16_b64_v4i16((__attribute__((address_space(3))) v4i16_t*)p)); }
#define AT_WAIT_BAR(N) asm volatile("s_waitcnt vmcnt(" #N ") lgkmcnt(0)\n\ts_barrier" ::: "memory")

__device__ __forceinline__ void attn_unit(__attribute__((address_space(3))) unsigned char* lds, const bf16_t* QKR, const bf16_t* PROJ, bf16_t* YA, const float* subln, float lam,
                                          int b, int h, int blk, int tid) {
    typedef __attribute__((address_space(3))) float lds_f;
    const int lane = tid & 63, r32 = lane & 31, hi = lane >> 5; const int w = __builtin_amdgcn_readfirstlane(tid >> 6), m = w & 1, rg = w >> 1;
    const int NT = 2 * blk + 2, my_nt = (rg < 2) ? NT - 1 : NT;
    const size_t tokb = (size_t)b * 8192;
    const unsigned lds0 = (unsigned)(size_t)lds;
    const bf16_t* ksrc0 = QKR + (tokb + lane) * 1024 + 512 + h * 128 + (2 * w) * 8;
    const bf16_t* vsrc0 = PROJ + (tokb + ((2 * w) & 3) * 16 + (lane >> 2)) * 5632 + 1024 + h * 128 + (w >> 1) * 32 + (lane & 3) * 8;
#define AT_DMA(t, slotoff) do { const bf16_t* ks_ = ksrc0 + (size_t)(t) * 64 * 1024; const bf16_t* vs_ = vsrc0 + (size_t)(t) * 64 * 5632; \
        const unsigned kd_ = (unsigned)__builtin_amdgcn_readfirstlane(lds0 + (unsigned)(slotoff) + (unsigned)w * 2048u); \
        glds16(ks_, kd_); glds16(ks_ + 8, kd_ + 1024u); glds16(vs_, kd_ + 16384u); glds16(vs_ + 16 * 5632, kd_ + 16384u + 1024u); } while (0)
    AT_DMA(0, 0); AT_DMA(1, SLOT);
    bf16x8 qr[4];
    { const bf16_t* qp = QKR + (tokb + blk * 128 + rg * 32 + r32) * 1024 + h * 128 + m * 64 + hi * 8;
#pragma unroll
      for (int d0 = 0; d0 < 4; ++d0) qr[d0] = *(const bf16x8*)(qp + d0 * 16); }
    f32x16 o[4];
#pragma unroll
    for (int i = 0; i < 4; ++i) o[i] = f32x16{};
    float m_run = -1e30f, lsum = 0.f;
    lds_f* wsf = (lds_f*)(lds + L_WSF) + w * 32;
    int slot = 0, slot2 = 2 * SLOT;
    for (int t = 0; t < NT; ++t) {
        if (t + 1 < NT) { AT_WAIT_BAR(4); } else { AT_WAIT_BAR(0); }
        if (t + 2 < NT) AT_DMA(t + 2, slot2);
        if (t < my_nt) {
            const lds_cptr kp = (lds_cptr)(lds + slot) + (m * 8 + hi) * 1024 + r32 * 16;
            f32x16 p0 = f32x16{}, p1 = f32x16{};
#pragma unroll
            for (int d0 = 0; d0 < 4; ++d0) { const bf16x8 k0 = *(const __attribute__((address_space(3))) bf16x8*)(kp + d0 * 2048), k1 = *(const __attribute__((address_space(3))) bf16x8*)(kp + d0 * 2048 + 512);
                p0 = __builtin_amdgcn_mfma_f32_32x32x16_bf16(k0, qr[d0], p0, 0, 0, 0); p1 = __builtin_amdgcn_mfma_f32_32x32x16_bf16(k1, qr[d0], p1, 0, 0, 0); }
            float rm = fmaxf(p0[0], p1[0]);
#pragma unroll
            for (int r = 1; r < 16; ++r) rm = fmaxf(rm, fmaxf(p0[r], p1[r]));
            { auto rr = __builtin_amdgcn_permlane32_swap(__float_as_uint(rm), __float_as_uint(rm), false, false); rm = fmaxf(__uint_as_float(rr[0]), __uint_as_float(rr[1])); }
            if (__any(rm > m_run + 8.f)) {
                const float mn = fmaxf(m_run, rm); const float f = __builtin_amdgcn_exp2f(m_run - mn); lsum *= f; m_run = mn;
                if (hi == 0) wsf[r32] = f;
                asm volatile("s_waitcnt lgkmcnt(0)" ::: "memory");
#pragma unroll
                for (int r = 0; r < 16; ++r) { const float fr_ = wsf[crow(r, hi)];
#pragma unroll
                    for (int d = 0; d < 4; ++d) o[d][r] *= fr_; }
                asm volatile("s_waitcnt lgkmcnt(0)" ::: "memory");
            }
            float sacc = 0.f;
#pragma unroll
            for (int r = 0; r < 16; ++r) { p0[r] = __builtin_amdgcn_exp2f(p0[r] - m_run); p1[r] = __builtin_amdgcn_exp2f(p1[r] - m_run); sacc += p0[r] + p1[r]; }
            lsum += sacc;
            bf16x8 pa[4];
            pa[0] = __builtin_bit_cast(bf16x8, (u32x4){cvtpk(p0[0], p0[1]), cvtpk(p0[2], p0[3]), cvtpk(p0[4], p0[5]), cvtpk(p0[6], p0[7])});
            pa[1] = __builtin_bit_cast(bf16x8, (u32x4){cvtpk(p0[8], p0[9]), cvtpk(p0[10], p0[11]), cvtpk(p0[12], p0[13]), cvtpk(p0[14], p0[15])});
            pa[2] = __builtin_bit_cast(bf16x8, (u32x4){cvtpk(p1[0], p1[1]), cvtpk(p1[2], p1[3]), cvtpk(p1[4], p1[5]), cvtpk(p1[6], p1[7])});
            pa[3] = __builtin_bit_cast(bf16x8, (u32x4){cvtpk(p1[8], p1[9]), cvtpk(p1[10], p1[11]), cvtpk(p1[12], p1[13]), cvtpk(p1[14], p1[15])});
            const lds_cptr vp = (lds_cptr)(lds + slot + 16384) + ((lane >> 4) & 1) * 32 + (lane & 3) * 8 + (4 * hi + ((lane & 15) >> 2)) * 64;
#pragma unroll
            for (int d = 0; d < 4; ++d) {
#pragma unroll
                for (int ks = 0; ks < 4; ++ks) { const s16x4 lo_ = vtr(vp + d * 4096 + ks * 1024), hi_ = vtr(vp + d * 4096 + ks * 1024 + 512);
                    const bf16x8 vf = (bf16x8){lo_[0], lo_[1], lo_[2], lo_[3], hi_[0], hi_[1], hi_[2], hi_[3]};
                    o[d] = __builtin_amdgcn_mfma_f32_32x32x16_bf16(pa[ks], vf, o[d], 0, 0, 0); } }
        }
        slot = (slot == 2 * SLOT) ? 0 : slot + SLOT; slot2 = (slot2 == 2 * SLOT) ? 0 : slot2 + SLOT;
    }
    { auto rr = __builtin_amdgcn_permlane32_swap(__float_as_uint(lsum), __float_as_uint(lsum), false, false); lsum = __uint_as_float(rr[0]) + __uint_as_float(rr[1]); }
    if (hi == 0) wsf[r32] = (m == 0 ? 1.f : -lam) / lsum;
    asm volatile("s_waitcnt lgkmcnt(0)" ::: "memory");
#pragma unroll
    for (int r = 0; r < 16; ++r) { const float fr_ = wsf[crow(r, hi)];
#pragma unroll
        for (int d = 0; d < 4; ++d) o[d][r] *= fr_; }
    AT_WAIT_BAR(0);
    lds_f* X = (lds_f*)lds + rg * 4096;
    if (m == 1) {
#pragma unroll
        for (int d = 0; d < 4; ++d)
#pragma unroll
            for (int r = 0; r < 16; ++r) X[(d * 16 + r) * 64 + lane] = o[d][r];
    }
    AT_WAIT_BAR(0);
    if (m == 0) {
        float ssq[16];
#pragma unroll
        for (int r = 0; r < 16; ++r) { float s = 0.f;
#pragma unroll
            for (int d = 0; d < 4; ++d) { o[d][r] += X[(d * 16 + r) * 64 + lane]; s += o[d][r] * o[d][r]; }
            ssq[r] = s; }
#pragma unroll
        for (int r = 0; r < 16; ++r) { float s = ssq[r];
#pragma unroll
            for (int of = 1; of < 32; of <<= 1) s += __shfl_xor(s, of);
            ssq[r] = rsqrtf(s * (1.f / 128.f) + 1e-6f) * 0.8f; }
        float sw[4];
#pragma unroll
        for (int d = 0; d < 4; ++d) sw[d] = subln[d * 32 + r32];
        bf16_t* yp = YA + (tokb + blk * 128 + rg * 32) * 512 + h * 128 + r32;
#pragma unroll
        for (int r = 0; r < 16; ++r)
#pragma unroll
            for (int d = 0; d < 4; ++d) yp[(size_t)crow(r, hi) * 512 + d * 32] = f2bf(o[d][r] * ssq[r] * sw[d]);
    }
    AT_WAIT_BAR(0);
#undef AT_DMA
}
}
namespace hg {
using at::bf16x8; using at::s16x4; using at::f32x16; using at::u32x4; using at::lds_cptr; using at::crow; using at::vtr; using at::cvtpk;
typedef __attribute__((address_space(3))) unsigned char lds_u8;
typedef __attribute__((address_space(3))) float lds_f;
typedef __attribute__((address_space(3))) bf16_t lds_h;
__device__ __forceinline__ float sigm(float x) { return 1.f / (1.f + __expf(-x)); }
__device__ __forceinline__ bf16x8 mkfrag(s16x4 a, s16x4 b) { return (bf16x8){a[0], a[1], a[2], a[3], b[0], b[1], b[2], b[3]}; }
template <int ROWS>
__device__ __forceinline__ void copy_img(lds_u8* lds, int off, const bf16_t* g, size_t gp, int tid) {
#pragma unroll
    for (int i = 0; i < ROWS * 16 / 512; ++i) { const int p = tid + 512 * i, r = p >> 4, q = p & 15;
        const u32x4 v = *(const u32x4*)(g + (size_t)r * gp + q * 8);
        *(__attribute__((address_space(3))) u32x4*)(lds + off + (q >> 2) * (ROWS * 64) + r * 64 + (q & 3) * 16) = v; }
}
__device__ __forceinline__ void copy_raw(lds_u8* lds, int off, const bf16_t* g, size_t gp, int tid) {
#pragma unroll
    for (int i = 0; i < 2; ++i) { const int p = tid + 512 * i, r = p >> 4, q = p & 15;
        const u32x4 v = *(const u32x4*)(g + (size_t)r * gp + q * 8);
        *(__attribute__((address_space(3))) u32x4*)(lds + off + r * 256 + q * 16) = v; }
}
__device__ __forceinline__ void gates(lds_u8* lds, int psum_off, int rawf_off, float lb, int tid, float (&f)[16], float (&G)[16], float& glast) {
    const int d = tid & 127, part = tid >> 7; lds_f* psum = (lds_f*)(lds + psum_off); const lds_h* rf = (const lds_h*)(lds + rawf_off) + part * 16 * 128 + d;
    float g = 0.f;
#pragma unroll
    for (int i = 0; i < 16; ++i) { const float raw = bf2f(rf[i * 128]); f[i] = lb + (1.f - lb) * sigm(raw); g += __logf(f[i]); G[i] = g; }
    psum[part * 128 + d] = g;
    __syncthreads();
    const float p0 = psum[d], p1 = psum[128 + d], p2 = psum[256 + d], p3 = psum[384 + d];
    const float offs = (part > 0 ? p0 : 0.f) + (part > 1 ? p1 : 0.f) + (part > 2 ? p2 : 0.f);
    glast = (p0 + p1) + (p2 + p3);
#pragma unroll
    for (int i = 0; i < 16; ++i) G[i] += offs;
}
constexpr int A_KD = 0, A_V = 16384, A_PS = 32768, A_RAWF = 36864, A_OUT = 53248;
__device__ __forceinline__ void hgA_unit(lds_u8* lds, const bf16_t* PROJ, const float* SCAL, bf16_t* DS, float* DEC, int bh, int n, int tid) {
    const int h = bh & 3, b = bh >> 2, lane = tid & 63, r32 = lane & 31, hi = lane >> 5, w = __builtin_amdgcn_readfirstlane(tid >> 6), d = tid & 127, part = tid >> 7;
    const size_t tok0 = (size_t)b * 8192 + n * 64;
    __syncthreads();
    copy_img<64>(lds, A_V, PROJ + tok0 * 5632 + 2560 + h * 128, 5632, tid);
    copy_raw(lds, A_RAWF, PROJ + tok0 * 5632 + 2048 + h * 128, 5632, tid);
    __syncthreads();
    float f[16], G[16], glast;
    gates(lds, A_PS, A_RAWF, SCAL[64 + h * 128 + d], tid, f, G, glast);
    lds_h* kd = (lds_h*)(lds + A_KD) + (d >> 5) * 2048 + (d & 31);
#pragma unroll
    for (int i = 0; i < 16; ++i) kd[(part * 16 + i) * 32] = f2bf((1.f - f[i]) * __expf(glast - G[i]));
    if (part == 0) DEC[(size_t)(bh * 128 + n) * 128 + d] = __expf(glast);
    __syncthreads();
    const int dt = w >> 1, vh = w & 1;
    const int lof = ((lane >> 4) & 1) * 32 + (lane & 3) * 8 + (8 * hi + ((lane & 15) >> 2)) * 64;
    const lds_cptr ap = (lds_cptr)(lds + A_KD) + dt * 4096 + lof;
    f32x16 acc[2] = {f32x16{}, f32x16{}};
#pragma unroll
    for (int ks = 0; ks < 4; ++ks) { const bf16x8 af = mkfrag(vtr(ap + ks * 1024), vtr(ap + ks * 1024 + 256));
#pragma unroll
        for (int t = 0; t < 2; ++t) { const lds_cptr bp = (lds_cptr)(lds + A_V) + (2 * vh + t) * 4096 + lof;
            const bf16x8 bfr = mkfrag(vtr(bp + ks * 1024), vtr(bp + ks * 1024 + 256));
            acc[t] = __builtin_amdgcn_mfma_f32_32x32x16_bf16(af, bfr, acc[t], 0, 0, 0); } }
    lds_h* ot = (lds_h*)(lds + A_OUT) + (dt * 32) * 128 + vh * 64 + r32;
#pragma unroll
    for (int t = 0; t < 2; ++t)
#pragma unroll
        for (int r = 0; r < 16; ++r) ot[crow(r, hi) * 128 + t * 32] = f2bf(acc[t][r]);
    __syncthreads();
    bf16_t* dst = DS + (size_t)(bh * 128 + n) * 16384;
#pragma unroll
    for (int i = 0; i < 4; ++i) { const int p = tid + 512 * i; *(u32x4*)(dst + p * 8) = *(const __attribute__((address_space(3))) u32x4*)(lds + A_OUT + p * 16); }
}
constexpr int C_QT = 0, C_KT = 16384, C_V = 32768, C_SP = 49152, C_PS = 81920, C_RAWF = 86016, C_RAWQ = 102400, C_OT = 86016;
__device__ __forceinline__ void hgC_unit(lds_u8* lds, const bf16_t* PROJ, const float* SCAL, const bf16_t* SP, const float* hgnorm, bf16_t* YB, int bh, int n, int tid) {
    const int h = bh & 3, b = bh >> 2, lane = tid & 63, r32 = lane & 31, hi = lane >> 5, w = __builtin_amdgcn_readfirstlane(tid >> 6), d = tid & 127, part = tid >> 7;
    const size_t tok0 = (size_t)b * 8192 + n * 64;
    __syncthreads();
    copy_img<64>(lds, C_V, PROJ + tok0 * 5632 + 2560 + h * 128, 5632, tid);
    copy_img<128>(lds, C_SP, SP + (size_t)(bh * 128 + n) * 16384, 128, tid);
    copy_raw(lds, C_RAWF, PROJ + tok0 * 5632 + 2048 + h * 128, 5632, tid);
    copy_raw(lds, C_RAWQ, PROJ + tok0 * 5632 + 1536 + h * 128, 5632, tid);
    __syncthreads();
    { float f[16], G[16], glast;
      gates(lds, C_PS, C_RAWF, SCAL[64 + h * 128 + d], tid, f, G, glast);
      const lds_h* rq = (const lds_h*)(lds + C_RAWQ) + part * 16 * 128 + d;
      lds_h* qt = (lds_h*)(lds + C_QT) + (d >> 3) * 512 + (d & 7) + part * 16 * 8; lds_h* kt = (lds_h*)(lds + C_KT) + (d >> 3) * 512 + (d & 7) + part * 16 * 8;
#pragma unroll
      for (int i = 0; i < 16; ++i) { const float q = bf2f(rq[i * 128]); const float eg = __expf(G[i]);
          qt[i * 8] = f2bf(q * sigm(q) * eg); kt[i * 8] = f2bf((1.f - f[i]) / eg); } }
    __syncthreads();
    const int ct = w & 1, vb = w >> 1;
    bf16x8 qf[8];
    { const lds_cptr qp = (lds_cptr)(lds + C_QT) + hi * 1024 + (32 * ct + r32) * 16;
#pragma unroll
      for (int ks = 0; ks < 8; ++ks) qf[ks] = *(const __attribute__((address_space(3))) bf16x8*)(qp + ks * 2048); }
    f32x16 o = f32x16{};
#pragma unroll
    for (int sh = 0; sh < 2; ++sh) { if (sh <= ct) {
        const lds_cptr kp = (lds_cptr)(lds + C_KT) + hi * 1024 + (32 * sh + r32) * 16;
        f32x16 p = f32x16{};
#pragma unroll
        for (int ks = 0; ks < 8; ++ks) { const bf16x8 kf = *(const __attribute__((address_space(3))) bf16x8*)(kp + ks * 2048); p = __builtin_amdgcn_mfma_f32_32x32x16_bf16(kf, qf[ks], p, 0, 0, 0); }
        const int cc = 32 * ct + r32;
#pragma unroll
        for (int r = 0; r < 16; ++r) { const int s = 32 * sh + crow(r, hi); if (s > cc) p[r] = 0.f; }
        const bf16x8 pa0 = __builtin_bit_cast(bf16x8, (u32x4){cvtpk(p[0], p[1]), cvtpk(p[2], p[3]), cvtpk(p[4], p[5]), cvtpk(p[6], p[7])});
        const bf16x8 pa1 = __builtin_bit_cast(bf16x8, (u32x4){cvtpk(p[8], p[9]), cvtpk(p[10], p[11]), cvtpk(p[12], p[13]), cvtpk(p[14], p[15])});
        const lds_cptr vp = (lds_cptr)(lds + C_V) + vb * 4096 + ((lane >> 4) & 1) * 32 + (lane & 3) * 8 + (4 * hi + ((lane & 15) >> 2)) * 64 + sh * 2048;
        o = __builtin_amdgcn_mfma_f32_32x32x16_bf16(pa0, mkfrag(vtr(vp), vtr(vp + 512)), o, 0, 0, 0);
        o = __builtin_amdgcn_mfma_f32_32x32x16_bf16(pa1, mkfrag(vtr(vp + 1024), vtr(vp + 1024 + 512)), o, 0, 0, 0); } }
    { const lds_cptr sp = (lds_cptr)(lds + C_SP) + vb * 8192 + ((lane >> 4) & 1) * 32 + (lane & 3) * 8 + (8 * hi + ((lane & 15) >> 2)) * 64;
#pragma unroll
      for (int ks = 0; ks < 8; ++ks) o = __builtin_amdgcn_mfma_f32_32x32x16_bf16(qf[ks], mkfrag(vtr(sp + ks * 1024), vtr(sp + ks * 1024 + 256)), o, 0, 0, 0); }
    { lds_f* ot = (lds_f*)(lds + C_OT) + (32 * ct) * 128 + 32 * vb + r32;
#pragma unroll
      for (int r = 0; r < 16; ++r) ot[crow(r, hi) * 128] = o[r]; }
    __syncthreads();
    { const int c = tid >> 3, sg = tid & 7; const __attribute__((address_space(3))) at::u32x4* orow = (const __attribute__((address_space(3))) at::u32x4*)(lds + C_OT + c * 512 + sg * 64);
      float ov[16]; float ss = 0.f;
#pragma unroll
      for (int q = 0; q < 4; ++q) { const at::u32x4 t4 = orow[q]; ov[4 * q] = __uint_as_float(t4.x); ov[4 * q + 1] = __uint_as_float(t4.y); ov[4 * q + 2] = __uint_as_float(t4.z); ov[4 * q + 3] = __uint_as_float(t4.w); }
#pragma unroll
      for (int q = 0; q < 16; ++q) ss += ov[q] * ov[q];
      ss += __shfl_xor(ss, 1); ss += __shfl_xor(ss, 2); ss += __shfl_xor(ss, 4);
      const float rstd = rsqrtf(ss * (1.f / 128.f) + 1e-6f);
      const bf16_t* gp = PROJ + (tok0 + c) * 5632 + 3072 + h * 128 + sg * 16; const u32x4 g0 = *(const u32x4*)gp, g1 = *(const u32x4*)(gp + 8);
      const unsigned gw[8] = {g0.x, g0.y, g0.z, g0.w, g1.x, g1.y, g1.z, g1.w}; unsigned ow[8];
#pragma unroll
      for (int q = 0; q < 8; ++q) { const float ga = __uint_as_float(gw[q] << 16), gb = __uint_as_float(gw[q] & 0xffff0000u);
          const float ra = ov[2 * q] * rstd * hgnorm[sg * 16 + 2 * q] * (ga * sigm(ga)), rb = ov[2 * q + 1] * rstd * hgnorm[sg * 16 + 2 * q + 1] * (gb * sigm(gb));
          ow[q] = cvtpk(ra, rb); }
      bf16_t* dst = YB + (tok0 + c) * 512 + h * 128 + sg * 16; *(u32x4*)dst = (u32x4){ow[0], ow[1], ow[2], ow[3]}; *(u32x4*)(dst + 8) = (u32x4){ow[4], ow[5], ow[6], ow[7]}; }
}
}
namespace mk {
using pg8::f32x4; using pg8::u32x4; using pg8::u32x2; using pg8::Unit;
constexpr int NWAVES = 8, NTHR = 512;
constexpr int RING_BYTES = 131072, LDSCTL_OFF = RING_BYTES, LDS_BYTES = 147456;
constexpr int LW_BAR = 0, LW_TPRE = 16  , LW_CNT = 64  , LW_MISC = 128;
enum Phase { PH_PRO = 0, PH_H1, PH_G1, PH_ROPE_HGA, PH_ATT_SCAN, PH_HGC, PH_G2A, PH_G2B, PH_G3, PH_TOK, PH_G4, PH_G5, PH_FIN, PH_N };

struct Args {
    const float* in[25]; float* out; unsigned char* ws; int ph_lo, ph_hi, li, pad;
};

__device__ __forceinline__ float wave_sum(float v) {
#pragma unroll
    for (int o = 1; o < 64; o <<= 1) v += __shfl_xor(v, o);
    return v;
}
__device__ __forceinline__ float sigm(float x) { return 1.f / (1.f + __expf(-x)); }
__device__ __forceinline__ unsigned pk2(float lo, float hi) { return (unsigned)f2bf(lo) | ((unsigned)f2bf(hi) << 16); }

struct EpiBf16 {
    static constexpr bool PERM = true;
    bf16_t* O; int ldc;
    __device__ __forceinline__ void operator()(const f32x4 (&acc)[2][2][4][2], const Unit& u, int wr, int wc, int fr, int fq) const {
        const int row0 = u.pm * 256 + wr * 64 + fr, col0 = u.pn * 256 + wc * 32 + 8 * fq;
#pragma unroll
        for (int ai = 0; ai < 2; ++ai)
#pragma unroll
            for (int m = 0; m < 4; ++m) { bf16_t* rowp = O + (size_t)(row0 + ai * 128 + m * 16) * ldc + col0;
#pragma unroll
                for (int bj = 0; bj < 2; ++bj) { const f32x4 v0 = acc[ai][bj][m][0], v1 = acc[ai][bj][m][1]; u32x4 w; w.x = pk2(v0[0], v0[1]); w.y = pk2(v0[2], v0[3]); w.z = pk2(v1[0], v1[1]); w.w = pk2(v1[2], v1[3]);
                    *(u32x4*)(rowp + bj * 128) = w; } }
    }
};
struct EpiF32 {
    static constexpr bool PERM = false;
    float* O; int ldc;
    __device__ __forceinline__ void operator()(const f32x4 (&acc)[2][2][4][2], const Unit& u, int wr, int wc, int fr, int fq) const {
        const int row0 = u.pm * 256 + wr * 64 + fr, col0 = u.pn * 256 + wc * 32 + 4 * fq;
#pragma unroll
        for (int ai = 0; ai < 2; ++ai)
#pragma unroll
            for (int m = 0; m < 4; ++m) { float* rowp = O + (size_t)(row0 + ai * 128 + m * 16) * ldc + col0;
#pragma unroll
                for (int bj = 0; bj < 2; ++bj)
#pragma unroll
                    for (int n = 0; n < 2; ++n) *(f32x4*)(rowp + bj * 128 + n * 16) = acc[ai][bj][m][n]; }
    }
};
template <bool SECOND> struct EpiBranch {
    static constexpr bool PERM = false;
    float* tmp; const bf16_t* proj; bf16_t* merged;
    __device__ __forceinline__ void operator()(const f32x4 (&acc)[2][2][4][2], const Unit& u, int wr, int wc, int fr, int fq) const {
        const int row0 = u.pm * 256 + wr * 64 + fr, col0 = u.pn * 256 + wc * 32 + 4 * fq;
#pragma unroll
        for (int ai = 0; ai < 2; ++ai)
#pragma unroll
            for (int m = 0; m < 4; ++m) { const size_t row = (size_t)(row0 + ai * 128 + m * 16);
#pragma unroll
                for (int bj = 0; bj < 2; ++bj)
#pragma unroll
                    for (int n = 0; n < 2; ++n) { const int col = col0 + bj * 128 + n * 16; const f32x4 a = acc[ai][bj][m][n];
                        const u32x2 gw = *(const u32x2*)(proj + row * 5632 + (SECOND ? 4608 : 3584) + col);
                        f32x4 gt; gt[0] = sigm(__uint_as_float(gw.x << 16)); gt[1] = sigm(__uint_as_float(gw.x & 0xffff0000u)); gt[2] = sigm(__uint_as_float(gw.y << 16)); gt[3] = sigm(__uint_as_float(gw.y & 0xffff0000u));
                        if (!SECOND) { *(f32x4*)(tmp + row * 1024 + col) = gt * a; }
                        else { const f32x4 t = *(const f32x4*)(tmp + row * 1024 + col); const f32x4 r = t + gt * a; u32x2 w; w.x = pk2(r[0], r[1]); w.y = pk2(r[2], r[3]); *(u32x2*)(merged + row * 1024 + col) = w; } } }
    }
};
struct EpiGateUp {
    static constexpr bool PERM = true;
    const float* bgu; bf16_t* act;
    __device__ __forceinline__ void operator()(const f32x4 (&acc)[2][2][4][2], const Unit& u, int wr, int wc, int fr, int fq) const {
        const int e = u.z, colA = u.pn * 128 + wc * 32 + 8 * fq;
        f32x4 bg[2], bu[2];
#pragma unroll
        for (int n = 0; n < 2; ++n) { bg[n] = *(const f32x4*)(bgu + e * 2048 + colA + 4 * n); bu[n] = *(const f32x4*)(bgu + e * 2048 + 1024 + colA + 4 * n); }
#pragma unroll
        for (int ai = 0; ai < 2; ++ai)
#pragma unroll
            for (int m = 0; m < 4; ++m) { const size_t slot = (size_t)(u.arow + ai * 128 + wr * 64 + m * 16 + fr); unsigned w[4];
#pragma unroll
                for (int n = 0; n < 2; ++n) { float r[4];
#pragma unroll
                    for (int j = 0; j < 4; ++j) { float g = acc[ai][0][m][n][j] + bg[n][j], uu = acc[ai][1][m][n][j] + bu[n][j]; g = fminf(g, 7.f); uu = fminf(fmaxf(uu, -7.f), 7.f); r[j] = (uu + 1.f) * g * sigm(1.702f * g); }
                    w[2 * n] = pk2(r[0], r[1]); w[2 * n + 1] = pk2(r[2], r[3]); }
                *(u32x4*)(act + slot * 1024 + colA) = (u32x4){w[0], w[1], w[2], w[3]}; }
    }
};
struct EpiDown {
    static constexpr bool PERM = true;
    const float* bd; const int* list; bf16_t* ym; const LAS int* cnt;
    __device__ __forceinline__ void operator()(const f32x4 (&acc)[2][2][4][2], const Unit& u, int wr, int wc, int fr, int fq) const {
        const int e = u.z, nvalid = cnt[e] - u.pm * 256, col0 = u.pn * 256 + wc * 32 + 8 * fq;
        f32x4 bv[2][2];
#pragma unroll
        for (int bj = 0; bj < 2; ++bj)
#pragma unroll
            for (int n = 0; n < 2; ++n) bv[bj][n] = *(const f32x4*)(bd + e * 1024 + col0 + bj * 128 + 4 * n);
#pragma unroll
        for (int ai = 0; ai < 2; ++ai)
#pragma unroll
            for (int m = 0; m < 4; ++m) { const int r = ai * 128 + wr * 64 + m * 16 + fr;
                if (r < nvalid) { const int a = list[(size_t)e * 32768 + u.pm * 256 + r]; bf16_t* rowp = ym + (size_t)a * 1024 + col0;
#pragma unroll
                    for (int bj = 0; bj < 2; ++bj) { const f32x4 v0 = acc[ai][bj][m][0] + bv[bj][0], v1 = acc[ai][bj][m][1] + bv[bj][1]; u32x4 w; w.x = pk2(v0[0], v0[1]); w.y = pk2(v0[2], v0[3]); w.z = pk2(v1[0], v1[1]); w.w = pk2(v1[2], v1[3]);
                        *(u32x4*)(rowp + bj * 128) = w; } } }
    }
};
struct MoeOrder {
    const LAS int* tpre; const LAS int* cnt; const int* list; int nN, G, c, rowpitch  , brows  ;
    __device__ bool next(int i, Unit& u) const {
        const int nwg = tpre[32] * nN; const long L = (long)i * G + c; if (L >= nwg) return false;
        int wgid = (int)L; { const int q = nwg / 8, r = nwg % 8, xcd = wgid % 8, off = wgid / 8; wgid = (xcd < r ? xcd * (q + 1) : r * (q + 1) + (xcd - r) * q) + off; }
        int e = 0;
#pragma unroll 1
        for (int s = 16; s > 0; s >>= 1) { if (tpre[e + s] * nN <= wgid) e += s; }
        const int w = wgid - tpre[e] * nN, nM = tpre[e + 1] - tpre[e];
        const int nig = 8 * nN, gid = w / nig, fm = gid * 8, gsz = (nM - fm) < 8 ? (nM - fm) : 8;
        u.pm = fm + ((w % nig) % gsz); u.pn = (w % nig) / gsz; u.z = e; u.arow = (tpre[e] + u.pm) * 256; u.brow = e * brows + u.pn * 256; return true;
    }
    __device__ __forceinline__ unsigned row_off(const Unit& u, int r) const {
        const int lr = u.pm * 256 + r; const int a = list[(size_t)u.z * 32768 + (lr < cnt[u.z] ? lr : 0)]; return (unsigned)(a >> 2) * (unsigned)rowpitch;
    }
};

__device__ __forceinline__ void transpose_item(const float* W, int K, int N, bf16_t* WT, int k0, int n0, int dst_row0, LAS float* scr, int lane) {
#pragma unroll 8
    for (int i = 0; i < 32; ++i) { const int kk = 2 * i + (lane >> 5); scr[kk * 33 + (lane & 31)] = W[(size_t)(k0 + kk) * N + n0 + (lane & 31)]; }
    asm volatile("s_waitcnt lgkmcnt(0)" ::: "memory");
    const int c = lane & 7;
#pragma unroll
    for (int j = 0; j < 4; ++j) { const int n = (lane >> 3) + 8 * j; const LAS float* s = scr + (8 * c) * 33 + n;
        u32x4 o; o.x = pk2(s[0 * 33], s[1 * 33]); o.y = pk2(s[2 * 33], s[3 * 33]); o.z = pk2(s[4 * 33], s[5 * 33]); o.w = pk2(s[6 * 33], s[7 * 33]);
        *(u32x4*)(WT + (size_t)(dst_row0 + n) * K + k0 + 8 * c) = o; }
    asm volatile("s_waitcnt lgkmcnt(0)" ::: "memory");
}
template <bool GU>
__device__ __forceinline__ void transpose_matrix(const float* W, int K, int N, bf16_t* WT, LAS float* scr, int lane, int gw, int NGW, int& itbase) {
    const int nblk = N / 32, nitems = (K / 64) * nblk;
    int first = (gw - itbase) % NGW; if (first < 0) first += NGW;
    for (int it = first; it < nitems; it += NGW) { const int kb = it / nblk, nb = it % nblk, n0 = nb * 32;
        int dst = n0; if (GU) { const int nn = n0 & 1023; dst = (nn >> 7) * 256 + (n0 >> 10) * 128 + (nn & 127); }
        transpose_item(W, K, N, WT, kb * 64, n0, dst, scr, lane); }
    itbase += nitems;
}


#define MOD ((float*)(ws + WS_SMALL))
#define SCAL ((float*)(ws + WS_SMALL + 128 * 1024))
#define ROPEC ((float*)(ws + WS_ROPEC))
#define ROPES ((float*)(ws + WS_ROPES))
#define TOPI ((int*)(ws + WS_TOPI))
#define TOPW ((float*)(ws + WS_TOPW))
#define LIST ((int*)(ws + WS_LIST))
#define RWT ((bf16_t*)(ws + WS_RWT))
#define CNT ((int*)(ws + WS_CTL) + CW_CNT)
#define H ((bf16_t*)(ws + WS_H))
#define QKR ((bf16_t*)(ws + WS_H))
#define PROJ ((bf16_t*)(ws + WS_PROJ))
#define YA ((bf16_t*)(ws + WS_YA))
#define YB ((bf16_t*)(ws + WS_YB))
#define DS ((bf16_t*)(ws + WS_DS))
#define DEC ((float*)(ws + WS_DEC))
#define MERGED ((bf16_t*)(ws + WS_MERGED))
#define SP ((bf16_t*)(ws + WS_MERGED))
#define Y ((float*)(ws + WS_Y))
#define ACT ((bf16_t*)(ws + WS_ACT))
#define YM ((bf16_t*)(ws + WS_YM))
#define WT_IN ((bf16_t*)(ws + WS_WIN))
#define WT_A ((bf16_t*)(ws + WS_WA))
#define WT_B ((bf16_t*)(ws + WS_WB))
#define WT_O ((bf16_t*)(ws + WS_WO))
#define WT_GU ((bf16_t*)(ws + WS_WGU))
#define WT_D ((bf16_t*)(ws + WS_WD))
#define PHASE_BEGIN unsigned char* ws = args.ws; asm volatile("" : "+s"(ws)); int tid = threadIdx.x; asm volatile("" : "+v"(tid)); const int lane = tid & 63; (void)lane; const float* x = args.in[0]; float* out = args.out; (void)x; (void)out;
__global__ void __launch_bounds__(NTHR, 2) mega(Args args) {
    extern __shared__ __attribute__((aligned(16))) unsigned char lds_[];
    LAS unsigned char* lds = (LAS unsigned char*)lds_;
    volatile LAS unsigned* LW = (volatile LAS unsigned*)(lds + LDSCTL_OFF);
    const int tid = threadIdx.x, lane = tid & 63, wave = __builtin_amdgcn_readfirstlane(tid >> 6);
    const int G = gridDim.x; const int bx = blockIdx.x; const int vcu = (G % 8 == 0) ? (bx % 8) * (G / 8) + bx / 8 : bx;
    const int gw = vcu * NWAVES + wave, NGW = G * NWAVES;
    unsigned* CTL = (unsigned*)(args.ws + WS_CTL);
    for (int u = tid; u < (LDS_BYTES - LDSCTL_OFF) / 4; u += NTHR) ((LAS unsigned*)(lds + LDSCTL_OFF))[u] = 0u;
    __syncthreads();
    const int lo = args.ph_lo, hi = args.ph_hi;
    XcdBarrier bar; bar.bar = CTL + CW_BAR + args.li * 4096; bar.x = 0; bar.st = nullptr;
    if (hi - lo > 1) bar = xcd_barrier_post(CTL + CW_BAR + args.li * 4096, LW + LW_BAR);
#ifndef PHMASK
#define PHMASK 0xffff
#endif
#ifndef DUP_PHASE
#define DUP_PHASE -1
#endif
#define IN(k) ((((PHMASK) >> (k)) & 1) && lo <= (k) && (k) < hi)
#define REPS(k) (((k) == DUP_PHASE) ? 2 : 1)
#define SEAM(k) do { if (IN(k) && IN((k) + 1)) xcd_barrier(bar); } while (0)

    if (IN(PH_PRO)) for (int rep_ = 0; rep_ < REPS(PH_PRO); ++rep_) {
        PHASE_BEGIN
        __syncthreads();
        const float* c = args.in[1]; const float* w_mod = args.in[2]; const float* b_mod = args.in[3];
        LAS float* cact = (LAS float*)lds; LAS float* red = cact + 4096;
        for (int i = tid; i < 4096; i += NTHR) { const float cv = c[i]; cact[i] = cv / (1.f + expf(-cv)); }
        __syncthreads();
        for (int it = vcu; it < 384; it += G) { const int b = it / 96, j0 = (it % 96) * 64, kq = tid >> 6, col = tid & 63; float acc = 0.f;
            for (int k = kq * 128; k < kq * 128 + 128; ++k) acc += cact[b * 1024 + k] * w_mod[(size_t)k * 6144 + j0 + col];
            red[kq * 64 + col] = acc; __syncthreads();
            if (tid < 64) { float s = 0.f;
#pragma unroll
                for (int q = 0; q < 8; ++q) s += red[q * 64 + tid];
                MOD[b * 6144 + j0 + tid] = s + b_mod[j0 + tid]; }
            __syncthreads(); }
        const int gt = vcu * NTHR + tid, NGT = G * NTHR;
        if (gt == 0) { const float* q1 = args.in[7]; const float* k1 = args.in[8]; const float* q2 = args.in[9]; const float* k2 = args.in[10]; float s1 = 0.f, s2 = 0.f;
            for (int i = 0; i < 64; ++i) { s1 += q1[i] * k1[i]; s2 += q2[i] * k2[i]; } SCAL[0] = expf(s1) - expf(s2) + 0.2f; }
        if (gt < 512) { const float* lbl = args.in[12]; SCAL[64 + gt] = 1.f / (1.f + expf(lbl[512 + gt] - lbl[gt])); }
        for (int i = gt; i < 8192 * 32; i += NGT) { const int s = i >> 5, j = i & 31; const float inv = powf(10000.f, -(float)(2 * j) / 64.f); const float ang = (float)s * inv; ROPEC[i] = cosf(ang); ROPES[i] = sinf(ang); }
        for (int i = gt; i < 32768; i += NGT) { const int e = i >> 10, k = i & 1023; const float wv = args.in[19][k * 32 + e]; const bf16_t hb = f2bf(wv); RWT[i] = hb; RWT[32768 + i] = f2bf(wv - bf2f(hb)); }
        LAS float* scr = (LAS float*)(lds + wave * 16384); int itbase = 0;
        transpose_matrix<false>(args.in[6], 1024, 5632, WT_IN, scr, lane, gw, NGW, itbase);
        transpose_matrix<false>(args.in[14], 512, 1024, WT_A, scr, lane, gw, NGW, itbase);
        transpose_matrix<false>(args.in[15], 512, 1024, WT_B, scr, lane, gw, NGW, itbase);
        transpose_matrix<false>(args.in[16], 1024, 1024, WT_O, scr, lane, gw, NGW, itbase);
        for (int e = 0; e < 32; ++e) transpose_matrix<true>(args.in[21] + (size_t)e * 1024 * 2048, 1024, 2048, WT_GU + (size_t)e * 2048 * 1024, scr, lane, gw, NGW, itbase);
        for (int e = 0; e < 32; ++e) transpose_matrix<false>(args.in[23] + (size_t)e * 1024 * 1024, 1024, 1024, WT_D + (size_t)e * 1024 * 1024, scr, lane, gw, NGW, itbase);
    }
    SEAM(PH_PRO);
#ifdef EXTRA_BARRIERS
    for (int eb = 0; eb < EXTRA_BARRIERS; ++eb) xcd_barrier(bar);
#endif
    if (IN(PH_H1)) for (int rep_ = 0; rep_ < REPS(PH_H1); ++rep_) {
        PHASE_BEGIN
        const float* w = args.in[4];
        for (int row = gw; row < T; row += NGW) { const int b = row >> 13; const f32x4* xr = (const f32x4*)(x + (size_t)row * 1024) + lane; f32x4 v[4]; float ss = 0.f;
#pragma unroll
            for (int j = 0; j < 4; ++j) { v[j] = xr[64 * j]; ss += (v[j][0] * v[j][0] + v[j][1] * v[j][1]) + (v[j][2] * v[j][2] + v[j][3] * v[j][3]); }
            const float rstd = rsqrtf(wave_sum(ss) * (1.f / 1024.f) + 1e-6f);
#pragma unroll
            for (int j = 0; j < 4; ++j) { const int col = 4 * lane + 256 * j; const f32x4 wv = *(const f32x4*)(w + col), sc = *(const f32x4*)(MOD + b * 6144 + 1024 + col), sh = *(const f32x4*)(MOD + b * 6144 + col);
                const f32x4 h = v[j] * rstd * wv * (sc + 1.f) + sh; u32x2 o; o.x = pk2(h[0], h[1]); o.y = pk2(h[2], h[3]); *(u32x2*)(H + (size_t)row * 1024 + col) = o; } }
    }
    SEAM(PH_H1);
    if (IN(PH_G1)) for (int rep_ = 0; rep_ < REPS(PH_G1); ++rep_) {
        PHASE_BEGIN
        pg8::Gemm g{H, WT_IN, 1024}; pg8::DenseOrder S; S.init(T, NC, G, bx);
        EpiBf16 E{PROJ, NC};
        pg8::gemm_phase<EpiBf16, pg8::DenseOrder, false>(lds, g, S, E);
    }
    SEAM(PH_G1);
    if (IN(PH_ROPE_HGA)) for (int rep_ = 0; rep_ < REPS(PH_ROPE_HGA); ++rep_) {
        PHASE_BEGIN
        for (int row = gw; row < T; row += NGW) { const int s = row & 8191;
#pragma unroll
            for (int j = 0; j < 2; ++j) { const int gq = lane + 64 * j, mb = gq >> 3, d4 = (gq & 7) * 4; const bf16_t* src = PROJ + (size_t)row * 5632 + mb * 64 + d4;
                const u32x2 a = *(const u32x2*)src, bq = *(const u32x2*)(src + 32); const f32x4 cs = *(const f32x4*)(ROPEC + s * 32 + d4), sn = *(const f32x4*)(ROPES + s * 32 + d4);
                const f32x4 x1 = (f32x4){__uint_as_float(a.x << 16), __uint_as_float(a.x & 0xffff0000u), __uint_as_float(a.y << 16), __uint_as_float(a.y & 0xffff0000u)};
                const f32x4 x2 = (f32x4){__uint_as_float(bq.x << 16), __uint_as_float(bq.x & 0xffff0000u), __uint_as_float(bq.y << 16), __uint_as_float(bq.y & 0xffff0000u)};
                const float sc = (mb < 8) ? at::C2 : 1.f; const f32x4 o1 = (x1 * cs - x2 * sn) * sc, o2 = (x2 * cs + x1 * sn) * sc;
                bf16_t* dst = QKR + (size_t)row * 1024 + mb * 64 + d4; u32x2 w1, w2; w1.x = pk2(o1[0], o1[1]); w1.y = pk2(o1[2], o1[3]); w2.x = pk2(o2[0], o2[1]); w2.y = pk2(o2[2], o2[3]);
                *(u32x2*)dst = w1; *(u32x2*)(dst + 32) = w2; } }
        for (int it = vcu; it < 2048; it += G) hg::hgA_unit(lds, PROJ, SCAL, DS, DEC, it >> 7, it & 127, tid);
        __syncthreads();
    }
    SEAM(PH_ROPE_HGA);
    if (IN(PH_ATT_SCAN)) for (int rep_ = 0; rep_ < REPS(PH_ATT_SCAN); ++rep_) {
        PHASE_BEGIN
        for (int gid = vcu * NTHR + tid; gid < 16 * 128 * 128; gid += G * NTHR) { const int bh = gid >> 14, d = (gid >> 7) & 127, v = gid & 127; float st = 0.f;
            const bf16_t* __restrict__ src = DS + ((size_t)(bh * 128) * 128 + d) * 128 + v; bf16_t* __restrict__ dst = SP + ((size_t)(bh * 128) * 128 + d) * 128 + v; const float* __restrict__ dc = DEC + (size_t)(bh * 128) * 128 + d;
            for (int n0 = 0; n0 < 128; n0 += 8) { float xv[8], dv[8];
#pragma unroll
                for (int i = 0; i < 8; ++i) { xv[i] = bf2f(src[(size_t)(n0 + i) * 16384]); dv[i] = dc[(n0 + i) * 128]; }
#pragma unroll
                for (int i = 0; i < 8; ++i) { dst[(size_t)(n0 + i) * 16384] = f2bf(st); st = dv[i] * st + xv[i]; } } }
        { const float lam = SCAL[0]; const float* subln = args.in[11];
          for (int it = vcu; it < 1024; it += G) { int bh, blk;
              if (G == 256) { const int i = it >> 8, v = it & 255, s = v & 15; bh = v >> 4; blk = (i == 0) ? 63 - s : (i == 1) ? 32 + s : (i == 2) ? 31 - s : s; }
              else { blk = 63 - (it >> 4); bh = it & 15; }
              at::attn_unit(lds, QKR, PROJ, YA, subln, lam, bh >> 2, bh & 3, blk, tid); } }
    }
    SEAM(PH_ATT_SCAN);
    if (IN(PH_HGC)) for (int rep_ = 0; rep_ < REPS(PH_HGC); ++rep_) {
        PHASE_BEGIN
        const float* hgnorm = args.in[13];
        for (int it = vcu; it < 2048; it += G) hg::hgC_unit(lds, PROJ, SCAL, SP, hgnorm, YB, it >> 7, it & 127, tid);
        __syncthreads();
    }
    SEAM(PH_HGC);
    if (IN(PH_G2A)) for (int rep_ = 0; rep_ < REPS(PH_G2A); ++rep_) {
        PHASE_BEGIN
        pg8::Gemm g{YA, WT_A, 512}; pg8::DenseOrder S; S.init(T, 1024, G, bx);
        EpiBranch<false> E{out, PROJ, MERGED};
        pg8::gemm_phase<EpiBranch<false>, pg8::DenseOrder, false>(lds, g, S, E);
    }
    if (IN(PH_G2B)) for (int rep_ = 0; rep_ < REPS(PH_G2B); ++rep_) {
        PHASE_BEGIN
        asm volatile("s_waitcnt vmcnt(0)" ::: "memory"); __syncthreads();
        pg8::Gemm g{YB, WT_B, 512}; pg8::DenseOrder S; S.init(T, 1024, G, bx);
        EpiBranch<true> E{out, PROJ, MERGED};
        pg8::gemm_phase<EpiBranch<true>, pg8::DenseOrder, false>(lds, g, S, E);
    }
    SEAM(PH_G2B);
    if (IN(PH_G3)) for (int rep_ = 0; rep_ < REPS(PH_G3); ++rep_) {
        PHASE_BEGIN
        pg8::Gemm g{MERGED, WT_O, 1024}; pg8::DenseOrder S; S.init(T, 1024, G, bx);
        EpiF32 E{Y, 1024};
        pg8::gemm_phase<EpiF32, pg8::DenseOrder, false>(lds, g, S, E);
    }
    SEAM(PH_G3);
    if (IN(PH_TOK)) for (int rep_ = 0; rep_ < REPS(PH_TOK); ++rep_) {
        PHASE_BEGIN
        const float* wpm = args.in[5]; const float* wpf = args.in[17]; const float* rb = args.in[20];
        const int wv_ = __builtin_amdgcn_readfirstlane(tid >> 6), r32 = lane & 31, hi = lane >> 5;
        LAS int* lcnt = (LAS int*)lds; LAS int* lbase = lcnt + 32; LAS int* asg = lcnt + 64;
        LAS float* rstd2 = (LAS float*)(lds + 4096);
        LAS float* XC = (LAS float*)(lds + 8192);
        LAS float* LG = (LAS float*)(lds + 24576);
        LAS float* CM = (LAS float*)(lds + 41984); LAS float* SHV = CM + 1024;
        for (int chunk = vcu; chunk < T / 128; chunk += G) { const int b = chunk >> 6;
            __syncthreads();
            if (tid < 32) lcnt[tid] = 0;
            for (int i = tid; i < 1024; i += NTHR) { CM[i] = wpf[i] * (1.f + MOD[b * 6144 + 4096 + i]); SHV[i] = MOD[b * 6144 + 3072 + i]; }
            __syncthreads();
            for (int i = 0; i < 16; ++i) { const int rloc = wv_ * 16 + i, row = chunk * 128 + rloc;
                const f32x4* yr = (const f32x4*)(Y + (size_t)row * 1024) + lane; const f32x4* xr = (const f32x4*)(x + (size_t)row * 1024) + lane; f32x4 v[4]; float ss = 0.f;
#pragma unroll
                for (int j = 0; j < 4; ++j) { v[j] = yr[64 * j]; ss += (v[j][0] * v[j][0] + v[j][1] * v[j][1]) + (v[j][2] * v[j][2] + v[j][3] * v[j][3]); }
                float rstd = rsqrtf(wave_sum(ss) * (1.f / 1024.f) + 1e-6f); ss = 0.f;
#pragma unroll
                for (int j = 0; j < 4; ++j) { const int col = 4 * lane + 256 * j; const f32x4 g1 = *(const f32x4*)(MOD + b * 6144 + 2048 + col), wv = *(const f32x4*)(wpm + col);
                    v[j] = xr[64 * j] + g1 * v[j] * rstd * wv; *(f32x4*)(out + (size_t)row * 1024 + col) = v[j]; ss += (v[j][0] * v[j][0] + v[j][1] * v[j][1]) + (v[j][2] * v[j][2] + v[j][3] * v[j][3]); }
                rstd = rsqrtf(wave_sum(ss) * (1.f / 1024.f) + 1e-6f);
                if (lane == 0) rstd2[rloc] = rstd;
#pragma unroll
                for (int j = 0; j < 4; ++j) { const int col = 4 * lane + 256 * j; const f32x4 cm = *(const LAS f32x4*)(CM + col), sh = *(const LAS f32x4*)(SHV + col);
                    const f32x4 h = v[j] * rstd * cm + sh; u32x2 o; o.x = pk2(h[0], h[1]); o.y = pk2(h[2], h[3]); *(u32x2*)(H + (size_t)row * 1024 + col) = o; } }
            asm volatile("s_waitcnt vmcnt(0)" ::: "memory");
            __syncthreads();
            { const int rt = wv_ & 3, kh = wv_ >> 2; const int rloc = 32 * rt + r32; const float rs = rstd2[rloc];
              const float* xrow = out + (size_t)(chunk * 128 + rloc) * 1024 + 512 * kh + 8 * hi; const bf16_t* whi = RWT + (size_t)r32 * 1024 + 512 * kh + 8 * hi; const bf16_t* wlo = whi + 32768;
              const LAS float* cmp = CM + 512 * kh + 8 * hi; const LAS float* shp = SHV + 512 * kh + 8 * hi;
              at::f32x16 acc = at::f32x16{};
#pragma unroll 4
              for (int ks = 0; ks < 32; ++ks) { const f32x4 xa = __builtin_nontemporal_load((const f32x4*)(xrow + 16 * ks)), xb = __builtin_nontemporal_load((const f32x4*)(xrow + 16 * ks + 4));
                  const f32x4 ca = *(const LAS f32x4*)(cmp + 16 * ks), cb = *(const LAS f32x4*)(cmp + 16 * ks + 4), sa = *(const LAS f32x4*)(shp + 16 * ks), sb = *(const LAS f32x4*)(shp + 16 * ks + 4);
                  const f32x4 ha = xa * rs * ca + sa, hb = xb * rs * cb + sb;
                  const unsigned h0 = at::cvtpk(ha[0], ha[1]), h1 = at::cvtpk(ha[2], ha[3]), h2 = at::cvtpk(hb[0], hb[1]), h3 = at::cvtpk(hb[2], hb[3]);
                  const unsigned l0 = at::cvtpk(ha[0] - __uint_as_float(h0 << 16), ha[1] - __uint_as_float(h0 & 0xffff0000u)), l1 = at::cvtpk(ha[2] - __uint_as_float(h1 << 16), ha[3] - __uint_as_float(h1 & 0xffff0000u));
                  const unsigned l2 = at::cvtpk(hb[0] - __uint_as_float(h2 << 16), hb[1] - __uint_as_float(h2 & 0xffff0000u)), l3 = at::cvtpk(hb[2] - __uint_as_float(h3 << 16), hb[3] - __uint_as_float(h3 & 0xffff0000u));
                  const at::bf16x8 ahi = __builtin_bit_cast(at::bf16x8, (u32x4){h0, h1, h2, h3}), alo = __builtin_bit_cast(at::bf16x8, (u32x4){l0, l1, l2, l3});
                  const at::bf16x8 bhi = *(const at::bf16x8*)(whi + 16 * ks), blo = *(const at::bf16x8*)(wlo + 16 * ks);
                  acc = __builtin_amdgcn_mfma_f32_32x32x16_bf16(ahi, bhi, acc, 0, 0, 0); acc = __builtin_amdgcn_mfma_f32_32x32x16_bf16(ahi, blo, acc, 0, 0, 0); acc = __builtin_amdgcn_mfma_f32_32x32x16_bf16(alo, bhi, acc, 0, 0, 0); }
              if (kh == 1) {
#pragma unroll
                  for (int r = 0; r < 16; ++r) XC[(rt * 16 + r) * 64 + lane] = acc[r]; }
              __syncthreads();
              if (kh == 0) { const float bias = rb[r32];
#pragma unroll
                  for (int r = 0; r < 16; ++r) LG[(32 * rt + at::crow(r, hi)) * 33 + r32] = acc[r] + XC[(rt * 16 + r) * 64 + lane] + bias; }
              __syncthreads(); }
            if (tid < 128) { const int rloc = tid, row = chunk * 128 + rloc; float lg[32];
#pragma unroll
                for (int e = 0; e < 32; ++e) lg[e] = LG[rloc * 33 + e];
                int bi[4]; float bv[4];
#pragma unroll
                for (int k = 0; k < 4; ++k) { float best = -3.0e38f; int be = 0;
#pragma unroll
                    for (int e = 0; e < 32; ++e) { bool taken = false;
#pragma unroll
                        for (int q = 0; q < 4; ++q) if (q < k && bi[q] == e) taken = true;
                        if (!taken && lg[e] > best) { best = lg[e]; be = e; } }
                    bi[k] = be; bv[k] = best; }
                const float e1 = expf(bv[1] - bv[0]), e2 = expf(bv[2] - bv[0]), e3 = expf(bv[3] - bv[0]); const float inv = 1.f / (1.f + e1 + e2 + e3);
                if (rep_ == REPS(PH_TOK) - 1) { *(f32x4*)(TOPW + row * 4) = (f32x4){inv, e1 * inv, e2 * inv, e3 * inv};
                    *(u32x4*)(TOPI + row * 4) = (u32x4){(unsigned)bi[0], (unsigned)bi[1], (unsigned)bi[2], (unsigned)bi[3]};
#pragma unroll
                    for (int k = 0; k < 4; ++k) { const int pos = __hip_atomic_fetch_add(lcnt + bi[k], 1, __ATOMIC_RELAXED, __HIP_MEMORY_SCOPE_WORKGROUP); asg[rloc * 4 + k] = (bi[k] << 16) | pos; } } }
            __syncthreads();
            if (tid < 32) lbase[tid] = atomicAdd(&CNT[tid], lcnt[tid]);
            __syncthreads();
            if (rep_ == REPS(PH_TOK) - 1) { const int v = asg[tid], e = v >> 16, pos = v & 0xffff; LIST[(size_t)e * 32768 + lbase[e] + pos] = chunk * 512 + tid; }
        }
        __syncthreads();
    }
    SEAM(PH_TOK);
    if (IN(PH_G4) || IN(PH_G5)) {
        PHASE_BEGIN
        if (tid < 32) ((LAS int*)LW)[LW_CNT + tid] = __hip_atomic_load(&CNT[tid], __ATOMIC_RELAXED, __HIP_MEMORY_SCOPE_AGENT);
        __syncthreads();
        if (tid == 0) { int s = 0; for (int e = 0; e < 32; ++e) { ((LAS int*)LW)[LW_TPRE + e] = s; s += (((LAS int*)LW)[LW_CNT + e] + 255) >> 8; } ((LAS int*)LW)[LW_TPRE + 32] = s; }
        __syncthreads();
    }
    if (IN(PH_G4)) for (int rep_ = 0; rep_ < REPS(PH_G4); ++rep_) {
        PHASE_BEGIN
        pg8::Gemm g{H, WT_GU, 1024}; MoeOrder S{(const LAS int*)LW + LW_TPRE, (const LAS int*)LW + LW_CNT, LIST, 8, G, bx, 2048, 2048};
        EpiGateUp E{args.in[22], ACT};
        pg8::gemm_phase<EpiGateUp, MoeOrder, true>(lds, g, S, E);
    }
    SEAM(PH_G4);
    if (IN(PH_G5)) for (int rep_ = 0; rep_ < REPS(PH_G5); ++rep_) {
        PHASE_BEGIN
        pg8::Gemm g{ACT, WT_D, 1024}; MoeOrder S{(const LAS int*)LW + LW_TPRE, (const LAS int*)LW + LW_CNT, LIST, 4, G, bx, 2048, 1024};
        EpiDown E{args.in[24], LIST, YM, (const LAS int*)LW + LW_CNT};
        pg8::gemm_phase<EpiDown, MoeOrder, false>(lds, g, S, E);
    }
    SEAM(PH_G5);
    if (IN(PH_FIN)) for (int rep_ = 0; rep_ < REPS(PH_FIN); ++rep_) {
        PHASE_BEGIN
        const float* w = args.in[18];
        for (int row = gw; row < T; row += NGW) { const int b = row >> 13; const f32x4 tw = *(const f32x4*)(TOPW + row * 4); const bf16_t* y0 = YM + (size_t)row * 4096; f32x4 v[4]; float ss = 0.f;
#pragma unroll
            for (int j = 0; j < 4; ++j) { const int col = 4 * lane + 256 * j; f32x4 a = (f32x4){0.f, 0.f, 0.f, 0.f};
#pragma unroll
                for (int k = 0; k < 4; ++k) { const u32x2 yw = *(const u32x2*)(y0 + k * 1024 + col);
                    a[0] += tw[k] * __uint_as_float(yw.x << 16); a[1] += tw[k] * __uint_as_float(yw.x & 0xffff0000u); a[2] += tw[k] * __uint_as_float(yw.y << 16); a[3] += tw[k] * __uint_as_float(yw.y & 0xffff0000u); }
                v[j] = a; ss += (a[0] * a[0] + a[1] * a[1]) + (a[2] * a[2] + a[3] * a[3]); }
            const float rstd = rsqrtf(wave_sum(ss) * (1.f / 1024.f) + 1e-6f);
#pragma unroll
            for (int j = 0; j < 4; ++j) { const int col = 4 * lane + 256 * j; const f32x4 g2 = *(const f32x4*)(MOD + b * 6144 + 5120 + col), wv = *(const f32x4*)(w + col);
                f32x4* op = (f32x4*)(out + (size_t)row * 1024 + col); const f32x4 res = *op + g2 * v[j] * rstd * wv; if (rep_ == REPS(PH_FIN) - 1) *op = res; else asm volatile("" :: "v"(res)); } }
    }
#undef IN
#undef SEAM
}
}
#undef MOD
#undef SCAL
#undef ROPEC
#undef ROPES
#undef TOPI
#undef TOPW
#undef LIST
#undef RWT
#undef CNT
#undef H
#undef QKR
#undef PROJ
#undef YA
#undef YB
#undef DS
#undef DEC
#undef MERGED
#undef SP
#undef Y
#undef ACT
#undef YM
#undef WT_IN
#undef WT_A
#undef WT_B
#undef WT_O
#undef WT_GU
#undef WT_D
#undef PHASE_BEGIN

#ifndef FASTMASK
#define FASTMASK 0x1fff
#endif

extern "C" void kernel_launch(void* const* d_in, const int* in_sizes, int n_in, void* d_out, int out_size, void* d_ws, size_t ws_size, hipStream_t stream) {
    if (n_in != 25 || out_size != T * D || ws_size < WS_END) { fprintf(stderr, "kernel_launch: unexpected shapes / workspace (%d inputs, out %d, ws %zu)\n", n_in, out_size, ws_size); return; }
    const float* x = (const float*)d_in[0]; const float* c = (const float*)d_in[1]; const float* w_mod = (const float*)d_in[2]; const float* b_mod = (const float*)d_in[3];
    const float* norm_pre_mix = (const float*)d_in[4]; const float* norm_post_mix = (const float*)d_in[5]; const float* w_in = (const float*)d_in[6];
    const float* lq1 = (const float*)d_in[7]; const float* lk1 = (const float*)d_in[8]; const float* lq2 = (const float*)d_in[9]; const float* lk2 = (const float*)d_in[10];
    const float* subln = (const float*)d_in[11]; const float* lbl = (const float*)d_in[12]; const float* hgnorm = (const float*)d_in[13];
    const float* wa = (const float*)d_in[14]; const float* wb = (const float*)d_in[15]; const float* wo = (const float*)d_in[16];
    const float* norm_pre_ffn = (const float*)d_in[17]; const float* norm_post_ffn = (const float*)d_in[18]; const float* rw = (const float*)d_in[19]; const float* rb = (const float*)d_in[20];
    const float* wgu = (const float*)d_in[21]; const float* bgu = (const float*)d_in[22]; const float* wd = (const float*)d_in[23]; const float* bd = (const float*)d_in[24];
    unsigned char* ws = (unsigned char*)d_ws; float* out = (float*)d_out;
    float* MOD = (float*)(ws + WS_SMALL); float* SCAL = (float*)(ws + WS_SMALL + 128 * 1024); int* PADS = (int*)(ws + WS_SMALL + 192 * 1024);
    float* ROPEC = (float*)(ws + WS_ROPEC); float* ROPES = (float*)(ws + WS_ROPES);
    int* TOPI = (int*)(ws + WS_TOPI); float* TOPW = (float*)(ws + WS_TOPW); int* LIST = (int*)(ws + WS_LIST); int* CNT = (int*)(ws + WS_CTL) + CW_CNT;
    bf16_t* H = (bf16_t*)(ws + WS_H); bf16_t* PROJ = (bf16_t*)(ws + WS_PROJ); bf16_t* YA = (bf16_t*)(ws + WS_YA); bf16_t* YB = (bf16_t*)(ws + WS_YB);
    bf16_t* DS = (bf16_t*)(ws + WS_DS); float* DEC = (float*)(ws + WS_DEC); bf16_t* MERGED = (bf16_t*)(ws + WS_MERGED); float* Y = (float*)(ws + WS_Y);
    bf16_t* SP = (bf16_t*)(ws + WS_MERGED);
    bf16_t* ACT = (bf16_t*)(ws + WS_ACT); bf16_t* YM = (bf16_t*)(ws + WS_YM);

    static int grid = 0;
    if (grid == 0) {
        (void)hipFuncSetAttribute((const void*)nv::k_attn, hipFuncAttributeMaxDynamicSharedMemorySize, nv::AT_LDS);
        (void)hipFuncSetAttribute((const void*)nv::k_hgA, hipFuncAttributeMaxDynamicSharedMemorySize, 65536);
        (void)hipFuncSetAttribute((const void*)nv::k_hgC, hipFuncAttributeMaxDynamicSharedMemorySize, nv::HC_LDS);
        (void)hipFuncSetAttribute((const void*)mk::mega, hipFuncAttributeMaxDynamicSharedMemorySize, mk::LDS_BYTES);
        int dev = 0, cus = 0; (void)hipGetDevice(&dev); (void)hipDeviceGetAttribute(&cus, hipDeviceAttributeMultiprocessorCount, dev);
        (void)hipGetLastError();
        grid = cus > 0 ? cus : 256;
    }
    (void)hipMemsetAsync(ws + WS_CTL, 0, 1 * MiB, stream);
    mk::Args a{}; for (int i = 0; i < 25; ++i) a.in[i] = (const float*)d_in[i]; a.out = out; a.ws = ws;
    const unsigned fast = FASTMASK; int li = 0;
    for (int p = 0; p < mk::PH_N;) {
        if (fast & (1u << p)) { int q = p; while (q < mk::PH_N && (fast & (1u << q))) ++q;
            a.ph_lo = p; a.ph_hi = q; a.li = li++; a.pad = 0;
            hipLaunchKernelGGL(mk::mega, dim3(grid), dim3(mk::NTHR), mk::LDS_BYTES, stream, a);
            p = q; continue; }
        switch (p) {
        case mk::PH_PRO:
            nv::k_mod<<<dim3(24, 4), 256, 0, stream>>>(c, w_mod, b_mod, MOD);
            nv::k_small<<<1024, 256, 0, stream>>>(lq1, lk1, lq2, lk2, lbl, SCAL, ROPEC, ROPES); break;
        case mk::PH_H1: nv::k_rowmod<<<T / 4, 256, 0, stream>>>(x, norm_pre_mix, MOD, H, 0, 1024); break;
        case mk::PH_G1: { nv::NG p_{}; p_.A = H; p_.lda = 1024; p_.M = T; p_.B = w_in; p_.ldb = NC; p_.K = 1024;
            nv::k_gemm<nv::EpiStoreBf16, 1><<<dim3(NC / 64, T / 64, 1), 256, 0, stream>>>(p_, nv::EpiStoreBf16{PROJ, (long long)NC}); } break;
        case mk::PH_ROPE_HGA: nv::k_hgA<<<dim3(128, 4, 4), 256, 65536, stream>>>(PROJ, SCAL, DS, DEC); break;
        case mk::PH_ATT_SCAN:
            nv::k_attn<<<dim3(128, 4, 4), 256, nv::AT_LDS, stream>>>(PROJ, ROPEC, ROPES, SCAL, subln, YA);
            nv::k_scan<<<1024, 256, 0, stream>>>(DS, DEC, SP); break;
        case mk::PH_HGC: nv::k_hgC<<<dim3(128, 4, 4), 256, nv::HC_LDS, stream>>>(PROJ, SCAL, SP, hgnorm, YB); break;
        case mk::PH_G2A: { nv::NG p_{}; p_.A = YA; p_.lda = 512; p_.M = T; p_.B = wa; p_.ldb = 1024; p_.K = 512;
            nv::k_gemm<nv::EpiBranchA, 1><<<dim3(16, T / 64, 1), 256, 0, stream>>>(p_, nv::EpiBranchA{out, PROJ}); } break;
        case mk::PH_G2B: { nv::NG p_{}; p_.A = YB; p_.lda = 512; p_.M = T; p_.B = wb; p_.ldb = 1024; p_.K = 512;
            nv::k_gemm<nv::EpiBranchB, 1><<<dim3(16, T / 64, 1), 256, 0, stream>>>(p_, nv::EpiBranchB{out, PROJ, MERGED}); } break;
        case mk::PH_G3: { nv::NG p_{}; p_.A = MERGED; p_.lda = 1024; p_.M = T; p_.B = wo; p_.ldb = 1024; p_.K = 1024;
            nv::k_gemm<nv::EpiStoreF32, 1><<<dim3(16, T / 64, 1), 256, 0, stream>>>(p_, nv::EpiStoreF32{Y, 1024LL}); } break;
        case mk::PH_TOK:
            nv::k_x1<<<T / 4, 256, 0, stream>>>(x, Y, norm_post_mix, MOD, 2048LL, out);
            nv::k_rowmod<<<T / 4, 256, 0, stream>>>(out, norm_pre_ffn, MOD, H, 3072, 4096);
            nv::k_route<<<T / 4, 256, 0, stream>>>(out, norm_pre_ffn, MOD, rw, rb, TOPI, TOPW);
            nv::k_lists<<<T * 4 / 256, 256, 0, stream>>>(TOPI, CNT, LIST);
            nv::k_pads<<<1, 64, 0, stream>>>(CNT, PADS); break;
        case mk::PH_G4: { nv::NG p_{}; p_.A = H; p_.lda = 1024; p_.rowidx = LIST; p_.idxstride = 32768; p_.idxshift = 2; p_.cnt = CNT; p_.rowbase = PADS; p_.B = wgu; p_.strideB = (size_t)1024 * 2048; p_.ldb = 2048; p_.K = 1024; p_.b1off = 1024;
            nv::k_gemm<nv::EpiGateUp, 2><<<dim3(16, T / 64, 32), 256, 0, stream>>>(p_, nv::EpiGateUp{bgu, ACT}); } break;
        case mk::PH_G5: { nv::NG p_{}; p_.A = ACT; p_.lda = 1024; p_.cnt = CNT; p_.rowbase = PADS; p_.B = wd; p_.strideB = (size_t)1024 * 1024; p_.ldb = 1024; p_.K = 1024;
            nv::k_gemm<nv::EpiDown, 1><<<dim3(16, T / 64, 32), 256, 0, stream>>>(p_, nv::EpiDown{bd, LIST, YM}); } break;
        case mk::PH_FIN: nv::k_final<<<T / 4, 256, 0, stream>>>(out, YM, TOPW, norm_post_ffn, MOD); break;
        }
        ++p;
    }
}
```

```cpp
#include <hip/hip_runtime.h>
#include <hip/hip_bf16.h>
#include <stdint.h>
#include <cstdio>

typedef unsigned short bf16_t;
__device__ __forceinline__ float bf2f(bf16_t v) { return __uint_as_float(((unsigned)v) << 16); }
__device__ __forceinline__ bf16_t f2bf(float f) { unsigned u = __float_as_uint(f); return (bf16_t)((u + 0x7fffu + ((u >> 16) & 1u)) >> 16); }

constexpr int NB_ = 4, SEQ = 8192, T = NB_ * SEQ, D = 1024, NC = 5632, NE = 32;
constexpr size_t MiB = 1u << 20;
constexpr size_t WS_CTL = 0;
constexpr size_t WS_SMALL = 1 * MiB;
constexpr size_t WS_ROPEC = 2 * MiB, WS_ROPES = 3 * MiB;
constexpr size_t WS_TOPI = 4 * MiB, WS_TOPW = 4 * MiB + 512 * 1024;
constexpr size_t WS_RWT = 5 * MiB;
constexpr size_t WS_LIST = 6 * MiB;
constexpr size_t WS_WIN = 16 * MiB, WS_WA = 28 * MiB, WS_WB = 29 * MiB, WS_WO = 30 * MiB, WS_WGU = 32 * MiB, WS_WD = 160 * MiB;
constexpr size_t WS_H = 224 * MiB;
constexpr size_t WS_PROJ = 288 * MiB;
constexpr size_t WS_YA = 640 * MiB, WS_YB = 672 * MiB;
constexpr size_t WS_DS = 704 * MiB, WS_DEC = 768 * MiB;
constexpr size_t WS_MERGED = 772 * MiB;
constexpr size_t WS_Y = 836 * MiB;
constexpr size_t WS_ACT = 288 * MiB;
constexpr size_t WS_YM = 560 * MiB;
constexpr size_t WS_END = 964 * MiB;
constexpr int CW_CNT = 1024;
constexpr int CW_KMAX = 2048;
constexpr int CW_BAR = 4096;

namespace nv {

__device__ __forceinline__ float wave_sum(float v) {
#pragma unroll
    for (int o = 1; o < 64; o <<= 1) v += __shfl_xor(v, o);
    return v;
}
__device__ __forceinline__ float sigm(float x) { return 1.f / (1.f + expf(-x)); }

__global__ void __launch_bounds__(256) k_mod(const float* c, const float* w_mod, const float* b_mod, float* mod) {
    const int j = blockIdx.x * 256 + threadIdx.x, b = blockIdx.y;
    float acc = 0.f;
    for (int k = 0; k < 1024; ++k) { const float cv = c[b * 1024 + k]; acc += (cv * sigm(cv)) * w_mod[(size_t)k * 6144 + j]; }
    mod[b * 6144 + j] = acc + b_mod[j];
}
__global__ void __launch_bounds__(256) k_small(const float* q1, const float* k1, const float* q2, const float* k2, const float* lbl,
                                               float* scal, float* ropec, float* ropes) {
    const int gid = blockIdx.x * 256 + threadIdx.x;
    if (gid == 0) { float s1 = 0.f, s2 = 0.f; for (int i = 0; i < 64; ++i) { s1 += q1[i] * k1[i]; s2 += q2[i] * k2[i]; } scal[0] = expf(s1) - expf(s2) + 0.2f; }
    if (gid < 512) { const float a = lbl[gid], b = lbl[512 + gid]; scal[64 + gid] = 1.f / (1.f + expf(b - a)); }
    if (gid < 8192 * 32) { const int s = gid >> 5, i = gid & 31; const float inv = powf(10000.f, -(float)(2 * i) / 64.f); const float ang = (float)s * inv; ropec[gid] = cosf(ang); ropes[gid] = sinf(ang); }
}
__global__ void __launch_bounds__(256) k_rowmod(const float* x, const float* w, const float* mod, bf16_t* out, int shoff, int scoff) {
    const int row = blockIdx.x * 4 + (threadIdx.x >> 6), lane = threadIdx.x & 63, b = row >> 13;
    const float* xr = x + (size_t)row * 1024; float v[16]; float ss = 0.f;
#pragma unroll
    for (int j = 0; j < 16; ++j) { v[j] = xr[lane + 64 * j]; ss += v[j] * v[j]; }
    ss = wave_sum(ss); const float rstd = rsqrtf(ss * (1.f / 1024.f) + 1e-6f);
#pragma unroll
    for (int j = 0; j < 16; ++j) { const int col = lane + 64 * j; const float h = v[j] * rstd * w[col] * (1.f + mod[b * 6144 + scoff + col]) + mod[b * 6144 + shoff + col]; out[(size_t)row * 1024 + col] = f2bf(h); }
}

struct NG {
    const bf16_t* A;
    const int* rowidx;
    const int* cnt;
    const int* rowbase;
    const float* B; size_t strideB;
    int lda, idxstride, idxshift, M  , ldb, K, b1off, pad;
};
template <class Epi, int NB>
__global__ void __launch_bounds__(256) k_gemm(NG p, Epi epi) {
    __shared__ float As[16][68];
    __shared__ float Bs[NB][16][64];
    const int z = blockIdx.z, Mz = p.cnt ? p.cnt[z] : p.M, m0 = blockIdx.y * 64, n0 = blockIdx.x * 64;
    if (m0 >= Mz) return;
    const int tid = threadIdx.x, tx = tid & 15, ty = tid >> 4;
    const float* B = p.B + (size_t)z * p.strideB;
    const int base = p.rowbase ? p.rowbase[z] : 0;
    const int lr = tid >> 2, lk = (tid & 3) * 4;
    int lrow = m0 + lr; if (lrow >= Mz) lrow = Mz - 1;
    const size_t arow = p.rowidx ? (size_t)(p.rowidx[(size_t)z * p.idxstride + lrow] >> p.idxshift) : (size_t)(base + lrow);
    const bf16_t* ap = p.A + arow * p.lda + lk;
    const int bk = tid >> 4, bc = (tid & 15) * 4;
    float acc[NB][4][4];
#pragma unroll
    for (int q = 0; q < NB; ++q)
#pragma unroll
        for (int i = 0; i < 4; ++i)
#pragma unroll
            for (int j = 0; j < 4; ++j) acc[q][i][j] = 0.f;
    for (int k0 = 0; k0 < p.K; k0 += 16) {
        const uint2 av = *(const uint2*)(ap + k0);
        As[lk + 0][lr] = __uint_as_float(av.x << 16); As[lk + 1][lr] = __uint_as_float(av.x & 0xffff0000u);
        As[lk + 2][lr] = __uint_as_float(av.y << 16); As[lk + 3][lr] = __uint_as_float(av.y & 0xffff0000u);
#pragma unroll
        for (int q = 0; q < NB; ++q) { const float4 bv = *(const float4*)(B + (size_t)(k0 + bk) * p.ldb + n0 + bc + q * p.b1off); *(float4*)&Bs[q][bk][bc] = bv; }
        __syncthreads();
#pragma unroll
        for (int k = 0; k < 16; ++k) {
            float a[4]; const float4 a4 = *(const float4*)&As[k][ty * 4]; a[0] = a4.x; a[1] = a4.y; a[2] = a4.z; a[3] = a4.w;
#pragma unroll
            for (int q = 0; q < NB; ++q) { const float4 b4 = *(const float4*)&Bs[q][k][tx * 4]; const float b[4] = {b4.x, b4.y, b4.z, b4.w};
#pragma unroll
                for (int i = 0; i < 4; ++i)
#pragma unroll
                    for (int j = 0; j < 4; ++j) acc[q][i][j] += a[i] * b[j]; }
        }
        __syncthreads();
    }
#pragma unroll
    for (int i = 0; i < 4; ++i) { const int lrw = m0 + ty * 4 + i; if (lrw < Mz) {
#pragma unroll
        for (int j = 0; j < 4; ++j) epi(z, lrw, base + lrw, n0 + tx * 4 + j, acc[0][i][j], NB == 2 ? acc[NB - 1][i][j] : 0.f); } }
}
struct EpiStoreBf16 { bf16_t* C; long long ldc; __device__ void operator()(int, int, int r, int c, float v, float) const { C[(size_t)r * ldc + c] = f2bf(v); } };
struct EpiStoreF32 { float* C; long long ldc; __device__ void operator()(int, int, int r, int c, float v, float) const { C[(size_t)r * ldc + c] = v; } };
struct EpiBranchA { float* tmp; const bf16_t* proj; __device__ void operator()(int, int, int r, int c, float v, float) const { tmp[(size_t)r * 1024 + c] = sigm(bf2f(proj[(size_t)r * 5632 + 3584 + c])) * v; } };
struct EpiBranchB { const float* tmp; const bf16_t* proj; bf16_t* merged; __device__ void operator()(int, int, int r, int c, float v, float) const {
    merged[(size_t)r * 1024 + c] = f2bf(tmp[(size_t)r * 1024 + c] + sigm(bf2f(proj[(size_t)r * 5632 + 4608 + c])) * v); } };
struct EpiGateUp { const float* bgu; bf16_t* act; __device__ void operator()(int e, int, int r, int c, float v0, float v1) const {
    float g = v0 + bgu[e * 2048 + c], u = v1 + bgu[e * 2048 + 1024 + c]; g = fminf(g, 7.f); u = fminf(fmaxf(u, -7.f), 7.f);
    const float glu = g * sigm(1.702f * g); act[(size_t)r * 1024 + c] = f2bf((u + 1.f) * glu); } };
struct EpiDown { const float* bd; const int* list; bf16_t* ym; __device__ void operator()(int e, int lr, int, int c, float v, float) const {
    const int a = list[(size_t)e * 32768 + lr]; ym[(size_t)a * 1024 + c] = f2bf(v + bd[e * 1024 + c]); } };

constexpr int AT_LD = 129;
constexpr int AT_LDS = (3 * 64 * AT_LD + 64 * 65) * 4;
__device__ __forceinline__ void at_load_rope(float* dst, const bf16_t* proj, int tok0, int colbase, const float* ropec, const float* ropes, int s0, int tid) {
    for (int i = 0; i < 16; ++i) { const int idx = tid + 256 * i, row = idx >> 6, rem = idx & 63, m = rem >> 5, d = rem & 31;
        const bf16_t* pr = proj + (size_t)(tok0 + row) * 5632 + colbase + m * 64;
        const float x1 = bf2f(pr[d]), x2 = bf2f(pr[32 + d]), c = ropec[(s0 + row) * 32 + d], s = ropes[(s0 + row) * 32 + d];
        dst[row * AT_LD + m * 64 + d] = x1 * c - x2 * s; dst[row * AT_LD + m * 64 + 32 + d] = x2 * c + x1 * s; }
}
__global__ void __launch_bounds__(256) k_attn(const bf16_t* proj, const float* ropec, const float* ropes, const float* scal, const float* subln, bf16_t* ya) {
    extern __shared__ float sm[];
    float* Qs = sm; float* Ks = Qs + 64 * AT_LD; float* Vs = Ks + 64 * AT_LD; float* As = Vs + 64 * AT_LD;
    const int qc = blockIdx.x, h = blockIdx.y, b = blockIdx.z, tid = threadIdx.x, r = tid >> 2, qd = tid & 3;
    const int tokq = b * 8192 + qc * 64; const float lam = scal[0];
    at_load_rope(Qs, proj, tokq, h * 128, ropec, ropes, qc * 64, tid);
    float m0 = -1e30f, l0 = 0.f, m1 = -1e30f, l1 = 0.f;
    for (int kc = 0; kc <= qc; ++kc) {
        __syncthreads();
        at_load_rope(Ks, proj, b * 8192 + kc * 64, 512 + h * 128, ropec, ropes, kc * 64, tid);
        __syncthreads();
        for (int i = 0; i < 16; ++i) { const int j = 4 * i + qd; float s0 = 0.f, s1 = 0.f;
            for (int d = 0; d < 64; ++d) { s0 += Qs[r * AT_LD + d] * Ks[j * AT_LD + d]; s1 += Qs[r * AT_LD + 64 + d] * Ks[j * AT_LD + 64 + d]; }
            s0 *= 0.125f; s1 *= 0.125f;
            float mn = fmaxf(m0, s0); l0 = l0 * expf(m0 - mn) + expf(s0 - mn); m0 = mn;
            mn = fmaxf(m1, s1); l1 = l1 * expf(m1 - mn) + expf(s1 - mn); m1 = mn; }
    }
#pragma unroll
    for (int o = 1; o < 4; o <<= 1) {
        float mo = __shfl_xor(m0, o), lo = __shfl_xor(l0, o); float mn = fmaxf(m0, mo); l0 = l0 * expf(m0 - mn) + lo * expf(mo - mn); m0 = mn;
        mo = __shfl_xor(m1, o); lo = __shfl_xor(l1, o); mn = fmaxf(m1, mo); l1 = l1 * expf(m1 - mn) + lo * expf(mo - mn); m1 = mn; }
    const float il0 = 1.f / l0, il1 = lam / l1;
    float o[32];
#pragma unroll
    for (int i = 0; i < 32; ++i) o[i] = 0.f;
    for (int kc = 0; kc <= qc; ++kc) {
        __syncthreads();
        at_load_rope(Ks, proj, b * 8192 + kc * 64, 512 + h * 128, ropec, ropes, kc * 64, tid);
        for (int i = 0; i < 32; ++i) { const int idx = tid + 256 * i, row = idx >> 7, col = idx & 127; Vs[row * AT_LD + col] = bf2f(proj[(size_t)(b * 8192 + kc * 64 + row) * 5632 + 1024 + h * 128 + col]); }
        __syncthreads();
        for (int i = 0; i < 16; ++i) { const int j = 4 * i + qd; float s0 = 0.f, s1 = 0.f;
            for (int d = 0; d < 64; ++d) { s0 += Qs[r * AT_LD + d] * Ks[j * AT_LD + d]; s1 += Qs[r * AT_LD + 64 + d] * Ks[j * AT_LD + 64 + d]; }
            s0 *= 0.125f; s1 *= 0.125f;
            As[r * 65 + j] = expf(s0 - m0) * il0 - expf(s1 - m1) * il1; }
        __syncthreads();
        for (int j = 0; j < 64; ++j) { const float av = As[r * 65 + j];
#pragma unroll
            for (int dv = 0; dv < 32; ++dv) o[dv] += av * Vs[j * AT_LD + 32 * qd + dv]; }
    }
    float ss = 0.f;
#pragma unroll
    for (int i = 0; i < 32; ++i) ss += o[i] * o[i];
    ss += __shfl_xor(ss, 1); ss += __shfl_xor(ss, 2);
    const float rstd = rsqrtf(ss * (1.f / 128.f) + 1e-6f);
#pragma unroll
    for (int i = 0; i < 32; ++i) { const int dv = 32 * qd + i; ya[(size_t)(tokq + r) * 512 + h * 128 + dv] = f2bf(o[i] * rstd * subln[dv] * 0.8f); }
}

__global__ void __launch_bounds__(256) k_hgA(const bf16_t* proj, const float* scal, bf16_t* ds, float* dec) {
    extern __shared__ float sm[];
    float* G = sm; float* V = sm + 64 * 128;
    const int n = blockIdx.x, h = blockIdx.y, b = blockIdx.z, tid = threadIdx.x, tok0 = b * 8192 + n * 64, bh = b * 4 + h;
    for (int i = 0; i < 32; ++i) { const int idx = tid + 256 * i, c = idx >> 7, d = idx & 127; const bf16_t* pr = proj + (size_t)(tok0 + c) * 5632 + h * 128 + d;
        const float lb = scal[64 + h * 128 + d]; const float f = lb + (1.f - lb) * sigm(bf2f(pr[2048])); G[c * 128 + d] = f; V[c * 128 + d] = bf2f(pr[2560]); }
    __syncthreads();
    float kk[64]; float glast = 0.f; const int d = tid & 127, vb = (tid >> 7) * 64;
    {
        float g = 0.f;
#pragma unroll
        for (int c = 0; c < 64; ++c) { const float f = G[c * 128 + d]; g += logf(f); kk[c] = g; }
        glast = g;
#pragma unroll
        for (int c = 0; c < 64; ++c) { const float f = G[c * 128 + d]; kk[c] = (1.f - f) * expf(glast - kk[c]); }
    }
    if (tid < 128) dec[(size_t)(bh * 128 + n) * 128 + d] = expf(glast);
    for (int v0 = 0; v0 < 64; v0 += 16) {
        float acc[16];
#pragma unroll
        for (int i = 0; i < 16; ++i) acc[i] = 0.f;
#pragma unroll
        for (int c = 0; c < 64; ++c) {
#pragma unroll
            for (int i = 0; i < 16; ++i) acc[i] += kk[c] * V[c * 128 + vb + v0 + i]; }
#pragma unroll
        for (int i = 0; i < 16; ++i) ds[((size_t)(bh * 128 + n) * 128 + d) * 128 + vb + v0 + i] = f2bf(acc[i]);
    }
}
__global__ void __launch_bounds__(256) k_scan(const bf16_t* ds, const float* dec, bf16_t* sp) {
    const int gid = blockIdx.x * 256 + threadIdx.x; const int bh = gid >> 14, d = (gid >> 7) & 127, v = gid & 127;
    float st = 0.f;
    for (int n = 0; n < 128; ++n) { const size_t o = ((size_t)(bh * 128 + n) * 128 + d) * 128 + v; const float x = bf2f(ds[o]); sp[o] = f2bf(st); st = dec[(size_t)(bh * 128 + n) * 128 + d] * st + x; }
}
constexpr int HC_LDS = (2 * 64 * 129 + 64 * 128 + 64 * 65) * 4;
__global__ void __launch_bounds__(256) k_hgC(const bf16_t* proj, const float* scal, const bf16_t* sp, const float* hgnorm, bf16_t* yb) {
    extern __shared__ float sm[];
    float* QT = sm; float* KT = QT + 64 * 129; float* V = KT + 64 * 129; float* As = V + 64 * 128;
    const int n = blockIdx.x, h = blockIdx.y, b = blockIdx.z, tid = threadIdx.x, tok0 = b * 8192 + n * 64, bh = b * 4 + h;
    for (int i = 0; i < 32; ++i) { const int idx = tid + 256 * i, c = idx >> 7, d = idx & 127; const bf16_t* pr = proj + (size_t)(tok0 + c) * 5632 + h * 128 + d;
        const float lb = scal[64 + h * 128 + d]; const float f = lb + (1.f - lb) * sigm(bf2f(pr[2048])); const float q = bf2f(pr[1536]);
        QT[c * 129 + d] = q * sigm(q); KT[c * 129 + d] = f; V[c * 128 + d] = bf2f(pr[2560]); }
    __syncthreads();
    if (tid < 128) { float g = 0.f; for (int c = 0; c < 64; ++c) { const float f = KT[c * 129 + tid]; g += logf(f); QT[c * 129 + tid] *= expf(g); KT[c * 129 + tid] = (1.f - f) * expf(-g); } }
    __syncthreads();
    const int c = tid >> 2, q4 = tid & 3;
    for (int i = 0; i < 16; ++i) { const int s = 4 * i + q4; float a = 0.f;
        if (s <= c) { for (int d = 0; d < 128; ++d) a += QT[c * 129 + d] * KT[s * 129 + d]; }
        As[c * 65 + s] = a; }
    __syncthreads();
    float o[32];
#pragma unroll
    for (int i = 0; i < 32; ++i) o[i] = 0.f;
    for (int s = 0; s < 64; ++s) { const float a = As[c * 65 + s];
#pragma unroll
        for (int i = 0; i < 32; ++i) o[i] += a * V[s * 128 + 32 * q4 + i]; }
    const bf16_t* spb = sp + (size_t)(bh * 128 + n) * 128 * 128;
    for (int d = 0; d < 128; ++d) { const float qv = QT[c * 129 + d];
#pragma unroll
        for (int i = 0; i < 32; ++i) o[i] += qv * bf2f(spb[d * 128 + 32 * q4 + i]); }
    float ss = 0.f;
#pragma unroll
    for (int i = 0; i < 32; ++i) ss += o[i] * o[i];
    ss += __shfl_xor(ss, 1); ss += __shfl_xor(ss, 2);
    const float rstd = rsqrtf(ss * (1.f / 128.f) + 1e-6f);
#pragma unroll
    for (int i = 0; i < 32; ++i) { const int v = 32 * q4 + i; const float g = bf2f(proj[(size_t)(tok0 + c) * 5632 + 3072 + h * 128 + v]);
        yb[(size_t)(tok0 + c) * 512 + h * 128 + v] = f2bf(o[i] * rstd * hgnorm[v] * (g * sigm(g))); }
}
__global__ void __launch_bounds__(256) k_x1(const float* x, const float* y, const float* w, const float* mod, long long goff, float* x1) {
    const int row = blockIdx.x * 4 + (threadIdx.x >> 6), lane = threadIdx.x & 63, b = row >> 13;
    const float* yr = y + (size_t)row * 1024; float v[16]; float ss = 0.f;
#pragma unroll
    for (int j = 0; j < 16; ++j) { v[j] = yr[lane + 64 * j]; ss += v[j] * v[j]; }
    ss = wave_sum(ss); const float rstd = rsqrtf(ss * (1.f / 1024.f) + 1e-6f);
#pragma unroll
    for (int j = 0; j < 16; ++j) { const int col = lane + 64 * j; x1[(size_t)row * 1024 + col] = x[(size_t)row * 1024 + col] + mod[b * 6144 + goff + col] * v[j] * rstd * w[col]; }
}
__global__ void __launch_bounds__(256) k_route(const float* x1, const float* w, const float* mod, const float* rw, const float* rb, int* topi, float* topw) {
    const int row = blockIdx.x * 4 + (threadIdx.x >> 6), lane = threadIdx.x & 63, b = row >> 13;
    const float* xr = x1 + (size_t)row * 1024; float v[16]; float ss = 0.f;
#pragma unroll
    for (int j = 0; j < 16; ++j) { v[j] = xr[lane + 64 * j]; ss += v[j] * v[j]; }
    ss = wave_sum(ss); const float rstd = rsqrtf(ss * (1.f / 1024.f) + 1e-6f);
    float lg[32];
#pragma unroll
    for (int e = 0; e < 32; ++e) lg[e] = 0.f;
#pragma unroll
    for (int j = 0; j < 16; ++j) { const int col = lane + 64 * j; const float h = v[j] * rstd * w[col] * (1.f + mod[b * 6144 + 4096 + col]) + mod[b * 6144 + 3072 + col];
#pragma unroll
        for (int e = 0; e < 32; ++e) lg[e] += h * rw[col * 32 + e]; }
#pragma unroll
    for (int e = 0; e < 32; ++e) lg[e] = wave_sum(lg[e]) + rb[e];
    int bi[4]; float bv[4];
#pragma unroll
    for (int k = 0; k < 4; ++k) { float best = -3.0e38f; int be = 0;
#pragma unroll
        for (int e = 0; e < 32; ++e) { bool taken = false;
#pragma unroll
            for (int q = 0; q < 4; ++q) if (q < k && bi[q] == e) taken = true;
            if (!taken && lg[e] > best) { best = lg[e]; be = e; } }
        bi[k] = be; bv[k] = best; }
    const float e1 = expf(bv[1] - bv[0]), e2 = expf(bv[2] - bv[0]), e3 = expf(bv[3] - bv[0]); const float inv = 1.f / (1.f + e1 + e2 + e3);
    if (lane == 0) { topi[row * 4 + 0] = bi[0]; topi[row * 4 + 1] = bi[1]; topi[row * 4 + 2] = bi[2]; topi[row * 4 + 3] = bi[3];
        topw[row * 4 + 0] = inv; topw[row * 4 + 1] = e1 * inv; topw[row * 4 + 2] = e2 * inv; topw[row * 4 + 3] = e3 * inv; }
}
__global__ void __launch_bounds__(256) k_lists(const int* topi, int* cnt, int* list) {
    const int a = blockIdx.x * 256 + threadIdx.x; const int e = topi[a]; const int pos = atomicAdd(&cnt[e], 1); list[(size_t)e * 32768 + pos] = a;
}
__global__ void k_pads(const int* cnt, int* pads) { if (threadIdx.x == 0) { int s = 0; for (int e = 0; e < 32; ++e) { pads[e] = s; s += ((cnt[e] + 255) / 256) * 256; } } }
__global__ void __launch_bounds__(256) k_final(float* out, const bf16_t* ym, const float* topw, const float* w, const float* mod) {
    const int row = blockIdx.x * 4 + (threadIdx.x >> 6), lane = threadIdx.x & 63, b = row >> 13;
    float v[16]; float ss = 0.f; const float w0 = topw[row * 4], w1 = topw[row * 4 + 1], w2 = topw[row * 4 + 2], w3 = topw[row * 4 + 3];
    const bf16_t* y0 = ym + (size_t)row * 4096;
#pragma unroll
    for (int j = 0; j < 16; ++j) { const int col = lane + 64 * j; v[j] = w0 * bf2f(y0[col]) + w1 * bf2f(y0[1024 + col]) + w2 * bf2f(y0[2048 + col]) + w3 * bf2f(y0[3072 + col]); ss += v[j] * v[j]; }
    ss = wave_sum(ss); const float rstd = rsqrtf(ss * (1.f / 1024.f) + 1e-6f);
#pragma unroll
    for (int j = 0; j < 16; ++j) { const int col = lane + 64 * j; out[(size_t)row * 1024 + col] += mod[b * 6144 + 5120 + col] * v[j] * rstd * w[col]; }
}
}
#define GAS __attribute__((address_space(1)))
#define LAS __attribute__((address_space(3)))
typedef GAS unsigned gu32;
#define RLX_AGENT __ATOMIC_RELAXED, __HIP_MEMORY_SCOPE_AGENT
#define XB_TMO      128
#define XB_XCNT(j)  (256  + 64 * (j))
#define XB_XSUB(j)  (1280 + 64 * (j))
#define XB_XGEN(j)  (2304 + 64 * (j))
#define XB_TOP      3328
#define XB_TOPGEN   3392
#define XCD_BAR_WORDS 3456
#define XB_SPIN_CAP (1u << 22)

__device__ __forceinline__ unsigned xb_ld(unsigned* p)              { return __hip_atomic_load(p, __ATOMIC_RELAXED, __HIP_MEMORY_SCOPE_AGENT); }
__device__ __forceinline__ unsigned xb_add(unsigned* p, unsigned v) { return __hip_atomic_fetch_add(p, v, __ATOMIC_RELAXED, __HIP_MEMORY_SCOPE_AGENT); }
__device__ __forceinline__ unsigned xb_xcc_id() { return (unsigned)__builtin_amdgcn_s_getreg((3 << 11) | 20) & 0xFu; }
#define XB_SPIN(cond, bar) do { unsigned _sp = 0; while (cond) { __builtin_amdgcn_s_sleep(1); \
    if ((++_sp & 255u) == 0u) { if (xb_ld(&(bar)[XB_TMO])) break; if (_sp > XB_SPIN_CAP) { atomicAdd(&(bar)[XB_TMO], 1u); break; } } } } while (0)

struct XcdBarrier {
    unsigned* bar; unsigned x;
    volatile LAS unsigned* st;
};
__device__ __forceinline__ XcdBarrier xcd_barrier_post(unsigned* bar, volatile LAS unsigned* st) {
    XcdBarrier b; b.bar = bar; b.x = xb_xcc_id(); b.st = st;
    if (threadIdx.x == 0) (void)xb_add(&bar[XB_XCNT(b.x)], 1u);
    return b;
}
__device__ __forceinline__ void xcd_barrier_complete(unsigned* bar, unsigned x, unsigned& nloc, unsigned& nx) {
    const unsigned G = gridDim.x * gridDim.y * gridDim.z;
    unsigned sum, cnt, mine, sp = 0u;
    for (;;) {
        sum = 0u; cnt = 0u; mine = 0u;
#pragma unroll
        for (unsigned j = 0; j < 16; ++j) { const unsigned c = xb_ld(&bar[XB_XCNT(j)]); sum += c; cnt += (c > 0u) ? 1u : 0u; mine = (j == x) ? c : mine; }
        if (sum == G) break;
        __builtin_amdgcn_s_sleep(1);
        if ((++sp & 255u) == 0u) { if (xb_ld(&bar[XB_TMO])) break; if (sp > XB_SPIN_CAP) { atomicAdd(&bar[XB_TMO], 1u); break; } }
    }
    nloc = mine > 0u ? mine : 1u; nx = cnt > 0u ? cnt : 1u;
}
__device__ __forceinline__ void xcd_barrier(const XcdBarrier& b) {
    asm volatile("s_waitcnt vmcnt(0)" ::: "memory");
    __syncthreads();
    if (threadIdx.x == 0) {
        unsigned* bar = b.bar;
        __builtin_amdgcn_s_waitcnt(0);
        unsigned nloc = b.st[0], nx = b.st[1];
        if (nloc == 0u) { xcd_barrier_complete(bar, b.x, nloc, nx); b.st[0] = nloc; b.st[1] = nx; }
        const unsigned old = xb_add(&bar[XB_XSUB(b.x)], 1u);
        const unsigned gen = old / nloc;
        if (old + 1u == (gen + 1u) * nloc) {
            __builtin_amdgcn_fence(__ATOMIC_RELEASE, "agent");
            asm volatile("s_waitcnt vmcnt(0)" ::: "memory");
            const unsigned og = xb_add(&bar[XB_TOP], 1u);
            const unsigned tg = og / nx;
            if (og + 1u == (tg + 1u) * nx) xb_add(&bar[XB_TOPGEN], 1u);
            else XB_SPIN(xb_ld(&bar[XB_TOPGEN]) == tg, bar);
            __builtin_amdgcn_fence(__ATOMIC_ACQUIRE, "agent");
            xb_add(&bar[XB_XGEN(b.x)], 1u);
            asm volatile("s_waitcnt vmcnt(0)" ::: "memory");
        } else {
            XB_SPIN(xb_ld(&bar[XB_XGEN(b.x)]) == gen, bar);
            __builtin_amdgcn_fence(__ATOMIC_ACQUIRE, "agent");
            asm volatile("s_waitcnt vmcnt(0)" ::: "memory");
        }
    }
    __syncthreads();
}
namespace pg8 {
#define PG8_LAS __attribute__((address_space(3)))
typedef short bf16x8 __attribute__((ext_vector_type(8)));
typedef float f32x4 __attribute__((ext_vector_type(4)));
typedef float f32x2 __attribute__((ext_vector_type(2)));
typedef unsigned u32x4 __attribute__((ext_vector_type(4)));
typedef unsigned u32x2 __attribute__((ext_vector_type(2)));
typedef int i32x4 __attribute__((ext_vector_type(4)));
typedef int i32x8 __attribute__((ext_vector_type(8)));
constexpr int BM = 256, BK = 64, HALF = 128, HTB = HALF * BK * 2  , STAGE_BYTES = 8 * HTB, NXCD = 8, WGM = 8;

__host__ __device__ __forceinline__ int lds_byte(int r, int c) { const int st = (r >> 4) * 2 + (c >> 5), rr = r & 15, cc = c & 31, ob = rr * 64 + cc * 2; return st * 1024 + (ob ^ (((ob >> 9) & 1) << 5)); }
__host__ __device__ __forceinline__ void stage_rc(int b, int& R, int& C) { const int st = b / 1024, sb = b % 1024, swz = sb ^ (((sb >> 9) & 1) << 5); R = (st >> 1) * 16 + swz / 64; C = (st & 1) * 32 + (swz % 64) / 2; }
__host__ __device__ __forceinline__ int perm32(int rho) { const int n = rho >> 4, i = rho & 15; return 8 * (i >> 2) + 4 * n + (i & 3); }

struct Unit { int pm, pn, z, arow, brow; };
struct Gemm { const bf16_t* A; const bf16_t* Bt; int K; const bf16_t* A2; const bf16_t* Bt2; };

struct DenseOrder {
    int nM, nN, nwg, G, c;
    __device__ void init(int M, int N, int G_, int c_) { nM = M / BM; nN = N / BM; nwg = nM * nN; G = G_; c = c_; }
    __device__ bool next(int i, Unit& u) const {
        const long L = (long)i * G + c; if (L >= nwg) return false;
        int wgid = (int)L; { const int q = nwg / NXCD, r = nwg % NXCD, xcd = wgid % NXCD, off = wgid / NXCD; wgid = (xcd < r ? xcd * (q + 1) : r * (q + 1) + (xcd - r) * q) + off; }
        const int nig = WGM * nN, gid = wgid / nig, fm = gid * WGM, gsz = (nM - fm) < WGM ? (nM - fm) : WGM;
        u.pm = fm + ((wgid % nig) % gsz); u.pn = (wgid % nig) / gsz; u.z = 0; u.arow = u.pm * BM; u.brow = u.pn * BM; return true;
    }
    __device__ __forceinline__ unsigned row_off(const Unit&, int) const { return 0u; }
};

struct DenseOrder2 { DenseOrder base;
    __device__ bool next(int i, Unit& u) const { if (!base.next(i >> 1, u)) return false; u.z = i & 1; return true; }
    __device__ __forceinline__ unsigned row_off(const Unit&, int) const { return 0u; }
};
__device__ __forceinline__ unsigned cvt_pk_bf16(float lo, float hi) { unsigned r; asm volatile("v_cvt_pk_bf16_f32 %0, %1, %2" : "=v"(r) : "v"(lo), "v"(hi)); return r; }


template <class Epi, class Sched, bool GATHER, bool TWOPART = false, bool FP8 = false>
__device__ __forceinline__ void gemm_phase(PG8_LAS unsigned char* lds, const Gemm g, const Sched& S, const Epi& E) {
    int tid_ = threadIdx.x; asm volatile("" : "+v"(tid_));
    const int tid = tid_, wid = __builtin_amdgcn_readfirstlane(tid >> 6), lane = tid & 63, wr = wid >> 2, wc = wid & 3, fr = lane & 15, fq = lane >> 4;
    const int K = g.K, nt = K / BK;
    unsigned voffA[2], voffB[2]; int RA[2];
#pragma unroll
    for (int i = 0; i < 2; ++i) { int R, C; stage_rc(tid * 16 + i * 8192, R, C); const int Rb = Epi::PERM ? ((R & ~31) + perm32(R & 31)) : R;
        RA[i] = R; voffA[i] = GATHER ? (unsigned)(C * 2) : (unsigned)(R * K + C) * 2u; voffB[i] = (unsigned)(Rb * K + C) * 2u; }
    const size_t kstep = (size_t)(BK * 2);
    const size_t hstep = (size_t)HALF * K * 2;
    const unsigned ldsw = (unsigned)wid * 1024u;
    const int aoff = lds_byte(wr * 64 + fr, fq * 8), boff = lds_byte(wc * 32 + fr, fq * 8);
    unsigned gAc[2][2], gAn[2][2];
#define PG8_SA(b, h) (((b) * 2 + (h)) * HTB)
#define PG8_SB(b, h) ((4 + (b) * 2 + (h)) * HTB)
#define PG8_STAGE(bufoff, gbase, voff) do { _Pragma("unroll") for (int _i = 0; _i < 2; ++_i) \
        __builtin_amdgcn_global_load_lds((const unsigned*)((const char*)(gbase) + (voff)[_i]), (PG8_LAS unsigned*)(lds + (bufoff) + ldsw + _i * 8192), 16, 0, 0); } while (0)
#define PG8_STAGEA(bufoff, gbase, h, nx) do { if constexpr (GATHER) { _Pragma("unroll") for (int _i = 0; _i < 2; ++_i) { const unsigned _v = ((nx) ? gAn[h][_i] : gAc[h][_i]) + voffA[_i]; \
        __builtin_amdgcn_global_load_lds((const unsigned*)((const char*)(gbase) + _v), (PG8_LAS unsigned*)(lds + (bufoff) + ldsw + _i * 8192), 16, 0, 0); } } \
        else { PG8_STAGE(bufoff, (const char*)(gbase) + (h) * hstep, voffA); } } while (0)
#define PG8_LD8(base) __builtin_shufflevector(*(const PG8_LAS i32x4*)(base), *(const PG8_LAS i32x4*)((base) + 1024), 0, 1, 2, 3, 4, 5, 6, 7)
#define PG8_LDA(dst, b, h) do { if constexpr (FP8) { _Pragma("unroll") for (int m = 0; m < 4; ++m) dst##8[m] = PG8_LD8(lds + PG8_SA(b, h) + aoff + m * 2048); } \
        else { _Pragma("unroll") for (int m = 0; m < 4; ++m) _Pragma("unroll") for (int k = 0; k < 2; ++k) dst[m][k] = *(const PG8_LAS bf16x8*)(lds + PG8_SA(b, h) + aoff + m * 2048 + k * 1024); } } while (0)
#define PG8_LDB(dst, b, h) do { if constexpr (FP8) { _Pragma("unroll") for (int n = 0; n < 2; ++n) dst##8[n] = PG8_LD8(lds + PG8_SB(b, h) + boff + n * 2048); } \
        else { _Pragma("unroll") for (int n = 0; n < 2; ++n) _Pragma("unroll") for (int k = 0; k < 2; ++k) dst[n][k] = *(const PG8_LAS bf16x8*)(lds + PG8_SB(b, h) + boff + n * 2048 + k * 1024); } } while (0)
#define PG8_CAT(x, y) __builtin_shufflevector(__builtin_bit_cast(i32x4, x), __builtin_bit_cast(i32x4, y), 0, 1, 2, 3, 4, 5, 6, 7)
#define PG8_MMA(ai, bj, At, Bt) do { __builtin_amdgcn_s_setprio(1); \
        if constexpr (FP8) { _Pragma("unroll") for (int m = 0; m < 4; ++m) _Pragma("unroll") for (int n = 0; n < 2; ++n) \
            asm volatile("v_mfma_scale_f32_16x16x128_f8f6f4 %0, %1, %2, %0, %3, %3 op_sel_hi:[0,0,0]" : "+v"(acc[ai][bj][m][n]) : "v"(Bt##8[n]), "v"(At##8[m]), "v"(one8)); } \
        else { _Pragma("unroll") for (int m = 0; m < 4; ++m) _Pragma("unroll") for (int n = 0; n < 2; ++n) _Pragma("unroll") for (int k = 0; k < 2; ++k) \
            acc[ai][bj][m][n] = __builtin_amdgcn_mfma_f32_16x16x32_bf16(Bt[n][k], At[m][k], acc[ai][bj][m][n], 0, 0, 0); } \
        __builtin_amdgcn_s_setprio(0); } while (0)
#define PG8_WAIT_V(n) asm volatile("s_waitcnt vmcnt(" #n ")" ::: "memory")
#define PG8_WAIT_L(n) asm volatile("s_waitcnt lgkmcnt(" #n ")" ::: "memory")
#define PG8_BAR __builtin_amdgcn_s_barrier()
#define PG8_SCHED __builtin_amdgcn_sched_barrier(0)
    Unit cur, nxt; int ui = 0;
    if (!S.next(0, cur)) return;
    f32x4 acc[2][2][4][2];
#pragma unroll
    for (int a = 0; a < 2; ++a)
#pragma unroll
        for (int b = 0; b < 2; ++b)
#pragma unroll
            for (int m = 0; m < 4; ++m)
#pragma unroll
                for (int n = 0; n < 2; ++n) acc[a][b][m][n] = (f32x4){0.f, 0.f, 0.f, 0.f};
    if constexpr (FP8) {
#pragma unroll
        for (int a = 0; a < 2; ++a)
#pragma unroll
            for (int b = 0; b < 2; ++b) asm volatile("s_nop 3" : "+v"(acc[a][b][0][0]), "+v"(acc[a][b][0][1]), "+v"(acc[a][b][1][0]), "+v"(acc[a][b][1][1]), "+v"(acc[a][b][2][0]), "+v"(acc[a][b][2][1]), "+v"(acc[a][b][3][0]), "+v"(acc[a][b][3][1]));
    }
    unsigned one8 = 0x7f7f7f7fu; asm volatile("" : "+v"(one8));
    bf16x8 At[4][2], B0[2][2], B1[2][2];
    i32x8 At8[4], B08[2], B18[2];
    const char* cA = GATHER ? (const char*)g.A : (const char*)((TWOPART && cur.z) ? g.A2 : g.A) + (size_t)cur.arow * K * 2; const char* cB = (const char*)((TWOPART && cur.z) ? g.Bt2 : g.Bt) + (size_t)cur.brow * K * 2;
    if constexpr (GATHER) {
#pragma unroll
        for (int h = 0; h < 2; ++h)
#pragma unroll
            for (int i = 0; i < 2; ++i) { gAc[h][i] = S.row_off(cur, h * HALF + RA[i]); gAn[h][i] = gAc[h][i]; }
    }
    PG8_STAGE(PG8_SB(0, 0), cB, voffB); PG8_STAGE(PG8_SB(0, 1), cB + hstep, voffB); PG8_STAGEA(PG8_SA(0, 0), cA, 0, false); PG8_STAGEA(PG8_SA(0, 1), cA, 1, false);
    if (wr == 1) PG8_BAR;
    PG8_WAIT_V(2); PG8_BAR;
    PG8_STAGE(PG8_SB(1, 0), cB + kstep, voffB); PG8_STAGEA(PG8_SA(1, 0), cA + kstep, 0, false); PG8_STAGE(PG8_SB(1, 1), cB + hstep + kstep, voffB);
    PG8_WAIT_V(6); PG8_BAR;
    for (;;) {
        const bool has_next = S.next(ui + 1, nxt);
        const char* nA = has_next ? (GATHER ? (const char*)g.A : (const char*)((TWOPART && nxt.z) ? g.A2 : g.A) + (size_t)nxt.arow * K * 2) : cA; const char* nB = has_next ? (const char*)((TWOPART && nxt.z) ? g.Bt2 : g.Bt) + (size_t)nxt.brow * K * 2 : cB;
        if constexpr (GATHER) { if (has_next) {
#pragma unroll
            for (int h = 0; h < 2; ++h)
#pragma unroll
                for (int i = 0; i < 2; ++i) gAn[h][i] = S.row_off(nxt, h * HALF + RA[i]); } }
#pragma unroll 1
        for (int t = 0; t < nt; t += 2) {
            const bool last = (t == nt - 2);
            const char* a1 = cA + (size_t)(t + 1) * kstep;
            const char* a2 = last ? nA : cA + (size_t)(t + 2) * kstep; const char* b2 = last ? nB : cB + (size_t)(t + 2) * kstep;
            const char* a3 = a2 + kstep; const char* b3 = b2 + kstep;
            PG8_LDB(B0, 0, 0); PG8_LDB(B1, 0, 1); PG8_SCHED; PG8_LDA(At, 0, 0); PG8_STAGEA(PG8_SA(1, 1), a1, 1, false);
            PG8_WAIT_V(8); PG8_WAIT_L(0); PG8_BAR; PG8_MMA(0, 0, At, B0); PG8_MMA(0, 1, At, B1); PG8_BAR; PG8_SCHED;
            PG8_LDA(At, 0, 1); PG8_STAGE(PG8_SB(0, 0), b2, voffB); PG8_STAGE(PG8_SB(0, 1), b2 + hstep, voffB); PG8_STAGEA(PG8_SA(0, 0), a2, 0, last);
            PG8_WAIT_V(8); PG8_WAIT_L(0); PG8_BAR; PG8_MMA(1, 0, At, B0); PG8_MMA(1, 1, At, B1); PG8_BAR; PG8_SCHED;
            PG8_LDB(B0, 1, 0); PG8_LDB(B1, 1, 1); PG8_SCHED; PG8_LDA(At, 1, 0); PG8_STAGEA(PG8_SA(0, 1), a2, 1, last);
            PG8_WAIT_V(8); PG8_WAIT_L(0); PG8_BAR; PG8_MMA(0, 0, At, B0); PG8_MMA(0, 1, At, B1); PG8_BAR; PG8_SCHED;
            PG8_LDA(At, 1, 1); PG8_STAGE(PG8_SB(1, 0), b3, voffB); PG8_STAGE(PG8_SB(1, 1), b3 + hstep, voffB); PG8_STAGEA(PG8_SA(1, 0), a3, 0, last);
            PG8_WAIT_V(8); PG8_WAIT_L(0); PG8_BAR; PG8_MMA(1, 0, At, B0); PG8_MMA(1, 1, At, B1); PG8_BAR; PG8_SCHED;
        }
        if constexpr (FP8) asm volatile("s_nop 15\n\ts_nop 15" ::: "memory");
        if (wr == 0) PG8_BAR;
        const bool keep = E(acc, cur, wr, wc, fr, fq);
        if (!has_next) break;
        if (!(TWOPART && keep))
#pragma unroll
        for (int a = 0; a < 2; ++a)
#pragma unroll
            for (int b = 0; b < 2; ++b)
#pragma unroll
                for (int m = 0; m < 4; ++m)
#pragma unroll
                    for (int n = 0; n < 2; ++n) acc[a][b][m][n] = (f32x4){0.f, 0.f, 0.f, 0.f};
        if constexpr (FP8) {
#pragma unroll
        for (int a = 0; a < 2; ++a)
#pragma unroll
            for (int b = 0; b < 2; ++b) asm volatile("s_nop 3" : "+v"(acc[a][b][0][0]), "+v"(acc[a][b][0][1]), "+v"(acc[a][b][1][0]), "+v"(acc[a][b][1][1]), "+v"(acc[a][b][2][0]), "+v"(acc[a][b][2][1]), "+v"(acc[a][b][3][0]), "+v"(acc[a][b][3][1]));
    }
        cur = nxt; cA = nA; cB = nB; ++ui;
        if constexpr (GATHER) {
#pragma unroll
            for (int h = 0; h < 2; ++h)
#pragma unroll
                for (int i = 0; i < 2; ++i) gAc[h][i] = gAn[h][i];
        }
        if (wr == 1) PG8_BAR;
    }
    PG8_WAIT_V(0);
    PG8_BAR;
#undef PG8_SA
#undef PG8_SB
#undef PG8_STAGE
#undef PG8_STAGEA
#undef PG8_LDA
#undef PG8_LDB
#undef PG8_MMA
#undef PG8_CAT
#undef PG8_LD8
#undef PG8_WAIT_V
#undef PG8_WAIT_L
#undef PG8_BAR
#undef PG8_SCHED
}
}
namespace at {
typedef short bf16x8 __attribute__((ext_vector_type(8)));
typedef short s16x4 __attribute__((ext_vector_type(4)));
typedef float f32x16 __attribute__((ext_vector_type(16)));
typedef unsigned u32x4 __attribute__((ext_vector_type(4)));
typedef __attribute__((address_space(3))) const char* lds_cptr;
typedef short v4i16_t __attribute__((ext_vector_type(4)));
constexpr int SLOT = 32768, L_WSF = 4 * SLOT + 2048;
constexpr float C2 = 0.125f * 1.4426950408889634f;
__device__ __forceinline__ int crow(int r, int hi) { return (r & 3) + 8 * (r >> 2) + 4 * hi; }
__device__ __forceinline__ void glds16(const void* gsrc, unsigned lds_dst) { unsigned keep;
    asm volatile("s_mov_b32 %0, m0\n\ts_mov_b32 m0, %2\n\ts_nop 0\n\tglobal_load_lds_dwordx4 %1, off\n\ts_mov_b32 m0, %0" : "=&s"(keep) : "v"(gsrc), "s"(lds_dst) : "memory"); }
typedef float f32x2_t __attribute__((ext_vector_type(2))); typedef __bf16 bf16x2_t __attribute__((ext_vector_type(2)));
__device__ __forceinline__ unsigned cvtpk(float lo, float hi) { f32x2_t v = {lo, hi}; bf16x2_t b = __builtin_convertvector(v, bf16x2_t); return __builtin_bit_cast(unsigned, b); }
__device__ __forceinline__ s16x4 vtr(lds_cptr p) { return __builtin_bit_cast(s16x4, __builtin_amdgcn_ds_read_tr16_b64_v4i16((__attribute__((address_space(3))) v4i16_t*)p)); }
#define AT_WAIT_BAR(N) asm volatile("s_waitcnt vmcnt(" #N ") lgkmcnt(0)\n\ts_barrier" ::: "memory")

__device__ __forceinline__ void attn_unit(__attribute__((address_space(3))) unsigned char* lds, const bf16_t* QR, const bf16_t* KIMG, const bf16_t* VIMG, bf16_t* YA, const float* subln, float lam, const unsigned* KMAX,
                                          int b, int h, int blk, int tid) {
    typedef __attribute__((address_space(3))) float lds_f;
    asm volatile("" : "+v"(tid));
    const int lane = tid & 63, r32 = lane & 31, hi = lane >> 5; const int w = __builtin_amdgcn_readfirstlane(tid >> 6), m = w & 1, rg = w >> 1;
    const int NT = 2 * blk + 2, bh = b * 4 + h;
    const size_t tokb = (size_t)b * 8192;
    const unsigned lds0 = (unsigned)(size_t)lds;
    const bf16_t* ksrc0 = KIMG + ((size_t)bh * 128 * 16 + 2 * w) * 512 + lane * 8;
    const bf16_t* vsrc0 = VIMG + ((size_t)bh * 128 * 16 + 2 * w) * 512 + lane * 8;
#define AT_DMA(t, slotoff) do { const bf16_t* ks_ = ksrc0 + (size_t)(t) * 8192; const bf16_t* vs_ = vsrc0 + (size_t)(t) * 8192; \
        const unsigned kd_ = (unsigned)__builtin_amdgcn_readfirstlane(lds0 + (unsigned)(slotoff) + (unsigned)w * 2048u); \
        glds16(ks_, kd_); glds16(ks_ + 512, kd_ + 1024u); glds16(vs_, kd_ + 16384u); glds16(vs_ + 512, kd_ + 16384u + 1024u); } while (0)
#define AT_QK(P0, P1, slotoff) do { const lds_cptr kp_ = (lds_cptr)(lds + (slotoff)) + (m * 8 + hi) * 1024 + r32 * 16; \
        _Pragma("unroll") for (int d0 = 0; d0 < 4; ++d0) { const bf16x8 k0 = *(const __attribute__((address_space(3))) bf16x8*)(kp_ + d0 * 2048), k1 = *(const __attribute__((address_space(3))) bf16x8*)(kp_ + d0 * 2048 + 512); \
            P0 = __builtin_amdgcn_mfma_f32_32x32x16_bf16(k0, qr[d0], d0 == 0 ? negm : P0, 0, 0, 0); P1 = __builtin_amdgcn_mfma_f32_32x32x16_bf16(k1, qr[d0], d0 == 0 ? negm : P1, 0, 0, 0); } } while (0)
    bf16x8 qr[4];
    { const bf16_t* qp = QR + ((((size_t)(b * 4 + h) * 128 + blk * 2 + (rg >> 1)) * 16 + m * 8 + hi) * 64 + (rg & 1) * 32 + r32) * 8;
#pragma unroll
      for (int d0 = 0; d0 < 4; ++d0) qr[d0] = *(const bf16x8*)(qp + (size_t)d0 * 1024); }
    AT_DMA(0, 0); AT_DMA(1, SLOT); if (NT > 2) AT_DMA(2, 2 * SLOT);
    f32x16 o[4];
#pragma unroll
    for (int i = 0; i < 4; ++i) o[i] = f32x16{};
    float lsum = 0.f; f32x16 negm;
    float mhat;
    { float qs = 0.f;
#pragma unroll
      for (int d0 = 0; d0 < 4; ++d0)
#pragma unroll
          for (int j = 0; j < 8; ++j) { const float qv = __uint_as_float(((unsigned)(unsigned short)qr[d0][j]) << 16); qs += qv * qv; }
      auto rr = __builtin_amdgcn_permlane32_swap(__float_as_uint(qs), __float_as_uint(qs), false, false); qs = __uint_as_float(rr[0]) + __uint_as_float(rr[1]);
      mhat = 1.01f * sqrtf(qs * __uint_as_float(KMAX[bh * 2 + m]));
#pragma unroll
      for (int r = 0; r < 16; ++r) negm[r] = -mhat; }
    lds_f* wsf = (lds_f*)(lds + L_WSF) + w * 32;
    f32x16 pA0, pA1, pB0 = f32x16{}, pB1 = f32x16{};
    if (NT > 2) { AT_WAIT_BAR(8); } else { AT_WAIT_BAR(4); }
    AT_QK(pA0, pA1, 0);
    int s0 = 0, s1 = SLOT, s3 = 3 * SLOT;
    const int vlane = ((lane >> 4) & 1) * 32 + (lane & 3) * 8 + (4 * hi + ((lane & 15) >> 2)) * 64;
#define AT_VLOAD(VF, i) do { _Pragma("unroll") for (int k2 = 0; k2 < 2; ++k2) { const int off_ = ((i) >> 1) * 4096 + (((i) & 1) * 2 + k2) * 1024; const s16x4 lo_ = vtr(vp_ + off_), hi_ = vtr(vp_ + off_ + 512); \
        VF[k2] = (bf16x8){lo_[0], lo_[1], lo_[2], lo_[3], hi_[0], hi_[1], hi_[2], hi_[3]}; } } while (0)
#define AT_PVMMA(VF, i) do { _Pragma("unroll") for (int k2 = 0; k2 < 2; ++k2) o[(i) >> 1] = __builtin_amdgcn_mfma_f32_32x32x16_bf16(pa[k2], VF[k2], o[(i) >> 1], 0, 0, 0); } while (0)
#define AT_SB() __builtin_amdgcn_sched_barrier(0)
#define AT_STEP(PC0, PC1, PN0, PN1, DOQK, DOSM) do { AT_SB(); \
        bf16x8 kf[4]; const lds_cptr kp_ = (lds_cptr)(lds + s1) + (m * 8 + hi) * 1024 + r32 * 16; \
        if (DOQK) { _Pragma("unroll") for (int d0 = 0; d0 < 2; ++d0) { kf[2 * d0] = *(const __attribute__((address_space(3))) bf16x8*)(kp_ + d0 * 2048); kf[2 * d0 + 1] = *(const __attribute__((address_space(3))) bf16x8*)(kp_ + d0 * 2048 + 512); } } \
        const lds_cptr vp_ = (lds_cptr)(lds + s0 + 16384) + vlane; bf16x8 vfa[2], vfb[2]; \
        if (DOSM) AT_VLOAD(vfa, 0); \
        if (DOQK) { \
            PN0 = __builtin_amdgcn_mfma_f32_32x32x16_bf16(kf[0], qr[0], negm, 0, 0, 0); PN1 = __builtin_amdgcn_mfma_f32_32x32x16_bf16(kf[1], qr[0], negm, 0, 0, 0); \
            PN0 = __builtin_amdgcn_mfma_f32_32x32x16_bf16(kf[2], qr[1], PN0, 0, 0, 0); PN1 = __builtin_amdgcn_mfma_f32_32x32x16_bf16(kf[3], qr[1], PN1, 0, 0, 0); \
            _Pragma("unroll") for (int d0 = 0; d0 < 2; ++d0) { kf[2 * d0] = *(const __attribute__((address_space(3))) bf16x8*)(kp_ + (d0 + 2) * 2048); kf[2 * d0 + 1] = *(const __attribute__((address_space(3))) bf16x8*)(kp_ + (d0 + 2) * 2048 + 512); } \
            PN0 = __builtin_amdgcn_mfma_f32_32x32x16_bf16(kf[0], qr[2], PN0, 0, 0, 0); PN1 = __builtin_amdgcn_mfma_f32_32x32x16_bf16(kf[1], qr[2], PN1, 0, 0, 0); \
            PN0 = __builtin_amdgcn_mfma_f32_32x32x16_bf16(kf[2], qr[3], PN0, 0, 0, 0); PN1 = __builtin_amdgcn_mfma_f32_32x32x16_bf16(kf[3], qr[3], PN1, 0, 0, 0); } \
        if (DOSM) { \
            float sacc = 0.f; bf16x8 pa[2]; \
            _Pragma("unroll") for (int r = 0; r < 16; ++r) { PC0[r] = __builtin_amdgcn_exp2f(PC0[r]); sacc += PC0[r]; } \
            pa[0] = __builtin_bit_cast(bf16x8, (u32x4){cvtpk(PC0[0], PC0[1]), cvtpk(PC0[2], PC0[3]), cvtpk(PC0[4], PC0[5]), cvtpk(PC0[6], PC0[7])}); \
            pa[1] = __builtin_bit_cast(bf16x8, (u32x4){cvtpk(PC0[8], PC0[9]), cvtpk(PC0[10], PC0[11]), cvtpk(PC0[12], PC0[13]), cvtpk(PC0[14], PC0[15])}); \
            AT_VLOAD(vfb, 2); AT_PVMMA(vfa, 0); AT_VLOAD(vfa, 4); AT_PVMMA(vfb, 2); AT_VLOAD(vfb, 6); AT_PVMMA(vfa, 4); AT_VLOAD(vfa, 1); AT_PVMMA(vfb, 6); \
            _Pragma("unroll") for (int r = 0; r < 16; ++r) { PC1[r] = __builtin_amdgcn_exp2f(PC1[r]); sacc += PC1[r]; } \
            lsum += sacc; asm volatile("" : "+v"(lsum)); \
            pa[0] = __builtin_bit_cast(bf16x8, (u32x4){cvtpk(PC1[0], PC1[1]), cvtpk(PC1[2], PC1[3]), cvtpk(PC1[4], PC1[5]), cvtpk(PC1[6], PC1[7])}); \
            pa[1] = __builtin_bit_cast(bf16x8, (u32x4){cvtpk(PC1[8], PC1[9]), cvtpk(PC1[10], PC1[11]), cvtpk(PC1[12], PC1[13]), cvtpk(PC1[14], PC1[15])}); \
            AT_VLOAD(vfb, 3); AT_PVMMA(vfa, 1); AT_VLOAD(vfa, 5); AT_PVMMA(vfb, 3); AT_VLOAD(vfb, 7); AT_PVMMA(vfa, 5); AT_PVMMA(vfb, 7); } \
        AT_SB(); \
        s0 = s1; s1 = (s1 == 3 * SLOT) ? 0 : s1 + SLOT; s3 = (s3 == 3 * SLOT) ? 0 : s3 + SLOT; \
    } while (0)
    for (int t = 0; t + 2 < NT; t += 2) {
        AT_WAIT_BAR(4); if (t + 3 < NT) AT_DMA(t + 3, s3);
        AT_STEP(pA0, pA1, pB0, pB1, true, true);
        AT_WAIT_BAR(4); if (t + 4 < NT) AT_DMA(t + 4, s3);
        AT_STEP(pB0, pB1, pA0, pA1, true, true);
    }
    if (rg < 2) {
#pragma unroll
        for (int r = 0; r < 16; ++r) negm[r] = -1e30f; }
    AT_WAIT_BAR(0);
    AT_STEP(pA0, pA1, pB0, pB1, true, true);
    AT_WAIT_BAR(0);
    AT_STEP(pB0, pB1, pA0, pA1, false, true);
    AT_WAIT_BAR(0);
    { auto rr = __builtin_amdgcn_permlane32_swap(__float_as_uint(lsum), __float_as_uint(lsum), false, false); lsum = __uint_as_float(rr[0]) + __uint_as_float(rr[1]); }
    if (hi == 0) wsf[r32] = (m == 0 ? 1.f : -lam) / lsum;
    asm volatile("s_waitcnt lgkmcnt(0)" ::: "memory");
#pragma unroll
    for (int r = 0; r < 16; ++r) { const float fr_ = wsf[crow(r, hi)];
#pragma unroll
        for (int d = 0; d < 4; ++d) o[d][r] *= fr_; }
    AT_WAIT_BAR(0);
    lds_f* X = (lds_f*)lds + rg * 4096;
    if (m == 1) {
#pragma unroll
        for (int d = 0; d < 4; ++d)
#pragma unroll
            for (int r = 0; r < 16; ++r) X[(d * 16 + r) * 64 + lane] = o[d][r];
    }
    AT_WAIT_BAR(0);
    if (m == 0) {
        float ssq[16];
#pragma unroll
        for (int r = 0; r < 16; ++r) { float s = 0.f;
#pragma unroll
            for (int d = 0; d < 4; ++d) { o[d][r] += X[(d * 16 + r) * 64 + lane]; s += o[d][r] * o[d][r]; }
            ssq[r] = s; }
#pragma unroll
        for (int r = 0; r < 16; ++r) { float s = ssq[r];
#pragma unroll
            for (int of = 1; of < 32; of <<= 1) s += __shfl_xor(s, of);
            ssq[r] = rsqrtf(s * (1.f / 128.f) + 1e-6f) * 0.8f; }
        float sw[4];
#pragma unroll
        for (int d = 0; d < 4; ++d) sw[d] = subln[d * 32 + r32];
        bf16_t* yp = YA + (tokb + blk * 128 + rg * 32) * 512 + h * 128 + r32;
#pragma unroll
        for (int r = 0; r < 16; ++r)
#pragma unroll
            for (int d = 0; d < 4; ++d) yp[(size_t)crow(r, hi) * 512 + d * 32] = f2bf(o[d][r] * ssq[r] * sw[d]);
    }
    AT_WAIT_BAR(0);
#undef AT_DMA
#undef AT_QK
#undef AT_STEP
#undef AT_SB
#undef AT_VLOAD
#undef AT_PVMMA
}
}
namespace hg {
using at::bf16x8; using at::s16x4; using at::f32x16; using at::u32x4; using at::lds_cptr; using at::crow; using at::vtr; using at::cvtpk;
typedef __attribute__((address_space(3))) unsigned char lds_u8;
typedef __attribute__((address_space(3))) float lds_f;
typedef __attribute__((address_space(3))) bf16_t lds_h;
__device__ __forceinline__ float sigm(float x) { return __builtin_amdgcn_rcpf(1.f + __expf(-x)); }
__device__ __forceinline__ bf16x8 mkfrag(s16x4 a, s16x4 b) { return (bf16x8){a[0], a[1], a[2], a[3], b[0], b[1], b[2], b[3]}; }
template <int ROWS>
__device__ __forceinline__ void copy_img(lds_u8* lds, int off, const bf16_t* g, size_t gp, int tid) {
#pragma unroll
    for (int i = 0; i < ROWS * 16 / 512; ++i) { const int p = tid + 512 * i, r = p >> 4, q = p & 15;
        const u32x4 v = *(const u32x4*)(g + (size_t)r * gp + q * 8);
        *(__attribute__((address_space(3))) u32x4*)(lds + off + (q >> 2) * (ROWS * 64) + r * 64 + (q & 3) * 16) = v; }
}
__device__ __forceinline__ void copy_raw(lds_u8* lds, int off, const bf16_t* g, size_t gp, int tid) {
#pragma unroll
    for (int i = 0; i < 2; ++i) { const int p = tid + 512 * i, r = p >> 4, q = p & 15;
        const u32x4 v = *(const u32x4*)(g + (size_t)r * gp + q * 8);
        *(__attribute__((address_space(3))) u32x4*)(lds + off + r * 256 + q * 16) = v; }
}
struct ARegs { u32x4 v[2], rf[2]; };
struct CRegs { u32x4 v[2], sp[4], rf[2], rq[2]; };
__device__ __forceinline__ void ld_tile64(u32x4 (&r)[2], const bf16_t* g, size_t gp, int tid) {
#pragma unroll
    for (int i = 0; i < 2; ++i) { const int p = tid + 512 * i; r[i] = *(const u32x4*)(g + (size_t)(p >> 4) * gp + (p & 15) * 8); } }
__device__ __forceinline__ void st_img64(lds_u8* lds, int off, const u32x4 (&r)[2], int tid) {
#pragma unroll
    for (int i = 0; i < 2; ++i) { const int p = tid + 512 * i, rr = p >> 4, q = p & 15; *(__attribute__((address_space(3))) u32x4*)(lds + off + (q >> 2) * 4096 + rr * 64 + (q & 3) * 16) = r[i]; } }
__device__ __forceinline__ void st_raw64(lds_u8* lds, int off, const u32x4 (&r)[2], int tid) {
#pragma unroll
    for (int i = 0; i < 2; ++i) { const int p = tid + 512 * i; *(__attribute__((address_space(3))) u32x4*)(lds + off + (p >> 4) * 256 + (p & 15) * 16) = r[i]; } }
__device__ __forceinline__ void hgA_load(ARegs& R, const bf16_t* PROJ, int bh, int n, int tid) {
    const size_t tok0 = (size_t)(bh >> 2) * 8192 + n * 64; const int h = bh & 3;
    ld_tile64(R.v, PROJ + tok0 * 5632 + 2560 + h * 128, 5632, tid); ld_tile64(R.rf, PROJ + tok0 * 5632 + 2048 + h * 128, 5632, tid); }
__device__ __forceinline__ void hgC_load(CRegs& R, const bf16_t* PROJ, const bf16_t* SP, int bh, int n, int tid) {
    const size_t tok0 = (size_t)(bh >> 2) * 8192 + n * 64; const int h = bh & 3;
    ld_tile64(R.v, PROJ + tok0 * 5632 + 2560 + h * 128, 5632, tid); ld_tile64(R.rf, PROJ + tok0 * 5632 + 2048 + h * 128, 5632, tid); ld_tile64(R.rq, PROJ + tok0 * 5632 + 1536 + h * 128, 5632, tid);
    const bf16_t* sp = SP + (size_t)(bh * 128 + n) * 16384;
#pragma unroll
    for (int i = 0; i < 4; ++i) { const int p = tid + 512 * i; R.sp[i] = *(const u32x4*)(sp + (size_t)(p >> 4) * 128 + (p & 15) * 8); } }
__device__ __forceinline__ void gates(lds_u8* lds, int psum_off, int rawf_off, float lb, int tid, float (&f)[16], float (&G)[16], float& glast) {
    const int d = tid & 127, part = tid >> 7; lds_f* psum = (lds_f*)(lds + psum_off); const lds_h* rf = (const lds_h*)(lds + rawf_off) + part * 16 * 128 + d;
    float g = 0.f;
#pragma unroll
    for (int i = 0; i < 16; ++i) { const float raw = bf2f(rf[i * 128]); f[i] = lb + (1.f - lb) * sigm(raw); g += __logf(f[i]); G[i] = g; }
    psum[part * 128 + d] = g;
    __syncthreads();
    const float p0 = psum[d], p1 = psum[128 + d], p2 = psum[256 + d], p3 = psum[384 + d];
    const float offs = (part > 0 ? p0 : 0.f) + (part > 1 ? p1 : 0.f) + (part > 2 ? p2 : 0.f);
    glast = (p0 + p1) + (p2 + p3);
#pragma unroll
    for (int i = 0; i < 16; ++i) G[i] += offs;
}
constexpr int A_KD = 0, A_V = 16384, A_PS = 32768, A_RAWF = 36864, A_OUT = 53248;
__device__ __forceinline__ void hgA_unit(lds_u8* lds, ARegs& R, const bf16_t* PROJ, const float* SCAL, bf16_t* DS, float* DEC, int bh, int n, int nbh, int nn, int tid) {
    const int h = bh & 3, b = bh >> 2, lane = tid & 63, r32 = lane & 31, hi = lane >> 5, w = __builtin_amdgcn_readfirstlane(tid >> 6), d = tid & 127, part = tid >> 7;
    const size_t tok0 = (size_t)b * 8192 + n * 64;
    __syncthreads();
    st_img64(lds, A_V, R.v, tid); st_raw64(lds, A_RAWF, R.rf, tid);
    if (nbh >= 0) hgA_load(R, PROJ, nbh, nn, tid);
    __syncthreads();
    float f[16], G[16], glast;
    gates(lds, A_PS, A_RAWF, SCAL[64 + h * 128 + d], tid, f, G, glast);
    lds_h* kd = (lds_h*)(lds + A_KD) + (d >> 5) * 2048 + (d & 31);
#pragma unroll
    for (int i = 0; i < 16; ++i) kd[(part * 16 + i) * 32] = f2bf((1.f - f[i]) * __expf(glast - G[i]));
    if (part == 0) DEC[(size_t)(bh * 128 + n) * 128 + d] = __expf(glast);
    __syncthreads();
    const int dt = w >> 1, vh = w & 1;
    const int lof = ((lane >> 4) & 1) * 32 + (lane & 3) * 8 + (8 * hi + ((lane & 15) >> 2)) * 64;
    const lds_cptr ap = (lds_cptr)(lds + A_KD) + dt * 4096 + lof;
    f32x16 acc[2] = {f32x16{}, f32x16{}};
#pragma unroll
    for (int ks = 0; ks < 4; ++ks) { const bf16x8 af = mkfrag(vtr(ap + ks * 1024), vtr(ap + ks * 1024 + 256));
#pragma unroll
        for (int t = 0; t < 2; ++t) { const lds_cptr bp = (lds_cptr)(lds + A_V) + (2 * vh + t) * 4096 + lof;
            const bf16x8 bfr = mkfrag(vtr(bp + ks * 1024), vtr(bp + ks * 1024 + 256));
            acc[t] = __builtin_amdgcn_mfma_f32_32x32x16_bf16(af, bfr, acc[t], 0, 0, 0); } }
    lds_h* ot = (lds_h*)(lds + A_OUT) + (dt * 32) * 128 + vh * 64 + r32;
#pragma unroll
    for (int t = 0; t < 2; ++t)
#pragma unroll
        for (int r = 0; r < 16; ++r) ot[crow(r, hi) * 128 + t * 32] = f2bf(acc[t][r]);
    __syncthreads();
    bf16_t* dst = DS + (size_t)(bh * 128 + n) * 16384;
#pragma unroll
    for (int i = 0; i < 4; ++i) { const int p = tid + 512 * i; *(u32x4*)(dst + p * 8) = *(const __attribute__((address_space(3))) u32x4*)(lds + A_OUT + p * 16); }
}
constexpr int C_QT = 0, C_KT = 16384, C_V = 32768, C_SP = 49152, C_PS = 81920, C_RAWF = 86016, C_RAWQ = 102400, C_OT = 86016;
__device__ __forceinline__ void hgC_unit(lds_u8* lds, CRegs& R, const bf16_t* PROJ, const float* SCAL, const bf16_t* SP, const float* hgnorm, bf16_t* YB, int bh, int n, int nbh, int nn, int tid) {
    const int h = bh & 3, b = bh >> 2, lane = tid & 63, r32 = lane & 31, hi = lane >> 5, w = __builtin_amdgcn_readfirstlane(tid >> 6), d = tid & 127, part = tid >> 7;
    const size_t tok0 = (size_t)b * 8192 + n * 64;
    __syncthreads();
    st_img64(lds, C_V, R.v, tid); st_raw64(lds, C_RAWF, R.rf, tid); st_raw64(lds, C_RAWQ, R.rq, tid);
#pragma unroll
    for (int i = 0; i < 4; ++i) { const int p = tid + 512 * i, rr = p >> 4, q = p & 15; *(__attribute__((address_space(3))) u32x4*)(lds + C_SP + (q >> 2) * 8192 + rr * 64 + (q & 3) * 16) = R.sp[i]; }
    if (nbh >= 0) hgC_load(R, PROJ, SP, nbh, nn, tid);
    __syncthreads();
    { float f[16], G[16], glast;
      gates(lds, C_PS, C_RAWF, SCAL[64 + h * 128 + d], tid, f, G, glast);
      const lds_h* rq = (const lds_h*)(lds + C_RAWQ) + part * 16 * 128 + d;
      lds_h* qt = (lds_h*)(lds + C_QT) + (d >> 3) * 512 + (d & 7) + part * 16 * 8; lds_h* kt = (lds_h*)(lds + C_KT) + (d >> 3) * 512 + (d & 7) + part * 16 * 8;
#pragma unroll
      for (int i = 0; i < 16; ++i) { const float q = bf2f(rq[i * 128]); const float eg = __expf(G[i]);
          qt[i * 8] = f2bf(q * sigm(q) * eg); kt[i * 8] = f2bf((1.f - f[i]) * __builtin_amdgcn_rcpf(eg)); } }
    __syncthreads();
    const int ct = w & 1, vb = w >> 1;
    bf16x8 qf[8];
    { const lds_cptr qp = (lds_cptr)(lds + C_QT) + hi * 1024 + (32 * ct + r32) * 16;
#pragma unroll
      for (int ks = 0; ks < 8; ++ks) qf[ks] = *(const __attribute__((address_space(3))) bf16x8*)(qp + ks * 2048); }
    f32x16 o = f32x16{};
#pragma unroll
    for (int sh = 0; sh < 2; ++sh) { if (sh <= ct) {
        const lds_cptr kp = (lds_cptr)(lds + C_KT) + hi * 1024 + (32 * sh + r32) * 16;
        f32x16 p = f32x16{};
#pragma unroll
        for (int ks = 0; ks < 8; ++ks) { const bf16x8 kf = *(const __attribute__((address_space(3))) bf16x8*)(kp + ks * 2048); p = __builtin_amdgcn_mfma_f32_32x32x16_bf16(kf, qf[ks], p, 0, 0, 0); }
        const int cc = 32 * ct + r32;
#pragma unroll
        for (int r = 0; r < 16; ++r) { const int s = 32 * sh + crow(r, hi); if (s > cc) p[r] = 0.f; }
        const bf16x8 pa0 = __builtin_bit_cast(bf16x8, (u32x4){cvtpk(p[0], p[1]), cvtpk(p[2], p[3]), cvtpk(p[4], p[5]), cvtpk(p[6], p[7])});
        const bf16x8 pa1 = __builtin_bit_cast(bf16x8, (u32x4){cvtpk(p[8], p[9]), cvtpk(p[10], p[11]), cvtpk(p[12], p[13]), cvtpk(p[14], p[15])});
        const lds_cptr vp = (lds_cptr)(lds + C_V) + vb * 4096 + ((lane >> 4) & 1) * 32 + (lane & 3) * 8 + (4 * hi + ((lane & 15) >> 2)) * 64 + sh * 2048;
        o = __builtin_amdgcn_mfma_f32_32x32x16_bf16(pa0, mkfrag(vtr(vp), vtr(vp + 512)), o, 0, 0, 0);
        o = __builtin_amdgcn_mfma_f32_32x32x16_bf16(pa1, mkfrag(vtr(vp + 1024), vtr(vp + 1024 + 512)), o, 0, 0, 0); } }
    { const lds_cptr sp = (lds_cptr)(lds + C_SP) + vb * 8192 + ((lane >> 4) & 1) * 32 + (lane & 3) * 8 + (8 * hi + ((lane & 15) >> 2)) * 64;
#pragma unroll
      for (int ks = 0; ks < 8; ++ks) o = __builtin_amdgcn_mfma_f32_32x32x16_bf16(qf[ks], mkfrag(vtr(sp + ks * 1024), vtr(sp + ks * 1024 + 256)), o, 0, 0, 0); }
    { lds_f* ot = (lds_f*)(lds + C_OT) + (32 * ct) * 128 + 32 * vb + r32;
#pragma unroll
      for (int r = 0; r < 16; ++r) ot[crow(r, hi) * 128] = o[r]; }
    __syncthreads();
    { const int c = tid >> 3, sg = tid & 7; const __attribute__((address_space(3))) at::u32x4* orow = (const __attribute__((address_space(3))) at::u32x4*)(lds + C_OT + c * 512 + sg * 64);
      float ov[16]; float ss = 0.f;
#pragma unroll
      for (int q = 0; q < 4; ++q) { const at::u32x4 t4 = orow[q]; ov[4 * q] = __uint_as_float(t4.x); ov[4 * q + 1] = __uint_as_float(t4.y); ov[4 * q + 2] = __uint_as_float(t4.z); ov[4 * q + 3] = __uint_as_float(t4.w); }
#pragma unroll
      for (int q = 0; q < 16; ++q) ss += ov[q] * ov[q];
      ss += __shfl_xor(ss, 1); ss += __shfl_xor(ss, 2); ss += __shfl_xor(ss, 4);
      const float rstd = rsqrtf(ss * (1.f / 128.f) + 1e-6f);
      const bf16_t* gp = PROJ + (tok0 + c) * 5632 + 3072 + h * 128 + sg * 16; const u32x4 g0 = *(const u32x4*)gp, g1 = *(const u32x4*)(gp + 8);
      const unsigned gw[8] = {g0.x, g0.y, g0.z, g0.w, g1.x, g1.y, g1.z, g1.w}; unsigned ow[8];
#pragma unroll
      for (int q = 0; q < 8; ++q) { const float ga = __uint_as_float(gw[q] << 16), gb = __uint_as_float(gw[q] & 0xffff0000u);
          const float ra = ov[2 * q] * rstd * hgnorm[sg * 16 + 2 * q] * (ga * sigm(ga)), rb = ov[2 * q + 1] * rstd * hgnorm[sg * 16 + 2 * q + 1] * (gb * sigm(gb));
          ow[q] = cvtpk(ra, rb); }
      bf16_t* dst = YB + (tok0 + c) * 512 + h * 128 + sg * 16; *(u32x4*)dst = (u32x4){ow[0], ow[1], ow[2], ow[3]}; *(u32x4*)(dst + 8) = (u32x4){ow[4], ow[5], ow[6], ow[7]}; }
}
}
namespace mk {
using pg8::f32x4; using pg8::u32x4; using pg8::u32x2; using pg8::Unit;
constexpr int NWAVES = 8, NTHR = 512;
constexpr int RING_BYTES = 131072, LDSCTL_OFF = RING_BYTES, LDS_BYTES = 147456;
constexpr int LW_BAR = 0, LW_TPRE = 16  , LW_CNT = 64  , LW_MISC = 128;
enum Phase { PH_PRO = 0, PH_H1, PH_G1, PH_ROPE_HGA, PH_ATT_SCAN, PH_HGC, PH_G2A, PH_G2B, PH_G3, PH_TOK, PH_G4, PH_G5, PH_FIN, PH_N };

struct Args {
    const float* in[25]; float* out; unsigned char* ws; int ph_lo, ph_hi, li, pad;
};

__device__ __forceinline__ float wave_sum(float v) {
#pragma unroll
    for (int o = 1; o < 64; o <<= 1) v += __shfl_xor(v, o);
    return v;
}
__device__ __forceinline__ float sigm(float x) { return __builtin_amdgcn_rcpf(1.f + __expf(-x)); }
__device__ __forceinline__ unsigned pk2(float lo, float hi) { return at::cvtpk(lo, hi); }

__device__ __forceinline__ unsigned pk4_fp8(float a, float b, float c, float d) { unsigned w = __builtin_amdgcn_cvt_pk_fp8_f32(a, b, 0u, false); return __builtin_amdgcn_cvt_pk_fp8_f32(c, d, w, true); }
constexpr float S8_W = 64.f, S8_H = 4.f, S8_A = 4.f, S8_Y = 4.f;
struct EpiBf16 {
    static constexpr bool PERM = true;
    bf16_t* O; int ldc;
    __device__ __forceinline__ bool operator()(f32x4 (&acc)[2][2][4][2], const Unit& u, int wr, int wc, int fr, int fq) const {
        const int row0 = u.pm * 256 + wr * 64 + fr, col0 = u.pn * 256 + wc * 32 + 8 * fq;
#pragma unroll
        for (int ai = 0; ai < 2; ++ai)
#pragma unroll
            for (int m = 0; m < 4; ++m) { bf16_t* rowp = O + (size_t)(row0 + ai * 128 + m * 16) * ldc + col0;
#pragma unroll
                for (int bj = 0; bj < 2; ++bj) { const f32x4 v0 = acc[ai][bj][m][0], v1 = acc[ai][bj][m][1]; u32x4 w; w.x = pk2(v0[0], v0[1]); w.y = pk2(v0[2], v0[3]); w.z = pk2(v1[0], v1[1]); w.w = pk2(v1[2], v1[3]);
                    *(u32x4*)(rowp + bj * 128) = w; } }
        return false;
    }
};
struct EpiF32 {
    static constexpr bool PERM = false;
    float* O; int ldc;
    __device__ __forceinline__ bool operator()(f32x4 (&acc)[2][2][4][2], const Unit& u, int wr, int wc, int fr, int fq) const {
        const int row0 = u.pm * 256 + wr * 64 + fr, col0 = u.pn * 256 + wc * 32 + 4 * fq;
#pragma unroll
        for (int ai = 0; ai < 2; ++ai)
#pragma unroll
            for (int m = 0; m < 4; ++m) { float* rowp = O + (size_t)(row0 + ai * 128 + m * 16) * ldc + col0;
#pragma unroll
                for (int bj = 0; bj < 2; ++bj)
#pragma unroll
                    for (int n = 0; n < 2; ++n) *(f32x4*)(rowp + bj * 128 + n * 16) = acc[ai][bj][m][n]; }
        return false;
    }
};
struct EpiBranch2 {
    static constexpr bool PERM = true;
    const bf16_t* proj; bf16_t* merged;
    __device__ __forceinline__ bool operator()(f32x4 (&acc)[2][2][4][2], const Unit& u, int wr, int wc, int fr, int fq) const {
        const int row0 = u.pm * 256 + wr * 64 + fr, col0 = u.pn * 256 + wc * 32 + 8 * fq; const bool first = (u.z == 0);
#pragma unroll
        for (int ai = 0; ai < 2; ++ai)
#pragma unroll
            for (int m = 0; m < 4; ++m) { const size_t row = (size_t)(row0 + ai * 128 + m * 16);
#pragma unroll
                for (int bj = 0; bj < 2; ++bj) { const int col = col0 + bj * 128;
                    const u32x4 gb = *(const u32x4*)(proj + row * 5632 + 4608 + col); const unsigned gbw[4] = {gb.x, gb.y, gb.z, gb.w}; float eb[8];
#pragma unroll
                    for (int q = 0; q < 4; ++q) { eb[2 * q] = __expf(-__uint_as_float(gbw[q] << 16)); eb[2 * q + 1] = __expf(-__uint_as_float(gbw[q] & 0xffff0000u)); }
                    if (first) { const u32x4 ga = *(const u32x4*)(proj + row * 5632 + 3584 + col); const unsigned gaw[4] = {ga.x, ga.y, ga.z, ga.w};
#pragma unroll
                        for (int q = 0; q < 4; ++q) { const float ea0 = __expf(-__uint_as_float(gaw[q] << 16)), ea1 = __expf(-__uint_as_float(gaw[q] & 0xffff0000u));
                            acc[ai][bj][m][q >> 1][(2 * q) & 3] *= (1.f + eb[2 * q]) * __builtin_amdgcn_rcpf(1.f + ea0); acc[ai][bj][m][q >> 1][(2 * q + 1) & 3] *= (1.f + eb[2 * q + 1]) * __builtin_amdgcn_rcpf(1.f + ea1); } }
                    else { unsigned w[4];
#pragma unroll
                        for (int q = 0; q < 4; ++q) w[q] = pk2(acc[ai][bj][m][q >> 1][(2 * q) & 3] * __builtin_amdgcn_rcpf(1.f + eb[2 * q]), acc[ai][bj][m][q >> 1][(2 * q + 1) & 3] * __builtin_amdgcn_rcpf(1.f + eb[2 * q + 1]));
                        *(u32x4*)(merged + row * 1024 + col) = (u32x4){w[0], w[1], w[2], w[3]}; } } }
        return first;
    }
};
struct EpiGateUp {
    static constexpr bool PERM = true;
    const float* bgu; unsigned char* act;
    __device__ __forceinline__ bool operator()(f32x4 (&acc)[2][2][4][2], const Unit& u, int wr, int wc, int fr, int fq) const {
        const int e = u.z, colA = u.pn * 128 + wc * 32 + 8 * fq;
        constexpr float DQ = 1.f / (S8_W * S8_H);
        f32x4 bg[2], bu[2];
#pragma unroll
        for (int n = 0; n < 2; ++n) { bg[n] = *(const f32x4*)(bgu + e * 2048 + colA + 4 * n); bu[n] = *(const f32x4*)(bgu + e * 2048 + 1024 + colA + 4 * n); }
#pragma unroll
        for (int ai = 0; ai < 2; ++ai)
#pragma unroll
            for (int m = 0; m < 4; ++m) { const size_t slot = (size_t)(u.arow + ai * 128 + wr * 64 + m * 16 + fr); unsigned w[2];
#pragma unroll
                for (int n = 0; n < 2; ++n) { float r[4];
#pragma unroll
                    for (int j = 0; j < 4; ++j) { float gg = acc[ai][0][m][n][j] * DQ + bg[n][j], uu = acc[ai][1][m][n][j] * DQ + bu[n][j]; gg = fminf(gg, 7.f); uu = fminf(fmaxf(uu, -7.f), 7.f); r[j] = (uu + 1.f) * gg * sigm(1.702f * gg) * S8_A; }
                    w[n] = pk4_fp8(r[0], r[1], r[2], r[3]); }
                *(u32x2*)(act + slot * 1024 + colA) = (u32x2){w[0], w[1]}; }
        return false;
    }
};
struct EpiDown {
    static constexpr bool PERM = true;
    const float* bd; const int* list; unsigned char* ym; const LAS int* cnt;
    __device__ __forceinline__ bool operator()(f32x4 (&acc)[2][2][4][2], const Unit& u, int wr, int wc, int fr, int fq) const {
        const int e = u.z, nvalid = cnt[e] - u.pm * 256, col0 = u.pn * 256 + wc * 32 + 8 * fq;
        constexpr float DQ = S8_Y / (S8_W * S8_A);
        f32x4 bv[2][2];
#pragma unroll
        for (int bj = 0; bj < 2; ++bj)
#pragma unroll
            for (int n = 0; n < 2; ++n) bv[bj][n] = *(const f32x4*)(bd + e * 1024 + col0 + bj * 128 + 4 * n) * S8_Y;
#pragma unroll
        for (int ai = 0; ai < 2; ++ai)
#pragma unroll
            for (int m = 0; m < 4; ++m) { const int r = ai * 128 + wr * 64 + m * 16 + fr;
                if (r < nvalid) { const int a = list[(size_t)e * 32768 + u.pm * 256 + r]; unsigned char* rowp = ym + (size_t)a * 1024 + col0;
#pragma unroll
                    for (int bj = 0; bj < 2; ++bj) { const f32x4 v0 = acc[ai][bj][m][0] * DQ + bv[bj][0], v1 = acc[ai][bj][m][1] * DQ + bv[bj][1];
                        *(u32x2*)(rowp + bj * 128) = (u32x2){pk4_fp8(v0[0], v0[1], v0[2], v0[3]), pk4_fp8(v1[0], v1[1], v1[2], v1[3])}; } } }
        return false;
    }
};
struct MoeOrder {
    const LAS int* tpre; const LAS int* cnt; const int* list; int nN, G, c, rowpitch  , brows  ; LAS int* idxbuf  ;
    __device__ bool next(int i, Unit& u) const {
        const int nwg = tpre[32] * nN; const long L = (long)i * G + c; if (L >= nwg) return false;
        int wgid = (int)L; { const int q = nwg / 8, r = nwg % 8, xcd = wgid % 8, off = wgid / 8; wgid = (xcd < r ? xcd * (q + 1) : r * (q + 1) + (xcd - r) * q) + off; }
        int e = 0;
#pragma unroll 1
        for (int s = 16; s > 0; s >>= 1) { if (tpre[e + s] * nN <= wgid) e += s; }
        const int w = wgid - tpre[e] * nN, nM = tpre[e + 1] - tpre[e];
        const int nig = 8 * nN, gid = w / nig, fm = gid * 8, gsz = (nM - fm) < 8 ? (nM - fm) : 8;
        u.pm = fm + ((w % nig) % gsz); u.pn = (w % nig) / gsz; u.z = e; u.arow = (tpre[e] + u.pm) * 256; u.brow = e * brows + u.pn * 256; return true;
    }
    __device__ __forceinline__ unsigned row_off(const Unit& u, int r) const {
        const int lr = u.pm * 256 + r; const int a = list[(size_t)u.z * 32768 + (lr < cnt[u.z] ? lr : 0)]; return (unsigned)(a >> 2) * (unsigned)rowpitch;
    }
    __device__ __forceinline__ const int* idx_src(const Unit& u) const { return list + (size_t)u.z * 32768 + u.pm * 256; }
    __device__ __forceinline__ unsigned off_from_idx(int a) const { unsigned tk = (unsigned)a >> 2; tk = tk < (unsigned)T ? tk : (unsigned)(T - 1); return tk * (unsigned)rowpitch; }
};

__device__ __forceinline__ void transpose_item(const float* W, int K, int N, bf16_t* WT, int k0, int n0, int dst_row0, LAS unsigned* scr, int lane) {
    const int cg = lane & 15, rp = lane >> 4;
    const float* src = W + (size_t)(k0 + 2 * rp) * N + n0 + 4 * cg;
#pragma unroll
    for (int q = 0; q < 8; ++q) { const f32x4 a = __builtin_nontemporal_load((const f32x4*)(src + (size_t)(8 * q) * N)), b = __builtin_nontemporal_load((const f32x4*)(src + (size_t)(8 * q + 1) * N));
#pragma unroll
        for (int c = 0; c < 4; ++c) scr[(4 * cg + c) * 33 + 4 * q + rp] = pk2(a[c], b[c]); }
    asm volatile("s_waitcnt lgkmcnt(0)" ::: "memory");
    const int nl = lane >> 3, wq = lane & 7;
#pragma unroll
    for (int i = 0; i < 8; ++i) { const LAS unsigned* s = scr + (8 * i + nl) * 33 + 4 * wq; u32x4 o; o.x = s[0]; o.y = s[1]; o.z = s[2]; o.w = s[3];
        *(u32x4*)(WT + (size_t)(dst_row0 + 8 * i + nl) * K + k0 + 8 * wq) = o; }
    asm volatile("s_waitcnt lgkmcnt(0)" ::: "memory");
}
__device__ __forceinline__ void transpose_item8(const float* W, int K, int N, unsigned char* WT, int k0, int n0, int dst_row0, LAS unsigned* scr, int lane) {
    const int cg = lane & 15, rp = lane >> 4;
    const float* src = W + (size_t)(k0 + 4 * rp) * N + n0 + 4 * cg;
#pragma unroll
    for (int q = 0; q < 4; ++q) { f32x4 a[4];
#pragma unroll
        for (int r = 0; r < 4; ++r) a[r] = __builtin_nontemporal_load((const f32x4*)(src + (size_t)(16 * q + r) * N));
#pragma unroll
        for (int c = 0; c < 4; ++c) scr[(4 * cg + c) * 17 + 4 * q + rp] = pk4_fp8(a[0][c] * S8_W, a[1][c] * S8_W, a[2][c] * S8_W, a[3][c] * S8_W); }
    asm volatile("s_waitcnt lgkmcnt(0)" ::: "memory");
    const int nl = lane >> 2, wq = lane & 3;
#pragma unroll
    for (int i = 0; i < 4; ++i) { const LAS unsigned* s = scr + (16 * i + nl) * 17 + 4 * wq; u32x4 o; o.x = s[0]; o.y = s[1]; o.z = s[2]; o.w = s[3];
        *(u32x4*)(WT + (size_t)(dst_row0 + 16 * i + nl) * K + k0 + 16 * wq) = o; }
    asm volatile("s_waitcnt lgkmcnt(0)" ::: "memory");
}
template <bool GU>
__device__ __forceinline__ void transpose_matrix8(const float* W, int K, int N, unsigned char* WT, LAS unsigned* scr, int lane, int gw, int NGW, int& itbase) {
    const int nblk = N / 64, nitems = (K / 64) * nblk;
    int first = (gw - itbase) % NGW; if (first < 0) first += NGW;
    for (int it = first; it < nitems; it += NGW) { const int kb = it / nblk, nb = it % nblk, n0 = nb * 64;
        int dst = n0; if (GU) { const int nn = n0 & 1023; dst = (nn >> 7) * 256 + (n0 >> 10) * 128 + (nn & 127); }
        transpose_item8(W, K, N, WT, kb * 64, n0, dst, scr, lane); }
    itbase += nitems;
}
template <bool GU>
__device__ __forceinline__ void transpose_matrix(const float* W, int K, int N, bf16_t* WT, LAS unsigned* scr, int lane, int gw, int NGW, int& itbase) {
    const int nblk = N / 64, nitems = (K / 64) * nblk;
    int first = (gw - itbase) % NGW; if (first < 0) first += NGW;
    for (int it = first; it < nitems; it += NGW) { const int kb = it / nblk, nb = it % nblk, n0 = nb * 64;
        int dst = n0; if (GU) { const int nn = n0 & 1023; dst = (nn >> 7) * 256 + (n0 >> 10) * 128 + (nn & 127); }
        transpose_item(W, K, N, WT, kb * 64, n0, dst, scr, lane); }
    itbase += nitems;
}

#define MOD ((float*)(ws + WS_SMALL))
#define SCAL ((float*)(ws + WS_SMALL + 128 * 1024))
#define ROPEC ((float*)(ws + WS_ROPEC))
#define ROPES ((float*)(ws + WS_ROPES))
#define TOPI ((int*)(ws + WS_TOPI))
#define TOPW ((float*)(ws + WS_TOPW))
#define LIST ((int*)(ws + WS_LIST))
#define RWT ((bf16_t*)(ws + WS_RWT))
#define CNT ((int*)(ws + WS_CTL) + CW_CNT)
#define H ((bf16_t*)(ws + WS_H))
#define QR ((bf16_t*)(ws + WS_H))
#define KIMG ((bf16_t*)(ws + WS_H + 32 * MiB))
#define VIMG ((bf16_t*)(ws + WS_YB))
#define PROJ ((bf16_t*)(ws + WS_PROJ))
#define YA ((bf16_t*)(ws + WS_YA))
#define YB ((bf16_t*)(ws + WS_YB))
#define DS ((bf16_t*)(ws + WS_DS))
#define DEC ((float*)(ws + WS_DEC))
#define MERGED ((bf16_t*)(ws + WS_MERGED))
#define SP ((bf16_t*)(ws + WS_MERGED))
#define Y ((float*)(ws + WS_Y))
#define YH ((bf16_t*)(ws + WS_Y))
#define ACT ((bf16_t*)(ws + WS_ACT))
#define YM ((bf16_t*)(ws + WS_YM))
#define WT_IN ((bf16_t*)(ws + WS_WIN))
#define WT_A ((bf16_t*)(ws + WS_WA))
#define WT_B ((bf16_t*)(ws + WS_WB))
#define WT_O ((bf16_t*)(ws + WS_WO))
#define WT_GU ((bf16_t*)(ws + WS_WGU))
#define WT_GU8 ((unsigned char*)(ws + WS_WGU))
#define WT_D8 ((unsigned char*)(ws + WS_WD))
#define H8 ((unsigned char*)(ws + WS_H))
#define ACT8 ((unsigned char*)(ws + WS_ACT))
#define YM8 ((unsigned char*)(ws + WS_YM))
#define WT_D ((bf16_t*)(ws + WS_WD))
#define PHASE_BEGIN unsigned char* ws = args.ws; asm volatile("" : "+s"(ws)); int tid = threadIdx.x; asm volatile("" : "+v"(tid)); const int lane = tid & 63; (void)lane; const float* x = args.in[0]; float* out = args.out; (void)x; (void)out;
__global__ void __launch_bounds__(NTHR, 2) mega(Args args) {
    extern __shared__ __attribute__((aligned(16))) unsigned char lds_[];
    LAS unsigned char* lds = (LAS unsigned char*)lds_;
    volatile LAS unsigned* LW = (volatile LAS unsigned*)(lds + LDSCTL_OFF);
    const int tid = threadIdx.x, lane = tid & 63, wave = __builtin_amdgcn_readfirstlane(tid >> 6);
    const int G = gridDim.x; const int bx = blockIdx.x; const int vcu = (G % 8 == 0) ? (bx % 8) * (G / 8) + bx / 8 : bx;
    const int gw = vcu * NWAVES + wave, NGW = G * NWAVES;
    unsigned* CTL = (unsigned*)(args.ws + WS_CTL);
    for (int u = tid; u < (LDS_BYTES - LDSCTL_OFF) / 4; u += NTHR) ((LAS unsigned*)(lds + LDSCTL_OFF))[u] = 0u;
    __syncthreads();
    const int lo = args.ph_lo, hi = args.ph_hi;
    XcdBarrier bar; bar.bar = CTL + CW_BAR + args.li * 4096; bar.x = 0; bar.st = nullptr;
    if (hi - lo > 1) bar = xcd_barrier_post(CTL + CW_BAR + args.li * 4096, LW + LW_BAR);
#ifndef PHMASK
#define PHMASK 0xffff
#endif
#ifndef DUP_PHASE
#define DUP_PHASE -1
#endif
#define IN(k) ((((PHMASK) >> (k)) & 1) && lo <= (k) && (k) < hi)
#define REPS(k) (((k) == DUP_PHASE) ? 2 : 1)
#ifdef PROBE_SPAN
#define STAMP(k) do { if (bx == 0 && threadIdx.x == 0) { const unsigned long long t_ = __builtin_amdgcn_s_memrealtime(); LW[160 + 2 * (k)] = (unsigned)t_; LW[161 + 2 * (k)] = (unsigned)(t_ >> 32); } } while (0)
#else
#define STAMP(k) do { } while (0)
#endif
#define SEAM(k) do { if (IN(k) && IN((k) + 1)) xcd_barrier(bar); STAMP((k) + 1); } while (0)

    STAMP(0);
    if (IN(PH_PRO)) for (int rep_ = 0; rep_ < REPS(PH_PRO); ++rep_) {
        PHASE_BEGIN
        __syncthreads();
        const float* c = args.in[1]; const float* w_mod = args.in[2]; const float* b_mod = args.in[3];
        LAS float* cact = (LAS float*)lds; LAS float* red = cact + 4096;
        for (int i = tid; i < 4096; i += NTHR) { const float cv = c[i]; cact[i] = cv / (1.f + expf(-cv)); }
        __syncthreads();
        for (int it = vcu; it < 192; it += G) { const int j0 = it * 32, kq = tid >> 5, col = tid & 31; float acc[4] = {0.f, 0.f, 0.f, 0.f};
            const float* wp = w_mod + (size_t)(kq * 64) * 6144 + j0 + col;
#pragma unroll 1
            for (int k = 0; k < 64; k += 16) { float wv[16];
#pragma unroll
                for (int i = 0; i < 16; ++i) wv[i] = wp[(size_t)(k + i) * 6144];
#pragma unroll
                for (int i = 0; i < 16; ++i) {
#pragma unroll
                    for (int b = 0; b < 4; ++b) acc[b] += cact[b * 1024 + kq * 64 + k + i] * wv[i]; } }
#pragma unroll
            for (int b = 0; b < 4; ++b) red[(kq * 4 + b) * 32 + col] = acc[b];
            __syncthreads();
            if (tid < 128) { const int b = tid >> 5, cc = tid & 31; float s = 0.f;
#pragma unroll
                for (int q = 0; q < 16; ++q) s += red[(q * 4 + b) * 32 + cc];
                MOD[b * 6144 + j0 + cc] = s + b_mod[j0 + cc]; }
            __syncthreads(); }
        const int gt = vcu * NTHR + tid, NGT = G * NTHR;
        if (gt == 0) { const float* q1 = args.in[7]; const float* k1 = args.in[8]; const float* q2 = args.in[9]; const float* k2 = args.in[10]; float s1 = 0.f, s2 = 0.f;
            for (int i = 0; i < 64; ++i) { s1 += q1[i] * k1[i]; s2 += q2[i] * k2[i]; } SCAL[0] = expf(s1) - expf(s2) + 0.2f; }
        if (gt < 512) { const float* lbl = args.in[12]; SCAL[64 + gt] = 1.f / (1.f + expf(lbl[512 + gt] - lbl[gt])); }
        for (int i = gt; i < 8192 * 32; i += NGT) { const int s = i >> 5, j = i & 31; const float inv = powf(10000.f, -(float)(2 * j) / 64.f); const float ang = (float)s * inv; ROPEC[i] = cosf(ang); ROPES[i] = sinf(ang); }
        for (int i = gt; i < 32768; i += NGT) { const int e = i >> 10, k = i & 1023; const float wv = args.in[19][k * 32 + e]; const bf16_t hb = f2bf(wv); RWT[i] = hb; RWT[32768 + i] = f2bf(wv - bf2f(hb)); }
        LAS unsigned* scr = (LAS unsigned*)(lds + wave * 16384); int itbase = 0;
        transpose_matrix<false>(args.in[6], 1024, 5632, WT_IN, scr, lane, gw, NGW, itbase);
        transpose_matrix<false>(args.in[14], 512, 1024, WT_A, scr, lane, gw, NGW, itbase);
        transpose_matrix<false>(args.in[15], 512, 1024, WT_B, scr, lane, gw, NGW, itbase);
        transpose_matrix<false>(args.in[16], 1024, 1024, WT_O, scr, lane, gw, NGW, itbase);
        for (int e = 0; e < 32; ++e) transpose_matrix8<true>(args.in[21] + (size_t)e * 1024 * 2048, 1024, 2048, WT_GU8 + (size_t)e * 2048 * 1024, scr, lane, gw, NGW, itbase);
        for (int e = 0; e < 32; ++e) transpose_matrix8<false>(args.in[23] + (size_t)e * 1024 * 1024, 1024, 1024, WT_D8 + (size_t)e * 1024 * 1024, scr, lane, gw, NGW, itbase);
    }
    SEAM(PH_PRO);
#ifdef EXTRA_BARRIERS
    for (int eb = 0; eb < EXTRA_BARRIERS; ++eb) xcd_barrier(bar);
#endif
    if (IN(PH_H1)) for (int rep_ = 0; rep_ < REPS(PH_H1); ++rep_) {
        PHASE_BEGIN
        const float* w = args.in[4];
        { constexpr int NR_ = 4;
        for (int row0 = gw; row0 < T; row0 += NR_ * NGW) { f32x4 v[NR_][4]; float ss[NR_]; int rows[NR_];
#pragma unroll
            for (int q = 0; q < NR_; ++q) { rows[q] = (row0 + q * NGW < T) ? row0 + q * NGW : row0; const f32x4* xr = (const f32x4*)(x + (size_t)rows[q] * 1024) + lane; ss[q] = 0.f;
#pragma unroll
                for (int j = 0; j < 4; ++j) v[q][j] = xr[64 * j]; }
#pragma unroll
            for (int q = 0; q < NR_; ++q) {
#pragma unroll
                for (int j = 0; j < 4; ++j) ss[q] += (v[q][j][0] * v[q][j][0] + v[q][j][1] * v[q][j][1]) + (v[q][j][2] * v[q][j][2] + v[q][j][3] * v[q][j][3]);
                ss[q] = rsqrtf(wave_sum(ss[q]) * (1.f / 1024.f) + 1e-6f); }
#pragma unroll
            for (int j = 0; j < 4; ++j) { const int col = 4 * lane + 256 * j; const f32x4 wv = *(const f32x4*)(w + col);
#pragma unroll
                for (int q = 0; q < NR_; ++q) { const int b = rows[q] >> 13; const f32x4 sc = *(const f32x4*)(MOD + b * 6144 + 1024 + col), sh = *(const f32x4*)(MOD + b * 6144 + col);
                    const f32x4 h = v[q][j] * ss[q] * wv * (sc + 1.f) + sh; u32x2 o; o.x = pk2(h[0], h[1]); o.y = pk2(h[2], h[3]); *(u32x2*)(H + (size_t)rows[q] * 1024 + col) = o; } } } }
    }
    SEAM(PH_H1);
    if (IN(PH_G1)) for (int rep_ = 0; rep_ < REPS(PH_G1); ++rep_) {
        PHASE_BEGIN
        pg8::Gemm g{H, WT_IN, 1024, nullptr, nullptr}; pg8::DenseOrder S; S.init(T, NC, G, bx);
        EpiBf16 E{PROJ, NC};
        pg8::gemm_phase<EpiBf16, pg8::DenseOrder, false>(lds, g, S, E);
    }
    SEAM(PH_G1);
    if (IN(PH_ROPE_HGA)) for (int rep_ = 0; rep_ < REPS(PH_ROPE_HGA); ++rep_) {
        PHASE_BEGIN
        LAS unsigned* kmx = (LAS unsigned*)(lds + 120 * 1024);
        if (tid < 32) kmx[tid] = 0u;
        __syncthreads();
        for (int item = gw; item < 2048; item += NGW) { const int hh = item & 3, tile = (item >> 2) & 127, b = item >> 9, s = tile * 64 + lane, bh = b * 4 + hh; const size_t row = (size_t)b * 8192 + s;
            f32x4 cs[8], sn[8];
#pragma unroll
            for (int i = 0; i < 8; ++i) { cs[i] = *(const f32x4*)(ROPEC + s * 32 + 4 * i); sn[i] = *(const f32x4*)(ROPES + s * 32 + 4 * i); }
            u32x4 inall[4][8];
#pragma unroll
            for (int part = 0; part < 4; ++part) { const bf16_t* src = PROJ + row * 5632 + (part >> 1) * 512 + hh * 128 + (part & 1) * 64;
#pragma unroll
                for (int i = 0; i < 8; ++i) inall[part][i] = *(const u32x4*)(src + 8 * i); }
#pragma unroll
            for (int part = 0; part < 4; ++part) { const int isk = part >> 1, m = part & 1;
                const u32x4 (&in)[8] = inall[part];
                const float sc = isk ? 1.f : at::C2; u32x4 o[8]; float ss = 0.f;
#pragma unroll
                for (int i = 0; i < 4; ++i) {
                    const unsigned a_[4] = {in[i].x, in[i].y, in[i].z, in[i].w}, b_[4] = {in[i + 4].x, in[i + 4].y, in[i + 4].z, in[i + 4].w}; unsigned w1[4], w2[4];
#pragma unroll
                    for (int q = 0; q < 4; ++q) { const float x1l = __uint_as_float(a_[q] << 16), x1h = __uint_as_float(a_[q] & 0xffff0000u), x2l = __uint_as_float(b_[q] << 16), x2h = __uint_as_float(b_[q] & 0xffff0000u);
                        const int d = 2 * q; const float cl = cs[2 * i + (d >> 2)][d & 3], ch = cs[2 * i + ((d + 1) >> 2)][(d + 1) & 3], sl = sn[2 * i + (d >> 2)][d & 3], sh_ = sn[2 * i + ((d + 1) >> 2)][(d + 1) & 3];
                        const float o1l = (x1l * cl - x2l * sl) * sc, o1h = (x1h * ch - x2h * sh_) * sc, o2l = (x2l * cl + x1l * sl) * sc, o2h = (x2h * ch + x1h * sh_) * sc;
                        ss += (o1l * o1l + o1h * o1h) + (o2l * o2l + o2h * o2h); w1[q] = pk2(o1l, o1h); w2[q] = pk2(o2l, o2h); }
                    o[i] = (u32x4){w1[0], w1[1], w1[2], w1[3]}; o[i + 4] = (u32x4){w2[0], w2[1], w2[2], w2[3]}; }
                if (!isk) { bf16_t* dst = QR + ((((size_t)bh * 128 + tile) * 16 + m * 8) * 64 + lane) * 8;
#pragma unroll
                    for (int i = 0; i < 8; ++i) *(u32x4*)(dst + (size_t)i * 512) = o[i]; }
                else { bf16_t* dst = KIMG + ((((size_t)bh * 128 + tile) * 16 + m * 8) * 64 + lane) * 8;
#pragma unroll
                    for (int i = 0; i < 8; ++i) *(u32x4*)(dst + (size_t)i * 512) = o[i];
                    float mx = ss;
#pragma unroll
                    for (int of = 1; of < 64; of <<= 1) mx = fmaxf(mx, __shfl_xor(mx, of));
                    if (lane == 0) __hip_atomic_fetch_max(kmx + b * 8 + hh * 2 + m, __float_as_uint(mx), __ATOMIC_RELAXED, __HIP_MEMORY_SCOPE_WORKGROUP); } }
            { const bf16_t* src = PROJ + row * 5632 + 1024 + hh * 128; u32x4 vin[16];
#pragma unroll
              for (int i = 0; i < 16; ++i) vin[i] = *(const u32x4*)(src + 8 * i);
#pragma unroll
              for (int i = 0; i < 16; ++i) *(u32x4*)(VIMG + ((((size_t)bh * 128 + tile) * 4 + (i >> 2)) * 64 + lane) * 32 + (i & 3) * 8) = vin[i]; } }
        __syncthreads();
        if (tid < 32) atomicMax((unsigned*)(ws + WS_CTL) + CW_KMAX + tid, kmx[tid]);
        STAMP(14);
        { hg::ARegs R; if (vcu < 2048) hg::hgA_load(R, PROJ, vcu >> 7, vcu & 127, tid);
          for (int it = vcu; it < 2048; it += G) { const int nx = it + G; hg::hgA_unit(lds, R, PROJ, SCAL, DS, DEC, it >> 7, it & 127, nx < 2048 ? (nx >> 7) : -1, nx & 127, tid); } }
        __syncthreads();
    }
    SEAM(PH_ROPE_HGA);
    if (IN(PH_ATT_SCAN)) for (int rep_ = 0; rep_ < REPS(PH_ATT_SCAN); ++rep_) {
        PHASE_BEGIN
        for (int gid = vcu * NTHR + tid; gid < 16 * 128 * 128; gid += G * NTHR) { const int bh = gid >> 14, d = (gid >> 7) & 127, v = gid & 127; float st = 0.f;
            const bf16_t* __restrict__ src = DS + ((size_t)(bh * 128) * 128 + d) * 128 + v; bf16_t* __restrict__ dst = SP + ((size_t)(bh * 128) * 128 + d) * 128 + v; const float* __restrict__ dc = DEC + (size_t)(bh * 128) * 128 + d;
            for (int n0 = 0; n0 < 128; n0 += 16) { float xv[16], dv[16];
#pragma unroll
                for (int i = 0; i < 16; ++i) { xv[i] = bf2f(src[(size_t)(n0 + i) * 16384]); dv[i] = dc[(n0 + i) * 128]; }
#pragma unroll
                for (int i = 0; i < 16; ++i) { dst[(size_t)(n0 + i) * 16384] = f2bf(st); st = dv[i] * st + xv[i]; } } }
        { const float lam = SCAL[0]; const float* subln = args.in[11];
          for (int it = vcu; it < 1024; it += G) { int bh, blk;
              if (G == 256) { const int i = it >> 8, v = it & 255, s = v & 15; bh = v >> 4; blk = (i == 0) ? 63 - s : (i == 1) ? 32 + s : (i == 2) ? 31 - s : s; }
              else { blk = 63 - (it >> 4); bh = it & 15; }
              at::attn_unit(lds, QR, KIMG, VIMG, YA, subln, lam, (const unsigned*)(ws + WS_CTL) + CW_KMAX, bh >> 2, bh & 3, blk, tid); } }
    }
    SEAM(PH_ATT_SCAN);
    if (IN(PH_HGC)) for (int rep_ = 0; rep_ < REPS(PH_HGC); ++rep_) {
        PHASE_BEGIN
        const float* hgnorm = args.in[13];
        { hg::CRegs R; if (vcu < 2048) hg::hgC_load(R, PROJ, SP, vcu >> 7, vcu & 127, tid);
          for (int it = vcu; it < 2048; it += G) { const int nx = it + G; hg::hgC_unit(lds, R, PROJ, SCAL, SP, hgnorm, YB, it >> 7, it & 127, nx < 2048 ? (nx >> 7) : -1, nx & 127, tid); } }
        __syncthreads();
    }
    SEAM(PH_HGC);
    if (IN(PH_G2A)) for (int rep_ = 0; rep_ < REPS(PH_G2A); ++rep_) {
        PHASE_BEGIN
        pg8::Gemm g{YA, WT_A, 512, YB, WT_B}; pg8::DenseOrder2 S; S.base.init(T, 1024, G, bx);
        EpiBranch2 E{PROJ, MERGED};
        pg8::gemm_phase<EpiBranch2, pg8::DenseOrder2, false, true>(lds, g, S, E);
    }
    SEAM(PH_G2B);
    if (IN(PH_G3)) for (int rep_ = 0; rep_ < REPS(PH_G3); ++rep_) {
        PHASE_BEGIN
        pg8::Gemm g{MERGED, WT_O, 1024, nullptr, nullptr}; pg8::DenseOrder S; S.init(T, 1024, G, bx);
        EpiBf16 E{YH, 1024};
        pg8::gemm_phase<EpiBf16, pg8::DenseOrder, false>(lds, g, S, E);
    }
    SEAM(PH_G3);
    if (IN(PH_TOK)) for (int rep_ = 0; rep_ < REPS(PH_TOK); ++rep_) {
        PHASE_BEGIN
        const float* wpm = args.in[5]; const float* wpf = args.in[17]; const float* rb = args.in[20];
        const int wv_ = __builtin_amdgcn_readfirstlane(tid >> 6), r32 = lane & 31, hi = lane >> 5;
        LAS int* lcnt = (LAS int*)lds; LAS int* lbase = lcnt + 32; LAS int* asg = lcnt + 64;
        LAS float* rstd2 = (LAS float*)(lds + 4096);
        LAS float* XC = (LAS float*)(lds + 8192);
        LAS float* LG = (LAS float*)(lds + 24576);
        LAS float* CM = (LAS float*)(lds + 41984); LAS float* SHV = CM + 1024;
        for (int chunk = vcu; chunk < T / 128; chunk += G) { const int b = chunk >> 6;
            __syncthreads();
            if (tid < 32) lcnt[tid] = 0;
            for (int i = tid; i < 1024; i += NTHR) { CM[i] = wpf[i] * (1.f + MOD[b * 6144 + 4096 + i]); SHV[i] = MOD[b * 6144 + 3072 + i]; }
            __syncthreads();
            { constexpr int NR_ = 4; for (int i = 0; i < 16; i += NR_) { const int rloc = wv_ * 16 + i, row = chunk * 128 + rloc;
                f32x4 v[NR_][4], xv[NR_][4]; float ss[NR_], rs[NR_];
#pragma unroll
                for (int q = 0; q < NR_; ++q) ss[q] = 0.f;
#pragma unroll
                for (int q = 0; q < NR_; ++q) { const u32x2* yr = (const u32x2*)(YH + (size_t)(row + q) * 1024) + lane; const f32x4* xr = (const f32x4*)(x + (size_t)(row + q) * 1024) + lane;
#pragma unroll
                    for (int j = 0; j < 4; ++j) { const u32x2 yw = yr[64 * j]; v[q][j] = (f32x4){__uint_as_float(yw.x << 16), __uint_as_float(yw.x & 0xffff0000u), __uint_as_float(yw.y << 16), __uint_as_float(yw.y & 0xffff0000u)}; xv[q][j] = xr[64 * j]; } }
#pragma unroll
                for (int q = 0; q < NR_; ++q)
#pragma unroll
                    for (int j = 0; j < 4; ++j) ss[q] += (v[q][j][0] * v[q][j][0] + v[q][j][1] * v[q][j][1]) + (v[q][j][2] * v[q][j][2] + v[q][j][3] * v[q][j][3]);
                #pragma unroll
                for (int q = 0; q < NR_; ++q) { rs[q] = rsqrtf(wave_sum(ss[q]) * (1.f / 1024.f) + 1e-6f); ss[q] = 0.f; }
#pragma unroll
                for (int j = 0; j < 4; ++j) { const int col = 4 * lane + 256 * j; const f32x4 g1 = *(const f32x4*)(MOD + b * 6144 + 2048 + col), wv = *(const f32x4*)(wpm + col);
#pragma unroll
                    for (int q = 0; q < NR_; ++q) { v[q][j] = xv[q][j] + g1 * v[q][j] * rs[q] * wv; *(f32x4*)(out + (size_t)(row + q) * 1024 + col) = v[q][j];
                        ss[q] += (v[q][j][0] * v[q][j][0] + v[q][j][1] * v[q][j][1]) + (v[q][j][2] * v[q][j][2] + v[q][j][3] * v[q][j][3]); } }
                #pragma unroll
                for (int q = 0; q < NR_; ++q) { rs[q] = rsqrtf(wave_sum(ss[q]) * (1.f / 1024.f) + 1e-6f); if (lane == 0) rstd2[rloc + q] = rs[q]; }
#pragma unroll
                for (int j = 0; j < 4; ++j) { const int col = 4 * lane + 256 * j; const f32x4 cm = *(const LAS f32x4*)(CM + col), sh = *(const LAS f32x4*)(SHV + col);
#pragma unroll
                    for (int q = 0; q < NR_; ++q) { const f32x4 h = (v[q][j] * rs[q] * cm + sh) * S8_H; *(unsigned*)(H8 + (size_t)(row + q) * 1024 + col) = pk4_fp8(h[0], h[1], h[2], h[3]); } } } }
            asm volatile("s_waitcnt vmcnt(0)" ::: "memory");
            __syncthreads();
            { const int rt = wv_ & 3, kh = wv_ >> 2; const int rloc = 32 * rt + r32; const float rs = rstd2[rloc];
              const float* xrow = out + (size_t)(chunk * 128 + rloc) * 1024 + 512 * kh + 8 * hi; const bf16_t* whi = RWT + (size_t)r32 * 1024 + 512 * kh + 8 * hi; const bf16_t* wlo = whi + 32768;
              const LAS float* cmp = CM + 512 * kh + 8 * hi; const LAS float* shp = SHV + 512 * kh + 8 * hi;
              at::f32x16 acc = at::f32x16{};
#pragma unroll 4
              for (int ks = 0; ks < 32; ++ks) { const f32x4 xa = __builtin_nontemporal_load((const f32x4*)(xrow + 16 * ks)), xb = __builtin_nontemporal_load((const f32x4*)(xrow + 16 * ks + 4));
                  const f32x4 ca = *(const LAS f32x4*)(cmp + 16 * ks), cb = *(const LAS f32x4*)(cmp + 16 * ks + 4), sa = *(const LAS f32x4*)(shp + 16 * ks), sb = *(const LAS f32x4*)(shp + 16 * ks + 4);
                  const f32x4 ha = xa * rs * ca + sa, hb = xb * rs * cb + sb;
                  const unsigned h0 = at::cvtpk(ha[0], ha[1]), h1 = at::cvtpk(ha[2], ha[3]), h2 = at::cvtpk(hb[0], hb[1]), h3 = at::cvtpk(hb[2], hb[3]);
                  const unsigned l0 = at::cvtpk(ha[0] - __uint_as_float(h0 << 16), ha[1] - __uint_as_float(h0 & 0xffff0000u)), l1 = at::cvtpk(ha[2] - __uint_as_float(h1 << 16), ha[3] - __uint_as_float(h1 & 0xffff0000u));
                  const unsigned l2 = at::cvtpk(hb[0] - __uint_as_float(h2 << 16), hb[1] - __uint_as_float(h2 & 0xffff0000u)), l3 = at::cvtpk(hb[2] - __uint_as_float(h3 << 16), hb[3] - __uint_as_float(h3 & 0xffff0000u));
                  const at::bf16x8 ahi = __builtin_bit_cast(at::bf16x8, (u32x4){h0, h1, h2, h3}), alo = __builtin_bit_cast(at::bf16x8, (u32x4){l0, l1, l2, l3});
                  const at::bf16x8 bhi = *(const at::bf16x8*)(whi + 16 * ks), blo = *(const at::bf16x8*)(wlo + 16 * ks);
                  acc = __builtin_amdgcn_mfma_f32_32x32x16_bf16(ahi, bhi, acc, 0, 0, 0); acc = __builtin_amdgcn_mfma_f32_32x32x16_bf16(ahi, blo, acc, 0, 0, 0); acc = __builtin_amdgcn_mfma_f32_32x32x16_bf16(alo, bhi, acc, 0, 0, 0); }
              if (kh == 1) {
#pragma unroll
                  for (int r = 0; r < 16; ++r) XC[(rt * 16 + r) * 64 + lane] = acc[r]; }
              __syncthreads();
              if (kh == 0) { const float bias = rb[r32];
#pragma unroll
                  for (int r = 0; r < 16; ++r) LG[(32 * rt + at::crow(r, hi)) * 33 + r32] = acc[r] + XC[(rt * 16 + r) * 64 + lane] + bias; }
              __syncthreads(); }
            if (tid < 128) { const int rloc = tid, row = chunk * 128 + rloc; float lg[32];
#pragma unroll
                for (int e = 0; e < 32; ++e) lg[e] = LG[rloc * 33 + e];
                int bi[4]; float bv[4];
#pragma unroll
                for (int k = 0; k < 4; ++k) { float best = -3.0e38f; int be = 0;
#pragma unroll
                    for (int e = 0; e < 32; ++e) { bool taken = false;
#pragma unroll
                        for (int q = 0; q < 4; ++q) if (q < k && bi[q] == e) taken = true;
                        if (!taken && lg[e] > best) { best = lg[e]; be = e; } }
                    bi[k] = be; bv[k] = best; }
                const float e1 = expf(bv[1] - bv[0]), e2 = expf(bv[2] - bv[0]), e3 = expf(bv[3] - bv[0]); const float inv = 1.f / (1.f + e1 + e2 + e3);
                if (rep_ == REPS(PH_TOK) - 1) { *(f32x4*)(TOPW + row * 4) = (f32x4){inv, e1 * inv, e2 * inv, e3 * inv};
                    *(u32x4*)(TOPI + row * 4) = (u32x4){(unsigned)bi[0], (unsigned)bi[1], (unsigned)bi[2], (unsigned)bi[3]};
#pragma unroll
                    for (int k = 0; k < 4; ++k) { const int pos = __hip_atomic_fetch_add(lcnt + bi[k], 1, __ATOMIC_RELAXED, __HIP_MEMORY_SCOPE_WORKGROUP); asg[rloc * 4 + k] = (bi[k] << 16) | pos; } } }
            __syncthreads();
            if (tid < 32) lbase[tid] = atomicAdd(&CNT[tid], lcnt[tid]);
            __syncthreads();
            if (rep_ == REPS(PH_TOK) - 1) { const int v = asg[tid], e = v >> 16, pos = v & 0xffff; LIST[(size_t)e * 32768 + lbase[e] + pos] = chunk * 512 + tid; }
        }
        __syncthreads();
    }
    SEAM(PH_TOK);
    if (IN(PH_G4) || IN(PH_G5)) {
        PHASE_BEGIN
        if (tid < 32) ((LAS int*)LW)[LW_CNT + tid] = __hip_atomic_load(&CNT[tid], __ATOMIC_RELAXED, __HIP_MEMORY_SCOPE_AGENT);
        __syncthreads();
        if (tid == 0) { int s = 0; for (int e = 0; e < 32; ++e) { ((LAS int*)LW)[LW_TPRE + e] = s; s += (((LAS int*)LW)[LW_CNT + e] + 255) >> 8; } ((LAS int*)LW)[LW_TPRE + 32] = s; }
        __syncthreads();
    }
    if (IN(PH_G4)) for (int rep_ = 0; rep_ < REPS(PH_G4); ++rep_) {
        PHASE_BEGIN
        pg8::Gemm g{(const bf16_t*)H8, (const bf16_t*)WT_GU8, 512, nullptr, nullptr}; MoeOrder S{(const LAS int*)LW + LW_TPRE, (const LAS int*)LW + LW_CNT, LIST, 8, G, bx, 1024, 2048, (LAS int*)LW + 1024};
        EpiGateUp E{args.in[22], ACT8};
        pg8::gemm_phase<EpiGateUp, MoeOrder, true, false, true>(lds, g, S, E);
    }
    SEAM(PH_G4);
    if (IN(PH_G5)) for (int rep_ = 0; rep_ < REPS(PH_G5); ++rep_) {
        PHASE_BEGIN
        pg8::Gemm g{(const bf16_t*)ACT8, (const bf16_t*)WT_D8, 512, nullptr, nullptr}; MoeOrder S{(const LAS int*)LW + LW_TPRE, (const LAS int*)LW + LW_CNT, LIST, 4, G, bx, 1024, 1024, (LAS int*)LW + 1024};
        EpiDown E{args.in[24], LIST, YM8, (const LAS int*)LW + LW_CNT};
        pg8::gemm_phase<EpiDown, MoeOrder, false, false, true>(lds, g, S, E);
    }
    SEAM(PH_G5);
    if (IN(PH_FIN)) for (int rep_ = 0; rep_ < REPS(PH_FIN); ++rep_) {
        PHASE_BEGIN
        const float* w = args.in[18];
        for (int row0 = gw; row0 < T; row0 += 2 * NGW) { f32x4 v[2][4], ov[2][4]; float ss[2] = {0.f, 0.f}; int rows[2] = {row0, (row0 + NGW < T) ? row0 + NGW : row0};
#pragma unroll
            for (int q = 0; q < 2; ++q) { const int row = rows[q]; const f32x4 tw = *(const f32x4*)(TOPW + row * 4) * (1.f / S8_Y); const unsigned char* y0 = YM8 + (size_t)row * 4096;
#pragma unroll
                for (int j = 0; j < 4; ++j) { const int col = 4 * lane + 256 * j; f32x4 a = (f32x4){0.f, 0.f, 0.f, 0.f};
#pragma unroll
                    for (int k = 0; k < 4; ++k) { const unsigned yw = *(const unsigned*)(y0 + k * 1024 + col); const pg8::f32x2 lo = __builtin_amdgcn_cvt_pk_f32_fp8(yw, false), hi = __builtin_amdgcn_cvt_pk_f32_fp8(yw, true);
                        a[0] += tw[k] * lo[0]; a[1] += tw[k] * lo[1]; a[2] += tw[k] * hi[0]; a[3] += tw[k] * hi[1]; }
                    v[q][j] = a; ov[q][j] = *(const f32x4*)(out + (size_t)row * 1024 + col); ss[q] += (a[0] * a[0] + a[1] * a[1]) + (a[2] * a[2] + a[3] * a[3]); } }
            const float rs[2] = {rsqrtf(wave_sum(ss[0]) * (1.f / 1024.f) + 1e-6f), rsqrtf(wave_sum(ss[1]) * (1.f / 1024.f) + 1e-6f)};
#pragma unroll
            for (int q = 0; q < 2; ++q) { const int row = rows[q], b = row >> 13; if (q == 1 && rows[1] == rows[0]) break;
#pragma unroll
                for (int j = 0; j < 4; ++j) { const int col = 4 * lane + 256 * j; const f32x4 g2 = *(const f32x4*)(MOD + b * 6144 + 5120 + col), wv = *(const f32x4*)(w + col);
                    const f32x4 res = ov[q][j] + g2 * v[q][j] * rs[q] * wv; if (rep_ == REPS(PH_FIN) - 1) *(f32x4*)(out + (size_t)row * 1024 + col) = res; else asm volatile("" :: "v"(res)); } } }
    }
#ifdef PROBE_SPAN
    STAMP(PH_N);
    if (bx == 0 && threadIdx.x == 0) { const unsigned long long t0_ = ((unsigned long long)LW[161 + 2 * (PROBE_SPAN)] << 32) | LW[160 + 2 * (PROBE_SPAN)], t1_ = ((unsigned long long)LW[161 + 2 * (PROBE_SPAN_END)] << 32) | LW[160 + 2 * (PROBE_SPAN_END)];
        const unsigned long long until_ = __builtin_amdgcn_s_memrealtime() + 4ull * (t1_ - t0_);
        while (__builtin_amdgcn_s_memrealtime() < until_) __builtin_amdgcn_s_sleep(8); }
#endif
#undef IN
#undef SEAM
}
}
#undef MOD
#undef SCAL
#undef ROPEC
#undef ROPES
#undef TOPI
#undef TOPW
#undef LIST
#undef RWT
#undef CNT
#undef H
#undef QR
#undef KIMG
#undef VIMG
#undef PROJ
#undef YA
#undef YB
#undef DS
#undef DEC
#undef MERGED
#undef SP
#undef Y
#undef YH
#undef ACT
#undef YM
#undef WT_IN
#undef WT_A
#undef WT_B
#undef WT_O
#undef WT_GU
#undef WT_GU8
#undef WT_D8
#undef H8
#undef ACT8
#undef YM8
#undef WT_D
#undef PHASE_BEGIN

#ifndef FASTMASK
#define FASTMASK 0x1fff
#endif

extern "C" void kernel_launch(void* const* d_in, const int* in_sizes, int n_in, void* d_out, int out_size, void* d_ws, size_t ws_size, hipStream_t stream) {
    if (n_in != 25 || out_size != T * D || ws_size < WS_END) { fprintf(stderr, "kernel_launch: unexpected shapes / workspace (%d inputs, out %d, ws %zu)\n", n_in, out_size, ws_size); return; }
    const float* x = (const float*)d_in[0]; const float* c = (const float*)d_in[1]; const float* w_mod = (const float*)d_in[2]; const float* b_mod = (const float*)d_in[3];
    const float* norm_pre_mix = (const float*)d_in[4]; const float* norm_post_mix = (const float*)d_in[5]; const float* w_in = (const float*)d_in[6];
    const float* lq1 = (const float*)d_in[7]; const float* lk1 = (const float*)d_in[8]; const float* lq2 = (const float*)d_in[9]; const float* lk2 = (const float*)d_in[10];
    const float* subln = (const float*)d_in[11]; const float* lbl = (const float*)d_in[12]; const float* hgnorm = (const float*)d_in[13];
    const float* wa = (const float*)d_in[14]; const float* wb = (const float*)d_in[15]; const float* wo = (const float*)d_in[16];
    const float* norm_pre_ffn = (const float*)d_in[17]; const float* norm_post_ffn = (const float*)d_in[18]; const float* rw = (const float*)d_in[19]; const float* rb = (const float*)d_in[20];
    const float* wgu = (const float*)d_in[21]; const float* bgu = (const float*)d_in[22]; const float* wd = (const float*)d_in[23]; const float* bd = (const float*)d_in[24];
    unsigned char* ws = (unsigned char*)d_ws; float* out = (float*)d_out;
    float* MOD = (float*)(ws + WS_SMALL); float* SCAL = (float*)(ws + WS_SMALL + 128 * 1024); int* PADS = (int*)(ws + WS_SMALL + 192 * 1024);
    float* ROPEC = (float*)(ws + WS_ROPEC); float* ROPES = (float*)(ws + WS_ROPES);
    int* TOPI = (int*)(ws + WS_TOPI); float* TOPW = (float*)(ws + WS_TOPW); int* LIST = (int*)(ws + WS_LIST); int* CNT = (int*)(ws + WS_CTL) + CW_CNT;
    bf16_t* H = (bf16_t*)(ws + WS_H); bf16_t* PROJ = (bf16_t*)(ws + WS_PROJ); bf16_t* YA = (bf16_t*)(ws + WS_YA); bf16_t* YB = (bf16_t*)(ws + WS_YB);
    bf16_t* DS = (bf16_t*)(ws + WS_DS); float* DEC = (float*)(ws + WS_DEC); bf16_t* MERGED = (bf16_t*)(ws + WS_MERGED); float* Y = (float*)(ws + WS_Y);
    bf16_t* SP = (bf16_t*)(ws + WS_MERGED);
    bf16_t* ACT = (bf16_t*)(ws + WS_ACT); bf16_t* YM = (bf16_t*)(ws + WS_YM);

    static int grid = 0;
    if (grid == 0) {
        (void)hipFuncSetAttribute((const void*)nv::k_attn, hipFuncAttributeMaxDynamicSharedMemorySize, nv::AT_LDS);
        (void)hipFuncSetAttribute((const void*)nv::k_hgA, hipFuncAttributeMaxDynamicSharedMemorySize, 65536);
        (void)hipFuncSetAttribute((const void*)nv::k_hgC, hipFuncAttributeMaxDynamicSharedMemorySize, nv::HC_LDS);
        (void)hipFuncSetAttribute((const void*)mk::mega, hipFuncAttributeMaxDynamicSharedMemorySize, mk::LDS_BYTES);
        int dev = 0, cus = 0; (void)hipGetDevice(&dev); (void)hipDeviceGetAttribute(&cus, hipDeviceAttributeMultiprocessorCount, dev);
        (void)hipGetLastError();
        grid = cus > 0 ? cus : 256;
    }
    (void)hipMemsetAsync(ws + WS_CTL, 0, 1 * MiB, stream);
    mk::Args a{}; for (int i = 0; i < 25; ++i) a.in[i] = (const float*)d_in[i]; a.out = out; a.ws = ws;
    const unsigned fast = FASTMASK; int li = 0;
    for (int p = 0; p < mk::PH_N;) {
        if (fast & (1u << p)) { int q = p; while (q < mk::PH_N && (fast & (1u << q))) ++q;
            a.ph_lo = p; a.ph_hi = q; a.li = li++; a.pad = 0;
            hipLaunchKernelGGL(mk::mega, dim3(grid), dim3(mk::NTHR), mk::LDS_BYTES, stream, a);
            p = q; continue; }
        switch (p) {
        case mk::PH_PRO:
            nv::k_mod<<<dim3(24, 4), 256, 0, stream>>>(c, w_mod, b_mod, MOD);
            nv::k_small<<<1024, 256, 0, stream>>>(lq1, lk1, lq2, lk2, lbl, SCAL, ROPEC, ROPES); break;
        case mk::PH_H1: nv::k_rowmod<<<T / 4, 256, 0, stream>>>(x, norm_pre_mix, MOD, H, 0, 1024); break;
        case mk::PH_G1: { nv::NG p_{}; p_.A = H; p_.lda = 1024; p_.M = T; p_.B = w_in; p_.ldb = NC; p_.K = 1024;
            nv::k_gemm<nv::EpiStoreBf16, 1><<<dim3(NC / 64, T / 64, 1), 256, 0, stream>>>(p_, nv::EpiStoreBf16{PROJ, (long long)NC}); } break;
        case mk::PH_ROPE_HGA: nv::k_hgA<<<dim3(128, 4, 4), 256, 65536, stream>>>(PROJ, SCAL, DS, DEC); break;
        case mk::PH_ATT_SCAN:
            nv::k_attn<<<dim3(128, 4, 4), 256, nv::AT_LDS, stream>>>(PROJ, ROPEC, ROPES, SCAL, subln, YA);
            nv::k_scan<<<1024, 256, 0, stream>>>(DS, DEC, SP); break;
        case mk::PH_HGC: nv::k_hgC<<<dim3(128, 4, 4), 256, nv::HC_LDS, stream>>>(PROJ, SCAL, SP, hgnorm, YB); break;
        case mk::PH_G2A: { nv::NG p_{}; p_.A = YA; p_.lda = 512; p_.M = T; p_.B = wa; p_.ldb = 1024; p_.K = 512;
            nv::k_gemm<nv::EpiBranchA, 1><<<dim3(16, T / 64, 1), 256, 0, stream>>>(p_, nv::EpiBranchA{out, PROJ}); } break;
        case mk::PH_G2B: { nv::NG p_{}; p_.A = YB; p_.lda = 512; p_.M = T; p_.B = wb; p_.ldb = 1024; p_.K = 512;
            nv::k_gemm<nv::EpiBranchB, 1><<<dim3(16, T / 64, 1), 256, 0, stream>>>(p_, nv::EpiBranchB{out, PROJ, MERGED}); } break;
        case mk::PH_G3: { nv::NG p_{}; p_.A = MERGED; p_.lda = 1024; p_.M = T; p_.B = wo; p_.ldb = 1024; p_.K = 1024;
            nv::k_gemm<nv::EpiStoreF32, 1><<<dim3(16, T / 64, 1), 256, 0, stream>>>(p_, nv::EpiStoreF32{Y, 1024LL}); } break;
        case mk::PH_TOK:
            nv::k_x1<<<T / 4, 256, 0, stream>>>(x, Y, norm_post_mix, MOD, 2048LL, out);
            nv::k_rowmod<<<T / 4, 256, 0, stream>>>(out, norm_pre_ffn, MOD, H, 3072, 4096);
            nv::k_route<<<T / 4, 256, 0, stream>>>(out, norm_pre_ffn, MOD, rw, rb, TOPI, TOPW);
            nv::k_lists<<<T * 4 / 256, 256, 0, stream>>>(TOPI, CNT, LIST);
            nv::k_pads<<<1, 64, 0, stream>>>(CNT, PADS); break;
        case mk::PH_G4: { nv::NG p_{}; p_.A = H; p_.lda = 1024; p_.rowidx = LIST; p_.idxstride = 32768; p_.idxshift = 2; p_.cnt = CNT; p_.rowbase = PADS; p_.B = wgu; p_.strideB = (size_t)1024 * 2048; p_.ldb = 2048; p_.K = 1024; p_.b1off = 1024;
            nv::k_gemm<nv::EpiGateUp, 2><<<dim3(16, T / 64, 32), 256, 0, stream>>>(p_, nv::EpiGateUp{bgu, ACT}); } break;
        case mk::PH_G5: { nv::NG p_{}; p_.A = ACT; p_.lda = 1024; p_.cnt = CNT; p_.rowbase = PADS; p_.B = wd; p_.strideB = (size_t)1024 * 1024; p_.ldb = 1024; p_.K = 1024;
            nv::k_gemm<nv::EpiDown, 1><<<dim3(16, T / 64, 32), 256, 0, stream>>>(p_, nv::EpiDown{bd, LIST, YM}); } break;
        case mk::PH_FIN: nv::k_final<<<T / 4, 256, 0, stream>>>(out, YM, TOPW, norm_post_ffn, MOD); break;
        }
        ++p;
    }
}
```

```cpp
#include <hip/hip_runtime.h>
#include <hip/hip_bf16.h>
#include <stdint.h>
#include <cstdio>

typedef unsigned short bf16_t;
__device__ __forceinline__ float bf2f(bf16_t v) { return __uint_as_float(((unsigned)v) << 16); }
__device__ __forceinline__ bf16_t f2bf(float f) { unsigned u = __float_as_uint(f); return (bf16_t)((u + 0x7fffu + ((u >> 16) & 1u)) >> 16); }

constexpr int NB_ = 4, SEQ = 8192, T = NB_ * SEQ, D = 1024, NC = 5632, NE = 32;
constexpr size_t MiB = 1u << 20;
constexpr size_t WS_CTL = 0;
constexpr size_t WS_SMALL = 1 * MiB;
constexpr size_t WS_ROPEC = 2 * MiB, WS_ROPES = 3 * MiB;
constexpr size_t WS_TOPI = 4 * MiB, WS_TOPW = 4 * MiB + 512 * 1024;
constexpr size_t WS_RWT = 5 * MiB;
constexpr size_t WS_LIST = 6 * MiB;
constexpr size_t WS_WIN = 16 * MiB, WS_WA = 28 * MiB, WS_WB = 29 * MiB, WS_WO = 30 * MiB, WS_WGU = 32 * MiB, WS_WD = 160 * MiB;
constexpr size_t WS_H = 224 * MiB;
constexpr size_t WS_PROJ = 288 * MiB;
constexpr size_t WS_YA = 640 * MiB, WS_YB = 672 * MiB;
constexpr size_t WS_DS = 704 * MiB, WS_DEC = 768 * MiB;
constexpr size_t WS_MERGED = 772 * MiB;
constexpr size_t WS_Y = 836 * MiB;
constexpr size_t WS_ACT = 288 * MiB;
constexpr size_t WS_YM = 560 * MiB;
constexpr size_t WS_END = 964 * MiB;
constexpr int CW_CNT = 1024;
constexpr int CW_KMAX = 2048;
constexpr int CW_BAR = 4096;

namespace nv {

__device__ __forceinline__ float wave_sum(float v) {
#pragma unroll
    for (int o = 1; o < 64; o <<= 1) v += __shfl_xor(v, o);
    return v;
}
__device__ __forceinline__ float sigm(float x) { return 1.f / (1.f + expf(-x)); }

__global__ void __launch_bounds__(256) k_mod(const float* c, const float* w_mod, const float* b_mod, float* mod) {
    const int j = blockIdx.x * 256 + threadIdx.x, b = blockIdx.y;
    float acc = 0.f;
    for (int k = 0; k < 1024; ++k) { const float cv = c[b * 1024 + k]; acc += (cv * sigm(cv)) * w_mod[(size_t)k * 6144 + j]; }
    mod[b * 6144 + j] = acc + b_mod[j];
}
__global__ void __launch_bounds__(256) k_small(const float* q1, const float* k1, const float* q2, const float* k2, const float* lbl,
                                               float* scal, float* ropec, float* ropes) {
    const int gid = blockIdx.x * 256 + threadIdx.x;
    if (gid == 0) { float s1 = 0.f, s2 = 0.f; for (int i = 0; i < 64; ++i) { s1 += q1[i] * k1[i]; s2 += q2[i] * k2[i]; } scal[0] = expf(s1) - expf(s2) + 0.2f; }
    if (gid < 512) { const float a = lbl[gid], b = lbl[512 + gid]; scal[64 + gid] = 1.f / (1.f + expf(b - a)); }
    if (gid < 8192 * 32) { const int s = gid >> 5, i = gid & 31; const float inv = powf(10000.f, -(float)(2 * i) / 64.f); const float ang = (float)s * inv; ropec[gid] = cosf(ang); ropes[gid] = sinf(ang); }
}
__global__ void __launch_bounds__(256) k_rowmod(const float* x, const float* w, const float* mod, bf16_t* out, int shoff, int scoff) {
    const int row = blockIdx.x * 4 + (threadIdx.x >> 6), lane = threadIdx.x & 63, b = row >> 13;
    const float* xr = x + (size_t)row * 1024; float v[16]; float ss = 0.f;
#pragma unroll
    for (int j = 0; j < 16; ++j) { v[j] = xr[lane + 64 * j]; ss += v[j] * v[j]; }
    ss = wave_sum(ss); const float rstd = rsqrtf(ss * (1.f / 1024.f) + 1e-6f);
#pragma unroll
    for (int j = 0; j < 16; ++j) { const int col = lane + 64 * j; const float h = v[j] * rstd * w[col] * (1.f + mod[b * 6144 + scoff + col]) + mod[b * 6144 + shoff + col]; out[(size_t)row * 1024 + col] = f2bf(h); }
}

struct NG {
    const bf16_t* A;
    const int* rowidx;
    const int* cnt;
    const int* rowbase;
    const float* B; size_t strideB;
    int lda, idxstride, idxshift, M  , ldb, K, b1off, pad;
};
template <class Epi, int NB>
__global__ void __launch_bounds__(256) k_gemm(NG p, Epi epi) {
    __shared__ float As[16][68];
    __shared__ float Bs[NB][16][64];
    const int z = blockIdx.z, Mz = p.cnt ? p.cnt[z] : p.M, m0 = blockIdx.y * 64, n0 = blockIdx.x * 64;
    if (m0 >= Mz) return;
    const int tid = threadIdx.x, tx = tid & 15, ty = tid >> 4;
    const float* B = p.B + (size_t)z * p.strideB;
    const int base = p.rowbase ? p.rowbase[z] : 0;
    const int lr = tid >> 2, lk = (tid & 3) * 4;
    int lrow = m0 + lr; if (lrow >= Mz) lrow = Mz - 1;
    const size_t arow = p.rowidx ? (size_t)(p.rowidx[(size_t)z * p.idxstride + lrow] >> p.idxshift) : (size_t)(base + lrow);
    const bf16_t* ap = p.A + arow * p.lda + lk;
    const int bk = tid >> 4, bc = (tid & 15) * 4;
    float acc[NB][4][4];
#pragma unroll
    for (int q = 0; q < NB; ++q)
#pragma unroll
        for (int i = 0; i < 4; ++i)
#pragma unroll
            for (int j = 0; j < 4; ++j) acc[q][i][j] = 0.f;
    for (int k0 = 0; k0 < p.K; k0 += 16) {
        const uint2 av = *(const uint2*)(ap + k0);
        As[lk + 0][lr] = __uint_as_float(av.x << 16); As[lk + 1][lr] = __uint_as_float(av.x & 0xffff0000u);
        As[lk + 2][lr] = __uint_as_float(av.y << 16); As[lk + 3][lr] = __uint_as_float(av.y & 0xffff0000u);
#pragma unroll
        for (int q = 0; q < NB; ++q) { const float4 bv = *(const float4*)(B + (size_t)(k0 + bk) * p.ldb + n0 + bc + q * p.b1off); *(float4*)&Bs[q][bk][bc] = bv; }
        __syncthreads();
#pragma unroll
        for (int k = 0; k < 16; ++k) {
            float a[4]; const float4 a4 = *(const float4*)&As[k][ty * 4]; a[0] = a4.x; a[1] = a4.y; a[2] = a4.z; a[3] = a4.w;
#pragma unroll
            for (int q = 0; q < NB; ++q) { const float4 b4 = *(const float4*)&Bs[q][k][tx * 4]; const float b[4] = {b4.x, b4.y, b4.z, b4.w};
#pragma unroll
                for (int i = 0; i < 4; ++i)
#pragma unroll
                    for (int j = 0; j < 4; ++j) acc[q][i][j] += a[i] * b[j]; }
        }
        __syncthreads();
    }
#pragma unroll
    for (int i = 0; i < 4; ++i) { const int lrw = m0 + ty * 4 + i; if (lrw < Mz) {
#pragma unroll
        for (int j = 0; j < 4; ++j) epi(z, lrw, base + lrw, n0 + tx * 4 + j, acc[0][i][j], NB == 2 ? acc[NB - 1][i][j] : 0.f); } }
}
struct EpiStoreBf16 { bf16_t* C; long long ldc; __device__ void operator()(int, int, int r, int c, float v, float) const { C[(size_t)r * ldc + c] = f2bf(v); } };
struct EpiStoreF32 { float* C; long long ldc; __device__ void operator()(int, int, int r, int c, float v, float) const { C[(size_t)r * ldc + c] = v; } };
struct EpiBranchA { float* tmp; const bf16_t* proj; __device__ void operator()(int, int, int r, int c, float v, float) const { tmp[(size_t)r * 1024 + c] = sigm(bf2f(proj[(size_t)r * 5632 + 3584 + c])) * v; } };
struct EpiBranchB { const float* tmp; const bf16_t* proj; bf16_t* merged; __device__ void operator()(int, int, int r, int c, float v, float) const {
    merged[(size_t)r * 1024 + c] = f2bf(tmp[(size_t)r * 1024 + c] + sigm(bf2f(proj[(size_t)r * 5632 + 4608 + c])) * v); } };
struct EpiGateUp { const float* bgu; bf16_t* act; __device__ void operator()(int e, int, int r, int c, float v0, float v1) const {
    float g = v0 + bgu[e * 2048 + c], u = v1 + bgu[e * 2048 + 1024 + c]; g = fminf(g, 7.f); u = fminf(fmaxf(u, -7.f), 7.f);
    const float glu = g * sigm(1.702f * g); act[(size_t)r * 1024 + c] = f2bf((u + 1.f) * glu); } };
struct EpiDown { const float* bd; const int* list; bf16_t* ym; __device__ void operator()(int e, int lr, int, int c, float v, float) const {
    const int a = list[(size_t)e * 32768 + lr]; ym[(size_t)a * 1024 + c] = f2bf(v + bd[e * 1024 + c]); } };

constexpr int AT_LD = 129;
constexpr int AT_LDS = (3 * 64 * AT_LD + 64 * 65) * 4;
__device__ __forceinline__ void at_load_rope(float* dst, const bf16_t* proj, int tok0, int colbase, const float* ropec, const float* ropes, int s0, int tid) {
    for (int i = 0; i < 16; ++i) { const int idx = tid + 256 * i, row = idx >> 6, rem = idx & 63, m = rem >> 5, d = rem & 31;
        const bf16_t* pr = proj + (size_t)(tok0 + row) * 5632 + colbase + m * 64;
        const float x1 = bf2f(pr[d]), x2 = bf2f(pr[32 + d]), c = ropec[(s0 + row) * 32 + d], s = ropes[(s0 + row) * 32 + d];
        dst[row * AT_LD + m * 64 + d] = x1 * c - x2 * s; dst[row * AT_LD + m * 64 + 32 + d] = x2 * c + x1 * s; }
}
__global__ void __launch_bounds__(256) k_attn(const bf16_t* proj, const float* ropec, const float* ropes, const float* scal, const float* subln, bf16_t* ya) {
    extern __shared__ float sm[];
    float* Qs = sm; float* Ks = Qs + 64 * AT_LD; float* Vs = Ks + 64 * AT_LD; float* As = Vs + 64 * AT_LD;
    const int qc = blockIdx.x, h = blockIdx.y, b = blockIdx.z, tid = threadIdx.x, r = tid >> 2, qd = tid & 3;
    const int tokq = b * 8192 + qc * 64; const float lam = scal[0];
    at_load_rope(Qs, proj, tokq, h * 128, ropec, ropes, qc * 64, tid);
    float m0 = -1e30f, l0 = 0.f, m1 = -1e30f, l1 = 0.f;
    for (int kc = 0; kc <= qc; ++kc) {
        __syncthreads();
        at_load_rope(Ks, proj, b * 8192 + kc * 64, 512 + h * 128, ropec, ropes, kc * 64, tid);
        __syncthreads();
        for (int i = 0; i < 16; ++i) { const int j = 4 * i + qd; float s0 = 0.f, s1 = 0.f;
            for (int d = 0; d < 64; ++d) { s0 += Qs[r * AT_LD + d] * Ks[j * AT_LD + d]; s1 += Qs[r * AT_LD + 64 + d] * Ks[j * AT_LD + 64 + d]; }
            s0 *= 0.125f; s1 *= 0.125f;
            float mn = fmaxf(m0, s0); l0 = l0 * expf(m0 - mn) + expf(s0 - mn); m0 = mn;
            mn = fmaxf(m1, s1); l1 = l1 * expf(m1 - mn) + expf(s1 - mn); m1 = mn; }
    }
#pragma unroll
    for (int o = 1; o < 4; o <<= 1) {
        float mo = __shfl_xor(m0, o), lo = __shfl_xor(l0, o); float mn = fmaxf(m0, mo); l0 = l0 * expf(m0 - mn) + lo * expf(mo - mn); m0 = mn;
        mo = __shfl_xor(m1, o); lo = __shfl_xor(l1, o); mn = fmaxf(m1, mo); l1 = l1 * expf(m1 - mn) + lo * expf(mo - mn); m1 = mn; }
    const float il0 = 1.f / l0, il1 = lam / l1;
    float o[32];
#pragma unroll
    for (int i = 0; i < 32; ++i) o[i] = 0.f;
    for (int kc = 0; kc <= qc; ++kc) {
        __syncthreads();
        at_load_rope(Ks, proj, b * 8192 + kc * 64, 512 + h * 128, ropec, ropes, kc * 64, tid);
        for (int i = 0; i < 32; ++i) { const int idx = tid + 256 * i, row = idx >> 7, col = idx & 127; Vs[row * AT_LD + col] = bf2f(proj[(size_t)(b * 8192 + kc * 64 + row) * 5632 + 1024 + h * 128 + col]); }
        __syncthreads();
        for (int i = 0; i < 16; ++i) { const int j = 4 * i + qd; float s0 = 0.f, s1 = 0.f;
            for (int d = 0; d < 64; ++d) { s0 += Qs[r * AT_LD + d] * Ks[j * AT_LD + d]; s1 += Qs[r * AT_LD + 64 + d] * Ks[j * AT_LD + 64 + d]; }
            s0 *= 0.125f; s1 *= 0.125f;
            As[r * 65 + j] = expf(s0 - m0) * il0 - expf(s1 - m1) * il1; }
        __syncthreads();
        for (int j = 0; j < 64; ++j) { const float av = As[r * 65 + j];
#pragma unroll
            for (int dv = 0; dv < 32; ++dv) o[dv] += av * Vs[j * AT_LD + 32 * qd + dv]; }
    }
    float ss = 0.f;
#pragma unroll
    for (int i = 0; i < 32; ++i) ss += o[i] * o[i];
    ss += __shfl_xor(ss, 1); ss += __shfl_xor(ss, 2);
    const float rstd = rsqrtf(ss * (1.f / 128.f) + 1e-6f);
#pragma unroll
    for (int i = 0; i < 32; ++i) { const int dv = 32 * qd + i; ya[(size_t)(tokq + r) * 512 + h * 128 + dv] = f2bf(o[i] * rstd * subln[dv] * 0.8f); }
}

__global__ void __launch_bounds__(256) k_hgA(const bf16_t* proj, const float* scal, bf16_t* ds, float* dec) {
    extern __shared__ float sm[];
    float* G = sm; float* V = sm + 64 * 128;
    const int n = blockIdx.x, h = blockIdx.y, b = blockIdx.z, tid = threadIdx.x, tok0 = b * 8192 + n * 64, bh = b * 4 + h;
    for (int i = 0; i < 32; ++i) { const int idx = tid + 256 * i, c = idx >> 7, d = idx & 127; const bf16_t* pr = proj + (size_t)(tok0 + c) * 5632 + h * 128 + d;
        const float lb = scal[64 + h * 128 + d]; const float f = lb + (1.f - lb) * sigm(bf2f(pr[2048])); G[c * 128 + d] = f; V[c * 128 + d] = bf2f(pr[2560]); }
    __syncthreads();
    float kk[64]; float glast = 0.f; const int d = tid & 127, vb = (tid >> 7) * 64;
    {
        float g = 0.f;
#pragma unroll
        for (int c = 0; c < 64; ++c) { const float f = G[c * 128 + d]; g += logf(f); kk[c] = g; }
        glast = g;
#pragma unroll
        for (int c = 0; c < 64; ++c) { const float f = G[c * 128 + d]; kk[c] = (1.f - f) * expf(glast - kk[c]); }
    }
    if (tid < 128) dec[(size_t)(bh * 128 + n) * 128 + d] = expf(glast);
    for (int v0 = 0; v0 < 64; v0 += 16) {
        float acc[16];
#pragma unroll
        for (int i = 0; i < 16; ++i) acc[i] = 0.f;
#pragma unroll
        for (int c = 0; c < 64; ++c) {
#pragma unroll
            for (int i = 0; i < 16; ++i) acc[i] += kk[c] * V[c * 128 + vb + v0 + i]; }
#pragma unroll
        for (int i = 0; i < 16; ++i) ds[((size_t)(bh * 128 + n) * 128 + d) * 128 + vb + v0 + i] = f2bf(acc[i]);
    }
}
__global__ void __launch_bounds__(256) k_scan(const bf16_t* ds, const float* dec, bf16_t* sp) {
    const int gid = blockIdx.x * 256 + threadIdx.x; const int bh = gid >> 14, d = (gid >> 7) & 127, v = gid & 127;
    float st = 0.f;
    for (int n = 0; n < 128; ++n) { const size_t o = ((size_t)(bh * 128 + n) * 128 + d) * 128 + v; const float x = bf2f(ds[o]); sp[o] = f2bf(st); st = dec[(size_t)(bh * 128 + n) * 128 + d] * st + x; }
}
constexpr int HC_LDS = (2 * 64 * 129 + 64 * 128 + 64 * 65) * 4;
__global__ void __launch_bounds__(256) k_hgC(const bf16_t* proj, const float* scal, const bf16_t* sp, const float* hgnorm, bf16_t* yb) {
    extern __shared__ float sm[];
    float* QT = sm; float* KT = QT + 64 * 129; float* V = KT + 64 * 129; float* As = V + 64 * 128;
    const int n = blockIdx.x, h = blockIdx.y, b = blockIdx.z, tid = threadIdx.x, tok0 = b * 8192 + n * 64, bh = b * 4 + h;
    for (int i = 0; i < 32; ++i) { const int idx = tid + 256 * i, c = idx >> 7, d = idx & 127; const bf16_t* pr = proj + (size_t)(tok0 + c) * 5632 + h * 128 + d;
        const float lb = scal[64 + h * 128 + d]; const float f = lb + (1.f - lb) * sigm(bf2f(pr[2048])); const float q = bf2f(pr[1536]);
        QT[c * 129 + d] = q * sigm(q); KT[c * 129 + d] = f; V[c * 128 + d] = bf2f(pr[2560]); }
    __syncthreads();
    if (tid < 128) { float g = 0.f; for (int c = 0; c < 64; ++c) { const float f = KT[c * 129 + tid]; g += logf(f); QT[c * 129 + tid] *= expf(g); KT[c * 129 + tid] = (1.f - f) * expf(-g); } }
    __syncthreads();
    const int c = tid >> 2, q4 = tid & 3;
    for (int i = 0; i < 16; ++i) { const int s = 4 * i + q4; float a = 0.f;
        if (s <= c) { for (int d = 0; d < 128; ++d) a += QT[c * 129 + d] * KT[s * 129 + d]; }
        As[c * 65 + s] = a; }
    __syncthreads();
    float o[32];
#pragma unroll
    for (int i = 0; i < 32; ++i) o[i] = 0.f;
    for (int s = 0; s < 64; ++s) { const float a = As[c * 65 + s];
#pragma unroll
        for (int i = 0; i < 32; ++i) o[i] += a * V[s * 128 + 32 * q4 + i]; }
    const bf16_t* spb = sp + (size_t)(bh * 128 + n) * 128 * 128;
    for (int d = 0; d < 128; ++d) { const float qv = QT[c * 129 + d];
#pragma unroll
        for (int i = 0; i < 32; ++i) o[i] += qv * bf2f(spb[d * 128 + 32 * q4 + i]); }
    float ss = 0.f;
#pragma unroll
    for (int i = 0; i < 32; ++i) ss += o[i] * o[i];
    ss += __shfl_xor(ss, 1); ss += __shfl_xor(ss, 2);
    const float rstd = rsqrtf(ss * (1.f / 128.f) + 1e-6f);
#pragma unroll
    for (int i = 0; i < 32; ++i) { const int v = 32 * q4 + i; const float g = bf2f(proj[(size_t)(tok0 + c) * 5632 + 3072 + h * 128 + v]);
        yb[(size_t)(tok0 + c) * 512 + h * 128 + v] = f2bf(o[i] * rstd * hgnorm[v] * (g * sigm(g))); }
}
__global__ void __launch_bounds__(256) k_x1(const float* x, const float* y, const float* w, const float* mod, long long goff, float* x1) {
    const int row = blockIdx.x * 4 + (threadIdx.x >> 6), lane = threadIdx.x & 63, b = row >> 13;
    const float* yr = y + (size_t)row * 1024; float v[16]; float ss = 0.f;
#pragma unroll
    for (int j = 0; j < 16; ++j) { v[j] = yr[lane + 64 * j]; ss += v[j] * v[j]; }
    ss = wave_sum(ss); const float rstd = rsqrtf(ss * (1.f / 1024.f) + 1e-6f);
#pragma unroll
    for (int j = 0; j < 16; ++j) { const int col = lane + 64 * j; x1[(size_t)row * 1024 + col] = x[(size_t)row * 1024 + col] + mod[b * 6144 + goff + col] * v[j] * rstd * w[col]; }
}
__global__ void __launch_bounds__(256) k_route(const float* x1, const float* w, const float* mod, const float* rw, const float* rb, int* topi, float* topw) {
    const int row = blockIdx.x * 4 + (threadIdx.x >> 6), lane = threadIdx.x & 63, b = row >> 13;
    const float* xr = x1 + (size_t)row * 1024; float v[16]; float ss = 0.f;
#pragma unroll
    for (int j = 0; j < 16; ++j) { v[j] = xr[lane + 64 * j]; ss += v[j] * v[j]; }
    ss = wave_sum(ss); const float rstd = rsqrtf(ss * (1.f / 1024.f) + 1e-6f);
    float lg[32];
#pragma unroll
    for (int e = 0; e < 32; ++e) lg[e] = 0.f;
#pragma unroll
    for (int j = 0; j < 16; ++j) { const int col = lane + 64 * j; const float h = v[j] * rstd * w[col] * (1.f + mod[b * 6144 + 4096 + col]) + mod[b * 6144 + 3072 + col];
#pragma unroll
        for (int e = 0; e < 32; ++e) lg[e] += h * rw[col * 32 + e]; }
#pragma unroll
    for (int e = 0; e < 32; ++e) lg[e] = wave_sum(lg[e]) + rb[e];
    int bi[4]; float bv[4];
#pragma unroll
    for (int k = 0; k < 4; ++k) { float best = -3.0e38f; int be = 0;
#pragma unroll
        for (int e = 0; e < 32; ++e) { bool taken = false;
#pragma unroll
            for (int q = 0; q < 4; ++q) if (q < k && bi[q] == e) taken = true;
            if (!taken && lg[e] > best) { best = lg[e]; be = e; } }
        bi[k] = be; bv[k] = best; }
    const float e1 = expf(bv[1] - bv[0]), e2 = expf(bv[2] - bv[0]), e3 = expf(bv[3] - bv[0]); const float inv = 1.f / (1.f + e1 + e2 + e3);
    if (lane == 0) { topi[row * 4 + 0] = bi[0]; topi[row * 4 + 1] = bi[1]; topi[row * 4 + 2] = bi[2]; topi[row * 4 + 3] = bi[3];
        topw[row * 4 + 0] = inv; topw[row * 4 + 1] = e1 * inv; topw[row * 4 + 2] = e2 * inv; topw[row * 4 + 3] = e3 * inv; }
}
__global__ void __launch_bounds__(256) k_lists(const int* topi, int* cnt, int* list) {
    const int a = blockIdx.x * 256 + threadIdx.x; const int e = topi[a]; const int pos = atomicAdd(&cnt[e], 1); list[(size_t)e * 32768 + pos] = a;
}
__global__ void k_pads(const int* cnt, int* pads) { if (threadIdx.x == 0) { int s = 0; for (int e = 0; e < 32; ++e) { pads[e] = s; s += ((cnt[e] + 255) / 256) * 256; } } }
__global__ void __launch_bounds__(256) k_final(float* out, const bf16_t* ym, const float* topw, const float* w, const float* mod) {
    const int row = blockIdx.x * 4 + (threadIdx.x >> 6), lane = threadIdx.x & 63, b = row >> 13;
    float v[16]; float ss = 0.f; const float w0 = topw[row * 4], w1 = topw[row * 4 + 1], w2 = topw[row * 4 + 2], w3 = topw[row * 4 + 3];
    const bf16_t* y0 = ym + (size_t)row * 4096;
#pragma unroll
    for (int j = 0; j < 16; ++j) { const int col = lane + 64 * j; v[j] = w0 * bf2f(y0[col]) + w1 * bf2f(y0[1024 + col]) + w2 * bf2f(y0[2048 + col]) + w3 * bf2f(y0[3072 + col]); ss += v[j] * v[j]; }
    ss = wave_sum(ss); const float rstd = rsqrtf(ss * (1.f / 1024.f) + 1e-6f);
#pragma unroll
    for (int j = 0; j < 16; ++j) { const int col = lane + 64 * j; out[(size_t)row * 1024 + col] += mod[b * 6144 + 5120 + col] * v[j] * rstd * w[col]; }
}
}
#define GAS __attribute__((address_space(1)))
#define LAS __attribute__((address_space(3)))
typedef GAS unsigned gu32;
#define RLX_AGENT __ATOMIC_RELAXED, __HIP_MEMORY_SCOPE_AGENT
#define XB_TMO      128
#define XB_XCNT(j)  (256  + 64 * (j))
#define XB_XSUB(j)  (1280 + 64 * (j))
#define XB_XGEN(j)  (2304 + 64 * (j))
#define XB_TOP      3328
#define XB_TOPGEN   3392
#define XCD_BAR_WORDS 3456
#define XB_SPIN_CAP (1u << 22)

__device__ __forceinline__ unsigned xb_ld(unsigned* p)              { return __hip_atomic_load(p, __ATOMIC_RELAXED, __HIP_MEMORY_SCOPE_AGENT); }
__device__ __forceinline__ unsigned xb_add(unsigned* p, unsigned v) { return __hip_atomic_fetch_add(p, v, __ATOMIC_RELAXED, __HIP_MEMORY_SCOPE_AGENT); }
__device__ __forceinline__ unsigned xb_xcc_id() { return (unsigned)__builtin_amdgcn_s_getreg((3 << 11) | 20) & 0xFu; }
#define XB_SPIN(cond, bar) do { unsigned _sp = 0; while (cond) { __builtin_amdgcn_s_sleep(1); \
    if ((++_sp & 255u) == 0u) { if (xb_ld(&(bar)[XB_TMO])) break; if (_sp > XB_SPIN_CAP) { atomicAdd(&(bar)[XB_TMO], 1u); break; } } } } while (0)

struct XcdBarrier {
    unsigned* bar; unsigned x;
    volatile LAS unsigned* st;
};
__device__ __forceinline__ XcdBarrier xcd_barrier_post(unsigned* bar, volatile LAS unsigned* st) {
    XcdBarrier b; b.bar = bar; b.x = xb_xcc_id(); b.st = st;
    if (threadIdx.x == 0) (void)xb_add(&bar[XB_XCNT(b.x)], 1u);
    return b;
}
__device__ __forceinline__ void xcd_barrier_complete(unsigned* bar, unsigned x, unsigned& nloc, unsigned& nx) {
    const unsigned G = gridDim.x * gridDim.y * gridDim.z;
    unsigned sum, cnt, mine, sp = 0u;
    for (;;) {
        sum = 0u; cnt = 0u; mine = 0u;
#pragma unroll
        for (unsigned j = 0; j < 16; ++j) { const unsigned c = xb_ld(&bar[XB_XCNT(j)]); sum += c; cnt += (c > 0u) ? 1u : 0u; mine = (j == x) ? c : mine; }
        if (sum == G) break;
        __builtin_amdgcn_s_sleep(1);
        if ((++sp & 255u) == 0u) { if (xb_ld(&bar[XB_TMO])) break; if (sp > XB_SPIN_CAP) { atomicAdd(&bar[XB_TMO], 1u); break; } }
    }
    nloc = mine > 0u ? mine : 1u; nx = cnt > 0u ? cnt : 1u;
}
__device__ __forceinline__ void xcd_barrier(const XcdBarrier& b) {
    asm volatile("s_waitcnt vmcnt(0)" ::: "memory");
    __syncthreads();
    if (threadIdx.x == 0) {
        unsigned* bar = b.bar;
        __builtin_amdgcn_s_waitcnt(0);
        unsigned nloc = b.st[0], nx = b.st[1];
        if (nloc == 0u) { xcd_barrier_complete(bar, b.x, nloc, nx); b.st[0] = nloc; b.st[1] = nx; }
        const unsigned old = xb_add(&bar[XB_XSUB(b.x)], 1u);
        const unsigned gen = old / nloc;
        if (old + 1u == (gen + 1u) * nloc) {
            __builtin_amdgcn_fence(__ATOMIC_RELEASE, "agent");
            asm volatile("s_waitcnt vmcnt(0)" ::: "memory");
            const unsigned og = xb_add(&bar[XB_TOP], 1u);
            const unsigned tg = og / nx;
            if (og + 1u == (tg + 1u) * nx) xb_add(&bar[XB_TOPGEN], 1u);
            else XB_SPIN(xb_ld(&bar[XB_TOPGEN]) == tg, bar);
            __builtin_amdgcn_fence(__ATOMIC_ACQUIRE, "agent");
            xb_add(&bar[XB_XGEN(b.x)], 1u);
            asm volatile("s_waitcnt vmcnt(0)" ::: "memory");
        } else {
            XB_SPIN(xb_ld(&bar[XB_XGEN(b.x)]) == gen, bar);
            __builtin_amdgcn_fence(__ATOMIC_ACQUIRE, "agent");
            asm volatile("s_waitcnt vmcnt(0)" ::: "memory");
        }
    }
    __syncthreads();
}
namespace pg8 {
#define PG8_LAS __attribute__((address_space(3)))
typedef short bf16x8 __attribute__((ext_vector_type(8)));
typedef float f32x4 __attribute__((ext_vector_type(4)));
typedef float f32x2 __attribute__((ext_vector_type(2)));
typedef unsigned u32x4 __attribute__((ext_vector_type(4)));
typedef unsigned u32x2 __attribute__((ext_vector_type(2)));
typedef int i32x4 __attribute__((ext_vector_type(4)));
typedef int i32x8 __attribute__((ext_vector_type(8)));
constexpr int BM = 256, BK = 64, HALF = 128, HTB = HALF * BK * 2  , STAGE_BYTES = 8 * HTB, NXCD = 8, WGM = 8;

__host__ __device__ __forceinline__ int lds_byte(int r, int c) { const int st = (r >> 4) * 2 + (c >> 5), rr = r & 15, cc = c & 31, ob = rr * 64 + cc * 2; return st * 1024 + (ob ^ (((ob >> 9) & 1) << 5)); }
__host__ __device__ __forceinline__ void stage_rc(int b, int& R, int& C) { const int st = b / 1024, sb = b % 1024, swz = sb ^ (((sb >> 9) & 1) << 5); R = (st >> 1) * 16 + swz / 64; C = (st & 1) * 32 + (swz % 64) / 2; }
__host__ __device__ __forceinline__ int perm32(int rho) { const int n = rho >> 4, i = rho & 15; return 8 * (i >> 2) + 4 * n + (i & 3); }

struct Unit { int pm, pn, z, arow, brow; };
struct Gemm { const bf16_t* A; const bf16_t* Bt; int K; const bf16_t* A2; const bf16_t* Bt2; };

struct DenseOrder {
    int nM, nN, nwg, G, c;
    __device__ void init(int M, int N, int G_, int c_) { nM = M / BM; nN = N / BM; nwg = nM * nN; G = G_; c = c_; }
    __device__ bool next(int i, Unit& u) const {
        const long L = (long)i * G + c; if (L >= nwg) return false;
        int wgid = (int)L; { const int q = nwg / NXCD, r = nwg % NXCD, xcd = wgid % NXCD, off = wgid / NXCD; wgid = (xcd < r ? xcd * (q + 1) : r * (q + 1) + (xcd - r) * q) + off; }
        const int nig = WGM * nN, gid = wgid / nig, fm = gid * WGM, gsz = (nM - fm) < WGM ? (nM - fm) : WGM;
        u.pm = fm + ((wgid % nig) % gsz); u.pn = (wgid % nig) / gsz; u.z = 0; u.arow = u.pm * BM; u.brow = u.pn * BM; return true;
    }
    __device__ __forceinline__ unsigned row_off(const Unit&, int) const { return 0u; }
};

struct DenseOrder2 { DenseOrder base;
    __device__ bool next(int i, Unit& u) const { if (!base.next(i >> 1, u)) return false; u.z = i & 1; return true; }
    __device__ __forceinline__ unsigned row_off(const Unit&, int) const { return 0u; }
};
__device__ __forceinline__ unsigned cvt_pk_bf16(float lo, float hi) { unsigned r; asm volatile("v_cvt_pk_bf16_f32 %0, %1, %2" : "=v"(r) : "v"(lo), "v"(hi)); return r; }


template <class Epi, class Sched, bool GATHER, bool TWOPART = false, bool FP8 = false>
__device__ __forceinline__ void gemm_phase(PG8_LAS unsigned char* lds, const Gemm g, const Sched& S, const Epi& E) {
    int tid_ = threadIdx.x; asm volatile("" : "+v"(tid_));
    const int tid = tid_, wid = __builtin_amdgcn_readfirstlane(tid >> 6), lane = tid & 63, wr = wid >> 2, wc = wid & 3, fr = lane & 15, fq = lane >> 4;
    const int K = g.K, nt = K / BK;
    unsigned voffA[2], voffB[2]; int RA[2];
#pragma unroll
    for (int i = 0; i < 2; ++i) { int R, C; stage_rc(tid * 16 + i * 8192, R, C); const int Rb = Epi::PERM ? ((R & ~31) + perm32(R & 31)) : R;
        RA[i] = R; voffA[i] = GATHER ? (unsigned)(C * 2) : (unsigned)(R * K + C) * 2u; voffB[i] = (unsigned)(Rb * K + C) * 2u; }
    const size_t kstep = (size_t)(BK * 2);
    const size_t hstep = (size_t)HALF * K * 2;
    const unsigned ldsw = (unsigned)wid * 1024u;
    const int aoff = lds_byte(wr * 64 + fr, fq * 8), boff = lds_byte(wc * 32 + fr, fq * 8);
    unsigned gAc[2][2], gAn[2][2];
#define PG8_SA(b, h) (((b) * 2 + (h)) * HTB)
#define PG8_SB(b, h) ((4 + (b) * 2 + (h)) * HTB)
#define PG8_STAGE(bufoff, gbase, voff) do { _Pragma("unroll") for (int _i = 0; _i < 2; ++_i) \
        __builtin_amdgcn_global_load_lds((const unsigned*)((const char*)(gbase) + (voff)[_i]), (PG8_LAS unsigned*)(lds + (bufoff) + ldsw + _i * 8192), 16, 0, 0); } while (0)
#define PG8_STAGEA(bufoff, gbase, h, nx) do { if constexpr (GATHER) { _Pragma("unroll") for (int _i = 0; _i < 2; ++_i) { const unsigned _v = ((nx) ? gAn[h][_i] : gAc[h][_i]) + voffA[_i]; \
        __builtin_amdgcn_global_load_lds((const unsigned*)((const char*)(gbase) + _v), (PG8_LAS unsigned*)(lds + (bufoff) + ldsw + _i * 8192), 16, 0, 0); } } \
        else { PG8_STAGE(bufoff, (const char*)(gbase) + (h) * hstep, voffA); } } while (0)
#define PG8_LD8(base) __builtin_shufflevector(*(const PG8_LAS i32x4*)(base), *(const PG8_LAS i32x4*)((base) + 1024), 0, 1, 2, 3, 4, 5, 6, 7)
#define PG8_LDA(dst, b, h) do { if constexpr (FP8) { _Pragma("unroll") for (int m = 0; m < 4; ++m) dst##8[m] = PG8_LD8(lds + PG8_SA(b, h) + aoff + m * 2048); } \
        else { _Pragma("unroll") for (int m = 0; m < 4; ++m) _Pragma("unroll") for (int k = 0; k < 2; ++k) dst[m][k] = *(const PG8_LAS bf16x8*)(lds + PG8_SA(b, h) + aoff + m * 2048 + k * 1024); } } while (0)
#define PG8_LDB(dst, b, h) do { if constexpr (FP8) { _Pragma("unroll") for (int n = 0; n < 2; ++n) dst##8[n] = PG8_LD8(lds + PG8_SB(b, h) + boff + n * 2048); } \
        else { _Pragma("unroll") for (int n = 0; n < 2; ++n) _Pragma("unroll") for (int k = 0; k < 2; ++k) dst[n][k] = *(const PG8_LAS bf16x8*)(lds + PG8_SB(b, h) + boff + n * 2048 + k * 1024); } } while (0)
#define PG8_CAT(x, y) __builtin_shufflevector(__builtin_bit_cast(i32x4, x), __builtin_bit_cast(i32x4, y), 0, 1, 2, 3, 4, 5, 6, 7)
#define PG8_MMA(ai, bj, At, Bt) do { __builtin_amdgcn_s_setprio(1); \
        if constexpr (FP8) { _Pragma("unroll") for (int m = 0; m < 4; ++m) _Pragma("unroll") for (int n = 0; n < 2; ++n) \
            asm volatile("v_mfma_scale_f32_16x16x128_f8f6f4 %0, %1, %2, %0, %3, %3 op_sel_hi:[0,0,0]" : "+v"(acc[ai][bj][m][n]) : "v"(Bt##8[n]), "v"(At##8[m]), "v"(one8)); } \
        else { _Pragma("unroll") for (int m = 0; m < 4; ++m) _Pragma("unroll") for (int n = 0; n < 2; ++n) _Pragma("unroll") for (int k = 0; k < 2; ++k) \
            acc[ai][bj][m][n] = __builtin_amdgcn_mfma_f32_16x16x32_bf16(Bt[n][k], At[m][k], acc[ai][bj][m][n], 0, 0, 0); } \
        __builtin_amdgcn_s_setprio(0); } while (0)
#define PG8_WAIT_V(n) asm volatile("s_waitcnt vmcnt(" #n ")" ::: "memory")
#define PG8_WAIT_L(n) asm volatile("s_waitcnt lgkmcnt(" #n ")" ::: "memory")
#define PG8_BAR __builtin_amdgcn_s_barrier()
#define PG8_SCHED __builtin_amdgcn_sched_barrier(0)
    Unit cur, nxt; int ui = 0;
    if (!S.next(0, cur)) return;
    f32x4 acc[2][2][4][2];
#pragma unroll
    for (int a = 0; a < 2; ++a)
#pragma unroll
        for (int b = 0; b < 2; ++b)
#pragma unroll
            for (int m = 0; m < 4; ++m)
#pragma unroll
                for (int n = 0; n < 2; ++n) acc[a][b][m][n] = (f32x4){0.f, 0.f, 0.f, 0.f};
    if constexpr (FP8) {
#pragma unroll
        for (int a = 0; a < 2; ++a)
#pragma unroll
            for (int b = 0; b < 2; ++b) asm volatile("s_nop 3" : "+v"(acc[a][b][0][0]), "+v"(acc[a][b][0][1]), "+v"(acc[a][b][1][0]), "+v"(acc[a][b][1][1]), "+v"(acc[a][b][2][0]), "+v"(acc[a][b][2][1]), "+v"(acc[a][b][3][0]), "+v"(acc[a][b][3][1]));
    }
    unsigned one8 = 0x7f7f7f7fu; asm volatile("" : "+v"(one8));
    bf16x8 At[4][2], B0[2][2], B1[2][2];
    i32x8 At8[4], B08[2], B18[2];
    const char* cA = GATHER ? (const char*)g.A : (const char*)((TWOPART && cur.z) ? g.A2 : g.A) + (size_t)cur.arow * K * 2; const char* cB = (const char*)((TWOPART && cur.z) ? g.Bt2 : g.Bt) + (size_t)cur.brow * K * 2;
    if constexpr (GATHER) {
#pragma unroll
        for (int h = 0; h < 2; ++h)
#pragma unroll
            for (int i = 0; i < 2; ++i) { gAc[h][i] = S.row_off(cur, h * HALF + RA[i]); gAn[h][i] = gAc[h][i]; }
    }
    PG8_STAGE(PG8_SB(0, 0), cB, voffB); PG8_STAGE(PG8_SB(0, 1), cB + hstep, voffB); PG8_STAGEA(PG8_SA(0, 0), cA, 0, false); PG8_STAGEA(PG8_SA(0, 1), cA, 1, false);
    if (wr == 1) PG8_BAR;
    PG8_WAIT_V(2); PG8_BAR;
    PG8_STAGE(PG8_SB(1, 0), cB + kstep, voffB); PG8_STAGEA(PG8_SA(1, 0), cA + kstep, 0, false); PG8_STAGE(PG8_SB(1, 1), cB + hstep + kstep, voffB);
    PG8_WAIT_V(6); PG8_BAR;
    for (;;) {
        const bool has_next = S.next(ui + 1, nxt);
        const char* nA = has_next ? (GATHER ? (const char*)g.A : (const char*)((TWOPART && nxt.z) ? g.A2 : g.A) + (size_t)nxt.arow * K * 2) : cA; const char* nB = has_next ? (const char*)((TWOPART && nxt.z) ? g.Bt2 : g.Bt) + (size_t)nxt.brow * K * 2 : cB;
        if constexpr (GATHER) { if (has_next) {
#pragma unroll
            for (int h = 0; h < 2; ++h)
#pragma unroll
                for (int i = 0; i < 2; ++i) gAn[h][i] = S.row_off(nxt, h * HALF + RA[i]); } }
#pragma unroll 1
        for (int t = 0; t < nt; t += 2) {
            const bool last = (t == nt - 2);
            const char* a1 = cA + (size_t)(t + 1) * kstep;
            const char* a2 = last ? nA : cA + (size_t)(t + 2) * kstep; const char* b2 = last ? nB : cB + (size_t)(t + 2) * kstep;
            const char* a3 = a2 + kstep; const char* b3 = b2 + kstep;
            PG8_LDB(B0, 0, 0); PG8_LDB(B1, 0, 1); PG8_SCHED; PG8_LDA(At, 0, 0); PG8_STAGEA(PG8_SA(1, 1), a1, 1, false);
            PG8_WAIT_V(8); PG8_WAIT_L(0); PG8_BAR; PG8_MMA(0, 0, At, B0); PG8_MMA(0, 1, At, B1); PG8_BAR; PG8_SCHED;
            PG8_LDA(At, 0, 1); PG8_STAGE(PG8_SB(0, 0), b2, voffB); PG8_STAGE(PG8_SB(0, 1), b2 + hstep, voffB); PG8_STAGEA(PG8_SA(0, 0), a2, 0, last);
            PG8_WAIT_V(8); PG8_WAIT_L(0); PG8_BAR; PG8_MMA(1, 0, At, B0); PG8_MMA(1, 1, At, B1); PG8_BAR; PG8_SCHED;
            PG8_LDB(B0, 1, 0); PG8_LDB(B1, 1, 1); PG8_SCHED; PG8_LDA(At, 1, 0); PG8_STAGEA(PG8_SA(0, 1), a2, 1, last);
            PG8_WAIT_V(8); PG8_WAIT_L(0); PG8_BAR; PG8_MMA(0, 0, At, B0); PG8_MMA(0, 1, At, B1); PG8_BAR; PG8_SCHED;
            PG8_LDA(At, 1, 1); PG8_STAGE(PG8_SB(1, 0), b3, voffB); PG8_STAGE(PG8_SB(1, 1), b3 + hstep, voffB); PG8_STAGEA(PG8_SA(1, 0), a3, 0, last);
            PG8_WAIT_V(8); PG8_WAIT_L(0); PG8_BAR; PG8_MMA(1, 0, At, B0); PG8_MMA(1, 1, At, B1); PG8_BAR; PG8_SCHED;
        }
        if constexpr (FP8) asm volatile("s_nop 15\n\ts_nop 15" ::: "memory");
        if (wr == 0) PG8_BAR;
        const bool keep = E(acc, cur, wr, wc, fr, fq);
        if (!has_next) break;
        if (!(TWOPART && keep))
#pragma unroll
        for (int a = 0; a < 2; ++a)
#pragma unroll
            for (int b = 0; b < 2; ++b)
#pragma unroll
                for (int m = 0; m < 4; ++m)
#pragma unroll
                    for (int n = 0; n < 2; ++n) acc[a][b][m][n] = (f32x4){0.f, 0.f, 0.f, 0.f};
        if constexpr (FP8) {
#pragma unroll
        for (int a = 0; a < 2; ++a)
#pragma unroll
            for (int b = 0; b < 2; ++b) asm volatile("s_nop 3" : "+v"(acc[a][b][0][0]), "+v"(acc[a][b][0][1]), "+v"(acc[a][b][1][0]), "+v"(acc[a][b][1][1]), "+v"(acc[a][b][2][0]), "+v"(acc[a][b][2][1]), "+v"(acc[a][b][3][0]), "+v"(acc[a][b][3][1]));
    }
        cur = nxt; cA = nA; cB = nB; ++ui;
        if constexpr (GATHER) {
#pragma unroll
            for (int h = 0; h < 2; ++h)
#pragma unroll
                for (int i = 0; i < 2; ++i) gAc[h][i] = gAn[h][i];
        }
        if (wr == 1) PG8_BAR;
    }
    PG8_WAIT_V(0);
    PG8_BAR;
#undef PG8_SA
#undef PG8_SB
#undef PG8_STAGE
#undef PG8_STAGEA
#undef PG8_LDA
#undef PG8_LDB
#undef PG8_MMA
#undef PG8_CAT
#undef PG8_LD8
#undef PG8_WAIT_V
#undef PG8_WAIT_L
#undef PG8_BAR
#undef PG8_SCHED
}
}
namespace at {
typedef short bf16x8 __attribute__((ext_vector_type(8)));
typedef short s16x4 __attribute__((ext_vector_type(4)));
typedef float f32x16 __attribute__((ext_vector_type(16)));
typedef unsigned u32x4 __attribute__((ext_vector_type(4)));
typedef __attribute__((address_space(3))) const char* lds_cptr;
typedef short v4i16_t __attribute__((ext_vector_type(4)));
constexpr int SLOT = 32768, L_WSF = 4 * SLOT + 2048;
constexpr float C2 = 0.125f * 1.4426950408889634f;
__device__ __forceinline__ int crow(int r, int hi) { return (r & 3) + 8 * (r >> 2) + 4 * hi; }
__device__ __forceinline__ void glds16(const void* gsrc, unsigned lds_dst) { unsigned keep;
    asm volatile("s_mov_b32 %0, m0\n\ts_mov_b32 m0, %2\n\ts_nop 0\n\tglobal_load_lds_dwordx4 %1, off\n\ts_mov_b32 m0, %0" : "=&s"(keep) : "v"(gsrc), "s"(lds_dst) : "memory"); }
typedef float f32x2_t __attribute__((ext_vector_type(2))); typedef __bf16 bf16x2_t __attribute__((ext_vector_type(2)));
__device__ __forceinline__ unsigned cvtpk(float lo, float hi) { f32x2_t v = {lo, hi}; bf16x2_t b = __builtin_convertvector(v, bf16x2_t); return __builtin_bit_cast(unsigned, b); }
__device__ __forceinline__ s16x4 vtr(lds_cptr p) { return __builtin_bit_cast(s16x4, __builtin_amdgcn_ds_read_tr16_b64_v4i16((__attribute__((address_space(3))) v4i16_t*)p)); }
#define AT_WAIT_BAR(N) asm volatile("s_waitcnt vmcnt(" #N ") lgkmcnt(0)\n\ts_barrier" ::: "memory")

__device__ __forceinline__ void attn_unit(__attribute__((address_space(3))) unsigned char* lds, const bf16_t* QR, const bf16_t* KIMG, const bf16_t* VIMG, bf16_t* YA, const float* subln, float lam, const unsigned* KMAX,
                                          int b, int h, int blk, int tid) {
    typedef __attribute__((address_space(3))) float lds_f;
    asm volatile("" : "+v"(tid));
    const int lane = tid & 63, r32 = lane & 31, hi = lane >> 5; const int w = __builtin_amdgcn_readfirstlane(tid >> 6), m = w & 1, rg = w >> 1;
    const int NT = 2 * blk + 2, bh = b * 4 + h;
    const size_t tokb = (size_t)b * 8192;
    const unsigned lds0 = (unsigned)(size_t)lds;
    const bf16_t* ksrc0 = KIMG + ((size_t)bh * 128 * 16 + 2 * w) * 512 + lane * 8;
    const bf16_t* vsrc0 = VIMG + ((size_t)bh * 128 * 16 + 2 * w) * 512 + lane * 8;
#define AT_DMA(t, slotoff) do { const bf16_t* ks_ = ksrc0 + (size_t)(t) * 8192; const bf16_t* vs_ = vsrc0 + (size_t)(t) * 8192; \
        const unsigned kd_ = (unsigned)__builtin_amdgcn_readfirstlane(lds0 + (unsigned)(slotoff) + (unsigned)w * 2048u); \
        glds16(ks_, kd_); glds16(ks_ + 512, kd_ + 1024u); glds16(vs_, kd_ + 16384u); glds16(vs_ + 512, kd_ + 16384u + 1024u); } while (0)
#define AT_QK(P0, P1, slotoff) do { const lds_cptr kp_ = (lds_cptr)(lds + (slotoff)) + (m * 8 + hi) * 1024 + r32 * 16; \
        _Pragma("unroll") for (int d0 = 0; d0 < 4; ++d0) { const bf16x8 k0 = *(const __attribute__((address_space(3))) bf16x8*)(kp_ + d0 * 2048), k1 = *(const __attribute__((address_space(3))) bf16x8*)(kp_ + d0 * 2048 + 512); \
            P0 = __builtin_amdgcn_mfma_f32_32x32x16_bf16(k0, qr[d0], d0 == 0 ? negm : P0, 0, 0, 0); P1 = __builtin_amdgcn_mfma_f32_32x32x16_bf16(k1, qr[d0], d0 == 0 ? negm : P1, 0, 0, 0); } } while (0)
    bf16x8 qr[4];
    { const bf16_t* qp = QR + ((((size_t)(b * 4 + h) * 128 + blk * 2 + (rg >> 1)) * 16 + m * 8 + hi) * 64 + (rg & 1) * 32 + r32) * 8;
#pragma unroll
      for (int d0 = 0; d0 < 4; ++d0) qr[d0] = *(const bf16x8*)(qp + (size_t)d0 * 1024); }
    AT_DMA(0, 0); AT_DMA(1, SLOT); if (NT > 2) AT_DMA(2, 2 * SLOT);
    f32x16 o[4];
#pragma unroll
    for (int i = 0; i < 4; ++i) o[i] = f32x16{};
    float lsum = 0.f; f32x16 negm;
    float mhat;
    { float qs = 0.f;
#pragma unroll
      for (int d0 = 0; d0 < 4; ++d0)
#pragma unroll
          for (int j = 0; j < 8; ++j) { const float qv = __uint_as_float(((unsigned)(unsigned short)qr[d0][j]) << 16); qs += qv * qv; }
      auto rr = __builtin_amdgcn_permlane32_swap(__float_as_uint(qs), __float_as_uint(qs), false, false); qs = __uint_as_float(rr[0]) + __uint_as_float(rr[1]);
      float k2 = 0.f;
#pragma unroll
      for (int gq = 0; gq < 8; ++gq) k2 += __uint_as_float(KMAX[(bh * 2 + m) * 8 + gq]);
      mhat = 1.01f * sqrtf(qs * k2);
#pragma unroll
      for (int r = 0; r < 16; ++r) negm[r] = -mhat; }
    lds_f* wsf = (lds_f*)(lds + L_WSF) + w * 32;
    f32x16 pA0, pA1, pB0 = f32x16{}, pB1 = f32x16{};
    if (NT > 2) { AT_WAIT_BAR(8); } else { AT_WAIT_BAR(4); }
    AT_QK(pA0, pA1, 0);
    int s0 = 0, s1 = SLOT, s3 = 3 * SLOT;
    const int vlane = ((lane >> 4) & 1) * 32 + (lane & 3) * 8 + (4 * hi + ((lane & 15) >> 2)) * 64;
#define AT_VLOAD(VF, i) do { _Pragma("unroll") for (int k2 = 0; k2 < 2; ++k2) { const int off_ = ((i) >> 1) * 4096 + (((i) & 1) * 2 + k2) * 1024; const s16x4 lo_ = vtr(vp_ + off_), hi_ = vtr(vp_ + off_ + 512); \
        VF[k2] = (bf16x8){lo_[0], lo_[1], lo_[2], lo_[3], hi_[0], hi_[1], hi_[2], hi_[3]}; } } while (0)
#define AT_PVMMA(VF, i) do { _Pragma("unroll") for (int k2 = 0; k2 < 2; ++k2) o[(i) >> 1] = __builtin_amdgcn_mfma_f32_32x32x16_bf16(pa[k2], VF[k2], o[(i) >> 1], 0, 0, 0); } while (0)
#define AT_SB() __builtin_amdgcn_sched_barrier(0)
#define AT_STEP(PC0, PC1, PN0, PN1, DOQK, DOSM) do { AT_SB(); \
        bf16x8 kf[4]; const lds_cptr kp_ = (lds_cptr)(lds + s1) + (m * 8 + hi) * 1024 + r32 * 16; \
        if (DOQK) { _Pragma("unroll") for (int d0 = 0; d0 < 2; ++d0) { kf[2 * d0] = *(const __attribute__((address_space(3))) bf16x8*)(kp_ + d0 * 2048); kf[2 * d0 + 1] = *(const __attribute__((address_space(3))) bf16x8*)(kp_ + d0 * 2048 + 512); } } \
        const lds_cptr vp_ = (lds_cptr)(lds + s0 + 16384) + vlane; bf16x8 vfa[2], vfb[2]; \
        if (DOSM) AT_VLOAD(vfa, 0); \
        if (DOQK) { \
            PN0 = __builtin_amdgcn_mfma_f32_32x32x16_bf16(kf[0], qr[0], negm, 0, 0, 0); PN1 = __builtin_amdgcn_mfma_f32_32x32x16_bf16(kf[1], qr[0], negm, 0, 0, 0); \
            PN0 = __builtin_amdgcn_mfma_f32_32x32x16_bf16(kf[2], qr[1], PN0, 0, 0, 0); PN1 = __builtin_amdgcn_mfma_f32_32x32x16_bf16(kf[3], qr[1], PN1, 0, 0, 0); \
            _Pragma("unroll") for (int d0 = 0; d0 < 2; ++d0) { kf[2 * d0] = *(const __attribute__((address_space(3))) bf16x8*)(kp_ + (d0 + 2) * 2048); kf[2 * d0 + 1] = *(const __attribute__((address_space(3))) bf16x8*)(kp_ + (d0 + 2) * 2048 + 512); } \
            PN0 = __builtin_amdgcn_mfma_f32_32x32x16_bf16(kf[0], qr[2], PN0, 0, 0, 0); PN1 = __builtin_amdgcn_mfma_f32_32x32x16_bf16(kf[1], qr[2], PN1, 0, 0, 0); \
            PN0 = __builtin_amdgcn_mfma_f32_32x32x16_bf16(kf[2], qr[3], PN0, 0, 0, 0); PN1 = __builtin_amdgcn_mfma_f32_32x32x16_bf16(kf[3], qr[3], PN1, 0, 0, 0); } \
        if (DOSM) { \
            float sacc = 0.f; bf16x8 pa[2]; \
            _Pragma("unroll") for (int r = 0; r < 16; ++r) { PC0[r] = __builtin_amdgcn_exp2f(PC0[r]); sacc += PC0[r]; } \
            pa[0] = __builtin_bit_cast(bf16x8, (u32x4){cvtpk(PC0[0], PC0[1]), cvtpk(PC0[2], PC0[3]), cvtpk(PC0[4], PC0[5]), cvtpk(PC0[6], PC0[7])}); \
            pa[1] = __builtin_bit_cast(bf16x8, (u32x4){cvtpk(PC0[8], PC0[9]), cvtpk(PC0[10], PC0[11]), cvtpk(PC0[12], PC0[13]), cvtpk(PC0[14], PC0[15])}); \
            AT_VLOAD(vfb, 2); AT_PVMMA(vfa, 0); AT_VLOAD(vfa, 4); AT_PVMMA(vfb, 2); AT_VLOAD(vfb, 6); AT_PVMMA(vfa, 4); AT_VLOAD(vfa, 1); AT_PVMMA(vfb, 6); \
            _Pragma("unroll") for (int r = 0; r < 16; ++r) { PC1[r] = __builtin_amdgcn_exp2f(PC1[r]); sacc += PC1[r]; } \
            lsum += sacc; asm volatile("" : "+v"(lsum)); \
            pa[0] = __builtin_bit_cast(bf16x8, (u32x4){cvtpk(PC1[0], PC1[1]), cvtpk(PC1[2], PC1[3]), cvtpk(PC1[4], PC1[5]), cvtpk(PC1[6], PC1[7])}); \
            pa[1] = __builtin_bit_cast(bf16x8, (u32x4){cvtpk(PC1[8], PC1[9]), cvtpk(PC1[10], PC1[11]), cvtpk(PC1[12], PC1[13]), cvtpk(PC1[14], PC1[15])}); \
            AT_VLOAD(vfb, 3); AT_PVMMA(vfa, 1); AT_VLOAD(vfa, 5); AT_PVMMA(vfb, 3); AT_VLOAD(vfb, 7); AT_PVMMA(vfa, 5); AT_PVMMA(vfb, 7); } \
        AT_SB(); \
        s0 = s1; s1 = (s1 == 3 * SLOT) ? 0 : s1 + SLOT; s3 = (s3 == 3 * SLOT) ? 0 : s3 + SLOT; \
    } while (0)
    for (int t = 0; t + 2 < NT; t += 2) {
        AT_WAIT_BAR(4); if (t + 3 < NT) AT_DMA(t + 3, s3);
        AT_STEP(pA0, pA1, pB0, pB1, true, true);
        AT_WAIT_BAR(4); if (t + 4 < NT) AT_DMA(t + 4, s3);
        AT_STEP(pB0, pB1, pA0, pA1, true, true);
    }
    if (rg < 2) {
#pragma unroll
        for (int r = 0; r < 16; ++r) negm[r] = -1e30f; }
    AT_WAIT_BAR(0);
    AT_STEP(pA0, pA1, pB0, pB1, true, true);
    AT_WAIT_BAR(0);
    AT_STEP(pB0, pB1, pA0, pA1, false, true);
    AT_WAIT_BAR(0);
    { auto rr = __builtin_amdgcn_permlane32_swap(__float_as_uint(lsum), __float_as_uint(lsum), false, false); lsum = __uint_as_float(rr[0]) + __uint_as_float(rr[1]); }
    if (hi == 0) wsf[r32] = (m == 0 ? 1.f : -lam) / lsum;
    asm volatile("s_waitcnt lgkmcnt(0)" ::: "memory");
#pragma unroll
    for (int r = 0; r < 16; ++r) { const float fr_ = wsf[crow(r, hi)];
#pragma unroll
        for (int d = 0; d < 4; ++d) o[d][r] *= fr_; }
    AT_WAIT_BAR(0);
    lds_f* X = (lds_f*)lds + rg * 4096;
    if (m == 1) {
#pragma unroll
        for (int d = 0; d < 4; ++d)
#pragma unroll
            for (int r = 0; r < 16; ++r) X[(d * 16 + r) * 64 + lane] = o[d][r];
    }
    AT_WAIT_BAR(0);
    if (m == 0) {
        float ssq[16];
#pragma unroll
        for (int r = 0; r < 16; ++r) { float s = 0.f;
#pragma unroll
            for (int d = 0; d < 4; ++d) { o[d][r] += X[(d * 16 + r) * 64 + lane]; s += o[d][r] * o[d][r]; }
            ssq[r] = s; }
#pragma unroll
        for (int r = 0; r < 16; ++r) { float s = ssq[r];
#pragma unroll
            for (int of = 1; of < 32; of <<= 1) s += __shfl_xor(s, of);
            ssq[r] = rsqrtf(s * (1.f / 128.f) + 1e-6f) * 0.8f; }
        float sw[4];
#pragma unroll
        for (int d = 0; d < 4; ++d) sw[d] = subln[d * 32 + r32];
        bf16_t* yp = YA + (tokb + blk * 128 + rg * 32) * 512 + h * 128 + r32;
#pragma unroll
        for (int r = 0; r < 16; ++r)
#pragma unroll
            for (int d = 0; d < 4; ++d) yp[(size_t)crow(r, hi) * 512 + d * 32] = f2bf(o[d][r] * ssq[r] * sw[d]);
    }
    AT_WAIT_BAR(0);
#undef AT_DMA
#undef AT_QK
#undef AT_STEP
#undef AT_SB
#undef AT_VLOAD
#undef AT_PVMMA
}
}
namespace hg {
using at::bf16x8; using at::s16x4; using at::f32x16; using at::u32x4; using at::lds_cptr; using at::crow; using at::vtr; using at::cvtpk;
typedef __attribute__((address_space(3))) unsigned char lds_u8;
typedef __attribute__((address_space(3))) float lds_f;
typedef __attribute__((address_space(3))) bf16_t lds_h;
__device__ __forceinline__ float sigm(float x) { return __builtin_amdgcn_rcpf(1.f + __expf(-x)); }
__device__ __forceinline__ bf16x8 mkfrag(s16x4 a, s16x4 b) { return (bf16x8){a[0], a[1], a[2], a[3], b[0], b[1], b[2], b[3]}; }
template <int ROWS>
__device__ __forceinline__ void copy_img(lds_u8* lds, int off, const bf16_t* g, size_t gp, int tid) {
#pragma unroll
    for (int i = 0; i < ROWS * 16 / 512; ++i) { const int p = tid + 512 * i, r = p >> 4, q = p & 15;
        const u32x4 v = *(const u32x4*)(g + (size_t)r * gp + q * 8);
        *(__attribute__((address_space(3))) u32x4*)(lds + off + (q >> 2) * (ROWS * 64) + r * 64 + (q & 3) * 16) = v; }
}
__device__ __forceinline__ void copy_raw(lds_u8* lds, int off, const bf16_t* g, size_t gp, int tid) {
#pragma unroll
    for (int i = 0; i < 2; ++i) { const int p = tid + 512 * i, r = p >> 4, q = p & 15;
        const u32x4 v = *(const u32x4*)(g + (size_t)r * gp + q * 8);
        *(__attribute__((address_space(3))) u32x4*)(lds + off + r * 256 + q * 16) = v; }
}
struct ARegs { u32x4 v[2], rf[2]; };
struct CRegs { u32x4 v[2], sp[4], rf[2], rq[2]; };
__device__ __forceinline__ void ld_tile64(u32x4 (&r)[2], const bf16_t* g, size_t gp, int tid) {
#pragma unroll
    for (int i = 0; i < 2; ++i) { const int p = tid + 512 * i; r[i] = *(const u32x4*)(g + (size_t)(p >> 4) * gp + (p & 15) * 8); } }
__device__ __forceinline__ void st_img64(lds_u8* lds, int off, const u32x4 (&r)[2], int tid) {
#pragma unroll
    for (int i = 0; i < 2; ++i) { const int p = tid + 512 * i, rr = p >> 4, q = p & 15; *(__attribute__((address_space(3))) u32x4*)(lds + off + (q >> 2) * 4096 + rr * 64 + (q & 3) * 16) = r[i]; } }
__device__ __forceinline__ void st_raw64(lds_u8* lds, int off, const u32x4 (&r)[2], int tid) {
#pragma unroll
    for (int i = 0; i < 2; ++i) { const int p = tid + 512 * i; *(__attribute__((address_space(3))) u32x4*)(lds + off + (p >> 4) * 256 + (p & 15) * 16) = r[i]; } }
__device__ __forceinline__ void hgA_load(ARegs& R, const bf16_t* PROJ, int bh, int n, int tid) {
    const size_t tok0 = (size_t)(bh >> 2) * 8192 + n * 64; const int h = bh & 3;
    ld_tile64(R.v, PROJ + tok0 * 5632 + 2560 + h * 128, 5632, tid); ld_tile64(R.rf, PROJ + tok0 * 5632 + 2048 + h * 128, 5632, tid); }
__device__ __forceinline__ void hgC_load(CRegs& R, const bf16_t* PROJ, const bf16_t* SP, int bh, int n, int tid) {
    const size_t tok0 = (size_t)(bh >> 2) * 8192 + n * 64; const int h = bh & 3;
    ld_tile64(R.v, PROJ + tok0 * 5632 + 2560 + h * 128, 5632, tid); ld_tile64(R.rf, PROJ + tok0 * 5632 + 2048 + h * 128, 5632, tid); ld_tile64(R.rq, PROJ + tok0 * 5632 + 1536 + h * 128, 5632, tid);
    const bf16_t* sp = SP + (size_t)(bh * 128 + n) * 16384;
#pragma unroll
    for (int i = 0; i < 4; ++i) { const int p = tid + 512 * i; R.sp[i] = *(const u32x4*)(sp + (size_t)(p >> 4) * 128 + (p & 15) * 8); } }
__device__ __forceinline__ void gates(lds_u8* lds, int psum_off, int rawf_off, float lb, int tid, float (&f)[16], float (&G)[16], float& glast) {
    const int d = tid & 127, part = tid >> 7; lds_f* psum = (lds_f*)(lds + psum_off); const lds_h* rf = (const lds_h*)(lds + rawf_off) + part * 16 * 128 + d;
    float g = 0.f;
#pragma unroll
    for (int i = 0; i < 16; ++i) { const float raw = bf2f(rf[i * 128]); f[i] = lb + (1.f - lb) * sigm(raw); g += __logf(f[i]); G[i] = g; }
    psum[part * 128 + d] = g;
    __syncthreads();
    const float p0 = psum[d], p1 = psum[128 + d], p2 = psum[256 + d], p3 = psum[384 + d];
    const float offs = (part > 0 ? p0 : 0.f) + (part > 1 ? p1 : 0.f) + (part > 2 ? p2 : 0.f);
    glast = (p0 + p1) + (p2 + p3);
#pragma unroll
    for (int i = 0; i < 16; ++i) G[i] += offs;
}
constexpr int A_KD = 0, A_V = 16384, A_PS = 32768, A_RAWF = 36864, A_OUT = 53248;
__device__ __forceinline__ void hgA_unit(lds_u8* lds, ARegs& R, const bf16_t* PROJ, const float* SCAL, bf16_t* DS, float* DEC, int bh, int n, int nbh, int nn, int tid) {
    const int h = bh & 3, b = bh >> 2, lane = tid & 63, r32 = lane & 31, hi = lane >> 5, w = __builtin_amdgcn_readfirstlane(tid >> 6), d = tid & 127, part = tid >> 7;
    const size_t tok0 = (size_t)b * 8192 + n * 64;
    __syncthreads();
    st_img64(lds, A_V, R.v, tid); st_raw64(lds, A_RAWF, R.rf, tid);
    if (nbh >= 0) hgA_load(R, PROJ, nbh, nn, tid);
    __syncthreads();
    float f[16], G[16], glast;
    gates(lds, A_PS, A_RAWF, SCAL[64 + h * 128 + d], tid, f, G, glast);
    lds_h* kd = (lds_h*)(lds + A_KD) + (d >> 5) * 2048 + (d & 31);
#pragma unroll
    for (int i = 0; i < 16; ++i) kd[(part * 16 + i) * 32] = f2bf((1.f - f[i]) * __expf(glast - G[i]));
    if (part == 0) DEC[(size_t)(bh * 128 + n) * 128 + d] = __expf(glast);
    __syncthreads();
    const int dt = w >> 1, vh = w & 1;
    const int lof = ((lane >> 4) & 1) * 32 + (lane & 3) * 8 + (8 * hi + ((lane & 15) >> 2)) * 64;
    const lds_cptr ap = (lds_cptr)(lds + A_KD) + dt * 4096 + lof;
    f32x16 acc[2] = {f32x16{}, f32x16{}};
#pragma unroll
    for (int ks = 0; ks < 4; ++ks) { const bf16x8 af = mkfrag(vtr(ap + ks * 1024), vtr(ap + ks * 1024 + 256));
#pragma unroll
        for (int t = 0; t < 2; ++t) { const lds_cptr bp = (lds_cptr)(lds + A_V) + (2 * vh + t) * 4096 + lof;
            const bf16x8 bfr = mkfrag(vtr(bp + ks * 1024), vtr(bp + ks * 1024 + 256));
            acc[t] = __builtin_amdgcn_mfma_f32_32x32x16_bf16(af, bfr, acc[t], 0, 0, 0); } }
    lds_h* ot = (lds_h*)(lds + A_OUT) + (dt * 32) * 128 + vh * 64 + r32;
#pragma unroll
    for (int t = 0; t < 2; ++t)
#pragma unroll
        for (int r = 0; r < 16; ++r) ot[crow(r, hi) * 128 + t * 32] = f2bf(acc[t][r]);
    __syncthreads();
    bf16_t* dst = DS + (size_t)(bh * 128 + n) * 16384;
#pragma unroll
    for (int i = 0; i < 4; ++i) { const int p = tid + 512 * i; *(u32x4*)(dst + p * 8) = *(const __attribute__((address_space(3))) u32x4*)(lds + A_OUT + p * 16); }
}
constexpr int C_QT = 0, C_KT = 16384, C_V = 32768, C_SP = 49152, C_PS = 81920, C_RAWF = 86016, C_RAWQ = 102400, C_OT = 86016;
__device__ __forceinline__ void hgC_unit(lds_u8* lds, CRegs& R, const bf16_t* PROJ, const float* SCAL, const bf16_t* SP, const float* hgnorm, bf16_t* YB, int bh, int n, int nbh, int nn, int tid) {
    const int h = bh & 3, b = bh >> 2, lane = tid & 63, r32 = lane & 31, hi = lane >> 5, w = __builtin_amdgcn_readfirstlane(tid >> 6), d = tid & 127, part = tid >> 7;
    const size_t tok0 = (size_t)b * 8192 + n * 64;
    __syncthreads();
    st_img64(lds, C_V, R.v, tid); st_raw64(lds, C_RAWF, R.rf, tid); st_raw64(lds, C_RAWQ, R.rq, tid);
#pragma unroll
    for (int i = 0; i < 4; ++i) { const int p = tid + 512 * i, rr = p >> 4, q = p & 15; *(__attribute__((address_space(3))) u32x4*)(lds + C_SP + (q >> 2) * 8192 + rr * 64 + (q & 3) * 16) = R.sp[i]; }
    if (nbh >= 0) hgC_load(R, PROJ, SP, nbh, nn, tid);
    __syncthreads();
    { float f[16], G[16], glast;
      gates(lds, C_PS, C_RAWF, SCAL[64 + h * 128 + d], tid, f, G, glast);
      const lds_h* rq = (const lds_h*)(lds + C_RAWQ) + part * 16 * 128 + d;
      lds_h* qt = (lds_h*)(lds + C_QT) + (d >> 3) * 512 + (d & 7) + part * 16 * 8; lds_h* kt = (lds_h*)(lds + C_KT) + (d >> 3) * 512 + (d & 7) + part * 16 * 8;
#pragma unroll
      for (int i = 0; i < 16; ++i) { const float q = bf2f(rq[i * 128]); const float eg = __expf(G[i]);
          qt[i * 8] = f2bf(q * sigm(q) * eg); kt[i * 8] = f2bf((1.f - f[i]) * __builtin_amdgcn_rcpf(eg)); } }
    __syncthreads();
    const int ct = w & 1, vb = w >> 1;
    bf16x8 qf[8];
    { const lds_cptr qp = (lds_cptr)(lds + C_QT) + hi * 1024 + (32 * ct + r32) * 16;
#pragma unroll
      for (int ks = 0; ks < 8; ++ks) qf[ks] = *(const __attribute__((address_space(3))) bf16x8*)(qp + ks * 2048); }
    f32x16 o = f32x16{};
#pragma unroll
    for (int sh = 0; sh < 2; ++sh) { if (sh <= ct) {
        const lds_cptr kp = (lds_cptr)(lds + C_KT) + hi * 1024 + (32 * sh + r32) * 16;
        f32x16 p = f32x16{};
#pragma unroll
        for (int ks = 0; ks < 8; ++ks) { const bf16x8 kf = *(const __attribute__((address_space(3))) bf16x8*)(kp + ks * 2048); p = __builtin_amdgcn_mfma_f32_32x32x16_bf16(kf, qf[ks], p, 0, 0, 0); }
        const int cc = 32 * ct + r32;
#pragma unroll
        for (int r = 0; r < 16; ++r) { const int s = 32 * sh + crow(r, hi); if (s > cc) p[r] = 0.f; }
        const bf16x8 pa0 = __builtin_bit_cast(bf16x8, (u32x4){cvtpk(p[0], p[1]), cvtpk(p[2], p[3]), cvtpk(p[4], p[5]), cvtpk(p[6], p[7])});
        const bf16x8 pa1 = __builtin_bit_cast(bf16x8, (u32x4){cvtpk(p[8], p[9]), cvtpk(p[10], p[11]), cvtpk(p[12], p[13]), cvtpk(p[14], p[15])});
        const lds_cptr vp = (lds_cptr)(lds + C_V) + vb * 4096 + ((lane >> 4) & 1) * 32 + (lane & 3) * 8 + (4 * hi + ((lane & 15) >> 2)) * 64 + sh * 2048;
        o = __builtin_amdgcn_mfma_f32_32x32x16_bf16(pa0, mkfrag(vtr(vp), vtr(vp + 512)), o, 0, 0, 0);
        o = __builtin_amdgcn_mfma_f32_32x32x16_bf16(pa1, mkfrag(vtr(vp + 1024), vtr(vp + 1024 + 512)), o, 0, 0, 0); } }
    { const lds_cptr sp = (lds_cptr)(lds + C_SP) + vb * 8192 + ((lane >> 4) & 1) * 32 + (lane & 3) * 8 + (8 * hi + ((lane & 15) >> 2)) * 64;
#pragma unroll
      for (int ks = 0; ks < 8; ++ks) o = __builtin_amdgcn_mfma_f32_32x32x16_bf16(qf[ks], mkfrag(vtr(sp + ks * 1024), vtr(sp + ks * 1024 + 256)), o, 0, 0, 0); }
    { lds_f* ot = (lds_f*)(lds + C_OT) + (32 * ct) * 128 + 32 * vb + r32;
#pragma unroll
      for (int r = 0; r < 16; ++r) ot[crow(r, hi) * 128] = o[r]; }
    __syncthreads();
    { const int c = tid >> 3, sg = tid & 7; const __attribute__((address_space(3))) at::u32x4* orow = (const __attribute__((address_space(3))) at::u32x4*)(lds + C_OT + c * 512 + sg * 64);
      float ov[16]; float ss = 0.f;
#pragma unroll
      for (int q = 0; q < 4; ++q) { const at::u32x4 t4 = orow[q]; ov[4 * q] = __uint_as_float(t4.x); ov[4 * q + 1] = __uint_as_float(t4.y); ov[4 * q + 2] = __uint_as_float(t4.z); ov[4 * q + 3] = __uint_as_float(t4.w); }
#pragma unroll
      for (int q = 0; q < 16; ++q) ss += ov[q] * ov[q];
      ss += __shfl_xor(ss, 1); ss += __shfl_xor(ss, 2); ss += __shfl_xor(ss, 4);
      const float rstd = rsqrtf(ss * (1.f / 128.f) + 1e-6f);
      const bf16_t* gp = PROJ + (tok0 + c) * 5632 + 3072 + h * 128 + sg * 16; const u32x4 g0 = *(const u32x4*)gp, g1 = *(const u32x4*)(gp + 8);
      const unsigned gw[8] = {g0.x, g0.y, g0.z, g0.w, g1.x, g1.y, g1.z, g1.w}; unsigned ow[8];
#pragma unroll
      for (int q = 0; q < 8; ++q) { const float ga = __uint_as_float(gw[q] << 16), gb = __uint_as_float(gw[q] & 0xffff0000u);
          const float ra = ov[2 * q] * rstd * hgnorm[sg * 16 + 2 * q] * (ga * sigm(ga)), rb = ov[2 * q + 1] * rstd * hgnorm[sg * 16 + 2 * q + 1] * (gb * sigm(gb));
          ow[q] = cvtpk(ra, rb); }
      bf16_t* dst = YB + (tok0 + c) * 512 + h * 128 + sg * 16; *(u32x4*)dst = (u32x4){ow[0], ow[1], ow[2], ow[3]}; *(u32x4*)(dst + 8) = (u32x4){ow[4], ow[5], ow[6], ow[7]}; }
}
}
namespace mk {
using pg8::f32x4; using pg8::u32x4; using pg8::u32x2; using pg8::Unit;
constexpr int NWAVES = 8, NTHR = 512;
constexpr int RING_BYTES = 131072, LDSCTL_OFF = RING_BYTES, LDS_BYTES = 147456;
constexpr int LW_BAR = 0, LW_TPRE = 16  , LW_CNT = 64  , LW_MISC = 128;
enum Phase { PH_PRO = 0, PH_H1, PH_G1, PH_ROPE_HGA, PH_ATT_SCAN, PH_HGC, PH_G2A, PH_G2B, PH_G3, PH_TOK, PH_G4, PH_G5, PH_FIN, PH_N };

struct Args {
    const float* in[25]; float* out; unsigned char* ws; int ph_lo, ph_hi, li, pad;
};

__device__ __forceinline__ float wave_sum(float v) {
#pragma unroll
    for (int o = 1; o < 64; o <<= 1) v += __shfl_xor(v, o);
    return v;
}
__device__ __forceinline__ float sigm(float x) { return __builtin_amdgcn_rcpf(1.f + __expf(-x)); }
__device__ __forceinline__ unsigned pk2(float lo, float hi) { return at::cvtpk(lo, hi); }

__device__ __forceinline__ unsigned pk4_fp8(float a, float b, float c, float d) { unsigned w = __builtin_amdgcn_cvt_pk_fp8_f32(a, b, 0u, false); return __builtin_amdgcn_cvt_pk_fp8_f32(c, d, w, true); }
constexpr float S8_W = 64.f, S8_H = 4.f, S8_A = 4.f, S8_Y = 4.f;
struct EpiBf16 {
    static constexpr bool PERM = true;
    bf16_t* O; int ldc;
    __device__ __forceinline__ bool operator()(f32x4 (&acc)[2][2][4][2], const Unit& u, int wr, int wc, int fr, int fq) const {
        const int row0 = u.pm * 256 + wr * 64 + fr, col0 = u.pn * 256 + wc * 32 + 8 * fq;
#pragma unroll
        for (int ai = 0; ai < 2; ++ai)
#pragma unroll
            for (int m = 0; m < 4; ++m) { bf16_t* rowp = O + (size_t)(row0 + ai * 128 + m * 16) * ldc + col0;
#pragma unroll
                for (int bj = 0; bj < 2; ++bj) { const f32x4 v0 = acc[ai][bj][m][0], v1 = acc[ai][bj][m][1]; u32x4 w; w.x = pk2(v0[0], v0[1]); w.y = pk2(v0[2], v0[3]); w.z = pk2(v1[0], v1[1]); w.w = pk2(v1[2], v1[3]);
                    *(u32x4*)(rowp + bj * 128) = w; } }
        return false;
    }
};
struct EpiProj {
    static constexpr bool PERM = true;
    bf16_t* O; const float* ropec; const float* ropes; bf16_t* qimg; bf16_t* kimg; bf16_t* vimg; unsigned* kmaxp;
    __device__ __forceinline__ bool operator()(f32x4 (&acc)[2][2][4][2], const Unit& u, int wr, int wc, int fr, int fq) const {
        const int row0 = u.pm * 256 + wr * 64 + fr;
        if (u.pn >= 6) { const int col0 = u.pn * 256 + wc * 32 + 8 * fq;
#pragma unroll
            for (int ai = 0; ai < 2; ++ai)
#pragma unroll
                for (int m = 0; m < 4; ++m) { bf16_t* rowp = O + (size_t)(row0 + ai * 128 + m * 16) * 5632 + col0;
#pragma unroll
                    for (int bj = 0; bj < 2; ++bj) { const f32x4 v0 = acc[ai][bj][m][0], v1 = acc[ai][bj][m][1]; *(u32x4*)(rowp + bj * 128) = (u32x4){pk2(v0[0], v0[1]), pk2(v0[2], v0[3]), pk2(v1[0], v1[1]), pk2(v1[2], v1[3])}; } }
            return false; }
        const int b = u.pm >> 5, hb = 2 * (u.pn & 1);
        if (u.pn >= 4) {
#pragma unroll
            for (int ai = 0; ai < 2; ++ai)
#pragma unroll
                for (int m = 0; m < 4; ++m) { const int s = (row0 + ai * 128 + m * 16) & 8191, tile = s >> 6, key = s & 63;
#pragma unroll
                    for (int bj = 0; bj < 2; ++bj) { const f32x4 v0 = acc[ai][bj][m][0], v1 = acc[ai][bj][m][1];
                        *(u32x4*)(vimg + ((((size_t)(b * 4 + hb + bj) * 128 + tile) * 4 + wc) * 64 + key) * 32 + 8 * fq) = (u32x4){pk2(v0[0], v0[1]), pk2(v0[2], v0[3]), pk2(v1[0], v1[1]), pk2(v1[2], v1[3])}; } }
            return false; }
        const bool isk = u.pn >= 2; const int mm = wc >> 1, w = wc & 1, d0 = 16 * w + 4 * fq; const float sc = isk ? 1.f : at::C2;
        bf16_t* img = isk ? kimg : qimg; float nmax[2] = {0.f, 0.f};
#pragma unroll
        for (int ai = 0; ai < 2; ++ai)
#pragma unroll
            for (int m = 0; m < 4; ++m) { const int s = (row0 + ai * 128 + m * 16) & 8191, tile = s >> 6, key = s & 63;
                const f32x4 cs = *(const f32x4*)(ropec + s * 32 + d0), sn = *(const f32x4*)(ropes + s * 32 + d0);
#pragma unroll
                for (int bj = 0; bj < 2; ++bj) { const f32x4 x1 = acc[ai][bj][m][0], x2 = acc[ai][bj][m][1]; const f32x4 o1 = (x1 * cs - x2 * sn) * sc, o2 = (x2 * cs + x1 * sn) * sc;
                    bf16_t* dst = img + ((((size_t)(b * 4 + hb + bj) * 128 + tile) * 16 + mm * 8 + (d0 >> 3)) * 64 + key) * 8 + (d0 & 7);
                    *(u32x2*)dst = (u32x2){pk2(o1[0], o1[1]), pk2(o1[2], o1[3])}; *(u32x2*)(dst + 4 * 512) = (u32x2){pk2(o2[0], o2[1]), pk2(o2[2], o2[3])};
                    if (isk) { const float ss = (o1[0] * o1[0] + o1[1] * o1[1]) + (o1[2] * o1[2] + o1[3] * o1[3]) + (o2[0] * o2[0] + o2[1] * o2[1]) + (o2[2] * o2[2] + o2[3] * o2[3]); nmax[bj] = fmaxf(nmax[bj], ss); } } }
        if (isk) {
#pragma unroll
            for (int bj = 0; bj < 2; ++bj) { float mx = nmax[bj];
#pragma unroll
                for (int of = 1; of < 16; of <<= 1) mx = fmaxf(mx, __shfl_xor(mx, of));
                if (fr == 0) atomicMax(kmaxp + (((b * 4 + hb + bj) * 2 + mm) * 8 + w * 4 + fq), __float_as_uint(mx)); } }
        return false;
    }
};
struct EpiF32 {
    static constexpr bool PERM = false;
    float* O; int ldc;
    __device__ __forceinline__ bool operator()(f32x4 (&acc)[2][2][4][2], const Unit& u, int wr, int wc, int fr, int fq) const {
        const int row0 = u.pm * 256 + wr * 64 + fr, col0 = u.pn * 256 + wc * 32 + 4 * fq;
#pragma unroll
        for (int ai = 0; ai < 2; ++ai)
#pragma unroll
            for (int m = 0; m < 4; ++m) { float* rowp = O + (size_t)(row0 + ai * 128 + m * 16) * ldc + col0;
#pragma unroll
                for (int bj = 0; bj < 2; ++bj)
#pragma unroll
                    for (int n = 0; n < 2; ++n) *(f32x4*)(rowp + bj * 128 + n * 16) = acc[ai][bj][m][n]; }
        return false;
    }
};
struct EpiBranch2 {
    static constexpr bool PERM = true;
    const bf16_t* proj; bf16_t* merged;
    __device__ __forceinline__ bool operator()(f32x4 (&acc)[2][2][4][2], const Unit& u, int wr, int wc, int fr, int fq) const {
        const int row0 = u.pm * 256 + wr * 64 + fr, col0 = u.pn * 256 + wc * 32 + 8 * fq; const bool first = (u.z == 0);
#pragma unroll
        for (int ai = 0; ai < 2; ++ai)
#pragma unroll
            for (int m = 0; m < 4; ++m) { const size_t row = (size_t)(row0 + ai * 128 + m * 16);
#pragma unroll
                for (int bj = 0; bj < 2; ++bj) { const int col = col0 + bj * 128;
                    const u32x4 gb = *(const u32x4*)(proj + row * 5632 + 4608 + col); const unsigned gbw[4] = {gb.x, gb.y, gb.z, gb.w}; float eb[8];
#pragma unroll
                    for (int q = 0; q < 4; ++q) { eb[2 * q] = __expf(-__uint_as_float(gbw[q] << 16)); eb[2 * q + 1] = __expf(-__uint_as_float(gbw[q] & 0xffff0000u)); }
                    if (first) { const u32x4 ga = *(const u32x4*)(proj + row * 5632 + 3584 + col); const unsigned gaw[4] = {ga.x, ga.y, ga.z, ga.w};
#pragma unroll
                        for (int q = 0; q < 4; ++q) { const float ea0 = __expf(-__uint_as_float(gaw[q] << 16)), ea1 = __expf(-__uint_as_float(gaw[q] & 0xffff0000u));
                            acc[ai][bj][m][q >> 1][(2 * q) & 3] *= (1.f + eb[2 * q]) * __builtin_amdgcn_rcpf(1.f + ea0); acc[ai][bj][m][q >> 1][(2 * q + 1) & 3] *= (1.f + eb[2 * q + 1]) * __builtin_amdgcn_rcpf(1.f + ea1); } }
                    else { unsigned w[4];
#pragma unroll
                        for (int q = 0; q < 4; ++q) w[q] = pk2(acc[ai][bj][m][q >> 1][(2 * q) & 3] * __builtin_amdgcn_rcpf(1.f + eb[2 * q]), acc[ai][bj][m][q >> 1][(2 * q + 1) & 3] * __builtin_amdgcn_rcpf(1.f + eb[2 * q + 1]));
                        *(u32x4*)(merged + row * 1024 + col) = (u32x4){w[0], w[1], w[2], w[3]}; } } }
        return first;
    }
};
struct EpiGateUp {
    static constexpr bool PERM = true;
    const float* bgu; unsigned char* act;
    __device__ __forceinline__ bool operator()(f32x4 (&acc)[2][2][4][2], const Unit& u, int wr, int wc, int fr, int fq) const {
        const int e = u.z, colA = u.pn * 128 + wc * 32 + 8 * fq;
        constexpr float DQ = 1.f / (S8_W * S8_H);
        f32x4 bg[2], bu[2];
#pragma unroll
        for (int n = 0; n < 2; ++n) { bg[n] = *(const f32x4*)(bgu + e * 2048 + colA + 4 * n); bu[n] = *(const f32x4*)(bgu + e * 2048 + 1024 + colA + 4 * n); }
#pragma unroll
        for (int ai = 0; ai < 2; ++ai)
#pragma unroll
            for (int m = 0; m < 4; ++m) { const size_t slot = (size_t)(u.arow + ai * 128 + wr * 64 + m * 16 + fr); unsigned w[2];
#pragma unroll
                for (int n = 0; n < 2; ++n) { float r[4];
#pragma unroll
                    for (int j = 0; j < 4; ++j) { float gg = acc[ai][0][m][n][j] * DQ + bg[n][j], uu = acc[ai][1][m][n][j] * DQ + bu[n][j]; gg = fminf(gg, 7.f); uu = fminf(fmaxf(uu, -7.f), 7.f); r[j] = (uu + 1.f) * gg * sigm(1.702f * gg) * S8_A; }
                    w[n] = pk4_fp8(r[0], r[1], r[2], r[3]); }
                *(u32x2*)(act + slot * 1024 + colA) = (u32x2){w[0], w[1]}; }
        return false;
    }
};
struct EpiDown {
    static constexpr bool PERM = true;
    const float* bd; const int* list; unsigned char* ym; const LAS int* cnt;
    __device__ __forceinline__ bool operator()(f32x4 (&acc)[2][2][4][2], const Unit& u, int wr, int wc, int fr, int fq) const {
        const int e = u.z, nvalid = cnt[e] - u.pm * 256, col0 = u.pn * 256 + wc * 32 + 8 * fq;
        constexpr float DQ = S8_Y / (S8_W * S8_A);
        f32x4 bv[2][2];
#pragma unroll
        for (int bj = 0; bj < 2; ++bj)
#pragma unroll
            for (int n = 0; n < 2; ++n) bv[bj][n] = *(const f32x4*)(bd + e * 1024 + col0 + bj * 128 + 4 * n) * S8_Y;
#pragma unroll
        for (int ai = 0; ai < 2; ++ai)
#pragma unroll
            for (int m = 0; m < 4; ++m) { const int r = ai * 128 + wr * 64 + m * 16 + fr;
                if (r < nvalid) { const int a = list[(size_t)e * 32768 + u.pm * 256 + r]; unsigned char* rowp = ym + (size_t)a * 1024 + col0;
#pragma unroll
                    for (int bj = 0; bj < 2; ++bj) { const f32x4 v0 = acc[ai][bj][m][0] * DQ + bv[bj][0], v1 = acc[ai][bj][m][1] * DQ + bv[bj][1];
                        *(u32x2*)(rowp + bj * 128) = (u32x2){pk4_fp8(v0[0], v0[1], v0[2], v0[3]), pk4_fp8(v1[0], v1[1], v1[2], v1[3])}; } } }
        return false;
    }
};
struct MoeOrder {
    const LAS int* tpre; const LAS int* cnt; const int* list; int nN, G, c, rowpitch  , brows  ; LAS int* idxbuf  ;
    __device__ bool next(int i, Unit& u) const {
        const int nwg = tpre[32] * nN; const long L = (long)i * G + c; if (L >= nwg) return false;
        int wgid = (int)L; { const int q = nwg / 8, r = nwg % 8, xcd = wgid % 8, off = wgid / 8; wgid = (xcd < r ? xcd * (q + 1) : r * (q + 1) + (xcd - r) * q) + off; }
        int e = 0;
#pragma unroll 1
        for (int s = 16; s > 0; s >>= 1) { if (tpre[e + s] * nN <= wgid) e += s; }
        const int w = wgid - tpre[e] * nN, nM = tpre[e + 1] - tpre[e];
        const int nig = 8 * nN, gid = w / nig, fm = gid * 8, gsz = (nM - fm) < 8 ? (nM - fm) : 8;
        u.pm = fm + ((w % nig) % gsz); u.pn = (w % nig) / gsz; u.z = e; u.arow = (tpre[e] + u.pm) * 256; u.brow = e * brows + u.pn * 256; return true;
    }
    __device__ __forceinline__ unsigned row_off(const Unit& u, int r) const {
        const int lr = u.pm * 256 + r; const int a = list[(size_t)u.z * 32768 + (lr < cnt[u.z] ? lr : 0)]; return (unsigned)(a >> 2) * (unsigned)rowpitch;
    }
    __device__ __forceinline__ const int* idx_src(const Unit& u) const { return list + (size_t)u.z * 32768 + u.pm * 256; }
    __device__ __forceinline__ unsigned off_from_idx(int a) const { unsigned tk = (unsigned)a >> 2; tk = tk < (unsigned)T ? tk : (unsigned)(T - 1); return tk * (unsigned)rowpitch; }
};

__device__ __forceinline__ int rope_pos(int d) { const int e = d & 31; return 32 * (e >> 4) + 8 * ((e >> 2) & 3) + 4 * (d >> 5) + (e & 3); }
template <bool RPERM = false>
__device__ __forceinline__ void transpose_item(const float* W, int K, int N, bf16_t* WT, int k0, int n0, int dst_row0, LAS unsigned* scr, int lane) {
    const int cg = lane & 15, rp = lane >> 4;
    const float* src = W + (size_t)(k0 + 2 * rp) * N + n0 + 4 * cg;
#pragma unroll
    for (int q = 0; q < 8; ++q) { const f32x4 a = __builtin_nontemporal_load((const f32x4*)(src + (size_t)(8 * q) * N)), b = __builtin_nontemporal_load((const f32x4*)(src + (size_t)(8 * q + 1) * N));
#pragma unroll
        for (int c = 0; c < 4; ++c) scr[(4 * cg + c) * 33 + 4 * q + rp] = pk2(a[c], b[c]); }
    asm volatile("s_waitcnt lgkmcnt(0)" ::: "memory");
    const int nl = lane >> 3, wq = lane & 7;
#pragma unroll
    for (int i = 0; i < 8; ++i) { const LAS unsigned* s = scr + (8 * i + nl) * 33 + 4 * wq; u32x4 o; o.x = s[0]; o.y = s[1]; o.z = s[2]; o.w = s[3];
        *(u32x4*)(WT + (size_t)(dst_row0 + (RPERM ? rope_pos(8 * i + nl) : 8 * i + nl)) * K + k0 + 8 * wq) = o; }
    asm volatile("s_waitcnt lgkmcnt(0)" ::: "memory");
}
__device__ __forceinline__ void transpose_item8(const float* W, int K, int N, unsigned char* WT, int k0, int n0, int dst_row0, LAS unsigned* scr, int lane) {
    const int cg = lane & 15, rp = lane >> 4;
    const float* src = W + (size_t)(k0 + 4 * rp) * N + n0 + 4 * cg;
#pragma unroll
    for (int q = 0; q < 4; ++q) { f32x4 a[4];
#pragma unroll
        for (int r = 0; r < 4; ++r) a[r] = __builtin_nontemporal_load((const f32x4*)(src + (size_t)(16 * q + r) * N));
#pragma unroll
        for (int c = 0; c < 4; ++c) scr[(4 * cg + c) * 17 + 4 * q + rp] = pk4_fp8(a[0][c] * S8_W, a[1][c] * S8_W, a[2][c] * S8_W, a[3][c] * S8_W); }
    asm volatile("s_waitcnt lgkmcnt(0)" ::: "memory");
    const int nl = lane >> 2, wq = lane & 3;
#pragma unroll
    for (int i = 0; i < 4; ++i) { const LAS unsigned* s = scr + (16 * i + nl) * 17 + 4 * wq; u32x4 o; o.x = s[0]; o.y = s[1]; o.z = s[2]; o.w = s[3];
        *(u32x4*)(WT + (size_t)(dst_row0 + 16 * i + nl) * K + k0 + 16 * wq) = o; }
    asm volatile("s_waitcnt lgkmcnt(0)" ::: "memory");
}
template <bool GU>
__device__ __forceinline__ void transpose_matrix8(const float* W, int K, int N, unsigned char* WT, LAS unsigned* scr, int lane, int gw, int NGW, int& itbase) {
    const int nblk = N / 64, nitems = (K / 64) * nblk;
    int first = (gw - itbase) % NGW; if (first < 0) first += NGW;
    for (int it = first; it < nitems; it += NGW) { const int kb = it / nblk, nb = it % nblk, n0 = nb * 64;
        int dst = n0; if (GU) { const int nn = n0 & 1023; dst = (nn >> 7) * 256 + (n0 >> 10) * 128 + (nn & 127); }
        transpose_item8(W, K, N, WT, kb * 64, n0, dst, scr, lane); }
    itbase += nitems;
}
template <bool GU, bool QK = false>
__device__ __forceinline__ void transpose_matrix(const float* W, int K, int N, bf16_t* WT, LAS unsigned* scr, int lane, int gw, int NGW, int& itbase) {
    const int nblk = N / 64, nitems = (K / 64) * nblk;
    int first = (gw - itbase) % NGW; if (first < 0) first += NGW;
    for (int it = first; it < nitems; it += NGW) { const int kb = it / nblk, nb = it % nblk, n0 = nb * 64;
        int dst = n0; if (GU) { const int nn = n0 & 1023; dst = (nn >> 7) * 256 + (n0 >> 10) * 128 + (nn & 127); }
        if (QK && n0 < 1024) transpose_item<true>(W, K, N, WT, kb * 64, n0, dst, scr, lane); else transpose_item<false>(W, K, N, WT, kb * 64, n0, dst, scr, lane); }
    itbase += nitems;
}

#define MOD ((float*)(ws + WS_SMALL))
#define SCAL ((float*)(ws + WS_SMALL + 128 * 1024))
#define ROPEC ((float*)(ws + WS_ROPEC))
#define ROPES ((float*)(ws + WS_ROPES))
#define TOPI ((int*)(ws + WS_TOPI))
#define TOPW ((float*)(ws + WS_TOPW))
#define LIST ((int*)(ws + WS_LIST))
#define RWT ((bf16_t*)(ws + WS_RWT))
#define CNT ((int*)(ws + WS_CTL) + CW_CNT)
#define H ((bf16_t*)(ws + WS_H))
#define QR ((bf16_t*)(ws + WS_Y + 64 * MiB))
#define KIMG ((bf16_t*)(ws + WS_Y + 96 * MiB))
#define VIMG ((bf16_t*)(ws + WS_YB))
#define PROJ ((bf16_t*)(ws + WS_PROJ))
#define YA ((bf16_t*)(ws + WS_YA))
#define YB ((bf16_t*)(ws + WS_YB))
#define DS ((bf16_t*)(ws + WS_DS))
#define DEC ((float*)(ws + WS_DEC))
#define MERGED ((bf16_t*)(ws + WS_MERGED))
#define SP ((bf16_t*)(ws + WS_MERGED))
#define Y ((float*)(ws + WS_Y))
#define YH ((bf16_t*)(ws + WS_Y))
#define ACT ((bf16_t*)(ws + WS_ACT))
#define YM ((bf16_t*)(ws + WS_YM))
#define WT_IN ((bf16_t*)(ws + WS_WIN))
#define WT_A ((bf16_t*)(ws + WS_WA))
#define WT_B ((bf16_t*)(ws + WS_WB))
#define WT_O ((bf16_t*)(ws + WS_WO))
#define WT_GU ((bf16_t*)(ws + WS_WGU))
#define WT_GU8 ((unsigned char*)(ws + WS_WGU))
#define WT_D8 ((unsigned char*)(ws + WS_WD))
#define H8 ((unsigned char*)(ws + WS_H))
#define ACT8 ((unsigned char*)(ws + WS_ACT))
#define YM8 ((unsigned char*)(ws + WS_YM))
#define WT_D ((bf16_t*)(ws + WS_WD))
#define PHASE_BEGIN unsigned char* ws = args.ws; asm volatile("" : "+s"(ws)); int tid = threadIdx.x; asm volatile("" : "+v"(tid)); const int lane = tid & 63; (void)lane; const float* x = args.in[0]; float* out = args.out; (void)x; (void)out;
__global__ void __launch_bounds__(NTHR, 2) mega(Args args) {
    extern __shared__ __attribute__((aligned(16))) unsigned char lds_[];
    LAS unsigned char* lds = (LAS unsigned char*)lds_;
    volatile LAS unsigned* LW = (volatile LAS unsigned*)(lds + LDSCTL_OFF);
    const int tid = threadIdx.x, lane = tid & 63, wave = __builtin_amdgcn_readfirstlane(tid >> 6);
    const int G = gridDim.x; const int bx = blockIdx.x; const int vcu = (G % 8 == 0) ? (bx % 8) * (G / 8) + bx / 8 : bx;
    const int gw = vcu * NWAVES + wave, NGW = G * NWAVES;
    unsigned* CTL = (unsigned*)(args.ws + WS_CTL);
    for (int u = tid; u < (LDS_BYTES - LDSCTL_OFF) / 4; u += NTHR) ((LAS unsigned*)(lds + LDSCTL_OFF))[u] = 0u;
    __syncthreads();
    const int lo = args.ph_lo, hi = args.ph_hi;
    XcdBarrier bar; bar.bar = CTL + CW_BAR + args.li * 4096; bar.x = 0; bar.st = nullptr;
    if (hi - lo > 1) bar = xcd_barrier_post(CTL + CW_BAR + args.li * 4096, LW + LW_BAR);
#ifndef PHMASK
#define PHMASK 0xffff
#endif
#ifndef DUP_PHASE
#define DUP_PHASE -1
#endif
#define IN(k) ((((PHMASK) >> (k)) & 1) && lo <= (k) && (k) < hi)
#define REPS(k) (((k) == DUP_PHASE) ? 2 : 1)
#ifdef PROBE_SPAN
#define STAMP(k) do { if (bx == 0 && threadIdx.x == 0) { const unsigned long long t_ = __builtin_amdgcn_s_memrealtime(); LW[160 + 2 * (k)] = (unsigned)t_; LW[161 + 2 * (k)] = (unsigned)(t_ >> 32); } } while (0)
#else
#define STAMP(k) do { } while (0)
#endif
#define SEAM(k) do { if (IN(k) && IN((k) + 1)) xcd_barrier(bar); STAMP((k) + 1); } while (0)

    STAMP(0);
    if (IN(PH_PRO)) for (int rep_ = 0; rep_ < REPS(PH_PRO); ++rep_) {
        PHASE_BEGIN
        __syncthreads();
        const float* c = args.in[1]; const float* w_mod = args.in[2]; const float* b_mod = args.in[3];
        LAS float* cact = (LAS float*)lds; LAS float* red = cact + 4096;
        for (int i = tid; i < 4096; i += NTHR) { const float cv = c[i]; cact[i] = cv / (1.f + expf(-cv)); }
        __syncthreads();
        for (int it = vcu; it < 192; it += G) { const int j0 = it * 32, kq = tid >> 5, col = tid & 31; float acc[4] = {0.f, 0.f, 0.f, 0.f};
            const float* wp = w_mod + (size_t)(kq * 64) * 6144 + j0 + col;
#pragma unroll 1
            for (int k = 0; k < 64; k += 16) { float wv[16];
#pragma unroll
                for (int i = 0; i < 16; ++i) wv[i] = wp[(size_t)(k + i) * 6144];
#pragma unroll
                for (int i = 0; i < 16; ++i) {
#pragma unroll
                    for (int b = 0; b < 4; ++b) acc[b] += cact[b * 1024 + kq * 64 + k + i] * wv[i]; } }
#pragma unroll
            for (int b = 0; b < 4; ++b) red[(kq * 4 + b) * 32 + col] = acc[b];
            __syncthreads();
            if (tid < 128) { const int b = tid >> 5, cc = tid & 31; float s = 0.f;
#pragma unroll
                for (int q = 0; q < 16; ++q) s += red[(q * 4 + b) * 32 + cc];
                MOD[b * 6144 + j0 + cc] = s + b_mod[j0 + cc]; }
            __syncthreads(); }
        const int gt = vcu * NTHR + tid, NGT = G * NTHR;
        if (gt == 0) { const float* q1 = args.in[7]; const float* k1 = args.in[8]; const float* q2 = args.in[9]; const float* k2 = args.in[10]; float s1 = 0.f, s2 = 0.f;
            for (int i = 0; i < 64; ++i) { s1 += q1[i] * k1[i]; s2 += q2[i] * k2[i]; } SCAL[0] = expf(s1) - expf(s2) + 0.2f; }
        if (gt < 512) { const float* lbl = args.in[12]; SCAL[64 + gt] = 1.f / (1.f + expf(lbl[512 + gt] - lbl[gt])); }
        for (int i = gt; i < 8192 * 32; i += NGT) { const int s = i >> 5, j = i & 31; const float inv = powf(10000.f, -(float)(2 * j) / 64.f); const float ang = (float)s * inv; ROPEC[i] = cosf(ang); ROPES[i] = sinf(ang); }
        for (int i = gt; i < 32768; i += NGT) { const int e = i >> 10, k = i & 1023; const float wv = args.in[19][k * 32 + e]; const bf16_t hb = f2bf(wv); RWT[i] = hb; RWT[32768 + i] = f2bf(wv - bf2f(hb)); }
        LAS unsigned* scr = (LAS unsigned*)(lds + wave * 16384); int itbase = 0;
        transpose_matrix<false, true>(args.in[6], 1024, 5632, WT_IN, scr, lane, gw, NGW, itbase);
        transpose_matrix<false>(args.in[14], 512, 1024, WT_A, scr, lane, gw, NGW, itbase);
        transpose_matrix<false>(args.in[15], 512, 1024, WT_B, scr, lane, gw, NGW, itbase);
        transpose_matrix<false>(args.in[16], 1024, 1024, WT_O, scr, lane, gw, NGW, itbase);
        for (int e = 0; e < 32; ++e) transpose_matrix8<true>(args.in[21] + (size_t)e * 1024 * 2048, 1024, 2048, WT_GU8 + (size_t)e * 2048 * 1024, scr, lane, gw, NGW, itbase);
        for (int e = 0; e < 32; ++e) transpose_matrix8<false>(args.in[23] + (size_t)e * 1024 * 1024, 1024, 1024, WT_D8 + (size_t)e * 1024 * 1024, scr, lane, gw, NGW, itbase);
    }
    SEAM(PH_PRO);
#ifdef EXTRA_BARRIERS
    for (int eb = 0; eb < EXTRA_BARRIERS; ++eb) xcd_barrier(bar);
#endif
    if (IN(PH_H1)) for (int rep_ = 0; rep_ < REPS(PH_H1); ++rep_) {
        PHASE_BEGIN
        const float* w = args.in[4];
        { constexpr int NR_ = 4;
        for (int row0 = gw; row0 < T; row0 += NR_ * NGW) { f32x4 v[NR_][4]; float ss[NR_]; int rows[NR_];
#pragma unroll
            for (int q = 0; q < NR_; ++q) { rows[q] = (row0 + q * NGW < T) ? row0 + q * NGW : row0; const f32x4* xr = (const f32x4*)(x + (size_t)rows[q] * 1024) + lane; ss[q] = 0.f;
#pragma unroll
                for (int j = 0; j < 4; ++j) v[q][j] = xr[64 * j]; }
#pragma unroll
            for (int q = 0; q < NR_; ++q) {
#pragma unroll
                for (int j = 0; j < 4; ++j) ss[q] += (v[q][j][0] * v[q][j][0] + v[q][j][1] * v[q][j][1]) + (v[q][j][2] * v[q][j][2] + v[q][j][3] * v[q][j][3]);
                ss[q] = rsqrtf(wave_sum(ss[q]) * (1.f / 1024.f) + 1e-6f); }
#pragma unroll
            for (int j = 0; j < 4; ++j) { const int col = 4 * lane + 256 * j; const f32x4 wv = *(const f32x4*)(w + col);
#pragma unroll
                for (int q = 0; q < NR_; ++q) { const int b = rows[q] >> 13; const f32x4 sc = *(const f32x4*)(MOD + b * 6144 + 1024 + col), sh = *(const f32x4*)(MOD + b * 6144 + col);
                    const f32x4 h = v[q][j] * ss[q] * wv * (sc + 1.f) + sh; u32x2 o; o.x = pk2(h[0], h[1]); o.y = pk2(h[2], h[3]); *(u32x2*)(H + (size_t)rows[q] * 1024 + col) = o; } } } }
    }
    SEAM(PH_H1);
    if (IN(PH_G1)) for (int rep_ = 0; rep_ < REPS(PH_G1); ++rep_) {
        PHASE_BEGIN
        pg8::Gemm g{H, WT_IN, 1024, nullptr, nullptr}; pg8::DenseOrder S; S.init(T, NC, G, bx);
        EpiProj E{PROJ, ROPEC, ROPES, QR, KIMG, VIMG, (unsigned*)(ws + WS_CTL) + CW_KMAX};
        pg8::gemm_phase<EpiProj, pg8::DenseOrder, false>(lds, g, S, E);
    }
    SEAM(PH_G1);
    if (IN(PH_ROPE_HGA)) for (int rep_ = 0; rep_ < REPS(PH_ROPE_HGA); ++rep_) {
        PHASE_BEGIN
        { hg::ARegs R; if (vcu < 2048) hg::hgA_load(R, PROJ, vcu >> 7, vcu & 127, tid);
          for (int it = vcu; it < 2048; it += G) { const int nx = it + G; hg::hgA_unit(lds, R, PROJ, SCAL, DS, DEC, it >> 7, it & 127, nx < 2048 ? (nx >> 7) : -1, nx & 127, tid); } }
        __syncthreads();
    }
    SEAM(PH_ROPE_HGA);
    if (IN(PH_ATT_SCAN)) for (int rep_ = 0; rep_ < REPS(PH_ATT_SCAN); ++rep_) {
        PHASE_BEGIN
        for (int gid = vcu * NTHR + tid; gid < 16 * 128 * 128; gid += G * NTHR) { const int bh = gid >> 14, d = (gid >> 7) & 127, v = gid & 127; float st = 0.f;
            const bf16_t* __restrict__ src = DS + ((size_t)(bh * 128) * 128 + d) * 128 + v; bf16_t* __restrict__ dst = SP + ((size_t)(bh * 128) * 128 + d) * 128 + v; const float* __restrict__ dc = DEC + (size_t)(bh * 128) * 128 + d;
            for (int n0 = 0; n0 < 128; n0 += 16) { float xv[16], dv[16];
#pragma unroll
                for (int i = 0; i < 16; ++i) { xv[i] = bf2f(src[(size_t)(n0 + i) * 16384]); dv[i] = dc[(n0 + i) * 128]; }
#pragma unroll
                for (int i = 0; i < 16; ++i) { dst[(size_t)(n0 + i) * 16384] = f2bf(st); st = dv[i] * st + xv[i]; } } }
        { const float lam = SCAL[0]; const float* subln = args.in[11];
          for (int it = vcu; it < 1024; it += G) { int bh, blk;
              if (G == 256) { const int i = it >> 8, v = it & 255, s = v & 15; bh = v >> 4; blk = (i == 0) ? 63 - s : (i == 1) ? 32 + s : (i == 2) ? 31 - s : s; }
              else { blk = 63 - (it >> 4); bh = it & 15; }
              at::attn_unit(lds, QR, KIMG, VIMG, YA, subln, lam, (const unsigned*)(ws + WS_CTL) + CW_KMAX, bh >> 2, bh & 3, blk, tid); } }
    }
    SEAM(PH_ATT_SCAN);
    if (IN(PH_HGC)) for (int rep_ = 0; rep_ < REPS(PH_HGC); ++rep_) {
        PHASE_BEGIN
        const float* hgnorm = args.in[13];
        { hg::CRegs R; if (vcu < 2048) hg::hgC_load(R, PROJ, SP, vcu >> 7, vcu & 127, tid);
          for (int it = vcu; it < 2048; it += G) { const int nx = it + G; hg::hgC_unit(lds, R, PROJ, SCAL, SP, hgnorm, YB, it >> 7, it & 127, nx < 2048 ? (nx >> 7) : -1, nx & 127, tid); } }
        __syncthreads();
    }
    SEAM(PH_HGC);
    if (IN(PH_G2A)) for (int rep_ = 0; rep_ < REPS(PH_G2A); ++rep_) {
        PHASE_BEGIN
        pg8::Gemm g{YA, WT_A, 512, YB, WT_B}; pg8::DenseOrder2 S; S.base.init(T, 1024, G, bx);
        EpiBranch2 E{PROJ, MERGED};
        pg8::gemm_phase<EpiBranch2, pg8::DenseOrder2, false, true>(lds, g, S, E);
    }
    SEAM(PH_G2B);
    if (IN(PH_G3)) for (int rep_ = 0; rep_ < REPS(PH_G3); ++rep_) {
        PHASE_BEGIN
        pg8::Gemm g{MERGED, WT_O, 1024, nullptr, nullptr}; pg8::DenseOrder S; S.init(T, 1024, G, bx);
        EpiBf16 E{YH, 1024};
        pg8::gemm_phase<EpiBf16, pg8::DenseOrder, false>(lds, g, S, E);
    }
    SEAM(PH_G3);
    if (IN(PH_TOK)) for (int rep_ = 0; rep_ < REPS(PH_TOK); ++rep_) {
        PHASE_BEGIN
        const float* wpm = args.in[5]; const float* wpf = args.in[17]; const float* rb = args.in[20];
        const int wv_ = __builtin_amdgcn_readfirstlane(tid >> 6), r32 = lane & 31, hi = lane >> 5;
        LAS int* lcnt = (LAS int*)lds; LAS int* lbase = lcnt + 32; LAS int* asg = lcnt + 64;
        LAS float* rstd2 = (LAS float*)(lds + 4096);
        LAS float* XC = (LAS float*)(lds + 8192);
        LAS float* LG = (LAS float*)(lds + 24576);
        LAS float* CM = (LAS float*)(lds + 41984); LAS float* SHV = CM + 1024;
        for (int chunk = vcu; chunk < T / 128; chunk += G) { const int b = chunk >> 6;
            __syncthreads();
            if (tid < 32) lcnt[tid] = 0;
            for (int i = tid; i < 1024; i += NTHR) { CM[i] = wpf[i] * (1.f + MOD[b * 6144 + 4096 + i]); SHV[i] = MOD[b * 6144 + 3072 + i]; }
            __syncthreads();
            { constexpr int NR_ = 4; for (int i = 0; i < 16; i += NR_) { const int rloc = wv_ * 16 + i, row = chunk * 128 + rloc;
                f32x4 v[NR_][4], xv[NR_][4]; float ss[NR_], rs[NR_];
#pragma unroll
                for (int q = 0; q < NR_; ++q) ss[q] = 0.f;
#pragma unroll
                for (int q = 0; q < NR_; ++q) { const u32x2* yr = (const u32x2*)(YH + (size_t)(row + q) * 1024) + lane; const f32x4* xr = (const f32x4*)(x + (size_t)(row + q) * 1024) + lane;
#pragma unroll
                    for (int j = 0; j < 4; ++j) { const u32x2 yw = yr[64 * j]; v[q][j] = (f32x4){__uint_as_float(yw.x << 16), __uint_as_float(yw.x & 0xffff0000u), __uint_as_float(yw.y << 16), __uint_as_float(yw.y & 0xffff0000u)}; xv[q][j] = xr[64 * j]; } }
#pragma unroll
                for (int q = 0; q < NR_; ++q)
#pragma unroll
                    for (int j = 0; j < 4; ++j) ss[q] += (v[q][j][0] * v[q][j][0] + v[q][j][1] * v[q][j][1]) + (v[q][j][2] * v[q][j][2] + v[q][j][3] * v[q][j][3]);
                #pragma unroll
                for (int q = 0; q < NR_; ++q) { rs[q] = rsqrtf(wave_sum(ss[q]) * (1.f / 1024.f) + 1e-6f); ss[q] = 0.f; }
#pragma unroll
                for (int j = 0; j < 4; ++j) { const int col = 4 * lane + 256 * j; const f32x4 g1 = *(const f32x4*)(MOD + b * 6144 + 2048 + col), wv = *(const f32x4*)(wpm + col);
#pragma unroll
                    for (int q = 0; q < NR_; ++q) { v[q][j] = xv[q][j] + g1 * v[q][j] * rs[q] * wv; *(f32x4*)(out + (size_t)(row + q) * 1024 + col) = v[q][j];
                        ss[q] += (v[q][j][0] * v[q][j][0] + v[q][j][1] * v[q][j][1]) + (v[q][j][2] * v[q][j][2] + v[q][j][3] * v[q][j][3]); } }
                #pragma unroll
                for (int q = 0; q < NR_; ++q) { rs[q] = rsqrtf(wave_sum(ss[q]) * (1.f / 1024.f) + 1e-6f); if (lane == 0) rstd2[rloc + q] = rs[q]; }
#pragma unroll
                for (int j = 0; j < 4; ++j) { const int col = 4 * lane + 256 * j; const f32x4 cm = *(const LAS f32x4*)(CM + col), sh = *(const LAS f32x4*)(SHV + col);
#pragma unroll
                    for (int q = 0; q < NR_; ++q) { const f32x4 h = (v[q][j] * rs[q] * cm + sh) * S8_H; *(unsigned*)(H8 + (size_t)(row + q) * 1024 + col) = pk4_fp8(h[0], h[1], h[2], h[3]); } } } }
            asm volatile("s_waitcnt vmcnt(0)" ::: "memory");
            __syncthreads();
            { const int rt = wv_ & 3, kh = wv_ >> 2; const int rloc = 32 * rt + r32; const float rs = rstd2[rloc];
              const float* xrow = out + (size_t)(chunk * 128 + rloc) * 1024 + 512 * kh + 8 * hi; const bf16_t* whi = RWT + (size_t)r32 * 1024 + 512 * kh + 8 * hi; const bf16_t* wlo = whi + 32768;
              const LAS float* cmp = CM + 512 * kh + 8 * hi; const LAS float* shp = SHV + 512 * kh + 8 * hi;
              at::f32x16 acc = at::f32x16{};
#pragma unroll 4
              for (int ks = 0; ks < 32; ++ks) { const f32x4 xa = __builtin_nontemporal_load((const f32x4*)(xrow + 16 * ks)), xb = __builtin_nontemporal_load((const f32x4*)(xrow + 16 * ks + 4));
                  const f32x4 ca = *(const LAS f32x4*)(cmp + 16 * ks), cb = *(const LAS f32x4*)(cmp + 16 * ks + 4), sa = *(const LAS f32x4*)(shp + 16 * ks), sb = *(const LAS f32x4*)(shp + 16 * ks + 4);
                  const f32x4 ha = xa * rs * ca + sa, hb = xb * rs * cb + sb;
                  const unsigned h0 = at::cvtpk(ha[0], ha[1]), h1 = at::cvtpk(ha[2], ha[3]), h2 = at::cvtpk(hb[0], hb[1]), h3 = at::cvtpk(hb[2], hb[3]);
                  const unsigned l0 = at::cvtpk(ha[0] - __uint_as_float(h0 << 16), ha[1] - __uint_as_float(h0 & 0xffff0000u)), l1 = at::cvtpk(ha[2] - __uint_as_float(h1 << 16), ha[3] - __uint_as_float(h1 & 0xffff0000u));
                  const unsigned l2 = at::cvtpk(hb[0] - __uint_as_float(h2 << 16), hb[1] - __uint_as_float(h2 & 0xffff0000u)), l3 = at::cvtpk(hb[2] - __uint_as_float(h3 << 16), hb[3] - __uint_as_float(h3 & 0xffff0000u));
                  const at::bf16x8 ahi = __builtin_bit_cast(at::bf16x8, (u32x4){h0, h1, h2, h3}), alo = __builtin_bit_cast(at::bf16x8, (u32x4){l0, l1, l2, l3});
                  const at::bf16x8 bhi = *(const at::bf16x8*)(whi + 16 * ks), blo = *(const at::bf16x8*)(wlo + 16 * ks);
                  acc = __builtin_amdgcn_mfma_f32_32x32x16_bf16(ahi, bhi, acc, 0, 0, 0); acc = __builtin_amdgcn_mfma_f32_32x32x16_bf16(ahi, blo, acc, 0, 0, 0); acc = __builtin_amdgcn_mfma_f32_32x32x16_bf16(alo, bhi, acc, 0, 0, 0); }
              if (kh == 1) {
#pragma unroll
                  for (int r = 0; r < 16; ++r) XC[(rt * 16 + r) * 64 + lane] = acc[r]; }
              __syncthreads();
              if (kh == 0) { const float bias = rb[r32];
#pragma unroll
                  for (int r = 0; r < 16; ++r) LG[(32 * rt + at::crow(r, hi)) * 33 + r32] = acc[r] + XC[(rt * 16 + r) * 64 + lane] + bias; }
              __syncthreads(); }
            if (tid < 128) { const int rloc = tid, row = chunk * 128 + rloc; float lg[32];
#pragma unroll
                for (int e = 0; e < 32; ++e) lg[e] = LG[rloc * 33 + e];
                int bi[4]; float bv[4];
#pragma unroll
                for (int k = 0; k < 4; ++k) { float best = -3.0e38f; int be = 0;
#pragma unroll
                    for (int e = 0; e < 32; ++e) { bool taken = false;
#pragma unroll
                        for (int q = 0; q < 4; ++q) if (q < k && bi[q] == e) taken = true;
                        if (!taken && lg[e] > best) { best = lg[e]; be = e; } }
                    bi[k] = be; bv[k] = best; }
                const float e1 = expf(bv[1] - bv[0]), e2 = expf(bv[2] - bv[0]), e3 = expf(bv[3] - bv[0]); const float inv = 1.f / (1.f + e1 + e2 + e3);
                if (rep_ == REPS(PH_TOK) - 1) { *(f32x4*)(TOPW + row * 4) = (f32x4){inv, e1 * inv, e2 * inv, e3 * inv};
                    *(u32x4*)(TOPI + row * 4) = (u32x4){(unsigned)bi[0], (unsigned)bi[1], (unsigned)bi[2], (unsigned)bi[3]};
#pragma unroll
                    for (int k = 0; k < 4; ++k) { const int pos = __hip_atomic_fetch_add(lcnt + bi[k], 1, __ATOMIC_RELAXED, __HIP_MEMORY_SCOPE_WORKGROUP); asg[rloc * 4 + k] = (bi[k] << 16) | pos; } } }
            __syncthreads();
            if (tid < 32) lbase[tid] = atomicAdd(&CNT[tid], lcnt[tid]);
            __syncthreads();
            if (rep_ == REPS(PH_TOK) - 1) { const int v = asg[tid], e = v >> 16, pos = v & 0xffff; LIST[(size_t)e * 32768 + lbase[e] + pos] = chunk * 512 + tid; }
        }
        __syncthreads();
    }
    SEAM(PH_TOK);
    if (IN(PH_G4) || IN(PH_G5)) {
        PHASE_BEGIN
        if (tid < 32) ((LAS int*)LW)[LW_CNT + tid] = __hip_atomic_load(&CNT[tid], __ATOMIC_RELAXED, __HIP_MEMORY_SCOPE_AGENT);
        __syncthreads();
        if (tid == 0) { int s = 0; for (int e = 0; e < 32; ++e) { ((LAS int*)LW)[LW_TPRE + e] = s; s += (((LAS int*)LW)[LW_CNT + e] + 255) >> 8; } ((LAS int*)LW)[LW_TPRE + 32] = s; }
        __syncthreads();
    }
    if (IN(PH_G4)) for (int rep_ = 0; rep_ < REPS(PH_G4); ++rep_) {
        PHASE_BEGIN
        pg8::Gemm g{(const bf16_t*)H8, (const bf16_t*)WT_GU8, 512, nullptr, nullptr}; MoeOrder S{(const LAS int*)LW + LW_TPRE, (const LAS int*)LW + LW_CNT, LIST, 8, G, bx, 1024, 2048, (LAS int*)LW + 1024};
        EpiGateUp E{args.in[22], ACT8};
        pg8::gemm_phase<EpiGateUp, MoeOrder, true, false, true>(lds, g, S, E);
    }
    SEAM(PH_G4);
    if (IN(PH_G5)) for (int rep_ = 0; rep_ < REPS(PH_G5); ++rep_) {
        PHASE_BEGIN
        pg8::Gemm g{(const bf16_t*)ACT8, (const bf16_t*)WT_D8, 512, nullptr, nullptr}; MoeOrder S{(const LAS int*)LW + LW_TPRE, (const LAS int*)LW + LW_CNT, LIST, 4, G, bx, 1024, 1024, (LAS int*)LW + 1024};
        EpiDown E{args.in[24], LIST, YM8, (const LAS int*)LW + LW_CNT};
        pg8::gemm_phase<EpiDown, MoeOrder, false, false, true>(lds, g, S, E);
    }
    SEAM(PH_G5);
    if (IN(PH_FIN)) for (int rep_ = 0; rep_ < REPS(PH_FIN); ++rep_) {
        PHASE_BEGIN
        const float* w = args.in[18];
        for (int row0 = gw; row0 < T; row0 += 2 * NGW) { f32x4 v[2][4], ov[2][4]; float ss[2] = {0.f, 0.f}; int rows[2] = {row0, (row0 + NGW < T) ? row0 + NGW : row0};
#pragma unroll
            for (int q = 0; q < 2; ++q) { const int row = rows[q]; const f32x4 tw = *(const f32x4*)(TOPW + row * 4) * (1.f / S8_Y); const unsigned char* y0 = YM8 + (size_t)row * 4096;
#pragma unroll
                for (int j = 0; j < 4; ++j) { const int col = 4 * lane + 256 * j; f32x4 a = (f32x4){0.f, 0.f, 0.f, 0.f};
#pragma unroll
                    for (int k = 0; k < 4; ++k) { const unsigned yw = *(const unsigned*)(y0 + k * 1024 + col); const pg8::f32x2 lo = __builtin_amdgcn_cvt_pk_f32_fp8(yw, false), hi = __builtin_amdgcn_cvt_pk_f32_fp8(yw, true);
                        a[0] += tw[k] * lo[0]; a[1] += tw[k] * lo[1]; a[2] += tw[k] * hi[0]; a[3] += tw[k] * hi[1]; }
                    v[q][j] = a; ov[q][j] = *(const f32x4*)(out + (size_t)row * 1024 + col); ss[q] += (a[0] * a[0] + a[1] * a[1]) + (a[2] * a[2] + a[3] * a[3]); } }
            const float rs[2] = {rsqrtf(wave_sum(ss[0]) * (1.f / 1024.f) + 1e-6f), rsqrtf(wave_sum(ss[1]) * (1.f / 1024.f) + 1e-6f)};
#pragma unroll
            for (int q = 0; q < 2; ++q) { const int row = rows[q], b = row >> 13; if (q == 1 && rows[1] == rows[0]) break;
#pragma unroll
                for (int j = 0; j < 4; ++j) { const int col = 4 * lane + 256 * j; const f32x4 g2 = *(const f32x4*)(MOD + b * 6144 + 5120 + col), wv = *(const f32x4*)(w + col);
                    const f32x4 res = ov[q][j] + g2 * v[q][j] * rs[q] * wv; if (rep_ == REPS(PH_FIN) - 1) *(f32x4*)(out + (size_t)row * 1024 + col) = res; else asm volatile("" :: "v"(res)); } } }
    }
#ifdef PROBE_SPAN
    STAMP(PH_N);
    if (bx == 0 && threadIdx.x == 0) { const unsigned long long t0_ = ((unsigned long long)LW[161 + 2 * (PROBE_SPAN)] << 32) | LW[160 + 2 * (PROBE_SPAN)], t1_ = ((unsigned long long)LW[161 + 2 * (PROBE_SPAN_END)] << 32) | LW[160 + 2 * (PROBE_SPAN_END)];
        const unsigned long long until_ = __builtin_amdgcn_s_memrealtime() + 4ull * (t1_ - t0_);
        while (__builtin_amdgcn_s_memrealtime() < until_) __builtin_amdgcn_s_sleep(8); }
#endif
#undef IN
#undef SEAM
}
}
#undef MOD
#undef SCAL
#undef ROPEC
#undef ROPES
#undef TOPI
#undef TOPW
#undef LIST
#undef RWT
#undef CNT
#undef H
#undef QR
#undef KIMG
#undef VIMG
#undef PROJ
#undef YA
#undef YB
#undef DS
#undef DEC
#undef MERGED
#undef SP
#undef Y
#undef YH
#undef ACT
#undef YM
#undef WT_IN
#undef WT_A
#undef WT_B
#undef WT_O
#undef WT_GU
#undef WT_GU8
#undef WT_D8
#undef H8
#undef ACT8
#undef YM8
#undef WT_D
#undef PHASE_BEGIN

#ifndef FASTMASK
#define FASTMASK 0x1fff
#endif

extern "C" void kernel_launch(void* const* d_in, const int* in_sizes, int n_in, void* d_out, int out_size, void* d_ws, size_t ws_size, hipStream_t stream) {
    if (n_in != 25 || out_size != T * D || ws_size < WS_END) { fprintf(stderr, "kernel_launch: unexpected shapes / workspace (%d inputs, out %d, ws %zu)\n", n_in, out_size, ws_size); return; }
    const float* x = (const float*)d_in[0]; const float* c = (const float*)d_in[1]; const float* w_mod = (const float*)d_in[2]; const float* b_mod = (const float*)d_in[3];
    const float* norm_pre_mix = (const float*)d_in[4]; const float* norm_post_mix = (const float*)d_in[5]; const float* w_in = (const float*)d_in[6];
    const float* lq1 = (const float*)d_in[7]; const float* lk1 = (const float*)d_in[8]; const float* lq2 = (const float*)d_in[9]; const float* lk2 = (const float*)d_in[10];
    const float* subln = (const float*)d_in[11]; const float* lbl = (const float*)d_in[12]; const float* hgnorm = (const float*)d_in[13];
    const float* wa = (const float*)d_in[14]; const float* wb = (const float*)d_in[15]; const float* wo = (const float*)d_in[16];
    const float* norm_pre_ffn = (const float*)d_in[17]; const float* norm_post_ffn = (const float*)d_in[18]; const float* rw = (const float*)d_in[19]; const float* rb = (const float*)d_in[20];
    const float* wgu = (const float*)d_in[21]; const float* bgu = (const float*)d_in[22]; const float* wd = (const float*)d_in[23]; const float* bd = (const float*)d_in[24];
    unsigned char* ws = (unsigned char*)d_ws; float* out = (float*)d_out;
    float* MOD = (float*)(ws + WS_SMALL); float* SCAL = (float*)(ws + WS_SMALL + 128 * 1024); int* PADS = (int*)(ws + WS_SMALL + 192 * 1024);
    float* ROPEC = (float*)(ws + WS_ROPEC); float* ROPES = (float*)(ws + WS_ROPES);
    int* TOPI = (int*)(ws + WS_TOPI); float* TOPW = (float*)(ws + WS_TOPW); int* LIST = (int*)(ws + WS_LIST); int* CNT = (int*)(ws + WS_CTL) + CW_CNT;
    bf16_t* H = (bf16_t*)(ws + WS_H); bf16_t* PROJ = (bf16_t*)(ws + WS_PROJ); bf16_t* YA = (bf16_t*)(ws + WS_YA); bf16_t* YB = (bf16_t*)(ws + WS_YB);
    bf16_t* DS = (bf16_t*)(ws + WS_DS); float* DEC = (float*)(ws + WS_DEC); bf16_t* MERGED = (bf16_t*)(ws + WS_MERGED); float* Y = (float*)(ws + WS_Y);
    bf16_t* SP = (bf16_t*)(ws + WS_MERGED);
    bf16_t* ACT = (bf16_t*)(ws + WS_ACT); bf16_t* YM = (bf16_t*)(ws + WS_YM);

    static int grid = 0;
    if (grid == 0) {
        (void)hipFuncSetAttribute((const void*)nv::k_attn, hipFuncAttributeMaxDynamicSharedMemorySize, nv::AT_LDS);
        (void)hipFuncSetAttribute((const void*)nv::k_hgA, hipFuncAttributeMaxDynamicSharedMemorySize, 65536);
        (void)hipFuncSetAttribute((const void*)nv::k_hgC, hipFuncAttributeMaxDynamicSharedMemorySize, nv::HC_LDS);
        (void)hipFuncSetAttribute((const void*)mk::mega, hipFuncAttributeMaxDynamicSharedMemorySize, mk::LDS_BYTES);
        int dev = 0, cus = 0; (void)hipGetDevice(&dev); (void)hipDeviceGetAttribute(&cus, hipDeviceAttributeMultiprocessorCount, dev);
        (void)hipGetLastError();
        grid = cus > 0 ? cus : 256;
    }
    (void)hipMemsetAsync(ws + WS_CTL, 0, 1 * MiB, stream);
    mk::Args a{}; for (int i = 0; i < 25; ++i) a.in[i] = (const float*)d_in[i]; a.out = out; a.ws = ws;
    const unsigned fast = FASTMASK; int li = 0;
    for (int p = 0; p < mk::PH_N;) {
        if (fast & (1u << p)) { int q = p; while (q < mk::PH_N && (fast & (1u << q))) ++q;
            a.ph_lo = p; a.ph_hi = q; a.li = li++; a.pad = 0;
            hipLaunchKernelGGL(mk::mega, dim3(grid), dim3(mk::NTHR), mk::LDS_BYTES, stream, a);
            p = q; continue; }
        switch (p) {
        case mk::PH_PRO:
            nv::k_mod<<<dim3(24, 4), 256, 0, stream>>>(c, w_mod, b_mod, MOD);
            nv::k_small<<<1024, 256, 0, stream>>>(lq1, lk1, lq2, lk2, lbl, SCAL, ROPEC, ROPES); break;
        case mk::PH_H1: nv::k_rowmod<<<T / 4, 256, 0, stream>>>(x, norm_pre_mix, MOD, H, 0, 1024); break;
        case mk::PH_G1: { nv::NG p_{}; p_.A = H; p_.lda = 1024; p_.M = T; p_.B = w_in; p_.ldb = NC; p_.K = 1024;
            nv::k_gemm<nv::EpiStoreBf16, 1><<<dim3(NC / 64, T / 64, 1), 256, 0, stream>>>(p_, nv::EpiStoreBf16{PROJ, (long long)NC}); } break;
        case mk::PH_ROPE_HGA: nv::k_hgA<<<dim3(128, 4, 4), 256, 65536, stream>>>(PROJ, SCAL, DS, DEC); break;
        case mk::PH_ATT_SCAN:
            nv::k_attn<<<dim3(128, 4, 4), 256, nv::AT_LDS, stream>>>(PROJ, ROPEC, ROPES, SCAL, subln, YA);
            nv::k_scan<<<1024, 256, 0, stream>>>(DS, DEC, SP); break;
        case mk::PH_HGC: nv::k_hgC<<<dim3(128, 4, 4), 256, nv::HC_LDS, stream>>>(PROJ, SCAL, SP, hgnorm, YB); break;
        case mk::PH_G2A: { nv::NG p_{}; p_.A = YA; p_.lda = 512; p_.M = T; p_.B = wa; p_.ldb = 1024; p_.K = 512;
            nv::k_gemm<nv::EpiBranchA, 1><<<dim3(16, T / 64, 1), 256, 0, stream>>>(p_, nv::EpiBranchA{out, PROJ}); } break;
        case mk::PH_G2B: { nv::NG p_{}; p_.A = YB; p_.lda = 512; p_.M = T; p_.B = wb; p_.ldb = 1024; p_.K = 512;
            nv::k_gemm<nv::EpiBranchB, 1><<<dim3(16, T / 64, 1), 256, 0, stream>>>(p_, nv::EpiBranchB{out, PROJ, MERGED}); } break;
        case mk::PH_G3: { nv::NG p_{}; p_.A = MERGED; p_.lda = 1024; p_.M = T; p_.B = wo; p_.ldb = 1024; p_.K = 1024;
            nv::k_gemm<nv::EpiStoreF32, 1><<<dim3(16, T / 64, 1), 256, 0, stream>>>(p_, nv::EpiStoreF32{Y, 1024LL}); } break;
        case mk::PH_TOK:
            nv::k_x1<<<T / 4, 256, 0, stream>>>(x, Y, norm_post_mix, MOD, 2048LL, out);
            nv::k_rowmod<<<T / 4, 256, 0, stream>>>(out, norm_pre_ffn, MOD, H, 3072, 4096);
            nv::k_route<<<T / 4, 256, 0, stream>>>(out, norm_pre_ffn, MOD, rw, rb, TOPI, TOPW);
            nv::k_lists<<<T * 4 / 256, 256, 0, stream>>>(TOPI, CNT, LIST);
            nv::k_pads<<<1, 64, 0, stream>>>(CNT, PADS); break;
        case mk::PH_G4: { nv::NG p_{}; p_.A = H; p_.lda = 1024; p_.rowidx = LIST; p_.idxstride = 32768; p_.idxshift = 2; p_.cnt = CNT; p_.rowbase = PADS; p_.B = wgu; p_.strideB = (size_t)1024 * 2048; p_.ldb = 2048; p_.K = 1024; p_.b1off = 1024;
            nv::k_gemm<nv::EpiGateUp, 2><<<dim3(16, T / 64, 32), 256, 0, stream>>>(p_, nv::EpiGateUp{bgu, ACT}); } break;
        case mk::PH_G5: { nv::NG p_{}; p_.A = ACT; p_.lda = 1024; p_.cnt = CNT; p_.rowbase = PADS; p_.B = wd; p_.strideB = (size_t)1024 * 1024; p_.ldb = 1024; p_.K = 1024;
            nv::k_gemm<nv::EpiDown, 1><<<dim3(16, T / 64, 32), 256, 0, stream>>>(p_, nv::EpiDown{bd, LIST, YM}); } break;
        case mk::PH_FIN: nv::k_final<<<T / 4, 256, 0, stream>>>(out, YM, TOPW, norm_post_ffn, MOD); break;
        }
        ++p;
    }
}
```

```cpp
#include <hip/hip_runtime.h>
#include <hip/hip_bf16.h>
#include <stdint.h>
#include <cstdio>

typedef unsigned short bf16_t;
__device__ __forceinline__ float bf2f(bf16_t v) { return __uint_as_float(((unsigned)v) << 16); }
__device__ __forceinline__ bf16_t f2bf(float f) { unsigned u = __float_as_uint(f); return (bf16_t)((u + 0x7fffu + ((u >> 16) & 1u)) >> 16); }

constexpr int NB_ = 4, SEQ = 8192, T = NB_ * SEQ, D = 1024, NC = 5632, NE = 32;
constexpr size_t MiB = 1u << 20;
constexpr size_t WS_CTL = 0;
constexpr size_t WS_SMALL = 1 * MiB;
constexpr size_t WS_ROPEC = 2 * MiB, WS_ROPES = 3 * MiB;
constexpr size_t WS_TOPI = 4 * MiB, WS_TOPW = 4 * MiB + 512 * 1024;
constexpr size_t WS_RWT = 5 * MiB;
constexpr size_t WS_LIST = 6 * MiB;
constexpr size_t WS_WIN = 16 * MiB, WS_WA = 28 * MiB, WS_WB = 29 * MiB, WS_WO = 30 * MiB, WS_WGU = 32 * MiB, WS_WD = 160 * MiB;
constexpr size_t WS_H = 224 * MiB;
constexpr size_t WS_PROJ = 288 * MiB;
constexpr size_t WS_YA = 640 * MiB, WS_YB = 672 * MiB;
constexpr size_t WS_DS = 704 * MiB, WS_DEC = 768 * MiB;
constexpr size_t WS_MERGED = 772 * MiB;
constexpr size_t WS_Y = 836 * MiB;
constexpr size_t WS_ACT = 288 * MiB;
constexpr size_t WS_YM = 560 * MiB;
constexpr size_t WS_END = 964 * MiB;
constexpr int CW_CNT = 1024;
constexpr int CW_KMAX = 2048;
constexpr int CW_BAR = 4096;

namespace nv {

__device__ __forceinline__ float wave_sum(float v) {
#pragma unroll
    for (int o = 1; o < 64; o <<= 1) v += __shfl_xor(v, o);
    return v;
}
__device__ __forceinline__ float sigm(float x) { return 1.f / (1.f + expf(-x)); }

__global__ void __launch_bounds__(256) k_mod(const float* c, const float* w_mod, const float* b_mod, float* mod) {
    const int j = blockIdx.x * 256 + threadIdx.x, b = blockIdx.y;
    float acc = 0.f;
    for (int k = 0; k < 1024; ++k) { const float cv = c[b * 1024 + k]; acc += (cv * sigm(cv)) * w_mod[(size_t)k * 6144 + j]; }
    mod[b * 6144 + j] = acc + b_mod[j];
}
__global__ void __launch_bounds__(256) k_small(const float* q1, const float* k1, const float* q2, const float* k2, const float* lbl,
                                               float* scal, float* ropec, float* ropes) {
    const int gid = blockIdx.x * 256 + threadIdx.x;
    if (gid == 0) { float s1 = 0.f, s2 = 0.f; for (int i = 0; i < 64; ++i) { s1 += q1[i] * k1[i]; s2 += q2[i] * k2[i]; } scal[0] = expf(s1) - expf(s2) + 0.2f; }
    if (gid < 512) { const float a = lbl[gid], b = lbl[512 + gid]; scal[64 + gid] = 1.f / (1.f + expf(b - a)); }
    if (gid < 8192 * 32) { const int s = gid >> 5, i = gid & 31; const float inv = powf(10000.f, -(float)(2 * i) / 64.f); const float ang = (float)s * inv; ropec[gid] = cosf(ang); ropes[gid] = sinf(ang); }
}
__global__ void __launch_bounds__(256) k_rowmod(const float* x, const float* w, const float* mod, bf16_t* out, int shoff, int scoff) {
    const int row = blockIdx.x * 4 + (threadIdx.x >> 6), lane = threadIdx.x & 63, b = row >> 13;
    const float* xr = x + (size_t)row * 1024; float v[16]; float ss = 0.f;
#pragma unroll
    for (int j = 0; j < 16; ++j) { v[j] = xr[lane + 64 * j]; ss += v[j] * v[j]; }
    ss = wave_sum(ss); const float rstd = rsqrtf(ss * (1.f / 1024.f) + 1e-6f);
#pragma unroll
    for (int j = 0; j < 16; ++j) { const int col = lane + 64 * j; const float h = v[j] * rstd * w[col] * (1.f + mod[b * 6144 + scoff + col]) + mod[b * 6144 + shoff + col]; out[(size_t)row * 1024 + col] = f2bf(h); }
}

struct NG {
    const bf16_t* A;
    const int* rowidx;
    const int* cnt;
    const int* rowbase;
    const float* B; size_t strideB;
    int lda, idxstride, idxshift, M  , ldb, K, b1off, pad;
};
template <class Epi, int NB>
__global__ void __launch_bounds__(256) k_gemm(NG p, Epi epi) {
    __shared__ float As[16][68];
    __shared__ float Bs[NB][16][64];
    const int z = blockIdx.z, Mz = p.cnt ? p.cnt[z] : p.M, m0 = blockIdx.y * 64, n0 = blockIdx.x * 64;
    if (m0 >= Mz) return;
    const int tid = threadIdx.x, tx = tid & 15, ty = tid >> 4;
    const float* B = p.B + (size_t)z * p.strideB;
    const int base = p.rowbase ? p.rowbase[z] : 0;
    const int lr = tid >> 2, lk = (tid & 3) * 4;
    int lrow = m0 + lr; if (lrow >= Mz) lrow = Mz - 1;
    const size_t arow = p.rowidx ? (size_t)(p.rowidx[(size_t)z * p.idxstride + lrow] >> p.idxshift) : (size_t)(base + lrow);
    const bf16_t* ap = p.A + arow * p.lda + lk;
    const int bk = tid >> 4, bc = (tid & 15) * 4;
    float acc[NB][4][4];
#pragma unroll
    for (int q = 0; q < NB; ++q)
#pragma unroll
        for (int i = 0; i < 4; ++i)
#pragma unroll
            for (int j = 0; j < 4; ++j) acc[q][i][j] = 0.f;
    for (int k0 = 0; k0 < p.K; k0 += 16) {
        const uint2 av = *(const uint2*)(ap + k0);
        As[lk + 0][lr] = __uint_as_float(av.x << 16); As[lk + 1][lr] = __uint_as_float(av.x & 0xffff0000u);
        As[lk + 2][lr] = __uint_as_float(av.y << 16); As[lk + 3][lr] = __uint_as_float(av.y & 0xffff0000u);
#pragma unroll
        for (int q = 0; q < NB; ++q) { const float4 bv = *(const float4*)(B + (size_t)(k0 + bk) * p.ldb + n0 + bc + q * p.b1off); *(float4*)&Bs[q][bk][bc] = bv; }
        __syncthreads();
#pragma unroll
        for (int k = 0; k < 16; ++k) {
            float a[4]; const float4 a4 = *(const float4*)&As[k][ty * 4]; a[0] = a4.x; a[1] = a4.y; a[2] = a4.z; a[3] = a4.w;
#pragma unroll
            for (int q = 0; q < NB; ++q) { const float4 b4 = *(const float4*)&Bs[q][k][tx * 4]; const float b[4] = {b4.x, b4.y, b4.z, b4.w};
#pragma unroll
                for (int i = 0; i < 4; ++i)
#pragma unroll
                    for (int j = 0; j < 4; ++j) acc[q][i][j] += a[i] * b[j]; }
        }
        __syncthreads();
    }
#pragma unroll
    for (int i = 0; i < 4; ++i) { const int lrw = m0 + ty * 4 + i; if (lrw < Mz) {
#pragma unroll
        for (int j = 0; j < 4; ++j) epi(z, lrw, base + lrw, n0 + tx * 4 + j, acc[0][i][j], NB == 2 ? acc[NB - 1][i][j] : 0.f); } }
}
struct EpiStoreBf16 { bf16_t* C; long long ldc; __device__ void operator()(int, int, int r, int c, float v, float) const { C[(size_t)r * ldc + c] = f2bf(v); } };
struct EpiStoreF32 { float* C; long long ldc; __device__ void operator()(int, int, int r, int c, float v, float) const { C[(size_t)r * ldc + c] = v; } };
struct EpiBranchA { float* tmp; const bf16_t* proj; __device__ void operator()(int, int, int r, int c, float v, float) const { tmp[(size_t)r * 1024 + c] = sigm(bf2f(proj[(size_t)r * 5632 + 3584 + c])) * v; } };
struct EpiBranchB { const float* tmp; const bf16_t* proj; bf16_t* merged; __device__ void operator()(int, int, int r, int c, float v, float) const {
    merged[(size_t)r * 1024 + c] = f2bf(tmp[(size_t)r * 1024 + c] + sigm(bf2f(proj[(size_t)r * 5632 + 4608 + c])) * v); } };
struct EpiGateUp { const float* bgu; bf16_t* act; __device__ void operator()(int e, int, int r, int c, float v0, float v1) const {
    float g = v0 + bgu[e * 2048 + c], u = v1 + bgu[e * 2048 + 1024 + c]; g = fminf(g, 7.f); u = fminf(fmaxf(u, -7.f), 7.f);
    const float glu = g * sigm(1.702f * g); act[(size_t)r * 1024 + c] = f2bf((u + 1.f) * glu); } };
struct EpiDown { const float* bd; const int* list; bf16_t* ym; __device__ void operator()(int e, int lr, int, int c, float v, float) const {
    const int a = list[(size_t)e * 32768 + lr]; ym[(size_t)a * 1024 + c] = f2bf(v + bd[e * 1024 + c]); } };

constexpr int AT_LD = 129;
constexpr int AT_LDS = (3 * 64 * AT_LD + 64 * 65) * 4;
__device__ __forceinline__ void at_load_rope(float* dst, const bf16_t* proj, int tok0, int colbase, const float* ropec, const float* ropes, int s0, int tid) {
    for (int i = 0; i < 16; ++i) { const int idx = tid + 256 * i, row = idx >> 6, rem = idx & 63, m = rem >> 5, d = rem & 31;
        const bf16_t* pr = proj + (size_t)(tok0 + row) * 5632 + colbase + m * 64;
        const float x1 = bf2f(pr[d]), x2 = bf2f(pr[32 + d]), c = ropec[(s0 + row) * 32 + d], s = ropes[(s0 + row) * 32 + d];
        dst[row * AT_LD + m * 64 + d] = x1 * c - x2 * s; dst[row * AT_LD + m * 64 + 32 + d] = x2 * c + x1 * s; }
}
__global__ void __launch_bounds__(256) k_attn(const bf16_t* proj, const float* ropec, const float* ropes, const float* scal, const float* subln, bf16_t* ya) {
    extern __shared__ float sm[];
    float* Qs = sm; float* Ks = Qs + 64 * AT_LD; float* Vs = Ks + 64 * AT_LD; float* As = Vs + 64 * AT_LD;
    const int qc = blockIdx.x, h = blockIdx.y, b = blockIdx.z, tid = threadIdx.x, r = tid >> 2, qd = tid & 3;
    const int tokq = b * 8192 + qc * 64; const float lam = scal[0];
    at_load_rope(Qs, proj, tokq, h * 128, ropec, ropes, qc * 64, tid);
    float m0 = -1e30f, l0 = 0.f, m1 = -1e30f, l1 = 0.f;
    for (int kc = 0; kc <= qc; ++kc) {
        __syncthreads();
        at_load_rope(Ks, proj, b * 8192 + kc * 64, 512 + h * 128, ropec, ropes, kc * 64, tid);
        __syncthreads();
        for (int i = 0; i < 16; ++i) { const int j = 4 * i + qd; float s0 = 0.f, s1 = 0.f;
            for (int d = 0; d < 64; ++d) { s0 += Qs[r * AT_LD + d] * Ks[j * AT_LD + d]; s1 += Qs[r * AT_LD + 64 + d] * Ks[j * AT_LD + 64 + d]; }
            s0 *= 0.125f; s1 *= 0.125f;
            float mn = fmaxf(m0, s0); l0 = l0 * expf(m0 - mn) + expf(s0 - mn); m0 = mn;
            mn = fmaxf(m1, s1); l1 = l1 * expf(m1 - mn) + expf(s1 - mn); m1 = mn; }
    }
#pragma unroll
    for (int o = 1; o < 4; o <<= 1) {
        float mo = __shfl_xor(m0, o), lo = __shfl_xor(l0, o); float mn = fmaxf(m0, mo); l0 = l0 * expf(m0 - mn) + lo * expf(mo - mn); m0 = mn;
        mo = __shfl_xor(m1, o); lo = __shfl_xor(l1, o); mn = fmaxf(m1, mo); l1 = l1 * expf(m1 - mn) + lo * expf(mo - mn); m1 = mn; }
    const float il0 = 1.f / l0, il1 = lam / l1;
    float o[32];
#pragma unroll
    for (int i = 0; i < 32; ++i) o[i] = 0.f;
    for (int kc = 0; kc <= qc; ++kc) {
        __syncthreads();
        at_load_rope(Ks, proj, b * 8192 + kc * 64, 512 + h * 128, ropec, ropes, kc * 64, tid);
        for (int i = 0; i < 32; ++i) { const int idx = tid + 256 * i, row = idx >> 7, col = idx & 127; Vs[row * AT_LD + col] = bf2f(proj[(size_t)(b * 8192 + kc * 64 + row) * 5632 + 1024 + h * 128 + col]); }
        __syncthreads();
        for (int i = 0; i < 16; ++i) { const int j = 4 * i + qd; float s0 = 0.f, s1 = 0.f;
            for (int d = 0; d < 64; ++d) { s0 += Qs[r * AT_LD + d] * Ks[j * AT_LD + d]; s1 += Qs[r * AT_LD + 64 + d] * Ks[j * AT_LD + 64 + d]; }
            s0 *= 0.125f; s1 *= 0.125f;
            As[r * 65 + j] = expf(s0 - m0) * il0 - expf(s1 - m1) * il1; }
        __syncthreads();
        for (int j = 0; j < 64; ++j) { const float av = As[r * 65 + j];
#pragma unroll
            for (int dv = 0; dv < 32; ++dv) o[dv] += av * Vs[j * AT_LD + 32 * qd + dv]; }
    }
    float ss = 0.f;
#pragma unroll
    for (int i = 0; i < 32; ++i) ss += o[i] * o[i];
    ss += __shfl_xor(ss, 1); ss += __shfl_xor(ss, 2);
    const float rstd = rsqrtf(ss * (1.f / 128.f) + 1e-6f);
#pragma unroll
    for (int i = 0; i < 32; ++i) { const int dv = 32 * qd + i; ya[(size_t)(tokq + r) * 512 + h * 128 + dv] = f2bf(o[i] * rstd * subln[dv] * 0.8f); }
}

__global__ void __launch_bounds__(256) k_hgA(const bf16_t* proj, const float* scal, bf16_t* ds, float* dec) {
    extern __shared__ float sm[];
    float* G = sm; float* V = sm + 64 * 128;
    const int n = blockIdx.x, h = blockIdx.y, b = blockIdx.z, tid = threadIdx.x, tok0 = b * 8192 + n * 64, bh = b * 4 + h;
    for (int i = 0; i < 32; ++i) { const int idx = tid + 256 * i, c = idx >> 7, d = idx & 127; const bf16_t* pr = proj + (size_t)(tok0 + c) * 5632 + h * 128 + d;
        const float lb = scal[64 + h * 128 + d]; const float f = lb + (1.f - lb) * sigm(bf2f(pr[2048])); G[c * 128 + d] = f; V[c * 128 + d] = bf2f(pr[2560]); }
    __syncthreads();
    float kk[64]; float glast = 0.f; const int d = tid & 127, vb = (tid >> 7) * 64;
    {
        float g = 0.f;
#pragma unroll
        for (int c = 0; c < 64; ++c) { const float f = G[c * 128 + d]; g += logf(f); kk[c] = g; }
        glast = g;
#pragma unroll
        for (int c = 0; c < 64; ++c) { const float f = G[c * 128 + d]; kk[c] = (1.f - f) * expf(glast - kk[c]); }
    }
    if (tid < 128) dec[(size_t)(bh * 128 + n) * 128 + d] = expf(glast);
    for (int v0 = 0; v0 < 64; v0 += 16) {
        float acc[16];
#pragma unroll
        for (int i = 0; i < 16; ++i) acc[i] = 0.f;
#pragma unroll
        for (int c = 0; c < 64; ++c) {
#pragma unroll
            for (int i = 0; i < 16; ++i) acc[i] += kk[c] * V[c * 128 + vb + v0 + i]; }
#pragma unroll
        for (int i = 0; i < 16; ++i) ds[((size_t)(bh * 128 + n) * 128 + d) * 128 + vb + v0 + i] = f2bf(acc[i]);
    }
}
__global__ void __launch_bounds__(256) k_scan(const bf16_t* ds, const float* dec, bf16_t* sp) {
    const int gid = blockIdx.x * 256 + threadIdx.x; const int bh = gid >> 14, d = (gid >> 7) & 127, v = gid & 127;
    float st = 0.f;
    for (int n = 0; n < 128; ++n) { const size_t o = ((size_t)(bh * 128 + n) * 128 + d) * 128 + v; const float x = bf2f(ds[o]); sp[o] = f2bf(st); st = dec[(size_t)(bh * 128 + n) * 128 + d] * st + x; }
}
constexpr int HC_LDS = (2 * 64 * 129 + 64 * 128 + 64 * 65) * 4;
__global__ void __launch_bounds__(256) k_hgC(const bf16_t* proj, const float* scal, const bf16_t* sp, const float* hgnorm, bf16_t* yb) {
    extern __shared__ float sm[];
    float* QT = sm; float* KT = QT + 64 * 129; float* V = KT + 64 * 129; float* As = V + 64 * 128;
    const int n = blockIdx.x, h = blockIdx.y, b = blockIdx.z, tid = threadIdx.x, tok0 = b * 8192 + n * 64, bh = b * 4 + h;
    for (int i = 0; i < 32; ++i) { const int idx = tid + 256 * i, c = idx >> 7, d = idx & 127; const bf16_t* pr = proj + (size_t)(tok0 + c) * 5632 + h * 128 + d;
        const float lb = scal[64 + h * 128 + d]; const float f = lb + (1.f - lb) * sigm(bf2f(pr[2048])); const float q = bf2f(pr[1536]);
        QT[c * 129 + d] = q * sigm(q); KT[c * 129 + d] = f; V[c * 128 + d] = bf2f(pr[2560]); }
    __syncthreads();
    if (tid < 128) { float g = 0.f; for (int c = 0; c < 64; ++c) { const float f = KT[c * 129 + tid]; g += logf(f); QT[c * 129 + tid] *= expf(g); KT[c * 129 + tid] = (1.f - f) * expf(-g); } }
    __syncthreads();
    const int c = tid >> 2, q4 = tid & 3;
    for (int i = 0; i < 16; ++i) { const int s = 4 * i + q4; float a = 0.f;
        if (s <= c) { for (int d = 0; d < 128; ++d) a += QT[c * 129 + d] * KT[s * 129 + d]; }
        As[c * 65 + s] = a; }
    __syncthreads();
    float o[32];
#pragma unroll
    for (int i = 0; i < 32; ++i) o[i] = 0.f;
    for (int s = 0; s < 64; ++s) { const float a = As[c * 65 + s];
#pragma unroll
        for (int i = 0; i < 32; ++i) o[i] += a * V[s * 128 + 32 * q4 + i]; }
    const bf16_t* spb = sp + (size_t)(bh * 128 + n) * 128 * 128;
    for (int d = 0; d < 128; ++d) { const float qv = QT[c * 129 + d];
#pragma unroll
        for (int i = 0; i < 32; ++i) o[i] += qv * bf2f(spb[d * 128 + 32 * q4 + i]); }
    float ss = 0.f;
#pragma unroll
    for (int i = 0; i < 32; ++i) ss += o[i] * o[i];
    ss += __shfl_xor(ss, 1); ss += __shfl_xor(ss, 2);
    const float rstd = rsqrtf(ss * (1.f / 128.f) + 1e-6f);
#pragma unroll
    for (int i = 0; i < 32; ++i) { const int v = 32 * q4 + i; const float g = bf2f(proj[(size_t)(tok0 + c) * 5632 + 3072 + h * 128 + v]);
        yb[(size_t)(tok0 + c) * 512 + h * 128 + v] = f2bf(o[i] * rstd * hgnorm[v] * (g * sigm(g))); }
}
__global__ void __launch_bounds__(256) k_x1(const float* x, const float* y, const float* w, const float* mod, long long goff, float* x1) {
    const int row = blockIdx.x * 4 + (threadIdx.x >> 6), lane = threadIdx.x & 63, b = row >> 13;
    const float* yr = y + (size_t)row * 1024; float v[16]; float ss = 0.f;
#pragma unroll
    for (int j = 0; j < 16; ++j) { v[j] = yr[lane + 64 * j]; ss += v[j] * v[j]; }
    ss = wave_sum(ss); const float rstd = rsqrtf(ss * (1.f / 1024.f) + 1e-6f);
#pragma unroll
    for (int j = 0; j < 16; ++j) { const int col = lane + 64 * j; x1[(size_t)row * 1024 + col] = x[(size_t)row * 1024 + col] + mod[b * 6144 + goff + col] * v[j] * rstd * w[col]; }
}
__global__ void __launch_bounds__(256) k_route(const float* x1, const float* w, const float* mod, const float* rw, const float* rb, int* topi, float* topw) {
    const int row = blockIdx.x * 4 + (threadIdx.x >> 6), lane = threadIdx.x & 63, b = row >> 13;
    const float* xr = x1 + (size_t)row * 1024; float v[16]; float ss = 0.f;
#pragma unroll
    for (int j = 0; j < 16; ++j) { v[j] = xr[lane + 64 * j]; ss += v[j] * v[j]; }
    ss = wave_sum(ss); const float rstd = rsqrtf(ss * (1.f / 1024.f) + 1e-6f);
    float lg[32];
#pragma unroll
    for (int e = 0; e < 32; ++e) lg[e] = 0.f;
#pragma unroll
    for (int j = 0; j < 16; ++j) { const int col = lane + 64 * j; const float h = v[j] * rstd * w[col] * (1.f + mod[b * 6144 + 4096 + col]) + mod[b * 6144 + 3072 + col];
#pragma unroll
        for (int e = 0; e < 32; ++e) lg[e] += h * rw[col * 32 + e]; }
#pragma unroll
    for (int e = 0; e < 32; ++e) lg[e] = wave_sum(lg[e]) + rb[e];
    int bi[4]; float bv[4];
#pragma unroll
    for (int k = 0; k < 4; ++k) { float best = -3.0e38f; int be = 0;
#pragma unroll
        for (int e = 0; e < 32; ++e) { bool taken = false;
#pragma unroll
            for (int q = 0; q < 4; ++q) if (q < k && bi[q] == e) taken = true;
            if (!taken && lg[e] > best) { best = lg[e]; be = e; } }
        bi[k] = be; bv[k] = best; }
    const float e1 = expf(bv[1] - bv[0]), e2 = expf(bv[2] - bv[0]), e3 = expf(bv[3] - bv[0]); const float inv = 1.f / (1.f + e1 + e2 + e3);
    if (lane == 0) { topi[row * 4 + 0] = bi[0]; topi[row * 4 + 1] = bi[1]; topi[row * 4 + 2] = bi[2]; topi[row * 4 + 3] = bi[3];
        topw[row * 4 + 0] = inv; topw[row * 4 + 1] = e1 * inv; topw[row * 4 + 2] = e2 * inv; topw[row * 4 + 3] = e3 * inv; }
}
__global__ void __launch_bounds__(256) k_lists(const int* topi, int* cnt, int* list) {
    const int a = blockIdx.x * 256 + threadIdx.x; const int e = topi[a]; const int pos = atomicAdd(&cnt[e], 1); list[(size_t)e * 32768 + pos] = a;
}
__global__ void k_pads(const int* cnt, int* pads) { if (threadIdx.x == 0) { int s = 0; for (int e = 0; e < 32; ++e) { pads[e] = s; s += ((cnt[e] + 255) / 256) * 256; } } }
__global__ void __launch_bounds__(256) k_final(float* out, const bf16_t* ym, const float* topw, const float* w, const float* mod) {
    const int row = blockIdx.x * 4 + (threadIdx.x >> 6), lane = threadIdx.x & 63, b = row >> 13;
    float v[16]; float ss = 0.f; const float w0 = topw[row * 4], w1 = topw[row * 4 + 1], w2 = topw[row * 4 + 2], w3 = topw[row * 4 + 3];
    const bf16_t* y0 = ym + (size_t)row * 4096;
#pragma unroll
    for (int j = 0; j < 16; ++j) { const int col = lane + 64 * j; v[j] = w0 * bf2f(y0[col]) + w1 * bf2f(y0[1024 + col]) + w2 * bf2f(y0[2048 + col]) + w3 * bf2f(y0[3072 + col]); ss += v[j] * v[j]; }
    ss = wave_sum(ss); const float rstd = rsqrtf(ss * (1.f / 1024.f) + 1e-6f);
#pragma unroll
    for (int j = 0; j < 16; ++j) { const int col = lane + 64 * j; out[(size_t)row * 1024 + col] += mod[b * 6144 + 5120 + col] * v[j] * rstd * w[col]; }
}
}
#define GAS __attribute__((address_space(1)))
#define LAS __attribute__((address_space(3)))
typedef GAS unsigned gu32;
#define RLX_AGENT __ATOMIC_RELAXED, __HIP_MEMORY_SCOPE_AGENT
#define XB_TMO      128
#define XB_XCNT(j)  (256  + 64 * (j))
#define XB_XSUB(j)  (1280 + 64 * (j))
#define XB_XGEN(j)  (2304 + 64 * (j))
#define XB_TOP      3328
#define XB_TOPGEN   3392
#define XCD_BAR_WORDS 3456
#define XB_SPIN_CAP (1u << 22)

__device__ __forceinline__ unsigned xb_ld(unsigned* p)              { return __hip_atomic_load(p, __ATOMIC_RELAXED, __HIP_MEMORY_SCOPE_AGENT); }
__device__ __forceinline__ unsigned xb_add(unsigned* p, unsigned v) { return __hip_atomic_fetch_add(p, v, __ATOMIC_RELAXED, __HIP_MEMORY_SCOPE_AGENT); }
__device__ __forceinline__ unsigned xb_xcc_id() { return (unsigned)__builtin_amdgcn_s_getreg((3 << 11) | 20) & 0xFu; }
#define XB_SPIN(cond, bar) do { unsigned _sp = 0; while (cond) { __builtin_amdgcn_s_sleep(1); \
    if ((++_sp & 255u) == 0u) { if (xb_ld(&(bar)[XB_TMO])) break; if (_sp > XB_SPIN_CAP) { atomicAdd(&(bar)[XB_TMO], 1u); break; } } } } while (0)

struct XcdBarrier {
    unsigned* bar; unsigned x;
    volatile LAS unsigned* st;
};
__device__ __forceinline__ XcdBarrier xcd_barrier_post(unsigned* bar, volatile LAS unsigned* st) {
    XcdBarrier b; b.bar = bar; b.x = xb_xcc_id(); b.st = st;
    if (threadIdx.x == 0) (void)xb_add(&bar[XB_XCNT(b.x)], 1u);
    return b;
}
__device__ __forceinline__ void xcd_barrier_complete(unsigned* bar, unsigned x, unsigned& nloc, unsigned& nx) {
    const unsigned G = gridDim.x * gridDim.y * gridDim.z;
    unsigned sum, cnt, mine, sp = 0u;
    for (;;) {
        sum = 0u; cnt = 0u; mine = 0u;
#pragma unroll
        for (unsigned j = 0; j < 16; ++j) { const unsigned c = xb_ld(&bar[XB_XCNT(j)]); sum += c; cnt += (c > 0u) ? 1u : 0u; mine = (j == x) ? c : mine; }
        if (sum == G) break;
        __builtin_amdgcn_s_sleep(1);
        if ((++sp & 255u) == 0u) { if (xb_ld(&bar[XB_TMO])) break; if (sp > XB_SPIN_CAP) { atomicAdd(&bar[XB_TMO], 1u); break; } }
    }
    nloc = mine > 0u ? mine : 1u; nx = cnt > 0u ? cnt : 1u;
}
__device__ __forceinline__ void xcd_barrier(const XcdBarrier& b) {
    asm volatile("s_waitcnt vmcnt(0)" ::: "memory");
    __syncthreads();
    if (threadIdx.x == 0) {
        unsigned* bar = b.bar;
        __builtin_amdgcn_s_waitcnt(0);
        unsigned nloc = b.st[0], nx = b.st[1];
        if (nloc == 0u) { xcd_barrier_complete(bar, b.x, nloc, nx); b.st[0] = nloc; b.st[1] = nx; }
        const unsigned old = xb_add(&bar[XB_XSUB(b.x)], 1u);
        const unsigned gen = old / nloc;
        if (old + 1u == (gen + 1u) * nloc) {
            __builtin_amdgcn_fence(__ATOMIC_RELEASE, "agent");
            asm volatile("s_waitcnt vmcnt(0)" ::: "memory");
            const unsigned og = xb_add(&bar[XB_TOP], 1u);
            const unsigned tg = og / nx;
            if (og + 1u == (tg + 1u) * nx) xb_add(&bar[XB_TOPGEN], 1u);
            else XB_SPIN(xb_ld(&bar[XB_TOPGEN]) == tg, bar);
            __builtin_amdgcn_fence(__ATOMIC_ACQUIRE, "agent");
            xb_add(&bar[XB_XGEN(b.x)], 1u);
            asm volatile("s_waitcnt vmcnt(0)" ::: "memory");
        } else {
            XB_SPIN(xb_ld(&bar[XB_XGEN(b.x)]) == gen, bar);
            __builtin_amdgcn_fence(__ATOMIC_ACQUIRE, "agent");
            asm volatile("s_waitcnt vmcnt(0)" ::: "memory");
        }
    }
    __syncthreads();
}
namespace pg8 {
#define PG8_LAS __attribute__((address_space(3)))
typedef short bf16x8 __attribute__((ext_vector_type(8)));
typedef float f32x4 __attribute__((ext_vector_type(4)));
typedef float f32x2 __attribute__((ext_vector_type(2)));
typedef unsigned u32x4 __attribute__((ext_vector_type(4)));
typedef unsigned u32x2 __attribute__((ext_vector_type(2)));
typedef int i32x4 __attribute__((ext_vector_type(4)));
typedef int i32x8 __attribute__((ext_vector_type(8)));
constexpr int BM = 256, BK = 64, HALF = 128, HTB = HALF * BK * 2  , STAGE_BYTES = 8 * HTB, NXCD = 8, WGM = 8;

__host__ __device__ __forceinline__ int lds_byte(int r, int c) { const int st = (r >> 4) * 2 + (c >> 5), rr = r & 15, cc = c & 31, ob = rr * 64 + cc * 2; return st * 1024 + (ob ^ (((ob >> 9) & 1) << 5)); }
__host__ __device__ __forceinline__ void stage_rc(int b, int& R, int& C) { const int st = b / 1024, sb = b % 1024, swz = sb ^ (((sb >> 9) & 1) << 5); R = (st >> 1) * 16 + swz / 64; C = (st & 1) * 32 + (swz % 64) / 2; }
__host__ __device__ __forceinline__ int perm32(int rho) { const int n = rho >> 4, i = rho & 15; return 8 * (i >> 2) + 4 * n + (i & 3); }

struct Unit { int pm, pn, z, arow, brow; };
struct Gemm { const bf16_t* A; const bf16_t* Bt; int K; const bf16_t* A2; const bf16_t* Bt2; };

struct DenseOrder {
    int nM, nN, nwg, G, c;
    __device__ void init(int M, int N, int G_, int c_) { nM = M / BM; nN = N / BM; nwg = nM * nN; G = G_; c = c_; }
    __device__ bool next(int i, Unit& u) const {
        const long L = (long)i * G + c; if (L >= nwg) return false;
        int wgid = (int)L; { const int q = nwg / NXCD, r = nwg % NXCD, xcd = wgid % NXCD, off = wgid / NXCD; wgid = (xcd < r ? xcd * (q + 1) : r * (q + 1) + (xcd - r) * q) + off; }
        const int nig = WGM * nN, gid = wgid / nig, fm = gid * WGM, gsz = (nM - fm) < WGM ? (nM - fm) : WGM;
        u.pm = fm + ((wgid % nig) % gsz); u.pn = (wgid % nig) / gsz; u.z = 0; u.arow = u.pm * BM; u.brow = u.pn * BM; return true;
    }
    __device__ __forceinline__ unsigned row_off(const Unit&, int) const { return 0u; }
};

struct DenseOrder2 { DenseOrder base;
    __device__ bool next(int i, Unit& u) const { if (!base.next(i >> 1, u)) return false; u.z = i & 1; return true; }
    __device__ __forceinline__ unsigned row_off(const Unit&, int) const { return 0u; }
};
__device__ __forceinline__ unsigned cvt_pk_bf16(float lo, float hi) { unsigned r; asm volatile("v_cvt_pk_bf16_f32 %0, %1, %2" : "=v"(r) : "v"(lo), "v"(hi)); return r; }


template <class Epi, class Sched, bool GATHER, bool TWOPART = false, bool FP8 = false>
__device__ __forceinline__ void gemm_phase(PG8_LAS unsigned char* lds, const Gemm g, const Sched& S, const Epi& E) {
    int tid_ = threadIdx.x; asm volatile("" : "+v"(tid_));
    const int tid = tid_, wid = __builtin_amdgcn_readfirstlane(tid >> 6), lane = tid & 63, wr = wid >> 2, wc = wid & 3, fr = lane & 15, fq = lane >> 4;
    const int K = g.K, nt = K / BK;
    unsigned voffA[2], voffB[2]; int RA[2];
#pragma unroll
    for (int i = 0; i < 2; ++i) { int R, C; stage_rc(tid * 16 + i * 8192, R, C); const int Rb = Epi::PERM ? ((R & ~31) + perm32(R & 31)) : R;
        RA[i] = R; voffA[i] = GATHER ? (unsigned)(C * 2) : (unsigned)(R * K + C) * 2u; voffB[i] = (unsigned)(Rb * K + C) * 2u; }
    const size_t kstep = (size_t)(BK * 2);
    const size_t hstep = (size_t)HALF * K * 2;
    const unsigned ldsw = (unsigned)wid * 1024u;
    const int aoff = lds_byte(wr * 64 + fr, fq * 8), boff = lds_byte(wc * 32 + fr, fq * 8);
    unsigned gAc[2][2], gAn[2][2];
#define PG8_SA(b, h) (((b) * 2 + (h)) * HTB)
#define PG8_SB(b, h) ((4 + (b) * 2 + (h)) * HTB)
#define PG8_STAGE(bufoff, gbase, voff) do { _Pragma("unroll") for (int _i = 0; _i < 2; ++_i) \
        __builtin_amdgcn_global_load_lds((const unsigned*)((const char*)(gbase) + (voff)[_i]), (PG8_LAS unsigned*)(lds + (bufoff) + ldsw + _i * 8192), 16, 0, 0); } while (0)
#define PG8_STAGEA(bufoff, gbase, h, nx) do { if constexpr (GATHER) { _Pragma("unroll") for (int _i = 0; _i < 2; ++_i) { const unsigned _v = ((nx) ? gAn[h][_i] : gAc[h][_i]) + voffA[_i]; \
        __builtin_amdgcn_global_load_lds((const unsigned*)((const char*)(gbase) + _v), (PG8_LAS unsigned*)(lds + (bufoff) + ldsw + _i * 8192), 16, 0, 0); } } \
        else { PG8_STAGE(bufoff, (const char*)(gbase) + (h) * hstep, voffA); } } while (0)
#define PG8_LD8(base) __builtin_shufflevector(*(const PG8_LAS i32x4*)(base), *(const PG8_LAS i32x4*)((base) + 1024), 0, 1, 2, 3, 4, 5, 6, 7)
#define PG8_LDA(dst, b, h) do { if constexpr (FP8) { _Pragma("unroll") for (int m = 0; m < 4; ++m) dst##8[m] = PG8_LD8(lds + PG8_SA(b, h) + aoff + m * 2048); } \
        else { _Pragma("unroll") for (int m = 0; m < 4; ++m) _Pragma("unroll") for (int k = 0; k < 2; ++k) dst[m][k] = *(const PG8_LAS bf16x8*)(lds + PG8_SA(b, h) + aoff + m * 2048 + k * 1024); } } while (0)
#define PG8_LDB(dst, b, h) do { if constexpr (FP8) { _Pragma("unroll") for (int n = 0; n < 2; ++n) dst##8[n] = PG8_LD8(lds + PG8_SB(b, h) + boff + n * 2048); } \
        else { _Pragma("unroll") for (int n = 0; n < 2; ++n) _Pragma("unroll") for (int k = 0; k < 2; ++k) dst[n][k] = *(const PG8_LAS bf16x8*)(lds + PG8_SB(b, h) + boff + n * 2048 + k * 1024); } } while (0)
#define PG8_CAT(x, y) __builtin_shufflevector(__builtin_bit_cast(i32x4, x), __builtin_bit_cast(i32x4, y), 0, 1, 2, 3, 4, 5, 6, 7)
#define PG8_MMA(ai, bj, At, Bt) do { __builtin_amdgcn_s_setprio(1); \
        if constexpr (FP8) { _Pragma("unroll") for (int m = 0; m < 4; ++m) _Pragma("unroll") for (int n = 0; n < 2; ++n) \
            asm volatile("v_mfma_scale_f32_16x16x128_f8f6f4 %0, %1, %2, %0, %3, %3 op_sel_hi:[0,0,0]" : "+v"(acc[ai][bj][m][n]) : "v"(Bt##8[n]), "v"(At##8[m]), "v"(one8)); } \
        else { _Pragma("unroll") for (int m = 0; m < 4; ++m) _Pragma("unroll") for (int n = 0; n < 2; ++n) _Pragma("unroll") for (int k = 0; k < 2; ++k) \
            acc[ai][bj][m][n] = __builtin_amdgcn_mfma_f32_16x16x32_bf16(Bt[n][k], At[m][k], acc[ai][bj][m][n], 0, 0, 0); } \
        __builtin_amdgcn_s_setprio(0); } while (0)
#define PG8_WAIT_V(n) asm volatile("s_waitcnt vmcnt(" #n ")" ::: "memory")
#define PG8_WAIT_L(n) asm volatile("s_waitcnt lgkmcnt(" #n ")" ::: "memory")
#define PG8_BAR __builtin_amdgcn_s_barrier()
#define PG8_SCHED __builtin_amdgcn_sched_barrier(0)
    Unit cur, nxt; int ui = 0;
    if (!S.next(0, cur)) return;
    f32x4 acc[2][2][4][2];
#pragma unroll
    for (int a = 0; a < 2; ++a)
#pragma unroll
        for (int b = 0; b < 2; ++b)
#pragma unroll
            for (int m = 0; m < 4; ++m)
#pragma unroll
                for (int n = 0; n < 2; ++n) acc[a][b][m][n] = (f32x4){0.f, 0.f, 0.f, 0.f};
    if constexpr (FP8) {
#pragma unroll
        for (int a = 0; a < 2; ++a)
#pragma unroll
            for (int b = 0; b < 2; ++b) asm volatile("s_nop 3" : "+v"(acc[a][b][0][0]), "+v"(acc[a][b][0][1]), "+v"(acc[a][b][1][0]), "+v"(acc[a][b][1][1]), "+v"(acc[a][b][2][0]), "+v"(acc[a][b][2][1]), "+v"(acc[a][b][3][0]), "+v"(acc[a][b][3][1]));
    }
    unsigned one8 = 0x7f7f7f7fu; asm volatile("" : "+v"(one8));
    bf16x8 At[4][2], B0[2][2], B1[2][2];
    i32x8 At8[4], B08[2], B18[2];
    const char* cA = GATHER ? (const char*)g.A : (const char*)((TWOPART && cur.z) ? g.A2 : g.A) + (size_t)cur.arow * K * 2; const char* cB = (const char*)((TWOPART && cur.z) ? g.Bt2 : g.Bt) + (size_t)cur.brow * K * 2;
    if constexpr (GATHER) {
#pragma unroll
        for (int h = 0; h < 2; ++h)
#pragma unroll
            for (int i = 0; i < 2; ++i) { gAc[h][i] = S.row_off(cur, h * HALF + RA[i]); gAn[h][i] = gAc[h][i]; }
    }
    PG8_STAGE(PG8_SB(0, 0), cB, voffB); PG8_STAGE(PG8_SB(0, 1), cB + hstep, voffB); PG8_STAGEA(PG8_SA(0, 0), cA, 0, false); PG8_STAGEA(PG8_SA(0, 1), cA, 1, false);
    if (wr == 1) PG8_BAR;
    PG8_WAIT_V(2); PG8_BAR;
    PG8_STAGE(PG8_SB(1, 0), cB + kstep, voffB); PG8_STAGEA(PG8_SA(1, 0), cA + kstep, 0, false); PG8_STAGE(PG8_SB(1, 1), cB + hstep + kstep, voffB);
    PG8_WAIT_V(6); PG8_BAR;
    for (;;) {
        const bool has_next = S.next(ui + 1, nxt);
        const char* nA = has_next ? (GATHER ? (const char*)g.A : (const char*)((TWOPART && nxt.z) ? g.A2 : g.A) + (size_t)nxt.arow * K * 2) : cA; const char* nB = has_next ? (const char*)((TWOPART && nxt.z) ? g.Bt2 : g.Bt) + (size_t)nxt.brow * K * 2 : cB;
        if constexpr (GATHER) { if (has_next) {
#pragma unroll
            for (int h = 0; h < 2; ++h)
#pragma unroll
                for (int i = 0; i < 2; ++i) gAn[h][i] = S.row_off(nxt, h * HALF + RA[i]); } }
#pragma unroll 1
        for (int t = 0; t < nt; t += 2) {
            const bool last = (t == nt - 2);
            const char* a1 = cA + (size_t)(t + 1) * kstep;
            const char* a2 = last ? nA : cA + (size_t)(t + 2) * kstep; const char* b2 = last ? nB : cB + (size_t)(t + 2) * kstep;
            const char* a3 = a2 + kstep; const char* b3 = b2 + kstep;
            PG8_LDB(B0, 0, 0); PG8_LDB(B1, 0, 1); PG8_SCHED; PG8_LDA(At, 0, 0); PG8_STAGEA(PG8_SA(1, 1), a1, 1, false);
            PG8_WAIT_V(8); PG8_WAIT_L(0); PG8_BAR; PG8_MMA(0, 0, At, B0); PG8_MMA(0, 1, At, B1); PG8_BAR; PG8_SCHED;
            PG8_LDA(At, 0, 1); PG8_STAGE(PG8_SB(0, 0), b2, voffB); PG8_STAGE(PG8_SB(0, 1), b2 + hstep, voffB); PG8_STAGEA(PG8_SA(0, 0), a2, 0, last);
            PG8_WAIT_V(8); PG8_WAIT_L(0); PG8_BAR; PG8_MMA(1, 0, At, B0); PG8_MMA(1, 1, At, B1); PG8_BAR; PG8_SCHED;
            PG8_LDB(B0, 1, 0); PG8_LDB(B1, 1, 1); PG8_SCHED; PG8_LDA(At, 1, 0); PG8_STAGEA(PG8_SA(0, 1), a2, 1, last);
            PG8_WAIT_V(8); PG8_WAIT_L(0); PG8_BAR; PG8_MMA(0, 0, At, B0); PG8_MMA(0, 1, At, B1); PG8_BAR; PG8_SCHED;
            PG8_LDA(At, 1, 1); PG8_STAGE(PG8_SB(1, 0), b3, voffB); PG8_STAGE(PG8_SB(1, 1), b3 + hstep, voffB); PG8_STAGEA(PG8_SA(1, 0), a3, 0, last);
            PG8_WAIT_V(8); PG8_WAIT_L(0); PG8_BAR; PG8_MMA(1, 0, At, B0); PG8_MMA(1, 1, At, B1); PG8_BAR; PG8_SCHED;
        }
        if constexpr (FP8) asm volatile("s_nop 15\n\ts_nop 15" ::: "memory");
        if (wr == 0) PG8_BAR;
        const bool keep = E(acc, cur, wr, wc, fr, fq);
        if (!has_next) break;
        if (!(TWOPART && keep))
#pragma unroll
        for (int a = 0; a < 2; ++a)
#pragma unroll
            for (int b = 0; b < 2; ++b)
#pragma unroll
                for (int m = 0; m < 4; ++m)
#pragma unroll
                    for (int n = 0; n < 2; ++n) acc[a][b][m][n] = (f32x4){0.f, 0.f, 0.f, 0.f};
        if constexpr (FP8) {
#pragma unroll
        for (int a = 0; a < 2; ++a)
#pragma unroll
            for (int b = 0; b < 2; ++b) asm volatile("s_nop 3" : "+v"(acc[a][b][0][0]), "+v"(acc[a][b][0][1]), "+v"(acc[a][b][1][0]), "+v"(acc[a][b][1][1]), "+v"(acc[a][b][2][0]), "+v"(acc[a][b][2][1]), "+v"(acc[a][b][3][0]), "+v"(acc[a][b][3][1]));
    }
        cur = nxt; cA = nA; cB = nB; ++ui;
        if constexpr (GATHER) {
#pragma unroll
            for (int h = 0; h < 2; ++h)
#pragma unroll
                for (int i = 0; i < 2; ++i) gAc[h][i] = gAn[h][i];
        }
        if (wr == 1) PG8_BAR;
    }
    PG8_WAIT_V(0);
    PG8_BAR;
#undef PG8_SA
#undef PG8_SB
#undef PG8_STAGE
#undef PG8_STAGEA
#undef PG8_LDA
#undef PG8_LDB
#undef PG8_MMA
#undef PG8_CAT
#undef PG8_LD8
#undef PG8_WAIT_V
#undef PG8_WAIT_L
#undef PG8_BAR
#undef PG8_SCHED
}
}
namespace at {
typedef short bf16x8 __attribute__((ext_vector_type(8)));
typedef short s16x4 __attribute__((ext_vector_type(4)));
typedef float f32x16 __attribute__((ext_vector_type(16)));
typedef unsigned u32x4 __attribute__((ext_vector_type(4)));
typedef __attribute__((address_space(3))) const char* lds_cptr;
typedef short v4i16_t __attribute__((ext_vector_type(4)));
constexpr int SLOT = 32768, L_WSF = 4 * SLOT + 2048;
constexpr float C2 = 0.125f * 1.4426950408889634f;
__device__ __forceinline__ int crow(int r, int hi) { return (r & 3) + 8 * (r >> 2) + 4 * hi; }
__device__ __forceinline__ void glds16(const void* gsrc, unsigned lds_dst) { unsigned keep;
    asm volatile("s_mov_b32 %0, m0\n\ts_mov_b32 m0, %2\n\ts_nop 0\n\tglobal_load_lds_dwordx4 %1, off\n\ts_mov_b32 m0, %0" : "=&s"(keep) : "v"(gsrc), "s"(lds_dst) : "memory"); }
typedef float f32x2_t __attribute__((ext_vector_type(2))); typedef __bf16 bf16x2_t __attribute__((ext_vector_type(2)));
__device__ __forceinline__ unsigned cvtpk(float lo, float hi) { f32x2_t v = {lo, hi}; bf16x2_t b = __builtin_convertvector(v, bf16x2_t); return __builtin_bit_cast(unsigned, b); }
__device__ __forceinline__ s16x4 vtr(lds_cptr p) { return __builtin_bit_cast(s16x4, __builtin_amdgcn_ds_read_tr16_b64_v4i16((__attribute__((address_space(3))) v4i16_t*)p)); }
#define AT_WAIT_BAR(N) asm volatile("s_waitcnt vmcnt(" #N ") lgkmcnt(0)\n\ts_barrier" ::: "memory")

__device__ __forceinline__ void attn_unit(__attribute__((address_space(3))) unsigned char* lds, const bf16_t* QR, const bf16_t* KIMG, const bf16_t* VIMG, bf16_t* YA, const float* subln, float lam, const unsigned* KMAX,
                                          int b, int h, int blk, int tid) {
    typedef __attribute__((address_space(3))) float lds_f;
    asm volatile("" : "+v"(tid));
    const int lane = tid & 63, r32 = lane & 31, hi = lane >> 5; const int w = __builtin_amdgcn_readfirstlane(tid >> 6), m = w & 1, rg = w >> 1;
    const int NT = 2 * blk + 2, bh = b * 4 + h;
    const size_t tokb = (size_t)b * 8192;
    const unsigned lds0 = (unsigned)(size_t)lds;
    const bf16_t* ksrc0 = KIMG + ((size_t)bh * 128 * 16 + 2 * w) * 512 + lane * 8;
    const bf16_t* vsrc0 = VIMG + ((size_t)bh * 128 * 16 + 2 * w) * 512 + lane * 8;
#define AT_DMA(t, slotoff) do { const bf16_t* ks_ = ksrc0 + (size_t)(t) * 8192; const bf16_t* vs_ = vsrc0 + (size_t)(t) * 8192; \
        const unsigned kd_ = (unsigned)__builtin_amdgcn_readfirstlane(lds0 + (unsigned)(slotoff) + (unsigned)w * 2048u); \
        glds16(ks_, kd_); glds16(ks_ + 512, kd_ + 1024u); glds16(vs_, kd_ + 16384u); glds16(vs_ + 512, kd_ + 16384u + 1024u); } while (0)
#define AT_QK(P0, P1, slotoff) do { const lds_cptr kp_ = (lds_cptr)(lds + (slotoff)) + (m * 8 + hi) * 1024 + r32 * 16; \
        _Pragma("unroll") for (int d0 = 0; d0 < 4; ++d0) { const bf16x8 k0 = *(const __attribute__((address_space(3))) bf16x8*)(kp_ + d0 * 2048), k1 = *(const __attribute__((address_space(3))) bf16x8*)(kp_ + d0 * 2048 + 512); \
            P0 = __builtin_amdgcn_mfma_f32_32x32x16_bf16(k0, qr[d0], d0 == 0 ? negm : P0, 0, 0, 0); P1 = __builtin_amdgcn_mfma_f32_32x32x16_bf16(k1, qr[d0], d0 == 0 ? negm : P1, 0, 0, 0); } } while (0)
    bf16x8 qr[4];
    { const bf16_t* qp = QR + ((((size_t)(b * 4 + h) * 128 + blk * 2 + (rg >> 1)) * 16 + m * 8 + hi) * 64 + (rg & 1) * 32 + r32) * 8;
#pragma unroll
      for (int d0 = 0; d0 < 4; ++d0) qr[d0] = *(const bf16x8*)(qp + (size_t)d0 * 1024); }
    AT_DMA(0, 0); AT_DMA(1, SLOT); if (NT > 2) AT_DMA(2, 2 * SLOT);
    f32x16 o[4];
#pragma unroll
    for (int i = 0; i < 4; ++i) o[i] = f32x16{};
    float lsum = 0.f; f32x16 negm;
    float mhat;
    { float qs = 0.f;
#pragma unroll
      for (int d0 = 0; d0 < 4; ++d0)
#pragma unroll
          for (int j = 0; j < 8; ++j) { const float qv = __uint_as_float(((unsigned)(unsigned short)qr[d0][j]) << 16); qs += qv * qv; }
      auto rr = __builtin_amdgcn_permlane32_swap(__float_as_uint(qs), __float_as_uint(qs), false, false); qs = __uint_as_float(rr[0]) + __uint_as_float(rr[1]);
      float k2 = 0.f;
#pragma unroll
      for (int gq = 0; gq < 8; ++gq) k2 += __uint_as_float(KMAX[(bh * 2 + m) * 8 + gq]);
      mhat = 1.01f * sqrtf(qs * k2);
#pragma unroll
      for (int r = 0; r < 16; ++r) negm[r] = -mhat; }
    lds_f* wsf = (lds_f*)(lds + L_WSF) + w * 32;
    f32x16 pA0, pA1, pB0 = f32x16{}, pB1 = f32x16{};
    if (NT > 2) { AT_WAIT_BAR(8); } else { AT_WAIT_BAR(4); }
    AT_QK(pA0, pA1, 0);
    int s0 = 0, s1 = SLOT, s3 = 3 * SLOT;
    const int vlane = ((lane >> 4) & 1) * 32 + (lane & 3) * 8 + (4 * hi + ((lane & 15) >> 2)) * 64;
#define AT_VLOAD(VF, i) do { _Pragma("unroll") for (int k2 = 0; k2 < 2; ++k2) { const int off_ = ((i) >> 1) * 4096 + (((i) & 1) * 2 + k2) * 1024; const s16x4 lo_ = vtr(vp_ + off_), hi_ = vtr(vp_ + off_ + 512); \
        VF[k2] = (bf16x8){lo_[0], lo_[1], lo_[2], lo_[3], hi_[0], hi_[1], hi_[2], hi_[3]}; } } while (0)
#define AT_PVMMA(VF, i) do { _Pragma("unroll") for (int k2 = 0; k2 < 2; ++k2) o[(i) >> 1] = __builtin_amdgcn_mfma_f32_32x32x16_bf16(pa[k2], VF[k2], o[(i) >> 1], 0, 0, 0); } while (0)
#define AT_SB() __builtin_amdgcn_sched_barrier(0)
#define AT_STEP(PC0, PC1, PN0, PN1, DOQK, DOSM) do { AT_SB(); \
        bf16x8 kf[4]; const lds_cptr kp_ = (lds_cptr)(lds + s1) + (m * 8 + hi) * 1024 + r32 * 16; \
        if (DOQK) { _Pragma("unroll") for (int d0 = 0; d0 < 2; ++d0) { kf[2 * d0] = *(const __attribute__((address_space(3))) bf16x8*)(kp_ + d0 * 2048); kf[2 * d0 + 1] = *(const __attribute__((address_space(3))) bf16x8*)(kp_ + d0 * 2048 + 512); } } \
        const lds_cptr vp_ = (lds_cptr)(lds + s0 + 16384) + vlane; bf16x8 vfa[2], vfb[2]; \
        if (DOSM) AT_VLOAD(vfa, 0); \
        if (DOQK) { \
            PN0 = __builtin_amdgcn_mfma_f32_32x32x16_bf16(kf[0], qr[0], negm, 0, 0, 0); PN1 = __builtin_amdgcn_mfma_f32_32x32x16_bf16(kf[1], qr[0], negm, 0, 0, 0); \
            PN0 = __builtin_amdgcn_mfma_f32_32x32x16_bf16(kf[2], qr[1], PN0, 0, 0, 0); PN1 = __builtin_amdgcn_mfma_f32_32x32x16_bf16(kf[3], qr[1], PN1, 0, 0, 0); \
            _Pragma("unroll") for (int d0 = 0; d0 < 2; ++d0) { kf[2 * d0] = *(const __attribute__((address_space(3))) bf16x8*)(kp_ + (d0 + 2) * 2048); kf[2 * d0 + 1] = *(const __attribute__((address_space(3))) bf16x8*)(kp_ + (d0 + 2) * 2048 + 512); } \
            PN0 = __builtin_amdgcn_mfma_f32_32x32x16_bf16(kf[0], qr[2], PN0, 0, 0, 0); PN1 = __builtin_amdgcn_mfma_f32_32x32x16_bf16(kf[1], qr[2], PN1, 0, 0, 0); \
            PN0 = __builtin_amdgcn_mfma_f32_32x32x16_bf16(kf[2], qr[3], PN0, 0, 0, 0); PN1 = __builtin_amdgcn_mfma_f32_32x32x16_bf16(kf[3], qr[3], PN1, 0, 0, 0); } \
        if (DOSM) { \
            float sacc = 0.f; bf16x8 pa[2]; \
            _Pragma("unroll") for (int r = 0; r < 16; ++r) { PC0[r] = __builtin_amdgcn_exp2f(PC0[r]); sacc += PC0[r]; } \
            pa[0] = __builtin_bit_cast(bf16x8, (u32x4){cvtpk(PC0[0], PC0[1]), cvtpk(PC0[2], PC0[3]), cvtpk(PC0[4], PC0[5]), cvtpk(PC0[6], PC0[7])}); \
            pa[1] = __builtin_bit_cast(bf16x8, (u32x4){cvtpk(PC0[8], PC0[9]), cvtpk(PC0[10], PC0[11]), cvtpk(PC0[12], PC0[13]), cvtpk(PC0[14], PC0[15])}); \
            AT_VLOAD(vfb, 2); AT_PVMMA(vfa, 0); AT_VLOAD(vfa, 4); AT_PVMMA(vfb, 2); AT_VLOAD(vfb, 6); AT_PVMMA(vfa, 4); AT_VLOAD(vfa, 1); AT_PVMMA(vfb, 6); \
            _Pragma("unroll") for (int r = 0; r < 16; ++r) { PC1[r] = __builtin_amdgcn_exp2f(PC1[r]); sacc += PC1[r]; } \
            lsum += sacc; asm volatile("" : "+v"(lsum)); \
            pa[0] = __builtin_bit_cast(bf16x8, (u32x4){cvtpk(PC1[0], PC1[1]), cvtpk(PC1[2], PC1[3]), cvtpk(PC1[4], PC1[5]), cvtpk(PC1[6], PC1[7])}); \
            pa[1] = __builtin_bit_cast(bf16x8, (u32x4){cvtpk(PC1[8], PC1[9]), cvtpk(PC1[10], PC1[11]), cvtpk(PC1[12], PC1[13]), cvtpk(PC1[14], PC1[15])}); \
            AT_VLOAD(vfb, 3); AT_PVMMA(vfa, 1); AT_VLOAD(vfa, 5); AT_PVMMA(vfb, 3); AT_VLOAD(vfb, 7); AT_PVMMA(vfa, 5); AT_PVMMA(vfb, 7); } \
        AT_SB(); \
        s0 = s1; s1 = (s1 == 3 * SLOT) ? 0 : s1 + SLOT; s3 = (s3 == 3 * SLOT) ? 0 : s3 + SLOT; \
    } while (0)
    for (int t = 0; t + 2 < NT; t += 2) {
        AT_WAIT_BAR(4); if (t + 3 < NT) AT_DMA(t + 3, s3);
        AT_STEP(pA0, pA1, pB0, pB1, true, true);
        AT_WAIT_BAR(4); if (t + 4 < NT) AT_DMA(t + 4, s3);
        AT_STEP(pB0, pB1, pA0, pA1, true, true);
    }
    if (rg < 2) {
#pragma unroll
        for (int r = 0; r < 16; ++r) negm[r] = -1e30f; }
    AT_WAIT_BAR(0);
    AT_STEP(pA0, pA1, pB0, pB1, true, true);
    AT_WAIT_BAR(0);
    AT_STEP(pB0, pB1, pA0, pA1, false, true);
    AT_WAIT_BAR(0);
    { auto rr = __builtin_amdgcn_permlane32_swap(__float_as_uint(lsum), __float_as_uint(lsum), false, false); lsum = __uint_as_float(rr[0]) + __uint_as_float(rr[1]); }
    if (hi == 0) wsf[r32] = (m == 0 ? 1.f : -lam) / lsum;
    asm volatile("s_waitcnt lgkmcnt(0)" ::: "memory");
#pragma unroll
    for (int r = 0; r < 16; ++r) { const float fr_ = wsf[crow(r, hi)];
#pragma unroll
        for (int d = 0; d < 4; ++d) o[d][r] *= fr_; }
    AT_WAIT_BAR(0);
    lds_f* X = (lds_f*)lds + rg * 4096;
    if (m == 1) {
#pragma unroll
        for (int d = 0; d < 4; ++d)
#pragma unroll
            for (int r = 0; r < 16; ++r) X[(d * 16 + r) * 64 + lane] = o[d][r];
    }
    AT_WAIT_BAR(0);
    if (m == 0) {
        float ssq[16];
#pragma unroll
        for (int r = 0; r < 16; ++r) { float s = 0.f;
#pragma unroll
            for (int d = 0; d < 4; ++d) { o[d][r] += X[(d * 16 + r) * 64 + lane]; s += o[d][r] * o[d][r]; }
            ssq[r] = s; }
#pragma unroll
        for (int r = 0; r < 16; ++r) { float s = ssq[r];
#pragma unroll
            for (int of = 1; of < 32; of <<= 1) s += __shfl_xor(s, of);
            ssq[r] = rsqrtf(s * (1.f / 128.f) + 1e-6f) * 0.8f; }
        float sw[4];
#pragma unroll
        for (int d = 0; d < 4; ++d) sw[d] = subln[d * 32 + r32];
        bf16_t* yp = YA + (tokb + blk * 128 + rg * 32) * 512 + h * 128 + r32;
#pragma unroll
        for (int r = 0; r < 16; ++r)
#pragma unroll
            for (int d = 0; d < 4; ++d) yp[(size_t)crow(r, hi) * 512 + d * 32] = f2bf(o[d][r] * ssq[r] * sw[d]);
    }
    AT_WAIT_BAR(0);
#undef AT_DMA
#undef AT_QK
#undef AT_STEP
#undef AT_SB
#undef AT_VLOAD
#undef AT_PVMMA
}
}
namespace hg {
using at::bf16x8; using at::s16x4; using at::f32x16; using at::u32x4; using at::lds_cptr; using at::crow; using at::vtr; using at::cvtpk;
typedef __attribute__((address_space(3))) unsigned char lds_u8;
typedef __attribute__((address_space(3))) float lds_f;
typedef __attribute__((address_space(3))) bf16_t lds_h;
__device__ __forceinline__ float sigm(float x) { return __builtin_amdgcn_rcpf(1.f + __expf(-x)); }
__device__ __forceinline__ bf16x8 mkfrag(s16x4 a, s16x4 b) { return (bf16x8){a[0], a[1], a[2], a[3], b[0], b[1], b[2], b[3]}; }
template <int ROWS>
__device__ __forceinline__ void copy_img(lds_u8* lds, int off, const bf16_t* g, size_t gp, int tid) {
#pragma unroll
    for (int i = 0; i < ROWS * 16 / 512; ++i) { const int p = tid + 512 * i, r = p >> 4, q = p & 15;
        const u32x4 v = *(const u32x4*)(g + (size_t)r * gp + q * 8);
        *(__attribute__((address_space(3))) u32x4*)(lds + off + (q >> 2) * (ROWS * 64) + r * 64 + (q & 3) * 16) = v; }
}
__device__ __forceinline__ void copy_raw(lds_u8* lds, int off, const bf16_t* g, size_t gp, int tid) {
#pragma unroll
    for (int i = 0; i < 2; ++i) { const int p = tid + 512 * i, r = p >> 4, q = p & 15;
        const u32x4 v = *(const u32x4*)(g + (size_t)r * gp + q * 8);
        *(__attribute__((address_space(3))) u32x4*)(lds + off + r * 256 + q * 16) = v; }
}
struct ARegs { u32x4 v[2], rf[2]; };
struct CRegs { u32x4 v[2], sp[4], rf[2], rq[2]; };
__device__ __forceinline__ void ld_tile64(u32x4 (&r)[2], const bf16_t* g, size_t gp, int tid) {
#pragma unroll
    for (int i = 0; i < 2; ++i) { const int p = tid + 512 * i; r[i] = *(const u32x4*)(g + (size_t)(p >> 4) * gp + (p & 15) * 8); } }
__device__ __forceinline__ void st_img64(lds_u8* lds, int off, const u32x4 (&r)[2], int tid) {
#pragma unroll
    for (int i = 0; i < 2; ++i) { const int p = tid + 512 * i, rr = p >> 4, q = p & 15; *(__attribute__((address_space(3))) u32x4*)(lds + off + (q >> 2) * 4096 + rr * 64 + (q & 3) * 16) = r[i]; } }
__device__ __forceinline__ void st_raw64(lds_u8* lds, int off, const u32x4 (&r)[2], int tid) {
#pragma unroll
    for (int i = 0; i < 2; ++i) { const int p = tid + 512 * i; *(__attribute__((address_space(3))) u32x4*)(lds + off + (p >> 4) * 256 + (p & 15) * 16) = r[i]; } }
__device__ __forceinline__ void hgA_load(ARegs& R, const bf16_t* PROJ, int bh, int n, int tid) {
    const size_t tok0 = (size_t)(bh >> 2) * 8192 + n * 64; const int h = bh & 3;
    ld_tile64(R.v, PROJ + tok0 * 5632 + 2560 + h * 128, 5632, tid); ld_tile64(R.rf, PROJ + tok0 * 5632 + 2048 + h * 128, 5632, tid); }
__device__ __forceinline__ void hgC_load(CRegs& R, const bf16_t* PROJ, const bf16_t* SP, int bh, int n, int tid) {
    const size_t tok0 = (size_t)(bh >> 2) * 8192 + n * 64; const int h = bh & 3;
    ld_tile64(R.v, PROJ + tok0 * 5632 + 2560 + h * 128, 5632, tid); ld_tile64(R.rf, PROJ + tok0 * 5632 + 2048 + h * 128, 5632, tid); ld_tile64(R.rq, PROJ + tok0 * 5632 + 1536 + h * 128, 5632, tid);
    const bf16_t* sp = SP + (size_t)(bh * 128 + n) * 16384;
#pragma unroll
    for (int i = 0; i < 4; ++i) { const int p = tid + 512 * i; R.sp[i] = __builtin_nontemporal_load((const u32x4*)(sp + (size_t)(p >> 4) * 128 + (p & 15) * 8)); } }
__device__ __forceinline__ void gates(lds_u8* lds, int psum_off, int rawf_off, float lb, int tid, float (&f)[16], float (&G)[16], float& glast) {
    const int d = tid & 127, part = tid >> 7; lds_f* psum = (lds_f*)(lds + psum_off); const lds_h* rf = (const lds_h*)(lds + rawf_off) + part * 16 * 128 + d;
    float g = 0.f;
#pragma unroll
    for (int i = 0; i < 16; ++i) { const float raw = bf2f(rf[i * 128]); f[i] = lb + (1.f - lb) * sigm(raw); g += __logf(f[i]); G[i] = g; }
    psum[part * 128 + d] = g;
    __syncthreads();
    const float p0 = psum[d], p1 = psum[128 + d], p2 = psum[256 + d], p3 = psum[384 + d];
    const float offs = (part > 0 ? p0 : 0.f) + (part > 1 ? p1 : 0.f) + (part > 2 ? p2 : 0.f);
    glast = (p0 + p1) + (p2 + p3);
#pragma unroll
    for (int i = 0; i < 16; ++i) G[i] += offs;
}
constexpr int A_KD = 0, A_V = 16384, A_PS = 32768, A_RAWF = 36864, A_OUT = 53248;
__device__ __forceinline__ void hgA_unit(lds_u8* lds, ARegs& R, const bf16_t* PROJ, const float* SCAL, bf16_t* DS, float* DEC, int bh, int n, int nbh, int nn, int tid) {
    const int h = bh & 3, b = bh >> 2, lane = tid & 63, r32 = lane & 31, hi = lane >> 5, w = __builtin_amdgcn_readfirstlane(tid >> 6), d = tid & 127, part = tid >> 7;
    const size_t tok0 = (size_t)b * 8192 + n * 64;
    __syncthreads();
    st_img64(lds, A_V, R.v, tid); st_raw64(lds, A_RAWF, R.rf, tid);
    if (nbh >= 0) hgA_load(R, PROJ, nbh, nn, tid);
    __syncthreads();
    float f[16], G[16], glast;
    gates(lds, A_PS, A_RAWF, SCAL[64 + h * 128 + d], tid, f, G, glast);
    lds_h* kd = (lds_h*)(lds + A_KD) + (d >> 5) * 2048 + (d & 31);
#pragma unroll
    for (int i = 0; i < 16; ++i) kd[(part * 16 + i) * 32] = f2bf((1.f - f[i]) * __expf(glast - G[i]));
    if (part == 0) DEC[(size_t)(bh * 128 + n) * 128 + d] = __expf(glast);
    __syncthreads();
    const int dt = w >> 1, vh = w & 1;
    const int lof = ((lane >> 4) & 1) * 32 + (lane & 3) * 8 + (8 * hi + ((lane & 15) >> 2)) * 64;
    const lds_cptr ap = (lds_cptr)(lds + A_KD) + dt * 4096 + lof;
    f32x16 acc[2] = {f32x16{}, f32x16{}};
#pragma unroll
    for (int ks = 0; ks < 4; ++ks) { const bf16x8 af = mkfrag(vtr(ap + ks * 1024), vtr(ap + ks * 1024 + 256));
#pragma unroll
        for (int t = 0; t < 2; ++t) { const lds_cptr bp = (lds_cptr)(lds + A_V) + (2 * vh + t) * 4096 + lof;
            const bf16x8 bfr = mkfrag(vtr(bp + ks * 1024), vtr(bp + ks * 1024 + 256));
            acc[t] = __builtin_amdgcn_mfma_f32_32x32x16_bf16(af, bfr, acc[t], 0, 0, 0); } }
    lds_h* ot = (lds_h*)(lds + A_OUT) + (dt * 32) * 128 + vh * 64 + r32;
#pragma unroll
    for (int t = 0; t < 2; ++t)
#pragma unroll
        for (int r = 0; r < 16; ++r) ot[crow(r, hi) * 128 + t * 32] = f2bf(acc[t][r]);
    __syncthreads();
    bf16_t* dst = DS + (size_t)(bh * 128 + n) * 16384;
#pragma unroll
    for (int i = 0; i < 4; ++i) { const int p = tid + 512 * i; *(u32x4*)(dst + p * 8) = *(const __attribute__((address_space(3))) u32x4*)(lds + A_OUT + p * 16); }
}
constexpr int C_QT = 0, C_KT = 16384, C_V = 32768, C_SP = 49152, C_PS = 81920, C_RAWF = 86016, C_RAWQ = 102400, C_OT = 86016;
__device__ __forceinline__ void hgC_unit(lds_u8* lds, CRegs& R, const bf16_t* PROJ, const float* SCAL, const bf16_t* SP, const float* hgnorm, bf16_t* YB, int bh, int n, int nbh, int nn, int tid) {
    const int h = bh & 3, b = bh >> 2, lane = tid & 63, r32 = lane & 31, hi = lane >> 5, w = __builtin_amdgcn_readfirstlane(tid >> 6), d = tid & 127, part = tid >> 7;
    const size_t tok0 = (size_t)b * 8192 + n * 64;
    __syncthreads();
    st_img64(lds, C_V, R.v, tid); st_raw64(lds, C_RAWF, R.rf, tid); st_raw64(lds, C_RAWQ, R.rq, tid);
#pragma unroll
    for (int i = 0; i < 4; ++i) { const int p = tid + 512 * i, rr = p >> 4, q = p & 15; *(__attribute__((address_space(3))) u32x4*)(lds + C_SP + (q >> 2) * 8192 + rr * 64 + (q & 3) * 16) = R.sp[i]; }
    if (nbh >= 0) hgC_load(R, PROJ, SP, nbh, nn, tid);
    __syncthreads();
    { float f[16], G[16], glast;
      gates(lds, C_PS, C_RAWF, SCAL[64 + h * 128 + d], tid, f, G, glast);
      const lds_h* rq = (const lds_h*)(lds + C_RAWQ) + part * 16 * 128 + d;
      lds_h* qt = (lds_h*)(lds + C_QT) + (d >> 3) * 512 + (d & 7) + part * 16 * 8; lds_h* kt = (lds_h*)(lds + C_KT) + (d >> 3) * 512 + (d & 7) + part * 16 * 8;
#pragma unroll
      for (int i = 0; i < 16; ++i) { const float q = bf2f(rq[i * 128]); const float eg = __expf(G[i]);
          qt[i * 8] = f2bf(q * sigm(q) * eg); kt[i * 8] = f2bf((1.f - f[i]) * __builtin_amdgcn_rcpf(eg)); } }
    __syncthreads();
    const int ct = w & 1, vb = w >> 1;
    bf16x8 qf[8];
    { const lds_cptr qp = (lds_cptr)(lds + C_QT) + hi * 1024 + (32 * ct + r32) * 16;
#pragma unroll
      for (int ks = 0; ks < 8; ++ks) qf[ks] = *(const __attribute__((address_space(3))) bf16x8*)(qp + ks * 2048); }
    f32x16 o = f32x16{};
#pragma unroll
    for (int sh = 0; sh < 2; ++sh) { if (sh <= ct) {
        const lds_cptr kp = (lds_cptr)(lds + C_KT) + hi * 1024 + (32 * sh + r32) * 16;
        f32x16 p = f32x16{};
#pragma unroll
        for (int ks = 0; ks < 8; ++ks) { const bf16x8 kf = *(const __attribute__((address_space(3))) bf16x8*)(kp + ks * 2048); p = __builtin_amdgcn_mfma_f32_32x32x16_bf16(kf, qf[ks], p, 0, 0, 0); }
        const int cc = 32 * ct + r32;
#pragma unroll
        for (int r = 0; r < 16; ++r) { const int s = 32 * sh + crow(r, hi); if (s > cc) p[r] = 0.f; }
        const bf16x8 pa0 = __builtin_bit_cast(bf16x8, (u32x4){cvtpk(p[0], p[1]), cvtpk(p[2], p[3]), cvtpk(p[4], p[5]), cvtpk(p[6], p[7])});
        const bf16x8 pa1 = __builtin_bit_cast(bf16x8, (u32x4){cvtpk(p[8], p[9]), cvtpk(p[10], p[11]), cvtpk(p[12], p[13]), cvtpk(p[14], p[15])});
        const lds_cptr vp = (lds_cptr)(lds + C_V) + vb * 4096 + ((lane >> 4) & 1) * 32 + (lane & 3) * 8 + (4 * hi + ((lane & 15) >> 2)) * 64 + sh * 2048;
        o = __builtin_amdgcn_mfma_f32_32x32x16_bf16(pa0, mkfrag(vtr(vp), vtr(vp + 512)), o, 0, 0, 0);
        o = __builtin_amdgcn_mfma_f32_32x32x16_bf16(pa1, mkfrag(vtr(vp + 1024), vtr(vp + 1024 + 512)), o, 0, 0, 0); } }
    { const lds_cptr sp = (lds_cptr)(lds + C_SP) + vb * 8192 + ((lane >> 4) & 1) * 32 + (lane & 3) * 8 + (8 * hi + ((lane & 15) >> 2)) * 64;
#pragma unroll
      for (int ks = 0; ks < 8; ++ks) o = __builtin_amdgcn_mfma_f32_32x32x16_bf16(qf[ks], mkfrag(vtr(sp + ks * 1024), vtr(sp + ks * 1024 + 256)), o, 0, 0, 0); }
    { lds_f* ot = (lds_f*)(lds + C_OT) + (32 * ct) * 128 + 32 * vb + r32;
#pragma unroll
      for (int r = 0; r < 16; ++r) ot[crow(r, hi) * 128] = o[r]; }
    __syncthreads();
    { const int c = tid >> 3, sg = tid & 7; const __attribute__((address_space(3))) at::u32x4* orow = (const __attribute__((address_space(3))) at::u32x4*)(lds + C_OT + c * 512 + sg * 64);
      float ov[16]; float ss = 0.f;
#pragma unroll
      for (int q = 0; q < 4; ++q) { const at::u32x4 t4 = orow[q]; ov[4 * q] = __uint_as_float(t4.x); ov[4 * q + 1] = __uint_as_float(t4.y); ov[4 * q + 2] = __uint_as_float(t4.z); ov[4 * q + 3] = __uint_as_float(t4.w); }
#pragma unroll
      for (int q = 0; q < 16; ++q) ss += ov[q] * ov[q];
      ss += __shfl_xor(ss, 1); ss += __shfl_xor(ss, 2); ss += __shfl_xor(ss, 4);
      const float rstd = rsqrtf(ss * (1.f / 128.f) + 1e-6f);
      const bf16_t* gp = PROJ + (tok0 + c) * 5632 + 3072 + h * 128 + sg * 16; const u32x4 g0 = *(const u32x4*)gp, g1 = *(const u32x4*)(gp + 8);
      const unsigned gw[8] = {g0.x, g0.y, g0.z, g0.w, g1.x, g1.y, g1.z, g1.w}; unsigned ow[8];
#pragma unroll
      for (int q = 0; q < 8; ++q) { const float ga = __uint_as_float(gw[q] << 16), gb = __uint_as_float(gw[q] & 0xffff0000u);
          const float ra = ov[2 * q] * rstd * hgnorm[sg * 16 + 2 * q] * (ga * sigm(ga)), rb = ov[2 * q + 1] * rstd * hgnorm[sg * 16 + 2 * q + 1] * (gb * sigm(gb));
          ow[q] = cvtpk(ra, rb); }
      bf16_t* dst = YB + (tok0 + c) * 512 + h * 128 + sg * 16; *(u32x4*)dst = (u32x4){ow[0], ow[1], ow[2], ow[3]}; *(u32x4*)(dst + 8) = (u32x4){ow[4], ow[5], ow[6], ow[7]}; }
}
}
namespace mk {
using pg8::f32x4; using pg8::u32x4; using pg8::u32x2; using pg8::Unit;
constexpr int NWAVES = 8, NTHR = 512;
constexpr int RING_BYTES = 131072, LDSCTL_OFF = RING_BYTES, LDS_BYTES = 147456;
constexpr int LW_BAR = 0, LW_TPRE = 16  , LW_CNT = 64  , LW_MISC = 128;
enum Phase { PH_PRO = 0, PH_H1, PH_G1, PH_ROPE_HGA, PH_ATT_SCAN, PH_HGC, PH_G2A, PH_G2B, PH_G3, PH_TOK, PH_G4, PH_G5, PH_FIN, PH_N };

struct Args {
    const float* in[25]; float* out; unsigned char* ws; int ph_lo, ph_hi, li, pad;
};

__device__ __forceinline__ float wave_sum(float v) {
#pragma unroll
    for (int o = 1; o < 64; o <<= 1) v += __shfl_xor(v, o);
    return v;
}
__device__ __forceinline__ float sigm(float x) { return __builtin_amdgcn_rcpf(1.f + __expf(-x)); }
__device__ __forceinline__ unsigned pk2(float lo, float hi) { return at::cvtpk(lo, hi); }

__device__ __forceinline__ unsigned pk4_fp8(float a, float b, float c, float d) { unsigned w = __builtin_amdgcn_cvt_pk_fp8_f32(a, b, 0u, false); return __builtin_amdgcn_cvt_pk_fp8_f32(c, d, w, true); }
constexpr float S8_W = 64.f, S8_H = 4.f, S8_A = 4.f, S8_Y = 4.f;
struct EpiBf16 {
    static constexpr bool PERM = true;
    bf16_t* O; int ldc;
    __device__ __forceinline__ bool operator()(f32x4 (&acc)[2][2][4][2], const Unit& u, int wr, int wc, int fr, int fq) const {
        const int row0 = u.pm * 256 + wr * 64 + fr, col0 = u.pn * 256 + wc * 32 + 8 * fq;
#pragma unroll
        for (int ai = 0; ai < 2; ++ai)
#pragma unroll
            for (int m = 0; m < 4; ++m) { bf16_t* rowp = O + (size_t)(row0 + ai * 128 + m * 16) * ldc + col0;
#pragma unroll
                for (int bj = 0; bj < 2; ++bj) { const f32x4 v0 = acc[ai][bj][m][0], v1 = acc[ai][bj][m][1]; u32x4 w; w.x = pk2(v0[0], v0[1]); w.y = pk2(v0[2], v0[3]); w.z = pk2(v1[0], v1[1]); w.w = pk2(v1[2], v1[3]);
                    *(u32x4*)(rowp + bj * 128) = w; } }
        return false;
    }
};
struct EpiProj {
    static constexpr bool PERM = true;
    bf16_t* O; const float* ropec; const float* ropes; bf16_t* qimg; bf16_t* kimg; bf16_t* vimg; unsigned* kmaxp;
    __device__ __forceinline__ bool operator()(f32x4 (&acc)[2][2][4][2], const Unit& u, int wr, int wc, int fr, int fq) const {
        const int row0 = u.pm * 256 + wr * 64 + fr;
        if (u.pn >= 6) { const int col0 = u.pn * 256 + wc * 32 + 8 * fq;
#pragma unroll
            for (int ai = 0; ai < 2; ++ai)
#pragma unroll
                for (int m = 0; m < 4; ++m) { bf16_t* rowp = O + (size_t)(row0 + ai * 128 + m * 16) * 5632 + col0;
#pragma unroll
                    for (int bj = 0; bj < 2; ++bj) { const f32x4 v0 = acc[ai][bj][m][0], v1 = acc[ai][bj][m][1]; *(u32x4*)(rowp + bj * 128) = (u32x4){pk2(v0[0], v0[1]), pk2(v0[2], v0[3]), pk2(v1[0], v1[1]), pk2(v1[2], v1[3])}; } }
            return false; }
        const int b = u.pm >> 5, hb = 2 * (u.pn & 1);
        if (u.pn >= 4) {
#pragma unroll
            for (int ai = 0; ai < 2; ++ai)
#pragma unroll
                for (int m = 0; m < 4; ++m) { const int s = (row0 + ai * 128 + m * 16) & 8191, tile = s >> 6, key = s & 63;
#pragma unroll
                    for (int bj = 0; bj < 2; ++bj) { const f32x4 v0 = acc[ai][bj][m][0], v1 = acc[ai][bj][m][1];
                        *(u32x4*)(vimg + ((((size_t)(b * 4 + hb + bj) * 128 + tile) * 4 + wc) * 64 + key) * 32 + 8 * fq) = (u32x4){pk2(v0[0], v0[1]), pk2(v0[2], v0[3]), pk2(v1[0], v1[1]), pk2(v1[2], v1[3])}; } }
            return false; }
        const bool isk = u.pn >= 2; const int mm = wc >> 1, w = wc & 1, d0 = 16 * w + 4 * fq; const float sc = isk ? 1.f : at::C2;
        bf16_t* img = isk ? kimg : qimg; float nmax[2] = {0.f, 0.f};
#pragma unroll
        for (int ai = 0; ai < 2; ++ai)
#pragma unroll
            for (int m = 0; m < 4; ++m) { const int s = (row0 + ai * 128 + m * 16) & 8191, tile = s >> 6, key = s & 63;
                const f32x4 cs = *(const f32x4*)(ropec + s * 32 + d0), sn = *(const f32x4*)(ropes + s * 32 + d0);
#pragma unroll
                for (int bj = 0; bj < 2; ++bj) { const f32x4 x1 = acc[ai][bj][m][0], x2 = acc[ai][bj][m][1]; const f32x4 o1 = (x1 * cs - x2 * sn) * sc, o2 = (x2 * cs + x1 * sn) * sc;
                    bf16_t* dst = img + ((((size_t)(b * 4 + hb + bj) * 128 + tile) * 16 + mm * 8 + (d0 >> 3)) * 64 + key) * 8 + (d0 & 7);
                    *(u32x2*)dst = (u32x2){pk2(o1[0], o1[1]), pk2(o1[2], o1[3])}; *(u32x2*)(dst + 4 * 512) = (u32x2){pk2(o2[0], o2[1]), pk2(o2[2], o2[3])};
                    if (isk) { const float ss = (o1[0] * o1[0] + o1[1] * o1[1]) + (o1[2] * o1[2] + o1[3] * o1[3]) + (o2[0] * o2[0] + o2[1] * o2[1]) + (o2[2] * o2[2] + o2[3] * o2[3]); nmax[bj] = fmaxf(nmax[bj], ss); } } }
        if (isk) {
#pragma unroll
            for (int bj = 0; bj < 2; ++bj) { float mx = nmax[bj];
#pragma unroll
                for (int of = 1; of < 16; of <<= 1) mx = fmaxf(mx, __shfl_xor(mx, of));
                if (fr == 0) atomicMax(kmaxp + (((b * 4 + hb + bj) * 2 + mm) * 8 + w * 4 + fq), __float_as_uint(mx)); } }
        return false;
    }
};
struct EpiF32 {
    static constexpr bool PERM = false;
    float* O; int ldc;
    __device__ __forceinline__ bool operator()(f32x4 (&acc)[2][2][4][2], const Unit& u, int wr, int wc, int fr, int fq) const {
        const int row0 = u.pm * 256 + wr * 64 + fr, col0 = u.pn * 256 + wc * 32 + 4 * fq;
#pragma unroll
        for (int ai = 0; ai < 2; ++ai)
#pragma unroll
            for (int m = 0; m < 4; ++m) { float* rowp = O + (size_t)(row0 + ai * 128 + m * 16) * ldc + col0;
#pragma unroll
                for (int bj = 0; bj < 2; ++bj)
#pragma unroll
                    for (int n = 0; n < 2; ++n) *(f32x4*)(rowp + bj * 128 + n * 16) = acc[ai][bj][m][n]; }
        return false;
    }
};
struct EpiBranch2 {
    static constexpr bool PERM = true;
    const bf16_t* proj; bf16_t* merged;
    __device__ __forceinline__ bool operator()(f32x4 (&acc)[2][2][4][2], const Unit& u, int wr, int wc, int fr, int fq) const {
        const int row0 = u.pm * 256 + wr * 64 + fr, col0 = u.pn * 256 + wc * 32 + 8 * fq; const bool first = (u.z == 0);
#pragma unroll
        for (int ai = 0; ai < 2; ++ai)
#pragma unroll
            for (int m = 0; m < 4; ++m) { const size_t row = (size_t)(row0 + ai * 128 + m * 16);
#pragma unroll
                for (int bj = 0; bj < 2; ++bj) { const int col = col0 + bj * 128;
                    const u32x4 gb = __builtin_nontemporal_load((const u32x4*)(proj + row * 5632 + 4608 + col)); const unsigned gbw[4] = {gb.x, gb.y, gb.z, gb.w}; float eb[8];
#pragma unroll
                    for (int q = 0; q < 4; ++q) { eb[2 * q] = __expf(-__uint_as_float(gbw[q] << 16)); eb[2 * q + 1] = __expf(-__uint_as_float(gbw[q] & 0xffff0000u)); }
                    if (first) { const u32x4 ga = __builtin_nontemporal_load((const u32x4*)(proj + row * 5632 + 3584 + col)); const unsigned gaw[4] = {ga.x, ga.y, ga.z, ga.w};
#pragma unroll
                        for (int q = 0; q < 4; ++q) { const float ea0 = __expf(-__uint_as_float(gaw[q] << 16)), ea1 = __expf(-__uint_as_float(gaw[q] & 0xffff0000u));
                            acc[ai][bj][m][q >> 1][(2 * q) & 3] *= (1.f + eb[2 * q]) * __builtin_amdgcn_rcpf(1.f + ea0); acc[ai][bj][m][q >> 1][(2 * q + 1) & 3] *= (1.f + eb[2 * q + 1]) * __builtin_amdgcn_rcpf(1.f + ea1); } }
                    else { unsigned w[4];
#pragma unroll
                        for (int q = 0; q < 4; ++q) w[q] = pk2(acc[ai][bj][m][q >> 1][(2 * q) & 3] * __builtin_amdgcn_rcpf(1.f + eb[2 * q]), acc[ai][bj][m][q >> 1][(2 * q + 1) & 3] * __builtin_amdgcn_rcpf(1.f + eb[2 * q + 1]));
                        *(u32x4*)(merged + row * 1024 + col) = (u32x4){w[0], w[1], w[2], w[3]}; } } }
        return first;
    }
};
struct EpiGateUp {
    static constexpr bool PERM = true;
    const float* bgu; unsigned char* act;
    __device__ __forceinline__ bool operator()(f32x4 (&acc)[2][2][4][2], const Unit& u, int wr, int wc, int fr, int fq) const {
        const int e = u.z, colA = u.pn * 128 + wc * 32 + 8 * fq;
        constexpr float DQ = 1.f / (S8_W * S8_H);
        f32x4 bg[2], bu[2];
#pragma unroll
        for (int n = 0; n < 2; ++n) { bg[n] = *(const f32x4*)(bgu + e * 2048 + colA + 4 * n); bu[n] = *(const f32x4*)(bgu + e * 2048 + 1024 + colA + 4 * n); }
#pragma unroll
        for (int ai = 0; ai < 2; ++ai)
#pragma unroll
            for (int m = 0; m < 4; ++m) { const size_t slot = (size_t)(u.arow + ai * 128 + wr * 64 + m * 16 + fr); unsigned w[2];
#pragma unroll
                for (int n = 0; n < 2; ++n) { float r[4];
#pragma unroll
                    for (int j = 0; j < 4; ++j) { float gg = acc[ai][0][m][n][j] * DQ + bg[n][j], uu = acc[ai][1][m][n][j] * DQ + bu[n][j]; gg = fminf(gg, 7.f); uu = fminf(fmaxf(uu, -7.f), 7.f); r[j] = (uu + 1.f) * gg * sigm(1.702f * gg) * S8_A; }
                    w[n] = pk4_fp8(r[0], r[1], r[2], r[3]); }
                *(u32x2*)(act + slot * 1024 + colA) = (u32x2){w[0], w[1]}; }
        return false;
    }
};
struct EpiDown {
    static constexpr bool PERM = true;
    const float* bd; const int* list; unsigned char* ym; const LAS int* cnt;
    __device__ __forceinline__ bool operator()(f32x4 (&acc)[2][2][4][2], const Unit& u, int wr, int wc, int fr, int fq) const {
        const int e = u.z, nvalid = cnt[e] - u.pm * 256, col0 = u.pn * 256 + wc * 32 + 8 * fq;
        constexpr float DQ = S8_Y / (S8_W * S8_A);
        f32x4 bv[2][2];
#pragma unroll
        for (int bj = 0; bj < 2; ++bj)
#pragma unroll
            for (int n = 0; n < 2; ++n) bv[bj][n] = *(const f32x4*)(bd + e * 1024 + col0 + bj * 128 + 4 * n) * S8_Y;
#pragma unroll
        for (int ai = 0; ai < 2; ++ai)
#pragma unroll
            for (int m = 0; m < 4; ++m) { const int r = ai * 128 + wr * 64 + m * 16 + fr;
                if (r < nvalid) { const int a = list[(size_t)e * 32768 + u.pm * 256 + r]; unsigned char* rowp = ym + (size_t)a * 1024 + col0;
#pragma unroll
                    for (int bj = 0; bj < 2; ++bj) { const f32x4 v0 = acc[ai][bj][m][0] * DQ + bv[bj][0], v1 = acc[ai][bj][m][1] * DQ + bv[bj][1];
                        *(u32x2*)(rowp + bj * 128) = (u32x2){pk4_fp8(v0[0], v0[1], v0[2], v0[3]), pk4_fp8(v1[0], v1[1], v1[2], v1[3])}; } } }
        return false;
    }
};
struct MoeOrder {
    const LAS int* tpre; const LAS int* cnt; const int* list; int nN, G, c, rowpitch  , brows  ; LAS int* idxbuf  ;
    __device__ bool next(int i, Unit& u) const {
        const int nwg = tpre[32] * nN; const long L = (long)i * G + c; if (L >= nwg) return false;
        int wgid = (int)L; { const int q = nwg / 8, r = nwg % 8, xcd = wgid % 8, off = wgid / 8; wgid = (xcd < r ? xcd * (q + 1) : r * (q + 1) + (xcd - r) * q) + off; }
        int e = 0;
#pragma unroll 1
        for (int s = 16; s > 0; s >>= 1) { if (tpre[e + s] * nN <= wgid) e += s; }
        const int w = wgid - tpre[e] * nN, nM = tpre[e + 1] - tpre[e];
        const int nig = 8 * nN, gid = w / nig, fm = gid * 8, gsz = (nM - fm) < 8 ? (nM - fm) : 8;
        u.pm = fm + ((w % nig) % gsz); u.pn = (w % nig) / gsz; u.z = e; u.arow = (tpre[e] + u.pm) * 256; u.brow = e * brows + u.pn * 256; return true;
    }
    __device__ __forceinline__ unsigned row_off(const Unit& u, int r) const {
        const int lr = u.pm * 256 + r; const int a = list[(size_t)u.z * 32768 + (lr < cnt[u.z] ? lr : 0)]; return (unsigned)(a >> 2) * (unsigned)rowpitch;
    }
    __device__ __forceinline__ const int* idx_src(const Unit& u) const { return list + (size_t)u.z * 32768 + u.pm * 256; }
    __device__ __forceinline__ unsigned off_from_idx(int a) const { unsigned tk = (unsigned)a >> 2; tk = tk < (unsigned)T ? tk : (unsigned)(T - 1); return tk * (unsigned)rowpitch; }
};

__device__ __forceinline__ int rope_pos(int d) { const int e = d & 31; return 32 * (e >> 4) + 8 * ((e >> 2) & 3) + 4 * (d >> 5) + (e & 3); }
template <bool RPERM = false>
__device__ __forceinline__ void transpose_item(const float* W, int K, int N, bf16_t* WT, int k0, int n0, int dst_row0, LAS unsigned* scr, int lane) {
    const int cg = lane & 15, rp = lane >> 4;
    const float* src = W + (size_t)(k0 + 2 * rp) * N + n0 + 4 * cg;
#pragma unroll
    for (int q = 0; q < 8; ++q) { const f32x4 a = __builtin_nontemporal_load((const f32x4*)(src + (size_t)(8 * q) * N)), b = __builtin_nontemporal_load((const f32x4*)(src + (size_t)(8 * q + 1) * N));
#pragma unroll
        for (int c = 0; c < 4; ++c) scr[(4 * cg + c) * 33 + 4 * q + rp] = pk2(a[c], b[c]); }
    asm volatile("s_waitcnt lgkmcnt(0)" ::: "memory");
    const int nl = lane >> 3, wq = lane & 7;
#pragma unroll
    for (int i = 0; i < 8; ++i) { const LAS unsigned* s = scr + (8 * i + nl) * 33 + 4 * wq; u32x4 o; o.x = s[0]; o.y = s[1]; o.z = s[2]; o.w = s[3];
        *(u32x4*)(WT + (size_t)(dst_row0 + (RPERM ? rope_pos(8 * i + nl) : 8 * i + nl)) * K + k0 + 8 * wq) = o; }
    asm volatile("s_waitcnt lgkmcnt(0)" ::: "memory");
}
__device__ __forceinline__ void transpose_item8(const float* W, int K, int N, unsigned char* WT, int k0, int n0, int dst_row0, LAS unsigned* scr, int lane) {
    const int cg = lane & 15, rp = lane >> 4;
    const float* src = W + (size_t)(k0 + 4 * rp) * N + n0 + 4 * cg;
#pragma unroll
    for (int q = 0; q < 4; ++q) { f32x4 a[4];
#pragma unroll
        for (int r = 0; r < 4; ++r) a[r] = __builtin_nontemporal_load((const f32x4*)(src + (size_t)(16 * q + r) * N));
#pragma unroll
        for (int c = 0; c < 4; ++c) scr[(4 * cg + c) * 17 + 4 * q + rp] = pk4_fp8(a[0][c] * S8_W, a[1][c] * S8_W, a[2][c] * S8_W, a[3][c] * S8_W); }
    asm volatile("s_waitcnt lgkmcnt(0)" ::: "memory");
    const int nl = lane >> 2, wq = lane & 3;
#pragma unroll
    for (int i = 0; i < 4; ++i) { const LAS unsigned* s = scr + (16 * i + nl) * 17 + 4 * wq; u32x4 o; o.x = s[0]; o.y = s[1]; o.z = s[2]; o.w = s[3];
        *(u32x4*)(WT + (size_t)(dst_row0 + 16 * i + nl) * K + k0 + 16 * wq) = o; }
    asm volatile("s_waitcnt lgkmcnt(0)" ::: "memory");
}
template <bool GU>
__device__ __forceinline__ void transpose_matrix8(const float* W, int K, int N, unsigned char* WT, LAS unsigned* scr, int lane, int gw, int NGW, int& itbase) {
    const int nblk = N / 64, nitems = (K / 64) * nblk;
    int first = (gw - itbase) % NGW; if (first < 0) first += NGW;
    for (int it = first; it < nitems; it += NGW) { const int kb = it / nblk, nb = it % nblk, n0 = nb * 64;
        int dst = n0; if (GU) { const int nn = n0 & 1023; dst = (nn >> 7) * 256 + (n0 >> 10) * 128 + (nn & 127); }
        transpose_item8(W, K, N, WT, kb * 64, n0, dst, scr, lane); }
    itbase += nitems;
}
template <bool GU, bool QK = false>
__device__ __forceinline__ void transpose_matrix(const float* W, int K, int N, bf16_t* WT, LAS unsigned* scr, int lane, int gw, int NGW, int& itbase) {
    const int nblk = N / 64, nitems = (K / 64) * nblk;
    int first = (gw - itbase) % NGW; if (first < 0) first += NGW;
    for (int it = first; it < nitems; it += NGW) { const int kb = it / nblk, nb = it % nblk, n0 = nb * 64;
        int dst = n0; if (GU) { const int nn = n0 & 1023; dst = (nn >> 7) * 256 + (n0 >> 10) * 128 + (nn & 127); }
        if (QK && n0 < 1024) transpose_item<true>(W, K, N, WT, kb * 64, n0, dst, scr, lane); else transpose_item<false>(W, K, N, WT, kb * 64, n0, dst, scr, lane); }
    itbase += nitems;
}

#define MOD ((float*)(ws + WS_SMALL))
#define SCAL ((float*)(ws + WS_SMALL + 128 * 1024))
#define ROPEC ((float*)(ws + WS_ROPEC))
#define ROPES ((float*)(ws + WS_ROPES))
#define TOPI ((int*)(ws + WS_TOPI))
#define TOPW ((float*)(ws + WS_TOPW))
#define LIST ((int*)(ws + WS_LIST))
#define RWT ((bf16_t*)(ws + WS_RWT))
#define CNT ((int*)(ws + WS_CTL) + CW_CNT)
#define H ((bf16_t*)(ws + WS_H))
#define QR ((bf16_t*)(ws + WS_Y + 64 * MiB))
#define KIMG ((bf16_t*)(ws + WS_Y + 96 * MiB))
#define VIMG ((bf16_t*)(ws + WS_YB))
#define PROJ ((bf16_t*)(ws + WS_PROJ))
#define YA ((bf16_t*)(ws + WS_YA))
#define YB ((bf16_t*)(ws + WS_YB))
#define DS ((bf16_t*)(ws + WS_DS))
#define DEC ((float*)(ws + WS_DEC))
#define MERGED ((bf16_t*)(ws + WS_MERGED))
#define SP ((bf16_t*)(ws + WS_MERGED))
#define Y ((float*)(ws + WS_Y))
#define YH ((bf16_t*)(ws + WS_Y))
#define ACT ((bf16_t*)(ws + WS_ACT))
#define YM ((bf16_t*)(ws + WS_YM))
#define WT_IN ((bf16_t*)(ws + WS_WIN))
#define WT_A ((bf16_t*)(ws + WS_WA))
#define WT_B ((bf16_t*)(ws + WS_WB))
#define WT_O ((bf16_t*)(ws + WS_WO))
#define WT_GU ((bf16_t*)(ws + WS_WGU))
#define WT_GU8 ((unsigned char*)(ws + WS_WGU))
#define WT_D8 ((unsigned char*)(ws + WS_WD))
#define H8 ((unsigned char*)(ws + WS_H))
#define ACT8 ((unsigned char*)(ws + WS_ACT))
#define YM8 ((unsigned char*)(ws + WS_YM))
#define WT_D ((bf16_t*)(ws + WS_WD))
#define PHASE_BEGIN unsigned char* ws = args.ws; asm volatile("" : "+s"(ws)); int tid = threadIdx.x; asm volatile("" : "+v"(tid)); const int lane = tid & 63; (void)lane; const float* x = args.in[0]; float* out = args.out; (void)x; (void)out;
__global__ void __launch_bounds__(NTHR, 2) mega(Args args) {
    extern __shared__ __attribute__((aligned(16))) unsigned char lds_[];
    LAS unsigned char* lds = (LAS unsigned char*)lds_;
    volatile LAS unsigned* LW = (volatile LAS unsigned*)(lds + LDSCTL_OFF);
    const int tid = threadIdx.x, lane = tid & 63, wave = __builtin_amdgcn_readfirstlane(tid >> 6);
    const int G = gridDim.x; const int bx = blockIdx.x; const int vcu = (G % 8 == 0) ? (bx % 8) * (G / 8) + bx / 8 : bx;
    const int gw = vcu * NWAVES + wave, NGW = G * NWAVES;
    unsigned* CTL = (unsigned*)(args.ws + WS_CTL);
    for (int u = tid; u < (LDS_BYTES - LDSCTL_OFF) / 4; u += NTHR) ((LAS unsigned*)(lds + LDSCTL_OFF))[u] = 0u;
    __syncthreads();
    const int lo = args.ph_lo, hi = args.ph_hi;
    XcdBarrier bar; bar.bar = CTL + CW_BAR + args.li * 4096; bar.x = 0; bar.st = nullptr;
    if (hi - lo > 1) bar = xcd_barrier_post(CTL + CW_BAR + args.li * 4096, LW + LW_BAR);
#ifndef PHMASK
#define PHMASK 0xffff
#endif
#ifndef DUP_PHASE
#define DUP_PHASE -1
#endif
#define IN(k) ((((PHMASK) >> (k)) & 1) && lo <= (k) && (k) < hi)
#define REPS(k) (((k) == DUP_PHASE) ? 2 : 1)
#ifdef PROBE_SPAN
#define STAMP(k) do { if (bx == 0 && threadIdx.x == 0) { const unsigned long long t_ = __builtin_amdgcn_s_memrealtime(); LW[160 + 2 * (k)] = (unsigned)t_; LW[161 + 2 * (k)] = (unsigned)(t_ >> 32); } } while (0)
#else
#define STAMP(k) do { } while (0)
#endif
#define SEAM(k) do { if (IN(k) && IN((k) + 1)) xcd_barrier(bar); STAMP((k) + 1); } while (0)

    STAMP(0);
    if (IN(PH_PRO)) for (int rep_ = 0; rep_ < REPS(PH_PRO); ++rep_) {
        PHASE_BEGIN
        __syncthreads();
        const float* c = args.in[1]; const float* w_mod = args.in[2]; const float* b_mod = args.in[3];
        LAS float* cact = (LAS float*)lds; LAS float* red = cact + 4096;
        for (int i = tid; i < 4096; i += NTHR) { const float cv = c[i]; cact[i] = cv / (1.f + expf(-cv)); }
        __syncthreads();
        for (int it = vcu; it < 192; it += G) { const int j0 = it * 32, kq = tid >> 5, col = tid & 31; float acc[4] = {0.f, 0.f, 0.f, 0.f};
            const float* wp = w_mod + (size_t)(kq * 64) * 6144 + j0 + col;
#pragma unroll 1
            for (int k = 0; k < 64; k += 16) { float wv[16];
#pragma unroll
                for (int i = 0; i < 16; ++i) wv[i] = wp[(size_t)(k + i) * 6144];
#pragma unroll
                for (int i = 0; i < 16; ++i) {
#pragma unroll
                    for (int b = 0; b < 4; ++b) acc[b] += cact[b * 1024 + kq * 64 + k + i] * wv[i]; } }
#pragma unroll
            for (int b = 0; b < 4; ++b) red[(kq * 4 + b) * 32 + col] = acc[b];
            __syncthreads();
            if (tid < 128) { const int b = tid >> 5, cc = tid & 31; float s = 0.f;
#pragma unroll
                for (int q = 0; q < 16; ++q) s += red[(q * 4 + b) * 32 + cc];
                MOD[b * 6144 + j0 + cc] = s + b_mod[j0 + cc]; }
            __syncthreads(); }
        const int gt = vcu * NTHR + tid, NGT = G * NTHR;
        if (gt == 0) { const float* q1 = args.in[7]; const float* k1 = args.in[8]; const float* q2 = args.in[9]; const float* k2 = args.in[10]; float s1 = 0.f, s2 = 0.f;
            for (int i = 0; i < 64; ++i) { s1 += q1[i] * k1[i]; s2 += q2[i] * k2[i]; } SCAL[0] = expf(s1) - expf(s2) + 0.2f; }
        if (gt < 512) { const float* lbl = args.in[12]; SCAL[64 + gt] = 1.f / (1.f + expf(lbl[512 + gt] - lbl[gt])); }
        for (int i = gt; i < 8192 * 32; i += NGT) { const int s = i >> 5, j = i & 31; const float inv = powf(10000.f, -(float)(2 * j) / 64.f); const float ang = (float)s * inv; ROPEC[i] = cosf(ang); ROPES[i] = sinf(ang); }
        for (int i = gt; i < 32768; i += NGT) { const int e = i >> 10, k = i & 1023; const float wv = args.in[19][k * 32 + e]; const bf16_t hb = f2bf(wv); RWT[i] = hb; RWT[32768 + i] = f2bf(wv - bf2f(hb)); }
        LAS unsigned* scr = (LAS unsigned*)(lds + wave * 16384); int itbase = 0;
        transpose_matrix<false, true>(args.in[6], 1024, 5632, WT_IN, scr, lane, gw, NGW, itbase);
        transpose_matrix<false>(args.in[14], 512, 1024, WT_A, scr, lane, gw, NGW, itbase);
        transpose_matrix<false>(args.in[15], 512, 1024, WT_B, scr, lane, gw, NGW, itbase);
        transpose_matrix<false>(args.in[16], 1024, 1024, WT_O, scr, lane, gw, NGW, itbase);
        for (int e = 0; e < 32; ++e) transpose_matrix8<true>(args.in[21] + (size_t)e * 1024 * 2048, 1024, 2048, WT_GU8 + (size_t)e * 2048 * 1024, scr, lane, gw, NGW, itbase);
        for (int e = 0; e < 32; ++e) transpose_matrix8<false>(args.in[23] + (size_t)e * 1024 * 1024, 1024, 1024, WT_D8 + (size_t)e * 1024 * 1024, scr, lane, gw, NGW, itbase);
    }
    SEAM(PH_PRO);
#ifdef EXTRA_BARRIERS
    for (int eb = 0; eb < EXTRA_BARRIERS; ++eb) xcd_barrier(bar);
#endif
    if (IN(PH_H1)) for (int rep_ = 0; rep_ < REPS(PH_H1); ++rep_) {
        PHASE_BEGIN
        const float* w = args.in[4];
        { constexpr int NR_ = 4;
        for (int row0 = gw; row0 < T; row0 += NR_ * NGW) { f32x4 v[NR_][4]; float ss[NR_]; int rows[NR_];
#pragma unroll
            for (int q = 0; q < NR_; ++q) { rows[q] = (row0 + q * NGW < T) ? row0 + q * NGW : row0; const f32x4* xr = (const f32x4*)(x + (size_t)rows[q] * 1024) + lane; ss[q] = 0.f;
#pragma unroll
                for (int j = 0; j < 4; ++j) v[q][j] = __builtin_nontemporal_load(xr + 64 * j); }
#pragma unroll
            for (int q = 0; q < NR_; ++q) {
#pragma unroll
                for (int j = 0; j < 4; ++j) ss[q] += (v[q][j][0] * v[q][j][0] + v[q][j][1] * v[q][j][1]) + (v[q][j][2] * v[q][j][2] + v[q][j][3] * v[q][j][3]);
                ss[q] = rsqrtf(wave_sum(ss[q]) * (1.f / 1024.f) + 1e-6f); }
#pragma unroll
            for (int j = 0; j < 4; ++j) { const int col = 4 * lane + 256 * j; const f32x4 wv = *(const f32x4*)(w + col);
#pragma unroll
                for (int q = 0; q < NR_; ++q) { const int b = rows[q] >> 13; const f32x4 sc = *(const f32x4*)(MOD + b * 6144 + 1024 + col), sh = *(const f32x4*)(MOD + b * 6144 + col);
                    const f32x4 h = v[q][j] * ss[q] * wv * (sc + 1.f) + sh; u32x2 o; o.x = pk2(h[0], h[1]); o.y = pk2(h[2], h[3]); *(u32x2*)(H + (size_t)rows[q] * 1024 + col) = o; } } } }
    }
    SEAM(PH_H1);
    if (IN(PH_G1)) for (int rep_ = 0; rep_ < REPS(PH_G1); ++rep_) {
        PHASE_BEGIN
        pg8::Gemm g{H, WT_IN, 1024, nullptr, nullptr}; pg8::DenseOrder S; S.init(T, NC, G, bx);
        EpiProj E{PROJ, ROPEC, ROPES, QR, KIMG, VIMG, (unsigned*)(ws + WS_CTL) + CW_KMAX};
        pg8::gemm_phase<EpiProj, pg8::DenseOrder, false>(lds, g, S, E);
    }
    SEAM(PH_G1);
    if (IN(PH_ROPE_HGA)) for (int rep_ = 0; rep_ < REPS(PH_ROPE_HGA); ++rep_) {
        PHASE_BEGIN
        { hg::ARegs R; if (vcu < 2048) hg::hgA_load(R, PROJ, vcu >> 7, vcu & 127, tid);
          for (int it = vcu; it < 2048; it += G) { const int nx = it + G; hg::hgA_unit(lds, R, PROJ, SCAL, DS, DEC, it >> 7, it & 127, nx < 2048 ? (nx >> 7) : -1, nx & 127, tid); } }
        __syncthreads();
    }
    SEAM(PH_ROPE_HGA);
    if (IN(PH_ATT_SCAN)) for (int rep_ = 0; rep_ < REPS(PH_ATT_SCAN); ++rep_) {
        PHASE_BEGIN
        for (int gid = vcu * NTHR + tid; gid < 16 * 128 * 128; gid += G * NTHR) { const int bh = gid >> 14, d = (gid >> 7) & 127, v = gid & 127; float st = 0.f;
            const bf16_t* __restrict__ src = DS + ((size_t)(bh * 128) * 128 + d) * 128 + v; bf16_t* __restrict__ dst = SP + ((size_t)(bh * 128) * 128 + d) * 128 + v; const float* __restrict__ dc = DEC + (size_t)(bh * 128) * 128 + d;
            for (int n0 = 0; n0 < 128; n0 += 16) { float xv[16], dv[16];
#pragma unroll
                for (int i = 0; i < 16; ++i) { xv[i] = bf2f(__builtin_nontemporal_load(src + (size_t)(n0 + i) * 16384)); dv[i] = dc[(n0 + i) * 128]; }
#pragma unroll
                for (int i = 0; i < 16; ++i) { dst[(size_t)(n0 + i) * 16384] = f2bf(st); st = dv[i] * st + xv[i]; } } }
        { const float lam = SCAL[0]; const float* subln = args.in[11];
          for (int it = vcu; it < 1024; it += G) { int bh, blk;
              if (G == 256) { const int i = it >> 8, v = it & 255, s = v & 15; bh = v >> 4; blk = (i == 0) ? 63 - s : (i == 1) ? 32 + s : (i == 2) ? 31 - s : s; }
              else { blk = 63 - (it >> 4); bh = it & 15; }
              at::attn_unit(lds, QR, KIMG, VIMG, YA, subln, lam, (const unsigned*)(ws + WS_CTL) + CW_KMAX, bh >> 2, bh & 3, blk, tid); } }
    }
    SEAM(PH_ATT_SCAN);
    if (IN(PH_HGC)) for (int rep_ = 0; rep_ < REPS(PH_HGC); ++rep_) {
        PHASE_BEGIN
        const float* hgnorm = args.in[13];
        { hg::CRegs R; if (vcu < 2048) hg::hgC_load(R, PROJ, SP, vcu >> 7, vcu & 127, tid);
          for (int it = vcu; it < 2048; it += G) { const int nx = it + G; hg::hgC_unit(lds, R, PROJ, SCAL, SP, hgnorm, YB, it >> 7, it & 127, nx < 2048 ? (nx >> 7) : -1, nx & 127, tid); } }
        __syncthreads();
    }
    SEAM(PH_HGC);
    if (IN(PH_G2A)) for (int rep_ = 0; rep_ < REPS(PH_G2A); ++rep_) {
        PHASE_BEGIN
        pg8::Gemm g{YA, WT_A, 512, YB, WT_B}; pg8::DenseOrder2 S; S.base.init(T, 1024, G, bx);
        EpiBranch2 E{PROJ, MERGED};
        pg8::gemm_phase<EpiBranch2, pg8::DenseOrder2, false, true>(lds, g, S, E);
    }
    SEAM(PH_G2B);
    if (IN(PH_G3)) for (int rep_ = 0; rep_ < REPS(PH_G3); ++rep_) {
        PHASE_BEGIN
        pg8::Gemm g{MERGED, WT_O, 1024, nullptr, nullptr}; pg8::DenseOrder S; S.init(T, 1024, G, bx);
        EpiBf16 E{YH, 1024};
        pg8::gemm_phase<EpiBf16, pg8::DenseOrder, false>(lds, g, S, E);
    }
    SEAM(PH_G3);
    if (IN(PH_TOK)) for (int rep_ = 0; rep_ < REPS(PH_TOK); ++rep_) {
        PHASE_BEGIN
        const float* wpm = args.in[5]; const float* wpf = args.in[17]; const float* rb = args.in[20];
        const int wv_ = __builtin_amdgcn_readfirstlane(tid >> 6), r32 = lane & 31, hi = lane >> 5;
        LAS int* lcnt = (LAS int*)lds; LAS int* lbase = lcnt + 32; LAS int* asg = lcnt + 64;
        LAS float* rstd2 = (LAS float*)(lds + 4096);
        LAS float* XC = (LAS float*)(lds + 8192);
        LAS float* LG = (LAS float*)(lds + 24576);
        LAS float* CM = (LAS float*)(lds + 41984); LAS float* SHV = CM + 1024;
        for (int chunk = vcu; chunk < T / 128; chunk += G) { const int b = chunk >> 6;
            __syncthreads();
            if (tid < 32) lcnt[tid] = 0;
            for (int i = tid; i < 1024; i += NTHR) { CM[i] = wpf[i] * (1.f + MOD[b * 6144 + 4096 + i]); SHV[i] = MOD[b * 6144 + 3072 + i]; }
            __syncthreads();
            { constexpr int NR_ = 4; for (int i = 0; i < 16; i += NR_) { const int rloc = wv_ * 16 + i, row = chunk * 128 + rloc;
                f32x4 v[NR_][4], xv[NR_][4]; float ss[NR_], rs[NR_];
#pragma unroll
                for (int q = 0; q < NR_; ++q) ss[q] = 0.f;
#pragma unroll
                for (int q = 0; q < NR_; ++q) { const u32x2* yr = (const u32x2*)(YH + (size_t)(row + q) * 1024) + lane; const f32x4* xr = (const f32x4*)(x + (size_t)(row + q) * 1024) + lane;
#pragma unroll
                    for (int j = 0; j < 4; ++j) { const u32x2 yw = __builtin_nontemporal_load(yr + 64 * j); v[q][j] = (f32x4){__uint_as_float(yw.x << 16), __uint_as_float(yw.x & 0xffff0000u), __uint_as_float(yw.y << 16), __uint_as_float(yw.y & 0xffff0000u)}; xv[q][j] = __builtin_nontemporal_load(xr + 64 * j); } }
#pragma unroll
                for (int q = 0; q < NR_; ++q)
#pragma unroll
                    for (int j = 0; j < 4; ++j) ss[q] += (v[q][j][0] * v[q][j][0] + v[q][j][1] * v[q][j][1]) + (v[q][j][2] * v[q][j][2] + v[q][j][3] * v[q][j][3]);
                #pragma unroll
                for (int q = 0; q < NR_; ++q) { rs[q] = rsqrtf(wave_sum(ss[q]) * (1.f / 1024.f) + 1e-6f); ss[q] = 0.f; }
#pragma unroll
                for (int j = 0; j < 4; ++j) { const int col = 4 * lane + 256 * j; const f32x4 g1 = *(const f32x4*)(MOD + b * 6144 + 2048 + col), wv = *(const f32x4*)(wpm + col);
#pragma unroll
                    for (int q = 0; q < NR_; ++q) { v[q][j] = xv[q][j] + g1 * v[q][j] * rs[q] * wv; *(f32x4*)(out + (size_t)(row + q) * 1024 + col) = v[q][j];
                        ss[q] += (v[q][j][0] * v[q][j][0] + v[q][j][1] * v[q][j][1]) + (v[q][j][2] * v[q][j][2] + v[q][j][3] * v[q][j][3]); } }
                #pragma unroll
                for (int q = 0; q < NR_; ++q) { rs[q] = rsqrtf(wave_sum(ss[q]) * (1.f / 1024.f) + 1e-6f); if (lane == 0) rstd2[rloc + q] = rs[q]; }
#pragma unroll
                for (int j = 0; j < 4; ++j) { const int col = 4 * lane + 256 * j; const f32x4 cm = *(const LAS f32x4*)(CM + col), sh = *(const LAS f32x4*)(SHV + col);
#pragma unroll
                    for (int q = 0; q < NR_; ++q) { const f32x4 h = (v[q][j] * rs[q] * cm + sh) * S8_H; *(unsigned*)(H8 + (size_t)(row + q) * 1024 + col) = pk4_fp8(h[0], h[1], h[2], h[3]); } } } }
            asm volatile("s_waitcnt vmcnt(0)" ::: "memory");
            __syncthreads();
            { const int rt = wv_ & 3, kh = wv_ >> 2; const int rloc = 32 * rt + r32; const float rs = rstd2[rloc];
              const float* xrow = out + (size_t)(chunk * 128 + rloc) * 1024 + 512 * kh + 8 * hi; const bf16_t* whi = RWT + (size_t)r32 * 1024 + 512 * kh + 8 * hi; const bf16_t* wlo = whi + 32768;
              const LAS float* cmp = CM + 512 * kh + 8 * hi; const LAS float* shp = SHV + 512 * kh + 8 * hi;
              at::f32x16 acc = at::f32x16{};
#pragma unroll 4
              for (int ks = 0; ks < 32; ++ks) { const f32x4 xa = __builtin_nontemporal_load((const f32x4*)(xrow + 16 * ks)), xb = __builtin_nontemporal_load((const f32x4*)(xrow + 16 * ks + 4));
                  const f32x4 ca = *(const LAS f32x4*)(cmp + 16 * ks), cb = *(const LAS f32x4*)(cmp + 16 * ks + 4), sa = *(const LAS f32x4*)(shp + 16 * ks), sb = *(const LAS f32x4*)(shp + 16 * ks + 4);
                  const f32x4 ha = xa * rs * ca + sa, hb = xb * rs * cb + sb;
                  const unsigned h0 = at::cvtpk(ha[0], ha[1]), h1 = at::cvtpk(ha[2], ha[3]), h2 = at::cvtpk(hb[0], hb[1]), h3 = at::cvtpk(hb[2], hb[3]);
                  const unsigned l0 = at::cvtpk(ha[0] - __uint_as_float(h0 << 16), ha[1] - __uint_as_float(h0 & 0xffff0000u)), l1 = at::cvtpk(ha[2] - __uint_as_float(h1 << 16), ha[3] - __uint_as_float(h1 & 0xffff0000u));
                  const unsigned l2 = at::cvtpk(hb[0] - __uint_as_float(h2 << 16), hb[1] - __uint_as_float(h2 & 0xffff0000u)), l3 = at::cvtpk(hb[2] - __uint_as_float(h3 << 16), hb[3] - __uint_as_float(h3 & 0xffff0000u));
                  const at::bf16x8 ahi = __builtin_bit_cast(at::bf16x8, (u32x4){h0, h1, h2, h3}), alo = __builtin_bit_cast(at::bf16x8, (u32x4){l0, l1, l2, l3});
                  const at::bf16x8 bhi = *(const at::bf16x8*)(whi + 16 * ks), blo = *(const at::bf16x8*)(wlo + 16 * ks);
                  acc = __builtin_amdgcn_mfma_f32_32x32x16_bf16(ahi, bhi, acc, 0, 0, 0); acc = __builtin_amdgcn_mfma_f32_32x32x16_bf16(ahi, blo, acc, 0, 0, 0); acc = __builtin_amdgcn_mfma_f32_32x32x16_bf16(alo, bhi, acc, 0, 0, 0); }
              if (kh == 1) {
#pragma unroll
                  for (int r = 0; r < 16; ++r) XC[(rt * 16 + r) * 64 + lane] = acc[r]; }
              __syncthreads();
              if (kh == 0) { const float bias = rb[r32];
#pragma unroll
                  for (int r = 0; r < 16; ++r) LG[(32 * rt + at::crow(r, hi)) * 33 + r32] = acc[r] + XC[(rt * 16 + r) * 64 + lane] + bias; }
              __syncthreads(); }
            if (tid < 128) { const int rloc = tid, row = chunk * 128 + rloc; float lg[32];
#pragma unroll
                for (int e = 0; e < 32; ++e) lg[e] = LG[rloc * 33 + e];
                int bi[4]; float bv[4];
#pragma unroll
                for (int k = 0; k < 4; ++k) { float best = -3.0e38f; int be = 0;
#pragma unroll
                    for (int e = 0; e < 32; ++e) { bool taken = false;
#pragma unroll
                        for (int q = 0; q < 4; ++q) if (q < k && bi[q] == e) taken = true;
                        if (!taken && lg[e] > best) { best = lg[e]; be = e; } }
                    bi[k] = be; bv[k] = best; }
                const float e1 = expf(bv[1] - bv[0]), e2 = expf(bv[2] - bv[0]), e3 = expf(bv[3] - bv[0]); const float inv = 1.f / (1.f + e1 + e2 + e3);
                if (rep_ == REPS(PH_TOK) - 1) { *(f32x4*)(TOPW + row * 4) = (f32x4){inv, e1 * inv, e2 * inv, e3 * inv};
                    *(u32x4*)(TOPI + row * 4) = (u32x4){(unsigned)bi[0], (unsigned)bi[1], (unsigned)bi[2], (unsigned)bi[3]};
#pragma unroll
                    for (int k = 0; k < 4; ++k) { const int pos = __hip_atomic_fetch_add(lcnt + bi[k], 1, __ATOMIC_RELAXED, __HIP_MEMORY_SCOPE_WORKGROUP); asg[rloc * 4 + k] = (bi[k] << 16) | pos; } } }
            __syncthreads();
            if (tid < 32) lbase[tid] = atomicAdd(&CNT[tid], lcnt[tid]);
            __syncthreads();
            if (rep_ == REPS(PH_TOK) - 1) { const int v = asg[tid], e = v >> 16, pos = v & 0xffff; LIST[(size_t)e * 32768 + lbase[e] + pos] = chunk * 512 + tid; }
        }
        __syncthreads();
    }
    SEAM(PH_TOK);
    if (IN(PH_G4) || IN(PH_G5)) {
        PHASE_BEGIN
        if (tid < 32) ((LAS int*)LW)[LW_CNT + tid] = __hip_atomic_load(&CNT[tid], __ATOMIC_RELAXED, __HIP_MEMORY_SCOPE_AGENT);
        __syncthreads();
        if (tid == 0) { int s = 0; for (int e = 0; e < 32; ++e) { ((LAS int*)LW)[LW_TPRE + e] = s; s += (((LAS int*)LW)[LW_CNT + e] + 255) >> 8; } ((LAS int*)LW)[LW_TPRE + 32] = s; }
        __syncthreads();
    }
    if (IN(PH_G4)) for (int rep_ = 0; rep_ < REPS(PH_G4); ++rep_) {
        PHASE_BEGIN
        pg8::Gemm g{(const bf16_t*)H8, (const bf16_t*)WT_GU8, 512, nullptr, nullptr}; MoeOrder S{(const LAS int*)LW + LW_TPRE, (const LAS int*)LW + LW_CNT, LIST, 8, G, bx, 1024, 2048, (LAS int*)LW + 1024};
        EpiGateUp E{args.in[22], ACT8};
        pg8::gemm_phase<EpiGateUp, MoeOrder, true, false, true>(lds, g, S, E);
    }
    SEAM(PH_G4);
    if (IN(PH_G5)) for (int rep_ = 0; rep_ < REPS(PH_G5); ++rep_) {
        PHASE_BEGIN
        pg8::Gemm g{(const bf16_t*)ACT8, (const bf16_t*)WT_D8, 512, nullptr, nullptr}; MoeOrder S{(const LAS int*)LW + LW_TPRE, (const LAS int*)LW + LW_CNT, LIST, 4, G, bx, 1024, 1024, (LAS int*)LW + 1024};
        EpiDown E{args.in[24], LIST, YM8, (const LAS int*)LW + LW_CNT};
        pg8::gemm_phase<EpiDown, MoeOrder, false, false, true>(lds, g, S, E);
    }
    SEAM(PH_G5);
    if (IN(PH_FIN)) for (int rep_ = 0; rep_ < REPS(PH_FIN); ++rep_) {
        PHASE_BEGIN
        const float* w = args.in[18];
        for (int row0 = gw; row0 < T; row0 += 2 * NGW) { f32x4 v[2][4], ov[2][4]; float ss[2] = {0.f, 0.f}; int rows[2] = {row0, (row0 + NGW < T) ? row0 + NGW : row0};
#pragma unroll
            for (int q = 0; q < 2; ++q) { const int row = rows[q]; const f32x4 tw = *(const f32x4*)(TOPW + row * 4) * (1.f / S8_Y); const unsigned char* y0 = YM8 + (size_t)row * 4096;
#pragma unroll
                for (int j = 0; j < 4; ++j) { const int col = 4 * lane + 256 * j; f32x4 a = (f32x4){0.f, 0.f, 0.f, 0.f};
#pragma unroll
                    for (int k = 0; k < 4; ++k) { const unsigned yw = __builtin_nontemporal_load((const unsigned*)(y0 + k * 1024 + col)); const pg8::f32x2 lo = __builtin_amdgcn_cvt_pk_f32_fp8(yw, false), hi = __builtin_amdgcn_cvt_pk_f32_fp8(yw, true);
                        a[0] += tw[k] * lo[0]; a[1] += tw[k] * lo[1]; a[2] += tw[k] * hi[0]; a[3] += tw[k] * hi[1]; }
                    v[q][j] = a; ov[q][j] = __builtin_nontemporal_load((const f32x4*)(out + (size_t)row * 1024 + col)); ss[q] += (a[0] * a[0] + a[1] * a[1]) + (a[2] * a[2] + a[3] * a[3]); } }
            const float rs[2] = {rsqrtf(wave_sum(ss[0]) * (1.f / 1024.f) + 1e-6f), rsqrtf(wave_sum(ss[1]) * (1.f / 1024.f) + 1e-6f)};
#pragma unroll
            for (int q = 0; q < 2; ++q) { const int row = rows[q], b = row >> 13; if (q == 1 && rows[1] == rows[0]) break;
#pragma unroll
                for (int j = 0; j < 4; ++j) { const int col = 4 * lane + 256 * j; const f32x4 g2 = *(const f32x4*)(MOD + b * 6144 + 5120 + col), wv = *(const f32x4*)(w + col);
                    const f32x4 res = ov[q][j] + g2 * v[q][j] * rs[q] * wv; if (rep_ == REPS(PH_FIN) - 1) *(f32x4*)(out + (size_t)row * 1024 + col) = res; else asm volatile("" :: "v"(res)); } } }
    }
#ifdef PROBE_SPAN
    STAMP(PH_N);
    if (bx == 0 && threadIdx.x == 0) { const unsigned long long t0_ = ((unsigned long long)LW[161 + 2 * (PROBE_SPAN)] << 32) | LW[160 + 2 * (PROBE_SPAN)], t1_ = ((unsigned long long)LW[161 + 2 * (PROBE_SPAN_END)] << 32) | LW[160 + 2 * (PROBE_SPAN_END)];
        const unsigned long long until_ = __builtin_amdgcn_s_memrealtime() + 4ull * (t1_ - t0_);
        while (__builtin_amdgcn_s_memrealtime() < until_) __builtin_amdgcn_s_sleep(8); }
#endif
#undef IN
#undef SEAM
}
}
#undef MOD
#undef SCAL
#undef ROPEC
#undef ROPES
#undef TOPI
#undef TOPW
#undef LIST
#undef RWT
#undef CNT
#undef H
#undef QR
#undef KIMG
#undef VIMG
#undef PROJ
#undef YA
#undef YB
#undef DS
#undef DEC
#undef MERGED
#undef SP
#undef Y
#undef YH
#undef ACT
#undef YM
#undef WT_IN
#undef WT_A
#undef WT_B
#undef WT_O
#undef WT_GU
#undef WT_GU8
#undef WT_D8
#undef H8
#undef ACT8
#undef YM8
#undef WT_D
#undef PHASE_BEGIN

#ifndef FASTMASK
#define FASTMASK 0x1fff
#endif

extern "C" void kernel_launch(void* const* d_in, const int* in_sizes, int n_in, void* d_out, int out_size, void* d_ws, size_t ws_size, hipStream_t stream) {
    if (n_in != 25 || out_size != T * D || ws_size < WS_END) { fprintf(stderr, "kernel_launch: unexpected shapes / workspace (%d inputs, out %d, ws %zu)\n", n_in, out_size, ws_size); return; }
    const float* x = (const float*)d_in[0]; const float* c = (const float*)d_in[1]; const float* w_mod = (const float*)d_in[2]; const float* b_mod = (const float*)d_in[3];
    const float* norm_pre_mix = (const float*)d_in[4]; const float* norm_post_mix = (const float*)d_in[5]; const float* w_in = (const float*)d_in[6];
    const float* lq1 = (const float*)d_in[7]; const float* lk1 = (const float*)d_in[8]; const float* lq2 = (const float*)d_in[9]; const float* lk2 = (const float*)d_in[10];
    const float* subln = (const float*)d_in[11]; const float* lbl = (const float*)d_in[12]; const float* hgnorm = (const float*)d_in[13];
    const float* wa = (const float*)d_in[14]; const float* wb = (const float*)d_in[15]; const float* wo = (const float*)d_in[16];
    const float* norm_pre_ffn = (const float*)d_in[17]; const float* norm_post_ffn = (const float*)d_in[18]; const float* rw = (const float*)d_in[19]; const float* rb = (const float*)d_in[20];
    const float* wgu = (const float*)d_in[21]; const float* bgu = (const float*)d_in[22]; const float* wd = (const float*)d_in[23]; const float* bd = (const float*)d_in[24];
    unsigned char* ws = (unsigned char*)d_ws; float* out = (float*)d_out;
    float* MOD = (float*)(ws + WS_SMALL); float* SCAL = (float*)(ws + WS_SMALL + 128 * 1024); int* PADS = (int*)(ws + WS_SMALL + 192 * 1024);
    float* ROPEC = (float*)(ws + WS_ROPEC); float* ROPES = (float*)(ws + WS_ROPES);
    int* TOPI = (int*)(ws + WS_TOPI); float* TOPW = (float*)(ws + WS_TOPW); int* LIST = (int*)(ws + WS_LIST); int* CNT = (int*)(ws + WS_CTL) + CW_CNT;
    bf16_t* H = (bf16_t*)(ws + WS_H); bf16_t* PROJ = (bf16_t*)(ws + WS_PROJ); bf16_t* YA = (bf16_t*)(ws + WS_YA); bf16_t* YB = (bf16_t*)(ws + WS_YB);
    bf16_t* DS = (bf16_t*)(ws + WS_DS); float* DEC = (float*)(ws + WS_DEC); bf16_t* MERGED = (bf16_t*)(ws + WS_MERGED); float* Y = (float*)(ws + WS_Y);
    bf16_t* SP = (bf16_t*)(ws + WS_MERGED);
    bf16_t* ACT = (bf16_t*)(ws + WS_ACT); bf16_t* YM = (bf16_t*)(ws + WS_YM);

    static int grid = 0;
    if (grid == 0) {
        (void)hipFuncSetAttribute((const void*)nv::k_attn, hipFuncAttributeMaxDynamicSharedMemorySize, nv::AT_LDS);
        (void)hipFuncSetAttribute((const void*)nv::k_hgA, hipFuncAttributeMaxDynamicSharedMemorySize, 65536);
        (void)hipFuncSetAttribute((const void*)nv::k_hgC, hipFuncAttributeMaxDynamicSharedMemorySize, nv::HC_LDS);
        (void)hipFuncSetAttribute((const void*)mk::mega, hipFuncAttributeMaxDynamicSharedMemorySize, mk::LDS_BYTES);
        int dev = 0, cus = 0; (void)hipGetDevice(&dev); (void)hipDeviceGetAttribute(&cus, hipDeviceAttributeMultiprocessorCount, dev);
        (void)hipGetLastError();
        grid = cus > 0 ? cus : 256;
    }
    (void)hipMemsetAsync(ws + WS_CTL, 0, 1 * MiB, stream);
    mk::Args a{}; for (int i = 0; i < 25; ++i) a.in[i] = (const float*)d_in[i]; a.out = out; a.ws = ws;
    const unsigned fast = FASTMASK; int li = 0;
    for (int p = 0; p < mk::PH_N;) {
        if (fast & (1u << p)) { int q = p; while (q < mk::PH_N && (fast & (1u << q))) ++q;
            a.ph_lo = p; a.ph_hi = q; a.li = li++; a.pad = 0;
            hipLaunchKernelGGL(mk::mega, dim3(grid), dim3(mk::NTHR), mk::LDS_BYTES, stream, a);
            p = q; continue; }
        switch (p) {
        case mk::PH_PRO:
            nv::k_mod<<<dim3(24, 4), 256, 0, stream>>>(c, w_mod, b_mod, MOD);
            nv::k_small<<<1024, 256, 0, stream>>>(lq1, lk1, lq2, lk2, lbl, SCAL, ROPEC, ROPES); break;
        case mk::PH_H1: nv::k_rowmod<<<T / 4, 256, 0, stream>>>(x, norm_pre_mix, MOD, H, 0, 1024); break;
        case mk::PH_G1: { nv::NG p_{}; p_.A = H; p_.lda = 1024; p_.M = T; p_.B = w_in; p_.ldb = NC; p_.K = 1024;
            nv::k_gemm<nv::EpiStoreBf16, 1><<<dim3(NC / 64, T / 64, 1), 256, 0, stream>>>(p_, nv::EpiStoreBf16{PROJ, (long long)NC}); } break;
        case mk::PH_ROPE_HGA: nv::k_hgA<<<dim3(128, 4, 4), 256, 65536, stream>>>(PROJ, SCAL, DS, DEC); break;
        case mk::PH_ATT_SCAN:
            nv::k_attn<<<dim3(128, 4, 4), 256, nv::AT_LDS, stream>>>(PROJ, ROPEC, ROPES, SCAL, subln, YA);
            nv::k_scan<<<1024, 256, 0, stream>>>(DS, DEC, SP); break;
        case mk::PH_HGC: nv::k_hgC<<<dim3(128, 4, 4), 256, nv::HC_LDS, stream>>>(PROJ, SCAL, SP, hgnorm, YB); break;
        case mk::PH_G2A: { nv::NG p_{}; p_.A = YA; p_.lda = 512; p_.M = T; p_.B = wa; p_.ldb = 1024; p_.K = 512;
            nv::k_gemm<nv::EpiBranchA, 1><<<dim3(16, T / 64, 1), 256, 0, stream>>>(p_, nv::EpiBranchA{out, PROJ}); } break;
        case mk::PH_G2B: { nv::NG p_{}; p_.A = YB; p_.lda = 512; p_.M = T; p_.B = wb; p_.ldb = 1024; p_.K = 512;
            nv::k_gemm<nv::EpiBranchB, 1><<<dim3(16, T / 64, 1), 256, 0, stream>>>(p_, nv::EpiBranchB{out, PROJ, MERGED}); } break;
        case mk::PH_G3: { nv::NG p_{}; p_.A = MERGED; p_.lda = 1024; p_.M = T; p_.B = wo; p_.ldb = 1024; p_.K = 1024;
            nv::k_gemm<nv::EpiStoreF32, 1><<<dim3(16, T / 64, 1), 256, 0, stream>>>(p_, nv::EpiStoreF32{Y, 1024LL}); } break;
        case mk::PH_TOK:
            nv::k_x1<<<T / 4, 256, 0, stream>>>(x, Y, norm_post_mix, MOD, 2048LL, out);
            nv::k_rowmod<<<T / 4, 256, 0, stream>>>(out, norm_pre_ffn, MOD, H, 3072, 4096);
            nv::k_route<<<T / 4, 256, 0, stream>>>(out, norm_pre_ffn, MOD, rw, rb, TOPI, TOPW);
            nv::k_lists<<<T * 4 / 256, 256, 0, stream>>>(TOPI, CNT, LIST);
            nv::k_pads<<<1, 64, 0, stream>>>(CNT, PADS); break;
        case mk::PH_G4: { nv::NG p_{}; p_.A = H; p_.lda = 1024; p_.rowidx = LIST; p_.idxstride = 32768; p_.idxshift = 2; p_.cnt = CNT; p_.rowbase = PADS; p_.B = wgu; p_.strideB = (size_t)1024 * 2048; p_.ldb = 2048; p_.K = 1024; p_.b1off = 1024;
            nv::k_gemm<nv::EpiGateUp, 2><<<dim3(16, T / 64, 32), 256, 0, stream>>>(p_, nv::EpiGateUp{bgu, ACT}); } break;
        case mk::PH_G5: { nv::NG p_{}; p_.A = ACT; p_.lda = 1024; p_.cnt = CNT; p_.rowbase = PADS; p_.B = wd; p_.strideB = (size_t)1024 * 1024; p_.ldb = 1024; p_.K = 1024;
            nv::k_gemm<nv::EpiDown, 1><<<dim3(16, T / 64, 32), 256, 0, stream>>>(p_, nv::EpiDown{bd, LIST, YM}); } break;
        case mk::PH_FIN: nv::k_final<<<T / 4, 256, 0, stream>>>(out, YM, TOPW, norm_post_ffn, MOD); break;
        }
        ++p;
    }
}
```

```cpp
#include <hip/hip_runtime.h>
#include <hip/hip_bf16.h>
#include <stdint.h>
#include <cstdio>

typedef unsigned short bf16_t;
__device__ __forceinline__ float bf2f(bf16_t v) { return __uint_as_float(((unsigned)v) << 16); }
__device__ __forceinline__ bf16_t f2bf(float f) { unsigned u = __float_as_uint(f); return (bf16_t)((u + 0x7fffu + ((u >> 16) & 1u)) >> 16); }

constexpr int NB_ = 4, SEQ = 8192, T = NB_ * SEQ, D = 1024, NC = 5632, NE = 32;
constexpr size_t MiB = 1u << 20;
constexpr size_t WS_CTL = 0;
constexpr size_t WS_SMALL = 1 * MiB;
constexpr size_t WS_ROPEC = 2 * MiB, WS_ROPES = 3 * MiB;
constexpr size_t WS_TOPI = 4 * MiB, WS_TOPW = 4 * MiB + 512 * 1024;
constexpr size_t WS_RWT = 5 * MiB;
constexpr size_t WS_LIST = 6 * MiB;
constexpr size_t WS_WIN = 16 * MiB, WS_WA = 28 * MiB, WS_WB = 29 * MiB, WS_WO = 30 * MiB, WS_WGU = 32 * MiB, WS_WD = 160 * MiB;
constexpr size_t WS_H = 224 * MiB;
constexpr size_t WS_PROJ = 288 * MiB;
constexpr size_t WS_YA = 640 * MiB, WS_YB = 672 * MiB;
constexpr size_t WS_DS = 704 * MiB, WS_DEC = 768 * MiB;
constexpr size_t WS_MERGED = 772 * MiB;
constexpr size_t WS_Y = 836 * MiB;
constexpr size_t WS_ACT = 288 * MiB;
constexpr size_t WS_YM = 560 * MiB;
constexpr size_t WS_END = 964 * MiB;
constexpr int CW_CNT = 1024;
constexpr int CW_KMAX = 2048;
constexpr int CW_BAR = 4096;

namespace nv {

__device__ __forceinline__ float wave_sum(float v) {
#pragma unroll
    for (int o = 1; o < 64; o <<= 1) v += __shfl_xor(v, o);
    return v;
}
__device__ __forceinline__ float sigm(float x) { return 1.f / (1.f + expf(-x)); }

__global__ void __launch_bounds__(256) k_mod(const float* c, const float* w_mod, const float* b_mod, float* mod) {
    const int j = blockIdx.x * 256 + threadIdx.x, b = blockIdx.y;
    float acc = 0.f;
    for (int k = 0; k < 1024; ++k) { const float cv = c[b * 1024 + k]; acc += (cv * sigm(cv)) * w_mod[(size_t)k * 6144 + j]; }
    mod[b * 6144 + j] = acc + b_mod[j];
}
__global__ void __launch_bounds__(256) k_small(const float* q1, const float* k1, const float* q2, const float* k2, const float* lbl,
                                               float* scal, float* ropec, float* ropes) {
    const int gid = blockIdx.x * 256 + threadIdx.x;
    if (gid == 0) { float s1 = 0.f, s2 = 0.f; for (int i = 0; i < 64; ++i) { s1 += q1[i] * k1[i]; s2 += q2[i] * k2[i]; } scal[0] = expf(s1) - expf(s2) + 0.2f; }
    if (gid < 512) { const float a = lbl[gid], b = lbl[512 + gid]; scal[64 + gid] = 1.f / (1.f + expf(b - a)); }
    if (gid < 8192 * 32) { const int s = gid >> 5, i = gid & 31; const float inv = powf(10000.f, -(float)(2 * i) / 64.f); const float ang = (float)s * inv; ropec[gid] = cosf(ang); ropes[gid] = sinf(ang); }
}
__global__ void __launch_bounds__(256) k_rowmod(const float* x, const float* w, const float* mod, bf16_t* out, int shoff, int scoff) {
    const int row = blockIdx.x * 4 + (threadIdx.x >> 6), lane = threadIdx.x & 63, b = row >> 13;
    const float* xr = x + (size_t)row * 1024; float v[16]; float ss = 0.f;
#pragma unroll
    for (int j = 0; j < 16; ++j) { v[j] = xr[lane + 64 * j]; ss += v[j] * v[j]; }
    ss = wave_sum(ss); const float rstd = rsqrtf(ss * (1.f / 1024.f) + 1e-6f);
#pragma unroll
    for (int j = 0; j < 16; ++j) { const int col = lane + 64 * j; const float h = v[j] * rstd * w[col] * (1.f + mod[b * 6144 + scoff + col]) + mod[b * 6144 + shoff + col]; out[(size_t)row * 1024 + col] = f2bf(h); }
}

struct NG {
    const bf16_t* A;
    const int* rowidx;
    const int* cnt;
    const int* rowbase;
    const float* B; size_t strideB;
    int lda, idxstride, idxshift, M  , ldb, K, b1off, pad;
};
template <class Epi, int NB>
__global__ void __launch_bounds__(256) k_gemm(NG p, Epi epi) {
    __shared__ float As[16][68];
    __shared__ float Bs[NB][16][64];
    const int z = blockIdx.z, Mz = p.cnt ? p.cnt[z] : p.M, m0 = blockIdx.y * 64, n0 = blockIdx.x * 64;
    if (m0 >= Mz) return;
    const int tid = threadIdx.x, tx = tid & 15, ty = tid >> 4;
    const float* B = p.B + (size_t)z * p.strideB;
    const int base = p.rowbase ? p.rowbase[z] : 0;
    const int lr = tid >> 2, lk = (tid & 3) * 4;
    int lrow = m0 + lr; if (lrow >= Mz) lrow = Mz - 1;
    const size_t arow = p.rowidx ? (size_t)(p.rowidx[(size_t)z * p.idxstride + lrow] >> p.idxshift) : (size_t)(base + lrow);
    const bf16_t* ap = p.A + arow * p.lda + lk;
    const int bk = tid >> 4, bc = (tid & 15) * 4;
    float acc[NB][4][4];
#pragma unroll
    for (int q = 0; q < NB; ++q)
#pragma unroll
        for (int i = 0; i < 4; ++i)
#pragma unroll
            for (int j = 0; j < 4; ++j) acc[q][i][j] = 0.f;
    for (int k0 = 0; k0 < p.K; k0 += 16) {
        const uint2 av = *(const uint2*)(ap + k0);
        As[lk + 0][lr] = __uint_as_float(av.x << 16); As[lk + 1][lr] = __uint_as_float(av.x & 0xffff0000u);
        As[lk + 2][lr] = __uint_as_float(av.y << 16); As[lk + 3][lr] = __uint_as_float(av.y & 0xffff0000u);
#pragma unroll
        for (int q = 0; q < NB; ++q) { const float4 bv = *(const float4*)(B + (size_t)(k0 + bk) * p.ldb + n0 + bc + q * p.b1off); *(float4*)&Bs[q][bk][bc] = bv; }
        __syncthreads();
#pragma unroll
        for (int k = 0; k < 16; ++k) {
            float a[4]; const float4 a4 = *(const float4*)&As[k][ty * 4]; a[0] = a4.x; a[1] = a4.y; a[2] = a4.z; a[3] = a4.w;
#pragma unroll
            for (int q = 0; q < NB; ++q) { const float4 b4 = *(const float4*)&Bs[q][k][tx * 4]; const float b[4] = {b4.x, b4.y, b4.z, b4.w};
#pragma unroll
                for (int i = 0; i < 4; ++i)
#pragma unroll
                    for (int j = 0; j < 4; ++j) acc[q][i][j] += a[i] * b[j]; }
        }
        __syncthreads();
    }
#pragma unroll
    for (int i = 0; i < 4; ++i) { const int lrw = m0 + ty * 4 + i; if (lrw < Mz) {
#pragma unroll
        for (int j = 0; j < 4; ++j) epi(z, lrw, base + lrw, n0 + tx * 4 + j, acc[0][i][j], NB == 2 ? acc[NB - 1][i][j] : 0.f); } }
}
struct EpiStoreBf16 { bf16_t* C; long long ldc; __device__ void operator()(int, int, int r, int c, float v, float) const { C[(size_t)r * ldc + c] = f2bf(v); } };
struct EpiStoreF32 { float* C; long long ldc; __device__ void operator()(int, int, int r, int c, float v, float) const { C[(size_t)r * ldc + c] = v; } };
struct EpiBranchA { float* tmp; const bf16_t* proj; __device__ void operator()(int, int, int r, int c, float v, float) const { tmp[(size_t)r * 1024 + c] = sigm(bf2f(proj[(size_t)r * 5632 + 3584 + c])) * v; } };
struct EpiBranchB { const float* tmp; const bf16_t* proj; bf16_t* merged; __device__ void operator()(int, int, int r, int c, float v, float) const {
    merged[(size_t)r * 1024 + c] = f2bf(tmp[(size_t)r * 1024 + c] + sigm(bf2f(proj[(size_t)r * 5632 + 4608 + c])) * v); } };
struct EpiGateUp { const float* bgu; bf16_t* act; __device__ void operator()(int e, int, int r, int c, float v0, float v1) const {
    float g = v0 + bgu[e * 2048 + c], u = v1 + bgu[e * 2048 + 1024 + c]; g = fminf(g, 7.f); u = fminf(fmaxf(u, -7.f), 7.f);
    const float glu = g * sigm(1.702f * g); act[(size_t)r * 1024 + c] = f2bf((u + 1.f) * glu); } };
struct EpiDown { const float* bd; const int* list; bf16_t* ym; __device__ void operator()(int e, int lr, int, int c, float v, float) const {
    const int a = list[(size_t)e * 32768 + lr]; ym[(size_t)a * 1024 + c] = f2bf(v + bd[e * 1024 + c]); } };

constexpr int AT_LD = 129;
constexpr int AT_LDS = (3 * 64 * AT_LD + 64 * 65) * 4;
__device__ __forceinline__ void at_load_rope(float* dst, const bf16_t* proj, int tok0, int colbase, const float* ropec, const float* ropes, int s0, int tid) {
    for (int i = 0; i < 16; ++i) { const int idx = tid + 256 * i, row = idx >> 6, rem = idx & 63, m = rem >> 5, d = rem & 31;
        const bf16_t* pr = proj + (size_t)(tok0 + row) * 5632 + colbase + m * 64;
        const float x1 = bf2f(pr[d]), x2 = bf2f(pr[32 + d]), c = ropec[(s0 + row) * 32 + d], s = ropes[(s0 + row) * 32 + d];
        dst[row * AT_LD + m * 64 + d] = x1 * c - x2 * s; dst[row * AT_LD + m * 64 + 32 + d] = x2 * c + x1 * s; }
}
__global__ void __launch_bounds__(256) k_attn(const bf16_t* proj, const float* ropec, const float* ropes, const float* scal, const float* subln, bf16_t* ya) {
    extern __shared__ float sm[];
    float* Qs = sm; float* Ks = Qs + 64 * AT_LD; float* Vs = Ks + 64 * AT_LD; float* As = Vs + 64 * AT_LD;
    const int qc = blockIdx.x, h = blockIdx.y, b = blockIdx.z, tid = threadIdx.x, r = tid >> 2, qd = tid & 3;
    const int tokq = b * 8192 + qc * 64; const float lam = scal[0];
    at_load_rope(Qs, proj, tokq, h * 128, ropec, ropes, qc * 64, tid);
    float m0 = -1e30f, l0 = 0.f, m1 = -1e30f, l1 = 0.f;
    for (int kc = 0; kc <= qc; ++kc) {
        __syncthreads();
        at_load_rope(Ks, proj, b * 8192 + kc * 64, 512 + h * 128, ropec, ropes, kc * 64, tid);
        __syncthreads();
        for (int i = 0; i < 16; ++i) { const int j = 4 * i + qd; float s0 = 0.f, s1 = 0.f;
            for (int d = 0; d < 64; ++d) { s0 += Qs[r * AT_LD + d] * Ks[j * AT_LD + d]; s1 += Qs[r * AT_LD + 64 + d] * Ks[j * AT_LD + 64 + d]; }
            s0 *= 0.125f; s1 *= 0.125f;
            float mn = fmaxf(m0, s0); l0 = l0 * expf(m0 - mn) + expf(s0 - mn); m0 = mn;
            mn = fmaxf(m1, s1); l1 = l1 * expf(m1 - mn) + expf(s1 - mn); m1 = mn; }
    }
#pragma unroll
    for (int o = 1; o < 4; o <<= 1) {
        float mo = __shfl_xor(m0, o), lo = __shfl_xor(l0, o); float mn = fmaxf(m0, mo); l0 = l0 * expf(m0 - mn) + lo * expf(mo - mn); m0 = mn;
        mo = __shfl_xor(m1, o); lo = __shfl_xor(l1, o); mn = fmaxf(m1, mo); l1 = l1 * expf(m1 - mn) + lo * expf(mo - mn); m1 = mn; }
    const float il0 = 1.f / l0, il1 = lam / l1;
    float o[32];
#pragma unroll
    for (int i = 0; i < 32; ++i) o[i] = 0.f;
    for (int kc = 0; kc <= qc; ++kc) {
        __syncthreads();
        at_load_rope(Ks, proj, b * 8192 + kc * 64, 512 + h * 128, ropec, ropes, kc * 64, tid);
        for (int i = 0; i < 32; ++i) { const int idx = tid + 256 * i, row = idx >> 7, col = idx & 127; Vs[row * AT_LD + col] = bf2f(proj[(size_t)(b * 8192 + kc * 64 + row) * 5632 + 1024 + h * 128 + col]); }
        __syncthreads();
        for (int i = 0; i < 16; ++i) { const int j = 4 * i + qd; float s0 = 0.f, s1 = 0.f;
            for (int d = 0; d < 64; ++d) { s0 += Qs[r * AT_LD + d] * Ks[j * AT_LD + d]; s1 += Qs[r * AT_LD + 64 + d] * Ks[j * AT_LD + 64 + d]; }
            s0 *= 0.125f; s1 *= 0.125f;
            As[r * 65 + j] = expf(s0 - m0) * il0 - expf(s1 - m1) * il1; }
        __syncthreads();
        for (int j = 0; j < 64; ++j) { const float av = As[r * 65 + j];
#pragma unroll
            for (int dv = 0; dv < 32; ++dv) o[dv] += av * Vs[j * AT_LD + 32 * qd + dv]; }
    }
    float ss = 0.f;
#pragma unroll
    for (int i = 0; i < 32; ++i) ss += o[i] * o[i];
    ss += __shfl_xor(ss, 1); ss += __shfl_xor(ss, 2);
    const float rstd = rsqrtf(ss * (1.f / 128.f) + 1e-6f);
#pragma unroll
    for (int i = 0; i < 32; ++i) { const int dv = 32 * qd + i; ya[(size_t)(tokq + r) * 512 + h * 128 + dv] = f2bf(o[i] * rstd * subln[dv] * 0.8f); }
}

__global__ void __launch_bounds__(256) k_hgA(const bf16_t* proj, const float* scal, bf16_t* ds, float* dec) {
    extern __shared__ float sm[];
    float* G = sm; float* V = sm + 64 * 128;
    const int n = blockIdx.x, h = blockIdx.y, b = blockIdx.z, tid = threadIdx.x, tok0 = b * 8192 + n * 64, bh = b * 4 + h;
    for (int i = 0; i < 32; ++i) { const int idx = tid + 256 * i, c = idx >> 7, d = idx & 127; const bf16_t* pr = proj + (size_t)(tok0 + c) * 5632 + h * 128 + d;
        const float lb = scal[64 + h * 128 + d]; const float f = lb + (1.f - lb) * sigm(bf2f(pr[2048])); G[c * 128 + d] = f; V[c * 128 + d] = bf2f(pr[2560]); }
    __syncthreads();
    float kk[64]; float glast = 0.f; const int d = tid & 127, vb = (tid >> 7) * 64;
    {
        float g = 0.f;
#pragma unroll
        for (int c = 0; c < 64; ++c) { const float f = G[c * 128 + d]; g += logf(f); kk[c] = g; }
        glast = g;
#pragma unroll
        for (int c = 0; c < 64; ++c) { const float f = G[c * 128 + d]; kk[c] = (1.f - f) * expf(glast - kk[c]); }
    }
    if (tid < 128) dec[(size_t)(bh * 128 + n) * 128 + d] = expf(glast);
    for (int v0 = 0; v0 < 64; v0 += 16) {
        float acc[16];
#pragma unroll
        for (int i = 0; i < 16; ++i) acc[i] = 0.f;
#pragma unroll
        for (int c = 0; c < 64; ++c) {
#pragma unroll
            for (int i = 0; i < 16; ++i) acc[i] += kk[c] * V[c * 128 + vb + v0 + i]; }
#pragma unroll
        for (int i = 0; i < 16; ++i) ds[((size_t)(bh * 128 + n) * 128 + d) * 128 + vb + v0 + i] = f2bf(acc[i]);
    }
}
__global__ void __launch_bounds__(256) k_scan(const bf16_t* ds, const float* dec, bf16_t* sp) {
    const int gid = blockIdx.x * 256 + threadIdx.x; const int bh = gid >> 14, d = (gid >> 7) & 127, v = gid & 127;
    float st = 0.f;
    for (int n = 0; n < 128; ++n) { const size_t o = ((size_t)(bh * 128 + n) * 128 + d) * 128 + v; const float x = bf2f(ds[o]); sp[o] = f2bf(st); st = dec[(size_t)(bh * 128 + n) * 128 + d] * st + x; }
}
constexpr int HC_LDS = (2 * 64 * 129 + 64 * 128 + 64 * 65) * 4;
__global__ void __launch_bounds__(256) k_hgC(const bf16_t* proj, const float* scal, const bf16_t* sp, const float* hgnorm, bf16_t* yb) {
    extern __shared__ float sm[];
    float* QT = sm; float* KT = QT + 64 * 129; float* V = KT + 64 * 129; float* As = V + 64 * 128;
    const int n = blockIdx.x, h = blockIdx.y, b = blockIdx.z, tid = threadIdx.x, tok0 = b * 8192 + n * 64, bh = b * 4 + h;
    for (int i = 0; i < 32; ++i) { const int idx = tid + 256 * i, c = idx >> 7, d = idx & 127; const bf16_t* pr = proj + (size_t)(tok0 + c) * 5632 + h * 128 + d;
        const float lb = scal[64 + h * 128 + d]; const float f = lb + (1.f - lb) * sigm(bf2f(pr[2048])); const float q = bf2f(pr[1536]);
        QT[c * 129 + d] = q * sigm(q); KT[c * 129 + d] = f; V[c * 128 + d] = bf2f(pr[2560]); }
    __syncthreads();
    if (tid < 128) { float g = 0.f; for (int c = 0; c < 64; ++c) { const float f = KT[c * 129 + tid]; g += logf(f); QT[c * 129 + tid] *= expf(g); KT[c * 129 + tid] = (1.f - f) * expf(-g); } }
    __syncthreads();
    const int c = tid >> 2, q4 = tid & 3;
    for (int i = 0; i < 16; ++i) { const int s = 4 * i + q4; float a = 0.f;
        if (s <= c) { for (int d = 0; d < 128; ++d) a += QT[c * 129 + d] * KT[s * 129 + d]; }
        As[c * 65 + s] = a; }
    __syncthreads();
    float o[32];
#pragma unroll
    for (int i = 0; i < 32; ++i) o[i] = 0.f;
    for (int s = 0; s < 64; ++s) { const float a = As[c * 65 + s];
#pragma unroll
        for (int i = 0; i < 32; ++i) o[i] += a * V[s * 128 + 32 * q4 + i]; }
    const bf16_t* spb = sp + (size_t)(bh * 128 + n) * 128 * 128;
    for (int d = 0; d < 128; ++d) { const float qv = QT[c * 129 + d];
#pragma unroll
        for (int i = 0; i < 32; ++i) o[i] += qv * bf2f(spb[d * 128 + 32 * q4 + i]); }
    float ss = 0.f;
#pragma unroll
    for (int i = 0; i < 32; ++i) ss += o[i] * o[i];
    ss += __shfl_xor(ss, 1); ss += __shfl_xor(ss, 2);
    const float rstd = rsqrtf(ss * (1.f / 128.f) + 1e-6f);
#pragma unroll
    for (int i = 0; i < 32; ++i) { const int v = 32 * q4 + i; const float g = bf2f(proj[(size_t)(tok0 + c) * 5632 + 3072 + h * 128 + v]);
        yb[(size_t)(tok0 + c) * 512 + h * 128 + v] = f2bf(o[i] * rstd * hgnorm[v] * (g * sigm(g))); }
}
__global__ void __launch_bounds__(256) k_x1(const float* x, const float* y, const float* w, const float* mod, long long goff, float* x1) {
    const int row = blockIdx.x * 4 + (threadIdx.x >> 6), lane = threadIdx.x & 63, b = row >> 13;
    const float* yr = y + (size_t)row * 1024; float v[16]; float ss = 0.f;
#pragma unroll
    for (int j = 0; j < 16; ++j) { v[j] = yr[lane + 64 * j]; ss += v[j] * v[j]; }
    ss = wave_sum(ss); const float rstd = rsqrtf(ss * (1.f / 1024.f) + 1e-6f);
#pragma unroll
    for (int j = 0; j < 16; ++j) { const int col = lane + 64 * j; x1[(size_t)row * 1024 + col] = x[(size_t)row * 1024 + col] + mod[b * 6144 + goff + col] * v[j] * rstd * w[col]; }
}
__global__ void __launch_bounds__(256) k_route(const float* x1, const float* w, const float* mod, const float* rw, const float* rb, int* topi, float* topw) {
    const int row = blockIdx.x * 4 + (threadIdx.x >> 6), lane = threadIdx.x & 63, b = row >> 13;
    const float* xr = x1 + (size_t)row * 1024; float v[16]; float ss = 0.f;
#pragma unroll
    for (int j = 0; j < 16; ++j) { v[j] = xr[lane + 64 * j]; ss += v[j] * v[j]; }
    ss = wave_sum(ss); const float rstd = rsqrtf(ss * (1.f / 1024.f) + 1e-6f);
    float lg[32];
#pragma unroll
    for (int e = 0; e < 32; ++e) lg[e] = 0.f;
#pragma unroll
    for (int j = 0; j < 16; ++j) { const int col = lane + 64 * j; const float h = v[j] * rstd * w[col] * (1.f + mod[b * 6144 + 4096 + col]) + mod[b * 6144 + 3072 + col];
#pragma unroll
        for (int e = 0; e < 32; ++e) lg[e] += h * rw[col * 32 + e]; }
#pragma unroll
    for (int e = 0; e < 32; ++e) lg[e] = wave_sum(lg[e]) + rb[e];
    int bi[4]; float bv[4];
#pragma unroll
    for (int k = 0; k < 4; ++k) { float best = -3.0e38f; int be = 0;
#pragma unroll
        for (int e = 0; e < 32; ++e) { bool taken = false;
#pragma unroll
            for (int q = 0; q < 4; ++q) if (q < k && bi[q] == e) taken = true;
            if (!taken && lg[e] > best) { best = lg[e]; be = e; } }
        bi[k] = be; bv[k] = best; }
    const float e1 = expf(bv[1] - bv[0]), e2 = expf(bv[2] - bv[0]), e3 = expf(bv[3] - bv[0]); const float inv = 1.f / (1.f + e1 + e2 + e3);
    if (lane == 0) { topi[row * 4 + 0] = bi[0]; topi[row * 4 + 1] = bi[1]; topi[row * 4 + 2] = bi[2]; topi[row * 4 + 3] = bi[3];
        topw[row * 4 + 0] = inv; topw[row * 4 + 1] = e1 * inv; topw[row * 4 + 2] = e2 * inv; topw[row * 4 + 3] = e3 * inv; }
}
__global__ void __launch_bounds__(256) k_lists(const int* topi, int* cnt, int* list) {
    const int a = blockIdx.x * 256 + threadIdx.x; const int e = topi[a]; const int pos = atomicAdd(&cnt[e], 1); list[(size_t)e * 32768 + pos] = a;
}
__global__ void k_pads(const int* cnt, int* pads) { if (threadIdx.x == 0) { int s = 0; for (int e = 0; e < 32; ++e) { pads[e] = s; s += ((cnt[e] + 255) / 256) * 256; } } }
__global__ void __launch_bounds__(256) k_final(float* out, const bf16_t* ym, const float* topw, const float* w, const float* mod) {
    const int row = blockIdx.x * 4 + (threadIdx.x >> 6), lane = threadIdx.x & 63, b = row >> 13;
    float v[16]; float ss = 0.f; const float w0 = topw[row * 4], w1 = topw[row * 4 + 1], w2 = topw[row * 4 + 2], w3 = topw[row * 4 + 3];
    const bf16_t* y0 = ym + (size_t)row * 4096;
#pragma unroll
    for (int j = 0; j < 16; ++j) { const int col = lane + 64 * j; v[j] = w0 * bf2f(y0[col]) + w1 * bf2f(y0[1024 + col]) + w2 * bf2f(y0[2048 + col]) + w3 * bf2f(y0[3072 + col]); ss += v[j] * v[j]; }
    ss = wave_sum(ss); const float rstd = rsqrtf(ss * (1.f / 1024.f) + 1e-6f);
#pragma unroll
    for (int j = 0; j < 16; ++j) { const int col = lane + 64 * j; out[(size_t)row * 1024 + col] += mod[b * 6144 + 5120 + col] * v[j] * rstd * w[col]; }
}
}
#define GAS __attribute__((address_space(1)))
#define LAS __attribute__((address_space(3)))
typedef GAS unsigned gu32;
#define RLX_AGENT __ATOMIC_RELAXED, __HIP_MEMORY_SCOPE_AGENT
#define XB_TMO      128
#define XB_XCNT(j)  (256  + 64 * (j))
#define XB_XSUB(j)  (1280 + 64 * (j))
#define XB_XGEN(j)  (2304 + 64 * (j))
#define XB_TOP      3328
#define XB_TOPGEN   3392
#define XCD_BAR_WORDS 3456
#define XB_SPIN_CAP (1u << 22)

__device__ __forceinline__ unsigned xb_ld(unsigned* p)              { return __hip_atomic_load(p, __ATOMIC_RELAXED, __HIP_MEMORY_SCOPE_AGENT); }
__device__ __forceinline__ unsigned xb_add(unsigned* p, unsigned v) { return __hip_atomic_fetch_add(p, v, __ATOMIC_RELAXED, __HIP_MEMORY_SCOPE_AGENT); }
__device__ __forceinline__ unsigned xb_xcc_id() { return (unsigned)__builtin_amdgcn_s_getreg((3 << 11) | 20) & 0xFu; }
#define XB_SPIN(cond, bar) do { unsigned _sp = 0; while (cond) { __builtin_amdgcn_s_sleep(1); \
    if ((++_sp & 255u) == 0u) { if (xb_ld(&(bar)[XB_TMO])) break; if (_sp > XB_SPIN_CAP) { atomicAdd(&(bar)[XB_TMO], 1u); break; } } } } while (0)

struct XcdBarrier {
    unsigned* bar; unsigned x;
    volatile LAS unsigned* st;
};
__device__ __forceinline__ XcdBarrier xcd_barrier_post(unsigned* bar, volatile LAS unsigned* st) {
    XcdBarrier b; b.bar = bar; b.x = xb_xcc_id(); b.st = st;
    if (threadIdx.x == 0) (void)xb_add(&bar[XB_XCNT(b.x)], 1u);
    return b;
}
__device__ __forceinline__ void xcd_barrier_complete(unsigned* bar, unsigned x, unsigned& nloc, unsigned& nx) {
    const unsigned G = gridDim.x * gridDim.y * gridDim.z;
    unsigned sum, cnt, mine, sp = 0u;
    for (;;) {
        sum = 0u; cnt = 0u; mine = 0u;
#pragma unroll
        for (unsigned j = 0; j < 16; ++j) { const unsigned c = xb_ld(&bar[XB_XCNT(j)]); sum += c; cnt += (c > 0u) ? 1u : 0u; mine = (j == x) ? c : mine; }
        if (sum == G) break;
        __builtin_amdgcn_s_sleep(1);
        if ((++sp & 255u) == 0u) { if (xb_ld(&bar[XB_TMO])) break; if (sp > XB_SPIN_CAP) { atomicAdd(&bar[XB_TMO], 1u); break; } }
    }
    nloc = mine > 0u ? mine : 1u; nx = cnt > 0u ? cnt : 1u;
}
__device__ __forceinline__ void xcd_barrier(const XcdBarrier& b) {
    asm volatile("s_waitcnt vmcnt(0)" ::: "memory");
    __syncthreads();
    if (threadIdx.x == 0) {
        unsigned* bar = b.bar;
        __builtin_amdgcn_s_waitcnt(0);
        unsigned nloc = b.st[0], nx = b.st[1];
        if (nloc == 0u) { xcd_barrier_complete(bar, b.x, nloc, nx); b.st[0] = nloc; b.st[1] = nx; }
        const unsigned old = xb_add(&bar[XB_XSUB(b.x)], 1u);
        const unsigned gen = old / nloc;
        if (old + 1u == (gen + 1u) * nloc) {
            __builtin_amdgcn_fence(__ATOMIC_RELEASE, "agent");
            asm volatile("s_waitcnt vmcnt(0)" ::: "memory");
            const unsigned og = xb_add(&bar[XB_TOP], 1u);
            const unsigned tg = og / nx;
            if (og + 1u == (tg + 1u) * nx) xb_add(&bar[XB_TOPGEN], 1u);
            else XB_SPIN(xb_ld(&bar[XB_TOPGEN]) == tg, bar);
            __builtin_amdgcn_fence(__ATOMIC_ACQUIRE, "agent");
            xb_add(&bar[XB_XGEN(b.x)], 1u);
            asm volatile("s_waitcnt vmcnt(0)" ::: "memory");
        } else {
            XB_SPIN(xb_ld(&bar[XB_XGEN(b.x)]) == gen, bar);
            __builtin_amdgcn_fence(__ATOMIC_ACQUIRE, "agent");
            asm volatile("s_waitcnt vmcnt(0)" ::: "memory");
        }
    }
    __syncthreads();
}
namespace pg8 {
#define PG8_LAS __attribute__((address_space(3)))
typedef short bf16x8 __attribute__((ext_vector_type(8)));
typedef float f32x4 __attribute__((ext_vector_type(4)));
typedef float f32x2 __attribute__((ext_vector_type(2)));
typedef unsigned u32x4 __attribute__((ext_vector_type(4)));
typedef unsigned u32x2 __attribute__((ext_vector_type(2)));
typedef int i32x4 __attribute__((ext_vector_type(4)));
typedef int i32x8 __attribute__((ext_vector_type(8)));
constexpr int BM = 256, BK = 64, HALF = 128, HTB = HALF * BK * 2  , STAGE_BYTES = 8 * HTB, NXCD = 8, WGM = 8;

__host__ __device__ __forceinline__ int lds_byte(int r, int c) { const int st = (r >> 4) * 2 + (c >> 5), rr = r & 15, cc = c & 31, ob = rr * 64 + cc * 2; return st * 1024 + (ob ^ (((ob >> 9) & 1) << 5)); }
__host__ __device__ __forceinline__ void stage_rc(int b, int& R, int& C) { const int st = b / 1024, sb = b % 1024, swz = sb ^ (((sb >> 9) & 1) << 5); R = (st >> 1) * 16 + swz / 64; C = (st & 1) * 32 + (swz % 64) / 2; }
__host__ __device__ __forceinline__ int perm32(int rho) { const int n = rho >> 4, i = rho & 15; return 8 * (i >> 2) + 4 * n + (i & 3); }

struct Unit { int pm, pn, z, arow, brow; };
struct Gemm { const bf16_t* A; const bf16_t* Bt; int K; const bf16_t* A2; const bf16_t* Bt2; };

struct DenseOrder {
    int nM, nN, nwg, G, c;
    __device__ void init(int M, int N, int G_, int c_) { nM = M / BM; nN = N / BM; nwg = nM * nN; G = G_; c = c_; }
    __device__ bool next(int i, Unit& u) const {
        const long L = (long)i * G + c; if (L >= nwg) return false;
        int wgid = (int)L; { const int q = nwg / NXCD, r = nwg % NXCD, xcd = wgid % NXCD, off = wgid / NXCD; wgid = (xcd < r ? xcd * (q + 1) : r * (q + 1) + (xcd - r) * q) + off; }
        const int nig = WGM * nN, gid = wgid / nig, fm = gid * WGM, gsz = (nM - fm) < WGM ? (nM - fm) : WGM;
        u.pm = fm + ((wgid % nig) % gsz); u.pn = (wgid % nig) / gsz; u.z = 0; u.arow = u.pm * BM; u.brow = u.pn * BM; return true;
    }
    __device__ __forceinline__ unsigned row_off(const Unit&, int) const { return 0u; }
};

struct DenseOrder2 { DenseOrder base;
    __device__ bool next(int i, Unit& u) const { if (!base.next(i >> 1, u)) return false; u.z = i & 1; return true; }
    __device__ __forceinline__ unsigned row_off(const Unit&, int) const { return 0u; }
};
__device__ __forceinline__ unsigned cvt_pk_bf16(float lo, float hi) { unsigned r; asm volatile("v_cvt_pk_bf16_f32 %0, %1, %2" : "=v"(r) : "v"(lo), "v"(hi)); return r; }


template <class Epi, class Sched, bool GATHER, bool TWOPART = false, bool FP8 = false>
__device__ __forceinline__ void gemm_phase(PG8_LAS unsigned char* lds, const Gemm g, const Sched& S, const Epi& E) {
    int tid_ = threadIdx.x; asm volatile("" : "+v"(tid_));
    const int tid = tid_, wid = __builtin_amdgcn_readfirstlane(tid >> 6), lane = tid & 63, wr = wid >> 2, wc = wid & 3, fr = lane & 15, fq = lane >> 4;
    const int K = g.K, nt = K / BK;
    unsigned voffA[2], voffB[2]; int RA[2];
#pragma unroll
    for (int i = 0; i < 2; ++i) { int R, C; stage_rc(tid * 16 + i * 8192, R, C); const int Rb = Epi::PERM ? ((R & ~31) + perm32(R & 31)) : R;
        RA[i] = R; voffA[i] = GATHER ? (unsigned)(C * 2) : (unsigned)(R * K + C) * 2u; voffB[i] = (unsigned)(Rb * K + C) * 2u; }
    const size_t kstep = (size_t)(BK * 2);
    const size_t hstep = (size_t)HALF * K * 2;
    const unsigned ldsw = (unsigned)wid * 1024u;
    const int aoff = lds_byte(wr * 64 + fr, fq * 8), boff = lds_byte(wc * 32 + fr, fq * 8);
    unsigned gAc[2][2], gAn[2][2];
#define PG8_SA(b, h) (((b) * 2 + (h)) * HTB)
#define PG8_SB(b, h) ((4 + (b) * 2 + (h)) * HTB)
#define PG8_STAGE(bufoff, gbase, voff) do { _Pragma("unroll") for (int _i = 0; _i < 2; ++_i) \
        __builtin_amdgcn_global_load_lds((const unsigned*)((const char*)(gbase) + (voff)[_i]), (PG8_LAS unsigned*)(lds + (bufoff) + ldsw + _i * 8192), 16, 0, 0); } while (0)
#define PG8_STAGEA(bufoff, gbase, h, nx) do { if constexpr (GATHER) { _Pragma("unroll") for (int _i = 0; _i < 2; ++_i) { const unsigned _v = ((nx) ? gAn[h][_i] : gAc[h][_i]) + voffA[_i]; \
        __builtin_amdgcn_global_load_lds((const unsigned*)((const char*)(gbase) + _v), (PG8_LAS unsigned*)(lds + (bufoff) + ldsw + _i * 8192), 16, 0, 0); } } \
        else { PG8_STAGE(bufoff, (const char*)(gbase) + (h) * hstep, voffA); } } while (0)
#define PG8_LD8(base) __builtin_shufflevector(*(const PG8_LAS i32x4*)(base), *(const PG8_LAS i32x4*)((base) + 1024), 0, 1, 2, 3, 4, 5, 6, 7)
#define PG8_LDA(dst, b, h) do { if constexpr (FP8) { _Pragma("unroll") for (int m = 0; m < 4; ++m) dst##8[m] = PG8_LD8(lds + PG8_SA(b, h) + aoff + m * 2048); } \
        else { _Pragma("unroll") for (int m = 0; m < 4; ++m) _Pragma("unroll") for (int k = 0; k < 2; ++k) dst[m][k] = *(const PG8_LAS bf16x8*)(lds + PG8_SA(b, h) + aoff + m * 2048 + k * 1024); } } while (0)
#define PG8_LDB(dst, b, h) do { if constexpr (FP8) { _Pragma("unroll") for (int n = 0; n < 2; ++n) dst##8[n] = PG8_LD8(lds + PG8_SB(b, h) + boff + n * 2048); } \
        else { _Pragma("unroll") for (int n = 0; n < 2; ++n) _Pragma("unroll") for (int k = 0; k < 2; ++k) dst[n][k] = *(const PG8_LAS bf16x8*)(lds + PG8_SB(b, h) + boff + n * 2048 + k * 1024); } } while (0)
#define PG8_CAT(x, y) __builtin_shufflevector(__builtin_bit_cast(i32x4, x), __builtin_bit_cast(i32x4, y), 0, 1, 2, 3, 4, 5, 6, 7)
#define PG8_MMA(ai, bj, At, Bt) do { __builtin_amdgcn_s_setprio(1); \
        if constexpr (FP8) { _Pragma("unroll") for (int m = 0; m < 4; ++m) _Pragma("unroll") for (int n = 0; n < 2; ++n) \
            asm volatile("v_mfma_scale_f32_16x16x128_f8f6f4 %0, %1, %2, %0, %3, %3 op_sel_hi:[0,0,0]" : "+v"(acc[ai][bj][m][n]) : "v"(Bt##8[n]), "v"(At##8[m]), "v"(one8)); } \
        else { _Pragma("unroll") for (int m = 0; m < 4; ++m) _Pragma("unroll") for (int n = 0; n < 2; ++n) _Pragma("unroll") for (int k = 0; k < 2; ++k) \
            acc[ai][bj][m][n] = __builtin_amdgcn_mfma_f32_16x16x32_bf16(Bt[n][k], At[m][k], acc[ai][bj][m][n], 0, 0, 0); } \
        __builtin_amdgcn_s_setprio(0); } while (0)
#define PG8_WAIT_V(n) asm volatile("s_waitcnt vmcnt(" #n ")" ::: "memory")
#define PG8_WAIT_L(n) asm volatile("s_waitcnt lgkmcnt(" #n ")" ::: "memory")
#define PG8_BAR __builtin_amdgcn_s_barrier()
#define PG8_SCHED __builtin_amdgcn_sched_barrier(0)
    Unit cur, nxt; int ui = 0;
    if (!S.next(0, cur)) return;
    f32x4 acc[2][2][4][2];
#pragma unroll
    for (int a = 0; a < 2; ++a)
#pragma unroll
        for (int b = 0; b < 2; ++b)
#pragma unroll
            for (int m = 0; m < 4; ++m)
#pragma unroll
                for (int n = 0; n < 2; ++n) acc[a][b][m][n] = (f32x4){0.f, 0.f, 0.f, 0.f};
    if constexpr (FP8) {
#pragma unroll
        for (int a = 0; a < 2; ++a)
#pragma unroll
            for (int b = 0; b < 2; ++b) asm volatile("s_nop 3" : "+v"(acc[a][b][0][0]), "+v"(acc[a][b][0][1]), "+v"(acc[a][b][1][0]), "+v"(acc[a][b][1][1]), "+v"(acc[a][b][2][0]), "+v"(acc[a][b][2][1]), "+v"(acc[a][b][3][0]), "+v"(acc[a][b][3][1]));
    }
    unsigned one8 = 0x7f7f7f7fu; asm volatile("" : "+v"(one8));
    bf16x8 At[4][2], B0[2][2], B1[2][2];
    i32x8 At8[4], B08[2], B18[2];
    const char* cA = GATHER ? (const char*)g.A : (const char*)((TWOPART && cur.z) ? g.A2 : g.A) + (size_t)cur.arow * K * 2; const char* cB = (const char*)((TWOPART && cur.z) ? g.Bt2 : g.Bt) + (size_t)cur.brow * K * 2;
    if constexpr (GATHER) {
#pragma unroll
        for (int h = 0; h < 2; ++h)
#pragma unroll
            for (int i = 0; i < 2; ++i) { gAc[h][i] = S.row_off(cur, h * HALF + RA[i]); gAn[h][i] = gAc[h][i]; }
    }
    PG8_STAGE(PG8_SB(0, 0), cB, voffB); PG8_STAGE(PG8_SB(0, 1), cB + hstep, voffB); PG8_STAGEA(PG8_SA(0, 0), cA, 0, false); PG8_STAGEA(PG8_SA(0, 1), cA, 1, false);
    if (wr == 1) PG8_BAR;
    PG8_WAIT_V(2); PG8_BAR;
    PG8_STAGE(PG8_SB(1, 0), cB + kstep, voffB); PG8_STAGEA(PG8_SA(1, 0), cA + kstep, 0, false); PG8_STAGE(PG8_SB(1, 1), cB + hstep + kstep, voffB);
    PG8_WAIT_V(6); PG8_BAR;
    for (;;) {
        const bool has_next = S.next(ui + 1, nxt);
        const char* nA = has_next ? (GATHER ? (const char*)g.A : (const char*)((TWOPART && nxt.z) ? g.A2 : g.A) + (size_t)nxt.arow * K * 2) : cA; const char* nB = has_next ? (const char*)((TWOPART && nxt.z) ? g.Bt2 : g.Bt) + (size_t)nxt.brow * K * 2 : cB;
        if constexpr (GATHER) { if (has_next) {
#pragma unroll
            for (int h = 0; h < 2; ++h)
#pragma unroll
                for (int i = 0; i < 2; ++i) gAn[h][i] = S.row_off(nxt, h * HALF + RA[i]); } }
#pragma unroll 1
        for (int t = 0; t < nt; t += 2) {
            const bool last = (t == nt - 2);
            const char* a1 = cA + (size_t)(t + 1) * kstep;
            const char* a2 = last ? nA : cA + (size_t)(t + 2) * kstep; const char* b2 = last ? nB : cB + (size_t)(t + 2) * kstep;
            const char* a3 = a2 + kstep; const char* b3 = b2 + kstep;
            PG8_LDB(B0, 0, 0); PG8_LDB(B1, 0, 1); PG8_SCHED; PG8_LDA(At, 0, 0); PG8_STAGEA(PG8_SA(1, 1), a1, 1, false);
            PG8_WAIT_V(8); PG8_WAIT_L(0); PG8_BAR; PG8_MMA(0, 0, At, B0); PG8_MMA(0, 1, At, B1); PG8_BAR; PG8_SCHED;
            PG8_LDA(At, 0, 1); PG8_STAGE(PG8_SB(0, 0), b2, voffB); PG8_STAGE(PG8_SB(0, 1), b2 + hstep, voffB); PG8_STAGEA(PG8_SA(0, 0), a2, 0, last);
            PG8_WAIT_V(8); PG8_WAIT_L(0); PG8_BAR; PG8_MMA(1, 0, At, B0); PG8_MMA(1, 1, At, B1); PG8_BAR; PG8_SCHED;
            PG8_LDB(B0, 1, 0); PG8_LDB(B1, 1, 1); PG8_SCHED; PG8_LDA(At, 1, 0); PG8_STAGEA(PG8_SA(0, 1), a2, 1, last);
            PG8_WAIT_V(8); PG8_WAIT_L(0); PG8_BAR; PG8_MMA(0, 0, At, B0); PG8_MMA(0, 1, At, B1); PG8_BAR; PG8_SCHED;
            PG8_LDA(At, 1, 1); PG8_STAGE(PG8_SB(1, 0), b3, voffB); PG8_STAGE(PG8_SB(1, 1), b3 + hstep, voffB); PG8_STAGEA(PG8_SA(1, 0), a3, 0, last);
            PG8_WAIT_V(8); PG8_WAIT_L(0); PG8_BAR; PG8_MMA(1, 0, At, B0); PG8_MMA(1, 1, At, B1); PG8_BAR; PG8_SCHED;
        }
        if constexpr (FP8) asm volatile("s_nop 15\n\ts_nop 15" ::: "memory");
        if (wr == 0) PG8_BAR;
        const bool keep = E(acc, cur, wr, wc, fr, fq);
        if (!has_next) break;
        if (!(TWOPART && keep))
#pragma unroll
        for (int a = 0; a < 2; ++a)
#pragma unroll
            for (int b = 0; b < 2; ++b)
#pragma unroll
                for (int m = 0; m < 4; ++m)
#pragma unroll
                    for (int n = 0; n < 2; ++n) acc[a][b][m][n] = (f32x4){0.f, 0.f, 0.f, 0.f};
        if constexpr (FP8) {
#pragma unroll
        for (int a = 0; a < 2; ++a)
#pragma unroll
            for (int b = 0; b < 2; ++b) asm volatile("s_nop 3" : "+v"(acc[a][b][0][0]), "+v"(acc[a][b][0][1]), "+v"(acc[a][b][1][0]), "+v"(acc[a][b][1][1]), "+v"(acc[a][b][2][0]), "+v"(acc[a][b][2][1]), "+v"(acc[a][b][3][0]), "+v"(acc[a][b][3][1]));
    }
        cur = nxt; cA = nA; cB = nB; ++ui;
        if constexpr (GATHER) {
#pragma unroll
            for (int h = 0; h < 2; ++h)
#pragma unroll
                for (int i = 0; i < 2; ++i) gAc[h][i] = gAn[h][i];
        }
        if (wr == 1) PG8_BAR;
    }
    PG8_WAIT_V(0);
    PG8_BAR;
#undef PG8_SA
#undef PG8_SB
#undef PG8_STAGE
#undef PG8_STAGEA
#undef PG8_LDA
#undef PG8_LDB
#undef PG8_MMA
#undef PG8_CAT
#undef PG8_LD8
#undef PG8_WAIT_V
#undef PG8_WAIT_L
#undef PG8_BAR
#undef PG8_SCHED
}
}
namespace at {
typedef short bf16x8 __attribute__((ext_vector_type(8)));
typedef short s16x4 __attribute__((ext_vector_type(4)));
typedef float f32x16 __attribute__((ext_vector_type(16)));
typedef unsigned u32x4 __attribute__((ext_vector_type(4)));
typedef __attribute__((address_space(3))) const char* lds_cptr;
typedef short v4i16_t __attribute__((ext_vector_type(4)));
constexpr int SLOT = 32768, L_WSF = 4 * SLOT + 2048;
constexpr float C2 = 0.125f * 1.4426950408889634f;
__device__ __forceinline__ int crow(int r, int hi) { return (r & 3) + 8 * (r >> 2) + 4 * hi; }
__device__ __forceinline__ void glds16(const void* gsrc, unsigned lds_dst) { unsigned keep;
    asm volatile("s_mov_b32 %0, m0\n\ts_mov_b32 m0, %2\n\ts_nop 0\n\tglobal_load_lds_dwordx4 %1, off\n\ts_mov_b32 m0, %0" : "=&s"(keep) : "v"(gsrc), "s"(lds_dst) : "memory"); }
typedef float f32x2_t __attribute__((ext_vector_type(2))); typedef __bf16 bf16x2_t __attribute__((ext_vector_type(2)));
__device__ __forceinline__ unsigned cvtpk(float lo, float hi) { f32x2_t v = {lo, hi}; bf16x2_t b = __builtin_convertvector(v, bf16x2_t); return __builtin_bit_cast(unsigned, b); }
__device__ __forceinline__ s16x4 vtr(lds_cptr p) { return __builtin_bit_cast(s16x4, __builtin_amdgcn_ds_read_tr16_b64_v4i16((__attribute__((address_space(3))) v4i16_t*)p)); }
#define AT_WAIT_BAR(N) asm volatile("s_waitcnt vmcnt(" #N ") lgkmcnt(0)\n\ts_barrier" ::: "memory")

__device__ __forceinline__ void attn_unit(__attribute__((address_space(3))) unsigned char* lds, const bf16_t* QR, const bf16_t* KIMG, const bf16_t* VIMG, bf16_t* YA, const float* subln, float lam, const unsigned* KMAX,
                                          int b, int h, int blk, int tid) {
    typedef __attribute__((address_space(3))) float lds_f;
    asm volatile("" : "+v"(tid));
    const int lane = tid & 63, r32 = lane & 31, hi = lane >> 5; const int w = __builtin_amdgcn_readfirstlane(tid >> 6), m = w & 1, rg = w >> 1;
    const int NT = 2 * blk + 2, bh = b * 4 + h;
    const size_t tokb = (size_t)b * 8192;
    const unsigned lds0 = (unsigned)(size_t)lds;
    const bf16_t* ksrc0 = KIMG + ((size_t)bh * 128 * 16 + 2 * w) * 512 + lane * 8;
    const bf16_t* vsrc0 = VIMG + ((size_t)bh * 128 * 16 + 2 * w) * 512 + lane * 8;
#define AT_DMA(t, slotoff) do { const bf16_t* ks_ = ksrc0 + (size_t)(t) * 8192; const bf16_t* vs_ = vsrc0 + (size_t)(t) * 8192; \
        const unsigned kd_ = (unsigned)__builtin_amdgcn_readfirstlane(lds0 + (unsigned)(slotoff) + (unsigned)w * 2048u); \
        glds16(ks_, kd_); glds16(ks_ + 512, kd_ + 1024u); glds16(vs_, kd_ + 16384u); glds16(vs_ + 512, kd_ + 16384u + 1024u); } while (0)
#define AT_QK(P0, P1, slotoff) do { const lds_cptr kp_ = (lds_cptr)(lds + (slotoff)) + (m * 8 + hi) * 1024 + r32 * 16; \
        _Pragma("unroll") for (int d0 = 0; d0 < 4; ++d0) { const bf16x8 k0 = *(const __attribute__((address_space(3))) bf16x8*)(kp_ + d0 * 2048), k1 = *(const __attribute__((address_space(3))) bf16x8*)(kp_ + d0 * 2048 + 512); \
            P0 = __builtin_amdgcn_mfma_f32_32x32x16_bf16(k0, qr[d0], d0 == 0 ? negm : P0, 0, 0, 0); P1 = __builtin_amdgcn_mfma_f32_32x32x16_bf16(k1, qr[d0], d0 == 0 ? negm : P1, 0, 0, 0); } } while (0)
    bf16x8 qr[4];
    { const bf16_t* qp = QR + ((((size_t)(b * 4 + h) * 128 + blk * 2 + (rg >> 1)) * 16 + m * 8 + hi) * 64 + (rg & 1) * 32 + r32) * 8;
#pragma unroll
      for (int d0 = 0; d0 < 4; ++d0) qr[d0] = *(const bf16x8*)(qp + (size_t)d0 * 1024); }
    AT_DMA(0, 0); AT_DMA(1, SLOT); if (NT > 2) AT_DMA(2, 2 * SLOT);
    f32x16 o[4];
#pragma unroll
    for (int i = 0; i < 4; ++i) o[i] = f32x16{};
    float lsum = 0.f; f32x16 negm;
    float mhat;
    { float qs = 0.f;
#pragma unroll
      for (int d0 = 0; d0 < 4; ++d0)
#pragma unroll
          for (int j = 0; j < 8; ++j) { const float qv = __uint_as_float(((unsigned)(unsigned short)qr[d0][j]) << 16); qs += qv * qv; }
      auto rr = __builtin_amdgcn_permlane32_swap(__float_as_uint(qs), __float_as_uint(qs), false, false); qs = __uint_as_float(rr[0]) + __uint_as_float(rr[1]);
      float k2 = 0.f;
#pragma unroll
      for (int gq = 0; gq < 8; ++gq) k2 += __uint_as_float(KMAX[(bh * 2 + m) * 8 + gq]);
      mhat = 1.01f * sqrtf(qs * k2);
#pragma unroll
      for (int r = 0; r < 16; ++r) negm[r] = -mhat; }
    lds_f* wsf = (lds_f*)(lds + L_WSF) + w * 32;
    f32x16 pA0, pA1, pB0 = f32x16{}, pB1 = f32x16{};
    if (NT > 2) { AT_WAIT_BAR(8); } else { AT_WAIT_BAR(4); }
    AT_QK(pA0, pA1, 0);
    int s0 = 0, s1 = SLOT, s3 = 3 * SLOT;
    const int vlane = ((lane >> 4) & 1) * 32 + (lane & 3) * 8 + (4 * hi + ((lane & 15) >> 2)) * 64;
#define AT_VLOAD(VF, i) do { _Pragma("unroll") for (int k2 = 0; k2 < 2; ++k2) { const int off_ = ((i) >> 1) * 4096 + (((i) & 1) * 2 + k2) * 1024; const s16x4 lo_ = vtr(vp_ + off_), hi_ = vtr(vp_ + off_ + 512); \
        VF[k2] = (bf16x8){lo_[0], lo_[1], lo_[2], lo_[3], hi_[0], hi_[1], hi_[2], hi_[3]}; } } while (0)
#define AT_PVMMA(VF, i) do { _Pragma("unroll") for (int k2 = 0; k2 < 2; ++k2) o[(i) >> 1] = __builtin_amdgcn_mfma_f32_32x32x16_bf16(pa[k2], VF[k2], o[(i) >> 1], 0, 0, 0); } while (0)
#define AT_SB() __builtin_amdgcn_sched_barrier(0)
#define AT_STEP(PC0, PC1, PN0, PN1, DOQK, DOSM) do { AT_SB(); \
        bf16x8 kf[4]; const lds_cptr kp_ = (lds_cptr)(lds + s1) + (m * 8 + hi) * 1024 + r32 * 16; \
        if (DOQK) { _Pragma("unroll") for (int d0 = 0; d0 < 2; ++d0) { kf[2 * d0] = *(const __attribute__((address_space(3))) bf16x8*)(kp_ + d0 * 2048); kf[2 * d0 + 1] = *(const __attribute__((address_space(3))) bf16x8*)(kp_ + d0 * 2048 + 512); } } \
        const lds_cptr vp_ = (lds_cptr)(lds + s0 + 16384) + vlane; bf16x8 vfa[2], vfb[2]; \
        if (DOSM) AT_VLOAD(vfa, 0); \
        if (DOQK) { \
            PN0 = __builtin_amdgcn_mfma_f32_32x32x16_bf16(kf[0], qr[0], negm, 0, 0, 0); PN1 = __builtin_amdgcn_mfma_f32_32x32x16_bf16(kf[1], qr[0], negm, 0, 0, 0); \
            PN0 = __builtin_amdgcn_mfma_f32_32x32x16_bf16(kf[2], qr[1], PN0, 0, 0, 0); PN1 = __builtin_amdgcn_mfma_f32_32x32x16_bf16(kf[3], qr[1], PN1, 0, 0, 0); \
            _Pragma("unroll") for (int d0 = 0; d0 < 2; ++d0) { kf[2 * d0] = *(const __attribute__((address_space(3))) bf16x8*)(kp_ + (d0 + 2) * 2048); kf[2 * d0 + 1] = *(const __attribute__((address_space(3))) bf16x8*)(kp_ + (d0 + 2) * 2048 + 512); } \
            PN0 = __builtin_amdgcn_mfma_f32_32x32x16_bf16(kf[0], qr[2], PN0, 0, 0, 0); PN1 = __builtin_amdgcn_mfma_f32_32x32x16_bf16(kf[1], qr[2], PN1, 0, 0, 0); \
            PN0 = __builtin_amdgcn_mfma_f32_32x32x16_bf16(kf[2], qr[3], PN0, 0, 0, 0); PN1 = __builtin_amdgcn_mfma_f32_32x32x16_bf16(kf[3], qr[3], PN1, 0, 0, 0); } \
        if (DOSM) { \
            float sacc = 0.f; bf16x8 pa[2]; \
            _Pragma("unroll") for (int r = 0; r < 16; ++r) { PC0[r] = __builtin_amdgcn_exp2f(PC0[r]); sacc += PC0[r]; } \
            pa[0] = __builtin_bit_cast(bf16x8, (u32x4){cvtpk(PC0[0], PC0[1]), cvtpk(PC0[2], PC0[3]), cvtpk(PC0[4], PC0[5]), cvtpk(PC0[6], PC0[7])}); \
            pa[1] = __builtin_bit_cast(bf16x8, (u32x4){cvtpk(PC0[8], PC0[9]), cvtpk(PC0[10], PC0[11]), cvtpk(PC0[12], PC0[13]), cvtpk(PC0[14], PC0[15])}); \
            AT_VLOAD(vfb, 2); AT_PVMMA(vfa, 0); AT_VLOAD(vfa, 4); AT_PVMMA(vfb, 2); AT_VLOAD(vfb, 6); AT_PVMMA(vfa, 4); AT_VLOAD(vfa, 1); AT_PVMMA(vfb, 6); \
            _Pragma("unroll") for (int r = 0; r < 16; ++r) { PC1[r] = __builtin_amdgcn_exp2f(PC1[r]); sacc += PC1[r]; } \
            lsum += sacc; asm volatile("" : "+v"(lsum)); \
            pa[0] = __builtin_bit_cast(bf16x8, (u32x4){cvtpk(PC1[0], PC1[1]), cvtpk(PC1[2], PC1[3]), cvtpk(PC1[4], PC1[5]), cvtpk(PC1[6], PC1[7])}); \
            pa[1] = __builtin_bit_cast(bf16x8, (u32x4){cvtpk(PC1[8], PC1[9]), cvtpk(PC1[10], PC1[11]), cvtpk(PC1[12], PC1[13]), cvtpk(PC1[14], PC1[15])}); \
            AT_VLOAD(vfb, 3); AT_PVMMA(vfa, 1); AT_VLOAD(vfa, 5); AT_PVMMA(vfb, 3); AT_VLOAD(vfb, 7); AT_PVMMA(vfa, 5); AT_PVMMA(vfb, 7); } \
        AT_SB(); \
        s0 = s1; s1 = (s1 == 3 * SLOT) ? 0 : s1 + SLOT; s3 = (s3 == 3 * SLOT) ? 0 : s3 + SLOT; \
    } while (0)
    for (int t = 0; t + 2 < NT; t += 2) {
        AT_WAIT_BAR(4); if (t + 3 < NT) AT_DMA(t + 3, s3);
        AT_STEP(pA0, pA1, pB0, pB1, true, true);
        AT_WAIT_BAR(4); if (t + 4 < NT) AT_DMA(t + 4, s3);
        AT_STEP(pB0, pB1, pA0, pA1, true, true);
    }
    if (rg < 2) {
#pragma unroll
        for (int r = 0; r < 16; ++r) negm[r] = -1e30f; }
    AT_WAIT_BAR(0);
    AT_STEP(pA0, pA1, pB0, pB1, true, true);
    AT_WAIT_BAR(0);
    AT_STEP(pB0, pB1, pA0, pA1, false, true);
    AT_WAIT_BAR(0);
    { auto rr = __builtin_amdgcn_permlane32_swap(__float_as_uint(lsum), __float_as_uint(lsum), false, false); lsum = __uint_as_float(rr[0]) + __uint_as_float(rr[1]); }
    if (hi == 0) wsf[r32] = (m == 0 ? 1.f : -lam) / lsum;
    asm volatile("s_waitcnt lgkmcnt(0)" ::: "memory");
#pragma unroll
    for (int r = 0; r < 16; ++r) { const float fr_ = wsf[crow(r, hi)];
#pragma unroll
        for (int d = 0; d < 4; ++d) o[d][r] *= fr_; }
    AT_WAIT_BAR(0);
    lds_f* X = (lds_f*)lds + rg * 4096;
    if (m == 1) {
#pragma unroll
        for (int d = 0; d < 4; ++d)
#pragma unroll
            for (int r = 0; r < 16; ++r) X[(d * 16 + r) * 64 + lane] = o[d][r];
    }
    AT_WAIT_BAR(0);
    if (m == 0) {
        float ssq[16];
#pragma unroll
        for (int r = 0; r < 16; ++r) { float s = 0.f;
#pragma unroll
            for (int d = 0; d < 4; ++d) { o[d][r] += X[(d * 16 + r) * 64 + lane]; s += o[d][r] * o[d][r]; }
            ssq[r] = s; }
#pragma unroll
        for (int r = 0; r < 16; ++r) { float s = ssq[r];
#pragma unroll
            for (int of = 1; of < 32; of <<= 1) s += __shfl_xor(s, of);
            ssq[r] = rsqrtf(s * (1.f / 128.f) + 1e-6f) * 0.8f; }
        float sw[4];
#pragma unroll
        for (int d = 0; d < 4; ++d) sw[d] = subln[d * 32 + r32];
        bf16_t* yp = YA + (tokb + blk * 128 + rg * 32) * 512 + h * 128 + r32;
#pragma unroll
        for (int r = 0; r < 16; ++r)
#pragma unroll
            for (int d = 0; d < 4; ++d) yp[(size_t)crow(r, hi) * 512 + d * 32] = f2bf(o[d][r] * ssq[r] * sw[d]);
    }
    AT_WAIT_BAR(0);
#undef AT_DMA
#undef AT_QK
#undef AT_STEP
#undef AT_SB
#undef AT_VLOAD
#undef AT_PVMMA
}
}
namespace hg {
using at::bf16x8; using at::s16x4; using at::f32x16; using at::u32x4; using at::lds_cptr; using at::crow; using at::vtr; using at::cvtpk;
typedef __attribute__((address_space(3))) unsigned char lds_u8;
typedef __attribute__((address_space(3))) float lds_f;
typedef __attribute__((address_space(3))) bf16_t lds_h;
__device__ __forceinline__ float sigm(float x) { return __builtin_amdgcn_rcpf(1.f + __expf(-x)); }
__device__ __forceinline__ bf16x8 mkfrag(s16x4 a, s16x4 b) { return (bf16x8){a[0], a[1], a[2], a[3], b[0], b[1], b[2], b[3]}; }
template <int ROWS>
__device__ __forceinline__ void copy_img(lds_u8* lds, int off, const bf16_t* g, size_t gp, int tid) {
#pragma unroll
    for (int i = 0; i < ROWS * 16 / 512; ++i) { const int p = tid + 512 * i, r = p >> 4, q = p & 15;
        const u32x4 v = *(const u32x4*)(g + (size_t)r * gp + q * 8);
        *(__attribute__((address_space(3))) u32x4*)(lds + off + (q >> 2) * (ROWS * 64) + r * 64 + (q & 3) * 16) = v; }
}
__device__ __forceinline__ void copy_raw(lds_u8* lds, int off, const bf16_t* g, size_t gp, int tid) {
#pragma unroll
    for (int i = 0; i < 2; ++i) { const int p = tid + 512 * i, r = p >> 4, q = p & 15;
        const u32x4 v = *(const u32x4*)(g + (size_t)r * gp + q * 8);
        *(__attribute__((address_space(3))) u32x4*)(lds + off + r * 256 + q * 16) = v; }
}
struct ARegs { u32x4 v[2], rf[2]; };
struct CRegs { u32x4 v[2], sp[4], gs[4], rf[2], rq[2]; float pd[4]; };
__device__ __forceinline__ void ld_tile64(u32x4 (&r)[2], const bf16_t* g, size_t gp, int tid) {
#pragma unroll
    for (int i = 0; i < 2; ++i) { const int p = tid + 512 * i; r[i] = *(const u32x4*)(g + (size_t)(p >> 4) * gp + (p & 15) * 8); } }
__device__ __forceinline__ void st_img64(lds_u8* lds, int off, const u32x4 (&r)[2], int tid) {
#pragma unroll
    for (int i = 0; i < 2; ++i) { const int p = tid + 512 * i, rr = p >> 4, q = p & 15; *(__attribute__((address_space(3))) u32x4*)(lds + off + (q >> 2) * 4096 + rr * 64 + (q & 3) * 16) = r[i]; } }
__device__ __forceinline__ void st_raw64(lds_u8* lds, int off, const u32x4 (&r)[2], int tid) {
#pragma unroll
    for (int i = 0; i < 2; ++i) { const int p = tid + 512 * i; *(__attribute__((address_space(3))) u32x4*)(lds + off + (p >> 4) * 256 + (p & 15) * 16) = r[i]; } }
__device__ __forceinline__ void hgA_load(ARegs& R, const bf16_t* PROJ, int bh, int n, int tid) {
    const size_t tok0 = (size_t)(bh >> 2) * 8192 + n * 64; const int h = bh & 3;
    ld_tile64(R.v, PROJ + tok0 * 5632 + 2560 + h * 128, 5632, tid); ld_tile64(R.rf, PROJ + tok0 * 5632 + 2048 + h * 128, 5632, tid); }
__device__ __forceinline__ void hgC_load(CRegs& R, const bf16_t* PROJ, const bf16_t* SP, const bf16_t* GS, const float* PD, int bh, int n, int tid) {
    const size_t tok0 = (size_t)(bh >> 2) * 8192 + n * 64; const int h = bh & 3;
    ld_tile64(R.v, PROJ + tok0 * 5632 + 2560 + h * 128, 5632, tid); ld_tile64(R.rf, PROJ + tok0 * 5632 + 2048 + h * 128, 5632, tid); ld_tile64(R.rq, PROJ + tok0 * 5632 + 1536 + h * 128, 5632, tid);
    const bf16_t* sp = SP + (size_t)(bh * 128 + n) * 16384; const bf16_t* gs = GS + (size_t)(bh * 16 + (n >> 3)) * 16384; const float* pd = PD + (size_t)(bh * 128 + n) * 128;
#pragma unroll
    for (int i = 0; i < 4; ++i) { const int p = tid + 512 * i; R.sp[i] = __builtin_nontemporal_load((const u32x4*)(sp + (size_t)(p >> 4) * 128 + (p & 15) * 8)); R.gs[i] = *(const u32x4*)(gs + (size_t)(p >> 4) * 128 + (p & 15) * 8); R.pd[i] = pd[p >> 4]; } }
__device__ __forceinline__ void gates(lds_u8* lds, int psum_off, int rawf_off, float lb, int tid, float (&f)[16], float (&G)[16], float& glast) {
    const int d = tid & 127, part = tid >> 7; lds_f* psum = (lds_f*)(lds + psum_off); const lds_h* rf = (const lds_h*)(lds + rawf_off) + part * 16 * 128 + d;
    float g = 0.f;
#pragma unroll
    for (int i = 0; i < 16; ++i) { const float raw = bf2f(rf[i * 128]); f[i] = lb + (1.f - lb) * sigm(raw); g += __logf(f[i]); G[i] = g; }
    psum[part * 128 + d] = g;
    __syncthreads();
    const float p0 = psum[d], p1 = psum[128 + d], p2 = psum[256 + d], p3 = psum[384 + d];
    const float offs = (part > 0 ? p0 : 0.f) + (part > 1 ? p1 : 0.f) + (part > 2 ? p2 : 0.f);
    glast = (p0 + p1) + (p2 + p3);
#pragma unroll
    for (int i = 0; i < 16; ++i) G[i] += offs;
}
constexpr int A_KD = 0, A_V = 16384, A_PS = 32768, A_DECL = 32768 + 2048, A_RAWF = 36864, A_OUT = 53248;
__device__ __forceinline__ void hgA_unit(lds_u8* lds, ARegs& R, const bf16_t* PROJ, const float* SCAL, bf16_t* SPL, float* PD, f32x16 (&acc)[2], float& pdec, int bh, int n, bool has_next, int tid) {
    const int h = bh & 3, lane = tid & 63, r32 = lane & 31, hi = lane >> 5, w = __builtin_amdgcn_readfirstlane(tid >> 6), d = tid & 127, part = tid >> 7;
    __syncthreads();
    st_img64(lds, A_V, R.v, tid); st_raw64(lds, A_RAWF, R.rf, tid);
    if (has_next) hgA_load(R, PROJ, bh, n + 1, tid);
    __syncthreads();
    float f[16], G[16], glast;
    gates(lds, A_PS, A_RAWF, SCAL[64 + h * 128 + d], tid, f, G, glast);
    lds_h* kd = (lds_h*)(lds + A_KD) + (d >> 5) * 2048 + (d & 31);
#pragma unroll
    for (int i = 0; i < 16; ++i) kd[(part * 16 + i) * 32] = f2bf((1.f - f[i]) * __expf(glast - G[i]));
    if (part == 0) { const float dc = __expf(glast); PD[(size_t)(bh * 128 + n) * 128 + d] = pdec; pdec *= dc; ((lds_f*)(lds + A_DECL))[d] = dc; }
    __syncthreads();
    const int dt = w >> 1, vh = w & 1;
    lds_h* ot = (lds_h*)(lds + A_OUT) + (dt * 32) * 128 + vh * 64 + r32;
#pragma unroll
    for (int t = 0; t < 2; ++t)
#pragma unroll
        for (int r = 0; r < 16; ++r) ot[crow(r, hi) * 128 + t * 32] = f2bf(acc[t][r]);
    { const lds_f* dl = (const lds_f*)(lds + A_DECL) + dt * 32;
#pragma unroll
      for (int r = 0; r < 16; ++r) { const float dr = dl[crow(r, hi)]; acc[0][r] *= dr; acc[1][r] *= dr; } }
    const int lof = ((lane >> 4) & 1) * 32 + (lane & 3) * 8 + (8 * hi + ((lane & 15) >> 2)) * 64;
    const lds_cptr ap = (lds_cptr)(lds + A_KD) + dt * 4096 + lof;
#pragma unroll
    for (int ks = 0; ks < 4; ++ks) { const bf16x8 af = mkfrag(vtr(ap + ks * 1024), vtr(ap + ks * 1024 + 256));
#pragma unroll
        for (int t = 0; t < 2; ++t) { const lds_cptr bp = (lds_cptr)(lds + A_V) + (2 * vh + t) * 4096 + lof;
            const bf16x8 bfr = mkfrag(vtr(bp + ks * 1024), vtr(bp + ks * 1024 + 256));
            acc[t] = __builtin_amdgcn_mfma_f32_32x32x16_bf16(af, bfr, acc[t], 0, 0, 0); } }
    __syncthreads();
    bf16_t* dst = SPL + (size_t)(bh * 128 + n) * 16384;
#pragma unroll
    for (int i = 0; i < 4; ++i) { const int p = tid + 512 * i; *(u32x4*)(dst + p * 8) = *(const __attribute__((address_space(3))) u32x4*)(lds + A_OUT + p * 16); }
}
__device__ __forceinline__ void hgA_group(lds_u8* lds, const bf16_t* PROJ, const float* SCAL, bf16_t* SPL, float* PD, float* TG, float* DG, int bh, int g, int tid) {
    const int lane = tid & 63, r32 = lane & 31, hi = lane >> 5, w = __builtin_amdgcn_readfirstlane(tid >> 6), d = tid & 127, part = tid >> 7, dt = w >> 1, vh = w & 1;
    ARegs R; hgA_load(R, PROJ, bh, 8 * g, tid);
    f32x16 acc[2] = {f32x16{}, f32x16{}}; float pdec = 1.f;
#pragma unroll 1
    for (int k = 0; k < 8; ++k) hgA_unit(lds, R, PROJ, SCAL, SPL, PD, acc, pdec, bh, 8 * g + k, k < 7, tid);
    float* tg = TG + (size_t)(bh * 16 + g) * 16384 + (size_t)(dt * 32) * 128 + vh * 64 + r32;
#pragma unroll
    for (int t = 0; t < 2; ++t)
#pragma unroll
        for (int r = 0; r < 16; ++r) tg[crow(r, hi) * 128 + t * 32] = acc[t][r];
    if (part == 0) DG[(bh * 16 + g) * 128 + d] = pdec;
}
constexpr int C_QT = 0, C_KT = 16384, C_V = 32768, C_SP = 49152, C_PS = 81920, C_RAWF = 86016, C_RAWQ = 102400, C_OT = 86016;
__device__ __forceinline__ void hgC_unit(lds_u8* lds, CRegs& R, const bf16_t* PROJ, const float* SCAL, const bf16_t* SP, const bf16_t* GS, const float* PD, const float* hgnorm, bf16_t* YB, int bh, int n, int nbh, int nn, int tid) {
    const int h = bh & 3, b = bh >> 2, lane = tid & 63, r32 = lane & 31, hi = lane >> 5, w = __builtin_amdgcn_readfirstlane(tid >> 6), d = tid & 127, part = tid >> 7;
    const size_t tok0 = (size_t)b * 8192 + n * 64;
    __syncthreads();
    st_img64(lds, C_V, R.v, tid); st_raw64(lds, C_RAWF, R.rf, tid); st_raw64(lds, C_RAWQ, R.rq, tid);
#pragma unroll
    for (int i = 0; i < 4; ++i) { const int p = tid + 512 * i, rr = p >> 4, q = p & 15; const float pd = R.pd[i];
        const unsigned sw[4] = {R.sp[i].x, R.sp[i].y, R.sp[i].z, R.sp[i].w}, gw[4] = {R.gs[i].x, R.gs[i].y, R.gs[i].z, R.gs[i].w}; unsigned ow[4];
#pragma unroll
        for (int j = 0; j < 4; ++j) ow[j] = cvtpk(pd * __uint_as_float(gw[j] << 16) + __uint_as_float(sw[j] << 16), pd * __uint_as_float(gw[j] & 0xffff0000u) + __uint_as_float(sw[j] & 0xffff0000u));
        *(__attribute__((address_space(3))) u32x4*)(lds + C_SP + (q >> 2) * 8192 + rr * 64 + (q & 3) * 16) = (u32x4){ow[0], ow[1], ow[2], ow[3]}; }
    if (nbh >= 0) hgC_load(R, PROJ, SP, GS, PD, nbh, nn, tid);
    __syncthreads();
    { float f[16], G[16], glast;
      gates(lds, C_PS, C_RAWF, SCAL[64 + h * 128 + d], tid, f, G, glast);
      const lds_h* rq = (const lds_h*)(lds + C_RAWQ) + part * 16 * 128 + d;
      lds_h* qt = (lds_h*)(lds + C_QT) + (d >> 3) * 512 + (d & 7) + part * 16 * 8; lds_h* kt = (lds_h*)(lds + C_KT) + (d >> 3) * 512 + (d & 7) + part * 16 * 8;
#pragma unroll
      for (int i = 0; i < 16; ++i) { const float q = bf2f(rq[i * 128]); const float eg = __expf(G[i]);
          qt[i * 8] = f2bf(q * sigm(q) * eg); kt[i * 8] = f2bf((1.f - f[i]) * __builtin_amdgcn_rcpf(eg)); } }
    __syncthreads();
    const int ct = w & 1, vb = w >> 1;
    bf16x8 qf[8];
    { const lds_cptr qp = (lds_cptr)(lds + C_QT) + hi * 1024 + (32 * ct + r32) * 16;
#pragma unroll
      for (int ks = 0; ks < 8; ++ks) qf[ks] = *(const __attribute__((address_space(3))) bf16x8*)(qp + ks * 2048); }
    f32x16 o = f32x16{};
#pragma unroll
    for (int sh = 0; sh < 2; ++sh) { if (sh <= ct) {
        const lds_cptr kp = (lds_cptr)(lds + C_KT) + hi * 1024 + (32 * sh + r32) * 16;
        f32x16 p = f32x16{};
#pragma unroll
        for (int ks = 0; ks < 8; ++ks) { const bf16x8 kf = *(const __attribute__((address_space(3))) bf16x8*)(kp + ks * 2048); p = __builtin_amdgcn_mfma_f32_32x32x16_bf16(kf, qf[ks], p, 0, 0, 0); }
        const int cc = 32 * ct + r32;
#pragma unroll
        for (int r = 0; r < 16; ++r) { const int s = 32 * sh + crow(r, hi); if (s > cc) p[r] = 0.f; }
        const bf16x8 pa0 = __builtin_bit_cast(bf16x8, (u32x4){cvtpk(p[0], p[1]), cvtpk(p[2], p[3]), cvtpk(p[4], p[5]), cvtpk(p[6], p[7])});
        const bf16x8 pa1 = __builtin_bit_cast(bf16x8, (u32x4){cvtpk(p[8], p[9]), cvtpk(p[10], p[11]), cvtpk(p[12], p[13]), cvtpk(p[14], p[15])});
        const lds_cptr vp = (lds_cptr)(lds + C_V) + vb * 4096 + ((lane >> 4) & 1) * 32 + (lane & 3) * 8 + (4 * hi + ((lane & 15) >> 2)) * 64 + sh * 2048;
        o = __builtin_amdgcn_mfma_f32_32x32x16_bf16(pa0, mkfrag(vtr(vp), vtr(vp + 512)), o, 0, 0, 0);
        o = __builtin_amdgcn_mfma_f32_32x32x16_bf16(pa1, mkfrag(vtr(vp + 1024), vtr(vp + 1024 + 512)), o, 0, 0, 0); } }
    { const lds_cptr sp = (lds_cptr)(lds + C_SP) + vb * 8192 + ((lane >> 4) & 1) * 32 + (lane & 3) * 8 + (8 * hi + ((lane & 15) >> 2)) * 64;
#pragma unroll
      for (int ks = 0; ks < 8; ++ks) o = __builtin_amdgcn_mfma_f32_32x32x16_bf16(qf[ks], mkfrag(vtr(sp + ks * 1024), vtr(sp + ks * 1024 + 256)), o, 0, 0, 0); }
    { lds_f* ot = (lds_f*)(lds + C_OT) + (32 * ct) * 128 + 32 * vb + r32;
#pragma unroll
      for (int r = 0; r < 16; ++r) ot[crow(r, hi) * 128] = o[r]; }
    __syncthreads();
    { const int c = tid >> 3, sg = tid & 7; const __attribute__((address_space(3))) at::u32x4* orow = (const __attribute__((address_space(3))) at::u32x4*)(lds + C_OT + c * 512 + sg * 64);
      float ov[16]; float ss = 0.f;
#pragma unroll
      for (int q = 0; q < 4; ++q) { const at::u32x4 t4 = orow[q]; ov[4 * q] = __uint_as_float(t4.x); ov[4 * q + 1] = __uint_as_float(t4.y); ov[4 * q + 2] = __uint_as_float(t4.z); ov[4 * q + 3] = __uint_as_float(t4.w); }
#pragma unroll
      for (int q = 0; q < 16; ++q) ss += ov[q] * ov[q];
      ss += __shfl_xor(ss, 1); ss += __shfl_xor(ss, 2); ss += __shfl_xor(ss, 4);
      const float rstd = rsqrtf(ss * (1.f / 128.f) + 1e-6f);
      const bf16_t* gp = PROJ + (tok0 + c) * 5632 + 3072 + h * 128 + sg * 16; const u32x4 g0 = *(const u32x4*)gp, g1 = *(const u32x4*)(gp + 8);
      const unsigned gw[8] = {g0.x, g0.y, g0.z, g0.w, g1.x, g1.y, g1.z, g1.w}; unsigned ow[8];
#pragma unroll
      for (int q = 0; q < 8; ++q) { const float ga = __uint_as_float(gw[q] << 16), gb = __uint_as_float(gw[q] & 0xffff0000u);
          const float ra = ov[2 * q] * rstd * hgnorm[sg * 16 + 2 * q] * (ga * sigm(ga)), rb = ov[2 * q + 1] * rstd * hgnorm[sg * 16 + 2 * q + 1] * (gb * sigm(gb));
          ow[q] = cvtpk(ra, rb); }
      bf16_t* dst = YB + (tok0 + c) * 512 + h * 128 + sg * 16; *(u32x4*)dst = (u32x4){ow[0], ow[1], ow[2], ow[3]}; *(u32x4*)(dst + 8) = (u32x4){ow[4], ow[5], ow[6], ow[7]}; }
}
}
namespace mk {
using pg8::f32x4; using pg8::u32x4; using pg8::u32x2; using pg8::Unit;
constexpr int NWAVES = 8, NTHR = 512;
constexpr int RING_BYTES = 131072, LDSCTL_OFF = RING_BYTES, LDS_BYTES = 147456;
constexpr int LW_BAR = 0, LW_TPRE = 16  , LW_CNT = 64  , LW_MISC = 128;
enum Phase { PH_PRO = 0, PH_H1, PH_G1, PH_ROPE_HGA, PH_ATT_SCAN, PH_HGC, PH_G2A, PH_G2B, PH_G3, PH_TOK, PH_G4, PH_G5, PH_FIN, PH_N };

struct Args {
    const float* in[25]; float* out; unsigned char* ws; int ph_lo, ph_hi, li, pad;
};

__device__ __forceinline__ float wave_sum(float v) {
#pragma unroll
    for (int o = 1; o < 64; o <<= 1) v += __shfl_xor(v, o);
    return v;
}
__device__ __forceinline__ float sigm(float x) { return __builtin_amdgcn_rcpf(1.f + __expf(-x)); }
__device__ __forceinline__ unsigned pk2(float lo, float hi) { return at::cvtpk(lo, hi); }

__device__ __forceinline__ unsigned pk4_fp8(float a, float b, float c, float d) { unsigned w = __builtin_amdgcn_cvt_pk_fp8_f32(a, b, 0u, false); return __builtin_amdgcn_cvt_pk_fp8_f32(c, d, w, true); }
constexpr float S8_W = 64.f, S8_H = 4.f, S8_A = 4.f, S8_Y = 4.f;
struct EpiBf16 {
    static constexpr bool PERM = true;
    bf16_t* O; int ldc;
    __device__ __forceinline__ bool operator()(f32x4 (&acc)[2][2][4][2], const Unit& u, int wr, int wc, int fr, int fq) const {
        const int row0 = u.pm * 256 + wr * 64 + fr, col0 = u.pn * 256 + wc * 32 + 8 * fq;
#pragma unroll
        for (int ai = 0; ai < 2; ++ai)
#pragma unroll
            for (int m = 0; m < 4; ++m) { bf16_t* rowp = O + (size_t)(row0 + ai * 128 + m * 16) * ldc + col0;
#pragma unroll
                for (int bj = 0; bj < 2; ++bj) { const f32x4 v0 = acc[ai][bj][m][0], v1 = acc[ai][bj][m][1]; u32x4 w; w.x = pk2(v0[0], v0[1]); w.y = pk2(v0[2], v0[3]); w.z = pk2(v1[0], v1[1]); w.w = pk2(v1[2], v1[3]);
                    *(u32x4*)(rowp + bj * 128) = w; } }
        return false;
    }
};
struct EpiProj {
    static constexpr bool PERM = true;
    bf16_t* O; const float* ropec; const float* ropes; bf16_t* qimg; bf16_t* kimg; bf16_t* vimg; unsigned* kmaxp;
    __device__ __forceinline__ bool operator()(f32x4 (&acc)[2][2][4][2], const Unit& u, int wr, int wc, int fr, int fq) const {
        const int row0 = u.pm * 256 + wr * 64 + fr;
        if (u.pn >= 6) { const int col0 = u.pn * 256 + wc * 32 + 8 * fq;
#pragma unroll
            for (int ai = 0; ai < 2; ++ai)
#pragma unroll
                for (int m = 0; m < 4; ++m) { bf16_t* rowp = O + (size_t)(row0 + ai * 128 + m * 16) * 5632 + col0;
#pragma unroll
                    for (int bj = 0; bj < 2; ++bj) { const f32x4 v0 = acc[ai][bj][m][0], v1 = acc[ai][bj][m][1]; *(u32x4*)(rowp + bj * 128) = (u32x4){pk2(v0[0], v0[1]), pk2(v0[2], v0[3]), pk2(v1[0], v1[1]), pk2(v1[2], v1[3])}; } }
            return false; }
        const int b = u.pm >> 5, hb = 2 * (u.pn & 1);
        if (u.pn >= 4) {
#pragma unroll
            for (int ai = 0; ai < 2; ++ai)
#pragma unroll
                for (int m = 0; m < 4; ++m) { const int s = (row0 + ai * 128 + m * 16) & 8191, tile = s >> 6, key = s & 63;
#pragma unroll
                    for (int bj = 0; bj < 2; ++bj) { const f32x4 v0 = acc[ai][bj][m][0], v1 = acc[ai][bj][m][1];
                        *(u32x4*)(vimg + ((((size_t)(b * 4 + hb + bj) * 128 + tile) * 4 + wc) * 64 + key) * 32 + 8 * fq) = (u32x4){pk2(v0[0], v0[1]), pk2(v0[2], v0[3]), pk2(v1[0], v1[1]), pk2(v1[2], v1[3])}; } }
            return false; }
        const bool isk = u.pn >= 2; const int mm = wc >> 1, w = wc & 1, d0 = 16 * w + 4 * fq; const float sc = isk ? 1.f : at::C2;
        bf16_t* img = isk ? kimg : qimg; float nmax[2] = {0.f, 0.f};
#pragma unroll
        for (int ai = 0; ai < 2; ++ai)
#pragma unroll
            for (int m = 0; m < 4; ++m) { const int s = (row0 + ai * 128 + m * 16) & 8191, tile = s >> 6, key = s & 63;
                const f32x4 cs = *(const f32x4*)(ropec + s * 32 + d0), sn = *(const f32x4*)(ropes + s * 32 + d0);
#pragma unroll
                for (int bj = 0; bj < 2; ++bj) { const f32x4 x1 = acc[ai][bj][m][0], x2 = acc[ai][bj][m][1]; const f32x4 o1 = (x1 * cs - x2 * sn) * sc, o2 = (x2 * cs + x1 * sn) * sc;
                    bf16_t* dst = img + ((((size_t)(b * 4 + hb + bj) * 128 + tile) * 16 + mm * 8 + (d0 >> 3)) * 64 + key) * 8 + (d0 & 7);
                    *(u32x2*)dst = (u32x2){pk2(o1[0], o1[1]), pk2(o1[2], o1[3])}; *(u32x2*)(dst + 4 * 512) = (u32x2){pk2(o2[0], o2[1]), pk2(o2[2], o2[3])};
                    if (isk) { const float ss = (o1[0] * o1[0] + o1[1] * o1[1]) + (o1[2] * o1[2] + o1[3] * o1[3]) + (o2[0] * o2[0] + o2[1] * o2[1]) + (o2[2] * o2[2] + o2[3] * o2[3]); nmax[bj] = fmaxf(nmax[bj], ss); } } }
        if (isk) {
#pragma unroll
            for (int bj = 0; bj < 2; ++bj) { float mx = nmax[bj];
#pragma unroll
                for (int of = 1; of < 16; of <<= 1) mx = fmaxf(mx, __shfl_xor(mx, of));
                if (fr == 0) atomicMax(kmaxp + (((b * 4 + hb + bj) * 2 + mm) * 8 + w * 4 + fq), __float_as_uint(mx)); } }
        return false;
    }
};
struct EpiF32 {
    static constexpr bool PERM = false;
    float* O; int ldc;
    __device__ __forceinline__ bool operator()(f32x4 (&acc)[2][2][4][2], const Unit& u, int wr, int wc, int fr, int fq) const {
        const int row0 = u.pm * 256 + wr * 64 + fr, col0 = u.pn * 256 + wc * 32 + 4 * fq;
#pragma unroll
        for (int ai = 0; ai < 2; ++ai)
#pragma unroll
            for (int m = 0; m < 4; ++m) { float* rowp = O + (size_t)(row0 + ai * 128 + m * 16) * ldc + col0;
#pragma unroll
                for (int bj = 0; bj < 2; ++bj)
#pragma unroll
                    for (int n = 0; n < 2; ++n) *(f32x4*)(rowp + bj * 128 + n * 16) = acc[ai][bj][m][n]; }
        return false;
    }
};
struct EpiBranch2 {
    static constexpr bool PERM = true;
    const bf16_t* proj; bf16_t* merged;
    __device__ __forceinline__ bool operator()(f32x4 (&acc)[2][2][4][2], const Unit& u, int wr, int wc, int fr, int fq) const {
        const int row0 = u.pm * 256 + wr * 64 + fr, col0 = u.pn * 256 + wc * 32 + 8 * fq; const bool first = (u.z == 0);
#pragma unroll
        for (int ai = 0; ai < 2; ++ai)
#pragma unroll
            for (int m = 0; m < 4; ++m) { const size_t row = (size_t)(row0 + ai * 128 + m * 16);
#pragma unroll
                for (int bj = 0; bj < 2; ++bj) { const int col = col0 + bj * 128;
                    const u32x4 gb = __builtin_nontemporal_load((const u32x4*)(proj + row * 5632 + 4608 + col)); const unsigned gbw[4] = {gb.x, gb.y, gb.z, gb.w}; float eb[8];
#pragma unroll
                    for (int q = 0; q < 4; ++q) { eb[2 * q] = __expf(-__uint_as_float(gbw[q] << 16)); eb[2 * q + 1] = __expf(-__uint_as_float(gbw[q] & 0xffff0000u)); }
                    if (first) { const u32x4 ga = __builtin_nontemporal_load((const u32x4*)(proj + row * 5632 + 3584 + col)); const unsigned gaw[4] = {ga.x, ga.y, ga.z, ga.w};
#pragma unroll
                        for (int q = 0; q < 4; ++q) { const float ea0 = __expf(-__uint_as_float(gaw[q] << 16)), ea1 = __expf(-__uint_as_float(gaw[q] & 0xffff0000u));
                            acc[ai][bj][m][q >> 1][(2 * q) & 3] *= (1.f + eb[2 * q]) * __builtin_amdgcn_rcpf(1.f + ea0); acc[ai][bj][m][q >> 1][(2 * q + 1) & 3] *= (1.f + eb[2 * q + 1]) * __builtin_amdgcn_rcpf(1.f + ea1); } }
                    else { unsigned w[4];
#pragma unroll
                        for (int q = 0; q < 4; ++q) w[q] = pk2(acc[ai][bj][m][q >> 1][(2 * q) & 3] * __builtin_amdgcn_rcpf(1.f + eb[2 * q]), acc[ai][bj][m][q >> 1][(2 * q + 1) & 3] * __builtin_amdgcn_rcpf(1.f + eb[2 * q + 1]));
                        *(u32x4*)(merged + row * 1024 + col) = (u32x4){w[0], w[1], w[2], w[3]}; } } }
        return first;
    }
};
struct EpiGateUp {
    static constexpr bool PERM = true;
    const float* bgu; unsigned char* act;
    __device__ __forceinline__ bool operator()(f32x4 (&acc)[2][2][4][2], const Unit& u, int wr, int wc, int fr, int fq) const {
        const int e = u.z, colA = u.pn * 128 + wc * 32 + 8 * fq;
        constexpr float DQ = 1.f / (S8_W * S8_H);
        f32x4 bg[2], bu[2];
#pragma unroll
        for (int n = 0; n < 2; ++n) { bg[n] = *(const f32x4*)(bgu + e * 2048 + colA + 4 * n); bu[n] = *(const f32x4*)(bgu + e * 2048 + 1024 + colA + 4 * n); }
#pragma unroll
        for (int ai = 0; ai < 2; ++ai)
#pragma unroll
            for (int m = 0; m < 4; ++m) { const size_t slot = (size_t)(u.arow + ai * 128 + wr * 64 + m * 16 + fr); unsigned w[2];
#pragma unroll
                for (int n = 0; n < 2; ++n) { float r[4];
#pragma unroll
                    for (int j = 0; j < 4; ++j) { float gg = acc[ai][0][m][n][j] * DQ + bg[n][j], uu = acc[ai][1][m][n][j] * DQ + bu[n][j]; gg = fminf(gg, 7.f); uu = fminf(fmaxf(uu, -7.f), 7.f); r[j] = (uu + 1.f) * gg * sigm(1.702f * gg) * S8_A; }
                    w[n] = pk4_fp8(r[0], r[1], r[2], r[3]); }
                *(u32x2*)(act + slot * 1024 + colA) = (u32x2){w[0], w[1]}; }
        return false;
    }
};
struct EpiDown {
    static constexpr bool PERM = true;
    const float* bd; const int* list; unsigned char* ym; const LAS int* cnt;
    __device__ __forceinline__ bool operator()(f32x4 (&acc)[2][2][4][2], const Unit& u, int wr, int wc, int fr, int fq) const {
        const int e = u.z, nvalid = cnt[e] - u.pm * 256, col0 = u.pn * 256 + wc * 32 + 8 * fq;
        constexpr float DQ = S8_Y / (S8_W * S8_A);
        f32x4 bv[2][2];
#pragma unroll
        for (int bj = 0; bj < 2; ++bj)
#pragma unroll
            for (int n = 0; n < 2; ++n) bv[bj][n] = *(const f32x4*)(bd + e * 1024 + col0 + bj * 128 + 4 * n) * S8_Y;
#pragma unroll
        for (int ai = 0; ai < 2; ++ai)
#pragma unroll
            for (int m = 0; m < 4; ++m) { const int r = ai * 128 + wr * 64 + m * 16 + fr;
                if (r < nvalid) { const int a = list[(size_t)e * 32768 + u.pm * 256 + r]; unsigned char* rowp = ym + (size_t)a * 1024 + col0;
#pragma unroll
                    for (int bj = 0; bj < 2; ++bj) { const f32x4 v0 = acc[ai][bj][m][0] * DQ + bv[bj][0], v1 = acc[ai][bj][m][1] * DQ + bv[bj][1];
                        *(u32x2*)(rowp + bj * 128) = (u32x2){pk4_fp8(v0[0], v0[1], v0[2], v0[3]), pk4_fp8(v1[0], v1[1], v1[2], v1[3])}; } } }
        return false;
    }
};
struct MoeOrder {
    const LAS int* tpre; const LAS int* cnt; const int* list; int nN, G, c, rowpitch  , brows  ; LAS int* idxbuf  ;
    __device__ bool next(int i, Unit& u) const {
        const int nwg = tpre[32] * nN; const long L = (long)i * G + c; if (L >= nwg) return false;
        int wgid = (int)L; { const int q = nwg / 8, r = nwg % 8, xcd = wgid % 8, off = wgid / 8; wgid = (xcd < r ? xcd * (q + 1) : r * (q + 1) + (xcd - r) * q) + off; }
        int e = 0;
#pragma unroll 1
        for (int s = 16; s > 0; s >>= 1) { if (tpre[e + s] * nN <= wgid) e += s; }
        const int w = wgid - tpre[e] * nN, nM = tpre[e + 1] - tpre[e];
        const int nig = 8 * nN, gid = w / nig, fm = gid * 8, gsz = (nM - fm) < 8 ? (nM - fm) : 8;
        u.pm = fm + ((w % nig) % gsz); u.pn = (w % nig) / gsz; u.z = e; u.arow = (tpre[e] + u.pm) * 256; u.brow = e * brows + u.pn * 256; return true;
    }
    __device__ __forceinline__ unsigned row_off(const Unit& u, int r) const {
        const int lr = u.pm * 256 + r; const int a = list[(size_t)u.z * 32768 + (lr < cnt[u.z] ? lr : 0)]; return (unsigned)(a >> 2) * (unsigned)rowpitch;
    }
    __device__ __forceinline__ const int* idx_src(const Unit& u) const { return list + (size_t)u.z * 32768 + u.pm * 256; }
    __device__ __forceinline__ unsigned off_from_idx(int a) const { unsigned tk = (unsigned)a >> 2; tk = tk < (unsigned)T ? tk : (unsigned)(T - 1); return tk * (unsigned)rowpitch; }
};

__device__ __forceinline__ int rope_pos(int d) { const int e = d & 31; return 32 * (e >> 4) + 8 * ((e >> 2) & 3) + 4 * (d >> 5) + (e & 3); }
template <bool RPERM = false>
__device__ __forceinline__ void transpose_item(const float* W, int K, int N, bf16_t* WT, int k0, int n0, int dst_row0, LAS unsigned* scr, int lane) {
    const int cg = lane & 15, rp = lane >> 4;
    const float* src = W + (size_t)(k0 + 2 * rp) * N + n0 + 4 * cg;
#pragma unroll
    for (int q = 0; q < 8; ++q) { const f32x4 a = __builtin_nontemporal_load((const f32x4*)(src + (size_t)(8 * q) * N)), b = __builtin_nontemporal_load((const f32x4*)(src + (size_t)(8 * q + 1) * N));
#pragma unroll
        for (int c = 0; c < 4; ++c) scr[(4 * cg + c) * 33 + 4 * q + rp] = pk2(a[c], b[c]); }
    asm volatile("s_waitcnt lgkmcnt(0)" ::: "memory");
    const int nl = lane >> 3, wq = lane & 7;
#pragma unroll
    for (int i = 0; i < 8; ++i) { const LAS unsigned* s = scr + (8 * i + nl) * 33 + 4 * wq; u32x4 o; o.x = s[0]; o.y = s[1]; o.z = s[2]; o.w = s[3];
        *(u32x4*)(WT + (size_t)(dst_row0 + (RPERM ? rope_pos(8 * i + nl) : 8 * i + nl)) * K + k0 + 8 * wq) = o; }
    asm volatile("s_waitcnt lgkmcnt(0)" ::: "memory");
}
__device__ __forceinline__ void transpose_item8(const float* W, int K, int N, unsigned char* WT, int k0, int n0, int dst_row0, LAS unsigned* scr, int lane) {
    const int cg = lane & 15, rp = lane >> 4;
    const float* src = W + (size_t)(k0 + 4 * rp) * N + n0 + 4 * cg;
#pragma unroll
    for (int q = 0; q < 4; ++q) { f32x4 a[4];
#pragma unroll
        for (int r = 0; r < 4; ++r) a[r] = __builtin_nontemporal_load((const f32x4*)(src + (size_t)(16 * q + r) * N));
#pragma unroll
        for (int c = 0; c < 4; ++c) scr[(4 * cg + c) * 17 + 4 * q + rp] = pk4_fp8(a[0][c] * S8_W, a[1][c] * S8_W, a[2][c] * S8_W, a[3][c] * S8_W); }
    asm volatile("s_waitcnt lgkmcnt(0)" ::: "memory");
    const int nl = lane >> 2, wq = lane & 3;
#pragma unroll
    for (int i = 0; i < 4; ++i) { const LAS unsigned* s = scr + (16 * i + nl) * 17 + 4 * wq; u32x4 o; o.x = s[0]; o.y = s[1]; o.z = s[2]; o.w = s[3];
        *(u32x4*)(WT + (size_t)(dst_row0 + 16 * i + nl) * K + k0 + 16 * wq) = o; }
    asm volatile("s_waitcnt lgkmcnt(0)" ::: "memory");
}
template <bool GU>
__device__ __forceinline__ void transpose_matrix8(const float* W, int K, int N, unsigned char* WT, LAS unsigned* scr, int lane, int gw, int NGW, int& itbase) {
    const int nblk = N / 64, nitems = (K / 64) * nblk;
    int first = (gw - itbase) % NGW; if (first < 0) first += NGW;
    for (int it = first; it < nitems; it += NGW) { const int kb = it / nblk, nb = it % nblk, n0 = nb * 64;
        int dst = n0; if (GU) { const int nn = n0 & 1023; dst = (nn >> 7) * 256 + (n0 >> 10) * 128 + (nn & 127); }
        transpose_item8(W, K, N, WT, kb * 64, n0, dst, scr, lane); }
    itbase += nitems;
}
template <bool GU, bool QK = false>
__device__ __forceinline__ void transpose_matrix(const float* W, int K, int N, bf16_t* WT, LAS unsigned* scr, int lane, int gw, int NGW, int& itbase) {
    const int nblk = N / 64, nitems = (K / 64) * nblk;
    int first = (gw - itbase) % NGW; if (first < 0) first += NGW;
    for (int it = first; it < nitems; it += NGW) { const int kb = it / nblk, nb = it % nblk, n0 = nb * 64;
        int dst = n0; if (GU) { const int nn = n0 & 1023; dst = (nn >> 7) * 256 + (n0 >> 10) * 128 + (nn & 127); }
        if (QK && n0 < 1024) transpose_item<true>(W, K, N, WT, kb * 64, n0, dst, scr, lane); else transpose_item<false>(W, K, N, WT, kb * 64, n0, dst, scr, lane); }
    itbase += nitems;
}

#define MOD ((float*)(ws + WS_SMALL))
#define SCAL ((float*)(ws + WS_SMALL + 128 * 1024))
#define ROPEC ((float*)(ws + WS_ROPEC))
#define ROPES ((float*)(ws + WS_ROPES))
#define TOPI ((int*)(ws + WS_TOPI))
#define TOPW ((float*)(ws + WS_TOPW))
#define LIST ((int*)(ws + WS_LIST))
#define RWT ((bf16_t*)(ws + WS_RWT))
#define CNT ((int*)(ws + WS_CTL) + CW_CNT)
#define H ((bf16_t*)(ws + WS_H))
#define QR ((bf16_t*)(ws + WS_Y + 64 * MiB))
#define KIMG ((bf16_t*)(ws + WS_Y + 96 * MiB))
#define VIMG ((bf16_t*)(ws + WS_YB))
#define PROJ ((bf16_t*)(ws + WS_PROJ))
#define YA ((bf16_t*)(ws + WS_YA))
#define YB ((bf16_t*)(ws + WS_YB))
#define DS ((bf16_t*)(ws + WS_DS))
#define DEC ((float*)(ws + WS_DEC))
#define TG ((float*)(ws + WS_DS))
#define GS ((bf16_t*)(ws + WS_DS + 16 * 1048576))
#define DG ((float*)(ws + WS_DEC + 2 * 1048576))
#define MERGED ((bf16_t*)(ws + WS_MERGED))
#define SP ((bf16_t*)(ws + WS_MERGED))
#define Y ((float*)(ws + WS_Y))
#define YH ((bf16_t*)(ws + WS_Y))
#define ACT ((bf16_t*)(ws + WS_ACT))
#define YM ((bf16_t*)(ws + WS_YM))
#define WT_IN ((bf16_t*)(ws + WS_WIN))
#define WT_A ((bf16_t*)(ws + WS_WA))
#define WT_B ((bf16_t*)(ws + WS_WB))
#define WT_O ((bf16_t*)(ws + WS_WO))
#define WT_GU ((bf16_t*)(ws + WS_WGU))
#define WT_GU8 ((unsigned char*)(ws + WS_WGU))
#define WT_D8 ((unsigned char*)(ws + WS_WD))
#define H8 ((unsigned char*)(ws + WS_H))
#define ACT8 ((unsigned char*)(ws + WS_ACT))
#define YM8 ((unsigned char*)(ws + WS_YM))
#define WT_D ((bf16_t*)(ws + WS_WD))
#define PHASE_BEGIN unsigned char* ws = args.ws; asm volatile("" : "+s"(ws)); int tid = threadIdx.x; asm volatile("" : "+v"(tid)); const int lane = tid & 63; (void)lane; const float* x = args.in[0]; float* out = args.out; (void)x; (void)out;
__global__ void __launch_bounds__(NTHR, 2) mega(Args args) {
    extern __shared__ __attribute__((aligned(16))) unsigned char lds_[];
    LAS unsigned char* lds = (LAS unsigned char*)lds_;
    volatile LAS unsigned* LW = (volatile LAS unsigned*)(lds + LDSCTL_OFF);
    const int tid = threadIdx.x, lane = tid & 63, wave = __builtin_amdgcn_readfirstlane(tid >> 6);
    const int G = gridDim.x; const int bx = blockIdx.x; const int vcu = (G % 8 == 0) ? (bx % 8) * (G / 8) + bx / 8 : bx;
    const int gw = vcu * NWAVES + wave, NGW = G * NWAVES;
    unsigned* CTL = (unsigned*)(args.ws + WS_CTL);
    for (int u = tid; u < (LDS_BYTES - LDSCTL_OFF) / 4; u += NTHR) ((LAS unsigned*)(lds + LDSCTL_OFF))[u] = 0u;
    __syncthreads();
    const int lo = args.ph_lo, hi = args.ph_hi;
    XcdBarrier bar; bar.bar = CTL + CW_BAR + args.li * 4096; bar.x = 0; bar.st = nullptr;
    if (hi - lo > 1) bar = xcd_barrier_post(CTL + CW_BAR + args.li * 4096, LW + LW_BAR);
#ifndef PHMASK
#define PHMASK 0xffff
#endif
#ifndef DUP_PHASE
#define DUP_PHASE -1
#endif
#define IN(k) ((((PHMASK) >> (k)) & 1) && lo <= (k) && (k) < hi)
#define REPS(k) (((k) == DUP_PHASE) ? 2 : 1)
#ifdef PROBE_SPAN
#define STAMP(k) do { if (bx == 0 && threadIdx.x == 0) { const unsigned long long t_ = __builtin_amdgcn_s_memrealtime(); LW[160 + 2 * (k)] = (unsigned)t_; LW[161 + 2 * (k)] = (unsigned)(t_ >> 32); } } while (0)
#else
#define STAMP(k) do { } while (0)
#endif
#define SEAM(k) do { if (IN(k) && IN((k) + 1)) xcd_barrier(bar); STAMP((k) + 1); } while (0)

    STAMP(0);
    if (IN(PH_PRO)) for (int rep_ = 0; rep_ < REPS(PH_PRO); ++rep_) {
        PHASE_BEGIN
        __syncthreads();
        const float* c = args.in[1]; const float* w_mod = args.in[2]; const float* b_mod = args.in[3];
        LAS float* cact = (LAS float*)lds; LAS float* red = cact + 4096;
        for (int i = tid; i < 4096; i += NTHR) { const float cv = c[i]; cact[i] = cv / (1.f + expf(-cv)); }
        __syncthreads();
        for (int it = vcu; it < 192; it += G) { const int j0 = it * 32, kq = tid >> 5, col = tid & 31; float acc[4] = {0.f, 0.f, 0.f, 0.f};
            const float* wp = w_mod + (size_t)(kq * 64) * 6144 + j0 + col;
#pragma unroll 1
            for (int k = 0; k < 64; k += 16) { float wv[16];
#pragma unroll
                for (int i = 0; i < 16; ++i) wv[i] = wp[(size_t)(k + i) * 6144];
#pragma unroll
                for (int i = 0; i < 16; ++i) {
#pragma unroll
                    for (int b = 0; b < 4; ++b) acc[b] += cact[b * 1024 + kq * 64 + k + i] * wv[i]; } }
#pragma unroll
            for (int b = 0; b < 4; ++b) red[(kq * 4 + b) * 32 + col] = acc[b];
            __syncthreads();
            if (tid < 128) { const int b = tid >> 5, cc = tid & 31; float s = 0.f;
#pragma unroll
                for (int q = 0; q < 16; ++q) s += red[(q * 4 + b) * 32 + cc];
                MOD[b * 6144 + j0 + cc] = s + b_mod[j0 + cc]; }
            __syncthreads(); }
        const int gt = vcu * NTHR + tid, NGT = G * NTHR;
        if (gt == 0) { const float* q1 = args.in[7]; const float* k1 = args.in[8]; const float* q2 = args.in[9]; const float* k2 = args.in[10]; float s1 = 0.f, s2 = 0.f;
            for (int i = 0; i < 64; ++i) { s1 += q1[i] * k1[i]; s2 += q2[i] * k2[i]; } SCAL[0] = expf(s1) - expf(s2) + 0.2f; }
        if (gt < 512) { const float* lbl = args.in[12]; SCAL[64 + gt] = 1.f / (1.f + expf(lbl[512 + gt] - lbl[gt])); }
        for (int i = gt; i < 8192 * 32; i += NGT) { const int s = i >> 5, j = i & 31; const float inv = powf(10000.f, -(float)(2 * j) / 64.f); const float ang = (float)s * inv; ROPEC[i] = cosf(ang); ROPES[i] = sinf(ang); }
        for (int i = gt; i < 32768; i += NGT) { const int e = i >> 10, k = i & 1023; const float wv = args.in[19][k * 32 + e]; const bf16_t hb = f2bf(wv); RWT[i] = hb; RWT[32768 + i] = f2bf(wv - bf2f(hb)); }
        LAS unsigned* scr = (LAS unsigned*)(lds + wave * 16384); int itbase = 0;
        transpose_matrix<false, true>(args.in[6], 1024, 5632, WT_IN, scr, lane, gw, NGW, itbase);
        transpose_matrix<false>(args.in[14], 512, 1024, WT_A, scr, lane, gw, NGW, itbase);
        transpose_matrix<false>(args.in[15], 512, 1024, WT_B, scr, lane, gw, NGW, itbase);
        transpose_matrix<false>(args.in[16], 1024, 1024, WT_O, scr, lane, gw, NGW, itbase);
        for (int e = 0; e < 32; ++e) transpose_matrix8<true>(args.in[21] + (size_t)e * 1024 * 2048, 1024, 2048, WT_GU8 + (size_t)e * 2048 * 1024, scr, lane, gw, NGW, itbase);
        for (int e = 0; e < 32; ++e) transpose_matrix8<false>(args.in[23] + (size_t)e * 1024 * 1024, 1024, 1024, WT_D8 + (size_t)e * 1024 * 1024, scr, lane, gw, NGW, itbase);
    }
    SEAM(PH_PRO);
#ifdef EXTRA_BARRIERS
    for (int eb = 0; eb < EXTRA_BARRIERS; ++eb) xcd_barrier(bar);
#endif
    if (IN(PH_H1)) for (int rep_ = 0; rep_ < REPS(PH_H1); ++rep_) {
        PHASE_BEGIN
        const float* w = args.in[4];
        { constexpr int NR_ = 4;
        for (int row0 = gw; row0 < T; row0 += NR_ * NGW) { f32x4 v[NR_][4]; float ss[NR_]; int rows[NR_];
#pragma unroll
            for (int q = 0; q < NR_; ++q) { rows[q] = (row0 + q * NGW < T) ? row0 + q * NGW : row0; const f32x4* xr = (const f32x4*)(x + (size_t)rows[q] * 1024) + lane; ss[q] = 0.f;
#pragma unroll
                for (int j = 0; j < 4; ++j) v[q][j] = __builtin_nontemporal_load(xr + 64 * j); }
#pragma unroll
            for (int q = 0; q < NR_; ++q) {
#pragma unroll
                for (int j = 0; j < 4; ++j) ss[q] += (v[q][j][0] * v[q][j][0] + v[q][j][1] * v[q][j][1]) + (v[q][j][2] * v[q][j][2] + v[q][j][3] * v[q][j][3]);
                ss[q] = rsqrtf(wave_sum(ss[q]) * (1.f / 1024.f) + 1e-6f); }
#pragma unroll
            for (int j = 0; j < 4; ++j) { const int col = 4 * lane + 256 * j; const f32x4 wv = *(const f32x4*)(w + col);
#pragma unroll
                for (int q = 0; q < NR_; ++q) { const int b = rows[q] >> 13; const f32x4 sc = *(const f32x4*)(MOD + b * 6144 + 1024 + col), sh = *(const f32x4*)(MOD + b * 6144 + col);
                    const f32x4 h = v[q][j] * ss[q] * wv * (sc + 1.f) + sh; u32x2 o; o.x = pk2(h[0], h[1]); o.y = pk2(h[2], h[3]); *(u32x2*)(H + (size_t)rows[q] * 1024 + col) = o; } } } }
    }
    SEAM(PH_H1);
    if (IN(PH_G1)) for (int rep_ = 0; rep_ < REPS(PH_G1); ++rep_) {
        PHASE_BEGIN
        pg8::Gemm g{H, WT_IN, 1024, nullptr, nullptr}; pg8::DenseOrder S; S.init(T, NC, G, bx);
        EpiProj E{PROJ, ROPEC, ROPES, QR, KIMG, VIMG, (unsigned*)(ws + WS_CTL) + CW_KMAX};
        pg8::gemm_phase<EpiProj, pg8::DenseOrder, false>(lds, g, S, E);
    }
    SEAM(PH_G1);
    if (IN(PH_ROPE_HGA)) for (int rep_ = 0; rep_ < REPS(PH_ROPE_HGA); ++rep_) {
        PHASE_BEGIN
        for (int grp = vcu; grp < 256; grp += G) hg::hgA_group(lds, PROJ, SCAL, SP, DEC, TG, DG, grp >> 4, grp & 15, tid);
        __syncthreads();
    }
    SEAM(PH_ROPE_HGA);
    if (IN(PH_ATT_SCAN)) for (int rep_ = 0; rep_ < REPS(PH_ATT_SCAN); ++rep_) {
        PHASE_BEGIN
        for (int gid = vcu * NTHR + tid; gid < 16 * 128 * 64; gid += G * NTHR) { const int bh = gid >> 13, d = (gid >> 6) & 127, v2 = gid & 63; float s0 = 0.f, s1 = 0.f;
            const float* tp = TG + ((size_t)(bh * 16) * 128 + d) * 128 + 2 * v2; const float* dp = DG + (bh * 16) * 128 + d; bf16_t* gp = GS + ((size_t)(bh * 16) * 128 + d) * 128 + 2 * v2;
            pg8::f32x2 tv[16]; float dv[16];
#pragma unroll
            for (int g = 0; g < 16; ++g) { tv[g] = __builtin_nontemporal_load((const pg8::f32x2*)(tp + (size_t)g * 16384)); dv[g] = dp[g * 128]; }
#pragma unroll
            for (int g = 0; g < 16; ++g) { *(unsigned*)(gp + (size_t)g * 16384) = pk2(s0, s1); s0 = dv[g] * s0 + tv[g][0]; s1 = dv[g] * s1 + tv[g][1]; } }
        { const float lam = SCAL[0]; const float* subln = args.in[11];
          for (int it = vcu; it < 1024; it += G) { int bh, blk;
              if (G == 256) { const int i = it >> 8, v = it & 255, s = v & 15; bh = v >> 4; blk = (i == 0) ? 63 - s : (i == 1) ? 32 + s : (i == 2) ? 31 - s : s; }
              else { blk = 63 - (it >> 4); bh = it & 15; }
              at::attn_unit(lds, QR, KIMG, VIMG, YA, subln, lam, (const unsigned*)(ws + WS_CTL) + CW_KMAX, bh >> 2, bh & 3, blk, tid); } }
    }
    SEAM(PH_ATT_SCAN);
    if (IN(PH_HGC)) for (int rep_ = 0; rep_ < REPS(PH_HGC); ++rep_) {
        PHASE_BEGIN
        const float* hgnorm = args.in[13];
        { hg::CRegs R; if (vcu < 256) hg::hgC_load(R, PROJ, SP, GS, DEC, vcu >> 4, 8 * (vcu & 15), tid);
          for (int grp = vcu; grp < 256; grp += G)
#pragma unroll 1
              for (int k = 0; k < 8; ++k) { const int bh = grp >> 4, n = 8 * (grp & 15) + k; const int ng = (k < 7) ? grp : grp + G; const int nbh = (ng < 256) ? (ng >> 4) : -1, nn = (k < 7) ? n + 1 : 8 * (ng & 15);
                  hg::hgC_unit(lds, R, PROJ, SCAL, SP, GS, DEC, hgnorm, YB, bh, n, nbh, nn, tid); } }
        __syncthreads();
    }
    SEAM(PH_HGC);
    if (IN(PH_G2A)) for (int rep_ = 0; rep_ < REPS(PH_G2A); ++rep_) {
        PHASE_BEGIN
        pg8::Gemm g{YA, WT_A, 512, YB, WT_B}; pg8::DenseOrder2 S; S.base.init(T, 1024, G, bx);
        EpiBranch2 E{PROJ, MERGED};
        pg8::gemm_phase<EpiBranch2, pg8::DenseOrder2, false, true>(lds, g, S, E);
    }
    SEAM(PH_G2B);
    if (IN(PH_G3)) for (int rep_ = 0; rep_ < REPS(PH_G3); ++rep_) {
        PHASE_BEGIN
        pg8::Gemm g{MERGED, WT_O, 1024, nullptr, nullptr}; pg8::DenseOrder S; S.init(T, 1024, G, bx);
        EpiBf16 E{YH, 1024};
        pg8::gemm_phase<EpiBf16, pg8::DenseOrder, false>(lds, g, S, E);
    }
    SEAM(PH_G3);
    if (IN(PH_TOK)) for (int rep_ = 0; rep_ < REPS(PH_TOK); ++rep_) {
        PHASE_BEGIN
        const float* wpm = args.in[5]; const float* wpf = args.in[17]; const float* rb = args.in[20];
        const int wv_ = __builtin_amdgcn_readfirstlane(tid >> 6), r32 = lane & 31, hi = lane >> 5;
        LAS int* lcnt = (LAS int*)lds; LAS int* lbase = lcnt + 32; LAS int* asg = lcnt + 64;
        LAS float* rstd2 = (LAS float*)(lds + 4096);
        LAS float* XC = (LAS float*)(lds + 8192);
        LAS float* LG = (LAS float*)(lds + 24576);
        LAS float* CM = (LAS float*)(lds + 41984); LAS float* SHV = CM + 1024;
        for (int chunk = vcu; chunk < T / 128; chunk += G) { const int b = chunk >> 6;
            __syncthreads();
            if (tid < 32) lcnt[tid] = 0;
            for (int i = tid; i < 1024; i += NTHR) { CM[i] = wpf[i] * (1.f + MOD[b * 6144 + 4096 + i]); SHV[i] = MOD[b * 6144 + 3072 + i]; }
            __syncthreads();
            { constexpr int NR_ = 4; for (int i = 0; i < 16; i += NR_) { const int rloc = wv_ * 16 + i, row = chunk * 128 + rloc;
                f32x4 v[NR_][4], xv[NR_][4]; float ss[NR_], rs[NR_];
#pragma unroll
                for (int q = 0; q < NR_; ++q) ss[q] = 0.f;
#pragma unroll
                for (int q = 0; q < NR_; ++q) { const u32x2* yr = (const u32x2*)(YH + (size_t)(row + q) * 1024) + lane; const f32x4* xr = (const f32x4*)(x + (size_t)(row + q) * 1024) + lane;
#pragma unroll
                    for (int j = 0; j < 4; ++j) { const u32x2 yw = __builtin_nontemporal_load(yr + 64 * j); v[q][j] = (f32x4){__uint_as_float(yw.x << 16), __uint_as_float(yw.x & 0xffff0000u), __uint_as_float(yw.y << 16), __uint_as_float(yw.y & 0xffff0000u)}; xv[q][j] = __builtin_nontemporal_load(xr + 64 * j); } }
#pragma unroll
                for (int q = 0; q < NR_; ++q)
#pragma unroll
                    for (int j = 0; j < 4; ++j) ss[q] += (v[q][j][0] * v[q][j][0] + v[q][j][1] * v[q][j][1]) + (v[q][j][2] * v[q][j][2] + v[q][j][3] * v[q][j][3]);
                #pragma unroll
                for (int q = 0; q < NR_; ++q) { rs[q] = rsqrtf(wave_sum(ss[q]) * (1.f / 1024.f) + 1e-6f); ss[q] = 0.f; }
#pragma unroll
                for (int j = 0; j < 4; ++j) { const int col = 4 * lane + 256 * j; const f32x4 g1 = *(const f32x4*)(MOD + b * 6144 + 2048 + col), wv = *(const f32x4*)(wpm + col);
#pragma unroll
                    for (int q = 0; q < NR_; ++q) { v[q][j] = xv[q][j] + g1 * v[q][j] * rs[q] * wv; *(f32x4*)(out + (size_t)(row + q) * 1024 + col) = v[q][j];
                        ss[q] += (v[q][j][0] * v[q][j][0] + v[q][j][1] * v[q][j][1]) + (v[q][j][2] * v[q][j][2] + v[q][j][3] * v[q][j][3]); } }
                #pragma unroll
                for (int q = 0; q < NR_; ++q) { rs[q] = rsqrtf(wave_sum(ss[q]) * (1.f / 1024.f) + 1e-6f); if (lane == 0) rstd2[rloc + q] = rs[q]; }
#pragma unroll
                for (int j = 0; j < 4; ++j) { const int col = 4 * lane + 256 * j; const f32x4 cm = *(const LAS f32x4*)(CM + col), sh = *(const LAS f32x4*)(SHV + col);
#pragma unroll
                    for (int q = 0; q < NR_; ++q) { const f32x4 h = (v[q][j] * rs[q] * cm + sh) * S8_H; *(unsigned*)(H8 + (size_t)(row + q) * 1024 + col) = pk4_fp8(h[0], h[1], h[2], h[3]); } } } }
            asm volatile("s_waitcnt vmcnt(0)" ::: "memory");
            __syncthreads();
            { const int rt = wv_ & 3, kh = wv_ >> 2; const int rloc = 32 * rt + r32; const float rs = rstd2[rloc];
              const float* xrow = out + (size_t)(chunk * 128 + rloc) * 1024 + 512 * kh + 8 * hi; const bf16_t* whi = RWT + (size_t)r32 * 1024 + 512 * kh + 8 * hi; const bf16_t* wlo = whi + 32768;
              const LAS float* cmp = CM + 512 * kh + 8 * hi; const LAS float* shp = SHV + 512 * kh + 8 * hi;
              at::f32x16 acc = at::f32x16{};
#pragma unroll 4
              for (int ks = 0; ks < 32; ++ks) { const f32x4 xa = __builtin_nontemporal_load((const f32x4*)(xrow + 16 * ks)), xb = __builtin_nontemporal_load((const f32x4*)(xrow + 16 * ks + 4));
                  const f32x4 ca = *(const LAS f32x4*)(cmp + 16 * ks), cb = *(const LAS f32x4*)(cmp + 16 * ks + 4), sa = *(const LAS f32x4*)(shp + 16 * ks), sb = *(const LAS f32x4*)(shp + 16 * ks + 4);
                  const f32x4 ha = xa * rs * ca + sa, hb = xb * rs * cb + sb;
                  const unsigned h0 = at::cvtpk(ha[0], ha[1]), h1 = at::cvtpk(ha[2], ha[3]), h2 = at::cvtpk(hb[0], hb[1]), h3 = at::cvtpk(hb[2], hb[3]);
                  const unsigned l0 = at::cvtpk(ha[0] - __uint_as_float(h0 << 16), ha[1] - __uint_as_float(h0 & 0xffff0000u)), l1 = at::cvtpk(ha[2] - __uint_as_float(h1 << 16), ha[3] - __uint_as_float(h1 & 0xffff0000u));
                  const unsigned l2 = at::cvtpk(hb[0] - __uint_as_float(h2 << 16), hb[1] - __uint_as_float(h2 & 0xffff0000u)), l3 = at::cvtpk(hb[2] - __uint_as_float(h3 << 16), hb[3] - __uint_as_float(h3 & 0xffff0000u));
                  const at::bf16x8 ahi = __builtin_bit_cast(at::bf16x8, (u32x4){h0, h1, h2, h3}), alo = __builtin_bit_cast(at::bf16x8, (u32x4){l0, l1, l2, l3});
                  const at::bf16x8 bhi = *(const at::bf16x8*)(whi + 16 * ks), blo = *(const at::bf16x8*)(wlo + 16 * ks);
                  acc = __builtin_amdgcn_mfma_f32_32x32x16_bf16(ahi, bhi, acc, 0, 0, 0); acc = __builtin_amdgcn_mfma_f32_32x32x16_bf16(ahi, blo, acc, 0, 0, 0); acc = __builtin_amdgcn_mfma_f32_32x32x16_bf16(alo, bhi, acc, 0, 0, 0); }
              if (kh == 1) {
#pragma unroll
                  for (int r = 0; r < 16; ++r) XC[(rt * 16 + r) * 64 + lane] = acc[r]; }
              __syncthreads();
              if (kh == 0) { const float bias = rb[r32];
#pragma unroll
                  for (int r = 0; r < 16; ++r) LG[(32 * rt + at::crow(r, hi)) * 33 + r32] = acc[r] + XC[(rt * 16 + r) * 64 + lane] + bias; }
              __syncthreads(); }
            if (tid < 128) { const int rloc = tid, row = chunk * 128 + rloc; float lg[32];
#pragma unroll
                for (int e = 0; e < 32; ++e) lg[e] = LG[rloc * 33 + e];
                int bi[4]; float bv[4];
#pragma unroll
                for (int k = 0; k < 4; ++k) { float best = -3.0e38f; int be = 0;
#pragma unroll
                    for (int e = 0; e < 32; ++e) { bool taken = false;
#pragma unroll
                        for (int q = 0; q < 4; ++q) if (q < k && bi[q] == e) taken = true;
                        if (!taken && lg[e] > best) { best = lg[e]; be = e; } }
                    bi[k] = be; bv[k] = best; }
                const float e1 = expf(bv[1] - bv[0]), e2 = expf(bv[2] - bv[0]), e3 = expf(bv[3] - bv[0]); const float inv = 1.f / (1.f + e1 + e2 + e3);
                if (rep_ == REPS(PH_TOK) - 1) { *(f32x4*)(TOPW + row * 4) = (f32x4){inv, e1 * inv, e2 * inv, e3 * inv};
                    *(u32x4*)(TOPI + row * 4) = (u32x4){(unsigned)bi[0], (unsigned)bi[1], (unsigned)bi[2], (unsigned)bi[3]};
#pragma unroll
                    for (int k = 0; k < 4; ++k) { const int pos = __hip_atomic_fetch_add(lcnt + bi[k], 1, __ATOMIC_RELAXED, __HIP_MEMORY_SCOPE_WORKGROUP); asg[rloc * 4 + k] = (bi[k] << 16) | pos; } } }
            __syncthreads();
            if (tid < 32) lbase[tid] = atomicAdd(&CNT[tid], lcnt[tid]);
            __syncthreads();
            if (rep_ == REPS(PH_TOK) - 1) { const int v = asg[tid], e = v >> 16, pos = v & 0xffff; LIST[(size_t)e * 32768 + lbase[e] + pos] = chunk * 512 + tid; }
        }
        __syncthreads();
    }
    SEAM(PH_TOK);
    if (IN(PH_G4) || IN(PH_G5)) {
        PHASE_BEGIN
        if (tid < 32) ((LAS int*)LW)[LW_CNT + tid] = __hip_atomic_load(&CNT[tid], __ATOMIC_RELAXED, __HIP_MEMORY_SCOPE_AGENT);
        __syncthreads();
        if (tid == 0) { int s = 0; for (int e = 0; e < 32; ++e) { ((LAS int*)LW)[LW_TPRE + e] = s; s += (((LAS int*)LW)[LW_CNT + e] + 255) >> 8; } ((LAS int*)LW)[LW_TPRE + 32] = s; }
        __syncthreads();
    }
    if (IN(PH_G4)) for (int rep_ = 0; rep_ < REPS(PH_G4); ++rep_) {
        PHASE_BEGIN
        pg8::Gemm g{(const bf16_t*)H8, (const bf16_t*)WT_GU8, 512, nullptr, nullptr}; MoeOrder S{(const LAS int*)LW + LW_TPRE, (const LAS int*)LW + LW_CNT, LIST, 8, G, bx, 1024, 2048, (LAS int*)LW + 1024};
        EpiGateUp E{args.in[22], ACT8};
        pg8::gemm_phase<EpiGateUp, MoeOrder, true, false, true>(lds, g, S, E);
    }
    SEAM(PH_G4);
    if (IN(PH_G5)) for (int rep_ = 0; rep_ < REPS(PH_G5); ++rep_) {
        PHASE_BEGIN
        pg8::Gemm g{(const bf16_t*)ACT8, (const bf16_t*)WT_D8, 512, nullptr, nullptr}; MoeOrder S{(const LAS int*)LW + LW_TPRE, (const LAS int*)LW + LW_CNT, LIST, 4, G, bx, 1024, 1024, (LAS int*)LW + 1024};
        EpiDown E{args.in[24], LIST, YM8, (const LAS int*)LW + LW_CNT};
        pg8::gemm_phase<EpiDown, MoeOrder, false, false, true>(lds, g, S, E);
    }
    SEAM(PH_G5);
    if (IN(PH_FIN)) for (int rep_ = 0; rep_ < REPS(PH_FIN); ++rep_) {
        PHASE_BEGIN
        const float* w = args.in[18];
        for (int row0 = gw; row0 < T; row0 += 2 * NGW) { f32x4 v[2][4], ov[2][4]; float ss[2] = {0.f, 0.f}; int rows[2] = {row0, (row0 + NGW < T) ? row0 + NGW : row0};
#pragma unroll
            for (int q = 0; q < 2; ++q) { const int row = rows[q]; const f32x4 tw = *(const f32x4*)(TOPW + row * 4) * (1.f / S8_Y); const unsigned char* y0 = YM8 + (size_t)row * 4096;
#pragma unroll
                for (int j = 0; j < 4; ++j) { const int col = 4 * lane + 256 * j; f32x4 a = (f32x4){0.f, 0.f, 0.f, 0.f};
#pragma unroll
                    for (int k = 0; k < 4; ++k) { const unsigned yw = __builtin_nontemporal_load((const unsigned*)(y0 + k * 1024 + col)); const pg8::f32x2 lo = __builtin_amdgcn_cvt_pk_f32_fp8(yw, false), hi = __builtin_amdgcn_cvt_pk_f32_fp8(yw, true);
                        a[0] += tw[k] * lo[0]; a[1] += tw[k] * lo[1]; a[2] += tw[k] * hi[0]; a[3] += tw[k] * hi[1]; }
                    v[q][j] = a; ov[q][j] = __builtin_nontemporal_load((const f32x4*)(out + (size_t)row * 1024 + col)); ss[q] += (a[0] * a[0] + a[1] * a[1]) + (a[2] * a[2] + a[3] * a[3]); } }
            const float rs[2] = {rsqrtf(wave_sum(ss[0]) * (1.f / 1024.f) + 1e-6f), rsqrtf(wave_sum(ss[1]) * (1.f / 1024.f) + 1e-6f)};
#pragma unroll
            for (int q = 0; q < 2; ++q) { const int row = rows[q], b = row >> 13; if (q == 1 && rows[1] == rows[0]) break;
#pragma unroll
                for (int j = 0; j < 4; ++j) { const int col = 4 * lane + 256 * j; const f32x4 g2 = *(const f32x4*)(MOD + b * 6144 + 5120 + col), wv = *(const f32x4*)(w + col);
                    const f32x4 res = ov[q][j] + g2 * v[q][j] * rs[q] * wv; if (rep_ == REPS(PH_FIN) - 1) *(f32x4*)(out + (size_t)row * 1024 + col) = res; else asm volatile("" :: "v"(res)); } } }
    }
#ifdef PROBE_SPAN
    STAMP(PH_N);
    if (bx == 0 && threadIdx.x == 0) { const unsigned long long t0_ = ((unsigned long long)LW[161 + 2 * (PROBE_SPAN)] << 32) | LW[160 + 2 * (PROBE_SPAN)], t1_ = ((unsigned long long)LW[161 + 2 * (PROBE_SPAN_END)] << 32) | LW[160 + 2 * (PROBE_SPAN_END)];
        const unsigned long long until_ = __builtin_amdgcn_s_memrealtime() + 4ull * (t1_ - t0_);
        while (__builtin_amdgcn_s_memrealtime() < until_) __builtin_amdgcn_s_sleep(8); }
#endif
#undef IN
#undef SEAM
}
}
#undef MOD
#undef SCAL
#undef ROPEC
#undef ROPES
#undef TOPI
#undef TOPW
#undef LIST
#undef RWT
#undef CNT
#undef H
#undef QR
#undef KIMG
#undef VIMG
#undef PROJ
#undef YA
#undef YB
#undef DS
#undef DEC
#undef TG
#undef GS
#undef DG
#undef MERGED
#undef SP
#undef Y
#undef YH
#undef ACT
#undef YM
#undef WT_IN
#undef WT_A
#undef WT_B
#undef WT_O
#undef WT_GU
#undef WT_GU8
#undef WT_D8
#undef H8
#undef ACT8
#undef YM8
#undef WT_D
#undef PHASE_BEGIN

#ifndef FASTMASK
#define FASTMASK 0x1fff
#endif

extern "C" void kernel_launch(void* const* d_in, const int* in_sizes, int n_in, void* d_out, int out_size, void* d_ws, size_t ws_size, hipStream_t stream) {
    if (n_in != 25 || out_size != T * D || ws_size < WS_END) { fprintf(stderr, "kernel_launch: unexpected shapes / workspace (%d inputs, out %d, ws %zu)\n", n_in, out_size, ws_size); return; }
    const float* x = (const float*)d_in[0]; const float* c = (const float*)d_in[1]; const float* w_mod = (const float*)d_in[2]; const float* b_mod = (const float*)d_in[3];
    const float* norm_pre_mix = (const float*)d_in[4]; const float* norm_post_mix = (const float*)d_in[5]; const float* w_in = (const float*)d_in[6];
    const float* lq1 = (const float*)d_in[7]; const float* lk1 = (const float*)d_in[8]; const float* lq2 = (const float*)d_in[9]; const float* lk2 = (const float*)d_in[10];
    const float* subln = (const float*)d_in[11]; const float* lbl = (const float*)d_in[12]; const float* hgnorm = (const float*)d_in[13];
    const float* wa = (const float*)d_in[14]; const float* wb = (const float*)d_in[15]; const float* wo = (const float*)d_in[16];
    const float* norm_pre_ffn = (const float*)d_in[17]; const float* norm_post_ffn = (const float*)d_in[18]; const float* rw = (const float*)d_in[19]; const float* rb = (const float*)d_in[20];
    const float* wgu = (const float*)d_in[21]; const float* bgu = (const float*)d_in[22]; const float* wd = (const float*)d_in[23]; const float* bd = (const float*)d_in[24];
    unsigned char* ws = (unsigned char*)d_ws; float* out = (float*)d_out;
    float* MOD = (float*)(ws + WS_SMALL); float* SCAL = (float*)(ws + WS_SMALL + 128 * 1024); int* PADS = (int*)(ws + WS_SMALL + 192 * 1024);
    float* ROPEC = (float*)(ws + WS_ROPEC); float* ROPES = (float*)(ws + WS_ROPES);
    int* TOPI = (int*)(ws + WS_TOPI); float* TOPW = (float*)(ws + WS_TOPW); int* LIST = (int*)(ws + WS_LIST); int* CNT = (int*)(ws + WS_CTL) + CW_CNT;
    bf16_t* H = (bf16_t*)(ws + WS_H); bf16_t* PROJ = (bf16_t*)(ws + WS_PROJ); bf16_t* YA = (bf16_t*)(ws + WS_YA); bf16_t* YB = (bf16_t*)(ws + WS_YB);
    bf16_t* DS = (bf16_t*)(ws + WS_DS); float* DEC = (float*)(ws + WS_DEC); bf16_t* MERGED = (bf16_t*)(ws + WS_MERGED); float* Y = (float*)(ws + WS_Y);
    bf16_t* SP = (bf16_t*)(ws + WS_MERGED);
    bf16_t* ACT = (bf16_t*)(ws + WS_ACT); bf16_t* YM = (bf16_t*)(ws + WS_YM);

    static int grid = 0;
    if (grid == 0) {
        (void)hipFuncSetAttribute((const void*)nv::k_attn, hipFuncAttributeMaxDynamicSharedMemorySize, nv::AT_LDS);
        (void)hipFuncSetAttribute((const void*)nv::k_hgA, hipFuncAttributeMaxDynamicSharedMemorySize, 65536);
        (void)hipFuncSetAttribute((const void*)nv::k_hgC, hipFuncAttributeMaxDynamicSharedMemorySize, nv::HC_LDS);
        (void)hipFuncSetAttribute((const void*)mk::mega, hipFuncAttributeMaxDynamicSharedMemorySize, mk::LDS_BYTES);
        int dev = 0, cus = 0; (void)hipGetDevice(&dev); (void)hipDeviceGetAttribute(&cus, hipDeviceAttributeMultiprocessorCount, dev);
        (void)hipGetLastError();
        grid = cus > 0 ? cus : 256;
    }
    (void)hipMemsetAsync(ws + WS_CTL, 0, 1 * MiB, stream);
    mk::Args a{}; for (int i = 0; i < 25; ++i) a.in[i] = (const float*)d_in[i]; a.out = out; a.ws = ws;
    const unsigned fast = FASTMASK; int li = 0;
    for (int p = 0; p < mk::PH_N;) {
        if (fast & (1u << p)) { int q = p; while (q < mk::PH_N && (fast & (1u << q))) ++q;
            a.ph_lo = p; a.ph_hi = q; a.li = li++; a.pad = 0;
            hipLaunchKernelGGL(mk::mega, dim3(grid), dim3(mk::NTHR), mk::LDS_BYTES, stream, a);
            p = q; continue; }
        switch (p) {
        case mk::PH_PRO:
            nv::k_mod<<<dim3(24, 4), 256, 0, stream>>>(c, w_mod, b_mod, MOD);
            nv::k_small<<<1024, 256, 0, stream>>>(lq1, lk1, lq2, lk2, lbl, SCAL, ROPEC, ROPES); break;
        case mk::PH_H1: nv::k_rowmod<<<T / 4, 256, 0, stream>>>(x, norm_pre_mix, MOD, H, 0, 1024); break;
        case mk::PH_G1: { nv::NG p_{}; p_.A = H; p_.lda = 1024; p_.M = T; p_.B = w_in; p_.ldb = NC; p_.K = 1024;
            nv::k_gemm<nv::EpiStoreBf16, 1><<<dim3(NC / 64, T / 64, 1), 256, 0, stream>>>(p_, nv::EpiStoreBf16{PROJ, (long long)NC}); } break;
        case mk::PH_ROPE_HGA: nv::k_hgA<<<dim3(128, 4, 4), 256, 65536, stream>>>(PROJ, SCAL, DS, DEC); break;
        case mk::PH_ATT_SCAN:
            nv::k_attn<<<dim3(128, 4, 4), 256, nv::AT_LDS, stream>>>(PROJ, ROPEC, ROPES, SCAL, subln, YA);
            nv::k_scan<<<1024, 256, 0, stream>>>(DS, DEC, SP); break;
        case mk::PH_HGC: nv::k_hgC<<<dim3(128, 4, 4), 256, nv::HC_LDS, stream>>>(PROJ, SCAL, SP, hgnorm, YB); break;
        case mk::PH_G2A: { nv::NG p_{}; p_.A = YA; p_.lda = 512; p_.M = T; p_.B = wa; p_.ldb = 1024; p_.K = 512;
            nv::k_gemm<nv::EpiBranchA, 1><<<dim3(16, T / 64, 1), 256, 0, stream>>>(p_, nv::EpiBranchA{out, PROJ}); } break;
        case mk::PH_G2B: { nv::NG p_{}; p_.A = YB; p_.lda = 512; p_.M = T; p_.B = wb; p_.ldb = 1024; p_.K = 512;
            nv::k_gemm<nv::EpiBranchB, 1><<<dim3(16, T / 64, 1), 256, 0, stream>>>(p_, nv::EpiBranchB{out, PROJ, MERGED}); } break;
        case mk::PH_G3: { nv::NG p_{}; p_.A = MERGED; p_.lda = 1024; p_.M = T; p_.B = wo; p_.ldb = 1024; p_.K = 1024;
            nv::k_gemm<nv::EpiStoreF32, 1><<<dim3(16, T / 64, 1), 256, 0, stream>>>(p_, nv::EpiStoreF32{Y, 1024LL}); } break;
        case mk::PH_TOK:
            nv::k_x1<<<T / 4, 256, 0, stream>>>(x, Y, norm_post_mix, MOD, 2048LL, out);
            nv::k_rowmod<<<T / 4, 256, 0, stream>>>(out, norm_pre_ffn, MOD, H, 3072, 4096);
            nv::k_route<<<T / 4, 256, 0, stream>>>(out, norm_pre_ffn, MOD, rw, rb, TOPI, TOPW);
            nv::k_lists<<<T * 4 / 256, 256, 0, stream>>>(TOPI, CNT, LIST);
            nv::k_pads<<<1, 64, 0, stream>>>(CNT, PADS); break;
        case mk::PH_G4: { nv::NG p_{}; p_.A = H; p_.lda = 1024; p_.rowidx = LIST; p_.idxstride = 32768; p_.idxshift = 2; p_.cnt = CNT; p_.rowbase = PADS; p_.B = wgu; p_.strideB = (size_t)1024 * 2048; p_.ldb = 2048; p_.K = 1024; p_.b1off = 1024;
            nv::k_gemm<nv::EpiGateUp, 2><<<dim3(16, T / 64, 32), 256, 0, stream>>>(p_, nv::EpiGateUp{bgu, ACT}); } break;
        case mk::PH_G5: { nv::NG p_{}; p_.A = ACT; p_.lda = 1024; p_.cnt = CNT; p_.rowbase = PADS; p_.B = wd; p_.strideB = (size_t)1024 * 1024; p_.ldb = 1024; p_.K = 1024;
            nv::k_gemm<nv::EpiDown, 1><<<dim3(16, T / 64, 32), 256, 0, stream>>>(p_, nv::EpiDown{bd, LIST, YM}); } break;
        case mk::PH_FIN: nv::k_final<<<T / 4, 256, 0, stream>>>(out, YM, TOPW, norm_post_ffn, MOD); break;
        }
        ++p;
    }
}
```

```cpp
#define G1_WGM 4
#include <hip/hip_runtime.h>
#include <hip/hip_bf16.h>
#include <stdint.h>
#include <cstdio>

typedef unsigned short bf16_t;
__device__ __forceinline__ float bf2f(bf16_t v) { return __uint_as_float(((unsigned)v) << 16); }
__device__ __forceinline__ bf16_t f2bf(float f) { unsigned u = __float_as_uint(f); return (bf16_t)((u + 0x7fffu + ((u >> 16) & 1u)) >> 16); }

constexpr int NB_ = 4, SEQ = 8192, T = NB_ * SEQ, D = 1024, NC = 5632, NE = 32;
constexpr size_t MiB = 1u << 20;
constexpr size_t WS_CTL = 0;
constexpr size_t WS_SMALL = 1 * MiB;
constexpr size_t WS_ROPEC = 2 * MiB, WS_ROPES = 3 * MiB;
constexpr size_t WS_TOPI = 4 * MiB, WS_TOPW = 4 * MiB + 512 * 1024;
constexpr size_t WS_RWT = 5 * MiB;
constexpr size_t WS_LIST = 6 * MiB;
constexpr size_t WS_WIN = 16 * MiB, WS_WA = 28 * MiB, WS_WB = 29 * MiB, WS_WO = 30 * MiB, WS_WGU = 32 * MiB, WS_WD = 160 * MiB;
constexpr size_t WS_H = 224 * MiB;
constexpr size_t WS_PROJ = 288 * MiB;
constexpr size_t WS_YA = 640 * MiB, WS_YB = 672 * MiB;
constexpr size_t WS_DS = 704 * MiB, WS_DEC = 768 * MiB;
constexpr size_t WS_MERGED = 772 * MiB;
constexpr size_t WS_Y = 836 * MiB;
constexpr size_t WS_ACT = 288 * MiB;
constexpr size_t WS_YM = 560 * MiB;
constexpr size_t WS_END = 964 * MiB;
constexpr int CW_CNT = 1024;
constexpr int CW_KMAX = 2048;
constexpr int CW_BAR = 4096;

namespace nv {

__device__ __forceinline__ float wave_sum(float v) {
#pragma unroll
    for (int o = 1; o < 64; o <<= 1) v += __shfl_xor(v, o);
    return v;
}
__device__ __forceinline__ float sigm(float x) { return 1.f / (1.f + expf(-x)); }

__global__ void __launch_bounds__(256) k_mod(const float* c, const float* w_mod, const float* b_mod, float* mod) {
    const int j = blockIdx.x * 256 + threadIdx.x, b = blockIdx.y;
    float acc = 0.f;
    for (int k = 0; k < 1024; ++k) { const float cv = c[b * 1024 + k]; acc += (cv * sigm(cv)) * w_mod[(size_t)k * 6144 + j]; }
    mod[b * 6144 + j] = acc + b_mod[j];
}
__global__ void __launch_bounds__(256) k_small(const float* q1, const float* k1, const float* q2, const float* k2, const float* lbl,
                                               float* scal, float* ropec, float* ropes) {
    const int gid = blockIdx.x * 256 + threadIdx.x;
    if (gid == 0) { float s1 = 0.f, s2 = 0.f; for (int i = 0; i < 64; ++i) { s1 += q1[i] * k1[i]; s2 += q2[i] * k2[i]; } scal[0] = expf(s1) - expf(s2) + 0.2f; }
    if (gid < 512) { const float a = lbl[gid], b = lbl[512 + gid]; scal[64 + gid] = 1.f / (1.f + expf(b - a)); }
    if (gid < 8192 * 32) { const int s = gid >> 5, i = gid & 31; const float inv = powf(10000.f, -(float)(2 * i) / 64.f); const float ang = (float)s * inv; ropec[gid] = cosf(ang); ropes[gid] = sinf(ang); }
}
__global__ void __launch_bounds__(256) k_rowmod(const float* x, const float* w, const float* mod, bf16_t* out, int shoff, int scoff) {
    const int row = blockIdx.x * 4 + (threadIdx.x >> 6), lane = threadIdx.x & 63, b = row >> 13;
    const float* xr = x + (size_t)row * 1024; float v[16]; float ss = 0.f;
#pragma unroll
    for (int j = 0; j < 16; ++j) { v[j] = xr[lane + 64 * j]; ss += v[j] * v[j]; }
    ss = wave_sum(ss); const float rstd = rsqrtf(ss * (1.f / 1024.f) + 1e-6f);
#pragma unroll
    for (int j = 0; j < 16; ++j) { const int col = lane + 64 * j; const float h = v[j] * rstd * w[col] * (1.f + mod[b * 6144 + scoff + col]) + mod[b * 6144 + shoff + col]; out[(size_t)row * 1024 + col] = f2bf(h); }
}

struct NG {
    const bf16_t* A;
    const int* rowidx;
    const int* cnt;
    const int* rowbase;
    const float* B; size_t strideB;
    int lda, idxstride, idxshift, M  , ldb, K, b1off, pad;
};
template <class Epi, int NB>
__global__ void __launch_bounds__(256) k_gemm(NG p, Epi epi) {
    __shared__ float As[16][68];
    __shared__ float Bs[NB][16][64];
    const int z = blockIdx.z, Mz = p.cnt ? p.cnt[z] : p.M, m0 = blockIdx.y * 64, n0 = blockIdx.x * 64;
    if (m0 >= Mz) return;
    const int tid = threadIdx.x, tx = tid & 15, ty = tid >> 4;
    const float* B = p.B + (size_t)z * p.strideB;
    const int base = p.rowbase ? p.rowbase[z] : 0;
    const int lr = tid >> 2, lk = (tid & 3) * 4;
    int lrow = m0 + lr; if (lrow >= Mz) lrow = Mz - 1;
    const size_t arow = p.rowidx ? (size_t)(p.rowidx[(size_t)z * p.idxstride + lrow] >> p.idxshift) : (size_t)(base + lrow);
    const bf16_t* ap = p.A + arow * p.lda + lk;
    const int bk = tid >> 4, bc = (tid & 15) * 4;
    float acc[NB][4][4];
#pragma unroll
    for (int q = 0; q < NB; ++q)
#pragma unroll
        for (int i = 0; i < 4; ++i)
#pragma unroll
            for (int j = 0; j < 4; ++j) acc[q][i][j] = 0.f;
    for (int k0 = 0; k0 < p.K; k0 += 16) {
        const uint2 av = *(const uint2*)(ap + k0);
        As[lk + 0][lr] = __uint_as_float(av.x << 16); As[lk + 1][lr] = __uint_as_float(av.x & 0xffff0000u);
        As[lk + 2][lr] = __uint_as_float(av.y << 16); As[lk + 3][lr] = __uint_as_float(av.y & 0xffff0000u);
#pragma unroll
        for (int q = 0; q < NB; ++q) { const float4 bv = *(const float4*)(B + (size_t)(k0 + bk) * p.ldb + n0 + bc + q * p.b1off); *(float4*)&Bs[q][bk][bc] = bv; }
        __syncthreads();
#pragma unroll
        for (int k = 0; k < 16; ++k) {
            float a[4]; const float4 a4 = *(const float4*)&As[k][ty * 4]; a[0] = a4.x; a[1] = a4.y; a[2] = a4.z; a[3] = a4.w;
#pragma unroll
            for (int q = 0; q < NB; ++q) { const float4 b4 = *(const float4*)&Bs[q][k][tx * 4]; const float b[4] = {b4.x, b4.y, b4.z, b4.w};
#pragma unroll
                for (int i = 0; i < 4; ++i)
#pragma unroll
                    for (int j = 0; j < 4; ++j) acc[q][i][j] += a[i] * b[j]; }
        }
        __syncthreads();
    }
#pragma unroll
    for (int i = 0; i < 4; ++i) { const int lrw = m0 + ty * 4 + i; if (lrw < Mz) {
#pragma unroll
        for (int j = 0; j < 4; ++j) epi(z, lrw, base + lrw, n0 + tx * 4 + j, acc[0][i][j], NB == 2 ? acc[NB - 1][i][j] : 0.f); } }
}
struct EpiStoreBf16 { bf16_t* C; long long ldc; __device__ void operator()(int, int, int r, int c, float v, float) const { C[(size_t)r * ldc + c] = f2bf(v); } };
struct EpiStoreF32 { float* C; long long ldc; __device__ void operator()(int, int, int r, int c, float v, float) const { C[(size_t)r * ldc + c] = v; } };
struct EpiBranchA { float* tmp; const bf16_t* proj; __device__ void operator()(int, int, int r, int c, float v, float) const { tmp[(size_t)r * 1024 + c] = sigm(bf2f(proj[(size_t)r * 5632 + 3584 + c])) * v; } };
struct EpiBranchB { const float* tmp; const bf16_t* proj; bf16_t* merged; __device__ void operator()(int, int, int r, int c, float v, float) const {
    merged[(size_t)r * 1024 + c] = f2bf(tmp[(size_t)r * 1024 + c] + sigm(bf2f(proj[(size_t)r * 5632 + 4608 + c])) * v); } };
struct EpiGateUp { const float* bgu; bf16_t* act; __device__ void operator()(int e, int, int r, int c, float v0, float v1) const {
    float g = v0 + bgu[e * 2048 + c], u = v1 + bgu[e * 2048 + 1024 + c]; g = fminf(g, 7.f); u = fminf(fmaxf(u, -7.f), 7.f);
    const float glu = g * sigm(1.702f * g); act[(size_t)r * 1024 + c] = f2bf((u + 1.f) * glu); } };
struct EpiDown { const float* bd; const int* list; bf16_t* ym; __device__ void operator()(int e, int lr, int, int c, float v, float) const {
    const int a = list[(size_t)e * 32768 + lr]; ym[(size_t)a * 1024 + c] = f2bf(v + bd[e * 1024 + c]); } };

constexpr int AT_LD = 129;
constexpr int AT_LDS = (3 * 64 * AT_LD + 64 * 65) * 4;
__device__ __forceinline__ void at_load_rope(float* dst, const bf16_t* proj, int tok0, int colbase, const float* ropec, const float* ropes, int s0, int tid) {
    for (int i = 0; i < 16; ++i) { const int idx = tid + 256 * i, row = idx >> 6, rem = idx & 63, m = rem >> 5, d = rem & 31;
        const bf16_t* pr = proj + (size_t)(tok0 + row) * 5632 + colbase + m * 64;
        const float x1 = bf2f(pr[d]), x2 = bf2f(pr[32 + d]), c = ropec[(s0 + row) * 32 + d], s = ropes[(s0 + row) * 32 + d];
        dst[row * AT_LD + m * 64 + d] = x1 * c - x2 * s; dst[row * AT_LD + m * 64 + 32 + d] = x2 * c + x1 * s; }
}
__global__ void __launch_bounds__(256) k_attn(const bf16_t* proj, const float* ropec, const float* ropes, const float* scal, const float* subln, bf16_t* ya) {
    extern __shared__ float sm[];
    float* Qs = sm; float* Ks = Qs + 64 * AT_LD; float* Vs = Ks + 64 * AT_LD; float* As = Vs + 64 * AT_LD;
    const int qc = blockIdx.x, h = blockIdx.y, b = blockIdx.z, tid = threadIdx.x, r = tid >> 2, qd = tid & 3;
    const int tokq = b * 8192 + qc * 64; const float lam = scal[0];
    at_load_rope(Qs, proj, tokq, h * 128, ropec, ropes, qc * 64, tid);
    float m0 = -1e30f, l0 = 0.f, m1 = -1e30f, l1 = 0.f;
    for (int kc = 0; kc <= qc; ++kc) {
        __syncthreads();
        at_load_rope(Ks, proj, b * 8192 + kc * 64, 512 + h * 128, ropec, ropes, kc * 64, tid);
        __syncthreads();
        for (int i = 0; i < 16; ++i) { const int j = 4 * i + qd; float s0 = 0.f, s1 = 0.f;
            for (int d = 0; d < 64; ++d) { s0 += Qs[r * AT_LD + d] * Ks[j * AT_LD + d]; s1 += Qs[r * AT_LD + 64 + d] * Ks[j * AT_LD + 64 + d]; }
            s0 *= 0.125f; s1 *= 0.125f;
            float mn = fmaxf(m0, s0); l0 = l0 * expf(m0 - mn) + expf(s0 - mn); m0 = mn;
            mn = fmaxf(m1, s1); l1 = l1 * expf(m1 - mn) + expf(s1 - mn); m1 = mn; }
    }
#pragma unroll
    for (int o = 1; o < 4; o <<= 1) {
        float mo = __shfl_xor(m0, o), lo = __shfl_xor(l0, o); float mn = fmaxf(m0, mo); l0 = l0 * expf(m0 - mn) + lo * expf(mo - mn); m0 = mn;
        mo = __shfl_xor(m1, o); lo = __shfl_xor(l1, o); mn = fmaxf(m1, mo); l1 = l1 * expf(m1 - mn) + lo * expf(mo - mn); m1 = mn; }
    const float il0 = 1.f / l0, il1 = lam / l1;
    float o[32];
#pragma unroll
    for (int i = 0; i < 32; ++i) o[i] = 0.f;
    for (int kc = 0; kc <= qc; ++kc) {
        __syncthreads();
        at_load_rope(Ks, proj, b * 8192 + kc * 64, 512 + h * 128, ropec, ropes, kc * 64, tid);
        for (int i = 0; i < 32; ++i) { const int idx = tid + 256 * i, row = idx >> 7, col = idx & 127; Vs[row * AT_LD + col] = bf2f(proj[(size_t)(b * 8192 + kc * 64 + row) * 5632 + 1024 + h * 128 + col]); }
        __syncthreads();
        for (int i = 0; i < 16; ++i) { const int j = 4 * i + qd; float s0 = 0.f, s1 = 0.f;
            for (int d = 0; d < 64; ++d) { s0 += Qs[r * AT_LD + d] * Ks[j * AT_LD + d]; s1 += Qs[r * AT_LD + 64 + d] * Ks[j * AT_LD + 64 + d]; }
            s0 *= 0.125f; s1 *= 0.125f;
            As[r * 65 + j] = expf(s0 - m0) * il0 - expf(s1 - m1) * il1; }
        __syncthreads();
        for (int j = 0; j < 64; ++j) { const float av = As[r * 65 + j];
#pragma unroll
            for (int dv = 0; dv < 32; ++dv) o[dv] += av * Vs[j * AT_LD + 32 * qd + dv]; }
    }
    float ss = 0.f;
#pragma unroll
    for (int i = 0; i < 32; ++i) ss += o[i] * o[i];
    ss += __shfl_xor(ss, 1); ss += __shfl_xor(ss, 2);
    const float rstd = rsqrtf(ss * (1.f / 128.f) + 1e-6f);
#pragma unroll
    for (int i = 0; i < 32; ++i) { const int dv = 32 * qd + i; ya[(size_t)(tokq + r) * 512 + h * 128 + dv] = f2bf(o[i] * rstd * subln[dv] * 0.8f); }
}

__global__ void __launch_bounds__(256) k_hgA(const bf16_t* proj, const float* scal, bf16_t* ds, float* dec) {
    extern __shared__ float sm[];
    float* G = sm; float* V = sm + 64 * 128;
    const int n = blockIdx.x, h = blockIdx.y, b = blockIdx.z, tid = threadIdx.x, tok0 = b * 8192 + n * 64, bh = b * 4 + h;
    for (int i = 0; i < 32; ++i) { const int idx = tid + 256 * i, c = idx >> 7, d = idx & 127; const bf16_t* pr = proj + (size_t)(tok0 + c) * 5632 + h * 128 + d;
        const float lb = scal[64 + h * 128 + d]; const float f = lb + (1.f - lb) * sigm(bf2f(pr[2048])); G[c * 128 + d] = f; V[c * 128 + d] = bf2f(pr[2560]); }
    __syncthreads();
    float kk[64]; float glast = 0.f; const int d = tid & 127, vb = (tid >> 7) * 64;
    {
        float g = 0.f;
#pragma unroll
        for (int c = 0; c < 64; ++c) { const float f = G[c * 128 + d]; g += logf(f); kk[c] = g; }
        glast = g;
#pragma unroll
        for (int c = 0; c < 64; ++c) { const float f = G[c * 128 + d]; kk[c] = (1.f - f) * expf(glast - kk[c]); }
    }
    if (tid < 128) dec[(size_t)(bh * 128 + n) * 128 + d] = expf(glast);
    for (int v0 = 0; v0 < 64; v0 += 16) {
        float acc[16];
#pragma unroll
        for (int i = 0; i < 16; ++i) acc[i] = 0.f;
#pragma unroll
        for (int c = 0; c < 64; ++c) {
#pragma unroll
            for (int i = 0; i < 16; ++i) acc[i] += kk[c] * V[c * 128 + vb + v0 + i]; }
#pragma unroll
        for (int i = 0; i < 16; ++i) ds[((size_t)(bh * 128 + n) * 128 + d) * 128 + vb + v0 + i] = f2bf(acc[i]);
    }
}
__global__ void __launch_bounds__(256) k_scan(const bf16_t* ds, const float* dec, bf16_t* sp) {
    const int gid = blockIdx.x * 256 + threadIdx.x; const int bh = gid >> 14, d = (gid >> 7) & 127, v = gid & 127;
    float st = 0.f;
    for (int n = 0; n < 128; ++n) { const size_t o = ((size_t)(bh * 128 + n) * 128 + d) * 128 + v; const float x = bf2f(ds[o]); sp[o] = f2bf(st); st = dec[(size_t)(bh * 128 + n) * 128 + d] * st + x; }
}
constexpr int HC_LDS = (2 * 64 * 129 + 64 * 128 + 64 * 65) * 4;
__global__ void __launch_bounds__(256) k_hgC(const bf16_t* proj, const float* scal, const bf16_t* sp, const float* hgnorm, bf16_t* yb) {
    extern __shared__ float sm[];
    float* QT = sm; float* KT = QT + 64 * 129; float* V = KT + 64 * 129; float* As = V + 64 * 128;
    const int n = blockIdx.x, h = blockIdx.y, b = blockIdx.z, tid = threadIdx.x, tok0 = b * 8192 + n * 64, bh = b * 4 + h;
    for (int i = 0; i < 32; ++i) { const int idx = tid + 256 * i, c = idx >> 7, d = idx & 127; const bf16_t* pr = proj + (size_t)(tok0 + c) * 5632 + h * 128 + d;
        const float lb = scal[64 + h * 128 + d]; const float f = lb + (1.f - lb) * sigm(bf2f(pr[2048])); const float q = bf2f(pr[1536]);
        QT[c * 129 + d] = q * sigm(q); KT[c * 129 + d] = f; V[c * 128 + d] = bf2f(pr[2560]); }
    __syncthreads();
    if (tid < 128) { float g = 0.f; for (int c = 0; c < 64; ++c) { const float f = KT[c * 129 + tid]; g += logf(f); QT[c * 129 + tid] *= expf(g); KT[c * 129 + tid] = (1.f - f) * expf(-g); } }
    __syncthreads();
    const int c = tid >> 2, q4 = tid & 3;
    for (int i = 0; i < 16; ++i) { const int s = 4 * i + q4; float a = 0.f;
        if (s <= c) { for (int d = 0; d < 128; ++d) a += QT[c * 129 + d] * KT[s * 129 + d]; }
        As[c * 65 + s] = a; }
    __syncthreads();
    float o[32];
#pragma unroll
    for (int i = 0; i < 32; ++i) o[i] = 0.f;
    for (int s = 0; s < 64; ++s) { const float a = As[c * 65 + s];
#pragma unroll
        for (int i = 0; i < 32; ++i) o[i] += a * V[s * 128 + 32 * q4 + i]; }
    const bf16_t* spb = sp + (size_t)(bh * 128 + n) * 128 * 128;
    for (int d = 0; d < 128; ++d) { const float qv = QT[c * 129 + d];
#pragma unroll
        for (int i = 0; i < 32; ++i) o[i] += qv * bf2f(spb[d * 128 + 32 * q4 + i]); }
    float ss = 0.f;
#pragma unroll
    for (int i = 0; i < 32; ++i) ss += o[i] * o[i];
    ss += __shfl_xor(ss, 1); ss += __shfl_xor(ss, 2);
    const float rstd = rsqrtf(ss * (1.f / 128.f) + 1e-6f);
#pragma unroll
    for (int i = 0; i < 32; ++i) { const int v = 32 * q4 + i; const float g = bf2f(proj[(size_t)(tok0 + c) * 5632 + 3072 + h * 128 + v]);
        yb[(size_t)(tok0 + c) * 512 + h * 128 + v] = f2bf(o[i] * rstd * hgnorm[v] * (g * sigm(g))); }
}
__global__ void __launch_bounds__(256) k_x1(const float* x, const float* y, const float* w, const float* mod, long long goff, float* x1) {
    const int row = blockIdx.x * 4 + (threadIdx.x >> 6), lane = threadIdx.x & 63, b = row >> 13;
    const float* yr = y + (size_t)row * 1024; float v[16]; float ss = 0.f;
#pragma unroll
    for (int j = 0; j < 16; ++j) { v[j] = yr[lane + 64 * j]; ss += v[j] * v[j]; }
    ss = wave_sum(ss); const float rstd = rsqrtf(ss * (1.f / 1024.f) + 1e-6f);
#pragma unroll
    for (int j = 0; j < 16; ++j) { const int col = lane + 64 * j; x1[(size_t)row * 1024 + col] = x[(size_t)row * 1024 + col] + mod[b * 6144 + goff + col] * v[j] * rstd * w[col]; }
}
__global__ void __launch_bounds__(256) k_route(const float* x1, const float* w, const float* mod, const float* rw, const float* rb, int* topi, float* topw) {
    const int row = blockIdx.x * 4 + (threadIdx.x >> 6), lane = threadIdx.x & 63, b = row >> 13;
    const float* xr = x1 + (size_t)row * 1024; float v[16]; float ss = 0.f;
#pragma unroll
    for (int j = 0; j < 16; ++j) { v[j] = xr[lane + 64 * j]; ss += v[j] * v[j]; }
    ss = wave_sum(ss); const float rstd = rsqrtf(ss * (1.f / 1024.f) + 1e-6f);
    float lg[32];
#pragma unroll
    for (int e = 0; e < 32; ++e) lg[e] = 0.f;
#pragma unroll
    for (int j = 0; j < 16; ++j) { const int col = lane + 64 * j; const float h = v[j] * rstd * w[col] * (1.f + mod[b * 6144 + 4096 + col]) + mod[b * 6144 + 3072 + col];
#pragma unroll
        for (int e = 0; e < 32; ++e) lg[e] += h * rw[col * 32 + e]; }
#pragma unroll
    for (int e = 0; e < 32; ++e) lg[e] = wave_sum(lg[e]) + rb[e];
    int bi[4]; float bv[4];
#pragma unroll
    for (int k = 0; k < 4; ++k) { float best = -3.0e38f; int be = 0;
#pragma unroll
        for (int e = 0; e < 32; ++e) { bool taken = false;
#pragma unroll
            for (int q = 0; q < 4; ++q) if (q < k && bi[q] == e) taken = true;
            if (!taken && lg[e] > best) { best = lg[e]; be = e; } }
        bi[k] = be; bv[k] = best; }
    const float e1 = expf(bv[1] - bv[0]), e2 = expf(bv[2] - bv[0]), e3 = expf(bv[3] - bv[0]); const float inv = 1.f / (1.f + e1 + e2 + e3);
    if (lane == 0) { topi[row * 4 + 0] = bi[0]; topi[row * 4 + 1] = bi[1]; topi[row * 4 + 2] = bi[2]; topi[row * 4 + 3] = bi[3];
        topw[row * 4 + 0] = inv; topw[row * 4 + 1] = e1 * inv; topw[row * 4 + 2] = e2 * inv; topw[row * 4 + 3] = e3 * inv; }
}
__global__ void __launch_bounds__(256) k_lists(const int* topi, int* cnt, int* list) {
    const int a = blockIdx.x * 256 + threadIdx.x; const int e = topi[a]; const int pos = atomicAdd(&cnt[e], 1); list[(size_t)e * 32768 + pos] = a;
}
__global__ void k_pads(const int* cnt, int* pads) { if (threadIdx.x == 0) { int s = 0; for (int e = 0; e < 32; ++e) { pads[e] = s; s += ((cnt[e] + 255) / 256) * 256; } } }
__global__ void __launch_bounds__(256) k_final(float* out, const bf16_t* ym, const float* topw, const float* w, const float* mod) {
    const int row = blockIdx.x * 4 + (threadIdx.x >> 6), lane = threadIdx.x & 63, b = row >> 13;
    float v[16]; float ss = 0.f; const float w0 = topw[row * 4], w1 = topw[row * 4 + 1], w2 = topw[row * 4 + 2], w3 = topw[row * 4 + 3];
    const bf16_t* y0 = ym + (size_t)row * 4096;
#pragma unroll
    for (int j = 0; j < 16; ++j) { const int col = lane + 64 * j; v[j] = w0 * bf2f(y0[col]) + w1 * bf2f(y0[1024 + col]) + w2 * bf2f(y0[2048 + col]) + w3 * bf2f(y0[3072 + col]); ss += v[j] * v[j]; }
    ss = wave_sum(ss); const float rstd = rsqrtf(ss * (1.f / 1024.f) + 1e-6f);
#pragma unroll
    for (int j = 0; j < 16; ++j) { const int col = lane + 64 * j; out[(size_t)row * 1024 + col] += mod[b * 6144 + 5120 + col] * v[j] * rstd * w[col]; }
}
}
#define GAS __attribute__((address_space(1)))
#define LAS __attribute__((address_space(3)))
typedef GAS unsigned gu32;
#define RLX_AGENT __ATOMIC_RELAXED, __HIP_MEMORY_SCOPE_AGENT
#define XB_TMO      128
#define XB_XCNT(j)  (256  + 64 * (j))
#define XB_XSUB(j)  (1280 + 64 * (j))
#define XB_XGEN(j)  (2304 + 64 * (j))
#define XB_TOP      3328
#define XB_TOPGEN   3392
#define XCD_BAR_WORDS 3456
#define XB_SPIN_CAP (1u << 22)

__device__ __forceinline__ unsigned xb_ld(unsigned* p)              { return __hip_atomic_load(p, __ATOMIC_RELAXED, __HIP_MEMORY_SCOPE_AGENT); }
__device__ __forceinline__ unsigned xb_add(unsigned* p, unsigned v) { return __hip_atomic_fetch_add(p, v, __ATOMIC_RELAXED, __HIP_MEMORY_SCOPE_AGENT); }
__device__ __forceinline__ unsigned xb_xcc_id() { return (unsigned)__builtin_amdgcn_s_getreg((3 << 11) | 20) & 0xFu; }
#define XB_SPIN(cond, bar) do { unsigned _sp = 0; while (cond) { __builtin_amdgcn_s_sleep(1); \
    if ((++_sp & 255u) == 0u) { if (xb_ld(&(bar)[XB_TMO])) break; if (_sp > XB_SPIN_CAP) { atomicAdd(&(bar)[XB_TMO], 1u); break; } } } } while (0)

struct XcdBarrier {
    unsigned* bar; unsigned x;
    volatile LAS unsigned* st;
};
__device__ __forceinline__ XcdBarrier xcd_barrier_post(unsigned* bar, volatile LAS unsigned* st) {
    XcdBarrier b; b.bar = bar; b.x = xb_xcc_id(); b.st = st;
    if (threadIdx.x == 0) (void)xb_add(&bar[XB_XCNT(b.x)], 1u);
    return b;
}
__device__ __forceinline__ void xcd_barrier_complete(unsigned* bar, unsigned x, unsigned& nloc, unsigned& nx) {
    const unsigned G = gridDim.x * gridDim.y * gridDim.z;
    unsigned sum, cnt, mine, sp = 0u;
    for (;;) {
        sum = 0u; cnt = 0u; mine = 0u;
#pragma unroll
        for (unsigned j = 0; j < 16; ++j) { const unsigned c = xb_ld(&bar[XB_XCNT(j)]); sum += c; cnt += (c > 0u) ? 1u : 0u; mine = (j == x) ? c : mine; }
        if (sum == G) break;
        __builtin_amdgcn_s_sleep(1);
        if ((++sp & 255u) == 0u) { if (xb_ld(&bar[XB_TMO])) break; if (sp > XB_SPIN_CAP) { atomicAdd(&bar[XB_TMO], 1u); break; } }
    }
    nloc = mine > 0u ? mine : 1u; nx = cnt > 0u ? cnt : 1u;
}
__device__ __forceinline__ void xcd_barrier(const XcdBarrier& b) {
    asm volatile("s_waitcnt vmcnt(0)" ::: "memory");
    __syncthreads();
    if (threadIdx.x == 0) {
        unsigned* bar = b.bar;
        __builtin_amdgcn_s_waitcnt(0);
        unsigned nloc = b.st[0], nx = b.st[1];
        if (nloc == 0u) { xcd_barrier_complete(bar, b.x, nloc, nx); b.st[0] = nloc; b.st[1] = nx; }
        const unsigned old = xb_add(&bar[XB_XSUB(b.x)], 1u);
        const unsigned gen = old / nloc;
        if (old + 1u == (gen + 1u) * nloc) {
            __builtin_amdgcn_fence(__ATOMIC_RELEASE, "agent");
            asm volatile("s_waitcnt vmcnt(0)" ::: "memory");
            const unsigned og = xb_add(&bar[XB_TOP], 1u);
            const unsigned tg = og / nx;
            if (og + 1u == (tg + 1u) * nx) xb_add(&bar[XB_TOPGEN], 1u);
            else XB_SPIN(xb_ld(&bar[XB_TOPGEN]) == tg, bar);
            __builtin_amdgcn_fence(__ATOMIC_ACQUIRE, "agent");
            xb_add(&bar[XB_XGEN(b.x)], 1u);
            asm volatile("s_waitcnt vmcnt(0)" ::: "memory");
        } else {
            XB_SPIN(xb_ld(&bar[XB_XGEN(b.x)]) == gen, bar);
            __builtin_amdgcn_fence(__ATOMIC_ACQUIRE, "agent");
            asm volatile("s_waitcnt vmcnt(0)" ::: "memory");
        }
    }
    __syncthreads();
}
namespace pg8 {
#define PG8_LAS __attribute__((address_space(3)))
typedef short bf16x8 __attribute__((ext_vector_type(8)));
typedef float f32x4 __attribute__((ext_vector_type(4)));
typedef float f32x2 __attribute__((ext_vector_type(2)));
typedef unsigned u32x4 __attribute__((ext_vector_type(4)));
typedef unsigned u32x2 __attribute__((ext_vector_type(2)));
typedef int i32x4 __attribute__((ext_vector_type(4)));
typedef int i32x8 __attribute__((ext_vector_type(8)));
constexpr int BM = 256, BK = 64, HALF = 128, HTB = HALF * BK * 2  , STAGE_BYTES = 8 * HTB, NXCD = 8, WGM = 8;

__host__ __device__ __forceinline__ int lds_byte(int r, int c) { const int st = (r >> 4) * 2 + (c >> 5), rr = r & 15, cc = c & 31, ob = rr * 64 + cc * 2; return st * 1024 + (ob ^ (((ob >> 9) & 1) << 5)); }
__host__ __device__ __forceinline__ void stage_rc(int b, int& R, int& C) { const int st = b / 1024, sb = b % 1024, swz = sb ^ (((sb >> 9) & 1) << 5); R = (st >> 1) * 16 + swz / 64; C = (st & 1) * 32 + (swz % 64) / 2; }
__host__ __device__ __forceinline__ int perm32(int rho) { const int n = rho >> 4, i = rho & 15; return 8 * (i >> 2) + 4 * n + (i & 3); }

struct Unit { int pm, pn, z, arow, brow; };
struct Gemm { const bf16_t* A; const bf16_t* Bt; int K; const bf16_t* A2; const bf16_t* Bt2; };

struct DenseOrder {
    int nM, nN, nwg, G, c, wgm;
    __device__ void init(int M, int N, int G_, int c_, int wgm_ = WGM) { nM = M / BM; nN = N / BM; nwg = nM * nN; G = G_; c = c_; wgm = wgm_; }
    __device__ bool next(int i, Unit& u) const {
        const long L = (long)i * G + c; if (L >= nwg) return false;
        int wgid = (int)L; { const int q = nwg / NXCD, r = nwg % NXCD, xcd = wgid % NXCD, off = wgid / NXCD; wgid = (xcd < r ? xcd * (q + 1) : r * (q + 1) + (xcd - r) * q) + off; }
        const int nig = wgm * nN, gid = wgid / nig, fm = gid * wgm, gsz = (nM - fm) < wgm ? (nM - fm) : wgm;
        u.pm = fm + ((wgid % nig) % gsz); u.pn = (wgid % nig) / gsz; u.z = 0; u.arow = u.pm * BM; u.brow = u.pn * BM; return true;
    }
    __device__ __forceinline__ unsigned row_off(const Unit&, int) const { return 0u; }
};

struct DenseOrder2 { DenseOrder base;
    __device__ bool next(int i, Unit& u) const { if (!base.next(i >> 1, u)) return false; u.z = i & 1; return true; }
    __device__ __forceinline__ unsigned row_off(const Unit&, int) const { return 0u; }
};
__device__ __forceinline__ unsigned cvt_pk_bf16(float lo, float hi) { unsigned r; asm volatile("v_cvt_pk_bf16_f32 %0, %1, %2" : "=v"(r) : "v"(lo), "v"(hi)); return r; }


template <class Epi, class Sched, bool GATHER, bool TWOPART = false, bool FP8 = false>
__device__ __forceinline__ void gemm_phase(PG8_LAS unsigned char* lds, const Gemm g, const Sched& S, const Epi& E) {
    int tid_ = threadIdx.x; asm volatile("" : "+v"(tid_));
    const int tid = tid_, wid = __builtin_amdgcn_readfirstlane(tid >> 6), lane = tid & 63, wr = wid >> 2, wc = wid & 3, fr = lane & 15, fq = lane >> 4;
    const int K = g.K, nt = K / BK;
    unsigned voffA[2], voffB[2]; int RA[2];
#pragma unroll
    for (int i = 0; i < 2; ++i) { int R, C; stage_rc(tid * 16 + i * 8192, R, C); const int Rb = Epi::PERM ? ((R & ~31) + perm32(R & 31)) : R;
        RA[i] = R; voffA[i] = GATHER ? (unsigned)(C * 2) : (unsigned)(R * K + C) * 2u; voffB[i] = (unsigned)(Rb * K + C) * 2u; }
    const size_t kstep = (size_t)(BK * 2);
    const size_t hstep = (size_t)HALF * K * 2;
    const unsigned ldsw = (unsigned)wid * 1024u;
    const int aoff = lds_byte(wr * 64 + fr, fq * 8), boff = lds_byte(wc * 32 + fr, fq * 8);
    unsigned gAc[2][2], gAn[2][2];
#define PG8_SA(b, h) (((b) * 2 + (h)) * HTB)
#define PG8_SB(b, h) ((4 + (b) * 2 + (h)) * HTB)
#define PG8_STAGE(bufoff, gbase, voff) do { _Pragma("unroll") for (int _i = 0; _i < 2; ++_i) \
        __builtin_amdgcn_global_load_lds((const unsigned*)((const char*)(gbase) + (voff)[_i]), (PG8_LAS unsigned*)(lds + (bufoff) + ldsw + _i * 8192), 16, 0, 0); } while (0)
#define PG8_STAGEA(bufoff, gbase, h, nx) do { if constexpr (GATHER) { _Pragma("unroll") for (int _i = 0; _i < 2; ++_i) { const unsigned _v = ((nx) ? gAn[h][_i] : gAc[h][_i]) + voffA[_i]; \
        __builtin_amdgcn_global_load_lds((const unsigned*)((const char*)(gbase) + _v), (PG8_LAS unsigned*)(lds + (bufoff) + ldsw + _i * 8192), 16, 0, 0); } } \
        else { PG8_STAGE(bufoff, (const char*)(gbase) + (h) * hstep, voffA); } } while (0)
#define PG8_LD8(base) __builtin_shufflevector(*(const PG8_LAS i32x4*)(base), *(const PG8_LAS i32x4*)((base) + 1024), 0, 1, 2, 3, 4, 5, 6, 7)
#define PG8_LDA(dst, b, h) do { if constexpr (FP8) { _Pragma("unroll") for (int m = 0; m < 4; ++m) dst##8[m] = PG8_LD8(lds + PG8_SA(b, h) + aoff + m * 2048); } \
        else { _Pragma("unroll") for (int m = 0; m < 4; ++m) _Pragma("unroll") for (int k = 0; k < 2; ++k) dst[m][k] = *(const PG8_LAS bf16x8*)(lds + PG8_SA(b, h) + aoff + m * 2048 + k * 1024); } } while (0)
#define PG8_LDB(dst, b, h) do { if constexpr (FP8) { _Pragma("unroll") for (int n = 0; n < 2; ++n) dst##8[n] = PG8_LD8(lds + PG8_SB(b, h) + boff + n * 2048); } \
        else { _Pragma("unroll") for (int n = 0; n < 2; ++n) _Pragma("unroll") for (int k = 0; k < 2; ++k) dst[n][k] = *(const PG8_LAS bf16x8*)(lds + PG8_SB(b, h) + boff + n * 2048 + k * 1024); } } while (0)
#define PG8_CAT(x, y) __builtin_shufflevector(__builtin_bit_cast(i32x4, x), __builtin_bit_cast(i32x4, y), 0, 1, 2, 3, 4, 5, 6, 7)
#define PG8_MMA(ai, bj, At, Bt) do { __builtin_amdgcn_s_setprio(1); \
        if constexpr (FP8) { _Pragma("unroll") for (int m = 0; m < 4; ++m) _Pragma("unroll") for (int n = 0; n < 2; ++n) \
            asm volatile("v_mfma_scale_f32_16x16x128_f8f6f4 %0, %1, %2, %0, %3, %3 op_sel_hi:[0,0,0]" : "+v"(acc[ai][bj][m][n]) : "v"(Bt##8[n]), "v"(At##8[m]), "v"(one8)); } \
        else { _Pragma("unroll") for (int m = 0; m < 4; ++m) _Pragma("unroll") for (int n = 0; n < 2; ++n) _Pragma("unroll") for (int k = 0; k < 2; ++k) \
            acc[ai][bj][m][n] = __builtin_amdgcn_mfma_f32_16x16x32_bf16(Bt[n][k], At[m][k], acc[ai][bj][m][n], 0, 0, 0); } \
        __builtin_amdgcn_s_setprio(0); } while (0)
#define PG8_WAIT_V(n) asm volatile("s_waitcnt vmcnt(" #n ")" ::: "memory")
#define PG8_WAIT_L(n) asm volatile("s_waitcnt lgkmcnt(" #n ")" ::: "memory")
#define PG8_BAR __builtin_amdgcn_s_barrier()
#define PG8_SCHED __builtin_amdgcn_sched_barrier(0)
    Unit cur, nxt; int ui = 0;
    if (!S.next(0, cur)) return;
    f32x4 acc[2][2][4][2];
#pragma unroll
    for (int a = 0; a < 2; ++a)
#pragma unroll
        for (int b = 0; b < 2; ++b)
#pragma unroll
            for (int m = 0; m < 4; ++m)
#pragma unroll
                for (int n = 0; n < 2; ++n) acc[a][b][m][n] = (f32x4){0.f, 0.f, 0.f, 0.f};
    if constexpr (FP8) {
#pragma unroll
        for (int a = 0; a < 2; ++a)
#pragma unroll
            for (int b = 0; b < 2; ++b) asm volatile("s_nop 3" : "+v"(acc[a][b][0][0]), "+v"(acc[a][b][0][1]), "+v"(acc[a][b][1][0]), "+v"(acc[a][b][1][1]), "+v"(acc[a][b][2][0]), "+v"(acc[a][b][2][1]), "+v"(acc[a][b][3][0]), "+v"(acc[a][b][3][1]));
    }
    unsigned one8 = 0x7f7f7f7fu; asm volatile("" : "+v"(one8));
    bf16x8 At[4][2], B0[2][2], B1[2][2];
    i32x8 At8[4], B08[2], B18[2];
    const char* cA = GATHER ? (const char*)g.A : (const char*)((TWOPART && cur.z) ? g.A2 : g.A) + (size_t)cur.arow * K * 2; const char* cB = (const char*)((TWOPART && cur.z) ? g.Bt2 : g.Bt) + (size_t)cur.brow * K * 2;
    if constexpr (GATHER) {
#pragma unroll
        for (int h = 0; h < 2; ++h)
#pragma unroll
            for (int i = 0; i < 2; ++i) { gAc[h][i] = S.row_off(cur, h * HALF + RA[i]); gAn[h][i] = gAc[h][i]; }
    }
    PG8_STAGE(PG8_SB(0, 0), cB, voffB); PG8_STAGE(PG8_SB(0, 1), cB + hstep, voffB); PG8_STAGEA(PG8_SA(0, 0), cA, 0, false); PG8_STAGEA(PG8_SA(0, 1), cA, 1, false);
    if (wr == 1) PG8_BAR;
    PG8_WAIT_V(2); PG8_BAR;
    PG8_STAGE(PG8_SB(1, 0), cB + kstep, voffB); PG8_STAGEA(PG8_SA(1, 0), cA + kstep, 0, false); PG8_STAGE(PG8_SB(1, 1), cB + hstep + kstep, voffB);
    PG8_WAIT_V(6); PG8_BAR;
    for (;;) {
        const bool has_next = S.next(ui + 1, nxt);
        const char* nA = has_next ? (GATHER ? (const char*)g.A : (const char*)((TWOPART && nxt.z) ? g.A2 : g.A) + (size_t)nxt.arow * K * 2) : cA; const char* nB = has_next ? (const char*)((TWOPART && nxt.z) ? g.Bt2 : g.Bt) + (size_t)nxt.brow * K * 2 : cB;
        if constexpr (GATHER) { if (has_next) {
#pragma unroll
            for (int h = 0; h < 2; ++h)
#pragma unroll
                for (int i = 0; i < 2; ++i) gAn[h][i] = S.row_off(nxt, h * HALF + RA[i]); } }
#ifndef PROBE_KDUP
#define PROBE_KDUP 1
#endif
        constexpr int KD_ = TWOPART ? 1 : PROBE_KDUP;
#pragma unroll 1
        for (int tt = 0; tt < nt * KD_; tt += 2) {
            const int t = tt % nt; const bool lastp = (tt >= nt * (KD_ - 1));
            if (KD_ > 1 && t == 0 && tt > 0) {
#pragma unroll
                for (int a = 0; a < 2; ++a)
#pragma unroll
                    for (int b = 0; b < 2; ++b)
#pragma unroll
                        for (int m = 0; m < 4; ++m)
#pragma unroll
                            for (int n = 0; n < 2; ++n) { acc[a][b][m][n] = (f32x4){0.f, 0.f, 0.f, 0.f}; asm volatile("s_nop 3" : "+v"(acc[a][b][m][n])); } }
            const bool wrap = (t == nt - 2); const bool last = wrap && lastp;
            const char* a1 = cA + (size_t)(t + 1) * kstep;
            const char* a2 = wrap ? (lastp ? nA : cA) : cA + (size_t)(t + 2) * kstep; const char* b2 = wrap ? (lastp ? nB : cB) : cB + (size_t)(t + 2) * kstep;
            const char* a3 = a2 + kstep; const char* b3 = b2 + kstep;
            PG8_LDB(B0, 0, 0); PG8_LDB(B1, 0, 1); PG8_SCHED; PG8_LDA(At, 0, 0); PG8_STAGEA(PG8_SA(1, 1), a1, 1, false);
            PG8_WAIT_V(8); PG8_WAIT_L(0); PG8_BAR; PG8_MMA(0, 0, At, B0); PG8_MMA(0, 1, At, B1); PG8_BAR; PG8_SCHED;
            PG8_LDA(At, 0, 1); PG8_STAGE(PG8_SB(0, 0), b2, voffB); PG8_STAGE(PG8_SB(0, 1), b2 + hstep, voffB); PG8_STAGEA(PG8_SA(0, 0), a2, 0, last);
            PG8_WAIT_V(8); PG8_WAIT_L(0); PG8_BAR; PG8_MMA(1, 0, At, B0); PG8_MMA(1, 1, At, B1); PG8_BAR; PG8_SCHED;
            PG8_LDB(B0, 1, 0); PG8_LDB(B1, 1, 1); PG8_SCHED; PG8_LDA(At, 1, 0); PG8_STAGEA(PG8_SA(0, 1), a2, 1, last);
            PG8_WAIT_V(8); PG8_WAIT_L(0); PG8_BAR; PG8_MMA(0, 0, At, B0); PG8_MMA(0, 1, At, B1); PG8_BAR; PG8_SCHED;
            PG8_LDA(At, 1, 1); PG8_STAGE(PG8_SB(1, 0), b3, voffB); PG8_STAGE(PG8_SB(1, 1), b3 + hstep, voffB); PG8_STAGEA(PG8_SA(1, 0), a3, 0, last);
            PG8_WAIT_V(8); PG8_WAIT_L(0); PG8_BAR; PG8_MMA(1, 0, At, B0); PG8_MMA(1, 1, At, B1); PG8_BAR; PG8_SCHED;
        }
        if constexpr (FP8) asm volatile("s_nop 15\n\ts_nop 15" ::: "memory");
        if (wr == 0) PG8_BAR;
        const bool keep = E(acc, cur, wr, wc, fr, fq);
        if (!has_next) break;
        if (!(TWOPART && keep))
#pragma unroll
        for (int a = 0; a < 2; ++a)
#pragma unroll
            for (int b = 0; b < 2; ++b)
#pragma unroll
                for (int m = 0; m < 4; ++m)
#pragma unroll
                    for (int n = 0; n < 2; ++n) acc[a][b][m][n] = (f32x4){0.f, 0.f, 0.f, 0.f};
        if constexpr (FP8) {
#pragma unroll
        for (int a = 0; a < 2; ++a)
#pragma unroll
            for (int b = 0; b < 2; ++b) asm volatile("s_nop 3" : "+v"(acc[a][b][0][0]), "+v"(acc[a][b][0][1]), "+v"(acc[a][b][1][0]), "+v"(acc[a][b][1][1]), "+v"(acc[a][b][2][0]), "+v"(acc[a][b][2][1]), "+v"(acc[a][b][3][0]), "+v"(acc[a][b][3][1]));
    }
        cur = nxt; cA = nA; cB = nB; ++ui;
        if constexpr (GATHER) {
#pragma unroll
            for (int h = 0; h < 2; ++h)
#pragma unroll
                for (int i = 0; i < 2; ++i) gAc[h][i] = gAn[h][i];
        }
        if (wr == 1) PG8_BAR;
    }
    PG8_WAIT_V(0);
    PG8_BAR;
#undef PG8_SA
#undef PG8_SB
#undef PG8_STAGE
#undef PG8_STAGEA
#undef PG8_LDA
#undef PG8_LDB
#undef PG8_MMA
#undef PG8_CAT
#undef PG8_LD8
#undef PG8_WAIT_V
#undef PG8_WAIT_L
#undef PG8_BAR
#undef PG8_SCHED
}
}
namespace at {
typedef short bf16x8 __attribute__((ext_vector_type(8)));
typedef short s16x4 __attribute__((ext_vector_type(4)));
typedef float f32x16 __attribute__((ext_vector_type(16)));
typedef unsigned u32x4 __attribute__((ext_vector_type(4)));
typedef __attribute__((address_space(3))) const char* lds_cptr;
typedef short v4i16_t __attribute__((ext_vector_type(4)));
constexpr int SLOT = 32768, L_WSF = 4 * SLOT + 2048;
constexpr float C2 = 0.125f * 1.4426950408889634f;
__device__ __forceinline__ int crow(int r, int hi) { return (r & 3) + 8 * (r >> 2) + 4 * hi; }
__device__ __forceinline__ void glds16(const void* gsrc, unsigned lds_dst) { unsigned keep;
    asm volatile("s_mov_b32 %0, m0\n\ts_mov_b32 m0, %2\n\ts_nop 0\n\tglobal_load_lds_dwordx4 %1, off\n\ts_mov_b32 m0, %0" : "=&s"(keep) : "v"(gsrc), "s"(lds_dst) : "memory"); }
typedef float f32x2_t __attribute__((ext_vector_type(2))); typedef __bf16 bf16x2_t __attribute__((ext_vector_type(2)));
__device__ __forceinline__ unsigned cvtpk(float lo, float hi) { f32x2_t v = {lo, hi}; bf16x2_t b = __builtin_convertvector(v, bf16x2_t); return __builtin_bit_cast(unsigned, b); }
__device__ __forceinline__ s16x4 vtr(lds_cptr p) { return __builtin_bit_cast(s16x4, __builtin_amdgcn_ds_read_tr16_b64_v4i16((__attribute__((address_space(3))) v4i16_t*)p)); }
#define AT_WAIT_BAR(N) asm volatile("s_waitcnt vmcnt(" #N ") lgkmcnt(0)\n\ts_barrier" ::: "memory")

__device__ __forceinline__ void attn_unit(__attribute__((address_space(3))) unsigned char* lds, const bf16_t* QR, const bf16_t* KIMG, const bf16_t* VIMG, bf16_t* YA, const float* subln, float lam, const unsigned* KMAX,
                                          int b, int h, int blk, int tid) {
    typedef __attribute__((address_space(3))) float lds_f;
    asm volatile("" : "+v"(tid));
    const int lane = tid & 63, r32 = lane & 31, hi = lane >> 5; const int w = __builtin_amdgcn_readfirstlane(tid >> 6), m = w & 1, rg = w >> 1;
    const int NT = 2 * blk + 2, bh = b * 4 + h;
    const size_t tokb = (size_t)b * 8192;
    const unsigned lds0 = (unsigned)(size_t)lds;
    const bf16_t* ksrc0 = KIMG + ((size_t)bh * 128 * 16 + 2 * w) * 512 + lane * 8;
    const bf16_t* vsrc0 = VIMG + ((size_t)bh * 128 * 16 + 2 * w) * 512 + lane * 8;
#define AT_DMA(t, slotoff) do { const bf16_t* ks_ = ksrc0 + (size_t)(t) * 8192; const bf16_t* vs_ = vsrc0 + (size_t)(t) * 8192; \
        const unsigned kd_ = (unsigned)__builtin_amdgcn_readfirstlane(lds0 + (unsigned)(slotoff) + (unsigned)w * 2048u); \
        glds16(ks_, kd_); glds16(ks_ + 512, kd_ + 1024u); glds16(vs_, kd_ + 16384u); glds16(vs_ + 512, kd_ + 16384u + 1024u); } while (0)
#define AT_QK(P0, P1, slotoff) do { const lds_cptr kp_ = (lds_cptr)(lds + (slotoff)) + (m * 8 + hi) * 1024 + r32 * 16; \
        _Pragma("unroll") for (int d0 = 0; d0 < 4; ++d0) { const bf16x8 k0 = *(const __attribute__((address_space(3))) bf16x8*)(kp_ + d0 * 2048), k1 = *(const __attribute__((address_space(3))) bf16x8*)(kp_ + d0 * 2048 + 512); \
            P0 = __builtin_amdgcn_mfma_f32_32x32x16_bf16(k0, qr[d0], d0 == 0 ? negm : P0, 0, 0, 0); P1 = __builtin_amdgcn_mfma_f32_32x32x16_bf16(k1, qr[d0], d0 == 0 ? negm : P1, 0, 0, 0); } } while (0)
    bf16x8 qr[4];
    { const bf16_t* qp = QR + ((((size_t)(b * 4 + h) * 128 + blk * 2 + (rg >> 1)) * 16 + m * 8 + hi) * 64 + (rg & 1) * 32 + r32) * 8;
#pragma unroll
      for (int d0 = 0; d0 < 4; ++d0) qr[d0] = *(const bf16x8*)(qp + (size_t)d0 * 1024); }
    AT_DMA(0, 0); AT_DMA(1, SLOT); if (NT > 2) AT_DMA(2, 2 * SLOT);
    f32x16 o[4];
#pragma unroll
    for (int i = 0; i < 4; ++i) o[i] = f32x16{};
    float lsum = 0.f; f32x16 negm;
    float mhat;
    { float qs = 0.f;
#pragma unroll
      for (int d0 = 0; d0 < 4; ++d0)
#pragma unroll
          for (int j = 0; j < 8; ++j) { const float qv = __uint_as_float(((unsigned)(unsigned short)qr[d0][j]) << 16); qs += qv * qv; }
      auto rr = __builtin_amdgcn_permlane32_swap(__float_as_uint(qs), __float_as_uint(qs), false, false); qs = __uint_as_float(rr[0]) + __uint_as_float(rr[1]);
      float k2 = 0.f;
#pragma unroll
      for (int gq = 0; gq < 8; ++gq) k2 += __uint_as_float(KMAX[(bh * 2 + m) * 8 + gq]);
      mhat = 1.01f * sqrtf(qs * k2);
#pragma unroll
      for (int r = 0; r < 16; ++r) negm[r] = -mhat; }
    lds_f* wsf = (lds_f*)(lds + L_WSF) + w * 32;
    f32x16 pA0, pA1, pB0 = f32x16{}, pB1 = f32x16{};
    if (NT > 2) { AT_WAIT_BAR(8); } else { AT_WAIT_BAR(4); }
    AT_QK(pA0, pA1, 0);
    int s0 = 0, s1 = SLOT, s3 = 3 * SLOT;
    const int vlane = ((lane >> 4) & 1) * 32 + (lane & 3) * 8 + (4 * hi + ((lane & 15) >> 2)) * 64;
#define AT_VLOAD(VF, i) do { _Pragma("unroll") for (int k2 = 0; k2 < 2; ++k2) { const int off_ = ((i) >> 1) * 4096 + (((i) & 1) * 2 + k2) * 1024; const s16x4 lo_ = vtr(vp_ + off_), hi_ = vtr(vp_ + off_ + 512); \
        VF[k2] = (bf16x8){lo_[0], lo_[1], lo_[2], lo_[3], hi_[0], hi_[1], hi_[2], hi_[3]}; } } while (0)
#define AT_PVMMA(VF, i) do { _Pragma("unroll") for (int k2 = 0; k2 < 2; ++k2) o[(i) >> 1] = __builtin_amdgcn_mfma_f32_32x32x16_bf16(pa[k2], VF[k2], o[(i) >> 1], 0, 0, 0); } while (0)
#define AT_SB() __builtin_amdgcn_sched_barrier(0)
#define AT_STEP(PC0, PC1, PN0, PN1, DOQK, DOSM) do { AT_SB(); \
        bf16x8 kf[4]; const lds_cptr kp_ = (lds_cptr)(lds + s1) + (m * 8 + hi) * 1024 + r32 * 16; \
        if (DOQK) { _Pragma("unroll") for (int d0 = 0; d0 < 2; ++d0) { kf[2 * d0] = *(const __attribute__((address_space(3))) bf16x8*)(kp_ + d0 * 2048); kf[2 * d0 + 1] = *(const __attribute__((address_space(3))) bf16x8*)(kp_ + d0 * 2048 + 512); } } \
        const lds_cptr vp_ = (lds_cptr)(lds + s0 + 16384) + vlane; bf16x8 vfa[2], vfb[2]; \
        if (DOSM) AT_VLOAD(vfa, 0); \
        if (DOQK) { \
            PN0 = __builtin_amdgcn_mfma_f32_32x32x16_bf16(kf[0], qr[0], negm, 0, 0, 0); PN1 = __builtin_amdgcn_mfma_f32_32x32x16_bf16(kf[1], qr[0], negm, 0, 0, 0); \
            PN0 = __builtin_amdgcn_mfma_f32_32x32x16_bf16(kf[2], qr[1], PN0, 0, 0, 0); PN1 = __builtin_amdgcn_mfma_f32_32x32x16_bf16(kf[3], qr[1], PN1, 0, 0, 0); \
            _Pragma("unroll") for (int d0 = 0; d0 < 2; ++d0) { kf[2 * d0] = *(const __attribute__((address_space(3))) bf16x8*)(kp_ + (d0 + 2) * 2048); kf[2 * d0 + 1] = *(const __attribute__((address_space(3))) bf16x8*)(kp_ + (d0 + 2) * 2048 + 512); } \
            PN0 = __builtin_amdgcn_mfma_f32_32x32x16_bf16(kf[0], qr[2], PN0, 0, 0, 0); PN1 = __builtin_amdgcn_mfma_f32_32x32x16_bf16(kf[1], qr[2], PN1, 0, 0, 0); \
            PN0 = __builtin_amdgcn_mfma_f32_32x32x16_bf16(kf[2], qr[3], PN0, 0, 0, 0); PN1 = __builtin_amdgcn_mfma_f32_32x32x16_bf16(kf[3], qr[3], PN1, 0, 0, 0); } \
        if (DOSM) { \
            float sacc = 0.f; bf16x8 pa[2]; \
            _Pragma("unroll") for (int r = 0; r < 16; ++r) { PC0[r] = __builtin_amdgcn_exp2f(PC0[r]); sacc += PC0[r]; } \
            pa[0] = __builtin_bit_cast(bf16x8, (u32x4){cvtpk(PC0[0], PC0[1]), cvtpk(PC0[2], PC0[3]), cvtpk(PC0[4], PC0[5]), cvtpk(PC0[6], PC0[7])}); \
            pa[1] = __builtin_bit_cast(bf16x8, (u32x4){cvtpk(PC0[8], PC0[9]), cvtpk(PC0[10], PC0[11]), cvtpk(PC0[12], PC0[13]), cvtpk(PC0[14], PC0[15])}); \
            AT_VLOAD(vfb, 2); AT_PVMMA(vfa, 0); AT_VLOAD(vfa, 4); AT_PVMMA(vfb, 2); AT_VLOAD(vfb, 6); AT_PVMMA(vfa, 4); AT_VLOAD(vfa, 1); AT_PVMMA(vfb, 6); \
            _Pragma("unroll") for (int r = 0; r < 16; ++r) { PC1[r] = __builtin_amdgcn_exp2f(PC1[r]); sacc += PC1[r]; } \
            lsum += sacc; asm volatile("" : "+v"(lsum)); \
            pa[0] = __builtin_bit_cast(bf16x8, (u32x4){cvtpk(PC1[0], PC1[1]), cvtpk(PC1[2], PC1[3]), cvtpk(PC1[4], PC1[5]), cvtpk(PC1[6], PC1[7])}); \
            pa[1] = __builtin_bit_cast(bf16x8, (u32x4){cvtpk(PC1[8], PC1[9]), cvtpk(PC1[10], PC1[11]), cvtpk(PC1[12], PC1[13]), cvtpk(PC1[14], PC1[15])}); \
            AT_VLOAD(vfb, 3); AT_PVMMA(vfa, 1); AT_VLOAD(vfa, 5); AT_PVMMA(vfb, 3); AT_VLOAD(vfb, 7); AT_PVMMA(vfa, 5); AT_PVMMA(vfb, 7); } \
        AT_SB(); \
        s0 = s1; s1 = (s1 == 3 * SLOT) ? 0 : s1 + SLOT; s3 = (s3 == 3 * SLOT) ? 0 : s3 + SLOT; \
    } while (0)
    for (int t = 0; t + 2 < NT; t += 2) {
        AT_WAIT_BAR(4); if (t + 3 < NT) AT_DMA(t + 3, s3);
        AT_STEP(pA0, pA1, pB0, pB1, true, true);
        AT_WAIT_BAR(4); if (t + 4 < NT) AT_DMA(t + 4, s3);
        AT_STEP(pB0, pB1, pA0, pA1, true, true);
    }
    if (rg < 2) {
#pragma unroll
        for (int r = 0; r < 16; ++r) negm[r] = -1e30f; }
    AT_WAIT_BAR(0);
    AT_STEP(pA0, pA1, pB0, pB1, true, true);
    AT_WAIT_BAR(0);
    AT_STEP(pB0, pB1, pA0, pA1, false, true);
    AT_WAIT_BAR(0);
    { auto rr = __builtin_amdgcn_permlane32_swap(__float_as_uint(lsum), __float_as_uint(lsum), false, false); lsum = __uint_as_float(rr[0]) + __uint_as_float(rr[1]); }
    if (hi == 0) wsf[r32] = (m == 0 ? 1.f : -lam) / lsum;
    asm volatile("s_waitcnt lgkmcnt(0)" ::: "memory");
#pragma unroll
    for (int r = 0; r < 16; ++r) { const float fr_ = wsf[crow(r, hi)];
#pragma unroll
        for (int d = 0; d < 4; ++d) o[d][r] *= fr_; }
    AT_WAIT_BAR(0);
    lds_f* X = (lds_f*)lds + rg * 4096;
    if (m == 1) {
#pragma unroll
        for (int d = 0; d < 4; ++d)
#pragma unroll
            for (int r = 0; r < 16; ++r) X[(d * 16 + r) * 64 + lane] = o[d][r];
    }
    AT_WAIT_BAR(0);
    if (m == 0) {
        float ssq[16];
#pragma unroll
        for (int r = 0; r < 16; ++r) { float s = 0.f;
#pragma unroll
            for (int d = 0; d < 4; ++d) { o[d][r] += X[(d * 16 + r) * 64 + lane]; s += o[d][r] * o[d][r]; }
            ssq[r] = s; }
#pragma unroll
        for (int r = 0; r < 16; ++r) { float s = ssq[r];
#pragma unroll
            for (int of = 1; of < 32; of <<= 1) s += __shfl_xor(s, of);
            ssq[r] = rsqrtf(s * (1.f / 128.f) + 1e-6f) * 0.8f; }
        float sw[4];
#pragma unroll
        for (int d = 0; d < 4; ++d) sw[d] = subln[d * 32 + r32];
        bf16_t* yp = YA + (tokb + blk * 128 + rg * 32) * 512 + h * 128 + r32;
#pragma unroll
        for (int r = 0; r < 16; ++r)
#pragma unroll
            for (int d = 0; d < 4; ++d) yp[(size_t)crow(r, hi) * 512 + d * 32] = f2bf(o[d][r] * ssq[r] * sw[d]);
    }
    AT_WAIT_BAR(0);
#undef AT_DMA
#undef AT_QK
#undef AT_STEP
#undef AT_SB
#undef AT_VLOAD
#undef AT_PVMMA
}
}
namespace hg {
using at::bf16x8; using at::s16x4; using at::f32x16; using at::u32x4; using at::lds_cptr; using at::crow; using at::vtr; using at::cvtpk;
typedef __attribute__((address_space(3))) unsigned char lds_u8;
typedef __attribute__((address_space(3))) float lds_f;
typedef __attribute__((address_space(3))) bf16_t lds_h;
__device__ __forceinline__ float sigm(float x) { return __builtin_amdgcn_rcpf(1.f + __expf(-x)); }
__device__ __forceinline__ bf16x8 mkfrag(s16x4 a, s16x4 b) { return (bf16x8){a[0], a[1], a[2], a[3], b[0], b[1], b[2], b[3]}; }
template <int ROWS>
__device__ __forceinline__ void copy_img(lds_u8* lds, int off, const bf16_t* g, size_t gp, int tid) {
#pragma unroll
    for (int i = 0; i < ROWS * 16 / 512; ++i) { const int p = tid + 512 * i, r = p >> 4, q = p & 15;
        const u32x4 v = *(const u32x4*)(g + (size_t)r * gp + q * 8);
        *(__attribute__((address_space(3))) u32x4*)(lds + off + (q >> 2) * (ROWS * 64) + r * 64 + (q & 3) * 16) = v; }
}
__device__ __forceinline__ void copy_raw(lds_u8* lds, int off, const bf16_t* g, size_t gp, int tid) {
#pragma unroll
    for (int i = 0; i < 2; ++i) { const int p = tid + 512 * i, r = p >> 4, q = p & 15;
        const u32x4 v = *(const u32x4*)(g + (size_t)r * gp + q * 8);
        *(__attribute__((address_space(3))) u32x4*)(lds + off + r * 256 + q * 16) = v; }
}
struct ARegs { u32x4 v[2], rf[2]; };
struct CRegs { u32x4 v[2], sp[4], gs[4], rf[2], rq[2]; float pd[4]; };
__device__ __forceinline__ void ld_tile64(u32x4 (&r)[2], const bf16_t* g, size_t gp, int tid) {
#pragma unroll
    for (int i = 0; i < 2; ++i) { const int p = tid + 512 * i; r[i] = *(const u32x4*)(g + (size_t)(p >> 4) * gp + (p & 15) * 8); } }
__device__ __forceinline__ void st_img64(lds_u8* lds, int off, const u32x4 (&r)[2], int tid) {
#pragma unroll
    for (int i = 0; i < 2; ++i) { const int p = tid + 512 * i, rr = p >> 4, q = p & 15; *(__attribute__((address_space(3))) u32x4*)(lds + off + (q >> 2) * 4096 + rr * 64 + (q & 3) * 16) = r[i]; } }
__device__ __forceinline__ void st_raw64(lds_u8* lds, int off, const u32x4 (&r)[2], int tid) {
#pragma unroll
    for (int i = 0; i < 2; ++i) { const int p = tid + 512 * i; *(__attribute__((address_space(3))) u32x4*)(lds + off + (p >> 4) * 256 + (p & 15) * 16) = r[i]; } }
__device__ __forceinline__ void hgA_load(ARegs& R, const bf16_t* PROJ, int bh, int n, int tid) {
    const size_t tok0 = (size_t)(bh >> 2) * 8192 + n * 64; const int h = bh & 3;
    ld_tile64(R.v, PROJ + tok0 * 5632 + 2560 + h * 128, 5632, tid); ld_tile64(R.rf, PROJ + tok0 * 5632 + 2048 + h * 128, 5632, tid); }
__device__ __forceinline__ void hgC_load(CRegs& R, const bf16_t* PROJ, const bf16_t* SP, const bf16_t* GS, const float* PD, int bh, int n, int tid) {
    const size_t tok0 = (size_t)(bh >> 2) * 8192 + n * 64; const int h = bh & 3;
    ld_tile64(R.v, PROJ + tok0 * 5632 + 2560 + h * 128, 5632, tid); ld_tile64(R.rf, PROJ + tok0 * 5632 + 2048 + h * 128, 5632, tid); ld_tile64(R.rq, PROJ + tok0 * 5632 + 1536 + h * 128, 5632, tid);
    const bf16_t* sp = SP + (size_t)(bh * 128 + n) * 16384; const bf16_t* gs = GS + (size_t)(bh * 16 + (n >> 3)) * 16384; const float* pd = PD + (size_t)(bh * 128 + n) * 128;
#pragma unroll
    for (int i = 0; i < 4; ++i) { const int p = tid + 512 * i; R.sp[i] = __builtin_nontemporal_load((const u32x4*)(sp + (size_t)(p >> 4) * 128 + (p & 15) * 8)); R.gs[i] = *(const u32x4*)(gs + (size_t)(p >> 4) * 128 + (p & 15) * 8); R.pd[i] = pd[p >> 4]; } }
__device__ __forceinline__ void gates(lds_u8* lds, int psum_off, int rawf_off, float lb, int tid, float (&f)[16], float (&G)[16], float& glast) {
    const int d = tid & 127, part = tid >> 7; lds_f* psum = (lds_f*)(lds + psum_off); const lds_h* rf = (const lds_h*)(lds + rawf_off) + part * 16 * 128 + d;
    float g = 0.f;
#pragma unroll
    for (int i = 0; i < 16; ++i) { const float raw = bf2f(rf[i * 128]); f[i] = lb + (1.f - lb) * sigm(raw); g += __logf(f[i]); G[i] = g; }
    psum[part * 128 + d] = g;
    __syncthreads();
    const float p0 = psum[d], p1 = psum[128 + d], p2 = psum[256 + d], p3 = psum[384 + d];
    const float offs = (part > 0 ? p0 : 0.f) + (part > 1 ? p1 : 0.f) + (part > 2 ? p2 : 0.f);
    glast = (p0 + p1) + (p2 + p3);
#pragma unroll
    for (int i = 0; i < 16; ++i) G[i] += offs;
}
constexpr int A_KD = 0, A_V = 16384, A_PS = 32768, A_DECL = 32768 + 2048, A_RAWF = 36864, A_OUT = 53248;
__device__ __forceinline__ void hgA_unit(lds_u8* lds, ARegs& R, const bf16_t* PROJ, const float* SCAL, bf16_t* SPL, float* PD, f32x16 (&acc)[2], float& pdec, int bh, int n, bool has_next, int tid) {
    const int h = bh & 3, lane = tid & 63, r32 = lane & 31, hi = lane >> 5, w = __builtin_amdgcn_readfirstlane(tid >> 6), d = tid & 127, part = tid >> 7;
    __syncthreads();
    st_img64(lds, A_V, R.v, tid); st_raw64(lds, A_RAWF, R.rf, tid);
    if (has_next) hgA_load(R, PROJ, bh, n + 1, tid);
    __syncthreads();
    float f[16], G[16], glast;
    gates(lds, A_PS, A_RAWF, SCAL[64 + h * 128 + d], tid, f, G, glast);
    lds_h* kd = (lds_h*)(lds + A_KD) + (d >> 5) * 2048 + (d & 31);
#pragma unroll
    for (int i = 0; i < 16; ++i) kd[(part * 16 + i) * 32] = f2bf((1.f - f[i]) * __expf(glast - G[i]));
    if (part == 0) { const float dc = __expf(glast); PD[(size_t)(bh * 128 + n) * 128 + d] = pdec; pdec *= dc; ((lds_f*)(lds + A_DECL))[d] = dc; }
    __syncthreads();
    const int dt = w >> 1, vh = w & 1;
    lds_h* ot = (lds_h*)(lds + A_OUT) + (dt * 32) * 128 + vh * 64 + r32;
#pragma unroll
    for (int t = 0; t < 2; ++t)
#pragma unroll
        for (int r = 0; r < 16; ++r) ot[crow(r, hi) * 128 + t * 32] = f2bf(acc[t][r]);
    { const lds_f* dl = (const lds_f*)(lds + A_DECL) + dt * 32;
#pragma unroll
      for (int r = 0; r < 16; ++r) { const float dr = dl[crow(r, hi)]; acc[0][r] *= dr; acc[1][r] *= dr; } }
    const int lof = ((lane >> 4) & 1) * 32 + (lane & 3) * 8 + (8 * hi + ((lane & 15) >> 2)) * 64;
    const lds_cptr ap = (lds_cptr)(lds + A_KD) + dt * 4096 + lof;
#pragma unroll
    for (int ks = 0; ks < 4; ++ks) { const bf16x8 af = mkfrag(vtr(ap + ks * 1024), vtr(ap + ks * 1024 + 256));
#pragma unroll
        for (int t = 0; t < 2; ++t) { const lds_cptr bp = (lds_cptr)(lds + A_V) + (2 * vh + t) * 4096 + lof;
            const bf16x8 bfr = mkfrag(vtr(bp + ks * 1024), vtr(bp + ks * 1024 + 256));
            acc[t] = __builtin_amdgcn_mfma_f32_32x32x16_bf16(af, bfr, acc[t], 0, 0, 0); } }
    __syncthreads();
    bf16_t* dst = SPL + (size_t)(bh * 128 + n) * 16384;
#pragma unroll
    for (int i = 0; i < 4; ++i) { const int p = tid + 512 * i; *(u32x4*)(dst + p * 8) = *(const __attribute__((address_space(3))) u32x4*)(lds + A_OUT + p * 16); }
}
__device__ __forceinline__ void hgA_group(lds_u8* lds, const bf16_t* PROJ, const float* SCAL, bf16_t* SPL, float* PD, float* TG, float* DG, int bh, int g, int tid) {
    const int lane = tid & 63, r32 = lane & 31, hi = lane >> 5, w = __builtin_amdgcn_readfirstlane(tid >> 6), d = tid & 127, part = tid >> 7, dt = w >> 1, vh = w & 1;
    ARegs R; hgA_load(R, PROJ, bh, 8 * g, tid);
    f32x16 acc[2] = {f32x16{}, f32x16{}}; float pdec = 1.f;
#pragma unroll 1
    for (int k = 0; k < 8; ++k) hgA_unit(lds, R, PROJ, SCAL, SPL, PD, acc, pdec, bh, 8 * g + k, k < 7, tid);
    float* tg = TG + (size_t)(bh * 16 + g) * 16384 + (size_t)(dt * 32) * 128 + vh * 64 + r32;
#pragma unroll
    for (int t = 0; t < 2; ++t)
#pragma unroll
        for (int r = 0; r < 16; ++r) tg[crow(r, hi) * 128 + t * 32] = acc[t][r];
    if (part == 0) DG[(bh * 16 + g) * 128 + d] = pdec;
}
constexpr int C_QT = 0, C_KT = 16384, C_V = 32768, C_SP = 49152, C_PS = 81920, C_RAWF = 86016, C_RAWQ = 102400, C_OT = 86016;
__device__ __forceinline__ void hgC_unit(lds_u8* lds, CRegs& R, const bf16_t* PROJ, const float* SCAL, const bf16_t* SP, const bf16_t* GS, const float* PD, const float* hgnorm, bf16_t* YB, int bh, int n, int nbh, int nn, int tid) {
    const int h = bh & 3, b = bh >> 2, lane = tid & 63, r32 = lane & 31, hi = lane >> 5, w = __builtin_amdgcn_readfirstlane(tid >> 6), d = tid & 127, part = tid >> 7;
    const size_t tok0 = (size_t)b * 8192 + n * 64;
    __syncthreads();
    st_img64(lds, C_V, R.v, tid); st_raw64(lds, C_RAWF, R.rf, tid); st_raw64(lds, C_RAWQ, R.rq, tid);
#pragma unroll
    for (int i = 0; i < 4; ++i) { const int p = tid + 512 * i, rr = p >> 4, q = p & 15; const float pd = R.pd[i];
        const unsigned sw[4] = {R.sp[i].x, R.sp[i].y, R.sp[i].z, R.sp[i].w}, gw[4] = {R.gs[i].x, R.gs[i].y, R.gs[i].z, R.gs[i].w}; unsigned ow[4];
#pragma unroll
        for (int j = 0; j < 4; ++j) ow[j] = cvtpk(pd * __uint_as_float(gw[j] << 16) + __uint_as_float(sw[j] << 16), pd * __uint_as_float(gw[j] & 0xffff0000u) + __uint_as_float(sw[j] & 0xffff0000u));
        *(__attribute__((address_space(3))) u32x4*)(lds + C_SP + (q >> 2) * 8192 + rr * 64 + (q & 3) * 16) = (u32x4){ow[0], ow[1], ow[2], ow[3]}; }
    if (nbh >= 0) hgC_load(R, PROJ, SP, GS, PD, nbh, nn, tid);
    __syncthreads();
    { float f[16], G[16], glast;
      gates(lds, C_PS, C_RAWF, SCAL[64 + h * 128 + d], tid, f, G, glast);
      const lds_h* rq = (const lds_h*)(lds + C_RAWQ) + part * 16 * 128 + d;
      lds_h* qt = (lds_h*)(lds + C_QT) + (d >> 3) * 512 + (d & 7) + part * 16 * 8; lds_h* kt = (lds_h*)(lds + C_KT) + (d >> 3) * 512 + (d & 7) + part * 16 * 8;
#pragma unroll
      for (int i = 0; i < 16; ++i) { const float q = bf2f(rq[i * 128]); const float eg = __expf(G[i]);
          qt[i * 8] = f2bf(q * sigm(q) * eg); kt[i * 8] = f2bf((1.f - f[i]) * __builtin_amdgcn_rcpf(eg)); } }
    __syncthreads();
    const int ct = w & 1, vb = w >> 1;
    bf16x8 qf[8];
    { const lds_cptr qp = (lds_cptr)(lds + C_QT) + hi * 1024 + (32 * ct + r32) * 16;
#pragma unroll
      for (int ks = 0; ks < 8; ++ks) qf[ks] = *(const __attribute__((address_space(3))) bf16x8*)(qp + ks * 2048); }
    f32x16 o = f32x16{};
#pragma unroll
    for (int sh = 0; sh < 2; ++sh) { if (sh <= ct) {
        const lds_cptr kp = (lds_cptr)(lds + C_KT) + hi * 1024 + (32 * sh + r32) * 16;
        f32x16 p = f32x16{};
#pragma unroll
        for (int ks = 0; ks < 8; ++ks) { const bf16x8 kf = *(const __attribute__((address_space(3))) bf16x8*)(kp + ks * 2048); p = __builtin_amdgcn_mfma_f32_32x32x16_bf16(kf, qf[ks], p, 0, 0, 0); }
        const int cc = 32 * ct + r32;
#pragma unroll
        for (int r = 0; r < 16; ++r) { const int s = 32 * sh + crow(r, hi); if (s > cc) p[r] = 0.f; }
        const bf16x8 pa0 = __builtin_bit_cast(bf16x8, (u32x4){cvtpk(p[0], p[1]), cvtpk(p[2], p[3]), cvtpk(p[4], p[5]), cvtpk(p[6], p[7])});
        const bf16x8 pa1 = __builtin_bit_cast(bf16x8, (u32x4){cvtpk(p[8], p[9]), cvtpk(p[10], p[11]), cvtpk(p[12], p[13]), cvtpk(p[14], p[15])});
        const lds_cptr vp = (lds_cptr)(lds + C_V) + vb * 4096 + ((lane >> 4) & 1) * 32 + (lane & 3) * 8 + (4 * hi + ((lane & 15) >> 2)) * 64 + sh * 2048;
        o = __builtin_amdgcn_mfma_f32_32x32x16_bf16(pa0, mkfrag(vtr(vp), vtr(vp + 512)), o, 0, 0, 0);
        o = __builtin_amdgcn_mfma_f32_32x32x16_bf16(pa1, mkfrag(vtr(vp + 1024), vtr(vp + 1024 + 512)), o, 0, 0, 0); } }
    { const lds_cptr sp = (lds_cptr)(lds + C_SP) + vb * 8192 + ((lane >> 4) & 1) * 32 + (lane & 3) * 8 + (8 * hi + ((lane & 15) >> 2)) * 64;
#pragma unroll
      for (int ks = 0; ks < 8; ++ks) o = __builtin_amdgcn_mfma_f32_32x32x16_bf16(qf[ks], mkfrag(vtr(sp + ks * 1024), vtr(sp + ks * 1024 + 256)), o, 0, 0, 0); }
    { lds_f* ot = (lds_f*)(lds + C_OT) + (32 * ct) * 128 + 32 * vb + r32;
#pragma unroll
      for (int r = 0; r < 16; ++r) ot[crow(r, hi) * 128] = o[r]; }
    __syncthreads();
    { const int c = tid >> 3, sg = tid & 7; const __attribute__((address_space(3))) at::u32x4* orow = (const __attribute__((address_space(3))) at::u32x4*)(lds + C_OT + c * 512 + sg * 64);
      float ov[16]; float ss = 0.f;
#pragma unroll
      for (int q = 0; q < 4; ++q) { const at::u32x4 t4 = orow[q]; ov[4 * q] = __uint_as_float(t4.x); ov[4 * q + 1] = __uint_as_float(t4.y); ov[4 * q + 2] = __uint_as_float(t4.z); ov[4 * q + 3] = __uint_as_float(t4.w); }
#pragma unroll
      for (int q = 0; q < 16; ++q) ss += ov[q] * ov[q];
      ss += __shfl_xor(ss, 1); ss += __shfl_xor(ss, 2); ss += __shfl_xor(ss, 4);
      const float rstd = rsqrtf(ss * (1.f / 128.f) + 1e-6f);
      const bf16_t* gp = PROJ + (tok0 + c) * 5632 + 3072 + h * 128 + sg * 16; const u32x4 g0 = *(const u32x4*)gp, g1 = *(const u32x4*)(gp + 8);
      const unsigned gw[8] = {g0.x, g0.y, g0.z, g0.w, g1.x, g1.y, g1.z, g1.w}; unsigned ow[8];
#pragma unroll
      for (int q = 0; q < 8; ++q) { const float ga = __uint_as_float(gw[q] << 16), gb = __uint_as_float(gw[q] & 0xffff0000u);
          const float ra = ov[2 * q] * rstd * hgnorm[sg * 16 + 2 * q] * (ga * sigm(ga)), rb = ov[2 * q + 1] * rstd * hgnorm[sg * 16 + 2 * q + 1] * (gb * sigm(gb));
          ow[q] = cvtpk(ra, rb); }
      bf16_t* dst = YB + (tok0 + c) * 512 + h * 128 + sg * 16; *(u32x4*)dst = (u32x4){ow[0], ow[1], ow[2], ow[3]}; *(u32x4*)(dst + 8) = (u32x4){ow[4], ow[5], ow[6], ow[7]}; }
}
}
namespace mk {
#ifndef G1_WGM
#define G1_WGM 8
#endif
using pg8::f32x4; using pg8::u32x4; using pg8::u32x2; using pg8::Unit;
constexpr int NWAVES = 8, NTHR = 512;
constexpr int RING_BYTES = 131072, LDSCTL_OFF = RING_BYTES, LDS_BYTES = 147456;
constexpr int LW_BAR = 0, LW_TPRE = 16  , LW_CNT = 64  , LW_MISC = 128;
enum Phase { PH_PRO = 0, PH_H1, PH_G1, PH_ROPE_HGA, PH_ATT_SCAN, PH_HGC, PH_G2A, PH_G2B, PH_G3, PH_TOK, PH_G4, PH_G5, PH_FIN, PH_N };

struct Args {
    const float* in[25]; float* out; unsigned char* ws; int ph_lo, ph_hi, li, pad;
};

__device__ __forceinline__ float wave_sum(float v) {
#pragma unroll
    for (int o = 1; o < 64; o <<= 1) v += __shfl_xor(v, o);
    return v;
}
__device__ __forceinline__ float sigm(float x) { return __builtin_amdgcn_rcpf(1.f + __expf(-x)); }
__device__ __forceinline__ unsigned pk2(float lo, float hi) { return at::cvtpk(lo, hi); }

__device__ __forceinline__ unsigned pk4_fp8(float a, float b, float c, float d) { unsigned w = __builtin_amdgcn_cvt_pk_fp8_f32(a, b, 0u, false); return __builtin_amdgcn_cvt_pk_fp8_f32(c, d, w, true); }
constexpr float S8_W = 64.f, S8_H = 4.f, S8_A = 4.f, S8_Y = 4.f;
struct EpiBf16 {
    static constexpr bool PERM = true;
    bf16_t* O; int ldc;
    __device__ __forceinline__ bool operator()(f32x4 (&acc)[2][2][4][2], const Unit& u, int wr, int wc, int fr, int fq) const {
        const int row0 = u.pm * 256 + wr * 64 + fr, col0 = u.pn * 256 + wc * 32 + 8 * fq;
#pragma unroll
        for (int ai = 0; ai < 2; ++ai)
#pragma unroll
            for (int m = 0; m < 4; ++m) { bf16_t* rowp = O + (size_t)(row0 + ai * 128 + m * 16) * ldc + col0;
#pragma unroll
                for (int bj = 0; bj < 2; ++bj) { const f32x4 v0 = acc[ai][bj][m][0], v1 = acc[ai][bj][m][1]; u32x4 w; w.x = pk2(v0[0], v0[1]); w.y = pk2(v0[2], v0[3]); w.z = pk2(v1[0], v1[1]); w.w = pk2(v1[2], v1[3]);
                    *(u32x4*)(rowp + bj * 128) = w; } }
        return false;
    }
};
struct EpiProj {
    static constexpr bool PERM = true;
    bf16_t* O; const float* ropec; const float* ropes; bf16_t* qimg; bf16_t* kimg; bf16_t* vimg; unsigned* kmaxp;
    __device__ __forceinline__ bool operator()(f32x4 (&acc)[2][2][4][2], const Unit& u, int wr, int wc, int fr, int fq) const {
        const int row0 = u.pm * 256 + wr * 64 + fr;
        if (u.pn >= 6) { const int col0 = u.pn * 256 + wc * 32 + 8 * fq;
#pragma unroll
            for (int ai = 0; ai < 2; ++ai)
#pragma unroll
                for (int m = 0; m < 4; ++m) { bf16_t* rowp = O + (size_t)(row0 + ai * 128 + m * 16) * 5632 + col0;
#pragma unroll
                    for (int bj = 0; bj < 2; ++bj) { const f32x4 v0 = acc[ai][bj][m][0], v1 = acc[ai][bj][m][1]; *(u32x4*)(rowp + bj * 128) = (u32x4){pk2(v0[0], v0[1]), pk2(v0[2], v0[3]), pk2(v1[0], v1[1]), pk2(v1[2], v1[3])}; } }
            return false; }
        const int b = u.pm >> 5, hb = 2 * (u.pn & 1);
        if (u.pn >= 4) {
#pragma unroll
            for (int ai = 0; ai < 2; ++ai)
#pragma unroll
                for (int m = 0; m < 4; ++m) { const int s = (row0 + ai * 128 + m * 16) & 8191, tile = s >> 6, key = s & 63;
#pragma unroll
                    for (int bj = 0; bj < 2; ++bj) { const f32x4 v0 = acc[ai][bj][m][0], v1 = acc[ai][bj][m][1];
                        *(u32x4*)(vimg + ((((size_t)(b * 4 + hb + bj) * 128 + tile) * 4 + wc) * 64 + key) * 32 + 8 * fq) = (u32x4){pk2(v0[0], v0[1]), pk2(v0[2], v0[3]), pk2(v1[0], v1[1]), pk2(v1[2], v1[3])}; } }
            return false; }
        const bool isk = u.pn >= 2; const int mm = wc >> 1, w = wc & 1, d0 = 16 * w + 4 * fq; const float sc = isk ? 1.f : at::C2;
        bf16_t* img = isk ? kimg : qimg; float nmax[2] = {0.f, 0.f};
#pragma unroll
        for (int ai = 0; ai < 2; ++ai)
#pragma unroll
            for (int m = 0; m < 4; ++m) { const int s = (row0 + ai * 128 + m * 16) & 8191, tile = s >> 6, key = s & 63;
                const f32x4 cs = *(const f32x4*)(ropec + s * 32 + d0), sn = *(const f32x4*)(ropes + s * 32 + d0);
#pragma unroll
                for (int bj = 0; bj < 2; ++bj) { const f32x4 x1 = acc[ai][bj][m][0], x2 = acc[ai][bj][m][1]; const f32x4 o1 = (x1 * cs - x2 * sn) * sc, o2 = (x2 * cs + x1 * sn) * sc;
                    bf16_t* dst = img + ((((size_t)(b * 4 + hb + bj) * 128 + tile) * 16 + mm * 8 + (d0 >> 3)) * 64 + key) * 8 + (d0 & 7);
                    *(u32x2*)dst = (u32x2){pk2(o1[0], o1[1]), pk2(o1[2], o1[3])}; *(u32x2*)(dst + 4 * 512) = (u32x2){pk2(o2[0], o2[1]), pk2(o2[2], o2[3])};
                    if (isk) { const float ss = (o1[0] * o1[0] + o1[1] * o1[1]) + (o1[2] * o1[2] + o1[3] * o1[3]) + (o2[0] * o2[0] + o2[1] * o2[1]) + (o2[2] * o2[2] + o2[3] * o2[3]); nmax[bj] = fmaxf(nmax[bj], ss); } } }
        if (isk) {
#pragma unroll
            for (int bj = 0; bj < 2; ++bj) { float mx = nmax[bj];
#pragma unroll
                for (int of = 1; of < 16; of <<= 1) mx = fmaxf(mx, __shfl_xor(mx, of));
                if (fr == 0) atomicMax(kmaxp + (((b * 4 + hb + bj) * 2 + mm) * 8 + w * 4 + fq), __float_as_uint(mx)); } }
        return false;
    }
};
struct EpiF32 {
    static constexpr bool PERM = false;
    float* O; int ldc;
    __device__ __forceinline__ bool operator()(f32x4 (&acc)[2][2][4][2], const Unit& u, int wr, int wc, int fr, int fq) const {
        const int row0 = u.pm * 256 + wr * 64 + fr, col0 = u.pn * 256 + wc * 32 + 4 * fq;
#pragma unroll
        for (int ai = 0; ai < 2; ++ai)
#pragma unroll
            for (int m = 0; m < 4; ++m) { float* rowp = O + (size_t)(row0 + ai * 128 + m * 16) * ldc + col0;
#pragma unroll
                for (int bj = 0; bj < 2; ++bj)
#pragma unroll
                    for (int n = 0; n < 2; ++n) *(f32x4*)(rowp + bj * 128 + n * 16) = acc[ai][bj][m][n]; }
        return false;
    }
};
struct EpiBranch2 {
    static constexpr bool PERM = true;
    const bf16_t* proj; bf16_t* merged;
    __device__ __forceinline__ bool operator()(f32x4 (&acc)[2][2][4][2], const Unit& u, int wr, int wc, int fr, int fq) const {
        const int row0 = u.pm * 256 + wr * 64 + fr, col0 = u.pn * 256 + wc * 32 + 8 * fq; const bool first = (u.z == 0);
#pragma unroll
        for (int ai = 0; ai < 2; ++ai)
#pragma unroll
            for (int m = 0; m < 4; ++m) { const size_t row = (size_t)(row0 + ai * 128 + m * 16);
#pragma unroll
                for (int bj = 0; bj < 2; ++bj) { const int col = col0 + bj * 128;
                    const u32x4 gb = __builtin_nontemporal_load((const u32x4*)(proj + row * 5632 + 4608 + col)); const unsigned gbw[4] = {gb.x, gb.y, gb.z, gb.w}; float eb[8];
#pragma unroll
                    for (int q = 0; q < 4; ++q) { eb[2 * q] = __expf(-__uint_as_float(gbw[q] << 16)); eb[2 * q + 1] = __expf(-__uint_as_float(gbw[q] & 0xffff0000u)); }
                    if (first) { const u32x4 ga = __builtin_nontemporal_load((const u32x4*)(proj + row * 5632 + 3584 + col)); const unsigned gaw[4] = {ga.x, ga.y, ga.z, ga.w};
#pragma unroll
                        for (int q = 0; q < 4; ++q) { const float ea0 = __expf(-__uint_as_float(gaw[q] << 16)), ea1 = __expf(-__uint_as_float(gaw[q] & 0xffff0000u));
                            acc[ai][bj][m][q >> 1][(2 * q) & 3] *= (1.f + eb[2 * q]) * __builtin_amdgcn_rcpf(1.f + ea0); acc[ai][bj][m][q >> 1][(2 * q + 1) & 3] *= (1.f + eb[2 * q + 1]) * __builtin_amdgcn_rcpf(1.f + ea1); } }
                    else { unsigned w[4];
#pragma unroll
                        for (int q = 0; q < 4; ++q) w[q] = pk2(acc[ai][bj][m][q >> 1][(2 * q) & 3] * __builtin_amdgcn_rcpf(1.f + eb[2 * q]), acc[ai][bj][m][q >> 1][(2 * q + 1) & 3] * __builtin_amdgcn_rcpf(1.f + eb[2 * q + 1]));
                        *(u32x4*)(merged + row * 1024 + col) = (u32x4){w[0], w[1], w[2], w[3]}; } } }
        return first;
    }
};
struct EpiGateUp {
    static constexpr bool PERM = true;
    const float* bgu; unsigned char* act;
    __device__ __forceinline__ bool operator()(f32x4 (&acc)[2][2][4][2], const Unit& u, int wr, int wc, int fr, int fq) const {
        const int e = u.z, colA = u.pn * 128 + wc * 32 + 8 * fq;
        constexpr float DQ = 1.f / (S8_W * S8_H);
        f32x4 bg[2], bu[2];
#pragma unroll
        for (int n = 0; n < 2; ++n) { bg[n] = *(const f32x4*)(bgu + e * 2048 + colA + 4 * n); bu[n] = *(const f32x4*)(bgu + e * 2048 + 1024 + colA + 4 * n); }
#pragma unroll
        for (int ai = 0; ai < 2; ++ai)
#pragma unroll
            for (int m = 0; m < 4; ++m) { const size_t slot = (size_t)(u.arow + ai * 128 + wr * 64 + m * 16 + fr); unsigned w[2];
#pragma unroll
                for (int n = 0; n < 2; ++n) { float r[4];
#pragma unroll
                    for (int j = 0; j < 4; ++j) { float gg = acc[ai][0][m][n][j] * DQ + bg[n][j], uu = acc[ai][1][m][n][j] * DQ + bu[n][j]; gg = fminf(gg, 7.f); uu = fminf(fmaxf(uu, -7.f), 7.f); r[j] = (uu + 1.f) * gg * sigm(1.702f * gg) * S8_A; }
                    w[n] = pk4_fp8(r[0], r[1], r[2], r[3]); }
                *(u32x2*)(act + slot * 1024 + colA) = (u32x2){w[0], w[1]}; }
        return false;
    }
};
struct EpiDown {
    static constexpr bool PERM = true;
    const float* bd; const int* list; unsigned char* ym; const LAS int* cnt;
    __device__ __forceinline__ bool operator()(f32x4 (&acc)[2][2][4][2], const Unit& u, int wr, int wc, int fr, int fq) const {
        const int e = u.z, nvalid = cnt[e] - u.pm * 256, col0 = u.pn * 256 + wc * 32 + 8 * fq;
        constexpr float DQ = S8_Y / (S8_W * S8_A);
        f32x4 bv[2][2];
#pragma unroll
        for (int bj = 0; bj < 2; ++bj)
#pragma unroll
            for (int n = 0; n < 2; ++n) bv[bj][n] = *(const f32x4*)(bd + e * 1024 + col0 + bj * 128 + 4 * n) * S8_Y;
#pragma unroll
        for (int ai = 0; ai < 2; ++ai)
#pragma unroll
            for (int m = 0; m < 4; ++m) { const int r = ai * 128 + wr * 64 + m * 16 + fr;
                if (r < nvalid) { const int a = list[(size_t)e * 32768 + u.pm * 256 + r]; unsigned char* rowp = ym + (size_t)a * 1024 + col0;
#pragma unroll
                    for (int bj = 0; bj < 2; ++bj) { const f32x4 v0 = acc[ai][bj][m][0] * DQ + bv[bj][0], v1 = acc[ai][bj][m][1] * DQ + bv[bj][1];
                        *(u32x2*)(rowp + bj * 128) = (u32x2){pk4_fp8(v0[0], v0[1], v0[2], v0[3]), pk4_fp8(v1[0], v1[1], v1[2], v1[3])}; } } }
        return false;
    }
};
struct MoeOrder {
    const LAS int* tpre; const LAS int* cnt; const int* list; int nN, G, c, rowpitch  , brows  ; LAS int* idxbuf  ;
    __device__ bool next(int i, Unit& u) const {
        const int nwg = tpre[32] * nN; const long L = (long)i * G + c; if (L >= nwg) return false;
        int wgid = (int)L; { const int q = nwg / 8, r = nwg % 8, xcd = wgid % 8, off = wgid / 8; wgid = (xcd < r ? xcd * (q + 1) : r * (q + 1) + (xcd - r) * q) + off; }
        int e = 0;
#pragma unroll 1
        for (int s = 16; s > 0; s >>= 1) { if (tpre[e + s] * nN <= wgid) e += s; }
        const int w = wgid - tpre[e] * nN, nM = tpre[e + 1] - tpre[e];
        const int nig = 8 * nN, gid = w / nig, fm = gid * 8, gsz = (nM - fm) < 8 ? (nM - fm) : 8;
        u.pm = fm + ((w % nig) % gsz); u.pn = (w % nig) / gsz; u.z = e; u.arow = (tpre[e] + u.pm) * 256; u.brow = e * brows + u.pn * 256; return true;
    }
    __device__ __forceinline__ unsigned row_off(const Unit& u, int r) const {
        const int lr = u.pm * 256 + r; const int a = list[(size_t)u.z * 32768 + (lr < cnt[u.z] ? lr : 0)]; return (unsigned)(a >> 2) * (unsigned)rowpitch;
    }
    __device__ __forceinline__ const int* idx_src(const Unit& u) const { return list + (size_t)u.z * 32768 + u.pm * 256; }
    __device__ __forceinline__ unsigned off_from_idx(int a) const { unsigned tk = (unsigned)a >> 2; tk = tk < (unsigned)T ? tk : (unsigned)(T - 1); return tk * (unsigned)rowpitch; }
};

__device__ __forceinline__ int rope_pos(int d) { const int e = d & 31; return 32 * (e >> 4) + 8 * ((e >> 2) & 3) + 4 * (d >> 5) + (e & 3); }
template <bool RPERM = false>
__device__ __forceinline__ void transpose_item(const float* W, int K, int N, bf16_t* WT, int k0, int n0, int dst_row0, LAS unsigned* scr, int lane) {
    const int cg = lane & 15, rp = lane >> 4;
    const float* src = W + (size_t)(k0 + 2 * rp) * N + n0 + 4 * cg;
#pragma unroll
    for (int q = 0; q < 8; ++q) { const f32x4 a = __builtin_nontemporal_load((const f32x4*)(src + (size_t)(8 * q) * N)), b = __builtin_nontemporal_load((const f32x4*)(src + (size_t)(8 * q + 1) * N));
#pragma unroll
        for (int c = 0; c < 4; ++c) scr[(4 * cg + c) * 33 + 4 * q + rp] = pk2(a[c], b[c]); }
    asm volatile("s_waitcnt lgkmcnt(0)" ::: "memory");
    const int nl = lane >> 3, wq = lane & 7;
#pragma unroll
    for (int i = 0; i < 8; ++i) { const LAS unsigned* s = scr + (8 * i + nl) * 33 + 4 * wq; u32x4 o; o.x = s[0]; o.y = s[1]; o.z = s[2]; o.w = s[3];
        *(u32x4*)(WT + (size_t)(dst_row0 + (RPERM ? rope_pos(8 * i + nl) : 8 * i + nl)) * K + k0 + 8 * wq) = o; }
    asm volatile("s_waitcnt lgkmcnt(0)" ::: "memory");
}
__device__ __forceinline__ void transpose_item8(const float* W, int K, int N, unsigned char* WT, int k0, int n0, int dst_row0, LAS unsigned* scr, int lane) {
    const int cg = lane & 15, rp = lane >> 4;
    const float* src = W + (size_t)(k0 + 4 * rp) * N + n0 + 4 * cg;
#pragma unroll
    for (int q = 0; q < 4; ++q) { f32x4 a[4];
#pragma unroll
        for (int r = 0; r < 4; ++r) a[r] = __builtin_nontemporal_load((const f32x4*)(src + (size_t)(16 * q + r) * N));
#pragma unroll
        for (int c = 0; c < 4; ++c) scr[(4 * cg + c) * 17 + 4 * q + rp] = pk4_fp8(a[0][c] * S8_W, a[1][c] * S8_W, a[2][c] * S8_W, a[3][c] * S8_W); }
    asm volatile("s_waitcnt lgkmcnt(0)" ::: "memory");
    const int nl = lane >> 2, wq = lane & 3;
#pragma unroll
    for (int i = 0; i < 4; ++i) { const LAS unsigned* s = scr + (16 * i + nl) * 17 + 4 * wq; u32x4 o; o.x = s[0]; o.y = s[1]; o.z = s[2]; o.w = s[3];
        *(u32x4*)(WT + (size_t)(dst_row0 + 16 * i + nl) * K + k0 + 16 * wq) = o; }
    asm volatile("s_waitcnt lgkmcnt(0)" ::: "memory");
}
template <bool GU>
__device__ __forceinline__ void transpose_matrix8(const float* W, int K, int N, unsigned char* WT, LAS unsigned* scr, int lane, int gw, int NGW, int& itbase) {
    const int nblk = N / 64, nitems = (K / 64) * nblk;
    int first = (gw - itbase) % NGW; if (first < 0) first += NGW;
    for (int it = first; it < nitems; it += NGW) { const int kb = it / nblk, nb = it % nblk, n0 = nb * 64;
        int dst = n0; if (GU) { const int nn = n0 & 1023; dst = (nn >> 7) * 256 + (n0 >> 10) * 128 + (nn & 127); }
        transpose_item8(W, K, N, WT, kb * 64, n0, dst, scr, lane); }
    itbase += nitems;
}
template <bool GU, bool QK = false>
__device__ __forceinline__ void transpose_matrix(const float* W, int K, int N, bf16_t* WT, LAS unsigned* scr, int lane, int gw, int NGW, int& itbase) {
    const int nblk = N / 64, nitems = (K / 64) * nblk;
    int first = (gw - itbase) % NGW; if (first < 0) first += NGW;
    for (int it = first; it < nitems; it += NGW) { const int kb = it / nblk, nb = it % nblk, n0 = nb * 64;
        int dst = n0; if (GU) { const int nn = n0 & 1023; dst = (nn >> 7) * 256 + (n0 >> 10) * 128 + (nn & 127); }
        if (QK && n0 < 1024) transpose_item<true>(W, K, N, WT, kb * 64, n0, dst, scr, lane); else transpose_item<false>(W, K, N, WT, kb * 64, n0, dst, scr, lane); }
    itbase += nitems;
}

#define MOD ((float*)(ws + WS_SMALL))
#define SCAL ((float*)(ws + WS_SMALL + 128 * 1024))
#define ROPEC ((float*)(ws + WS_ROPEC))
#define ROPES ((float*)(ws + WS_ROPES))
#define TOPI ((int*)(ws + WS_TOPI))
#define TOPW ((float*)(ws + WS_TOPW))
#define LIST ((int*)(ws + WS_LIST))
#define RWT ((bf16_t*)(ws + WS_RWT))
#define CNT ((int*)(ws + WS_CTL) + CW_CNT)
#define H ((bf16_t*)(ws + WS_H))
#define QR ((bf16_t*)(ws + WS_Y + 64 * MiB))
#define KIMG ((bf16_t*)(ws + WS_Y + 96 * MiB))
#define VIMG ((bf16_t*)(ws + WS_YB))
#define PROJ ((bf16_t*)(ws + WS_PROJ))
#define YA ((bf16_t*)(ws + WS_YA))
#define YB ((bf16_t*)(ws + WS_YB))
#define DS ((bf16_t*)(ws + WS_DS))
#define DEC ((float*)(ws + WS_DEC))
#define TG ((float*)(ws + WS_DS))
#define GS ((bf16_t*)(ws + WS_DS + 16 * 1048576))
#define DG ((float*)(ws + WS_DEC + 2 * 1048576))
#define MERGED ((bf16_t*)(ws + WS_MERGED))
#define SP ((bf16_t*)(ws + WS_MERGED))
#define Y ((float*)(ws + WS_Y))
#define YH ((bf16_t*)(ws + WS_Y))
#define ACT ((bf16_t*)(ws + WS_ACT))
#define YM ((bf16_t*)(ws + WS_YM))
#define WT_IN ((bf16_t*)(ws + WS_WIN))
#define WT_A ((bf16_t*)(ws + WS_WA))
#define WT_B ((bf16_t*)(ws + WS_WB))
#define WT_O ((bf16_t*)(ws + WS_WO))
#define WT_GU ((bf16_t*)(ws + WS_WGU))
#define WT_GU8 ((unsigned char*)(ws + WS_WGU))
#define WT_D8 ((unsigned char*)(ws + WS_WD))
#define H8 ((unsigned char*)(ws + WS_H))
#define ACT8 ((unsigned char*)(ws + WS_ACT))
#define YM8 ((unsigned char*)(ws + WS_YM))
#define WT_D ((bf16_t*)(ws + WS_WD))
#define PHASE_BEGIN unsigned char* ws = args.ws; asm volatile("" : "+s"(ws)); int tid = threadIdx.x; asm volatile("" : "+v"(tid)); const int lane = tid & 63; (void)lane; const float* x = args.in[0]; float* out = args.out; (void)x; (void)out;
__global__ void __launch_bounds__(NTHR, 2) mega(Args args) {
    extern __shared__ __attribute__((aligned(16))) unsigned char lds_[];
    LAS unsigned char* lds = (LAS unsigned char*)lds_;
    volatile LAS unsigned* LW = (volatile LAS unsigned*)(lds + LDSCTL_OFF);
    const int tid = threadIdx.x, lane = tid & 63, wave = __builtin_amdgcn_readfirstlane(tid >> 6);
    const int G = gridDim.x; const int bx = blockIdx.x; const int vcu = (G % 8 == 0) ? (bx % 8) * (G / 8) + bx / 8 : bx;
    const int gw = vcu * NWAVES + wave, NGW = G * NWAVES;
    unsigned* CTL = (unsigned*)(args.ws + WS_CTL);
    for (int u = tid; u < (LDS_BYTES - LDSCTL_OFF) / 4; u += NTHR) ((LAS unsigned*)(lds + LDSCTL_OFF))[u] = 0u;
    __syncthreads();
    const int lo = args.ph_lo, hi = args.ph_hi;
    XcdBarrier bar; bar.bar = CTL + CW_BAR + args.li * 4096; bar.x = 0; bar.st = nullptr;
    if (hi - lo > 1) bar = xcd_barrier_post(CTL + CW_BAR + args.li * 4096, LW + LW_BAR);
#ifndef PHMASK
#define PHMASK 0xffff
#endif
#ifndef DUP_PHASE
#define DUP_PHASE -1
#endif
#define IN(k) ((((PHMASK) >> (k)) & 1) && lo <= (k) && (k) < hi)
#define REPS(k) (((k) == DUP_PHASE) ? 2 : 1)
#ifdef PROBE_SPAN
#define STAMP(k) do { if (bx == 0 && threadIdx.x == 0) { const unsigned long long t_ = __builtin_amdgcn_s_memrealtime(); LW[160 + 2 * (k)] = (unsigned)t_; LW[161 + 2 * (k)] = (unsigned)(t_ >> 32); } } while (0)
#else
#define STAMP(k) do { } while (0)
#endif
#define SEAM(k) do { if (IN(k) && IN((k) + 1)) xcd_barrier(bar); STAMP((k) + 1); } while (0)

    STAMP(0);
    if (IN(PH_PRO)) for (int rep_ = 0; rep_ < REPS(PH_PRO); ++rep_) {
        PHASE_BEGIN
        __syncthreads();
        const float* c = args.in[1]; const float* w_mod = args.in[2]; const float* b_mod = args.in[3];
        LAS float* cact = (LAS float*)lds; LAS float* red = cact + 4096;
        for (int i = tid; i < 4096; i += NTHR) { const float cv = c[i]; cact[i] = cv / (1.f + expf(-cv)); }
        __syncthreads();
        for (int it = vcu; it < 192; it += G) { const int j0 = it * 32, kq = tid >> 5, col = tid & 31; float acc[4] = {0.f, 0.f, 0.f, 0.f};
            const float* wp = w_mod + (size_t)(kq * 64) * 6144 + j0 + col;
#pragma unroll 1
            for (int k = 0; k < 64; k += 16) { float wv[16];
#pragma unroll
                for (int i = 0; i < 16; ++i) wv[i] = wp[(size_t)(k + i) * 6144];
#pragma unroll
                for (int i = 0; i < 16; ++i) {
#pragma unroll
                    for (int b = 0; b < 4; ++b) acc[b] += cact[b * 1024 + kq * 64 + k + i] * wv[i]; } }
#pragma unroll
            for (int b = 0; b < 4; ++b) red[(kq * 4 + b) * 32 + col] = acc[b];
            __syncthreads();
            if (tid < 128) { const int b = tid >> 5, cc = tid & 31; float s = 0.f;
#pragma unroll
                for (int q = 0; q < 16; ++q) s += red[(q * 4 + b) * 32 + cc];
                MOD[b * 6144 + j0 + cc] = s + b_mod[j0 + cc]; }
            __syncthreads(); }
        const int gt = vcu * NTHR + tid, NGT = G * NTHR;
        if (gt == 0) { const float* q1 = args.in[7]; const float* k1 = args.in[8]; const float* q2 = args.in[9]; const float* k2 = args.in[10]; float s1 = 0.f, s2 = 0.f;
            for (int i = 0; i < 64; ++i) { s1 += q1[i] * k1[i]; s2 += q2[i] * k2[i]; } SCAL[0] = expf(s1) - expf(s2) + 0.2f; }
        if (gt < 512) { const float* lbl = args.in[12]; SCAL[64 + gt] = 1.f / (1.f + expf(lbl[512 + gt] - lbl[gt])); }
        for (int i = gt; i < 8192 * 32; i += NGT) { const int s = i >> 5, j = i & 31; const float inv = powf(10000.f, -(float)(2 * j) / 64.f); const float ang = (float)s * inv; ROPEC[i] = cosf(ang); ROPES[i] = sinf(ang); }
        for (int i = gt; i < 32768; i += NGT) { const int e = i >> 10, k = i & 1023; const float wv = args.in[19][k * 32 + e]; const bf16_t hb = f2bf(wv); RWT[i] = hb; RWT[32768 + i] = f2bf(wv - bf2f(hb)); }
        LAS unsigned* scr = (LAS unsigned*)(lds + wave * 16384); int itbase = 0;
        transpose_matrix<false, true>(args.in[6], 1024, 5632, WT_IN, scr, lane, gw, NGW, itbase);
        transpose_matrix<false>(args.in[14], 512, 1024, WT_A, scr, lane, gw, NGW, itbase);
        transpose_matrix<false>(args.in[15], 512, 1024, WT_B, scr, lane, gw, NGW, itbase);
        transpose_matrix<false>(args.in[16], 1024, 1024, WT_O, scr, lane, gw, NGW, itbase);
        for (int e = 0; e < 32; ++e) transpose_matrix8<true>(args.in[21] + (size_t)e * 1024 * 2048, 1024, 2048, WT_GU8 + (size_t)e * 2048 * 1024, scr, lane, gw, NGW, itbase);
        for (int e = 0; e < 32; ++e) transpose_matrix8<false>(args.in[23] + (size_t)e * 1024 * 1024, 1024, 1024, WT_D8 + (size_t)e * 1024 * 1024, scr, lane, gw, NGW, itbase);
    }
    SEAM(PH_PRO);
#ifdef EXTRA_BARRIERS
    for (int eb = 0; eb < EXTRA_BARRIERS; ++eb) xcd_barrier(bar);
#endif
    if (IN(PH_H1)) for (int rep_ = 0; rep_ < REPS(PH_H1); ++rep_) {
        PHASE_BEGIN
        const float* w = args.in[4];
        { constexpr int NR_ = 4;
        for (int row0 = gw; row0 < T; row0 += NR_ * NGW) { f32x4 v[NR_][4]; float ss[NR_]; int rows[NR_];
#pragma unroll
            for (int q = 0; q < NR_; ++q) { rows[q] = (row0 + q * NGW < T) ? row0 + q * NGW : row0; const f32x4* xr = (const f32x4*)(x + (size_t)rows[q] * 1024) + lane; ss[q] = 0.f;
#pragma unroll
                for (int j = 0; j < 4; ++j) v[q][j] = __builtin_nontemporal_load(xr + 64 * j); }
#pragma unroll
            for (int q = 0; q < NR_; ++q) {
#pragma unroll
                for (int j = 0; j < 4; ++j) ss[q] += (v[q][j][0] * v[q][j][0] + v[q][j][1] * v[q][j][1]) + (v[q][j][2] * v[q][j][2] + v[q][j][3] * v[q][j][3]);
                ss[q] = rsqrtf(wave_sum(ss[q]) * (1.f / 1024.f) + 1e-6f); }
#pragma unroll
            for (int j = 0; j < 4; ++j) { const int col = 4 * lane + 256 * j; const f32x4 wv = *(const f32x4*)(w + col);
#pragma unroll
                for (int q = 0; q < NR_; ++q) { const int b = rows[q] >> 13; const f32x4 sc = *(const f32x4*)(MOD + b * 6144 + 1024 + col), sh = *(const f32x4*)(MOD + b * 6144 + col);
                    const f32x4 h = v[q][j] * ss[q] * wv * (sc + 1.f) + sh; u32x2 o; o.x = pk2(h[0], h[1]); o.y = pk2(h[2], h[3]); *(u32x2*)(H + (size_t)rows[q] * 1024 + col) = o; } } } }
    }
    SEAM(PH_H1);
    if (IN(PH_G1)) for (int rep_ = 0; rep_ < REPS(PH_G1); ++rep_) {
        PHASE_BEGIN
        pg8::Gemm g{H, WT_IN, 1024, nullptr, nullptr}; pg8::DenseOrder S; S.init(T, NC, G, bx, G1_WGM);
        EpiProj E{PROJ, ROPEC, ROPES, QR, KIMG, VIMG, (unsigned*)(ws + WS_CTL) + CW_KMAX};
        pg8::gemm_phase<EpiProj, pg8::DenseOrder, false>(lds, g, S, E);
    }
    SEAM(PH_G1);
    if (IN(PH_ROPE_HGA)) for (int rep_ = 0; rep_ < REPS(PH_ROPE_HGA); ++rep_) {
        PHASE_BEGIN
        for (int grp = vcu; grp < 256; grp += G) hg::hgA_group(lds, PROJ, SCAL, SP, DEC, TG, DG, grp >> 4, grp & 15, tid);
        __syncthreads();
    }
    SEAM(PH_ROPE_HGA);
    if (IN(PH_ATT_SCAN)) for (int rep_ = 0; rep_ < REPS(PH_ATT_SCAN); ++rep_) {
        PHASE_BEGIN
        for (int gid = vcu * NTHR + tid; gid < 16 * 128 * 64; gid += G * NTHR) { const int bh = gid >> 13, d = (gid >> 6) & 127, v2 = gid & 63; float s0 = 0.f, s1 = 0.f;
            const float* tp = TG + ((size_t)(bh * 16) * 128 + d) * 128 + 2 * v2; const float* dp = DG + (bh * 16) * 128 + d; bf16_t* gp = GS + ((size_t)(bh * 16) * 128 + d) * 128 + 2 * v2;
            pg8::f32x2 tv[16]; float dv[16];
#pragma unroll
            for (int g = 0; g < 16; ++g) { tv[g] = __builtin_nontemporal_load((const pg8::f32x2*)(tp + (size_t)g * 16384)); dv[g] = dp[g * 128]; }
#pragma unroll
            for (int g = 0; g < 16; ++g) { *(unsigned*)(gp + (size_t)g * 16384) = pk2(s0, s1); s0 = dv[g] * s0 + tv[g][0]; s1 = dv[g] * s1 + tv[g][1]; } }
        { const float lam = SCAL[0]; const float* subln = args.in[11];
          for (int it = vcu; it < 1024; it += G) { int bh, blk;
              if (G == 256) { const int i = it >> 8, v = it & 255, s = v & 15; bh = v >> 4; blk = (i == 0) ? 63 - s : (i == 1) ? 32 + s : (i == 2) ? 31 - s : s; }
              else { blk = 63 - (it >> 4); bh = it & 15; }
              at::attn_unit(lds, QR, KIMG, VIMG, YA, subln, lam, (const unsigned*)(ws + WS_CTL) + CW_KMAX, bh >> 2, bh & 3, blk, tid); } }
    }
    SEAM(PH_ATT_SCAN);
    if (IN(PH_HGC)) for (int rep_ = 0; rep_ < REPS(PH_HGC); ++rep_) {
        PHASE_BEGIN
        const float* hgnorm = args.in[13];
        { hg::CRegs R; if (vcu < 256) hg::hgC_load(R, PROJ, SP, GS, DEC, vcu >> 4, 8 * (vcu & 15), tid);
          for (int grp = vcu; grp < 256; grp += G)
#pragma unroll 1
              for (int k = 0; k < 8; ++k) { const int bh = grp >> 4, n = 8 * (grp & 15) + k; const int ng = (k < 7) ? grp : grp + G; const int nbh = (ng < 256) ? (ng >> 4) : -1, nn = (k < 7) ? n + 1 : 8 * (ng & 15);
                  hg::hgC_unit(lds, R, PROJ, SCAL, SP, GS, DEC, hgnorm, YB, bh, n, nbh, nn, tid); } }
        __syncthreads();
    }
    SEAM(PH_HGC);
    if (IN(PH_G2A)) for (int rep_ = 0; rep_ < REPS(PH_G2A); ++rep_) {
        PHASE_BEGIN
        pg8::Gemm g{YA, WT_A, 512, YB, WT_B}; pg8::DenseOrder2 S; S.base.init(T, 1024, G, bx);
        EpiBranch2 E{PROJ, MERGED};
        pg8::gemm_phase<EpiBranch2, pg8::DenseOrder2, false, true>(lds, g, S, E);
    }
    SEAM(PH_G2B);
    if (IN(PH_G3)) for (int rep_ = 0; rep_ < REPS(PH_G3); ++rep_) {
        PHASE_BEGIN
        pg8::Gemm g{MERGED, WT_O, 1024, nullptr, nullptr}; pg8::DenseOrder S; S.init(T, 1024, G, bx);
        EpiBf16 E{YH, 1024};
        pg8::gemm_phase<EpiBf16, pg8::DenseOrder, false>(lds, g, S, E);
    }
    SEAM(PH_G3);
    if (IN(PH_TOK)) for (int rep_ = 0; rep_ < REPS(PH_TOK); ++rep_) {
        PHASE_BEGIN
        const float* wpm = args.in[5]; const float* wpf = args.in[17]; const float* rb = args.in[20];
        const int wv_ = __builtin_amdgcn_readfirstlane(tid >> 6), r32 = lane & 31, hi = lane >> 5;
        LAS int* lcnt = (LAS int*)lds; LAS int* lbase = lcnt + 32; LAS int* asg = lcnt + 64;
        LAS float* rstd2 = (LAS float*)(lds + 4096);
        LAS float* XC = (LAS float*)(lds + 8192);
        LAS float* LG = (LAS float*)(lds + 24576);
        LAS float* CM = (LAS float*)(lds + 41984); LAS float* SHV = CM + 1024;
        for (int chunk = vcu; chunk < T / 128; chunk += G) { const int b = chunk >> 6;
            __syncthreads();
            if (tid < 32) lcnt[tid] = 0;
            for (int i = tid; i < 1024; i += NTHR) { CM[i] = wpf[i] * (1.f + MOD[b * 6144 + 4096 + i]); SHV[i] = MOD[b * 6144 + 3072 + i]; }
            __syncthreads();
            { constexpr int NR_ = 4; for (int i = 0; i < 16; i += NR_) { const int rloc = wv_ * 16 + i, row = chunk * 128 + rloc;
                f32x4 v[NR_][4], xv[NR_][4]; float ss[NR_], rs[NR_];
#pragma unroll
                for (int q = 0; q < NR_; ++q) ss[q] = 0.f;
#pragma unroll
                for (int q = 0; q < NR_; ++q) { const u32x2* yr = (const u32x2*)(YH + (size_t)(row + q) * 1024) + lane; const f32x4* xr = (const f32x4*)(x + (size_t)(row + q) * 1024) + lane;
#pragma unroll
                    for (int j = 0; j < 4; ++j) { const u32x2 yw = __builtin_nontemporal_load(yr + 64 * j); v[q][j] = (f32x4){__uint_as_float(yw.x << 16), __uint_as_float(yw.x & 0xffff0000u), __uint_as_float(yw.y << 16), __uint_as_float(yw.y & 0xffff0000u)}; xv[q][j] = __builtin_nontemporal_load(xr + 64 * j); } }
#pragma unroll
                for (int q = 0; q < NR_; ++q)
#pragma unroll
                    for (int j = 0; j < 4; ++j) ss[q] += (v[q][j][0] * v[q][j][0] + v[q][j][1] * v[q][j][1]) + (v[q][j][2] * v[q][j][2] + v[q][j][3] * v[q][j][3]);
                #pragma unroll
                for (int q = 0; q < NR_; ++q) { rs[q] = rsqrtf(wave_sum(ss[q]) * (1.f / 1024.f) + 1e-6f); ss[q] = 0.f; }
#pragma unroll
                for (int j = 0; j < 4; ++j) { const int col = 4 * lane + 256 * j; const f32x4 g1 = *(const f32x4*)(MOD + b * 6144 + 2048 + col), wv = *(const f32x4*)(wpm + col);
#pragma unroll
                    for (int q = 0; q < NR_; ++q) { v[q][j] = xv[q][j] + g1 * v[q][j] * rs[q] * wv; *(f32x4*)(out + (size_t)(row + q) * 1024 + col) = v[q][j];
                        ss[q] += (v[q][j][0] * v[q][j][0] + v[q][j][1] * v[q][j][1]) + (v[q][j][2] * v[q][j][2] + v[q][j][3] * v[q][j][3]); } }
                #pragma unroll
                for (int q = 0; q < NR_; ++q) { rs[q] = rsqrtf(wave_sum(ss[q]) * (1.f / 1024.f) + 1e-6f); if (lane == 0) rstd2[rloc + q] = rs[q]; }
#pragma unroll
                for (int j = 0; j < 4; ++j) { const int col = 4 * lane + 256 * j; const f32x4 cm = *(const LAS f32x4*)(CM + col), sh = *(const LAS f32x4*)(SHV + col);
#pragma unroll
                    for (int q = 0; q < NR_; ++q) { const f32x4 h = (v[q][j] * rs[q] * cm + sh) * S8_H; *(unsigned*)(H8 + (size_t)(row + q) * 1024 + col) = pk4_fp8(h[0], h[1], h[2], h[3]); } } } }
            asm volatile("s_waitcnt vmcnt(0)" ::: "memory");
            __syncthreads();
            { const int rt = wv_ & 3, kh = wv_ >> 2; const int rloc = 32 * rt + r32; const float rs = rstd2[rloc];
              const float* xrow = out + (size_t)(chunk * 128 + rloc) * 1024 + 512 * kh + 8 * hi; const bf16_t* whi = RWT + (size_t)r32 * 1024 + 512 * kh + 8 * hi; const bf16_t* wlo = whi + 32768;
              const LAS float* cmp = CM + 512 * kh + 8 * hi; const LAS float* shp = SHV + 512 * kh + 8 * hi;
              at::f32x16 acc = at::f32x16{};
#pragma unroll 4
              for (int ks = 0; ks < 32; ++ks) { const f32x4 xa = __builtin_nontemporal_load((const f32x4*)(xrow + 16 * ks)), xb = __builtin_nontemporal_load((const f32x4*)(xrow + 16 * ks + 4));
                  const f32x4 ca = *(const LAS f32x4*)(cmp + 16 * ks), cb = *(const LAS f32x4*)(cmp + 16 * ks + 4), sa = *(const LAS f32x4*)(shp + 16 * ks), sb = *(const LAS f32x4*)(shp + 16 * ks + 4);
                  const f32x4 ha = xa * rs * ca + sa, hb = xb * rs * cb + sb;
                  const unsigned h0 = at::cvtpk(ha[0], ha[1]), h1 = at::cvtpk(ha[2], ha[3]), h2 = at::cvtpk(hb[0], hb[1]), h3 = at::cvtpk(hb[2], hb[3]);
                  const unsigned l0 = at::cvtpk(ha[0] - __uint_as_float(h0 << 16), ha[1] - __uint_as_float(h0 & 0xffff0000u)), l1 = at::cvtpk(ha[2] - __uint_as_float(h1 << 16), ha[3] - __uint_as_float(h1 & 0xffff0000u));
                  const unsigned l2 = at::cvtpk(hb[0] - __uint_as_float(h2 << 16), hb[1] - __uint_as_float(h2 & 0xffff0000u)), l3 = at::cvtpk(hb[2] - __uint_as_float(h3 << 16), hb[3] - __uint_as_float(h3 & 0xffff0000u));
                  const at::bf16x8 ahi = __builtin_bit_cast(at::bf16x8, (u32x4){h0, h1, h2, h3}), alo = __builtin_bit_cast(at::bf16x8, (u32x4){l0, l1, l2, l3});
                  const at::bf16x8 bhi = *(const at::bf16x8*)(whi + 16 * ks), blo = *(const at::bf16x8*)(wlo + 16 * ks);
                  acc = __builtin_amdgcn_mfma_f32_32x32x16_bf16(ahi, bhi, acc, 0, 0, 0); acc = __builtin_amdgcn_mfma_f32_32x32x16_bf16(ahi, blo, acc, 0, 0, 0); acc = __builtin_amdgcn_mfma_f32_32x32x16_bf16(alo, bhi, acc, 0, 0, 0); }
              if (kh == 1) {
#pragma unroll
                  for (int r = 0; r < 16; ++r) XC[(rt * 16 + r) * 64 + lane] = acc[r]; }
              __syncthreads();
              if (kh == 0) { const float bias = rb[r32];
#pragma unroll
                  for (int r = 0; r < 16; ++r) LG[(32 * rt + at::crow(r, hi)) * 33 + r32] = acc[r] + XC[(rt * 16 + r) * 64 + lane] + bias; }
              __syncthreads(); }
            if (tid < 128) { const int rloc = tid, row = chunk * 128 + rloc; float lg[32];
#pragma unroll
                for (int e = 0; e < 32; ++e) lg[e] = LG[rloc * 33 + e];
                int bi[4]; float bv[4];
#pragma unroll
                for (int k = 0; k < 4; ++k) { float best = -3.0e38f; int be = 0;
#pragma unroll
                    for (int e = 0; e < 32; ++e) { bool taken = false;
#pragma unroll
                        for (int q = 0; q < 4; ++q) if (q < k && bi[q] == e) taken = true;
                        if (!taken && lg[e] > best) { best = lg[e]; be = e; } }
                    bi[k] = be; bv[k] = best; }
                const float e1 = expf(bv[1] - bv[0]), e2 = expf(bv[2] - bv[0]), e3 = expf(bv[3] - bv[0]); const float inv = 1.f / (1.f + e1 + e2 + e3);
                if (rep_ == REPS(PH_TOK) - 1) { *(f32x4*)(TOPW + row * 4) = (f32x4){inv, e1 * inv, e2 * inv, e3 * inv};
                    *(u32x4*)(TOPI + row * 4) = (u32x4){(unsigned)bi[0], (unsigned)bi[1], (unsigned)bi[2], (unsigned)bi[3]};
#pragma unroll
                    for (int k = 0; k < 4; ++k) { const int pos = __hip_atomic_fetch_add(lcnt + bi[k], 1, __ATOMIC_RELAXED, __HIP_MEMORY_SCOPE_WORKGROUP); asg[rloc * 4 + k] = (bi[k] << 16) | pos; } } }
            __syncthreads();
            if (tid < 32) lbase[tid] = atomicAdd(&CNT[tid], lcnt[tid]);
            __syncthreads();
            if (rep_ == REPS(PH_TOK) - 1) { const int v = asg[tid], e = v >> 16, pos = v & 0xffff; LIST[(size_t)e * 32768 + lbase[e] + pos] = chunk * 512 + tid; }
        }
        __syncthreads();
    }
    SEAM(PH_TOK);
    if (IN(PH_G4) || IN(PH_G5)) {
        PHASE_BEGIN
        if (tid < 32) ((LAS int*)LW)[LW_CNT + tid] = __hip_atomic_load(&CNT[tid], __ATOMIC_RELAXED, __HIP_MEMORY_SCOPE_AGENT);
        __syncthreads();
        if (tid == 0) { int s = 0; for (int e = 0; e < 32; ++e) { ((LAS int*)LW)[LW_TPRE + e] = s; s += (((LAS int*)LW)[LW_CNT + e] + 255) >> 8; } ((LAS int*)LW)[LW_TPRE + 32] = s; }
        __syncthreads();
    }
    if (IN(PH_G4)) for (int rep_ = 0; rep_ < REPS(PH_G4); ++rep_) {
        PHASE_BEGIN
        pg8::Gemm g{(const bf16_t*)H8, (const bf16_t*)WT_GU8, 512, nullptr, nullptr}; MoeOrder S{(const LAS int*)LW + LW_TPRE, (const LAS int*)LW + LW_CNT, LIST, 8, G, bx, 1024, 2048, (LAS int*)LW + 1024};
        EpiGateUp E{args.in[22], ACT8};
        pg8::gemm_phase<EpiGateUp, MoeOrder, true, false, true>(lds, g, S, E);
    }
    SEAM(PH_G4);
    if (IN(PH_G5)) for (int rep_ = 0; rep_ < REPS(PH_G5); ++rep_) {
        PHASE_BEGIN
        pg8::Gemm g{(const bf16_t*)ACT8, (const bf16_t*)WT_D8, 512, nullptr, nullptr}; MoeOrder S{(const LAS int*)LW + LW_TPRE, (const LAS int*)LW + LW_CNT, LIST, 4, G, bx, 1024, 1024, (LAS int*)LW + 1024};
        EpiDown E{args.in[24], LIST, YM8, (const LAS int*)LW + LW_CNT};
        pg8::gemm_phase<EpiDown, MoeOrder, false, false, true>(lds, g, S, E);
    }
    SEAM(PH_G5);
    if (IN(PH_FIN)) for (int rep_ = 0; rep_ < REPS(PH_FIN); ++rep_) {
        PHASE_BEGIN
        const float* w = args.in[18];
        for (int row0 = gw; row0 < T; row0 += 2 * NGW) { f32x4 v[2][4], ov[2][4]; float ss[2] = {0.f, 0.f}; int rows[2] = {row0, (row0 + NGW < T) ? row0 + NGW : row0};
#pragma unroll
            for (int q = 0; q < 2; ++q) { const int row = rows[q]; const f32x4 tw = *(const f32x4*)(TOPW + row * 4) * (1.f / S8_Y); const unsigned char* y0 = YM8 + (size_t)row * 4096;
#pragma unroll
                for (int j = 0; j < 4; ++j) { const int col = 4 * lane + 256 * j; f32x4 a = (f32x4){0.f, 0.f, 0.f, 0.f};
#pragma unroll
                    for (int k = 0; k < 4; ++k) { const unsigned yw = __builtin_nontemporal_load((const unsigned*)(y0 + k * 1024 + col)); const pg8::f32x2 lo = __builtin_amdgcn_cvt_pk_f32_fp8(yw, false), hi = __builtin_amdgcn_cvt_pk_f32_fp8(yw, true);
                        a[0] += tw[k] * lo[0]; a[1] += tw[k] * lo[1]; a[2] += tw[k] * hi[0]; a[3] += tw[k] * hi[1]; }
                    v[q][j] = a; ov[q][j] = __builtin_nontemporal_load((const f32x4*)(out + (size_t)row * 1024 + col)); ss[q] += (a[0] * a[0] + a[1] * a[1]) + (a[2] * a[2] + a[3] * a[3]); } }
            const float rs[2] = {rsqrtf(wave_sum(ss[0]) * (1.f / 1024.f) + 1e-6f), rsqrtf(wave_sum(ss[1]) * (1.f / 1024.f) + 1e-6f)};
#pragma unroll
            for (int q = 0; q < 2; ++q) { const int row = rows[q], b = row >> 13; if (q == 1 && rows[1] == rows[0]) break;
#pragma unroll
                for (int j = 0; j < 4; ++j) { const int col = 4 * lane + 256 * j; const f32x4 g2 = *(const f32x4*)(MOD + b * 6144 + 5120 + col), wv = *(const f32x4*)(w + col);
                    const f32x4 res = ov[q][j] + g2 * v[q][j] * rs[q] * wv; if (rep_ == REPS(PH_FIN) - 1) *(f32x4*)(out + (size_t)row * 1024 + col) = res; else asm volatile("" :: "v"(res)); } } }
    }
#ifdef PROBE_SPAN
    STAMP(PH_N);
    if (bx == 0 && threadIdx.x == 0) { const unsigned long long t0_ = ((unsigned long long)LW[161 + 2 * (PROBE_SPAN)] << 32) | LW[160 + 2 * (PROBE_SPAN)], t1_ = ((unsigned long long)LW[161 + 2 * (PROBE_SPAN_END)] << 32) | LW[160 + 2 * (PROBE_SPAN_END)];
        const unsigned long long until_ = __builtin_amdgcn_s_memrealtime() + 4ull * (t1_ - t0_);
        while (__builtin_amdgcn_s_memrealtime() < until_) __builtin_amdgcn_s_sleep(8); }
#endif
#undef IN
#undef SEAM
}
}
#undef MOD
#undef SCAL
#undef ROPEC
#undef ROPES
#undef TOPI
#undef TOPW
#undef LIST
#undef RWT
#undef CNT
#undef H
#undef QR
#undef KIMG
#undef VIMG
#undef PROJ
#undef YA
#undef YB
#undef DS
#undef DEC
#undef TG
#undef GS
#undef DG
#undef MERGED
#undef SP
#undef Y
#undef YH
#undef ACT
#undef YM
#undef WT_IN
#undef WT_A
#undef WT_B
#undef WT_O
#undef WT_GU
#undef WT_GU8
#undef WT_D8
#undef H8
#undef ACT8
#undef YM8
#undef WT_D
#undef PHASE_BEGIN

#ifndef FASTMASK
#define FASTMASK 0x1fff
#endif

extern "C" void kernel_launch(void* const* d_in, const int* in_sizes, int n_in, void* d_out, int out_size, void* d_ws, size_t ws_size, hipStream_t stream) {
    if (n_in != 25 || out_size != T * D || ws_size < WS_END) { fprintf(stderr, "kernel_launch: unexpected shapes / workspace (%d inputs, out %d, ws %zu)\n", n_in, out_size, ws_size); return; }
    const float* x = (const float*)d_in[0]; const float* c = (const float*)d_in[1]; const float* w_mod = (const float*)d_in[2]; const float* b_mod = (const float*)d_in[3];
    const float* norm_pre_mix = (const float*)d_in[4]; const float* norm_post_mix = (const float*)d_in[5]; const float* w_in = (const float*)d_in[6];
    const float* lq1 = (const float*)d_in[7]; const float* lk1 = (const float*)d_in[8]; const float* lq2 = (const float*)d_in[9]; const float* lk2 = (const float*)d_in[10];
    const float* subln = (const float*)d_in[11]; const float* lbl = (const float*)d_in[12]; const float* hgnorm = (const float*)d_in[13];
    const float* wa = (const float*)d_in[14]; const float* wb = (const float*)d_in[15]; const float* wo = (const float*)d_in[16];
    const float* norm_pre_ffn = (const float*)d_in[17]; const float* norm_post_ffn = (const float*)d_in[18]; const float* rw = (const float*)d_in[19]; const float* rb = (const float*)d_in[20];
    const float* wgu = (const float*)d_in[21]; const float* bgu = (const float*)d_in[22]; const float* wd = (const float*)d_in[23]; const float* bd = (const float*)d_in[24];
    unsigned char* ws = (unsigned char*)d_ws; float* out = (float*)d_out;
    float* MOD = (float*)(ws + WS_SMALL); float* SCAL = (float*)(ws + WS_SMALL + 128 * 1024); int* PADS = (int*)(ws + WS_SMALL + 192 * 1024);
    float* ROPEC = (float*)(ws + WS_ROPEC); float* ROPES = (float*)(ws + WS_ROPES);
    int* TOPI = (int*)(ws + WS_TOPI); float* TOPW = (float*)(ws + WS_TOPW); int* LIST = (int*)(ws + WS_LIST); int* CNT = (int*)(ws + WS_CTL) + CW_CNT;
    bf16_t* H = (bf16_t*)(ws + WS_H); bf16_t* PROJ = (bf16_t*)(ws + WS_PROJ); bf16_t* YA = (bf16_t*)(ws + WS_YA); bf16_t* YB = (bf16_t*)(ws + WS_YB);
    bf16_t* DS = (bf16_t*)(ws + WS_DS); float* DEC = (float*)(ws + WS_DEC); bf16_t* MERGED = (bf16_t*)(ws + WS_MERGED); float* Y = (float*)(ws + WS_Y);
    bf16_t* SP = (bf16_t*)(ws + WS_MERGED);
    bf16_t* ACT = (bf16_t*)(ws + WS_ACT); bf16_t* YM = (bf16_t*)(ws + WS_YM);

    static int grid = 0;
    if (grid == 0) {
        (void)hipFuncSetAttribute((const void*)nv::k_attn, hipFuncAttributeMaxDynamicSharedMemorySize, nv::AT_LDS);
        (void)hipFuncSetAttribute((const void*)nv::k_hgA, hipFuncAttributeMaxDynamicSharedMemorySize, 65536);
        (void)hipFuncSetAttribute((const void*)nv::k_hgC, hipFuncAttributeMaxDynamicSharedMemorySize, nv::HC_LDS);
        (void)hipFuncSetAttribute((const void*)mk::mega, hipFuncAttributeMaxDynamicSharedMemorySize, mk::LDS_BYTES);
        int dev = 0, cus = 0; (void)hipGetDevice(&dev); (void)hipDeviceGetAttribute(&cus, hipDeviceAttributeMultiprocessorCount, dev);
        (void)hipGetLastError();
        grid = cus > 0 ? cus : 256;
    }
    (void)hipMemsetAsync(ws + WS_CTL, 0, 1 * MiB, stream);
    mk::Args a{}; for (int i = 0; i < 25; ++i) a.in[i] = (const float*)d_in[i]; a.out = out; a.ws = ws;
    const unsigned fast = FASTMASK; int li = 0;
    for (int p = 0; p < mk::PH_N;) {
        if (fast & (1u << p)) { int q = p; while (q < mk::PH_N && (fast & (1u << q))) ++q;
            a.ph_lo = p; a.ph_hi = q; a.li = li++; a.pad = 0;
            hipLaunchKernelGGL(mk::mega, dim3(grid), dim3(mk::NTHR), mk::LDS_BYTES, stream, a);
            p = q; continue; }
        switch (p) {
        case mk::PH_PRO:
            nv::k_mod<<<dim3(24, 4), 256, 0, stream>>>(c, w_mod, b_mod, MOD);
            nv::k_small<<<1024, 256, 0, stream>>>(lq1, lk1, lq2, lk2, lbl, SCAL, ROPEC, ROPES); break;
        case mk::PH_H1: nv::k_rowmod<<<T / 4, 256, 0, stream>>>(x, norm_pre_mix, MOD, H, 0, 1024); break;
        case mk::PH_G1: { nv::NG p_{}; p_.A = H; p_.lda = 1024; p_.M = T; p_.B = w_in; p_.ldb = NC; p_.K = 1024;
            nv::k_gemm<nv::EpiStoreBf16, 1><<<dim3(NC / 64, T / 64, 1), 256, 0, stream>>>(p_, nv::EpiStoreBf16{PROJ, (long long)NC}); } break;
        case mk::PH_ROPE_HGA: nv::k_hgA<<<dim3(128, 4, 4), 256, 65536, stream>>>(PROJ, SCAL, DS, DEC); break;
        case mk::PH_ATT_SCAN:
            nv::k_attn<<<dim3(128, 4, 4), 256, nv::AT_LDS, stream>>>(PROJ, ROPEC, ROPES, SCAL, subln, YA);
            nv::k_scan<<<1024, 256, 0, stream>>>(DS, DEC, SP); break;
        case mk::PH_HGC: nv::k_hgC<<<dim3(128, 4, 4), 256, nv::HC_LDS, stream>>>(PROJ, SCAL, SP, hgnorm, YB); break;
        case mk::PH_G2A: { nv::NG p_{}; p_.A = YA; p_.lda = 512; p_.M = T; p_.B = wa; p_.ldb = 1024; p_.K = 512;
            nv::k_gemm<nv::EpiBranchA, 1><<<dim3(16, T / 64, 1), 256, 0, stream>>>(p_, nv::EpiBranchA{out, PROJ}); } break;
        case mk::PH_G2B: { nv::NG p_{}; p_.A = YB; p_.lda = 512; p_.M = T; p_.B = wb; p_.ldb = 1024; p_.K = 512;
            nv::k_gemm<nv::EpiBranchB, 1><<<dim3(16, T / 64, 1), 256, 0, stream>>>(p_, nv::EpiBranchB{out, PROJ, MERGED}); } break;
        case mk::PH_G3: { nv::NG p_{}; p_.A = MERGED; p_.lda = 1024; p_.M = T; p_.B = wo; p_.ldb = 1024; p_.K = 1024;
            nv::k_gemm<nv::EpiStoreF32, 1><<<dim3(16, T / 64, 1), 256, 0, stream>>>(p_, nv::EpiStoreF32{Y, 1024LL}); } break;
        case mk::PH_TOK:
            nv::k_x1<<<T / 4, 256, 0, stream>>>(x, Y, norm_post_mix, MOD, 2048LL, out);
            nv::k_rowmod<<<T / 4, 256, 0, stream>>>(out, norm_pre_ffn, MOD, H, 3072, 4096);
            nv::k_route<<<T / 4, 256, 0, stream>>>(out, norm_pre_ffn, MOD, rw, rb, TOPI, TOPW);
            nv::k_lists<<<T * 4 / 256, 256, 0, stream>>>(TOPI, CNT, LIST);
            nv::k_pads<<<1, 64, 0, stream>>>(CNT, PADS); break;
        case mk::PH_G4: { nv::NG p_{}; p_.A = H; p_.lda = 1024; p_.rowidx = LIST; p_.idxstride = 32768; p_.idxshift = 2; p_.cnt = CNT; p_.rowbase = PADS; p_.B = wgu; p_.strideB = (size_t)1024 * 2048; p_.ldb = 2048; p_.K = 1024; p_.b1off = 1024;
            nv::k_gemm<nv::EpiGateUp, 2><<<dim3(16, T / 64, 32), 256, 0, stream>>>(p_, nv::EpiGateUp{bgu, ACT}); } break;
        case mk::PH_G5: { nv::NG p_{}; p_.A = ACT; p_.lda = 1024; p_.cnt = CNT; p_.rowbase = PADS; p_.B = wd; p_.strideB = (size_t)1024 * 1024; p_.ldb = 1024; p_.K = 1024;
            nv::k_gemm<nv::EpiDown, 1><<<dim3(16, T / 64, 32), 256, 0, stream>>>(p_, nv::EpiDown{bd, LIST, YM}); } break;
        case mk::PH_FIN: nv::k_final<<<T / 4, 256, 0, stream>>>(out, YM, TOPW, norm_post_ffn, MOD); break;
        }
        ++p;
    }
}
```
